# Optimizing an MI355X kernel written in HIP

```python
import math
import jax, jax.numpy as jnp
from jax import lax
import numpy as np


D_MODEL = 1024
BATCH = 8
SEQ = 2048
DEPTH = 2

RMS_EPS = 1e-6
HEAD_DIM = 64
A_Q_HEADS = 8
A_KV_HEADS = 2
A_GROUP = A_Q_HEADS // A_KV_HEADS
A_WINDOW = 128
B_HEADS = 8
ATTN_BLOCK = 128
EVEN_IN = (A_Q_HEADS + 2 * A_KV_HEADS + 3 * B_HEADS) * HEAD_DIM + B_HEADS
EVEN_MIX = (A_Q_HEADS + B_HEADS) * HEAD_DIM
C_HEADS = 16
C_HEAD_DIM = 64
C_INNER = C_HEADS * C_HEAD_DIM
C_GROUPS = 2
C_HPG = C_HEADS // C_GROUPS
C_STATE = 128
C_CONV = 4
C_CHUNK = 128
C_CONV_DIM = C_INNER + 2 * C_GROUPS * C_STATE
D_HEADS = 4
D_KEY = D_MODEL // 2
D_VAL = D_MODEL
D_HK = D_KEY // D_HEADS
D_HV = D_VAL // D_HEADS
D_GATE_RANK = 16
D_GATE_NORM = 16.0
D_CHUNK = 64
ODD_IN = C_INNER + C_CONV_DIM + C_HEADS + 2 * D_KEY + D_VAL + D_GATE_RANK + D_VAL
ODD_MIX = C_INNER + D_VAL
MOE_GROUPS = 4
MOE_EPG = 8
MOE_EXPERTS = MOE_GROUPS * MOE_EPG
MOE_TOPK = 2
MOE_FF = 512
MOE_BLOCK = 128
N_EVEN = (DEPTH + 1) // 2
N_ODD = DEPTH // 2

kernel_name = 'hybrid_swa_fox_ssd_gla_hmoe'


def rmsnorm(x, g):
    xf = x.astype(jnp.float32)
    y = xf * lax.rsqrt(jnp.mean(xf * xf, axis=-1, keepdims=True) + RMS_EPS)
    return (y * g.astype(jnp.float32)).astype(x.dtype)


def split_cols(p, widths):
    offs = [int(o) for o in np.cumsum(widths)[:-1]]
    return jnp.split(p, offs, axis=-1)


def alibi_slopes(n_heads):
    return jnp.asarray(2.0 ** (-8.0 * np.arange(1, n_heads + 1) / n_heads), dtype=jnp.float32)


def sliding_window_sink_attention(q, k, v, sinks):
    b, s, kvh, g, hd = q.shape
    blk = A_WINDOW
    nb = s // blk

    def windows(t):
        tp = jnp.pad(t, ((0, 0), (blk, 0), (0, 0), (0, 0))).reshape(b, nb + 1, blk, kvh, hd)
        return jnp.concatenate([tp[:, :-1], tp[:, 1:]], axis=2)

    kw, vw = windows(k), windows(v)
    qb = q.reshape(b, nb, blk, kvh, g, hd)
    scores = jnp.einsum('bnqkgd,bnskd->bnkgqs', qb, kw).astype(jnp.float32) * (hd ** -0.5)
    dist = blk + jnp.arange(blk)[:, None] - jnp.arange(2 * blk)[None, :]
    key_pos = jnp.arange(nb)[:, None, None] * blk + jnp.arange(2 * blk)[None, None, :] - blk
    valid = (dist >= 0) & (dist < A_WINDOW) & (key_pos >= 0)
    slopes = alibi_slopes(kvh * g).reshape(kvh, g, 1, 1)
    scores = scores - slopes * dist.astype(jnp.float32)
    scores = jnp.where(valid[None, :, None, None], scores, -jnp.inf)
    sink = sinks.astype(jnp.float32).reshape(1, 1, kvh, g, 1, 1)
    m = jnp.maximum(jnp.max(scores, axis=-1, keepdims=True), sink)
    p = jnp.exp(scores - m)
    p = p / (jnp.sum(p, axis=-1, keepdims=True) + jnp.exp(sink - m))
    out = jnp.einsum('bnkgqs,bnskd->bnqkgd', p.astype(v.dtype), vw)
    return out.reshape(b, s, kvh * g, hd)


def forgetting_attention(q, k, v, log_f):
    b, s, h, hd = q.shape
    nb = s // ATTN_BLOCK
    c = jnp.transpose(jnp.cumsum(log_f, axis=1), (0, 2, 1))
    kpos = jnp.arange(s)

    def block(n):
        start = n * ATTN_BLOCK
        qb = lax.dynamic_slice_in_dim(q, start, ATTN_BLOCK, axis=1)
        cb = lax.dynamic_slice_in_dim(c, start, ATTN_BLOCK, axis=2)
        sc = jnp.einsum('bqhd,bshd->bhqs', qb, k).astype(jnp.float32) * (hd ** -0.5)
        sc = sc + cb[..., None] - c[:, :, None, :]
        qpos = start + jnp.arange(ATTN_BLOCK)
        sc = jnp.where(kpos[None, :] <= qpos[:, None], sc, -jnp.inf)
        p = jax.nn.softmax(sc, axis=-1).astype(v.dtype)
        return jnp.einsum('bhqs,bshd->bqhd', p, v)

    out = lax.map(block, jnp.arange(nb))
    return jnp.transpose(out, (1, 0, 2, 3, 4)).reshape(b, s, h, hd)


def causal_depthwise_conv(x, w, bias):
    kw, ch = w.shape
    y = lax.conv_general_dilated(x, w[:, None, :].astype(x.dtype), window_strides=(1,), padding=[(kw - 1, 0)],
                                 dimension_numbers=('NWC', 'WIO', 'NWC'), feature_group_count=ch)
    return y + bias.astype(y.dtype)


def ssd_chunked(x, dt, a, bm, cm):
    b, s, g, hg, p = x.shape
    n = bm.shape[-1]
    q = C_CHUNK
    nc = s // q
    xd = (x.astype(jnp.float32) * dt[..., None]).reshape(b, nc, q, g, hg, p)
    acs = jnp.cumsum(jnp.transpose((dt * a).reshape(b, nc, q, g, hg), (0, 3, 4, 1, 2)), axis=-1)
    bc = bm.astype(jnp.float32).reshape(b, nc, q, g, n)
    cc = cm.astype(jnp.float32).reshape(b, nc, q, g, n)
    tri = jnp.tril(jnp.ones((q, q), dtype=bool))
    seg = jnp.exp(jnp.where(tri, acs[..., :, None] - acs[..., None, :], -jnp.inf))
    cb = jnp.einsum('bclgn,bcsgn->bgcls', cc, bc)
    y_diag = jnp.einsum('bgcls,bghcls,bcsghp->bclghp', cb, seg, xd)
    decay_to_end = jnp.exp(acs[..., -1:] - acs)
    states = jnp.einsum('bcsgn,bghcs,bcsghp->bcghpn', bc, decay_to_end, xd)
    chunk_decay = jnp.exp(acs[..., -1])

    def step(hstate, inp):
        st, dec = inp
        return hstate * dec[..., None, None] + st, hstate

    h0 = jnp.zeros((b, g, hg, p, n), jnp.float32)
    _, prev = lax.scan(step, h0, (jnp.moveaxis(states, 1, 0), jnp.moveaxis(chunk_decay, 3, 0)))
    y_off = jnp.einsum('bclgn,cbghpn,bghcl->bclghp', cc, prev, jnp.exp(acs))
    return (y_diag + y_off).reshape(b, s, g, hg, p)


def gla_chunked(q, k, v, log_alpha):
    b, s, h, dk = q.shape
    dv = v.shape[-1]
    cq = D_CHUNK
    nc = s // cq
    qc = (q.astype(jnp.float32) * (dk ** -0.5)).reshape(b, nc, cq, h, dk)
    kc = k.astype(jnp.float32).reshape(b, nc, cq, h, dk)
    vc = v.astype(jnp.float32).reshape(b, nc, cq, h, dv)
    gcs = jnp.cumsum(log_alpha.reshape(b, nc, cq, h, dk), axis=2)
    q_dec = qc * jnp.exp(gcs)
    k_inv = kc * jnp.exp(-gcs)
    k_end = kc * jnp.exp(gcs[:, :, -1:] - gcs)
    tri = jnp.tril(jnp.ones((cq, cq), dtype=bool))
    attn = jnp.where(tri, jnp.einsum('bclhd,bcshd->bchls', q_dec, k_inv), 0.0)
    o_intra = jnp.einsum('bchls,bcshv->bclhv', attn, vc)
    states = jnp.einsum('bcshd,bcshv->bchdv', k_end, vc)
    chunk_decay = jnp.exp(gcs[:, :, -1])

    def step(hstate, inp):
        st, dec = inp
        return hstate * dec[..., None] + st, hstate

    h0 = jnp.zeros((b, h, dk, dv), jnp.float32)
    _, prev = lax.scan(step, h0, (jnp.moveaxis(states, 1, 0), jnp.moveaxis(chunk_decay, 1, 0)))
    o_inter = jnp.einsum('bclhd,cbhdv->bclhv', q_dec, prev)
    return (o_intra + o_inter).reshape(b, s, h, dv)


def even_mixer(h, w_in, sinks, forget_bias, w_out):
    b, s, _ = h.shape
    proj = h @ w_in
    q_a, k_a, v_a, q_b, k_b, v_b, f_b = split_cols(
        proj, (A_Q_HEADS * HEAD_DIM, A_KV_HEADS * HEAD_DIM, A_KV_HEADS * HEAD_DIM,
               B_HEADS * HEAD_DIM, B_HEADS * HEAD_DIM, B_HEADS * HEAD_DIM, B_HEADS))
    out_a = sliding_window_sink_attention(q_a.reshape(b, s, A_KV_HEADS, A_GROUP, HEAD_DIM),
                                          k_a.reshape(b, s, A_KV_HEADS, HEAD_DIM),
                                          v_a.reshape(b, s, A_KV_HEADS, HEAD_DIM), sinks)
    log_f = jax.nn.log_sigmoid(f_b.astype(jnp.float32) + forget_bias.astype(jnp.float32))
    out_b = forgetting_attention(q_b.reshape(b, s, B_HEADS, HEAD_DIM), k_b.reshape(b, s, B_HEADS, HEAD_DIM),
                                 v_b.reshape(b, s, B_HEADS, HEAD_DIM), log_f)
    heads = jnp.concatenate([out_a.reshape(b, s, -1), out_b.reshape(b, s, -1)], axis=-1).astype(h.dtype)
    return heads @ w_out


def odd_mixer(h, w_in, conv_w, conv_b, dt_bias, a_log, d_skip, ssd_norm, gk_w, gk_b, gla_norm, w_out):
    b, s, _ = h.shape
    proj = h @ w_in
    z, xbc, dt, q, k, v, g_lr, r = split_cols(
        proj, (C_INNER, C_CONV_DIM, C_HEADS, D_KEY, D_KEY, D_VAL, D_GATE_RANK, D_VAL))
    xbc = jax.nn.silu(causal_depthwise_conv(xbc, conv_w, conv_b))
    xs, bm, cm = split_cols(xbc, (C_INNER, C_GROUPS * C_STATE, C_GROUPS * C_STATE))
    dt = jax.nn.softplus(dt.astype(jnp.float32) + dt_bias.astype(jnp.float32)).reshape(b, s, C_GROUPS, C_HPG)
    a = -jnp.exp(a_log.astype(jnp.float32)).reshape(C_GROUPS, C_HPG)
    xs = xs.reshape(b, s, C_GROUPS, C_HPG, C_HEAD_DIM)
    y = ssd_chunked(xs, dt, a, bm.reshape(b, s, C_GROUPS, C_STATE), cm.reshape(b, s, C_GROUPS, C_STATE))
    y = y + d_skip.astype(jnp.float32).reshape(C_GROUPS, C_HPG, 1) * xs.astype(jnp.float32)
    y = rmsnorm(y.reshape(b, s, C_INNER) * jax.nn.silu(z.astype(jnp.float32)), ssd_norm)
    log_alpha = jax.nn.log_sigmoid((g_lr @ gk_w + gk_b).astype(jnp.float32)) / D_GATE_NORM
    o = gla_chunked(q.reshape(b, s, D_HEADS, D_HK), k.reshape(b, s, D_HEADS, D_HK),
                    v.reshape(b, s, D_HEADS, D_HV), log_alpha.reshape(b, s, D_HEADS, D_HK))
    o = rmsnorm(o, gla_norm).reshape(b, s, D_VAL) * jax.nn.silu(r.astype(jnp.float32))
    mixed = jnp.concatenate([y, o], axis=-1).astype(h.dtype)
    return mixed @ w_out


def hierarchical_moe(h, w_group, b_group, w_router, b_router, w_gate, w_up, w_down):
    b, s, d = h.shape
    n_tok = b * s
    xt = h.reshape(n_tok, d)
    g_prob = jax.nn.softmax((xt @ w_group).astype(jnp.float32) + b_group.astype(jnp.float32), axis=-1)
    g_w, g_idx = lax.top_k(g_prob, 1)
    e_logits = ((xt @ w_router).astype(jnp.float32) + b_router.astype(jnp.float32)).reshape(n_tok, MOE_GROUPS, MOE_EPG)
    e_logits = jnp.take_along_axis(e_logits, g_idx[:, :, None], axis=1)[:, 0]
    e_w, e_idx = lax.top_k(jax.nn.softmax(e_logits, axis=-1), MOE_TOPK)
    e_w = e_w / jnp.sum(e_w, axis=-1, keepdims=True)
    gate = (g_w * e_w).reshape(-1)
    expert = (g_idx * MOE_EPG + e_idx).reshape(-1).astype(jnp.int32)
    token = jnp.repeat(jnp.arange(n_tok, dtype=jnp.int32), MOE_TOPK)
    n_assign = n_tok * MOE_TOPK
    order = jnp.argsort(expert)
    expert_s, token_s, gate_s = expert[order], token[order], gate[order]
    counts = jnp.zeros((MOE_EXPERTS,), jnp.int32).at[expert].add(1)
    starts = jnp.cumsum(counts) - counts
    padded = (counts + MOE_BLOCK - 1) // MOE_BLOCK * MOE_BLOCK
    pad_ends = jnp.cumsum(padded)
    pad_starts = pad_ends - padded
    row = pad_starts[expert_s] + (jnp.arange(n_assign, dtype=jnp.int32) - starts[expert_s])
    n_blocks = (n_assign + MOE_EXPERTS * (MOE_BLOCK - 1) + MOE_BLOCK - 1) // MOE_BLOCK
    n_rows = n_blocks * MOE_BLOCK
    row_token = jnp.full((n_rows,), n_tok, jnp.int32).at[row].set(token_s)
    row_gate = jnp.zeros((n_rows,), jnp.float32).at[row].set(gate_s)
    block_start = jnp.arange(n_blocks, dtype=jnp.int32) * MOE_BLOCK
    block_expert = jnp.minimum(jnp.sum(block_start[:, None] >= pad_ends[None, :], axis=1),
                               MOE_EXPERTS - 1).astype(jnp.int32)
    x_rows = jnp.concatenate([xt, jnp.zeros((1, d), xt.dtype)], axis=0)[row_token].reshape(n_blocks, MOE_BLOCK, d)

    def expert_block(args):
        xb, e = args
        return (jax.nn.silu(xb @ w_gate[e]) * (xb @ w_up[e])) @ w_down[e]

    y_rows = lax.map(expert_block, (x_rows, block_expert)).reshape(n_rows, d)
    y = jax.ops.segment_sum(y_rows.astype(jnp.float32) * row_gate[:, None], row_token, num_segments=n_tok + 1)[:n_tok]
    return y.reshape(b, s, d).astype(h.dtype)


def setup_inputs(seed: int = 0) -> dict:
    key = jax.random.key(seed)
    ks = jax.random.split(key, 26)
    f32 = jnp.float32

    def nrm(k, shape, scale):
        return jax.random.normal(k, shape, f32) * scale

    dt0 = jnp.exp(jax.random.uniform(ks[11], (N_ODD, C_HEADS), f32) * (math.log(0.1) - math.log(0.001)) + math.log(0.001))
    return {
        'x': nrm(ks[0], (BATCH, SEQ, D_MODEL), 1.0),
        'norm_mix': 1.0 + nrm(ks[1], (DEPTH, D_MODEL), 0.02),
        'norm_moe': 1.0 + nrm(ks[2], (DEPTH, D_MODEL), 0.02),
        'norm_final': 1.0 + nrm(ks[3], (D_MODEL,), 0.02),
        'even_w_in': nrm(ks[4], (N_EVEN, D_MODEL, EVEN_IN), D_MODEL ** -0.5),
        'even_sinks': nrm(ks[5], (N_EVEN, A_Q_HEADS), 0.5),
        'even_forget_bias': 4.0 + nrm(ks[6], (N_EVEN, B_HEADS), 0.5),
        'even_w_out': nrm(ks[7], (N_EVEN, EVEN_MIX, D_MODEL), EVEN_MIX ** -0.5),
        'odd_w_in': nrm(ks[8], (N_ODD, D_MODEL, ODD_IN), D_MODEL ** -0.5),
        'odd_conv_w': nrm(ks[9], (N_ODD, C_CONV, C_CONV_DIM), C_CONV ** -0.5),
        'odd_conv_b': nrm(ks[10], (N_ODD, C_CONV_DIM), 0.02),
        'odd_dt_bias': dt0 + jnp.log(-jnp.expm1(-dt0)),
        'odd_a_log': jnp.log(jax.random.uniform(ks[12], (N_ODD, C_HEADS), f32, 1.0, 16.0)),
        'odd_d_skip': 1.0 + nrm(ks[13], (N_ODD, C_HEADS), 0.1),
        'odd_ssd_norm': 1.0 + nrm(ks[14], (N_ODD, C_INNER), 0.02),
        'odd_gk_w': nrm(ks[15], (N_ODD, D_GATE_RANK, D_KEY), D_GATE_RANK ** -0.5),
        'odd_gk_b': nrm(ks[16], (N_ODD, D_KEY), 0.02),
        'odd_gla_norm': 1.0 + nrm(ks[17], (N_ODD, D_HV), 0.02),
        'odd_w_out': nrm(ks[18], (N_ODD, ODD_MIX, D_MODEL), ODD_MIX ** -0.5),
        'moe_w_group': nrm(ks[19], (DEPTH, D_MODEL, MOE_GROUPS), D_MODEL ** -0.5),
        'moe_b_group': nrm(ks[20], (DEPTH, MOE_GROUPS), 0.01),
        'moe_w_router': nrm(ks[21], (DEPTH, D_MODEL, MOE_EXPERTS), D_MODEL ** -0.5),
        'moe_b_router': nrm(ks[22], (DEPTH, MOE_EXPERTS), 0.01),
        'moe_w_gate': nrm(ks[23], (DEPTH, MOE_EXPERTS, D_MODEL, MOE_FF), D_MODEL ** -0.5),
        'moe_w_up': nrm(ks[24], (DEPTH, MOE_EXPERTS, D_MODEL, MOE_FF), D_MODEL ** -0.5),
        'moe_w_down': nrm(ks[25], (DEPTH, MOE_EXPERTS, MOE_FF, D_MODEL), MOE_FF ** -0.5),
    }


def reference(x, norm_mix, norm_moe, norm_final, even_w_in, even_sinks, even_forget_bias, even_w_out,
              odd_w_in, odd_conv_w, odd_conv_b, odd_dt_bias, odd_a_log, odd_d_skip, odd_ssd_norm,
              odd_gk_w, odd_gk_b, odd_gla_norm, odd_w_out, moe_w_group, moe_b_group, moe_w_router,
              moe_b_router, moe_w_gate, moe_w_up, moe_w_down):
    h = x
    for layer in range(DEPTH):
        i = layer // 2
        hn = rmsnorm(h, norm_mix[layer])
        if layer % 2 == 0:
            mix = even_mixer(hn, even_w_in[i], even_sinks[i], even_forget_bias[i], even_w_out[i])
        else:
            mix = odd_mixer(hn, odd_w_in[i], odd_conv_w[i], odd_conv_b[i], odd_dt_bias[i], odd_a_log[i],
                            odd_d_skip[i], odd_ssd_norm[i], odd_gk_w[i], odd_gk_b[i], odd_gla_norm[i], odd_w_out[i])
        h = h + mix.astype(h.dtype)
        h = h + hierarchical_moe(rmsnorm(h, norm_moe[layer]), moe_w_group[layer], moe_b_group[layer],
                                 moe_w_router[layer], moe_b_router[layer], moe_w_gate[layer],
                                 moe_w_up[layer], moe_w_down[layer])
    return rmsnorm(h, norm_final)
```

```cpp
#include <hip/hip_runtime.h>
#include <hip/hip_bf16.h>
#include <cstdio>
#include <cstdint>
#include <cmath>
namespace mk {
#define LAS __attribute__((address_space(3)))
#define GAS __attribute__((address_space(1)))
typedef unsigned short bf16_t;
typedef short bf16x8 __attribute__((ext_vector_type(8)));
typedef short s16x4 __attribute__((ext_vector_type(4)));
typedef float f32x4 __attribute__((ext_vector_type(4)));
typedef float f32x2 __attribute__((ext_vector_type(2)));
typedef float f32x16 __attribute__((ext_vector_type(16)));
typedef unsigned u32x4 __attribute__((ext_vector_type(4)));
typedef unsigned u32x2 __attribute__((ext_vector_type(2)));

constexpr int T = 16384, DM = 1024, SEQ = 2048, NBATCH = 8;
constexpr int NE_IN = 2560, NO_IN = 5888;
constexpr int CAP = 16384;
constexpr float EPS = 1e-6f;
constexpr float LOG2E = 1.4426950408889634f;
constexpr float C2 = 0.125f * LOG2E;
constexpr int NWAVES = 8, NTHR = 512;
constexpr size_t MiB = 1u << 20;
constexpr size_t WS_CTL = 0, CTL_ZERO_BYTES = 1 * MiB;
constexpr size_t WS_WEIN = 2 * MiB, WS_WEOUT = 7 * MiB, WS_WOIN = 9 * MiB, WS_WOOUT = 21 * MiB, WS_WRT = 25 * MiB;
constexpr size_t WS_WGU = 26 * MiB, WS_WD = 90 * MiB;
constexpr size_t WS_XN = 122 * MiB;
constexpr size_t WS_PROJ = 154 * MiB;
constexpr size_t WS_H = WS_PROJ, WS_Y = WS_PROJ + 40 * MiB;
constexpr size_t WS_MIX = 338 * MiB;
constexpr size_t WS_CONV = 402 * MiB;
constexpr size_t WS_FB = 450 * MiB;
constexpr size_t WS_DTG = 451 * MiB;
constexpr size_t WS_LISTS = 453 * MiB;
constexpr size_t WS_GATES = 455 * MiB;
constexpr size_t WS_RSTD = 455 * MiB + 512 * 1024;
constexpr size_t WS_END = 456 * MiB, WS_HB = 476 * MiB, WS_TOTAL = 508 * MiB;
constexpr int CW_BAR = 4096;
constexpr int CW_CNT = 16384;
constexpr int RING_BYTES = 146432;
constexpr int MISC_OFF = RING_BYTES;
constexpr int LDS_BYTES = 147456;

typedef __bf16 bf16x2_t __attribute__((ext_vector_type(2)));
__device__ __forceinline__ unsigned cvt_pk_bf16(float lo, float hi) { f32x2 v = {lo, hi}; bf16x2_t b = __builtin_convertvector(v, bf16x2_t); return __builtin_bit_cast(unsigned, b); }
__device__ __forceinline__ float bf2f(unsigned short b) { return __uint_as_float((unsigned)b << 16); }
__device__ __forceinline__ float wave_sum(float v) {
#pragma unroll
    for (int o = 1; o < 64; o <<= 1) v += __shfl_xor(v, o);
    return v;
}
__device__ __forceinline__ float siluf(float x) { return x * __builtin_amdgcn_rcpf(1.f + __expf(-x)); }
__device__ __forceinline__ float log_sigmoidf(float x) { return fminf(x, 0.f) - log1pf(expf(-fabsf(x))); }
__device__ __forceinline__ float log_sigmoid_fast(float x) { return fminf(x, 0.f) - __logf(1.f + __expf(-fabsf(x))); }
__device__ __forceinline__ float softplusf(float x) { return fmaxf(x, 0.f) + __logf(1.f + __expf(-fabsf(x))); }

#define XB_TMO      128
#define XB_XCNT(j)  (256  + 64 * (j))
#define XB_XSUB(j)  (1280 + 64 * (j))
#define XB_XGEN(j)  (2304 + 64 * (j))
#define XB_TOP      3328
#define XB_TOPGEN   3392
#define XCD_BAR_WORDS 3456
#define XB_SPIN_CAP (1u << 18)
__device__ __forceinline__ unsigned xb_ld(unsigned* p)              { return __hip_atomic_load(p, __ATOMIC_RELAXED, __HIP_MEMORY_SCOPE_AGENT); }
__device__ __forceinline__ unsigned xb_add(unsigned* p, unsigned v) { return __hip_atomic_fetch_add(p, v, __ATOMIC_RELAXED, __HIP_MEMORY_SCOPE_AGENT); }
__device__ __forceinline__ unsigned xb_xcc_id() { return (unsigned)__builtin_amdgcn_s_getreg((3 << 11) | 20) & 0xFu; }
#define XB_SPIN(cond, bar) do { unsigned _sp = 0; while (cond) { __builtin_amdgcn_s_sleep(1); \
    if ((++_sp & 255u) == 0u) { if (xb_ld(&(bar)[XB_TMO])) break; if (_sp > XB_SPIN_CAP) { atomicAdd(&(bar)[XB_TMO], 1u); break; } } } } while (0)
struct XcdBarrier { unsigned* bar; unsigned x; volatile LAS unsigned* st; };
__device__ __forceinline__ XcdBarrier xcd_barrier_post(unsigned* bar, volatile LAS unsigned* st) {
    XcdBarrier b; b.bar = bar; b.x = xb_xcc_id(); b.st = st;
    if (threadIdx.x == 0) (void)xb_add(&bar[XB_XCNT(b.x)], 1u);
    return b;
}
__device__ __forceinline__ void xcd_barrier_complete(unsigned* bar, unsigned x, unsigned& nloc, unsigned& nx) {
    const unsigned G = gridDim.x * gridDim.y * gridDim.z;
    unsigned sum, cnt, mine, sp = 0u;
    for (;;) {
        sum = 0u; cnt = 0u; mine = 0u;
#pragma unroll
        for (unsigned j = 0; j < 16; ++j) { const unsigned c = xb_ld(&bar[XB_XCNT(j)]); sum += c; cnt += (c > 0u) ? 1u : 0u; mine = (j == x) ? c : mine; }
        if (sum == G) break;
        __builtin_amdgcn_s_sleep(1);
        if ((++sp & 255u) == 0u) { if (xb_ld(&bar[XB_TMO])) break; if (sp > XB_SPIN_CAP) { atomicAdd(&bar[XB_TMO], 1u); break; } }
    }
    nloc = mine > 0u ? mine : 1u; nx = cnt > 0u ? cnt : 1u;
}
__device__ __forceinline__ void xcd_barrier(const XcdBarrier& b) {
    asm volatile("s_waitcnt vmcnt(0)" ::: "memory");
    __syncthreads();
    if (threadIdx.x == 0) {
        unsigned* bar = b.bar;
        __builtin_amdgcn_s_waitcnt(0);
        unsigned nloc = b.st[0], nx = b.st[1];
        if (nloc == 0u) { xcd_barrier_complete(bar, b.x, nloc, nx); b.st[0] = nloc; b.st[1] = nx; }
        const unsigned old = xb_add(&bar[XB_XSUB(b.x)], 1u);
        const unsigned gen = old / nloc;
        if (old + 1u == (gen + 1u) * nloc) {
            __builtin_amdgcn_fence(__ATOMIC_RELEASE, "agent");
            asm volatile("s_waitcnt vmcnt(0)" ::: "memory");
            const unsigned og = xb_add(&bar[XB_TOP], 1u);
            const unsigned tg = og / nx;
            if (og + 1u == (tg + 1u) * nx) xb_add(&bar[XB_TOPGEN], 1u);
            else XB_SPIN(xb_ld(&bar[XB_TOPGEN]) == tg, bar);
            __builtin_amdgcn_fence(__ATOMIC_ACQUIRE, "agent");
            xb_add(&bar[XB_XGEN(b.x)], 1u);
            asm volatile("s_waitcnt vmcnt(0)" ::: "memory");
        } else {
            XB_SPIN(xb_ld(&bar[XB_XGEN(b.x)]) == gen, bar);
            __builtin_amdgcn_fence(__ATOMIC_ACQUIRE, "agent");
            asm volatile("s_waitcnt vmcnt(0)" ::: "memory");
        }
    }
    __syncthreads();
}

struct SrcPlain { const float* W; int N; __device__ __forceinline__ const float* operator()(int k, int n) const { return W + (size_t)k * N + n; } };
struct SrcEvenIn { const float* W; __device__ __forceinline__ const float* operator()(int k, int n) const { return n < 2312 ? W + (size_t)k * 2312 + n : nullptr; } };
struct SrcOddIn { const float* W;
    __device__ __forceinline__ const float* operator()(int k, int n) const {
        int s;
        if (n < 2560) s = n; else if (n < 4608) s = n + 16; else if (n < 5632) s = n + 32; else if (n < 5648) s = 2560 + (n - 5632); else if (n < 5664) s = 4624 + (n - 5648); else s = -1;
        return s >= 0 ? W + (size_t)k * 5664 + s : nullptr; } };
struct SrcGateUp { const float* Wg; const float* Wu;
    __device__ __forceinline__ const float* operator()(int k, int n) const { const int j = (n >> 5) * 16 + (n & 15); const long d = (n & 16) ? (long)(Wu - Wg) : 0l; return Wg + d + (size_t)k * 512 + j; } };
__device__ __forceinline__ struct CvItem cv_make_gu(const float* Wg, const float* Wu, bf16_t* WT, int item, int lane);
struct CvItem { const float* p; size_t stride; bf16_t* dst; int K; int gu; };
template <class Src> __device__ __forceinline__ CvItem cv_make(const Src& src, int srcN, int K, int nblk, bf16_t* WT, int item, int lane) {
    const int kb = item / nblk, nb = item % nblk, k0 = 64 * kb, n0 = 32 * nb;
    CvItem d; d.p = src(k0 + (lane >> 5), n0 + (lane & 31)); d.stride = (size_t)2 * srcN; d.dst = WT + (size_t)n0 * K + k0; d.K = K; d.gu = 0; return d;
}
__device__ __forceinline__ CvItem cv_make_gu(const float* Wg, const float* Wu, bf16_t* WT, int item, int lane) {
    const int half = item >> 8, r = item & 255, kb = r >> 4, jb = r & 15, k0 = 64 * kb, j0 = 32 * jb;
    CvItem d; d.p = (half ? Wu : Wg) + (size_t)(k0 + (lane >> 5)) * 512 + j0 + (lane & 31); d.stride = 1024; d.dst = WT + (size_t)(jb * 64 + half * 16) * 1024 + k0; d.K = 1024; d.gu = 1; return d;
}
__device__ __forceinline__ void cv_load(const CvItem& d, float (&v)[32]) {
#pragma unroll
    for (int i = 0; i < 32; ++i) v[i] = d.p ? d.p[(size_t)i * d.stride] : 0.f;
}
__device__ __forceinline__ void cv_finish(const CvItem& d, const float (&v)[32], LAS float* scr, int lane) {
#pragma unroll
    for (int i = 0; i < 32; ++i) { const int kk = 2 * i + (lane >> 5); scr[kk * 33 + (lane & 31)] = v[i]; }
    asm volatile("s_waitcnt lgkmcnt(0)" ::: "memory");
    const int c = lane & 7;
#pragma unroll
    for (int j = 0; j < 4; ++j) { const int n = (lane >> 3) + 8 * j; const LAS float* s = scr + (8 * c) * 33 + n; const int dr = d.gu ? ((n >> 4) * 32 + (n & 15)) : n;
        u32x4 o; o.x = cvt_pk_bf16(s[0 * 33], s[1 * 33]); o.y = cvt_pk_bf16(s[2 * 33], s[3 * 33]); o.z = cvt_pk_bf16(s[4 * 33], s[5 * 33]); o.w = cvt_pk_bf16(s[6 * 33], s[7 * 33]);
        *(u32x4*)(d.dst + (size_t)dr * d.K + 8 * c) = o; }
    asm volatile("s_waitcnt lgkmcnt(0)" ::: "memory");
}

namespace pg8 {
constexpr int BM = 256, BK = 64, HALF = 128, HTB = HALF * BK * 2, STAGE_BYTES = 8 * HTB, NXCD = 8, WGM = 8;
__host__ __device__ __forceinline__ int lds_byte(int r, int c) { const int st = (r >> 4) * 2 + (c >> 5), rr = r & 15, cc = c & 31, ob = rr * 64 + cc * 2; return st * 1024 + (ob ^ (((ob >> 9) & 1) << 5)); }
__host__ __device__ __forceinline__ void stage_rc(int b, int& R, int& C) { const int st = b / 1024, sb = b % 1024, swz = sb ^ (((sb >> 9) & 1) << 5); R = (st >> 1) * 16 + swz / 64; C = (st & 1) * 32 + (swz % 64) / 2; }
__host__ __device__ __forceinline__ int perm32(int rho) { const int n = rho >> 4, i = rho & 15; return 8 * (i >> 2) + 4 * n + (i & 3); }

struct Unit { int pm, pn, e, j; };
struct Gemm { const bf16_t* A; const bf16_t* Bt; int K; size_t b_estride; };

struct DenseOrder {
    int nM, nN, nwg, G, c, rep;
    __device__ void init(int M, int N, int G_, int c_, int rep_ = 1) { nM = M / BM; nN = N / BM; nwg = nM * nN; G = G_; c = c_; rep = rep_; }
    __device__ bool next(int i, Unit& u) const {
        if (rep > 1) { const int n = (nwg - c + G - 1) / G; if (n <= 0 || i >= n * rep) return false; i = i % n; }
        const long L = (long)i * G + c; if (L >= nwg) return false;
        int wgid = (int)L; { const int q = nwg / NXCD, r = nwg % NXCD, xcd = wgid % NXCD, off = wgid / NXCD; wgid = (xcd < r ? xcd * (q + 1) : r * (q + 1) + (xcd - r) * q) + off; }
        const int nig = WGM * nN, gid = wgid / nig, fm = gid * WGM, gsz = (nM - fm) < WGM ? (nM - fm) : WGM;
        u.pm = fm + ((wgid % nig) % gsz); u.pn = (wgid % nig) / gsz; u.e = 0; u.j = 0; return true;
    }
    __device__ __forceinline__ unsigned arow(const Unit& u, int r) const { return (unsigned)(u.pm * BM + r); }
};
struct MoeOrder {
    const volatile LAS int* ts; const volatile LAS int* cnt; const int* lists; int G, c; bool gather; int rep;
    __device__ bool next(int i, Unit& u) const {
        const int U = ts[32] * 4;
        if (rep > 1) { const int n = (U - c + G - 1) / G; if (n <= 0 || i >= n * rep) return false; i = i % n; }
        const long L = (long)i * G + c; if (L >= U) return false;
        int v = (int)L; { const int q = U / NXCD, r = U % NXCD, xcd = v % NXCD, off = v / NXCD; v = (xcd < r ? xcd * (q + 1) : r * (q + 1) + (xcd - r) * q) + off; }
        const int m = v >> 2; u.pm = m; u.pn = v & 3;
        int e = 0;
        for (int k = 1; k < 32; ++k) if (ts[k] <= m) e = k;
        u.e = e; u.j = m - ts[e]; return true;
    }
    __device__ __forceinline__ unsigned arow(const Unit& u, int r) const {
        if (!gather) return (unsigned)(u.pm * BM + r);
        const int ri = u.j * BM + r; const int n = cnt[u.e];
        return ri < n ? (unsigned)(lists[u.e * CAP + ri] >> 1) : 0u;
    }
};

struct EpiProjEven {
    static constexpr bool PERM = true;
    bf16_t* O; float* fb;
    __device__ __forceinline__ void operator()(const f32x4 (&acc)[2][2][4][2], const Unit& u, int wr, int wc, int fr, int fq) const {
        const int row0 = u.pm * BM + wr * 64 + fr;
        if (u.pn == 9) {
            if (wc == 0 && fq == 0) {
#pragma unroll
                for (int ai = 0; ai < 2; ++ai)
#pragma unroll
                    for (int m = 0; m < 4; ++m) { float* p = fb + (size_t)(row0 + ai * HALF + m * 16) * 8; *(f32x4*)p = acc[ai][0][m][0]; *(f32x4*)(p + 4) = acc[ai][0][m][1]; }
            }
            return;
        }
        const float sc = (u.pn == 0 || u.pn == 1 || u.pn == 3 || u.pn == 4) ? C2 : 1.f;
        const int col0 = u.pn * BM + wc * 32 + 8 * fq;
#pragma unroll
        for (int ai = 0; ai < 2; ++ai)
#pragma unroll
            for (int m = 0; m < 4; ++m) { bf16_t* rowp = O + (size_t)(row0 + ai * HALF + m * 16) * NE_IN + col0;
#pragma unroll
                for (int bj = 0; bj < 2; ++bj) { const f32x4 v0 = acc[ai][bj][m][0] * sc, v1 = acc[ai][bj][m][1] * sc;
                    u32x4 w; w.x = cvt_pk_bf16(v0[0], v0[1]); w.y = cvt_pk_bf16(v0[2], v0[3]); w.z = cvt_pk_bf16(v1[0], v1[1]); w.w = cvt_pk_bf16(v1[2], v1[3]);
                    *(u32x4*)(rowp + bj * HALF) = w; } }
    }
};
struct EpiProjOdd {
    static constexpr bool PERM = true;
    bf16_t* O; float* dtg;
    __device__ __forceinline__ void operator()(const f32x4 (&acc)[2][2][4][2], const Unit& u, int wr, int wc, int fr, int fq) const {
        const int row0 = u.pm * BM + wr * 64 + fr;
        if (u.pn == 22) {
            if (wc == 0) {
#pragma unroll
                for (int ai = 0; ai < 2; ++ai)
#pragma unroll
                    for (int m = 0; m < 4; ++m) { float* p = dtg + (size_t)(row0 + ai * HALF + m * 16) * 32 + 8 * fq; *(f32x4*)p = acc[ai][0][m][0]; *(f32x4*)(p + 4) = acc[ai][0][m][1]; }
            }
            return;
        }
        const int col0 = u.pn * BM + wc * 32 + 8 * fq;
#pragma unroll
        for (int ai = 0; ai < 2; ++ai)
#pragma unroll
            for (int m = 0; m < 4; ++m) { bf16_t* rowp = O + (size_t)(row0 + ai * HALF + m * 16) * NO_IN + col0;
#pragma unroll
                for (int bj = 0; bj < 2; ++bj) { const f32x4 v0 = acc[ai][bj][m][0], v1 = acc[ai][bj][m][1];
                    u32x4 w; w.x = cvt_pk_bf16(v0[0], v0[1]); w.y = cvt_pk_bf16(v0[2], v0[3]); w.z = cvt_pk_bf16(v1[0], v1[1]); w.w = cvt_pk_bf16(v1[2], v1[3]);
                    *(u32x4*)(rowp + bj * HALF) = w; } }
    }
};
struct EpiResid {
    static constexpr bool PERM = false;
    const float* base; float* out;
    __device__ __forceinline__ void operator()(const f32x4 (&acc)[2][2][4][2], const Unit& u, int wr, int wc, int fr, int fq) const {
        const int col0 = u.pn * BM + wc * 32 + 4 * fq;
#pragma unroll
        for (int ai = 0; ai < 2; ++ai)
#pragma unroll
            for (int m = 0; m < 4; ++m) { const size_t off = (size_t)(u.pm * BM + ai * HALF + wr * 64 + m * 16 + fr) * DM + col0;
#pragma unroll
                for (int bj = 0; bj < 2; ++bj)
#pragma unroll
                    for (int n = 0; n < 2; ++n) { const f32x4 bs = *(const f32x4*)(base + off + bj * HALF + n * 16); *(f32x4*)(out + off + bj * HALF + n * 16) = bs + acc[ai][bj][m][n]; } }
    }
};
template <bool BASE_F32> struct EpiResidB {
    static constexpr bool PERM = true;
    const void* base; bf16_t* out;
    __device__ __forceinline__ void operator()(const f32x4 (&acc)[2][2][4][2], const Unit& u, int wr, int wc, int fr, int fq) const {
        const int row0 = u.pm * BM + wr * 64 + fr, col0 = u.pn * BM + wc * 32 + 8 * fq;
#pragma unroll
        for (int ai = 0; ai < 2; ++ai)
#pragma unroll
            for (int m = 0; m < 4; ++m) { const size_t ro = (size_t)(row0 + ai * HALF + m * 16) * DM + col0;
#pragma unroll
                for (int bj = 0; bj < 2; ++bj) { f32x4 v0 = acc[ai][bj][m][0], v1 = acc[ai][bj][m][1];
                    if (BASE_F32) { const float* b = (const float*)base + ro + bj * HALF; v0 += *(const f32x4*)b; v1 += *(const f32x4*)(b + 4); }
                    else { const u32x4 bb = *(const u32x4*)((const bf16_t*)base + ro + bj * HALF);
                        v0[0] += __uint_as_float(bb.x << 16); v0[1] += __uint_as_float(bb.x & 0xffff0000u); v0[2] += __uint_as_float(bb.y << 16); v0[3] += __uint_as_float(bb.y & 0xffff0000u);
                        v1[0] += __uint_as_float(bb.z << 16); v1[1] += __uint_as_float(bb.z & 0xffff0000u); v1[2] += __uint_as_float(bb.w << 16); v1[3] += __uint_as_float(bb.w & 0xffff0000u); }
                    u32x4 w; w.x = cvt_pk_bf16(v0[0], v0[1]); w.y = cvt_pk_bf16(v0[2], v0[3]); w.z = cvt_pk_bf16(v1[0], v1[1]); w.w = cvt_pk_bf16(v1[2], v1[3]);
                    *(u32x4*)(out + ro + bj * HALF) = w; } }
    }
};
struct EpiGateUp {
    static constexpr bool PERM = false;
    bf16_t* H;
    __device__ __forceinline__ void operator()(const f32x4 (&acc)[2][2][4][2], const Unit& u, int wr, int wc, int fr, int fq) const {
#pragma unroll
        for (int ai = 0; ai < 2; ++ai)
#pragma unroll
            for (int m = 0; m < 4; ++m) { bf16_t* rowp = H + (size_t)(u.pm * BM + ai * HALF + wr * 64 + m * 16 + fr) * 512;
#pragma unroll
                for (int bj = 0; bj < 2; ++bj) { const int j0 = (u.pn * 8 + bj * 4 + wc) * 16 + 4 * fq; const f32x4 g = acc[ai][bj][m][0], up = acc[ai][bj][m][1];
                    u32x2 w; w.x = cvt_pk_bf16(siluf(g[0]) * up[0], siluf(g[1]) * up[1]); w.y = cvt_pk_bf16(siluf(g[2]) * up[2], siluf(g[3]) * up[3]);
                    *(u32x2*)(rowp + j0) = w; } }
    }
};
struct EpiDown {
    static constexpr bool PERM = true;
    bf16_t* Y; const int* lists; const float* gates; const volatile LAS int* cnt;
    __device__ __forceinline__ void operator()(const f32x4 (&acc)[2][2][4][2], const Unit& u, int wr, int wc, int fr, int fq) const {
        const int n = cnt[u.e]; const int col0 = u.pn * BM + wc * 32 + 8 * fq;
#pragma unroll
        for (int ai = 0; ai < 2; ++ai)
#pragma unroll
            for (int m = 0; m < 4; ++m) { const int ri = u.j * BM + ai * HALF + wr * 64 + m * 16 + fr;
                if (ri < n) { const int a = lists[u.e * CAP + ri]; const float g = gates[a]; bf16_t* rowp = Y + ((size_t)(a & 1) * T + (a >> 1)) * DM + col0;
#pragma unroll
                    for (int bj = 0; bj < 2; ++bj) { const f32x4 v0 = acc[ai][bj][m][0] * g, v1 = acc[ai][bj][m][1] * g;
                        u32x4 w; w.x = cvt_pk_bf16(v0[0], v0[1]); w.y = cvt_pk_bf16(v0[2], v0[3]); w.z = cvt_pk_bf16(v1[0], v1[1]); w.w = cvt_pk_bf16(v1[2], v1[3]);
                        *(u32x4*)(rowp + bj * HALF) = w; } } }
    }
};

template <class Epi, class Sched, bool ALIGN_EPI>
__device__ __forceinline__ void gemm_phase(LAS unsigned char* lds, const Gemm g, const Sched& S, const Epi& E) {
    const int tid = threadIdx.x, wid = __builtin_amdgcn_readfirstlane(tid >> 6), lane = tid & 63, wr = wid >> 2, wc = wid & 3, fr = lane & 15, fq = lane >> 4;
    const int K = g.K, nt = K / BK;
    int RA[2]; unsigned cbA[2], voffB[2];
#pragma unroll
    for (int i = 0; i < 2; ++i) { int R, C; stage_rc(tid * 16 + i * 8192, R, C); const int Rb = Epi::PERM ? ((R & ~31) + perm32(R & 31)) : R;
        RA[i] = R; cbA[i] = (unsigned)C * 2u; voffB[i] = (unsigned)(Rb * K + C) * 2u; }
    const unsigned kstep = (unsigned)(BK * 2);
    const size_t hstep = (size_t)HALF * K * 2;
    const size_t tstep = 2 * hstep;
    const unsigned rowb = (unsigned)K * 2u;
    const unsigned ldsw = (unsigned)wid * 1024u;
    const int aoff = lds_byte(wr * 64 + fr, fq * 8), boff = lds_byte(wc * 32 + fr, fq * 8);
    const char* Ab = (const char*)g.A;
#define PG8_SA(b, h) (((b) * 2 + (h)) * HTB)
#define PG8_SB(b, h) ((4 + (b) * 2 + (h)) * HTB)
#define PG8_STAGE(bufoff, gbase, voff) do { _Pragma("unroll") for (int _i = 0; _i < 2; ++_i) \
        __builtin_amdgcn_global_load_lds((const unsigned*)((const char*)(gbase) + (voff)[_i]), (LAS unsigned*)(lds + (bufoff) + ldsw + _i * 8192), 16, 0, 0); } while (0)
#define PG8_STAGE_A(bufoff, kb, o0, o1) do { \
        __builtin_amdgcn_global_load_lds((const unsigned*)(Ab + (kb) + (o0)), (LAS unsigned*)(lds + (bufoff) + ldsw), 16, 0, 0); \
        __builtin_amdgcn_global_load_lds((const unsigned*)(Ab + (kb) + (o1)), (LAS unsigned*)(lds + (bufoff) + ldsw + 8192), 16, 0, 0); } while (0)
#define PG8_LDA(dst, b, h) do { _Pragma("unroll") for (int m = 0; m < 4; ++m) _Pragma("unroll") for (int k = 0; k < 2; ++k) dst[m][k] = *(const LAS bf16x8*)(lds + PG8_SA(b, h) + aoff + m * 2048 + k * 1024); } while (0)
#define PG8_LDB(dst, b, h) do { _Pragma("unroll") for (int n = 0; n < 2; ++n) _Pragma("unroll") for (int k = 0; k < 2; ++k) dst[n][k] = *(const LAS bf16x8*)(lds + PG8_SB(b, h) + boff + n * 2048 + k * 1024); } while (0)
#define PG8_MMA(ai, bj, At, Bt) do { __builtin_amdgcn_s_setprio(1); _Pragma("unroll") for (int m = 0; m < 4; ++m) _Pragma("unroll") for (int n = 0; n < 2; ++n) _Pragma("unroll") for (int k = 0; k < 2; ++k) \
        acc[ai][bj][m][n] = __builtin_amdgcn_mfma_f32_16x16x32_bf16(Bt[n][k], At[m][k], acc[ai][bj][m][n], 0, 0, 0); __builtin_amdgcn_s_setprio(0); } while (0)
#define PG8_WAIT_V(n) asm volatile("s_waitcnt vmcnt(" #n ")" ::: "memory")
#define PG8_WAIT_L(n) asm volatile("s_waitcnt lgkmcnt(" #n ")" ::: "memory")
#define PG8_BAR __builtin_amdgcn_s_barrier()
#define PG8_SCHED __builtin_amdgcn_sched_barrier(0)
    Unit cur, nxt; int ui = 0;
    if (!S.next(0, cur)) return;
    f32x4 acc[2][2][4][2];
#pragma unroll
    for (int a = 0; a < 2; ++a)
#pragma unroll
        for (int b = 0; b < 2; ++b)
#pragma unroll
            for (int m = 0; m < 4; ++m)
#pragma unroll
                for (int n = 0; n < 2; ++n) acc[a][b][m][n] = (f32x4){0.f, 0.f, 0.f, 0.f};
    bf16x8 At[4][2], B0[2][2], B1[2][2];
    unsigned oC00 = S.arow(cur, RA[0]) * rowb + cbA[0], oC01 = S.arow(cur, RA[1]) * rowb + cbA[1];
    unsigned oC10 = S.arow(cur, HALF + RA[0]) * rowb + cbA[0], oC11 = S.arow(cur, HALF + RA[1]) * rowb + cbA[1];
    const char* cB = (const char*)g.Bt + (size_t)cur.e * g.b_estride + (size_t)cur.pn * tstep;
    PG8_STAGE(PG8_SB(0, 0), cB, voffB); PG8_STAGE(PG8_SB(0, 1), cB + hstep, voffB); PG8_STAGE_A(PG8_SA(0, 0), 0u, oC00, oC01); PG8_STAGE_A(PG8_SA(0, 1), 0u, oC10, oC11);
    if (wr == 1) PG8_BAR;
    PG8_WAIT_V(2); PG8_BAR;
    PG8_STAGE(PG8_SB(1, 0), cB + kstep, voffB); PG8_STAGE_A(PG8_SA(1, 0), kstep, oC00, oC01); PG8_STAGE(PG8_SB(1, 1), cB + hstep + kstep, voffB);
    PG8_WAIT_V(6); PG8_BAR;
    for (;;) {
        const bool has_next = S.next(ui + 1, nxt);
        unsigned oN00 = oC00, oN01 = oC01, oN10 = oC10, oN11 = oC11;
        if (has_next) { oN00 = S.arow(nxt, RA[0]) * rowb + cbA[0]; oN01 = S.arow(nxt, RA[1]) * rowb + cbA[1];
                        oN10 = S.arow(nxt, HALF + RA[0]) * rowb + cbA[0]; oN11 = S.arow(nxt, HALF + RA[1]) * rowb + cbA[1]; }
        const char* nB = has_next ? (const char*)g.Bt + (size_t)nxt.e * g.b_estride + (size_t)nxt.pn * tstep : cB;
        for (int t = 0; t < nt; t += 2) {
            const bool last = (t == nt - 2);
            const unsigned k1 = (unsigned)(t + 1) * kstep;
            const unsigned k2 = last ? 0u : (unsigned)(t + 2) * kstep, k3 = k2 + kstep;
            const unsigned o00 = last ? oN00 : oC00, o01 = last ? oN01 : oC01, o10 = last ? oN10 : oC10, o11 = last ? oN11 : oC11;
            const char* b2 = last ? nB : cB + (size_t)(t + 2) * kstep; const char* b3 = b2 + kstep;
            PG8_LDB(B0, 0, 0); PG8_LDB(B1, 0, 1); PG8_SCHED; PG8_LDA(At, 0, 0); PG8_STAGE_A(PG8_SA(1, 1), k1, oC10, oC11);
            PG8_WAIT_V(8); PG8_WAIT_L(0); PG8_BAR; PG8_MMA(0, 0, At, B0); PG8_MMA(0, 1, At, B1); PG8_BAR; PG8_SCHED;
            PG8_LDA(At, 0, 1); PG8_STAGE(PG8_SB(0, 0), b2, voffB); PG8_STAGE(PG8_SB(0, 1), b2 + hstep, voffB); PG8_STAGE_A(PG8_SA(0, 0), k2, o00, o01);
            PG8_WAIT_V(8); PG8_WAIT_L(0); PG8_BAR; PG8_MMA(1, 0, At, B0); PG8_MMA(1, 1, At, B1); PG8_BAR; PG8_SCHED;
            PG8_LDB(B0, 1, 0); PG8_LDB(B1, 1, 1); PG8_SCHED; PG8_LDA(At, 1, 0); PG8_STAGE_A(PG8_SA(0, 1), k2, o10, o11);
            PG8_WAIT_V(8); PG8_WAIT_L(0); PG8_BAR; PG8_MMA(0, 0, At, B0); PG8_MMA(0, 1, At, B1); PG8_BAR; PG8_SCHED;
            PG8_LDA(At, 1, 1); PG8_STAGE(PG8_SB(1, 0), b3, voffB); PG8_STAGE(PG8_SB(1, 1), b3 + hstep, voffB); PG8_STAGE_A(PG8_SA(1, 0), k3, o00, o01);
            PG8_WAIT_V(8); PG8_WAIT_L(0); PG8_BAR; PG8_MMA(1, 0, At, B0); PG8_MMA(1, 1, At, B1); PG8_BAR; PG8_SCHED;
        }
        if constexpr (ALIGN_EPI) { if (wr == 0) PG8_BAR; }
        E(acc, cur, wr, wc, fr, fq);
        if (!has_next) break;
#pragma unroll
        for (int a = 0; a < 2; ++a)
#pragma unroll
            for (int b = 0; b < 2; ++b)
#pragma unroll
                for (int m = 0; m < 4; ++m)
#pragma unroll
                    for (int n = 0; n < 2; ++n) acc[a][b][m][n] = (f32x4){0.f, 0.f, 0.f, 0.f};
        cur = nxt; cB = nB; oC00 = oN00; oC01 = oN01; oC10 = oN10; oC11 = oN11; ++ui;
        if constexpr (ALIGN_EPI) { if (wr == 1) PG8_BAR; }
    }
    PG8_WAIT_V(0);
    if constexpr (!ALIGN_EPI) { if (wr == 0) PG8_BAR; }
    PG8_BAR;
#undef PG8_SA
#undef PG8_SB
#undef PG8_STAGE
#undef PG8_STAGE_A
#undef PG8_LDA
#undef PG8_LDB
#undef PG8_MMA
#undef PG8_WAIT_V
#undef PG8_WAIT_L
#undef PG8_BAR
#undef PG8_SCHED
}
}
}
namespace att {
using namespace mk;
constexpr int KVBLK = 64;
constexpr int A_K = 0, A_V = 32768, A_WS = 65536, A_OST = A_WS + NWAVES * 256, A_BIAS = A_OST + NWAVES * 4096, A_SCAN = A_BIAS + 8192, A_BYTES = A_SCAN + 64;
static_assert(A_BYTES <= RING_BYTES, "attention LDS");
__device__ __forceinline__ int crow(int r, int hi) { return (r & 3) + 8 * (r >> 2) + 4 * hi; }
__device__ __forceinline__ void glds16(const void* gsrc, unsigned lds_dst) { unsigned keep;
    asm volatile("s_mov_b32 %0, m0\n\ts_mov_b32 m0, %2\n\ts_nop 0\n\tglobal_load_lds_dwordx4 %1, off\n\ts_mov_b32 m0, %0" : "=&s"(keep) : "v"(gsrc), "s"(lds_dst) : "memory"); }
__device__ __forceinline__ unsigned cvtpk(float lo, float hi) { return cvt_pk_bf16(lo, hi); }
__device__ __forceinline__ void qkt(f32x16& p0, f32x16& p1, const LAS char* Kslot, const bf16x8* qr, int r32, int hi) {
    const LAS char* kb = Kslot + hi * 1024 + r32 * 16;
    const f32x16 z = {};
#pragma unroll
    for (int d0 = 0; d0 < 4; ++d0) {
        const bf16x8 b0 = *(const LAS bf16x8*)(kb + d0 * 2048);
        const bf16x8 b1 = *(const LAS bf16x8*)(kb + d0 * 2048 + 512);
        if (d0 == 0) { p0 = __builtin_amdgcn_mfma_f32_32x32x16_bf16(b0, qr[0], z, 0, 0, 0); p1 = __builtin_amdgcn_mfma_f32_32x32x16_bf16(b1, qr[0], z, 0, 0, 0); }
        else { p0 = __builtin_amdgcn_mfma_f32_32x32x16_bf16(b0, qr[d0], p0, 0, 0, 0); p1 = __builtin_amdgcn_mfma_f32_32x32x16_bf16(b1, qr[d0], p1, 0, 0, 0); } }
}
__device__ __forceinline__ void pv(f32x16* o, int vb, bf16x8 pa0, bf16x8 pa1, bf16x8 pa2, bf16x8 pa3) {
#pragma unroll
    for (int d0 = 0; d0 < 2; ++d0) { s16x4 lo[4], hi[4];
#pragma unroll
        for (int ks = 0; ks < 4; ++ks) {
            asm volatile("ds_read_b64_tr_b16 %0,%1 offset:%c2" : "=&v"(lo[ks]) : "v"(vb), "i"(d0 * 4096 + ks * 1024) : "memory");
            asm volatile("ds_read_b64_tr_b16 %0,%1 offset:%c2" : "=&v"(hi[ks]) : "v"(vb), "i"(d0 * 4096 + ks * 1024 + 512) : "memory"); }
        asm volatile("s_waitcnt lgkmcnt(0)" ::: "memory"); __builtin_amdgcn_sched_barrier(0);
#define PK(k) (bf16x8){lo[k][0], lo[k][1], lo[k][2], lo[k][3], hi[k][0], hi[k][1], hi[k][2], hi[k][3]}
        o[d0] = __builtin_amdgcn_mfma_f32_32x32x16_bf16(pa0, PK(0), o[d0], 0, 0, 0);
        o[d0] = __builtin_amdgcn_mfma_f32_32x32x16_bf16(pa1, PK(1), o[d0], 0, 0, 0);
        o[d0] = __builtin_amdgcn_mfma_f32_32x32x16_bf16(pa2, PK(2), o[d0], 0, 0, 0);
        o[d0] = __builtin_amdgcn_mfma_f32_32x32x16_bf16(pa3, PK(3), o[d0], 0, 0, 0);
#undef PK
    }
}
__device__ __forceinline__ float rowmax32(const f32x16& p0, const f32x16& p1) {
    float a = fmaxf(p0[0], p1[0]);
#pragma unroll
    for (int r = 1; r < 16; ++r) a = fmaxf(a, fmaxf(p0[r], p1[r]));
    auto rr = __builtin_amdgcn_permlane32_swap(__float_as_uint(a), __float_as_uint(a), false, false);
    return fmaxf(__uint_as_float(rr[0]), __uint_as_float(rr[1]));
}
#define A_WAIT_BAR(N) asm volatile("s_waitcnt vmcnt(" #N ") lgkmcnt(0)\n\ts_barrier" ::: "memory")

template <bool SWA>
__device__ __forceinline__ void attn_tiles(LAS char* shm, const bf16_t* Qw, int qpitch, const bf16_t* Kh, const bf16_t* Vh, int kvpitch, bf16_t* Ow, int opitch,
                                           int kt0, int ntile, int qpos0, float sl2, float sink2) {
    const int tid = threadIdx.x, lane = tid & 63, r32 = lane & 31, hi = lane >> 5; const int wid = __builtin_amdgcn_readfirstlane(tid >> 6);
    const unsigned lds0 = (unsigned)(uintptr_t)shm;
    LAS float* wsf = (LAS float*)(shm + A_WS) + wid * 64;
    const LAS float* biasl = (const LAS float*)(shm + A_BIAS);
    const bf16_t* ksrc = Kh + (long)lane * kvpitch + wid * 8;
    const bf16_t* vsrc = Vh + (long)(16 * (wid & 3) + (lane >> 2)) * kvpitch + (wid >> 2) * 32 + (lane & 3) * 8;
    const unsigned kdst = lds0 + A_K + wid * 1024, vdst = lds0 + A_V + wid * 1024;
#define DMA_K(t, slot) glds16(ksrc + (long)(t) * KVBLK * kvpitch, (unsigned)__builtin_amdgcn_readfirstlane(kdst + (slot)))
#define DMA_V(t, slot) glds16(vsrc + (long)(t) * KVBLK * kvpitch, (unsigned)__builtin_amdgcn_readfirstlane(vdst + (slot)))
    const int vb0 = (int)(lds0 + A_V) + ((lane >> 4) & 1) * 32 + (lane & 3) * 8 + (4 * hi + ((lane & 15) >> 2)) * 64;
    DMA_K(kt0, 0); DMA_V(kt0, 0);
    if (ntile > 1) { DMA_K(kt0 + 1, 8192); DMA_V(kt0 + 1, 8192); }
    if (ntile > 2) { DMA_K(kt0 + 2, 16384); DMA_V(kt0 + 2, 16384); }
    bf16x8 qr[4];
#pragma unroll
    for (int d0 = 0; d0 < 4; ++d0) qr[d0] = *(const bf16x8*)(Qw + (long)r32 * qpitch + d0 * 16 + hi * 8);
    float m = SWA ? sink2 : -INFINITY, l = (SWA && hi == 0) ? 1.f : 0.f;
    f32x16 o[2]; o[0] = f32x16{}; o[1] = f32x16{};
    const int qpos = qpos0 + r32;
    if (ntile > 2) { A_WAIT_BAR(4); } else if (ntile > 1) { A_WAIT_BAR(2); } else { A_WAIT_BAR(0); }
    f32x16 p0, p1;
    qkt(p0, p1, shm + A_K, qr, r32, hi);
    for (int it = 0; it < ntile; ++it) {
        const int kt = kt0 + it, slot = (it & 3) * 8192;
        f32x16 n0, n1;
        if (it + 1 < ntile) {
            if (it + 2 < ntile) { A_WAIT_BAR(2); } else { A_WAIT_BAR(0); }
            if (it + 3 < ntile) { DMA_K(kt + 3, ((it + 3) & 3) * 8192); DMA_V(kt + 3, ((it + 3) & 3) * 8192); }
            qkt(n0, n1, shm + A_K + ((it + 1) & 3) * 8192, qr, r32, hi);
        }
        const int kb = kt * 64 + 4 * hi;
        if (SWA) {
#pragma unroll
            for (int r = 0; r < 16; ++r) { const int k0 = kb + (r & 3) + 8 * (r >> 2), k1 = k0 + 32;
                p0[r] = (k0 <= qpos && k0 >= qpos - 127) ? p0[r] + sl2 * (float)(k0 - qpos) : -INFINITY;
                p1[r] = (k1 <= qpos && k1 >= qpos - 127) ? p1[r] + sl2 * (float)(k1 - qpos) : -INFINITY; }
        } else {
#pragma unroll
            for (int g = 0; g < 4; ++g) { const f32x4 b0 = *(const LAS f32x4*)(biasl + kb + 8 * g), b1 = *(const LAS f32x4*)(biasl + kb + 32 + 8 * g);
#pragma unroll
                for (int i = 0; i < 4; ++i) { p0[4 * g + i] += b0[i]; p1[4 * g + i] += b1[i]; } }
            if (kt * 64 + 63 > qpos0) {
#pragma unroll
                for (int r = 0; r < 16; ++r) { const int k0 = kb + (r & 3) + 8 * (r >> 2); if (k0 > qpos) p0[r] = -INFINITY; if (k0 + 32 > qpos) p1[r] = -INFINITY; }
            }
        }
        const float rm = rowmax32(p0, p1), mn = fmaxf(m, rm), ms = (mn == -INFINITY) ? 0.f : mn;
        const float alpha = __builtin_amdgcn_exp2f(m - ms);
        float rs = 0.f;
#pragma unroll
        for (int r = 0; r < 16; ++r) { p0[r] = __builtin_amdgcn_exp2f(p0[r] - ms); p1[r] = __builtin_amdgcn_exp2f(p1[r] - ms); rs += p0[r] + p1[r]; }
        l = l * alpha + rs; m = mn;
        if (hi == 0) wsf[r32] = alpha;
        asm volatile("s_waitcnt lgkmcnt(0)" ::: "memory");
#pragma unroll
        for (int r = 0; r < 16; ++r) { const float a = wsf[crow(r, hi)]; o[0][r] *= a; o[1][r] *= a; }
        u32x4 pw0, pw1, pw2, pw3;
        pw0 = (u32x4){cvtpk(p0[0], p0[1]), cvtpk(p0[2], p0[3]), cvtpk(p0[4], p0[5]), cvtpk(p0[6], p0[7])};
        pw1 = (u32x4){cvtpk(p0[8], p0[9]), cvtpk(p0[10], p0[11]), cvtpk(p0[12], p0[13]), cvtpk(p0[14], p0[15])};
        pw2 = (u32x4){cvtpk(p1[0], p1[1]), cvtpk(p1[2], p1[3]), cvtpk(p1[4], p1[5]), cvtpk(p1[6], p1[7])};
        pw3 = (u32x4){cvtpk(p1[8], p1[9]), cvtpk(p1[10], p1[11]), cvtpk(p1[12], p1[13]), cvtpk(p1[14], p1[15])};
        pv(o, vb0 + slot, __builtin_bit_cast(bf16x8, pw0), __builtin_bit_cast(bf16x8, pw1), __builtin_bit_cast(bf16x8, pw2), __builtin_bit_cast(bf16x8, pw3));
        asm volatile("s_waitcnt lgkmcnt(0)" ::: "memory");
        if (it + 1 < ntile) { p0 = n0; p1 = n1; }
    }
    { auto rr = __builtin_amdgcn_permlane32_swap(__float_as_uint(l), __float_as_uint(l), false, false); l = __uint_as_float(rr[0]) + __uint_as_float(rr[1]); }
    if (hi == 0) wsf[32 + r32] = l;
    asm volatile("s_waitcnt lgkmcnt(0)" ::: "memory");
    LAS bf16_t* stg = (LAS bf16_t*)(shm + A_OST) + wid * 2048;
#pragma unroll
    for (int r = 0; r < 16; ++r) { const int orow = crow(r, hi); const float rl = 1.f / wsf[32 + orow];
#pragma unroll
        for (int d0 = 0; d0 < 2; ++d0) stg[orow * 64 + d0 * 32 + r32] = (bf16_t)(cvt_pk_bf16(o[d0][r] * rl, 0.f) & 0xffffu); }
    asm volatile("s_waitcnt lgkmcnt(0)" ::: "memory");
#pragma unroll
    for (int i = 0; i < 4; ++i) { const int row = i * 8 + (lane >> 3), ch = lane & 7; const u32x4 v = *(const LAS u32x4*)(stg + row * 64 + ch * 8); *(u32x4*)(Ow + (long)row * opitch + ch * 8) = v; }
    asm volatile("s_waitcnt vmcnt(0) lgkmcnt(0)\n\ts_barrier" ::: "memory");
#undef DMA_K
#undef DMA_V
}

__device__ __forceinline__ void fox_unit(LAS char* shm, int b, int h, int qb, const bf16_t* proj, const float* fb, float fbias_h, bf16_t* heads) {
    const int tid = threadIdx.x, lane = tid & 63; const int wid = __builtin_amdgcn_readfirstlane(tid >> 6);
    LAS float* biasl = (LAS float*)(shm + A_BIAS); LAS float* scan = (LAS float*)(shm + A_SCAN);
    const int kend = (qb + 1) * 256;
    float v[4]; float s = 0.f;
#pragma unroll
    for (int i = 0; i < 4; ++i) { const int p = tid * 4 + i; float lf = 0.f; if (p < kend) lf = log_sigmoid_fast(fb[((size_t)b * SEQ + p) * 8 + h] + fbias_h); s += lf; v[i] = s; }
    float w = s;
#pragma unroll
    for (int o = 1; o < 64; o <<= 1) { const float t = __shfl_up(w, o); if (lane >= o) w += t; }
    if (lane == 63) scan[wid] = w;
    asm volatile("s_waitcnt lgkmcnt(0)\n\ts_barrier" ::: "memory");
    float off = w - s;
    for (int k = 0; k < 8; ++k) if (k < wid) off += scan[k];
#pragma unroll
    for (int i = 0; i < 4; ++i) biasl[tid * 4 + i] = -(v[i] + off) * LOG2E;
    asm volatile("s_waitcnt lgkmcnt(0)\n\ts_barrier" ::: "memory");
    const size_t rowb = (size_t)b * SEQ; const int q0 = qb * 256 + wid * 32;
    attn_tiles<false>(shm, proj + (rowb + q0) * NE_IN + 768 + h * 64, NE_IN, proj + rowb * NE_IN + 1280 + h * 64, proj + rowb * NE_IN + 1792 + h * 64, NE_IN,
                      heads + (rowb + q0) * 1024 + 512 + h * 64, 1024, 0, 4 * (qb + 1), q0, 0.f, 0.f);
}
__device__ __forceinline__ void swa_unit(LAS char* shm, int b, int kvh, int blk, const bf16_t* proj, const float* sinks, bf16_t* heads) {
    const int wid = __builtin_amdgcn_readfirstlane(threadIdx.x >> 6);
    const int qh = kvh * 4 + (wid >> 1), q0 = blk * 64 + (wid & 1) * 32;
    const size_t rowb = (size_t)b * SEQ;
    const int kt0 = blk >= 2 ? blk - 2 : 0, ntile = blk - kt0 + 1;
    const float sl2 = exp2f(-(float)(qh + 1)) * LOG2E, sink2 = sinks[qh] * LOG2E;
    attn_tiles<true>(shm, proj + (rowb + q0) * NE_IN + qh * 64, NE_IN, proj + rowb * NE_IN + 512 + kvh * 64, proj + rowb * NE_IN + 640 + kvh * 64, NE_IN,
                     heads + (rowb + q0) * 1024 + qh * 64, 1024, kt0, ntile, q0, sl2, sink2);
}
#undef A_WAIT_BAR
}

namespace attp {
using bf16=__hip_bfloat16;
using bf16x8=__attribute__((ext_vector_type(8)))short;
using s16x4=__attribute__((ext_vector_type(4)))short;
using f32x16=__attribute__((ext_vector_type(16)))float;
using u32x4=__attribute__((ext_vector_type(4)))unsigned;
constexpr int BATCH=8,NHEAD=8,SEQ=2048,D=64,DM=2560,OPITCH=1024;
constexpr int NW=8,QBLK=32,QB=QBLK*NW,KVBLK=64,NQB=SEQ/QB;
constexpr int ATTN_PITCH=DM, ATTN_UNIT_ROWS=QB;
__device__ __forceinline__ int crow(int r,int hi){return (r&3)+8*(r>>2)+4*hi;}
#define SBAR() __builtin_amdgcn_sched_barrier(0)
__device__ __forceinline__ void cmask(f32x16&p0,f32x16&p1,int jb,int qrel,int hi){
  const float NEG=-INFINITY; int kb=64*jb+4*hi;
  #pragma unroll
  for(int r=0;r<16;++r){int kv=kb+(r&3)+8*(r>>2); if(kv>qrel)p0[r]=NEG; if(kv+32>qrel)p1[r]=NEG;}
}

constexpr int NSLOT=3, SLOTB=8192;
constexpr int LDS_K=0, LDS_V=NSLOT*SLOTB, LDS_WS=2*NSLOT*SLOTB, LDS_OST=LDS_WS+NW*64*4, LDS_BIAS=LDS_OST+NW*4096, LDS_SCAN=LDS_BIAS+8192, LDS_BYTES=LDS_SCAN+64;
constexpr float C2=0.125f*1.4426950408889634f;
__device__ __forceinline__ void glds16(const void*gsrc,unsigned lds_dst){unsigned keep;
  asm volatile("s_mov_b32 %0, m0\n\ts_mov_b32 m0, %2\n\ts_nop 0\n\tglobal_load_lds_dwordx4 %1, off\n\ts_mov_b32 m0, %0":"=&s"(keep):"v"(gsrc),"s"(lds_dst):"memory");}
__device__ __forceinline__ float max3f(float a,float b,float c){float r;asm("v_max3_f32 %0, %1, %2, %3":"=v"(r):"v"(a),"v"(b),"v"(c));return r;}
__device__ __forceinline__ float max2f(float a,float b){float r;asm("v_max_f32_e32 %0, %1, %2":"=v"(r):"v"(a),"v"(b));return r;}
__device__ __forceinline__ float fadd_s(float a,float b){float r;asm("v_add_f32_e32 %0, %1, %2":"=v"(r):"v"(a),"v"(b));return r;}
__device__ __forceinline__ float fsub_s(float a,float b){float r;asm("v_sub_f32_e32 %0, %1, %2":"=v"(r):"v"(a),"v"(b));return r;}
typedef float f32x2_t __attribute__((ext_vector_type(2))); typedef __bf16 bf16x2_t __attribute__((ext_vector_type(2)));
__device__ __forceinline__ unsigned cvtpk_s(float lo,float hi){f32x2_t v={lo,hi};bf16x2_t b=__builtin_convertvector(v,bf16x2_t);return __builtin_bit_cast(unsigned,b);}
#define WAIT_BAR(N) asm volatile("s_waitcnt vmcnt(" #N ") lgkmcnt(0)\n\ts_barrier":::"memory")

__device__ __forceinline__ void qkt(f32x16&p0,f32x16&p1,const char*Kslot,const bf16x8*qr,int r32,int hi){ const f32x16 zc_=f32x16{};
  const char*kb=Kslot+hi*1024+r32*16;
  #pragma unroll
  for(int d0=0;d0<4;++d0){
    const bf16x8 b0=*reinterpret_cast<const bf16x8*>(kb+d0*2048);
    const bf16x8 b1=*reinterpret_cast<const bf16x8*>(kb+d0*2048+512);
    if(d0==0){p0=__builtin_amdgcn_mfma_f32_32x32x16_bf16(b0,qr[0],zc_,0,0,0);p1=__builtin_amdgcn_mfma_f32_32x32x16_bf16(b1,qr[0],zc_,0,0,0);}
    else{p0=__builtin_amdgcn_mfma_f32_32x32x16_bf16(b0,qr[d0],p0,0,0,0);p1=__builtin_amdgcn_mfma_f32_32x32x16_bf16(b1,qr[d0],p1,0,0,0);}}
}
typedef __attribute__((address_space(3))) const char* lds_cptr;
typedef short v4i16_t __attribute__((ext_vector_type(4)));
__device__ __forceinline__ void kload8(bf16x8*kf,lds_cptr kp){
  kf[0]=*(const __attribute__((address_space(3))) bf16x8*)(kp);      kf[1]=*(const __attribute__((address_space(3))) bf16x8*)(kp+512);
  kf[2]=*(const __attribute__((address_space(3))) bf16x8*)(kp+2048); kf[3]=*(const __attribute__((address_space(3))) bf16x8*)(kp+2560);
  kf[4]=*(const __attribute__((address_space(3))) bf16x8*)(kp+4096); kf[5]=*(const __attribute__((address_space(3))) bf16x8*)(kp+4608);
  kf[6]=*(const __attribute__((address_space(3))) bf16x8*)(kp+6144); kf[7]=*(const __attribute__((address_space(3))) bf16x8*)(kp+6656);
}
__device__ __forceinline__ void kload2(bf16x8*kf,lds_cptr kp,int j){ kf[2*j]=*(const __attribute__((address_space(3))) bf16x8*)(kp+j*2048); kf[2*j+1]=*(const __attribute__((address_space(3))) bf16x8*)(kp+j*2048+512); }
__device__ __forceinline__ s16x4 vtr(lds_cptr p){ return __builtin_bit_cast(s16x4,__builtin_amdgcn_ds_read_tr16_b64_v4i16((__attribute__((address_space(3))) v4i16_t*)p)); }
__device__ __forceinline__ float rowmax(const f32x16&p0,const f32x16&p1){
  float a=max3f(p0[0],p0[1],p1[0]),b=max3f(p0[2],p0[3],p1[1]);a=max3f(a,p1[2],p1[3]);
  #pragma unroll
  for(int r=4;r<16;r+=4){a=max3f(a,p0[r],p0[r+1]);b=max3f(b,p0[r+2],p0[r+3]);a=max3f(a,p1[r],p1[r+1]);b=max3f(b,p1[r+2],p1[r+3]);}
  const float m=max2f(a,b);
  auto rr=__builtin_amdgcn_permlane32_swap(__float_as_uint(m),__float_as_uint(m),false,false);
  return max2f(__uint_as_float(rr[0]),__uint_as_float(rr[1]));
}
__device__ __forceinline__ void pv(f32x16*o,int vb,bf16x8 pa0,bf16x8 pa1,bf16x8 pa2,bf16x8 pa3){
  #pragma unroll
  for(int d0=0;d0<2;++d0){s16x4 lo[4],hi[4];
    #pragma unroll
    for(int ks=0;ks<4;++ks){
      asm volatile("ds_read_b64_tr_b16 %0,%1 offset:%c2":"=&v"(lo[ks]):"v"(vb),"i"(d0*4096+ks*1024):"memory");
      asm volatile("ds_read_b64_tr_b16 %0,%1 offset:%c2":"=&v"(hi[ks]):"v"(vb),"i"(d0*4096+ks*1024+512):"memory");}
    asm volatile("s_waitcnt lgkmcnt(0)":::"memory");SBAR();
    #define PK(k) (bf16x8){lo[k][0],lo[k][1],lo[k][2],lo[k][3],hi[k][0],hi[k][1],hi[k][2],hi[k][3]}
    o[d0]=__builtin_amdgcn_mfma_f32_32x32x16_bf16(pa0,PK(0),o[d0],0,0,0);
    o[d0]=__builtin_amdgcn_mfma_f32_32x32x16_bf16(pa1,PK(1),o[d0],0,0,0);
    o[d0]=__builtin_amdgcn_mfma_f32_32x32x16_bf16(pa2,PK(2),o[d0],0,0,0);
    o[d0]=__builtin_amdgcn_mfma_f32_32x32x16_bf16(pa3,PK(3),o[d0],0,0,0);
    #undef PK
  }
}

#ifndef ATTN_STORE16
#define ATTN_STORE16(p,v) (*(u32x4*)(p)=(v))
#endif
template<int THRL,bool CHECK> __device__ __forceinline__ void attn_unit(int b,int h,int qb,const bf16*Q,const bf16*__restrict__ K,const bf16*__restrict__ V,bf16*O,char*shm,unsigned*mism){
  const int tid=threadIdx.x,lane=tid&63,r32=lane&31,hi=lane>>5; const int wid=__builtin_amdgcn_readfirstlane(tid>>6);
  const long rowbase=(long)b*SEQ; const int q0=qb*QB;
  const bf16*Qw=Q+(rowbase+q0+wid*QBLK)*DM+h*D;
  const bf16*Kh=K+rowbase*DM+h*D,*Vh=V+rowbase*DM+h*D;
  const unsigned lds0=(unsigned)(uintptr_t)shm;
  float*wsf=(float*)(shm+LDS_WS)+wid*64;
  const bf16*ksrc=Kh+(long)lane*DM+wid*8;
  const bf16*vsrc=Vh+(long)(16*(wid&3)+(lane>>2))*DM+(wid>>2)*32+(lane&3)*8;
  const unsigned kdst=lds0+LDS_K+wid*1024, vdst=lds0+LDS_V+wid*1024;
  #define DMA_K(t,slot) glds16(ksrc+(long)(t)*KVBLK*DM,(unsigned)__builtin_amdgcn_readfirstlane(kdst+(slot)))
  #define DMA_V(t,slot) glds16(vsrc+(long)(t)*KVBLK*DM,(unsigned)__builtin_amdgcn_readfirstlane(vdst+(slot)))
  const int vb0=(int)(lds0+LDS_V)+((lane>>4)&1)*32+(lane&3)*8+(4*hi+((lane&15)>>2))*64;
  const char*Kbase=shm+LDS_K; bf16x8 kf[8];
  const lds_cptr shm3=(lds_cptr)shm; const lds_cptr kp0=shm3+LDS_K+hi*1024+r32*16; const lds_cptr vp0=shm3+LDS_V+((lane>>4)&1)*32+(lane&3)*8+(4*hi+((lane&15)>>2))*64;
  const int NT=(q0+QB)/KVBLK;
  DMA_K(0,0);DMA_V(0,0);DMA_K(1,SLOTB);
  bf16x8 qr[4];
  #pragma unroll
  for(int d0=0;d0<4;++d0)qr[d0]=*reinterpret_cast<const bf16x8*>(&Qw[(long)r32*DM+d0*16+hi*8]);
  float mhat=0.f,l_reg=0.f;f32x16 o[2];o[0]=f32x16{};o[1]=f32x16{};u32x4 qaw={hi==0?0x3f803f80u:0u,0u,0u,0u};
  const int qrel=wid*QBLK+r32;
  #define CMASK(P0,P1,t) do{int jb_=(t)-(NT-4); if(jb_>=0)cmask(P0,P1,jb_,qrel,hi);}while(0)
  const __attribute__((address_space(3))) unsigned* biasw=(const __attribute__((address_space(3))) unsigned*)(shm3+LDS_BIAS)+r32;
  #define SETM() do{ const float nm_=-mhat; const unsigned h_=cvtpk_s(nm_,0.f)&0xffffu; const unsigned l_=cvtpk_s(nm_-__uint_as_float(h_<<16),0.f)&0xffffu; qaw[1]=(hi==0)?(h_|(l_<<16)):0u; }while(0)
  #define AUG(P0,P1,t) do{ const unsigned w0_=biasw[64*(t)], w1_=biasw[64*(t)+32]; const u32x4 ka0_={w0_,0x3f803f80u,0u,0u}, ka1_={w1_,0x3f803f80u,0u,0u}; \
      P0=__builtin_amdgcn_mfma_f32_32x32x16_bf16(__builtin_bit_cast(bf16x8,ka0_),__builtin_bit_cast(bf16x8,qaw),P0,0,0,0); \
      P1=__builtin_amdgcn_mfma_f32_32x32x16_bf16(__builtin_bit_cast(bf16x8,ka1_),__builtin_bit_cast(bf16x8,qaw),P1,0,0,0); }while(0)
  bool resc=false;
  #define START(P0,P1) do{ const float rm=rowmax(P0,P1); resc=false; \
    { const float dl=rm; mhat=fadd_s(mhat,dl); \
      _Pragma("unroll") for(int r=0;r<16;++r){P0[r]=fsub_s(P0[r],dl);P1[r]=fsub_s(P1[r],dl);} \
      SETM(); } \
    _Pragma("unroll") for(int r=0;r<16;++r)P0[r]=__builtin_amdgcn_exp2f(P0[r]); }while(0)
  #define RESC() do{ if(resc){ asm volatile("s_waitcnt lgkmcnt(0)":::"memory"); \
      _Pragma("unroll") for(int d_=0;d_<2;++d_) _Pragma("unroll") for(int r=0;r<16;++r)o[d_][r]*=wsf[crow(r,hi)]; } }while(0)
  f32x16 pA0,pA1,pB0,pB1;
  int sl_prev=0,sl_cur=0,sl_next=SLOTB;
  #define ROT() do{sl_prev=sl_cur;sl_cur=sl_next;sl_next=(sl_next==(NSLOT-1)*SLOTB)?0:sl_next+SLOTB;}while(0)
  DMA_K(2,2*SLOTB);
  WAIT_BAR(3);
  qkt(pA0,pA1,Kbase,qr,r32,hi);AUG(pA0,pA1,0);asm volatile("s_nop 15\n\ts_nop 7":"+v"(pA0),"+v"(pA1));CMASK(pA0,pA1,0);
  START(pA0,pA1);
  _Pragma("unroll") for(int r=0;r<16;++r)pA1[r]=__builtin_amdgcn_exp2f(pA1[r]);
  WAIT_BAR(0);
  DMA_K(3,0);DMA_V(1,SLOTB);
  ROT();
  kload8(kf,kp0+sl_cur);
  WAIT_BAR(2);
  s16x4 vlo[8],vhi[8]; u32x4 pw0,pw1,pw2,pw3; const f32x16 zc16=f32x16{};
  #define PKW(P,B) cvtpk_s(P[B],P[B+1])
  #define PAF(k) __builtin_bit_cast(bf16x8,pw##k)
  #define VFR(i) (bf16x8){vlo[i][0],vlo[i][1],vlo[i][2],vlo[i][3],vhi[i][0],vhi[i][1],vhi[i][2],vhi[i][3]}
  #define PIN(x) asm volatile("":"+v"(x))
  #define MX3(a,b,c) __builtin_fmaxf(__builtin_fmaxf((a),(b)),(c))
  #define GAPA(MF,A0,A1,A2,A3,W0,W1,PW) do{ MF; sacc+=A0; sacc+=A1; sacc+=A2; sacc+=A3; PIN(sacc); W0; W1; PIN(PW); SBAR(); }while(0)
  #define EX(v) __builtin_amdgcn_exp2f(v)
  #define GAPB(MF,X,B) do{ MF; X[B]=EX(X[B]); X[B+1]=EX(X[B+1]); X[B+2]=EX(X[B+2]); X[B+3]=EX(X[B+3]); PIN(X); SBAR(); }while(0)
  #define VRD(i) do{ vlo[i]=vtr(vp_+(((i)>>2)*4096+((i)&3)*1024)); vhi[i]=vtr(vp_+(((i)>>2)*4096+((i)&3)*1024+512)); }while(0)
  #define KRD(G,j) do{ if(G){ kload2(kf,kp0+sl_next,j); SBAR(); } }while(0)
  #define STEP(C0,C1,P0,P1,t,GK,GV,GL) do{ SBAR(); \
    const lds_cptr vp_=vp0+sl_prev; \
    VRD(0); SBAR(); float sacc=(P0[0]+P0[1]); \
    GAPA(C0=__builtin_amdgcn_mfma_f32_32x32x16_bf16(kf[0],qr[0],zc16,0,0,0), P0[2],P0[3],P0[4],P0[5],     pw0[0]=PKW(P0,0), pw0[1]=PKW(P0,2), pw0); \
    VRD(4); SBAR(); GAPA(C1=__builtin_amdgcn_mfma_f32_32x32x16_bf16(kf[1],qr[0],zc16,0,0,0), P0[6],P0[7],P0[8],P0[9],     pw0[2]=PKW(P0,4), pw0[3]=PKW(P0,6), pw0); \
    VRD(1); SBAR(); GAPA(C0=__builtin_amdgcn_mfma_f32_32x32x16_bf16(kf[2],qr[1],C0,0,0,0),   P0[10],P0[11],P0[12],P0[13], pw1[0]=PKW(P0,8), pw1[1]=PKW(P0,10), pw1); \
    VRD(5); SBAR(); GAPA(C1=__builtin_amdgcn_mfma_f32_32x32x16_bf16(kf[3],qr[1],C1,0,0,0),   P0[14],P0[15],P1[0],P1[1],   pw1[2]=PKW(P0,12),pw1[3]=PKW(P0,14), pw1); \
    VRD(2); SBAR(); GAPA(C0=__builtin_amdgcn_mfma_f32_32x32x16_bf16(kf[4],qr[2],C0,0,0,0),   P1[2],P1[3],P1[4],P1[5],     pw2[0]=PKW(P1,0), pw2[1]=PKW(P1,2), pw2); \
    VRD(6); SBAR(); GAPA(C1=__builtin_amdgcn_mfma_f32_32x32x16_bf16(kf[5],qr[2],C1,0,0,0),   P1[6],P1[7],P1[8],P1[9],     pw2[2]=PKW(P1,4), pw2[3]=PKW(P1,6), pw2); \
    VRD(3); SBAR(); GAPA(C0=__builtin_amdgcn_mfma_f32_32x32x16_bf16(kf[6],qr[3],C0,0,0,0),   P1[10],P1[11],P1[12],P1[13], pw3[0]=PKW(P1,8), pw3[1]=PKW(P1,10), pw3); \
    VRD(7); SBAR(); GAPA(C1=__builtin_amdgcn_mfma_f32_32x32x16_bf16(kf[7],qr[3],C1,0,0,0),   P1[14],P1[15],0.f,0.f,       pw3[2]=PKW(P1,12),pw3[3]=PKW(P1,14), pw3); \
    AUG(C0,C1,t); l_reg+=sacc; \
    if(GK){DMA_K((t)+3,sl_cur);} if(GV){DMA_V((t)+1,sl_next);} \
    CMASK(C0,C1,t); \
    { float a=MX3(C0[0],C0[1],C1[0]),b=MX3(C0[2],C0[3],C1[1]); a=MX3(a,C1[2],C1[3]); \
      _Pragma("unroll") for(int r=4;r<16;r+=4){a=MX3(a,C0[r],C0[r+1]);b=MX3(b,C0[r+2],C0[r+3]);a=MX3(a,C1[r],C1[r+1]);b=MX3(b,C1[r+2],C1[r+3]);} \
      float rm=__builtin_fmaxf(a,b); { auto rr=__builtin_amdgcn_permlane32_swap(__float_as_uint(rm),__float_as_uint(rm),false,false); rm=__builtin_fmaxf(__uint_as_float(rr[0]),__uint_as_float(rr[1])); } \
      resc=false; \
      if(__builtin_expect(__any(rm>(float)THRL),0)){ const float dl=__builtin_fmaxf(rm,0.f); mhat+=dl; \
        _Pragma("unroll") for(int r=0;r<16;++r){C0[r]-=dl;C1[r]-=dl;} \
        SETM(); \
        const float f=__builtin_amdgcn_exp2f(-dl); l_reg*=f; if(hi==0)wsf[r32]=f; resc=true; } } \
    SBAR(); \
    GAPB(o[0]=__builtin_amdgcn_mfma_f32_32x32x16_bf16(PAF(0),VFR(0),o[0],0,0,0), C0,0); \
    GAPB(o[1]=__builtin_amdgcn_mfma_f32_32x32x16_bf16(PAF(0),VFR(4),o[1],0,0,0), C0,4); \
    KRD(GL,0); GAPB(o[0]=__builtin_amdgcn_mfma_f32_32x32x16_bf16(PAF(1),VFR(1),o[0],0,0,0), C0,8); \
    KRD(GL,1); GAPB(o[1]=__builtin_amdgcn_mfma_f32_32x32x16_bf16(PAF(1),VFR(5),o[1],0,0,0), C0,12); \
    KRD(GL,2); GAPB(o[0]=__builtin_amdgcn_mfma_f32_32x32x16_bf16(PAF(2),VFR(2),o[0],0,0,0), C1,0); \
    KRD(GL,3); GAPB(o[1]=__builtin_amdgcn_mfma_f32_32x32x16_bf16(PAF(2),VFR(6),o[1],0,0,0), C1,4); \
    GAPB(o[0]=__builtin_amdgcn_mfma_f32_32x32x16_bf16(PAF(3),VFR(3),o[0],0,0,0), C1,8); \
    GAPB(o[1]=__builtin_amdgcn_mfma_f32_32x32x16_bf16(PAF(3),VFR(7),o[1],0,0,0), C1,12); \
    }while(0)
  int t=1;
  #undef CMASK
  #define CMASK(P0,P1,t) do{}while(0)
  for(;t+5<NT;t+=2){
    STEP(pB0,pB1,pA0,pA1,t,true,true,true);     WAIT_BAR(2); RESC(); ROT();
    STEP(pA0,pA1,pB0,pB1,t+1,true,true,true);   WAIT_BAR(2); RESC(); ROT();
  }
  #undef CMASK
  #define CMASK(P0,P1,t) do{int jb_=(t)-(NT-4); if(jb_>=0)cmask(P0,P1,jb_,qrel,hi);}while(0)
  #define ENDW(tt) do{ if((tt)+3<NT){WAIT_BAR(2);} else if((tt)+2<NT){WAIT_BAR(1);} else {WAIT_BAR(0);} }while(0)
  for(;t+1<NT;t+=2){
    STEP(pB0,pB1,pA0,pA1,t,(t+3<NT),(t+1<NT),(t+1<NT));       ENDW(t);   RESC(); ROT();
    STEP(pA0,pA1,pB0,pB1,t+1,(t+4<NT),(t+2<NT),(t+2<NT));     ENDW(t+1); RESC(); ROT();
  }
  STEP(pB0,pB1,pA0,pA1,NT-1,false,false,false); RESC();
  { float sacc=pB0[0]+pB0[1]; _Pragma("unroll") for(int r=2;r<16;++r)sacc+=pB0[r]; _Pragma("unroll") for(int r=0;r<16;++r)sacc+=pB1[r]; l_reg+=sacc;
    pw0=(u32x4){PKW(pB0,0),PKW(pB0,2),PKW(pB0,4),PKW(pB0,6)};pw1=(u32x4){PKW(pB0,8),PKW(pB0,10),PKW(pB0,12),PKW(pB0,14)};pw2=(u32x4){PKW(pB1,0),PKW(pB1,2),PKW(pB1,4),PKW(pB1,6)};pw3=(u32x4){PKW(pB1,8),PKW(pB1,10),PKW(pB1,12),PKW(pB1,14)};
    SBAR(); pv(o,vb0+sl_cur,PAF(0),PAF(1),PAF(2),PAF(3)); }
  #undef PKW
  #undef PAF
  #undef VFR
  #undef PIN
  #undef MX3
  #undef GAPA
  #undef GAPB
  #undef EX
  #undef VRD
  #undef KRD
  #undef STEP
  #undef ENDW
  {auto rr=__builtin_amdgcn_permlane32_swap(__float_as_uint(l_reg),__float_as_uint(l_reg),false,false);l_reg=__uint_as_float(rr[0])+__uint_as_float(rr[1]);}
  if(hi==0)wsf[32+r32]=l_reg;asm volatile("s_waitcnt lgkmcnt(0)":::"memory");
  float rli[16];
  #pragma unroll
  for(int r=0;r<16;++r)rli[r]=__builtin_amdgcn_rcpf(wsf[32+crow(r,hi)]);
  bf16*Ow=O+(rowbase+q0+wid*QBLK)*OPITCH+h*D;
  { bf16*stg=(bf16*)(shm+LDS_OST)+wid*2048;
    #pragma unroll
    for(int r=0;r<16;++r){const int orow=crow(r,hi);
      #pragma unroll
      for(int d0=0;d0<2;++d0)stg[orow*64+d0*32+r32]=__float2bfloat16(o[d0][r]*rli[r]);}
    asm volatile("s_waitcnt lgkmcnt(0)":::"memory");
    #pragma unroll
    for(int i=0;i<4;++i){const int row=i*8+(lane>>3),ch=lane&7; const u32x4 v=*(const u32x4*)(stg+row*64+ch*8); ATTN_STORE16(Ow+(long)row*OPITCH+ch*8,v);} }
  asm volatile("s_waitcnt lgkmcnt(0)\n\ts_barrier":::"memory");
  #undef DMA_K
  #undef DMA_V
  #undef CMASK
  #undef AUG
  #undef SETM
  #undef START
  #undef RESC
  #undef ROT
}
constexpr int ATTN_LDS_BYTES=LDS_BYTES;
#undef SBAR
#undef WAIT_BAR
}

namespace att {
template <bool CHECK> __device__ __forceinline__ void fox_unit_p(char* shm_g, LAS char* shm, int b, int h, int qb, const bf16_t* proj, const float* fb, float fbias_h, bf16_t* heads, unsigned* mism, bool do_scan) {
    const int tid = threadIdx.x, lane = tid & 63; const int wid = __builtin_amdgcn_readfirstlane(tid >> 6);
    if (do_scan) {
    LAS unsigned* biasw = (LAS unsigned*)(shm + attp::LDS_BIAS); LAS float* scan = (LAS float*)(shm + attp::LDS_SCAN);
    const int kend = (qb + 1) * 256;
    float v[4]; float s = 0.f;
#pragma unroll
    for (int i = 0; i < 4; ++i) { const int p = tid * 4 + i; float lf = 0.f; if (p < kend) lf = log_sigmoid_fast(fb[((size_t)b * SEQ + p) * 8 + h] + fbias_h); s += lf; v[i] = s; }
    float w = s;
#pragma unroll
    for (int o = 1; o < 64; o <<= 1) { const float t = __shfl_up(w, o); if (lane >= o) w += t; }
    if (lane == 63) scan[wid] = w;
    asm volatile("s_waitcnt lgkmcnt(0)\n\ts_barrier" ::: "memory");
    float off = w - s;
    for (int k = 0; k < 8; ++k) if (k < wid) off += scan[k];
#pragma unroll
    for (int i = 0; i < 4; ++i) { const float bv = -(v[i] + off) * LOG2E; const unsigned hb = cvt_pk_bf16(bv, 0.f) & 0xffffu; const unsigned lb = cvt_pk_bf16(bv - __uint_as_float(hb << 16), 0.f) & 0xffffu; biasw[tid * 4 + i] = hb | (lb << 16); }
    asm volatile("s_waitcnt vmcnt(0) lgkmcnt(0)\n\ts_barrier" ::: "memory");
    }
    attp::attn_unit<8, CHECK>(b, h, qb, (const attp::bf16*)(proj + 768), (const attp::bf16*)(proj + 1280), (const attp::bf16*)(proj + 1792), (attp::bf16*)(heads + 512), shm_g, mism);
    asm volatile("s_waitcnt vmcnt(0)" ::: "memory");
}
}
namespace mx {
using namespace mk;
constexpr size_t WS_QD = WS_XN, WS_KI = WS_XN + 16 * MiB, WS_DTV = 456 * MiB, WS_ACS = 457 * MiB, WS_KE = 458 * MiB, WS_DEC = 474 * MiB;
constexpr int XROW = 144;
__device__ __forceinline__ s16x4 tr_read(unsigned addr) { s16x4 r; asm volatile("ds_read_b64_tr_b16 %0, %1" : "=v"(r) : "v"(addr) : "memory"); return r; }
template <int OFF> __device__ __forceinline__ s16x4 tr_read_o(unsigned addr) { s16x4 r; asm volatile("ds_read_b64_tr_b16 %0, %1 offset:%2" : "=v"(r) : "v"(addr), "i"(OFF) : "memory"); return r; }
#define MX_LGKM0() do { asm volatile("s_waitcnt lgkmcnt(0)" ::: "memory"); __builtin_amdgcn_sched_barrier(0); } while (0)
#define MX_BAR() asm volatile("s_waitcnt vmcnt(0) lgkmcnt(0)\n\ts_barrier" ::: "memory")
#define MX_BAR_L() asm volatile("s_waitcnt lgkmcnt(0)\n\ts_barrier" ::: "memory")
__device__ __forceinline__ bf16x8 cat8(s16x4 lo, s16x4 hi) { return (bf16x8){lo[0], lo[1], lo[2], lo[3], hi[0], hi[1], hi[2], hi[3]}; }
__device__ __forceinline__ unsigned sw256(int row, int ch) { return (unsigned)(row * 256 + ((ch ^ (row & 15)) << 4)); }

__device__ __forceinline__ void prep_conv(const bf16_t* PROJ, bf16_t* CONV, const float* conv_w, const float* conv_b, int vcu, int G, int tid) {
    for (int item = vcu * NTHR + tid; item < (T / 16) * 192; item += G * NTHR) {
        const int cg = item % 192, rb = item / 192, ch0 = cg * 8, row0 = rb * 16, t0 = row0 & (SEQ - 1);
        float w[4][8], bs[8], xw[3][8];
#pragma unroll
        for (int j = 0; j < 4; ++j) { const f32x4 a = *(const f32x4*)(conv_w + j * 1536 + ch0), b = *(const f32x4*)(conv_w + j * 1536 + ch0 + 4);
#pragma unroll
            for (int i = 0; i < 4; ++i) { w[j][i] = a[i]; w[j][4 + i] = b[i]; } }
        { const f32x4 a = *(const f32x4*)(conv_b + ch0), b = *(const f32x4*)(conv_b + ch0 + 4);
#pragma unroll
          for (int i = 0; i < 4; ++i) { bs[i] = a[i]; bs[4 + i] = b[i]; } }
#pragma unroll
        for (int j = 0; j < 3; ++j) { const int tt = t0 - 3 + j;
            u32x4 v = {0u, 0u, 0u, 0u}; if (tt >= 0) v = *(const u32x4*)(PROJ + (size_t)(row0 - 3 + j) * NO_IN + 1024 + ch0);
#pragma unroll
            for (int i = 0; i < 4; ++i) { xw[j][2 * i] = __uint_as_float(v[i] << 16); xw[j][2 * i + 1] = __uint_as_float(v[i] & 0xffff0000u); } }
#pragma unroll 4
        for (int r = 0; r < 16; ++r) {
            const u32x4 v = *(const u32x4*)(PROJ + (size_t)(row0 + r) * NO_IN + 1024 + ch0);
            float x3[8], o[8];
#pragma unroll
            for (int i = 0; i < 4; ++i) { x3[2 * i] = __uint_as_float(v[i] << 16); x3[2 * i + 1] = __uint_as_float(v[i] & 0xffff0000u); }
#pragma unroll
            for (int i = 0; i < 8; ++i) { const float a = bs[i] + w[0][i] * xw[0][i] + w[1][i] * xw[1][i] + w[2][i] * xw[2][i] + w[3][i] * x3[i]; o[i] = siluf(a);
                xw[0][i] = xw[1][i]; xw[1][i] = xw[2][i]; xw[2][i] = x3[i]; }
            u32x4 ov; ov.x = cvt_pk_bf16(o[0], o[1]); ov.y = cvt_pk_bf16(o[2], o[3]); ov.z = cvt_pk_bf16(o[4], o[5]); ov.w = cvt_pk_bf16(o[6], o[7]);
            *(u32x4*)(CONV + (size_t)(row0 + r) * 1536 + ch0) = ov;
        }
    }
}
__device__ __forceinline__ void prep_ssd(const float* DTG, float* DTV, float* ACS, const float* dt_bias, const float* a_log, int vcu, int G, int lane, int wave) {
    const int gw = vcu * NWAVES + wave, ngw = G * NWAVES;
    for (int item = gw; item < NBATCH * 32 * 16; item += ngw) {
        const int h = item & 15, c = (item >> 4) & 31, b = item >> 9; const size_t r0 = (size_t)b * SEQ + c * 64 + lane;
        const float a = -expf(a_log[h]), db = dt_bias[h];
        const float d0 = softplusf(DTG[r0 * 32 + h] + db);
        float w = a * d0;
#pragma unroll
        for (int o = 1; o < 64; o <<= 1) { const float t = __shfl_up(w, o); if (lane >= o) w += t; }
        ACS[r0 * 16 + h] = w; DTV[r0 * 16 + h] = d0;
    }
}
__device__ __forceinline__ void prep_gla(const bf16_t* PROJ, const float* DTG, bf16_t* QD, bf16_t* KI, bf16_t* KE, float* DEC, const float* gk_w, const float* gk_b, int vcu, int G, int tid, int lane, int wave, LAS char* shm) {
    {
        LAS float* gl = (LAS float*)(shm);
        LAS float* tot = (LAS float*)(shm + 8192);
        const int half = wave >> 2, rq = wave & 3, t256 = tid & 255;
        for (int pair = vcu; pair < NBATCH * 32 * 4 / 2; pair += G) {
            const int item = pair * 2 + half; const int h = item & 3, c = (item >> 2) & 31, b = item >> 7; const size_t r0 = (size_t)b * SEQ + c * 64;
            unsigned short qv[16][2], kv[16][2];
#pragma unroll
            for (int r = 0; r < 16; ++r) { const bf16_t* pr = PROJ + (r0 + rq * 16 + r) * NO_IN;
                qv[r][0] = pr[2560 + h * 128 + lane]; qv[r][1] = pr[2560 + h * 128 + 64 + lane]; kv[r][0] = pr[3072 + h * 128 + lane]; kv[r][1] = pr[3072 + h * 128 + 64 + lane]; }
            float w0[16], w1[16];
#pragma unroll
            for (int j = 0; j < 16; ++j) { w0[j] = gk_w[j * 512 + h * 128 + lane]; w1[j] = gk_w[j * 512 + h * 128 + 64 + lane]; }
            const float b0 = gk_b[h * 128 + lane], b1 = gk_b[h * 128 + 64 + lane];
            { const int rr = t256 >> 2, q4 = t256 & 3; *(LAS f32x4*)(gl + half * 1024 + rr * 16 + q4 * 4) = *(const f32x4*)(DTG + (r0 + rr) * 32 + 16 + q4 * 4); }
            asm volatile("s_waitcnt vmcnt(0) lgkmcnt(0)\n\ts_barrier" ::: "memory");
            float c0[16], c1[16]; float run0 = 0.f, run1 = 0.f;
#pragma unroll
            for (int r = 0; r < 16; ++r) {
                const LAS f32x4* gp = (const LAS f32x4*)(gl + half * 1024 + (rq * 16 + r) * 16); float a0 = b0, a1 = b1;
#pragma unroll
                for (int q = 0; q < 4; ++q) { const f32x4 g = gp[q];
#pragma unroll
                    for (int i = 0; i < 4; ++i) { a0 += g[i] * w0[4 * q + i]; a1 += g[i] * w1[4 * q + i]; } }
                run0 += log_sigmoid_fast(a0) * (1.f / 16.f); run1 += log_sigmoid_fast(a1) * (1.f / 16.f); c0[r] = run0; c1[r] = run1;
            }
            tot[(half * 4 + rq) * 128 + lane] = run0; tot[(half * 4 + rq) * 128 + 64 + lane] = run1;
            asm volatile("s_waitcnt lgkmcnt(0)\n\ts_barrier" ::: "memory");
            float pre0 = 0.f, pre1 = 0.f, last0 = 0.f, last1 = 0.f;
#pragma unroll
            for (int q = 0; q < 4; ++q) { const float t0 = tot[(half * 4 + q) * 128 + lane], t1 = tot[(half * 4 + q) * 128 + 64 + lane]; if (q < rq) { pre0 += t0; pre1 += t1; } last0 += t0; last1 += t1; }
            const float scale = 0.08838834764831845f;
#pragma unroll
            for (int r = 0; r < 16; ++r) {
                const float g0 = pre0 + c0[r], g1 = pre1 + c1[r];
                const float q0 = bf2f(qv[r][0]), q1 = bf2f(qv[r][1]), k0 = bf2f(kv[r][0]), k1 = bf2f(kv[r][1]);
                const size_t o = (r0 + rq * 16 + r) * 512 + h * 128 + lane;
                QD[o] = (bf16_t)(cvt_pk_bf16(q0 * scale * __expf(g0), 0.f) & 0xffffu); QD[o + 64] = (bf16_t)(cvt_pk_bf16(q1 * scale * __expf(g1), 0.f) & 0xffffu);
                KI[o] = (bf16_t)(cvt_pk_bf16(k0 * __expf(-g0), 0.f) & 0xffffu); KI[o + 64] = (bf16_t)(cvt_pk_bf16(k1 * __expf(-g1), 0.f) & 0xffffu);
            }
            if (rq == 0) { DEC[((size_t)b * 32 + c) * 512 + h * 128 + lane] = __expf(last0); DEC[((size_t)b * 32 + c) * 512 + h * 128 + 64 + lane] = __expf(last1); }
            asm volatile("s_waitcnt lgkmcnt(0)\n\ts_barrier" ::: "memory");
        }
    }
}

constexpr int S_C = 0, S_B = 32768, S_X = 65536, S_XW = S_X + 128 * XROW, S_PREV = S_XW + 128 * XROW, S_ACS = S_PREV + 16384, S_DT = S_ACS + 512, S_YST = S_DT + 512, S_END = S_YST + 8 * 2304;
static_assert(S_END <= RING_BYTES, "SSD LDS");
__device__ __forceinline__ void ssd_unit(LAS char* shm, int b, int h, const bf16_t* CONV, const float* ACS, const float* DTV, float dsk, bf16_t* MIX) {
    const int tid = threadIdx.x, lane = tid & 63, fr = lane & 15, fq = lane >> 4; const int w = __builtin_amdgcn_readfirstlane(tid >> 6);
    const int g = h >> 3, row = tid >> 2, qd = tid & 3, l0 = 16 * w;
    const unsigned lds0 = (unsigned)(uintptr_t)shm;
    LAS float* acsl = (LAS float*)(shm + S_ACS); LAS float* dtl = (LAS float*)(shm + S_DT);
    f32x4 st[4];
#pragma unroll
    for (int i = 0; i < 4; ++i) st[i] = (f32x4){0.f, 0.f, 0.f, 0.f};
    u32x4 rc[4], rb[4], rx[2]; float racs, rdt, rend;
    const size_t seq0 = (size_t)b * SEQ;
#define SSD_LOAD(c) do { const size_t gr = seq0 + (size_t)(c) * 128 + row; const bf16_t* p = CONV + gr * 1536; \
        _Pragma("unroll") for (int i = 0; i < 4; ++i) { rc[i] = *(const u32x4*)(p + 1280 + g * 128 + qd * 32 + 8 * i); rb[i] = *(const u32x4*)(p + 1024 + g * 128 + qd * 32 + 8 * i); } \
        _Pragma("unroll") for (int i = 0; i < 2; ++i) rx[i] = *(const u32x4*)(p + h * 64 + qd * 16 + 8 * i); \
        racs = ACS[gr * 16 + h]; rdt = DTV[gr * 16 + h]; rend = ACS[(seq0 + (size_t)(c) * 128 + 127) * 16 + h]; } while (0)
#ifdef SSD_DUMMY
    SSD_LOAD(0);
    for (int c = 0; c < 16; ++c) {
#pragma unroll
        for (int i = 0; i < 4; ++i) { *(LAS u32x4*)(shm + S_C + sw256(row, qd * 4 + i)) = rc[i]; *(LAS u32x4*)(shm + S_B + sw256(row, qd * 4 + i)) = rb[i]; }
        const float wr = rdt * __expf(rend - racs);
#pragma unroll
        for (int i = 0; i < 2; ++i) { *(LAS u32x4*)(shm + S_X + row * XROW + qd * 32 + 16 * i) = rx[i];
            u32x4 o;
#pragma unroll
            for (int k = 0; k < 4; ++k) o[k] = cvt_pk_bf16(__uint_as_float(rx[i][k] << 16) * wr, __uint_as_float(rx[i][k] & 0xffff0000u) * wr);
            *(LAS u32x4*)(shm + S_XW + row * XROW + qd * 32 + 16 * i) = o; }
        if (qd == 0) { acsl[row] = racs; dtl[row] = rdt; }
        MX_BAR_L();
        if (c + 1 < 16) SSD_LOAD(c + 1);
        MX_BAR_L();
    }
#endif
#ifndef SSD_NOPREF
    SSD_LOAD(0);
#endif
    const unsigned xtr = lds0 + (unsigned)(((lane & 15) >> 2) * XROW + (lane & 3) * 8);
    for (int c = 0; c < 16; ++c) {
#ifdef SSD_NOPREF
        SSD_LOAD(c);
#endif
#ifdef SSD_REP_WR
        for (int rep_ = 0; rep_ < 2; ++rep_)
#endif
        {
#pragma unroll
            for (int i = 0; i < 4; ++i) { *(LAS u32x4*)(shm + S_C + sw256(row, qd * 4 + i)) = rc[i]; *(LAS u32x4*)(shm + S_B + sw256(row, qd * 4 + i)) = rb[i]; }
            const float wr = rdt * __expf(rend - racs);
#pragma unroll
            for (int i = 0; i < 2; ++i) { *(LAS u32x4*)(shm + S_X + row * XROW + qd * 32 + 16 * i) = rx[i];
                u32x4 o;
#pragma unroll
                for (int k = 0; k < 4; ++k) o[k] = cvt_pk_bf16(__uint_as_float(rx[i][k] << 16) * wr, __uint_as_float(rx[i][k] & 0xffff0000u) * wr);
                *(LAS u32x4*)(shm + S_XW + row * XROW + qd * 32 + 16 * i) = o; }
            if (qd == 0) { acsl[row] = racs; dtl[row] = rdt; }
#pragma unroll
            for (int pt = 0; pt < 4; ++pt) { u32x2 v; v.x = cvt_pk_bf16(st[pt][0], st[pt][1]); v.y = cvt_pk_bf16(st[pt][2], st[pt][3]);
                const int p = 16 * pt + fr; *(LAS u32x2*)(shm + S_PREV + sw256(p, 2 * w + (fq >> 1)) + (fq & 1) * 8) = v; }
        }
        MX_BAR_L();
#ifndef SSD_NOPREF
        if (c + 1 < 16) SSD_LOAD(c + 1);
#endif
        bf16x8 cf[4];
#pragma unroll
        for (int ks = 0; ks < 4; ++ks) cf[ks] = *(const LAS bf16x8*)(shm + S_C + sw256(l0 + fr, 4 * ks + fq));
        f32x4 yd[4], yo[4];
#pragma unroll
        for (int i = 0; i < 4; ++i) { yd[i] = (f32x4){0.f, 0.f, 0.f, 0.f}; yo[i] = (f32x4){0.f, 0.f, 0.f, 0.f}; }
        const float acs_l = acsl[l0 + fr]; const int lcol = l0 + fr;
        const int nsb = (w >> 1) + 1;
#ifdef SSD_REP_SB
        for (int rep_ = 0; rep_ < 2; ++rep_) {
#pragma unroll
        for (int i = 0; i < 4; ++i) yd[i] = (f32x4){0.f, 0.f, 0.f, 0.f};
#endif
        for (int sb = 0; sb < nsb; ++sb) {
            const int s0 = 32 * sb; const bool two = (2 * sb + 1) <= w;
            s16x4 lo[4], hi[4];
#pragma unroll
            for (int pt = 0; pt < 4; ++pt) { lo[pt] = tr_read(xtr + S_X + (unsigned)((s0 + 4 * fq) * XROW + pt * 32)); hi[pt] = tr_read(xtr + S_X + (unsigned)((s0 + 16 + 4 * fq) * XROW + pt * 32)); }
            f32x4 a0 = {0.f, 0.f, 0.f, 0.f}, a1 = {0.f, 0.f, 0.f, 0.f};
#pragma unroll
            for (int ks = 0; ks < 4; ++ks) { const bf16x8 bf = *(const LAS bf16x8*)(shm + S_B + sw256(s0 + fr, 4 * ks + fq)); a0 = __builtin_amdgcn_mfma_f32_16x16x32_bf16(bf, cf[ks], a0, 0, 0, 0); }
            if (two) {
#pragma unroll
                for (int ks = 0; ks < 4; ++ks) { const bf16x8 bf = *(const LAS bf16x8*)(shm + S_B + sw256(s0 + 16 + fr, 4 * ks + fq)); a1 = __builtin_amdgcn_mfma_f32_16x16x32_bf16(bf, cf[ks], a1, 0, 0, 0); }
            }
            const f32x4 as0 = *(const LAS f32x4*)(acsl + s0 + 4 * fq), as1 = *(const LAS f32x4*)(acsl + s0 + 16 + 4 * fq);
            const f32x4 dq0 = *(const LAS f32x4*)(dtl + s0 + 4 * fq), dq1 = *(const LAS f32x4*)(dtl + s0 + 16 + 4 * fq);
            float g0[4], g1[4];
#pragma unroll
            for (int i = 0; i < 4; ++i) { const int sa = s0 + 4 * fq + i, sb2 = sa + 16;
                g0[i] = (sa <= lcol) ? a0[i] * __expf(fminf(acs_l - as0[i], 0.f)) * dq0[i] : 0.f;
                g1[i] = (two && sb2 <= lcol) ? a1[i] * __expf(fminf(acs_l - as1[i], 0.f)) * dq1[i] : 0.f; }
            u32x4 ap; ap.x = cvt_pk_bf16(g0[0], g0[1]); ap.y = cvt_pk_bf16(g0[2], g0[3]); ap.z = cvt_pk_bf16(g1[0], g1[1]); ap.w = cvt_pk_bf16(g1[2], g1[3]);
            const bf16x8 af = __builtin_bit_cast(bf16x8, ap);
            MX_LGKM0();
#pragma unroll
            for (int pt = 0; pt < 4; ++pt) yd[pt] = __builtin_amdgcn_mfma_f32_16x16x32_bf16(af, cat8(lo[pt], hi[pt]), yd[pt], 0, 0, 0);
        }
#ifdef SSD_REP_SB
        }
#endif
#ifdef SSD_REP_YO
        for (int rep_ = 0; rep_ < 2; ++rep_) {
#pragma unroll
        for (int i = 0; i < 4; ++i) yo[i] = (f32x4){0.f, 0.f, 0.f, 0.f};
#endif
#pragma unroll
        for (int pt = 0; pt < 4; ++pt)
#pragma unroll
            for (int ks = 0; ks < 4; ++ks) { const bf16x8 pf = *(const LAS bf16x8*)(shm + S_PREV + sw256(16 * pt + fr, 4 * ks + fq)); yo[pt] = __builtin_amdgcn_mfma_f32_16x16x32_bf16(cf[ks], pf, yo[pt], 0, 0, 0); }
#ifdef SSD_REP_YO
        }
#endif
#ifdef SSD_REP_CS
        for (int rep_ = 0; rep_ < 2; ++rep_)
#endif
        {
            const f32x4 al = *(const LAS f32x4*)(acsl + l0 + 4 * fq);
            float ea[4];
#pragma unroll
            for (int i = 0; i < 4; ++i) ea[i] = __expf(al[i]);
            s16x4 xs[4];
#pragma unroll
            for (int pt = 0; pt < 4; ++pt) xs[pt] = tr_read(xtr + S_X + (unsigned)((l0 + 4 * fq) * XROW + pt * 32));
            MX_LGKM0();
            LAS bf16_t* yst = (LAS bf16_t*)(shm + S_YST + w * 2304);
#pragma unroll
            for (int pt = 0; pt < 4; ++pt)
#pragma unroll
                for (int i = 0; i < 4; ++i) { const float y = yd[pt][i] + ea[i] * yo[pt][i] + dsk * bf2f((unsigned short)xs[pt][i]);
                    yst[(4 * fq + i) * 72 + pt * 16 + fr] = (bf16_t)(cvt_pk_bf16(y, 0.f) & 0xffffu); }
            asm volatile("s_waitcnt lgkmcnt(0)" ::: "memory");
            bf16_t* yp = MIX + (seq0 + (size_t)c * 128 + l0) * 2048 + h * 64;
#pragma unroll
            for (int j = 0; j < 2; ++j) { const int rr = (lane >> 3) + 8 * j, ch = lane & 7; const u32x4 v = *(const LAS u32x4*)(yst + rr * 72 + ch * 8); *(u32x4*)(yp + (size_t)rr * 2048 + ch * 8) = v; }
        }
#ifdef SSD_REP_ST
        f32x4 stsave[4];
#pragma unroll
        for (int i = 0; i < 4; ++i) stsave[i] = st[i];
        for (int rep_ = 0; rep_ < 2; ++rep_) {
#pragma unroll
        for (int i = 0; i < 4; ++i) st[i] = stsave[i];
#endif
        {
            const float cd = __expf(acsl[127]);
#pragma unroll
            for (int pt = 0; pt < 4; ++pt) st[pt] = st[pt] * cd;
#pragma unroll
            for (int ks = 0; ks < 4; ++ks) {
                const int s0 = 32 * ks, q = (lane & 15) >> 2, p = lane & 3;
                const int r1 = s0 + 8 * fq + q, r2 = r1 + 4;
                const s16x4 alo = tr_read(lds0 + S_B + sw256(r1, 2 * w + (p >> 1)) + (p & 1) * 8), ahi = tr_read(lds0 + S_B + sw256(r2, 2 * w + (p >> 1)) + (p & 1) * 8);
                s16x4 lo[4], hi[4];
#pragma unroll
                for (int pt = 0; pt < 4; ++pt) { lo[pt] = tr_read(xtr + S_XW + (unsigned)((s0 + 8 * fq) * XROW + pt * 32)); hi[pt] = tr_read(xtr + S_XW + (unsigned)((s0 + 8 * fq + 4) * XROW + pt * 32)); }
                MX_LGKM0();
                const bf16x8 af = cat8(alo, ahi);
#pragma unroll
                for (int pt = 0; pt < 4; ++pt) st[pt] = __builtin_amdgcn_mfma_f32_16x16x32_bf16(af, cat8(lo[pt], hi[pt]), st[pt], 0, 0, 0);
            }
        }
#ifdef SSD_REP_ST
        }
#endif
        MX_BAR_L();
    }
    asm volatile("s_waitcnt vmcnt(0)" ::: "memory");
#undef SSD_LOAD
}

constexpr int S2_C = 0, S2_B = 16384, S2_X = 32768, S2_XW = S2_X + 64 * XROW, S2_ACS = S2_XW + 64 * XROW, S2_DT = S2_ACS + 256, S2_BUF = 53248, S2_PREV = 2 * S2_BUF, S2_END = S2_PREV + 2 * 16384;
static_assert(S2_DT + 256 <= S2_BUF && S2_END <= RING_BYTES, "SSD64 LDS");
__device__ __forceinline__ void ssd_unit64(LAS char* shm, int b, int h, const bf16_t* CONV, const float* ACS, const float* DTV, float dsk, bf16_t* MIX) {
    const int tid = threadIdx.x, lane = tid & 63, fr = lane & 15, fq = lane >> 4; const int w = __builtin_amdgcn_readfirstlane(tid >> 6);
    const int g = h >> 3, row = tid >> 3, ec = tid & 7, lt = w >> 1, l0 = 16 * lt, pt0 = 2 * (w & 1);
    const unsigned lds0 = (unsigned)(uintptr_t)shm;
    f32x4 st[4];
#pragma unroll
    for (int i = 0; i < 4; ++i) st[i] = (f32x4){0.f, 0.f, 0.f, 0.f};
    u32x4 rc[2], rb[2], rx; float racs, rdt, rend;
    const size_t seq0 = (size_t)b * SEQ;
#define S2_LOAD(c) do { const size_t gr = seq0 + (size_t)(c) * 64 + row; const bf16_t* p = CONV + gr * 1536; \
        _Pragma("unroll") for (int i = 0; i < 2; ++i) { rc[i] = *(const u32x4*)(p + 1280 + g * 128 + ec * 16 + 8 * i); rb[i] = *(const u32x4*)(p + 1024 + g * 128 + ec * 16 + 8 * i); } \
        rx = *(const u32x4*)(p + h * 64 + ec * 8); \
        racs = ACS[gr * 16 + h]; rdt = DTV[gr * 16 + h]; rend = ACS[(seq0 + (size_t)(c) * 64 + 63) * 16 + h]; } while (0)
#define S2_WRITE(pb) do { LAS char* gb_ = shm + (pb) * S2_BUF; \
        _Pragma("unroll") for (int i = 0; i < 2; ++i) { *(LAS u32x4*)(gb_ + S2_C + sw256(row, ec * 2 + i)) = rc[i]; *(LAS u32x4*)(gb_ + S2_B + sw256(row, ec * 2 + i)) = rb[i]; } \
        *(LAS u32x4*)(gb_ + S2_X + row * XROW + ec * 16) = rx; \
        { const float wr_ = rdt * __expf(rend - racs); u32x4 o_; \
          _Pragma("unroll") for (int k = 0; k < 4; ++k) o_[k] = cvt_pk_bf16(__uint_as_float(rx[k] << 16) * wr_, __uint_as_float(rx[k] & 0xffff0000u) * wr_); \
          *(LAS u32x4*)(gb_ + S2_XW + row * XROW + ec * 16) = o_; } \
        if (ec == 0) { ((LAS float*)(gb_ + S2_ACS))[row] = racs; ((LAS float*)(gb_ + S2_DT))[row] = rdt; } \
        _Pragma("unroll") for (int pt = 0; pt < 4; ++pt) { u32x2 v; v.x = cvt_pk_bf16(st[pt][0], st[pt][1]); v.y = cvt_pk_bf16(st[pt][2], st[pt][3]); \
            const int p_ = 16 * pt + fr; *(LAS u32x2*)(shm + S2_PREV + (pb) * 16384 + sw256(p_, 2 * w + (fq >> 1)) + (fq & 1) * 8) = v; } } while (0)
    S2_LOAD(0);
    S2_WRITE(0);
    MX_BAR_L();
    unsigned swz[4];
#pragma unroll
    for (int ks = 0; ks < 4; ++ks) swz[ks] = (unsigned)(fr * 256 + (((4 * ks + fq) ^ fr) << 4));
    const int q_ = (lane & 15) >> 2, p_ = lane & 3;
    const unsigned xq4 = (unsigned)((4 * fq + q_) * XROW + p_ * 8), xq8 = (unsigned)((8 * fq + q_) * XROW + p_ * 8);
    const int ra = 8 * fq + q_, rb2 = ra + 4;
    const unsigned bt1 = (unsigned)(ra * 256 + (((2 * w + (p_ >> 1)) ^ (ra & 15)) << 4) + (p_ & 1) * 8), bt2 = (unsigned)(rb2 * 256 + (((2 * w + (p_ >> 1)) ^ (rb2 & 15)) << 4) + (p_ & 1) * 8);
    for (int c = 0; c < 32; ++c) {
        const int pb = c & 1; LAS char* gb = shm + pb * S2_BUF; const unsigned gba = lds0 + (unsigned)(pb * S2_BUF);
        const LAS float* acsl = (const LAS float*)(gb + S2_ACS); const LAS float* dtl = (const LAS float*)(gb + S2_DT);
        if (c + 1 < 32) S2_LOAD(c + 1);
        const LAS char* cbp[4]; const LAS char* pvp[4];
#pragma unroll
        for (int ks = 0; ks < 4; ++ks) { cbp[ks] = gb + swz[ks]; pvp[ks] = shm + S2_PREV + pb * 16384 + pt0 * 4096 + swz[ks]; }
        const unsigned xa4 = gba + xq4 + (unsigned)(pt0 * 32), xa8 = gba + xq8, ba1 = gba + bt1, ba2 = gba + bt2;
        bf16x8 cf[4];
#pragma unroll
        for (int ks = 0; ks < 4; ++ks) cf[ks] = *(const LAS bf16x8*)(cbp[ks] + S2_C + l0 * 256);
        f32x4 yd[2], yo[2];
#pragma unroll
        for (int i = 0; i < 2; ++i) { yd[i] = (f32x4){0.f, 0.f, 0.f, 0.f}; yo[i] = (f32x4){0.f, 0.f, 0.f, 0.f}; }
        const float acs_l = acsl[l0 + fr]; const int lcol = l0 + fr;
#pragma unroll
        for (int sb = 0; sb < 2; ++sb) if (2 * sb <= lt) {
            constexpr int dummy = 0; (void)dummy;
            const int s0 = 32 * sb; const bool two = (2 * sb + 1) <= lt;
            s16x4 lo[2], hi[2];
            if (sb == 0) { lo[0] = tr_read_o<S2_X>(xa4); lo[1] = tr_read_o<S2_X + 32>(xa4); hi[0] = tr_read_o<S2_X + 16 * XROW>(xa4); hi[1] = tr_read_o<S2_X + 16 * XROW + 32>(xa4); }
            else         { lo[0] = tr_read_o<S2_X + 32 * XROW>(xa4); lo[1] = tr_read_o<S2_X + 32 * XROW + 32>(xa4); hi[0] = tr_read_o<S2_X + 48 * XROW>(xa4); hi[1] = tr_read_o<S2_X + 48 * XROW + 32>(xa4); }
            f32x4 a0 = {0.f, 0.f, 0.f, 0.f}, a1 = {0.f, 0.f, 0.f, 0.f};
#pragma unroll
            for (int ks = 0; ks < 4; ++ks) { const bf16x8 bf = *(const LAS bf16x8*)(cbp[ks] + S2_B + s0 * 256); a0 = __builtin_amdgcn_mfma_f32_16x16x32_bf16(bf, cf[ks], a0, 0, 0, 0); }
            if (two) {
#pragma unroll
                for (int ks = 0; ks < 4; ++ks) { const bf16x8 bf = *(const LAS bf16x8*)(cbp[ks] + S2_B + (s0 + 16) * 256); a1 = __builtin_amdgcn_mfma_f32_16x16x32_bf16(bf, cf[ks], a1, 0, 0, 0); }
            }
            const f32x4 as0 = *(const LAS f32x4*)(acsl + s0 + 4 * fq), as1 = *(const LAS f32x4*)(acsl + s0 + 16 + 4 * fq);
            const f32x4 dq0 = *(const LAS f32x4*)(dtl + s0 + 4 * fq), dq1 = *(const LAS f32x4*)(dtl + s0 + 16 + 4 * fq);
            float g0[4], g1[4];
#pragma unroll
            for (int i = 0; i < 4; ++i) { g0[i] = a0[i] * __expf(acs_l - as0[i]) * dq0[i]; g1[i] = a1[i] * __expf(acs_l - as1[i]) * dq1[i]; }
            if (2 * sb == lt) {
#pragma unroll
                for (int i = 0; i < 4; ++i) { if (s0 + 4 * fq + i > lcol) g0[i] = 0.f; }
            }
            if (!two) {
#pragma unroll
                for (int i = 0; i < 4; ++i) g1[i] = 0.f;
            } else if (2 * sb + 1 == lt) {
#pragma unroll
                for (int i = 0; i < 4; ++i) { if (s0 + 16 + 4 * fq + i > lcol) g1[i] = 0.f; }
            }
            u32x4 ap; ap.x = cvt_pk_bf16(g0[0], g0[1]); ap.y = cvt_pk_bf16(g0[2], g0[3]); ap.z = cvt_pk_bf16(g1[0], g1[1]); ap.w = cvt_pk_bf16(g1[2], g1[3]);
            const bf16x8 af = __builtin_bit_cast(bf16x8, ap);
            MX_LGKM0();
#pragma unroll
            for (int vi = 0; vi < 2; ++vi) yd[vi] = __builtin_amdgcn_mfma_f32_16x16x32_bf16(af, cat8(lo[vi], hi[vi]), yd[vi], 0, 0, 0);
        }
#pragma unroll
        for (int vi = 0; vi < 2; ++vi)
#pragma unroll
            for (int ks = 0; ks < 4; ++ks) { const bf16x8 pf = *(const LAS bf16x8*)(pvp[ks] + vi * 4096); yo[vi] = __builtin_amdgcn_mfma_f32_16x16x32_bf16(cf[ks], pf, yo[vi], 0, 0, 0); }
        {
            const f32x4 al = *(const LAS f32x4*)(acsl + l0 + 4 * fq);
            float ea[4];
#pragma unroll
            for (int i = 0; i < 4; ++i) ea[i] = __expf(al[i]);
            const unsigned xl = xa4 + (unsigned)(l0 * XROW);
            s16x4 xs[2]; xs[0] = tr_read_o<S2_X>(xl); xs[1] = tr_read_o<S2_X + 32>(xl);
            MX_LGKM0();
            bf16_t* yp = MIX + (seq0 + (size_t)c * 64 + l0 + 4 * fq) * 2048 + h * 64 + pt0 * 16 + fr;
#pragma unroll
            for (int vi = 0; vi < 2; ++vi)
#pragma unroll
                for (int i = 0; i < 4; ++i) { const float y = yd[vi][i] + ea[i] * yo[vi][i] + dsk * bf2f((unsigned short)xs[vi][i]);
                    yp[(size_t)i * 2048 + vi * 16] = (bf16_t)(cvt_pk_bf16(y, 0.f) & 0xffffu); }
        }
        {
            const float cd = __expf(acsl[63]);
#pragma unroll
            for (int pt = 0; pt < 4; ++pt) st[pt] = st[pt] * cd;
            {   s16x4 lo[4], hi[4];
                const s16x4 alo = tr_read_o<S2_B>(ba1), ahi = tr_read_o<S2_B>(ba2);
                lo[0] = tr_read_o<S2_XW>(xa8); lo[1] = tr_read_o<S2_XW + 32>(xa8); lo[2] = tr_read_o<S2_XW + 64>(xa8); lo[3] = tr_read_o<S2_XW + 96>(xa8);
                hi[0] = tr_read_o<S2_XW + 4 * XROW>(xa8); hi[1] = tr_read_o<S2_XW + 4 * XROW + 32>(xa8); hi[2] = tr_read_o<S2_XW + 4 * XROW + 64>(xa8); hi[3] = tr_read_o<S2_XW + 4 * XROW + 96>(xa8);
                MX_LGKM0();
                const bf16x8 af = cat8(alo, ahi);
#pragma unroll
                for (int pt = 0; pt < 4; ++pt) st[pt] = __builtin_amdgcn_mfma_f32_16x16x32_bf16(af, cat8(lo[pt], hi[pt]), st[pt], 0, 0, 0); }
            {   s16x4 lo[4], hi[4];
                const s16x4 alo = tr_read_o<S2_B + 32 * 256>(ba1), ahi = tr_read_o<S2_B + 32 * 256>(ba2);
                lo[0] = tr_read_o<S2_XW + 32 * XROW>(xa8); lo[1] = tr_read_o<S2_XW + 32 * XROW + 32>(xa8); lo[2] = tr_read_o<S2_XW + 32 * XROW + 64>(xa8); lo[3] = tr_read_o<S2_XW + 32 * XROW + 96>(xa8);
                hi[0] = tr_read_o<S2_XW + 36 * XROW>(xa8); hi[1] = tr_read_o<S2_XW + 36 * XROW + 32>(xa8); hi[2] = tr_read_o<S2_XW + 36 * XROW + 64>(xa8); hi[3] = tr_read_o<S2_XW + 36 * XROW + 96>(xa8);
                MX_LGKM0();
                const bf16x8 af = cat8(alo, ahi);
#pragma unroll
                for (int pt = 0; pt < 4; ++pt) st[pt] = __builtin_amdgcn_mfma_f32_16x16x32_bf16(af, cat8(lo[pt], hi[pt]), st[pt], 0, 0, 0); }
        }
        if (c + 1 < 32) S2_WRITE(pb ^ 1);
        MX_BAR_L();
    }
    asm volatile("s_waitcnt vmcnt(0)" ::: "memory");
#undef S2_LOAD
#undef S2_WRITE
}

constexpr int G_QD = 0, G_KI = 16384, G_V = 32768, G_DEC = G_V + 64 * XROW, G_BUF = 45056, G_SP = 2 * G_BUF, G_END = G_SP + 2 * 16384;
static_assert(G_DEC + 512 <= G_BUF && G_END <= RING_BYTES, "GLA LDS");
template <bool CHECK> __device__ __forceinline__ void gla_unit(LAS char* shm, int b, int h, int vs, const bf16_t* PROJ, const bf16_t* QD, const bf16_t* KI, const float* DEC, bf16_t* MIX, unsigned* mismatch) {
    const int tid = threadIdx.x, lane = tid & 63, fr = lane & 15, fq = lane >> 4; const int w = __builtin_amdgcn_readfirstlane(tid >> 6);
    const int row = tid >> 3, ec = tid & 7, lt = w >> 1, l0 = 16 * lt, vt0 = 2 * (w & 1);
    const unsigned lds0 = (unsigned)(uintptr_t)shm;
    f32x4 st[4];
#pragma unroll
    for (int i = 0; i < 4; ++i) st[i] = (f32x4){0.f, 0.f, 0.f, 0.f};
    u32x4 rq[2], rk[2], rv; float rdec = 0.f;
    const size_t seq0 = (size_t)b * SEQ;
#define GLA_LOAD(c) do { const size_t gr = seq0 + (size_t)(c) * 64 + row; const size_t o = gr * 512 + h * 128 + ec * 16; \
        _Pragma("unroll") for (int i = 0; i < 2; ++i) { rq[i] = *(const u32x4*)(QD + o + 8 * i); rk[i] = *(const u32x4*)(KI + o + 8 * i); } \
        rv = *(const u32x4*)(PROJ + gr * NO_IN + 3584 + h * 256 + vs * 64 + ec * 8); \
        if (tid < 128) rdec = DEC[((size_t)b * 32 + (c)) * 512 + h * 128 + tid]; } while (0)
#define GLA_WRITE(pb) do { LAS char* gb_ = shm + (pb) * G_BUF; \
        _Pragma("unroll") for (int i = 0; i < 2; ++i) { *(LAS u32x4*)(gb_ + G_QD + sw256(row, ec * 2 + i)) = rq[i]; *(LAS u32x4*)(gb_ + G_KI + sw256(row, ec * 2 + i)) = rk[i]; } \
        *(LAS u32x4*)(gb_ + G_V + row * XROW + ec * 16) = rv; \
        if (tid < 128) ((LAS float*)(gb_ + G_DEC))[tid] = rdec; \
        _Pragma("unroll") for (int vt = 0; vt < 4; ++vt) { u32x2 v; v.x = cvt_pk_bf16(st[vt][0], st[vt][1]); v.y = cvt_pk_bf16(st[vt][2], st[vt][3]); \
            const int vv = 16 * vt + fr; *(LAS u32x2*)(shm + G_SP + (pb) * 16384 + sw256(vv, 2 * w + (fq >> 1)) + (fq & 1) * 8) = v; } } while (0)
    GLA_LOAD(0);
    GLA_WRITE(0);
    MX_BAR_L();
    const unsigned xtr = lds0 + (unsigned)(((lane & 15) >> 2) * XROW + (lane & 3) * 8);
    for (int c = 0; c < 32; ++c) {
        const int pb = c & 1; LAS char* gb = shm + pb * G_BUF; const unsigned gbo = (unsigned)(pb * G_BUF); LAS char* sp = shm + G_SP + pb * 16384;
        if (c + 1 < 32) GLA_LOAD(c + 1);
        bf16x8 qf[4];
#pragma unroll
        for (int ks = 0; ks < 4; ++ks) qf[ks] = *(const LAS bf16x8*)(gb + G_QD + sw256(l0 + fr, 4 * ks + fq));
        f32x4 o[2]; o[0] = (f32x4){0.f, 0.f, 0.f, 0.f}; o[1] = (f32x4){0.f, 0.f, 0.f, 0.f};
        const int lcol = l0 + fr; const int nsb = (lt >> 1) + 1;
        for (int sb = 0; sb < nsb; ++sb) {
            const int s0 = 32 * sb; const bool two = (2 * sb + 1) <= lt;
            f32x4 a0 = {0.f, 0.f, 0.f, 0.f}, a1 = {0.f, 0.f, 0.f, 0.f};
#pragma unroll
            for (int ks = 0; ks < 4; ++ks) { const bf16x8 kf = *(const LAS bf16x8*)(gb + G_KI + sw256(s0 + fr, 4 * ks + fq)); a0 = __builtin_amdgcn_mfma_f32_16x16x32_bf16(kf, qf[ks], a0, 0, 0, 0); }
            if (two) {
#pragma unroll
                for (int ks = 0; ks < 4; ++ks) { const bf16x8 kf = *(const LAS bf16x8*)(gb + G_KI + sw256(s0 + 16 + fr, 4 * ks + fq)); a1 = __builtin_amdgcn_mfma_f32_16x16x32_bf16(kf, qf[ks], a1, 0, 0, 0); }
            }
            float g0[4], g1[4];
#pragma unroll
            for (int i = 0; i < 4; ++i) { const int sa = s0 + 4 * fq + i; g0[i] = (sa <= lcol) ? a0[i] : 0.f; g1[i] = (two && sa + 16 <= lcol) ? a1[i] : 0.f; }
            u32x4 ap; ap.x = cvt_pk_bf16(g0[0], g0[1]); ap.y = cvt_pk_bf16(g0[2], g0[3]); ap.z = cvt_pk_bf16(g1[0], g1[1]); ap.w = cvt_pk_bf16(g1[2], g1[3]);
            const bf16x8 af = __builtin_bit_cast(bf16x8, ap);
            s16x4 lo[2], hi[2];
#pragma unroll
            for (int vi = 0; vi < 2; ++vi) { lo[vi] = tr_read(xtr + gbo + G_V + (unsigned)((s0 + 4 * fq) * XROW + (vt0 + vi) * 32)); hi[vi] = tr_read(xtr + gbo + G_V + (unsigned)((s0 + 16 + 4 * fq) * XROW + (vt0 + vi) * 32)); }
            MX_LGKM0();
#pragma unroll
            for (int vi = 0; vi < 2; ++vi) o[vi] = __builtin_amdgcn_mfma_f32_16x16x32_bf16(af, cat8(lo[vi], hi[vi]), o[vi], 0, 0, 0);
        }
#pragma unroll
        for (int vi = 0; vi < 2; ++vi)
#pragma unroll
            for (int ks = 0; ks < 4; ++ks) { const bf16x8 sf = *(const LAS bf16x8*)(sp + sw256(16 * (vt0 + vi) + fr, 4 * ks + fq)); o[vi] = __builtin_amdgcn_mfma_f32_16x16x32_bf16(qf[ks], sf, o[vi], 0, 0, 0); }
        {
            bf16_t* op = MIX + (seq0 + (size_t)c * 64 + l0 + 4 * fq) * 2048 + 1024 + h * 256 + vs * 64 + vt0 * 16 + fr;
#pragma unroll
            for (int vi = 0; vi < 2; ++vi)
#pragma unroll
                for (int i = 0; i < 4; ++i) { const bf16_t val = (bf16_t)(cvt_pk_bf16(o[vi][i], 0.f) & 0xffffu);
                    if (CHECK) { if (op[(size_t)i * 2048 + vi * 16] != val) atomicAdd(mismatch, 1u); } else op[(size_t)i * 2048 + vi * 16] = val; }
        }
        {
#pragma unroll
            for (int ks = 0; ks < 2; ++ks) {
                const int s0 = 32 * ks, q = (lane & 15) >> 2, p = lane & 3;
                const int r1 = s0 + 8 * fq + q, r2 = r1 + 4;
                const s16x4 alo = tr_read(lds0 + gbo + G_KI + sw256(r1, 2 * w + (p >> 1)) + (p & 1) * 8), ahi = tr_read(lds0 + gbo + G_KI + sw256(r2, 2 * w + (p >> 1)) + (p & 1) * 8);
                s16x4 lo[4], hi[4];
#pragma unroll
                for (int vt = 0; vt < 4; ++vt) { lo[vt] = tr_read(xtr + gbo + G_V + (unsigned)((s0 + 8 * fq) * XROW + vt * 32)); hi[vt] = tr_read(xtr + gbo + G_V + (unsigned)((s0 + 8 * fq + 4) * XROW + vt * 32)); }
                MX_LGKM0();
                const bf16x8 af = cat8(alo, ahi);
#pragma unroll
                for (int vt = 0; vt < 4; ++vt) st[vt] = __builtin_amdgcn_mfma_f32_16x16x32_bf16(af, cat8(lo[vt], hi[vt]), st[vt], 0, 0, 0);
            }
            const f32x4 d4 = *(const LAS f32x4*)((LAS float*)(gb + G_DEC) + 16 * w + 4 * fq);
#pragma unroll
            for (int vt = 0; vt < 4; ++vt) st[vt] = st[vt] * d4;
        }
        if (c + 1 < 32) GLA_WRITE(pb ^ 1);
        MX_BAR_L();
    }
    asm volatile("s_waitcnt vmcnt(0)" ::: "memory");
#undef GLA_LOAD
#undef GLA_WRITE
}

__device__ __forceinline__ void finalize_phase(bf16_t* MIX, const bf16_t* PROJ, const float* ssd_norm, const float* gla_norm, int gw, int ngw, int lane) {
    for (int m = gw; m < T; m += ngw) {
        bf16_t* mr = MIX + (size_t)m * 2048; const bf16_t* pr = PROJ + (size_t)m * NO_IN;
        float y[2][8]; float s = 0.f;
#pragma unroll
        for (int j = 0; j < 2; ++j) { const int col = 512 * j + 8 * lane; const u32x4 a = *(const u32x4*)(mr + col), z = *(const u32x4*)(pr + col);
#pragma unroll
            for (int i = 0; i < 4; ++i) { const float y0 = __uint_as_float(a[i] << 16), y1 = __uint_as_float(a[i] & 0xffff0000u), z0 = __uint_as_float(z[i] << 16), z1 = __uint_as_float(z[i] & 0xffff0000u);
                y[j][2 * i] = y0 * siluf(z0); y[j][2 * i + 1] = y1 * siluf(z1); s += y[j][2 * i] * y[j][2 * i] + y[j][2 * i + 1] * y[j][2 * i + 1]; } }
        const float rs = rsqrtf(wave_sum(s) * (1.f / 1024.f) + EPS);
#pragma unroll
        for (int j = 0; j < 2; ++j) { const int col = 512 * j + 8 * lane; const f32x4 w0 = *(const f32x4*)(ssd_norm + col), w1 = *(const f32x4*)(ssd_norm + col + 4);
            u32x4 o; o.x = cvt_pk_bf16(y[j][0] * rs * w0[0], y[j][1] * rs * w0[1]); o.y = cvt_pk_bf16(y[j][2] * rs * w0[2], y[j][3] * rs * w0[3]);
            o.z = cvt_pk_bf16(y[j][4] * rs * w1[0], y[j][5] * rs * w1[1]); o.w = cvt_pk_bf16(y[j][6] * rs * w1[2], y[j][7] * rs * w1[3]);
            *(u32x4*)(mr + col) = o; }
#pragma unroll
        for (int j = 0; j < 2; ++j) { const int cc = 512 * j + 8 * lane; const u32x4 a = *(const u32x4*)(mr + 1024 + cc), r = *(const u32x4*)(pr + 4608 + cc);
            float o[8]; float s2 = 0.f;
#pragma unroll
            for (int i = 0; i < 4; ++i) { o[2 * i] = __uint_as_float(a[i] << 16); o[2 * i + 1] = __uint_as_float(a[i] & 0xffff0000u); s2 += o[2 * i] * o[2 * i] + o[2 * i + 1] * o[2 * i + 1]; }
#pragma unroll
            for (int of = 1; of < 32; of <<= 1) s2 += __shfl_xor(s2, of);
            const float r2 = rsqrtf(s2 * (1.f / 256.f) + EPS); const int v0 = 8 * (lane & 31);
            const f32x4 w0 = *(const f32x4*)(gla_norm + v0), w1 = *(const f32x4*)(gla_norm + v0 + 4);
            float f[8];
#pragma unroll
            for (int i = 0; i < 4; ++i) { f[2 * i] = siluf(__uint_as_float(r[i] << 16)); f[2 * i + 1] = siluf(__uint_as_float(r[i] & 0xffff0000u)); }
            u32x4 ov; ov.x = cvt_pk_bf16(o[0] * r2 * w0[0] * f[0], o[1] * r2 * w0[1] * f[1]); ov.y = cvt_pk_bf16(o[2] * r2 * w0[2] * f[2], o[3] * r2 * w0[3] * f[3]);
            ov.z = cvt_pk_bf16(o[4] * r2 * w1[0] * f[4], o[5] * r2 * w1[1] * f[5]); ov.w = cvt_pk_bf16(o[6] * r2 * w1[2] * f[6], o[7] * r2 * w1[3] * f[7]);
            *(u32x4*)(mr + 1024 + cc) = ov; }
    }
}
#undef MX_LGKM0
#undef MX_BAR
#undef MX_BAR_L
}
namespace mk {
__device__ __forceinline__ void tp_norm_rows(const float* src, const float* g, bf16_t* xn, int gw, int ngw, int lane) {
    f32x4 gg[4];
#pragma unroll
    for (int j = 0; j < 4; ++j) gg[j] = ((const f32x4*)g)[lane + 64 * j];
    for (int m = gw; m < T; m += ngw) {
        const f32x4* p = (const f32x4*)(src + (size_t)m * DM); f32x4 v[4]; float s = 0.f;
#pragma unroll
        for (int j = 0; j < 4; ++j) { v[j] = p[lane + 64 * j]; s += (v[j][0] * v[j][0] + v[j][1] * v[j][1]) + (v[j][2] * v[j][2] + v[j][3] * v[j][3]); }
        const float r = rsqrtf(wave_sum(s) * (1.f / DM) + EPS);
        u32x2* o = (u32x2*)(xn + (size_t)m * DM);
#pragma unroll
        for (int j = 0; j < 4; ++j) { const f32x4 y = v[j] * r * gg[j]; u32x2 w; w.x = cvt_pk_bf16(y[0], y[1]); w.y = cvt_pk_bf16(y[2], y[3]); o[lane + 64 * j] = w; }
    }
}
template <bool FINAL> __device__ __forceinline__ void tp_combine_norm(bf16_t* hb, const bf16_t* Y, const float* g, bf16_t* xn, float* out, int gw, int ngw, int lane) {
    f32x4 gg[2][2];
#pragma unroll
    for (int j = 0; j < 2; ++j) { gg[j][0] = *(const f32x4*)(g + 512 * j + 8 * lane); gg[j][1] = *(const f32x4*)(g + 512 * j + 8 * lane + 4); }
    for (int m = gw; m < T; m += ngw) {
        float v[2][8]; float s = 0.f;
#pragma unroll
        for (int j = 0; j < 2; ++j) { const size_t o = (size_t)m * DM + 512 * j + 8 * lane;
            const u32x4 a = *(const u32x4*)(hb + o), y0 = *(const u32x4*)(Y + o), y1 = *(const u32x4*)(Y + (size_t)T * DM + o);
#pragma unroll
            for (int i = 0; i < 4; ++i) { v[j][2 * i] = __uint_as_float(a[i] << 16) + __uint_as_float(y0[i] << 16) + __uint_as_float(y1[i] << 16);
                v[j][2 * i + 1] = __uint_as_float(a[i] & 0xffff0000u) + __uint_as_float(y0[i] & 0xffff0000u) + __uint_as_float(y1[i] & 0xffff0000u);
                s += v[j][2 * i] * v[j][2 * i] + v[j][2 * i + 1] * v[j][2 * i + 1]; } }
        const float r = rsqrtf(wave_sum(s) * (1.f / DM) + EPS);
#pragma unroll
        for (int j = 0; j < 2; ++j) { const size_t o = (size_t)m * DM + 512 * j + 8 * lane;
            if (FINAL) { f32x4 o0, o1;
#pragma unroll
                for (int i = 0; i < 4; ++i) { o0[i] = v[j][i] * r * gg[j][0][i]; o1[i] = v[j][4 + i] * r * gg[j][1][i]; }
                *(f32x4*)(out + o) = o0; *(f32x4*)(out + o + 4) = o1;
            } else { u32x4 hw, xw;
#pragma unroll
                for (int i = 0; i < 4; ++i) { hw[i] = cvt_pk_bf16(v[j][2 * i], v[j][2 * i + 1]);
                    xw[i] = cvt_pk_bf16(v[j][2 * i] * r * gg[j][i >> 1][(2 * i) & 3], v[j][2 * i + 1] * r * gg[j][i >> 1][(2 * i + 1) & 3]); }
                *(u32x4*)(hb + o) = hw; *(u32x4*)(xn + o) = xw; }
        }
    }
}
template <bool DRY> __device__ __forceinline__ void tp_route_mfma(const bf16_t* hb, const float* g, bf16_t* xn, const bf16_t* whi, const bf16_t* wlo, const float* bg, const float* br,
                                                                  unsigned* counts, int* lists, float* gates, LAS char* shm, int vcu, int G, int lane, int wave) {
    const int grp = wave >> 2, wq = wave & 3, fr = lane & 15, fq = lane >> 4;
    LAS u32x4* stage = (LAS u32x4*)(shm + wave * 8192);
    LAS float* xacc = (LAS float*)(shm + 65536 + grp * 12288);
    LAS float* ltile = (LAS float*)(shm + 90112 + grp * 4096);
    LAS float* rsl = (LAS float*)(shm + 98304 + grp * 64);
    for (int blk = vcu; blk < T / 32; blk += G) {
        const int r0 = blk * 32 + grp * 16; const int kbase = wq * 256;
        const bf16_t* hp = hb + (size_t)(r0 + fr) * DM + kbase + 8 * fq; const float* gp = g + kbase + 8 * fq;
        f32x4 acc[3]; acc[0] = (f32x4){0.f, 0.f, 0.f, 0.f}; acc[1] = acc[0]; acc[2] = acc[0];
        float ss = 0.f;
#pragma unroll 4
        for (int ks = 0; ks < 8; ++ks) {
            const u32x4 hv = *(const u32x4*)(hp + 32 * ks);
            const f32x4 g0 = *(const f32x4*)(gp + 32 * ks), g1 = *(const f32x4*)(gp + 32 * ks + 4);
            f32x4 x0, x1;
            x0[0] = __uint_as_float(hv.x << 16); x0[1] = __uint_as_float(hv.x & 0xffff0000u); x0[2] = __uint_as_float(hv.y << 16); x0[3] = __uint_as_float(hv.y & 0xffff0000u);
            x1[0] = __uint_as_float(hv.z << 16); x1[1] = __uint_as_float(hv.z & 0xffff0000u); x1[2] = __uint_as_float(hv.w << 16); x1[3] = __uint_as_float(hv.w & 0xffff0000u);
            ss += (x0[0] * x0[0] + x0[1] * x0[1]) + (x0[2] * x0[2] + x0[3] * x0[3]) + (x1[0] * x1[0] + x1[1] * x1[1]) + (x1[2] * x1[2] + x1[3] * x1[3]);
            const f32x4 y0 = x0 * g0, y1 = x1 * g1;
            u32x4 hi; hi.x = cvt_pk_bf16(y0[0], y0[1]); hi.y = cvt_pk_bf16(y0[2], y0[3]); hi.z = cvt_pk_bf16(y1[0], y1[1]); hi.w = cvt_pk_bf16(y1[2], y1[3]);
            stage[ks * 64 + lane] = hi;
            u32x4 lo;
            lo.x = cvt_pk_bf16(y0[0] - __uint_as_float(hi.x << 16), y0[1] - __uint_as_float(hi.x & 0xffff0000u)); lo.y = cvt_pk_bf16(y0[2] - __uint_as_float(hi.y << 16), y0[3] - __uint_as_float(hi.y & 0xffff0000u));
            lo.z = cvt_pk_bf16(y1[0] - __uint_as_float(hi.z << 16), y1[1] - __uint_as_float(hi.z & 0xffff0000u)); lo.w = cvt_pk_bf16(y1[2] - __uint_as_float(hi.w << 16), y1[3] - __uint_as_float(hi.w & 0xffff0000u));
            const bf16x8 ah = __builtin_bit_cast(bf16x8, hi), al = __builtin_bit_cast(bf16x8, lo);
#pragma unroll
            for (int nt = 0; nt < 3; ++nt) {
                const size_t wo = (size_t)(nt * 16 + fr) * DM + kbase + 32 * ks + 8 * fq;
                const bf16x8 bh = *(const bf16x8*)(whi + wo), bl = *(const bf16x8*)(wlo + wo);
                acc[nt] = __builtin_amdgcn_mfma_f32_16x16x32_bf16(ah, bh, acc[nt], 0, 0, 0);
                acc[nt] = __builtin_amdgcn_mfma_f32_16x16x32_bf16(ah, bl, acc[nt], 0, 0, 0);
                acc[nt] = __builtin_amdgcn_mfma_f32_16x16x32_bf16(al, bh, acc[nt], 0, 0, 0);
            }
        }
        ss += __shfl_xor(ss, 16); ss += __shfl_xor(ss, 32);
        if (wq != 0) { LAS float* xa = xacc + (wq - 1) * 13 * 64;
#pragma unroll
            for (int nt = 0; nt < 3; ++nt)
#pragma unroll
                for (int i = 0; i < 4; ++i) xa[(nt * 4 + i) * 64 + lane] = acc[nt][i];
            xa[12 * 64 + lane] = ss;
        }
        asm volatile("s_waitcnt lgkmcnt(0)\n\ts_barrier" ::: "memory");
        if (wq == 0) {
#pragma unroll
            for (int nt = 0; nt < 3; ++nt)
#pragma unroll
                for (int i = 0; i < 4; ++i) { const int o = (nt * 4 + i) * 64 + lane; const float v = acc[nt][i] + xacc[o] + xacc[13 * 64 + o] + xacc[26 * 64 + o]; ltile[(4 * fq + i) * 48 + nt * 16 + fr] = v; }
            ss += xacc[12 * 64 + lane] + xacc[25 * 64 + lane] + xacc[38 * 64 + lane];
            const float rs = rsqrtf(ss * (1.f / DM) + EPS);
            if (fq == 0) rsl[fr] = rs;
        }
        asm volatile("s_waitcnt lgkmcnt(0)\n\ts_barrier" ::: "memory");
        { const float rs = rsl[fr]; bf16_t* xp = xn + (size_t)(r0 + fr) * DM + kbase + 8 * fq;
#pragma unroll
          for (int ks = 0; ks < 8; ++ks) { const u32x4 v = stage[ks * 64 + lane]; u32x4 o;
              o.x = cvt_pk_bf16(__uint_as_float(v.x << 16) * rs, __uint_as_float(v.x & 0xffff0000u) * rs); o.y = cvt_pk_bf16(__uint_as_float(v.y << 16) * rs, __uint_as_float(v.y & 0xffff0000u) * rs);
              o.z = cvt_pk_bf16(__uint_as_float(v.z << 16) * rs, __uint_as_float(v.z & 0xffff0000u) * rs); o.w = cvt_pk_bf16(__uint_as_float(v.w << 16) * rs, __uint_as_float(v.w & 0xffff0000u) * rs);
              *(u32x4*)(xp + 32 * ks) = o; } }
        if (wq == 0 && lane < 16) {
            const LAS float* lt = ltile + lane * 48; const float rsr = rsl[lane];
            float gl[4];
#pragma unroll
            for (int e = 0; e < 4; ++e) gl[e] = rsr * lt[e] + bg[e];
            int gi = 0; float gm = gl[0];
#pragma unroll
            for (int e = 1; e < 4; ++e) if (gl[e] > gm) { gm = gl[e]; gi = e; }
            float gs = 0.f;
#pragma unroll
            for (int e = 0; e < 4; ++e) gs += expf(gl[e] - gm);
            const float gwt = 1.f / gs;
            float b0 = -INFINITY, b1 = -INFINITY; int i0 = 0, i1 = 0;
#pragma unroll
            for (int i = 0; i < 8; ++i) { const float v = rsr * lt[4 + gi * 8 + i] + br[gi * 8 + i];
                if (v > b0) { b1 = b0; i1 = i0; b0 = v; i0 = i; } else if (v > b1) { b1 = v; i1 = i; } }
            const int t = r0 + lane;
            const float w0 = 1.f / (1.f + expf(b1 - b0)), w1 = 1.f - w0;
            const int e0 = gi * 8 + i0, e1 = gi * 8 + i1;
            gates[2 * t] = gwt * w0; gates[2 * t + 1] = gwt * w1;
            if (!DRY) {
                const unsigned p0 = __hip_atomic_fetch_add(counts + e0 * 64, 1u, __ATOMIC_RELAXED, __HIP_MEMORY_SCOPE_AGENT); lists[e0 * CAP + p0] = 2 * t;
                const unsigned p1 = __hip_atomic_fetch_add(counts + e1 * 64, 1u, __ATOMIC_RELAXED, __HIP_MEMORY_SCOPE_AGENT); lists[e1 * CAP + p1] = 2 * t + 1; }
        }
        asm volatile("s_waitcnt lgkmcnt(0)\n\ts_barrier" ::: "memory");
    }
}

struct Args {
    const float* in[26]; float* out; unsigned char* ws; int ph_lo, ph_hi, use_bar, li;
};
enum Phase { P_CONV0 = 0, P_G1, P_ATT, P_G2, P_TP1, P_G3, P_G4, P_TP2, P_G5, P_CONV, P_MIXER, P_FIN, P_G6, P_TP3, P_G7, P_G8, P_TP4, P_COUNT };

__device__ __forceinline__ void moe_setup(volatile LAS int* misc, unsigned* counts) {
    if (threadIdx.x == 0) {
        int run = 0;
        for (int e = 0; e < 32; ++e) { const int c = (int)__hip_atomic_load(counts + e * 64, __ATOMIC_RELAXED, __HIP_MEMORY_SCOPE_AGENT); misc[64 + e] = c; misc[16 + e] = run; run += (c + 255) >> 8; }
        misc[16 + 32] = run;
    }
    __syncthreads();
}

#ifndef CV_TAIL_ITEMS
#define CV_TAIL_ITEMS 8192
#endif
constexpr int CV_I_EIN = 16 * 80, CV_I_EOUT = 16 * 32, CV_I_OIN = 16 * 184, CV_I_OOUT = 32 * 32, CV_I_GU = 16 * 32, CV_I_D = 8 * 32;
constexpr int CV_NITEMS = CV_I_EIN + CV_I_EOUT + CV_I_OIN + CV_I_OOUT + 32 * CV_I_GU + 32 * CV_I_D;
__device__ __forceinline__ CvItem cv_decode0(const float* const* in, unsigned char* ws, int it, int lane) {
    int r = it;
    if (r < CV_I_EIN) return cv_make(SrcEvenIn{in[4]}, 2312, 1024, 80, (bf16_t*)(ws + WS_WEIN), r, lane); r -= CV_I_EIN;
    if (r < CV_I_EOUT) return cv_make(SrcPlain{in[7], 1024}, 1024, 1024, 32, (bf16_t*)(ws + WS_WEOUT), r, lane); r -= CV_I_EOUT;
    if (r < CV_I_OIN) return cv_make(SrcOddIn{in[8]}, 5664, 1024, 184, (bf16_t*)(ws + WS_WOIN), r, lane); r -= CV_I_OIN;
    if (r < CV_I_OOUT) return cv_make(SrcPlain{in[18], 1024}, 1024, 2048, 32, (bf16_t*)(ws + WS_WOOUT), r, lane); r -= CV_I_OOUT;
    if (r < 32 * CV_I_GU) { const int e = r / CV_I_GU; return cv_make_gu(in[23] + (size_t)e * 1024 * 512, in[24] + (size_t)e * 1024 * 512, (bf16_t*)(ws + WS_WGU) + (size_t)e * 1024 * 1024, r % CV_I_GU, lane); } r -= 32 * CV_I_GU;
    { const int e = r / CV_I_D; return cv_make(SrcPlain{in[25] + (size_t)e * 512 * 1024, 1024}, 1024, 512, 32, (bf16_t*)(ws + WS_WD) + (size_t)e * 1024 * 512, r % CV_I_D, lane); }
}
__device__ __forceinline__ void cv_run0(const float* const* in, unsigned char* ws, int lo, int hi, int w, int nw, LAS float* scr, int lane) {
    for (int it = lo + 2 * w; it < hi; it += 2 * nw) {
        float va[32], vb[32]; const CvItem da = cv_decode0(in, ws, it, lane); cv_load(da, va);
        const bool n1 = it + 1 < hi; CvItem db = da; if (n1) { db = cv_decode0(in, ws, it + 1, lane); cv_load(db, vb); }
        cv_finish(da, va, scr, lane);
        if (n1) cv_finish(db, vb, scr, lane);
    }
}

constexpr int CV_NIT1 = 32 * (CV_I_GU + CV_I_D);
#ifndef CV1_TAIL_G5
#define CV1_TAIL_G5 4096
#endif
#ifndef CV1_TAIL_MIX
#define CV1_TAIL_MIX 8192
#endif
#ifndef CV0_TAIL_G3
#define CV0_TAIL_G3 0
#endif
__device__ __forceinline__ CvItem cv_decode1(const float* const* in, unsigned char* ws, int it, int lane) {
    const size_t L1 = (size_t)32 * 1024 * 512; int r = it;
    if (r < 32 * CV_I_GU) { const int e = r / CV_I_GU; return cv_make_gu(in[23] + L1 + (size_t)e * 1024 * 512, in[24] + L1 + (size_t)e * 1024 * 512, (bf16_t*)(ws + WS_WGU) + (size_t)e * 1024 * 1024, r % CV_I_GU, lane); } r -= 32 * CV_I_GU;
    { const int e = r / CV_I_D; return cv_make(SrcPlain{in[25] + L1 + (size_t)e * 512 * 1024, 1024}, 1024, 512, 32, (bf16_t*)(ws + WS_WD) + (size_t)e * 1024 * 512, r % CV_I_D, lane); }
}
__device__ __forceinline__ void cv_run1(const float* const* in, unsigned char* ws, int lo, int hi, int w, int nw, LAS float* scr, int lane) {
    for (int it = lo + 2 * w; it < hi; it += 2 * nw) {
        float va[32], vb[32]; const CvItem da = cv_decode1(in, ws, it, lane); cv_load(da, va);
        const bool n1 = it + 1 < hi; CvItem db = da; if (n1) { db = cv_decode1(in, ws, it + 1, lane); cv_load(db, vb); }
        cv_finish(da, va, scr, lane);
        if (n1) cv_finish(db, vb, scr, lane);
    }
}

__global__ void __launch_bounds__(NTHR, 2) mk_fwd(Args args) {
    extern __shared__ __attribute__((aligned(16))) unsigned char lds_raw[];
    LAS unsigned char* lds = (LAS unsigned char*)lds_raw;
    volatile LAS int* misc = (volatile LAS int*)(lds + MISC_OFF);
    const int tid = threadIdx.x, lane = tid & 63, wave = __builtin_amdgcn_readfirstlane(tid >> 6);
    const int G = gridDim.x, bx = blockIdx.x;
    const int vcu = (G % 8 == 0) ? (bx % 8) * (G / 8) + bx / 8 : bx;
    const int gw = vcu * NWAVES + wave, ngw = G * NWAVES;
    unsigned char* ws = args.ws;
    unsigned* ctl = (unsigned*)(ws + WS_CTL);
    for (int u = tid; u < 256; u += NTHR) misc[u] = 0;
    __syncthreads();
    XcdBarrier bar; bar.bar = ctl + CW_BAR + args.li * XCD_BAR_WORDS; bar.x = 0; bar.st = nullptr;
    if (args.use_bar) bar = xcd_barrier_post(ctl + CW_BAR + args.li * XCD_BAR_WORDS, (volatile LAS unsigned*)misc);
#ifdef BAR_TWICE
#define GRID_BAR() do { if (args.use_bar) { xcd_barrier(bar); xcd_barrier(bar); } } while (0)
#else
#define GRID_BAR() do { if (args.use_bar) xcd_barrier(bar); } while (0)
#endif
    const int lo = args.ph_lo, hi = args.ph_hi;
#ifndef MK_PHASE_MASK
#define MK_PHASE_MASK 0xffffffffu
#endif
#define IN(k) (((MK_PHASE_MASK >> (k)) & 1u) && lo <= (k) && (k) < hi)
#ifndef MK_REP_MASK
#define MK_REP_MASK 0u
#endif
#define NREP(k) ((((MK_REP_MASK) >> (k)) & 1u) ? 2 : 1)
#define REP(k) for (int _r = 0; _r < ((((MK_REP_MASK) >> (k)) & 1u) ? 2 : 1); ++_r)
#define SEAM(k) do { if (IN(k) && IN((k) + 1)) GRID_BAR(); } while (0)
    const float* x = args.in[0];
    bf16_t* XN = (bf16_t*)(ws + WS_XN); bf16_t* PROJ = (bf16_t*)(ws + WS_PROJ); bf16_t* MIX = (bf16_t*)(ws + WS_MIX);
    float* FB = (float*)(ws + WS_FB); int* LISTS = (int*)(ws + WS_LISTS); float* GATES = (float*)(ws + WS_GATES);
    bf16_t* HB = (bf16_t*)(ws + WS_H); bf16_t* YB = (bf16_t*)(ws + WS_Y);
    float* outp = args.out; bf16_t* HBS = (bf16_t*)(ws + WS_HB);

    if (IN(P_CONV0)) REP(P_CONV0) {
        LAS float* scr = (LAS float*)(lds + wave * 16384);
        constexpr int OI_LO = CV_I_EIN + CV_I_EOUT, OI_HI = OI_LO + CV_I_OIN + CV_I_OOUT;
        if (CV0_TAIL_G3 && G == 256) { cv_run0(args.in, ws, 0, OI_LO, gw, ngw, scr, lane); cv_run0(args.in, ws, OI_HI, CV_NITEMS - CV_TAIL_ITEMS, gw, ngw, scr, lane); }
        else cv_run0(args.in, ws, 0, CV_NITEMS - CV_TAIL_ITEMS, gw, ngw, scr, lane);
        { bf16_t* wrt = (bf16_t*)(ws + WS_WRT);
          for (int i = gw * 64 + lane; i < 2 * 48 * 1024; i += ngw * 64) { const int l = i / (48 * 1024), rem = i % (48 * 1024), e = rem >> 10, k = rem & 1023;
              const float v = (e < 4) ? args.in[19][(size_t)l * 4096 + k * 4 + e] : (e < 36 ? args.in[21][(size_t)l * 32768 + k * 32 + (e - 4)] : 0.f);
              const unsigned hi = cvt_pk_bf16(v, 0.f) & 0xffffu; const unsigned lo = cvt_pk_bf16(v - __uint_as_float(hi << 16), 0.f) & 0xffffu;
              wrt[(size_t)(2 * l) * 48 * 1024 + rem] = (bf16_t)hi; wrt[(size_t)(2 * l + 1) * 48 * 1024 + rem] = (bf16_t)lo; } }
        tp_norm_rows(x, args.in[1], XN, gw, ngw, lane);
    }
    SEAM(P_CONV0);
    if (IN(P_G1)) {
        pg8::Gemm g{XN, (const bf16_t*)(ws + WS_WEIN), 1024, 0}; pg8::DenseOrder S; S.init(T, NE_IN, G, bx, NREP(P_G1));
        pg8::EpiProjEven E{PROJ, FB};
        pg8::gemm_phase<pg8::EpiProjEven, pg8::DenseOrder, true>(lds, g, S, E);
        if (CV_TAIL_ITEMS > 0 && G == 256 && bx >= 128)
            cv_run0(args.in, ws, CV_NITEMS - CV_TAIL_ITEMS, CV_NITEMS, (bx - 128) * NWAVES + wave, 128 * NWAVES, (LAS float*)(lds + wave * 16384), lane);
        else if (CV_TAIL_ITEMS > 0 && G != 256) cv_run0(args.in, ws, CV_NITEMS - CV_TAIL_ITEMS, CV_NITEMS, gw, ngw, (LAS float*)(lds + wave * 16384), lane);
    }
    SEAM(P_G1);
    if (IN(P_ATT)) REP(P_ATT) {
        if (G == 256) {
            const int bh = vcu >> 2, s = vcu & 3, b = bh >> 3, h = bh & 7;
            const float fbias = args.in[6][h];
            att::fox_unit_p<false>((char*)lds_raw, (LAS char*)lds, b, h, 7 - s, PROJ, FB, fbias, MIX, ctl + 32, true);
            att::fox_unit_p<false>((char*)lds_raw, (LAS char*)lds, b, h, s, PROJ, FB, fbias, MIX, ctl + 32, false);
            for (int i = 0; i < 2; ++i) { const int u = vcu * 2 + i; const int sb = u >> 6, kvh = (u >> 5) & 1, blk = u & 31; att::swa_unit((LAS char*)lds, sb, kvh, blk, PROJ, args.in[5], MIX); }
        }
    }
    SEAM(P_ATT);
    if (IN(P_G2)) {
        pg8::Gemm g{MIX, (const bf16_t*)(ws + WS_WEOUT), 1024, 0}; pg8::DenseOrder S; S.init(T, DM, G, bx, NREP(P_G2));
        pg8::EpiResidB<true> E{x, HBS};
        pg8::gemm_phase<pg8::EpiResidB<true>, pg8::DenseOrder, true>(lds, g, S, E);
    }
    SEAM(P_G2);
    if (IN(P_TP1)) {
#ifdef TP1_REP
        tp_route_mfma<true>(HBS, args.in[2], XN, (const bf16_t*)(ws + WS_WRT), (const bf16_t*)(ws + WS_WRT) + 48 * 1024, args.in[20], args.in[22], ctl + CW_CNT, LISTS, GATES, (LAS char*)lds, vcu, G, lane, wave);
#endif
        tp_route_mfma<false>(HBS, args.in[2], XN, (const bf16_t*)(ws + WS_WRT), (const bf16_t*)(ws + WS_WRT) + 48 * 1024, args.in[20], args.in[22], ctl + CW_CNT, LISTS, GATES, (LAS char*)lds, vcu, G, lane, wave);
    }
    SEAM(P_TP1);
    if (IN(P_G3)) {
        moe_setup(misc, ctl + CW_CNT);
        if (CV0_TAIL_G3 && G == 256) {
            const int U = misc[16 + 32] * 4, nidle = 768 - U;
            if (nidle > 0 && bx >= 256 - nidle) { constexpr int OI_LO = CV_I_EIN + CV_I_EOUT, OI_HI = OI_LO + CV_I_OIN + CV_I_OOUT;
                cv_run0(args.in, ws, OI_LO, OI_HI, (bx - (256 - nidle)) * NWAVES + wave, nidle * NWAVES, (LAS float*)(lds + wave * 16384), lane); }
            else if (nidle <= 0) { constexpr int OI_LO = CV_I_EIN + CV_I_EOUT, OI_HI = OI_LO + CV_I_OIN + CV_I_OOUT; cv_run0(args.in, ws, OI_LO, OI_HI, gw, ngw, (LAS float*)(lds + wave * 16384), lane); }
        }
        __syncthreads();
        pg8::Gemm g{XN, (const bf16_t*)(ws + WS_WGU), 1024, (size_t)1024 * 1024 * 2};
        pg8::MoeOrder S{(const volatile LAS int*)(misc + 16), (const volatile LAS int*)(misc + 64), LISTS, G, bx, true, NREP(P_G3)};
        pg8::EpiGateUp E{HB};
        pg8::gemm_phase<pg8::EpiGateUp, pg8::MoeOrder, true>(lds, g, S, E);
    }
    SEAM(P_G3);
    if (IN(P_G4)) {
        moe_setup(misc, ctl + CW_CNT);
        pg8::Gemm g{HB, (const bf16_t*)(ws + WS_WD), 512, (size_t)1024 * 512 * 2};
        pg8::MoeOrder S{(const volatile LAS int*)(misc + 16), (const volatile LAS int*)(misc + 64), LISTS, G, bx, false, NREP(P_G4)};
        pg8::EpiDown E{YB, LISTS, GATES, (const volatile LAS int*)(misc + 64)};
        pg8::gemm_phase<pg8::EpiDown, pg8::MoeOrder, true>(lds, g, S, E);
    }
    SEAM(P_G4);
    if (IN(P_TP2)) {
        tp_combine_norm<false>(HBS, YB, args.in[1] + DM, XN, nullptr, gw, ngw, lane);
        LAS float* scr = (LAS float*)(lds + wave * 16384);
        constexpr int I_GU = 16 * 32, I_D = 8 * 32; const size_t L1 = (size_t)32 * 1024 * 512;
        auto decode = [&](int it) -> CvItem {
            int r = it;
            if (r < 32 * I_GU) { const int e = r / I_GU; return cv_make_gu(args.in[23] + L1 + (size_t)e * 1024 * 512, args.in[24] + L1 + (size_t)e * 1024 * 512, (bf16_t*)(ws + WS_WGU) + (size_t)e * 1024 * 1024, r % I_GU, lane); } r -= 32 * I_GU;
            { const int e = r / I_D; return cv_make(SrcPlain{args.in[25] + L1 + (size_t)e * 512 * 1024, 1024}, 1024, 512, 32, (bf16_t*)(ws + WS_WD) + (size_t)e * 1024 * 512, r % I_D, lane); }
        };
        const int NIT1 = CV_NIT1 - ((G == 256) ? (CV1_TAIL_G5 + CV1_TAIL_MIX) : 0);
        for (int it = 2 * gw; it < NIT1; it += 2 * ngw) {
            float va[32], vb[32]; const CvItem da = decode(it); cv_load(da, va);
            const bool n1 = it + 1 < NIT1; CvItem db = da; if (n1) { db = decode(it + 1); cv_load(db, vb); }
            cv_finish(da, va, scr, lane);
            if (n1) cv_finish(db, vb, scr, lane);
        }
    }
    SEAM(P_TP2);
    if (IN(P_G5)) {
        pg8::Gemm g{XN, (const bf16_t*)(ws + WS_WOIN), 1024, 0}; pg8::DenseOrder S; S.init(T, NO_IN, G, bx, NREP(P_G5));
        pg8::EpiProjOdd E{PROJ, (float*)(ws + WS_DTG)};
        pg8::gemm_phase<pg8::EpiProjOdd, pg8::DenseOrder, true>(lds, g, S, E);
        if (CV1_TAIL_G5 > 0 && G == 256 && bx >= 192)
            cv_run1(args.in, ws, CV_NIT1 - CV1_TAIL_G5 - CV1_TAIL_MIX, CV_NIT1 - CV1_TAIL_MIX, (bx - 192) * NWAVES + wave, 64 * NWAVES, (LAS float*)(lds + wave * 16384), lane);
    }
    SEAM(P_G5);
    if (IN(P_CONV)) {
        mx::prep_conv(PROJ, (bf16_t*)(ws + WS_CONV), args.in[9], args.in[10], vcu, G, tid);
#ifdef PREP_REP_CONV
        mx::prep_conv(PROJ, (bf16_t*)(ws + WS_CONV), args.in[9], args.in[10], vcu, G, tid);
#endif
        mx::prep_ssd((const float*)(ws + WS_DTG), (float*)(ws + mx::WS_DTV), (float*)(ws + mx::WS_ACS), args.in[11], args.in[12], vcu, G, lane, wave);
#ifdef PREP_REP_SSD
        mx::prep_ssd((const float*)(ws + WS_DTG), (float*)(ws + mx::WS_DTV), (float*)(ws + mx::WS_ACS), args.in[11], args.in[12], vcu, G, lane, wave);
#endif
        mx::prep_gla(PROJ, (const float*)(ws + WS_DTG), (bf16_t*)(ws + mx::WS_QD), (bf16_t*)(ws + mx::WS_KI), (bf16_t*)(ws + mx::WS_KE), (float*)(ws + mx::WS_DEC), args.in[15], args.in[16], vcu, G, tid, lane, wave, (LAS char*)lds);
#ifdef PREP_REP_GLA
        mx::prep_gla(PROJ, (const float*)(ws + WS_DTG), (bf16_t*)(ws + mx::WS_QD), (bf16_t*)(ws + mx::WS_KI), (bf16_t*)(ws + mx::WS_KE), (float*)(ws + mx::WS_DEC), args.in[15], args.in[16], vcu, G, tid, lane, wave, (LAS char*)lds);
#endif
    }
    SEAM(P_CONV);
    if (IN(P_MIXER)) {
        if (G == 256) {
            if (vcu < 128) {
                mx::ssd_unit64((LAS char*)lds, vcu >> 4, vcu & 15, (const bf16_t*)(ws + WS_CONV), (const float*)(ws + mx::WS_ACS), (const float*)(ws + mx::WS_DTV), args.in[13][vcu & 15], MIX);
#ifdef MIX_SSD_REP
                __syncthreads(); mx::ssd_unit((LAS char*)lds, vcu >> 4, vcu & 15, (const bf16_t*)(ws + WS_CONV), (const float*)(ws + mx::WS_ACS), (const float*)(ws + mx::WS_DTV), args.in[13][vcu & 15], MIX);
#endif
            }
            else { const int u = vcu - 128; mx::gla_unit<false>((LAS char*)lds, u >> 4, (u >> 2) & 3, u & 3, PROJ, (const bf16_t*)(ws + mx::WS_QD), (const bf16_t*)(ws + mx::WS_KI),
                                                          (const float*)(ws + mx::WS_DEC), MIX, ctl + 32);
                if (CV1_TAIL_MIX > 0) { __syncthreads(); cv_run1(args.in, ws, CV_NIT1 - CV1_TAIL_MIX, CV_NIT1, (vcu - 128) * NWAVES + wave, 128 * NWAVES, (LAS float*)(lds + wave * 16384), lane); }
#ifdef MIX_GLA_REP
                __syncthreads(); mx::gla_unit<false>((LAS char*)lds, u >> 4, (u >> 2) & 3, u & 3, PROJ, (const bf16_t*)(ws + mx::WS_QD), (const bf16_t*)(ws + mx::WS_KI), (const float*)(ws + mx::WS_DEC), MIX, ctl + 32);
#endif
            }
        }
    }
    SEAM(P_MIXER);
    if (IN(P_FIN)) {
        mx::finalize_phase(MIX, PROJ, args.in[14], args.in[17], gw, ngw, lane);
    }
    SEAM(P_FIN);
    if (IN(P_G6)) {
        pg8::Gemm g{MIX, (const bf16_t*)(ws + WS_WOOUT), 2048, 0}; pg8::DenseOrder S; S.init(T, DM, G, bx, NREP(P_G6));
        pg8::EpiResidB<false> E{HBS, HBS};
        pg8::gemm_phase<pg8::EpiResidB<false>, pg8::DenseOrder, true>(lds, g, S, E);
    }
    SEAM(P_G6);
    if (IN(P_TP3)) {
        tp_route_mfma<false>(HBS, args.in[2] + DM, XN, (const bf16_t*)(ws + WS_WRT) + 2 * 48 * 1024, (const bf16_t*)(ws + WS_WRT) + 3 * 48 * 1024, args.in[20] + 4, args.in[22] + 32,
                             ctl + CW_CNT + 32 * 64, LISTS, GATES, (LAS char*)lds, vcu, G, lane, wave);
    }
    SEAM(P_TP3);
    if (IN(P_G7)) {
        moe_setup(misc, ctl + CW_CNT + 32 * 64);
        pg8::Gemm g{XN, (const bf16_t*)(ws + WS_WGU), 1024, (size_t)1024 * 1024 * 2};
        pg8::MoeOrder S{(const volatile LAS int*)(misc + 16), (const volatile LAS int*)(misc + 64), LISTS, G, bx, true, NREP(P_G7)};
        pg8::EpiGateUp E{HB};
        pg8::gemm_phase<pg8::EpiGateUp, pg8::MoeOrder, true>(lds, g, S, E);
    }
    SEAM(P_G7);
    if (IN(P_G8)) {
        moe_setup(misc, ctl + CW_CNT + 32 * 64);
        pg8::Gemm g{HB, (const bf16_t*)(ws + WS_WD), 512, (size_t)1024 * 512 * 2};
        pg8::MoeOrder S{(const volatile LAS int*)(misc + 16), (const volatile LAS int*)(misc + 64), LISTS, G, bx, false, NREP(P_G8)};
        pg8::EpiDown E{YB, LISTS, GATES, (const volatile LAS int*)(misc + 64)};
        pg8::gemm_phase<pg8::EpiDown, pg8::MoeOrder, true>(lds, g, S, E);
    }
    SEAM(P_G8);
    if (IN(P_TP4)) {
        tp_combine_norm<true>(HBS, YB, args.in[3], nullptr, outp, gw, ngw, lane);
#if defined(GLA_CHECK) || defined(ATT_CHECK)
        if (__hip_atomic_load(ctl + 32, __ATOMIC_RELAXED, __HIP_MEMORY_SCOPE_AGENT) != 0u) { for (int m = gw; m < T; m += ngw) outp[(size_t)m * DM + lane] = 1000.f; }
#endif
    }
#undef IN
#undef SEAM
#undef GRID_BAR
}
}

extern "C" void kernel_launch(void* const* d_in, const int* in_sizes, int n_in, void* d_out, int out_size, void* d_ws, size_t ws_size, hipStream_t stream) {
    static int grid = 0;
    if (grid == 0) {
        int dev = 0, cus = 0, per_cu = 0;
        (void)hipGetDevice(&dev); (void)hipDeviceGetAttribute(&cus, hipDeviceAttributeMultiprocessorCount, dev);
        if (n_in != 26 || out_size != mk::T * mk::DM || ws_size < mk::WS_TOTAL) { fprintf(stderr, "kernel_launch: unexpected shapes (n_in %d out %d ws %zu)\n", n_in, out_size, ws_size); grid = -1; return; }
        if (hipFuncSetAttribute((const void*)mk::mk_fwd, hipFuncAttributeMaxDynamicSharedMemorySize, mk::LDS_BYTES) != hipSuccess) { fprintf(stderr, "hipFuncSetAttribute failed\n"); grid = -1; return; }
        if (hipOccupancyMaxActiveBlocksPerMultiprocessor(&per_cu, (const void*)mk::mk_fwd, mk::NTHR, mk::LDS_BYTES) != hipSuccess || per_cu < 1) { fprintf(stderr, "occupancy query reports %d blocks per CU\n", per_cu); }
        (void)hipGetLastError();
        grid = cus;
        if (grid != 256) fprintf(stderr, "kernel_launch: %d CUs; the attention / mixer phases need 256\n", grid);
    }
    if (grid < 0) return;
    (void)hipMemsetAsync((char*)d_ws + mk::WS_CTL, 0, mk::CTL_ZERO_BYTES, stream);
    mk::Args a{};
    for (int i = 0; i < 26; ++i) a.in[i] = (const float*)d_in[i];
    a.out = (float*)d_out; a.ws = (unsigned char*)d_ws;
    a.ph_lo = 0; a.ph_hi = mk::P_COUNT; a.use_bar = 1; a.li = 0;
    hipLaunchKernelGGL(mk::mk_fwd, dim3(grid), dim3(mk::NTHR), mk::LDS_BYTES, stream, a);
}
```

```cpp
#include <hip/hip_runtime.h>
#include <hip/hip_bf16.h>
#include <cstdio>
#include <cstdint>
#include <cmath>
namespace mk {
#define LAS __attribute__((address_space(3)))
#define GAS __attribute__((address_space(1)))
typedef unsigned short bf16_t;
typedef short bf16x8 __attribute__((ext_vector_type(8)));
typedef short s16x4 __attribute__((ext_vector_type(4)));
typedef float f32x4 __attribute__((ext_vector_type(4)));
typedef float f32x2 __attribute__((ext_vector_type(2)));
typedef float f32x16 __attribute__((ext_vector_type(16)));
typedef unsigned u32x4 __attribute__((ext_vector_type(4)));
typedef unsigned u32x2 __attribute__((ext_vector_type(2)));

constexpr int T = 16384, DM = 1024, SEQ = 2048, NBATCH = 8;
constexpr int NE_IN = 2560, NO_IN = 5888;
constexpr int CAP = 16384;
constexpr float EPS = 1e-6f;
constexpr float LOG2E = 1.4426950408889634f;
constexpr float C2 = 0.125f * LOG2E;
constexpr int NWAVES = 8, NTHR = 512;
constexpr size_t MiB = 1u << 20;
constexpr size_t WS_CTL = 0, CTL_ZERO_BYTES = 1 * MiB;
constexpr size_t WS_WEIN = 2 * MiB, WS_WEOUT = 7 * MiB, WS_WOIN = 9 * MiB, WS_WOOUT = 21 * MiB, WS_WRT = 25 * MiB;
constexpr size_t WS_WGU = 26 * MiB, WS_WD = 90 * MiB;
constexpr size_t WS_XN = 122 * MiB;
constexpr size_t WS_PROJ = 154 * MiB;
constexpr size_t WS_H = WS_PROJ, WS_Y = WS_PROJ + 40 * MiB;
constexpr size_t WS_MIX = 338 * MiB;
constexpr size_t WS_CONV = 402 * MiB;
constexpr size_t WS_FB = 450 * MiB;
constexpr size_t WS_DTG = 451 * MiB;
constexpr size_t WS_LISTS = 453 * MiB;
constexpr size_t WS_GATES = 455 * MiB;
constexpr size_t WS_RSTD = 455 * MiB + 512 * 1024;
constexpr size_t WS_END = 456 * MiB, WS_HB = 476 * MiB, WS_TOTAL = 508 * MiB;
constexpr int CW_BAR = 4096;
constexpr int CW_CNT = 16384;
constexpr int RING_BYTES = 146432;
constexpr int MISC_OFF = RING_BYTES;
constexpr int LDS_BYTES = 147456;

typedef __bf16 bf16x2_t __attribute__((ext_vector_type(2)));
__device__ __forceinline__ unsigned cvt_pk_bf16(float lo, float hi) { f32x2 v = {lo, hi}; bf16x2_t b = __builtin_convertvector(v, bf16x2_t); return __builtin_bit_cast(unsigned, b); }
__device__ __forceinline__ float bf2f(unsigned short b) { return __uint_as_float((unsigned)b << 16); }
__device__ __forceinline__ float wave_sum(float v) {
#pragma unroll
    for (int o = 1; o < 64; o <<= 1) v += __shfl_xor(v, o);
    return v;
}
__device__ __forceinline__ float siluf(float x) { return x * __builtin_amdgcn_rcpf(1.f + __expf(-x)); }
__device__ __forceinline__ float log_sigmoidf(float x) { return fminf(x, 0.f) - log1pf(expf(-fabsf(x))); }
__device__ __forceinline__ float log_sigmoid_fast(float x) { return fminf(x, 0.f) - __logf(1.f + __expf(-fabsf(x))); }
__device__ __forceinline__ float softplusf(float x) { return fmaxf(x, 0.f) + __logf(1.f + __expf(-fabsf(x))); }

#define XB_TMO      128
#define XB_XCNT(j)  (256  + 64 * (j))
#define XB_XSUB(j)  (1280 + 64 * (j))
#define XB_XGEN(j)  (2304 + 64 * (j))
#define XB_TOP      3328
#define XB_TOPGEN   3392
#define XCD_BAR_WORDS 3456
#define XB_SPIN_CAP (1u << 18)
__device__ __forceinline__ unsigned xb_ld(unsigned* p)              { return __hip_atomic_load(p, __ATOMIC_RELAXED, __HIP_MEMORY_SCOPE_AGENT); }
__device__ __forceinline__ unsigned xb_add(unsigned* p, unsigned v) { return __hip_atomic_fetch_add(p, v, __ATOMIC_RELAXED, __HIP_MEMORY_SCOPE_AGENT); }
__device__ __forceinline__ unsigned xb_xcc_id() { return (unsigned)__builtin_amdgcn_s_getreg((3 << 11) | 20) & 0xFu; }
#define XB_SPIN(cond, bar) do { unsigned _sp = 0; while (cond) { __builtin_amdgcn_s_sleep(1); \
    if ((++_sp & 255u) == 0u) { if (xb_ld(&(bar)[XB_TMO])) break; if (_sp > XB_SPIN_CAP) { atomicAdd(&(bar)[XB_TMO], 1u); break; } } } } while (0)
struct XcdBarrier { unsigned* bar; unsigned x; volatile LAS unsigned* st; };
__device__ __forceinline__ XcdBarrier xcd_barrier_post(unsigned* bar, volatile LAS unsigned* st) {
    XcdBarrier b; b.bar = bar; b.x = xb_xcc_id(); b.st = st;
    if (threadIdx.x == 0) (void)xb_add(&bar[XB_XCNT(b.x)], 1u);
    return b;
}
__device__ __forceinline__ void xcd_barrier_complete(unsigned* bar, unsigned x, unsigned& nloc, unsigned& nx) {
    const unsigned G = gridDim.x * gridDim.y * gridDim.z;
    unsigned sum, cnt, mine, sp = 0u;
    for (;;) {
        sum = 0u; cnt = 0u; mine = 0u;
#pragma unroll
        for (unsigned j = 0; j < 16; ++j) { const unsigned c = xb_ld(&bar[XB_XCNT(j)]); sum += c; cnt += (c > 0u) ? 1u : 0u; mine = (j == x) ? c : mine; }
        if (sum == G) break;
        __builtin_amdgcn_s_sleep(1);
        if ((++sp & 255u) == 0u) { if (xb_ld(&bar[XB_TMO])) break; if (sp > XB_SPIN_CAP) { atomicAdd(&bar[XB_TMO], 1u); break; } }
    }
    nloc = mine > 0u ? mine : 1u; nx = cnt > 0u ? cnt : 1u;
}
__device__ __forceinline__ void xcd_barrier(const XcdBarrier& b) {
    asm volatile("s_waitcnt vmcnt(0)" ::: "memory");
    __syncthreads();
    if (threadIdx.x == 0) {
        unsigned* bar = b.bar;
        __builtin_amdgcn_s_waitcnt(0);
        unsigned nloc = b.st[0], nx = b.st[1];
        if (nloc == 0u) { xcd_barrier_complete(bar, b.x, nloc, nx); b.st[0] = nloc; b.st[1] = nx; }
        const unsigned old = xb_add(&bar[XB_XSUB(b.x)], 1u);
        const unsigned gen = old / nloc;
        if (old + 1u == (gen + 1u) * nloc) {
            __builtin_amdgcn_fence(__ATOMIC_RELEASE, "agent");
            asm volatile("s_waitcnt vmcnt(0)" ::: "memory");
            const unsigned og = xb_add(&bar[XB_TOP], 1u);
            const unsigned tg = og / nx;
            if (og + 1u == (tg + 1u) * nx) xb_add(&bar[XB_TOPGEN], 1u);
            else XB_SPIN(xb_ld(&bar[XB_TOPGEN]) == tg, bar);
            __builtin_amdgcn_fence(__ATOMIC_ACQUIRE, "agent");
            xb_add(&bar[XB_XGEN(b.x)], 1u);
            asm volatile("s_waitcnt vmcnt(0)" ::: "memory");
        } else {
            XB_SPIN(xb_ld(&bar[XB_XGEN(b.x)]) == gen, bar);
            __builtin_amdgcn_fence(__ATOMIC_ACQUIRE, "agent");
            asm volatile("s_waitcnt vmcnt(0)" ::: "memory");
        }
    }
    __syncthreads();
}

struct SrcPlain { const float* W; int N; __device__ __forceinline__ const float* operator()(int k, int n) const { return W + (size_t)k * N + n; } };
struct SrcEvenIn { const float* W; __device__ __forceinline__ const float* operator()(int k, int n) const { return n < 2312 ? W + (size_t)k * 2312 + n : nullptr; } };
struct SrcOddIn { const float* W;
    __device__ __forceinline__ const float* operator()(int k, int n) const {
        int s;
        if (n < 2560) s = n; else if (n < 4608) s = n + 16; else if (n < 5632) s = n + 32; else if (n < 5648) s = 2560 + (n - 5632); else if (n < 5664) s = 4624 + (n - 5648); else s = -1;
        return s >= 0 ? W + (size_t)k * 5664 + s : nullptr; } };
struct SrcGateUp { const float* Wg; const float* Wu;
    __device__ __forceinline__ const float* operator()(int k, int n) const { const int j = (n >> 5) * 16 + (n & 15); const long d = (n & 16) ? (long)(Wu - Wg) : 0l; return Wg + d + (size_t)k * 512 + j; } };
__device__ __forceinline__ struct CvItem cv_make_gu(const float* Wg, const float* Wu, bf16_t* WT, int item, int lane);
struct CvItem { const float* p; size_t stride; bf16_t* dst; int K; int gu; };
template <class Src> __device__ __forceinline__ CvItem cv_make(const Src& src, int srcN, int K, int nblk, bf16_t* WT, int item, int lane) {
    const int kb = item / nblk, nb = item % nblk, k0 = 64 * kb, n0 = 32 * nb;
    CvItem d; d.p = src(k0 + (lane >> 5), n0 + (lane & 31)); d.stride = (size_t)2 * srcN; d.dst = WT + (size_t)n0 * K + k0; d.K = K; d.gu = 0; return d;
}
__device__ __forceinline__ CvItem cv_make_gu(const float* Wg, const float* Wu, bf16_t* WT, int item, int lane) {
    const int half = item >> 8, r = item & 255, kb = r >> 4, jb = r & 15, k0 = 64 * kb, j0 = 32 * jb;
    CvItem d; d.p = (half ? Wu : Wg) + (size_t)(k0 + (lane >> 5)) * 512 + j0 + (lane & 31); d.stride = 1024; d.dst = WT + (size_t)(jb * 64 + half * 16) * 1024 + k0; d.K = 1024; d.gu = 1; return d;
}
__device__ __forceinline__ void cv_load(const CvItem& d, float (&v)[32]) {
#pragma unroll
    for (int i = 0; i < 32; ++i) v[i] = d.p ? __builtin_nontemporal_load(d.p + (size_t)i * d.stride) : 0.f;
}
__device__ __forceinline__ void cv_finish(const CvItem& d, const float (&v)[32], LAS float* scr, int lane) {
#pragma unroll
    for (int i = 0; i < 32; ++i) { const int kk = 2 * i + (lane >> 5); scr[kk * 33 + (lane & 31)] = v[i]; }
    asm volatile("s_waitcnt lgkmcnt(0)" ::: "memory");
    const int c = lane & 7;
#pragma unroll
    for (int j = 0; j < 4; ++j) { const int n = (lane >> 3) + 8 * j; const LAS float* s = scr + (8 * c) * 33 + n; const int dr = d.gu ? ((n >> 4) * 32 + (n & 15)) : n;
        u32x4 o; o.x = cvt_pk_bf16(s[0 * 33], s[1 * 33]); o.y = cvt_pk_bf16(s[2 * 33], s[3 * 33]); o.z = cvt_pk_bf16(s[4 * 33], s[5 * 33]); o.w = cvt_pk_bf16(s[6 * 33], s[7 * 33]);
        __builtin_nontemporal_store(o, (u32x4*)(d.dst + (size_t)dr * d.K + 8 * c)); }
    asm volatile("s_waitcnt lgkmcnt(0)" ::: "memory");
}

namespace pg8 {
constexpr int BM = 256, BK = 64, HALF = 128, HTB = HALF * BK * 2, STAGE_BYTES = 8 * HTB, NXCD = 8, WGM = 8;
__host__ __device__ __forceinline__ int lds_byte(int r, int c) { const int st = (r >> 4) * 2 + (c >> 5), rr = r & 15, cc = c & 31, ob = rr * 64 + cc * 2; return st * 1024 + (ob ^ (((ob >> 9) & 1) << 5)); }
__host__ __device__ __forceinline__ void stage_rc(int b, int& R, int& C) { const int st = b / 1024, sb = b % 1024, swz = sb ^ (((sb >> 9) & 1) << 5); R = (st >> 1) * 16 + swz / 64; C = (st & 1) * 32 + (swz % 64) / 2; }
__host__ __device__ __forceinline__ int perm32(int rho) { const int n = rho >> 4, i = rho & 15; return 8 * (i >> 2) + 4 * n + (i & 3); }

struct Unit { int pm, pn, e, j; };
struct Gemm { const bf16_t* A; const bf16_t* Bt; int K; size_t b_estride; };

struct DenseOrder {
    int nM, nN, nwg, G, c, rep;
    __device__ void init(int M, int N, int G_, int c_, int rep_ = 1) { nM = M / BM; nN = N / BM; nwg = nM * nN; G = G_; c = c_; rep = rep_; }
    __device__ bool next(int i, Unit& u) const {
        if (rep > 1) { const int n = (nwg - c + G - 1) / G; if (n <= 0 || i >= n * rep) return false; i = i % n; }
        const long L = (long)i * G + c; if (L >= nwg) return false;
        int wgid = (int)L; { const int q = nwg / NXCD, r = nwg % NXCD, xcd = wgid % NXCD, off = wgid / NXCD; wgid = (xcd < r ? xcd * (q + 1) : r * (q + 1) + (xcd - r) * q) + off; }
        const int nig = WGM * nN, gid = wgid / nig, fm = gid * WGM, gsz = (nM - fm) < WGM ? (nM - fm) : WGM;
        u.pm = fm + ((wgid % nig) % gsz); u.pn = (wgid % nig) / gsz; u.e = 0; u.j = 0; return true;
    }
    __device__ __forceinline__ unsigned arow(const Unit& u, int r) const { return (unsigned)(u.pm * BM + r); }
};
struct MoeOrder {
    const volatile LAS int* ts; const volatile LAS int* cnt; const int* lists; int G, c; bool gather; int rep;
    __device__ bool next(int i, Unit& u) const {
        const int U = ts[32] * 4;
        if (rep > 1) { const int n = (U - c + G - 1) / G; if (n <= 0 || i >= n * rep) return false; i = i % n; }
        const long L = (long)i * G + c; if (L >= U) return false;
        int v = (int)L; { const int q = U / NXCD, r = U % NXCD, xcd = v % NXCD, off = v / NXCD; v = (xcd < r ? xcd * (q + 1) : r * (q + 1) + (xcd - r) * q) + off; }
        const int m = v >> 2; u.pm = m; u.pn = v & 3;
        int e = 0;
        for (int k = 1; k < 32; ++k) if (ts[k] <= m) e = k;
        u.e = e; u.j = m - ts[e]; return true;
    }
    __device__ __forceinline__ unsigned arow(const Unit& u, int r) const {
        if (!gather) return (unsigned)(u.pm * BM + r);
        const int ri = u.j * BM + r; const int n = cnt[u.e];
        return ri < n ? (unsigned)(lists[u.e * CAP + ri] >> 1) : 0u;
    }
};

struct EpiProjEven {
    static constexpr bool PERM = true;
    bf16_t* O; float* fb;
    __device__ __forceinline__ void operator()(const f32x4 (&acc)[2][2][4][2], const Unit& u, int wr, int wc, int fr, int fq) const {
        const int row0 = u.pm * BM + wr * 64 + fr;
        if (u.pn == 9) {
            if (wc == 0 && fq == 0) {
#pragma unroll
                for (int ai = 0; ai < 2; ++ai)
#pragma unroll
                    for (int m = 0; m < 4; ++m) { float* p = fb + (size_t)(row0 + ai * HALF + m * 16) * 8; *(f32x4*)p = acc[ai][0][m][0]; *(f32x4*)(p + 4) = acc[ai][0][m][1]; }
            }
            return;
        }
        const float sc = (u.pn == 0 || u.pn == 1 || u.pn == 3 || u.pn == 4) ? C2 : 1.f;
        const int col0 = u.pn * BM + wc * 32 + 8 * fq;
#pragma unroll
        for (int ai = 0; ai < 2; ++ai)
#pragma unroll
            for (int m = 0; m < 4; ++m) { bf16_t* rowp = O + (size_t)(row0 + ai * HALF + m * 16) * NE_IN + col0;
#pragma unroll
                for (int bj = 0; bj < 2; ++bj) { const f32x4 v0 = acc[ai][bj][m][0] * sc, v1 = acc[ai][bj][m][1] * sc;
                    u32x4 w; w.x = cvt_pk_bf16(v0[0], v0[1]); w.y = cvt_pk_bf16(v0[2], v0[3]); w.z = cvt_pk_bf16(v1[0], v1[1]); w.w = cvt_pk_bf16(v1[2], v1[3]);
                    *(u32x4*)(rowp + bj * HALF) = w; } }
    }
};
struct EpiProjOdd {
    static constexpr bool PERM = true;
    bf16_t* O; float* dtg;
    __device__ __forceinline__ void operator()(const f32x4 (&acc)[2][2][4][2], const Unit& u, int wr, int wc, int fr, int fq) const {
        const int row0 = u.pm * BM + wr * 64 + fr;
        if (u.pn == 22) {
            if (wc == 0) {
#pragma unroll
                for (int ai = 0; ai < 2; ++ai)
#pragma unroll
                    for (int m = 0; m < 4; ++m) { float* p = dtg + (size_t)(row0 + ai * HALF + m * 16) * 32 + 8 * fq; *(f32x4*)p = acc[ai][0][m][0]; *(f32x4*)(p + 4) = acc[ai][0][m][1]; }
            }
            return;
        }
        const int col0 = u.pn * BM + wc * 32 + 8 * fq;
#pragma unroll
        for (int ai = 0; ai < 2; ++ai)
#pragma unroll
            for (int m = 0; m < 4; ++m) { bf16_t* rowp = O + (size_t)(row0 + ai * HALF + m * 16) * NO_IN + col0;
#pragma unroll
                for (int bj = 0; bj < 2; ++bj) { const f32x4 v0 = acc[ai][bj][m][0], v1 = acc[ai][bj][m][1];
                    u32x4 w; w.x = cvt_pk_bf16(v0[0], v0[1]); w.y = cvt_pk_bf16(v0[2], v0[3]); w.z = cvt_pk_bf16(v1[0], v1[1]); w.w = cvt_pk_bf16(v1[2], v1[3]);
                    *(u32x4*)(rowp + bj * HALF) = w; } }
    }
};
struct EpiResid {
    static constexpr bool PERM = false;
    const float* base; float* out;
    __device__ __forceinline__ void operator()(const f32x4 (&acc)[2][2][4][2], const Unit& u, int wr, int wc, int fr, int fq) const {
        const int col0 = u.pn * BM + wc * 32 + 4 * fq;
#pragma unroll
        for (int ai = 0; ai < 2; ++ai)
#pragma unroll
            for (int m = 0; m < 4; ++m) { const size_t off = (size_t)(u.pm * BM + ai * HALF + wr * 64 + m * 16 + fr) * DM + col0;
#pragma unroll
                for (int bj = 0; bj < 2; ++bj)
#pragma unroll
                    for (int n = 0; n < 2; ++n) { const f32x4 bs = *(const f32x4*)(base + off + bj * HALF + n * 16); *(f32x4*)(out + off + bj * HALF + n * 16) = bs + acc[ai][bj][m][n]; } }
    }
};
template <bool BASE_F32> struct EpiResidB {
    static constexpr bool PERM = true;
    const void* base; bf16_t* out;
    __device__ __forceinline__ void operator()(const f32x4 (&acc)[2][2][4][2], const Unit& u, int wr, int wc, int fr, int fq) const {
        const int row0 = u.pm * BM + wr * 64 + fr, col0 = u.pn * BM + wc * 32 + 8 * fq;
#pragma unroll
        for (int ai = 0; ai < 2; ++ai)
#pragma unroll
            for (int m = 0; m < 4; ++m) { const size_t ro = (size_t)(row0 + ai * HALF + m * 16) * DM + col0;
#pragma unroll
                for (int bj = 0; bj < 2; ++bj) { f32x4 v0 = acc[ai][bj][m][0], v1 = acc[ai][bj][m][1];
                    if (BASE_F32) { const float* b = (const float*)base + ro + bj * HALF; v0 += __builtin_nontemporal_load((const f32x4*)b); v1 += __builtin_nontemporal_load((const f32x4*)(b + 4)); }
                    else { const u32x4 bb = *(const u32x4*)((const bf16_t*)base + ro + bj * HALF);
                        v0[0] += __uint_as_float(bb.x << 16); v0[1] += __uint_as_float(bb.x & 0xffff0000u); v0[2] += __uint_as_float(bb.y << 16); v0[3] += __uint_as_float(bb.y & 0xffff0000u);
                        v1[0] += __uint_as_float(bb.z << 16); v1[1] += __uint_as_float(bb.z & 0xffff0000u); v1[2] += __uint_as_float(bb.w << 16); v1[3] += __uint_as_float(bb.w & 0xffff0000u); }
                    u32x4 w; w.x = cvt_pk_bf16(v0[0], v0[1]); w.y = cvt_pk_bf16(v0[2], v0[3]); w.z = cvt_pk_bf16(v1[0], v1[1]); w.w = cvt_pk_bf16(v1[2], v1[3]);
                    *(u32x4*)(out + ro + bj * HALF) = w; } }
    }
};
struct EpiGateUp {
    static constexpr bool PERM = false;
    bf16_t* H;
    __device__ __forceinline__ void operator()(const f32x4 (&acc)[2][2][4][2], const Unit& u, int wr, int wc, int fr, int fq) const {
#pragma unroll
        for (int ai = 0; ai < 2; ++ai)
#pragma unroll
            for (int m = 0; m < 4; ++m) { bf16_t* rowp = H + (size_t)(u.pm * BM + ai * HALF + wr * 64 + m * 16 + fr) * 512;
#pragma unroll
                for (int bj = 0; bj < 2; ++bj) { const int j0 = (u.pn * 8 + bj * 4 + wc) * 16 + 4 * fq; const f32x4 g = acc[ai][bj][m][0], up = acc[ai][bj][m][1];
                    u32x2 w; w.x = cvt_pk_bf16(siluf(g[0]) * up[0], siluf(g[1]) * up[1]); w.y = cvt_pk_bf16(siluf(g[2]) * up[2], siluf(g[3]) * up[3]);
                    *(u32x2*)(rowp + j0) = w; } }
    }
};
struct EpiDown {
    static constexpr bool PERM = true;
    bf16_t* Y; const int* lists; const float* gates; const volatile LAS int* cnt;
    __device__ __forceinline__ void operator()(const f32x4 (&acc)[2][2][4][2], const Unit& u, int wr, int wc, int fr, int fq) const {
        const int n = cnt[u.e]; const int col0 = u.pn * BM + wc * 32 + 8 * fq;
#pragma unroll
        for (int ai = 0; ai < 2; ++ai)
#pragma unroll
            for (int m = 0; m < 4; ++m) { const int ri = u.j * BM + ai * HALF + wr * 64 + m * 16 + fr;
                if (ri < n) { const int a = lists[u.e * CAP + ri]; const float g = gates[a]; bf16_t* rowp = Y + ((size_t)(a & 1) * T + (a >> 1)) * DM + col0;
#pragma unroll
                    for (int bj = 0; bj < 2; ++bj) { const f32x4 v0 = acc[ai][bj][m][0] * g, v1 = acc[ai][bj][m][1] * g;
                        u32x4 w; w.x = cvt_pk_bf16(v0[0], v0[1]); w.y = cvt_pk_bf16(v0[2], v0[3]); w.z = cvt_pk_bf16(v1[0], v1[1]); w.w = cvt_pk_bf16(v1[2], v1[3]);
                        *(u32x4*)(rowp + bj * HALF) = w; } } }
    }
};

template <class Epi, class Sched, bool ALIGN_EPI>
__device__ __forceinline__ void gemm_phase(LAS unsigned char* lds, const Gemm g, const Sched& S, const Epi& E) {
    const int tid = threadIdx.x, wid = __builtin_amdgcn_readfirstlane(tid >> 6), lane = tid & 63, wr = wid >> 2, wc = wid & 3, fr = lane & 15, fq = lane >> 4;
    const int K = g.K, nt = K / BK;
    int RA[2]; unsigned cbA[2], voffB[2];
#pragma unroll
    for (int i = 0; i < 2; ++i) { int R, C; stage_rc(tid * 16 + i * 8192, R, C); const int Rb = Epi::PERM ? ((R & ~31) + perm32(R & 31)) : R;
        RA[i] = R; cbA[i] = (unsigned)C * 2u; voffB[i] = (unsigned)(Rb * K + C) * 2u; }
    const unsigned kstep = (unsigned)(BK * 2);
    const size_t hstep = (size_t)HALF * K * 2;
    const size_t tstep = 2 * hstep;
    const unsigned rowb = (unsigned)K * 2u;
    const unsigned ldsw = (unsigned)wid * 1024u;
    const int aoff = lds_byte(wr * 64 + fr, fq * 8), boff = lds_byte(wc * 32 + fr, fq * 8);
    const char* Ab = (const char*)g.A;
#define PG8_SA(b, h) (((b) * 2 + (h)) * HTB)
#define PG8_SB(b, h) ((4 + (b) * 2 + (h)) * HTB)
#define PG8_STAGE(bufoff, gbase, voff) do { _Pragma("unroll") for (int _i = 0; _i < 2; ++_i) \
        __builtin_amdgcn_global_load_lds((const unsigned*)((const char*)(gbase) + (voff)[_i]), (LAS unsigned*)(lds + (bufoff) + ldsw + _i * 8192), 16, 0, 0); } while (0)
#define PG8_STAGE_A(bufoff, kb, o0, o1) do { \
        __builtin_amdgcn_global_load_lds((const unsigned*)(Ab + (kb) + (o0)), (LAS unsigned*)(lds + (bufoff) + ldsw), 16, 0, 0); \
        __builtin_amdgcn_global_load_lds((const unsigned*)(Ab + (kb) + (o1)), (LAS unsigned*)(lds + (bufoff) + ldsw + 8192), 16, 0, 0); } while (0)
#define PG8_LDA(dst, b, h) do { _Pragma("unroll") for (int m = 0; m < 4; ++m) _Pragma("unroll") for (int k = 0; k < 2; ++k) dst[m][k] = *(const LAS bf16x8*)(lds + PG8_SA(b, h) + aoff + m * 2048 + k * 1024); } while (0)
#define PG8_LDB(dst, b, h) do { _Pragma("unroll") for (int n = 0; n < 2; ++n) _Pragma("unroll") for (int k = 0; k < 2; ++k) dst[n][k] = *(const LAS bf16x8*)(lds + PG8_SB(b, h) + boff + n * 2048 + k * 1024); } while (0)
#define PG8_MMA(ai, bj, At, Bt) do { __builtin_amdgcn_s_setprio(1); _Pragma("unroll") for (int m = 0; m < 4; ++m) _Pragma("unroll") for (int n = 0; n < 2; ++n) _Pragma("unroll") for (int k = 0; k < 2; ++k) \
        acc[ai][bj][m][n] = __builtin_amdgcn_mfma_f32_16x16x32_bf16(Bt[n][k], At[m][k], acc[ai][bj][m][n], 0, 0, 0); __builtin_amdgcn_s_setprio(0); } while (0)
#define PG8_WAIT_V(n) asm volatile("s_waitcnt vmcnt(" #n ")" ::: "memory")
#define PG8_WAIT_L(n) asm volatile("s_waitcnt lgkmcnt(" #n ")" ::: "memory")
#define PG8_BAR __builtin_amdgcn_s_barrier()
#define PG8_SCHED __builtin_amdgcn_sched_barrier(0)
    Unit cur, nxt; int ui = 0;
    if (!S.next(0, cur)) return;
    f32x4 acc[2][2][4][2];
#pragma unroll
    for (int a = 0; a < 2; ++a)
#pragma unroll
        for (int b = 0; b < 2; ++b)
#pragma unroll
            for (int m = 0; m < 4; ++m)
#pragma unroll
                for (int n = 0; n < 2; ++n) acc[a][b][m][n] = (f32x4){0.f, 0.f, 0.f, 0.f};
    bf16x8 At[4][2], B0[2][2], B1[2][2];
    unsigned oC00 = S.arow(cur, RA[0]) * rowb + cbA[0], oC01 = S.arow(cur, RA[1]) * rowb + cbA[1];
    unsigned oC10 = S.arow(cur, HALF + RA[0]) * rowb + cbA[0], oC11 = S.arow(cur, HALF + RA[1]) * rowb + cbA[1];
    const char* cB = (const char*)g.Bt + (size_t)cur.e * g.b_estride + (size_t)cur.pn * tstep;
    PG8_STAGE(PG8_SB(0, 0), cB, voffB); PG8_STAGE(PG8_SB(0, 1), cB + hstep, voffB); PG8_STAGE_A(PG8_SA(0, 0), 0u, oC00, oC01); PG8_STAGE_A(PG8_SA(0, 1), 0u, oC10, oC11);
    if (wr == 1) PG8_BAR;
    PG8_WAIT_V(2); PG8_BAR;
    PG8_STAGE(PG8_SB(1, 0), cB + kstep, voffB); PG8_STAGE_A(PG8_SA(1, 0), kstep, oC00, oC01); PG8_STAGE(PG8_SB(1, 1), cB + hstep + kstep, voffB);
    PG8_WAIT_V(6); PG8_BAR;
    for (;;) {
        const bool has_next = S.next(ui + 1, nxt);
        unsigned oN00 = oC00, oN01 = oC01, oN10 = oC10, oN11 = oC11;
        if (has_next) { oN00 = S.arow(nxt, RA[0]) * rowb + cbA[0]; oN01 = S.arow(nxt, RA[1]) * rowb + cbA[1];
                        oN10 = S.arow(nxt, HALF + RA[0]) * rowb + cbA[0]; oN11 = S.arow(nxt, HALF + RA[1]) * rowb + cbA[1]; }
        const char* nB = has_next ? (const char*)g.Bt + (size_t)nxt.e * g.b_estride + (size_t)nxt.pn * tstep : cB;
        for (int t = 0; t < nt; t += 2) {
            const bool last = (t == nt - 2);
            const unsigned k1 = (unsigned)(t + 1) * kstep;
            const unsigned k2 = last ? 0u : (unsigned)(t + 2) * kstep, k3 = k2 + kstep;
            const unsigned o00 = last ? oN00 : oC00, o01 = last ? oN01 : oC01, o10 = last ? oN10 : oC10, o11 = last ? oN11 : oC11;
            const char* b2 = last ? nB : cB + (size_t)(t + 2) * kstep; const char* b3 = b2 + kstep;
            PG8_LDB(B0, 0, 0); PG8_LDB(B1, 0, 1); PG8_SCHED; PG8_LDA(At, 0, 0); PG8_STAGE_A(PG8_SA(1, 1), k1, oC10, oC11);
            PG8_WAIT_V(8); PG8_WAIT_L(0); PG8_BAR; PG8_MMA(0, 0, At, B0); PG8_MMA(0, 1, At, B1); PG8_BAR; PG8_SCHED;
            PG8_LDA(At, 0, 1); PG8_STAGE(PG8_SB(0, 0), b2, voffB); PG8_STAGE(PG8_SB(0, 1), b2 + hstep, voffB); PG8_STAGE_A(PG8_SA(0, 0), k2, o00, o01);
            PG8_WAIT_V(8); PG8_WAIT_L(0); PG8_BAR; PG8_MMA(1, 0, At, B0); PG8_MMA(1, 1, At, B1); PG8_BAR; PG8_SCHED;
            PG8_LDB(B0, 1, 0); PG8_LDB(B1, 1, 1); PG8_SCHED; PG8_LDA(At, 1, 0); PG8_STAGE_A(PG8_SA(0, 1), k2, o10, o11);
            PG8_WAIT_V(8); PG8_WAIT_L(0); PG8_BAR; PG8_MMA(0, 0, At, B0); PG8_MMA(0, 1, At, B1); PG8_BAR; PG8_SCHED;
            PG8_LDA(At, 1, 1); PG8_STAGE(PG8_SB(1, 0), b3, voffB); PG8_STAGE(PG8_SB(1, 1), b3 + hstep, voffB); PG8_STAGE_A(PG8_SA(1, 0), k3, o00, o01);
            PG8_WAIT_V(8); PG8_WAIT_L(0); PG8_BAR; PG8_MMA(1, 0, At, B0); PG8_MMA(1, 1, At, B1); PG8_BAR; PG8_SCHED;
        }
        if constexpr (ALIGN_EPI) { if (wr == 0) PG8_BAR; }
        E(acc, cur, wr, wc, fr, fq);
        if (!has_next) break;
#pragma unroll
        for (int a = 0; a < 2; ++a)
#pragma unroll
            for (int b = 0; b < 2; ++b)
#pragma unroll
                for (int m = 0; m < 4; ++m)
#pragma unroll
                    for (int n = 0; n < 2; ++n) acc[a][b][m][n] = (f32x4){0.f, 0.f, 0.f, 0.f};
        cur = nxt; cB = nB; oC00 = oN00; oC01 = oN01; oC10 = oN10; oC11 = oN11; ++ui;
        if constexpr (ALIGN_EPI) { if (wr == 1) PG8_BAR; }
    }
    PG8_WAIT_V(0);
    if constexpr (!ALIGN_EPI) { if (wr == 0) PG8_BAR; }
    PG8_BAR;
#undef PG8_SA
#undef PG8_SB
#undef PG8_STAGE
#undef PG8_STAGE_A
#undef PG8_LDA
#undef PG8_LDB
#undef PG8_MMA
#undef PG8_WAIT_V
#undef PG8_WAIT_L
#undef PG8_BAR
#undef PG8_SCHED
}
}
}
namespace att {
using namespace mk;
constexpr int KVBLK = 64;
constexpr int A_K = 0, A_V = 32768, A_WS = 65536, A_OST = A_WS + NWAVES * 256, A_BIAS = A_OST + NWAVES * 4096, A_SCAN = A_BIAS + 8192, A_BYTES = A_SCAN + 64;
static_assert(A_BYTES <= RING_BYTES, "attention LDS");
__device__ __forceinline__ int crow(int r, int hi) { return (r & 3) + 8 * (r >> 2) + 4 * hi; }
__device__ __forceinline__ void glds16(const void* gsrc, unsigned lds_dst) { unsigned keep;
    asm volatile("s_mov_b32 %0, m0\n\ts_mov_b32 m0, %2\n\ts_nop 0\n\tglobal_load_lds_dwordx4 %1, off\n\ts_mov_b32 m0, %0" : "=&s"(keep) : "v"(gsrc), "s"(lds_dst) : "memory"); }
__device__ __forceinline__ unsigned cvtpk(float lo, float hi) { return cvt_pk_bf16(lo, hi); }
__device__ __forceinline__ void qkt(f32x16& p0, f32x16& p1, const LAS char* Kslot, const bf16x8* qr, int r32, int hi) {
    const LAS char* kb = Kslot + hi * 1024 + r32 * 16;
    const f32x16 z = {};
#pragma unroll
    for (int d0 = 0; d0 < 4; ++d0) {
        const bf16x8 b0 = *(const LAS bf16x8*)(kb + d0 * 2048);
        const bf16x8 b1 = *(const LAS bf16x8*)(kb + d0 * 2048 + 512);
        if (d0 == 0) { p0 = __builtin_amdgcn_mfma_f32_32x32x16_bf16(b0, qr[0], z, 0, 0, 0); p1 = __builtin_amdgcn_mfma_f32_32x32x16_bf16(b1, qr[0], z, 0, 0, 0); }
        else { p0 = __builtin_amdgcn_mfma_f32_32x32x16_bf16(b0, qr[d0], p0, 0, 0, 0); p1 = __builtin_amdgcn_mfma_f32_32x32x16_bf16(b1, qr[d0], p1, 0, 0, 0); } }
}
__device__ __forceinline__ void pv(f32x16* o, int vb, bf16x8 pa0, bf16x8 pa1, bf16x8 pa2, bf16x8 pa3) {
#pragma unroll
    for (int d0 = 0; d0 < 2; ++d0) { s16x4 lo[4], hi[4];
#pragma unroll
        for (int ks = 0; ks < 4; ++ks) {
            asm volatile("ds_read_b64_tr_b16 %0,%1 offset:%c2" : "=&v"(lo[ks]) : "v"(vb), "i"(d0 * 4096 + ks * 1024) : "memory");
            asm volatile("ds_read_b64_tr_b16 %0,%1 offset:%c2" : "=&v"(hi[ks]) : "v"(vb), "i"(d0 * 4096 + ks * 1024 + 512) : "memory"); }
        asm volatile("s_waitcnt lgkmcnt(0)" ::: "memory"); __builtin_amdgcn_sched_barrier(0);
#define PK(k) (bf16x8){lo[k][0], lo[k][1], lo[k][2], lo[k][3], hi[k][0], hi[k][1], hi[k][2], hi[k][3]}
        o[d0] = __builtin_amdgcn_mfma_f32_32x32x16_bf16(pa0, PK(0), o[d0], 0, 0, 0);
        o[d0] = __builtin_amdgcn_mfma_f32_32x32x16_bf16(pa1, PK(1), o[d0], 0, 0, 0);
        o[d0] = __builtin_amdgcn_mfma_f32_32x32x16_bf16(pa2, PK(2), o[d0], 0, 0, 0);
        o[d0] = __builtin_amdgcn_mfma_f32_32x32x16_bf16(pa3, PK(3), o[d0], 0, 0, 0);
#undef PK
    }
}
__device__ __forceinline__ float rowmax32(const f32x16& p0, const f32x16& p1) {
    float a = fmaxf(p0[0], p1[0]);
#pragma unroll
    for (int r = 1; r < 16; ++r) a = fmaxf(a, fmaxf(p0[r], p1[r]));
    auto rr = __builtin_amdgcn_permlane32_swap(__float_as_uint(a), __float_as_uint(a), false, false);
    return fmaxf(__uint_as_float(rr[0]), __uint_as_float(rr[1]));
}
#define A_WAIT_BAR(N) asm volatile("s_waitcnt vmcnt(" #N ") lgkmcnt(0)\n\ts_barrier" ::: "memory")

template <bool SWA>
__device__ __forceinline__ void attn_tiles(LAS char* shm, const bf16_t* Qw, int qpitch, const bf16_t* Kh, const bf16_t* Vh, int kvpitch, bf16_t* Ow, int opitch,
                                           int kt0, int ntile, int qpos0, float sl2, float sink2) {
    const int tid = threadIdx.x, lane = tid & 63, r32 = lane & 31, hi = lane >> 5; const int wid = __builtin_amdgcn_readfirstlane(tid >> 6);
    const unsigned lds0 = (unsigned)(uintptr_t)shm;
    LAS float* wsf = (LAS float*)(shm + A_WS) + wid * 64;
    const LAS float* biasl = (const LAS float*)(shm + A_BIAS);
    const bf16_t* ksrc = Kh + (long)lane * kvpitch + wid * 8;
    const bf16_t* vsrc = Vh + (long)(16 * (wid & 3) + (lane >> 2)) * kvpitch + (wid >> 2) * 32 + (lane & 3) * 8;
    const unsigned kdst = lds0 + A_K + wid * 1024, vdst = lds0 + A_V + wid * 1024;
#define DMA_K(t, slot) glds16(ksrc + (long)(t) * KVBLK * kvpitch, (unsigned)__builtin_amdgcn_readfirstlane(kdst + (slot)))
#define DMA_V(t, slot) glds16(vsrc + (long)(t) * KVBLK * kvpitch, (unsigned)__builtin_amdgcn_readfirstlane(vdst + (slot)))
    const int vb0 = (int)(lds0 + A_V) + ((lane >> 4) & 1) * 32 + (lane & 3) * 8 + (4 * hi + ((lane & 15) >> 2)) * 64;
    DMA_K(kt0, 0); DMA_V(kt0, 0);
    if (ntile > 1) { DMA_K(kt0 + 1, 8192); DMA_V(kt0 + 1, 8192); }
    if (ntile > 2) { DMA_K(kt0 + 2, 16384); DMA_V(kt0 + 2, 16384); }
    bf16x8 qr[4];
#pragma unroll
    for (int d0 = 0; d0 < 4; ++d0) qr[d0] = *(const bf16x8*)(Qw + (long)r32 * qpitch + d0 * 16 + hi * 8);
    float m = SWA ? sink2 : -INFINITY, l = (SWA && hi == 0) ? 1.f : 0.f;
    f32x16 o[2]; o[0] = f32x16{}; o[1] = f32x16{};
    const int qpos = qpos0 + r32;
    if (ntile > 2) { A_WAIT_BAR(4); } else if (ntile > 1) { A_WAIT_BAR(2); } else { A_WAIT_BAR(0); }
    f32x16 p0, p1;
    qkt(p0, p1, shm + A_K, qr, r32, hi);
    for (int it = 0; it < ntile; ++it) {
        const int kt = kt0 + it, slot = (it & 3) * 8192;
        f32x16 n0, n1;
        if (it + 1 < ntile) {
            if (it + 2 < ntile) { A_WAIT_BAR(2); } else { A_WAIT_BAR(0); }
            if (it + 3 < ntile) { DMA_K(kt + 3, ((it + 3) & 3) * 8192); DMA_V(kt + 3, ((it + 3) & 3) * 8192); }
            qkt(n0, n1, shm + A_K + ((it + 1) & 3) * 8192, qr, r32, hi);
        }
        const int kb = kt * 64 + 4 * hi;
        if (SWA) {
#pragma unroll
            for (int r = 0; r < 16; ++r) { const int k0 = kb + (r & 3) + 8 * (r >> 2), k1 = k0 + 32;
                p0[r] = (k0 <= qpos && k0 >= qpos - 127) ? p0[r] + sl2 * (float)(k0 - qpos) : -INFINITY;
                p1[r] = (k1 <= qpos && k1 >= qpos - 127) ? p1[r] + sl2 * (float)(k1 - qpos) : -INFINITY; }
        } else {
#pragma unroll
            for (int g = 0; g < 4; ++g) { const f32x4 b0 = *(const LAS f32x4*)(biasl + kb + 8 * g), b1 = *(const LAS f32x4*)(biasl + kb + 32 + 8 * g);
#pragma unroll
                for (int i = 0; i < 4; ++i) { p0[4 * g + i] += b0[i]; p1[4 * g + i] += b1[i]; } }
            if (kt * 64 + 63 > qpos0) {
#pragma unroll
                for (int r = 0; r < 16; ++r) { const int k0 = kb + (r & 3) + 8 * (r >> 2); if (k0 > qpos) p0[r] = -INFINITY; if (k0 + 32 > qpos) p1[r] = -INFINITY; }
            }
        }
        const float rm = rowmax32(p0, p1), mn = fmaxf(m, rm), ms = (mn == -INFINITY) ? 0.f : mn;
        const float alpha = __builtin_amdgcn_exp2f(m - ms);
        float rs = 0.f;
#pragma unroll
        for (int r = 0; r < 16; ++r) { p0[r] = __builtin_amdgcn_exp2f(p0[r] - ms); p1[r] = __builtin_amdgcn_exp2f(p1[r] - ms); rs += p0[r] + p1[r]; }
        l = l * alpha + rs; m = mn;
        if (hi == 0) wsf[r32] = alpha;
        asm volatile("s_waitcnt lgkmcnt(0)" ::: "memory");
#pragma unroll
        for (int r = 0; r < 16; ++r) { const float a = wsf[crow(r, hi)]; o[0][r] *= a; o[1][r] *= a; }
        u32x4 pw0, pw1, pw2, pw3;
        pw0 = (u32x4){cvtpk(p0[0], p0[1]), cvtpk(p0[2], p0[3]), cvtpk(p0[4], p0[5]), cvtpk(p0[6], p0[7])};
        pw1 = (u32x4){cvtpk(p0[8], p0[9]), cvtpk(p0[10], p0[11]), cvtpk(p0[12], p0[13]), cvtpk(p0[14], p0[15])};
        pw2 = (u32x4){cvtpk(p1[0], p1[1]), cvtpk(p1[2], p1[3]), cvtpk(p1[4], p1[5]), cvtpk(p1[6], p1[7])};
        pw3 = (u32x4){cvtpk(p1[8], p1[9]), cvtpk(p1[10], p1[11]), cvtpk(p1[12], p1[13]), cvtpk(p1[14], p1[15])};
        pv(o, vb0 + slot, __builtin_bit_cast(bf16x8, pw0), __builtin_bit_cast(bf16x8, pw1), __builtin_bit_cast(bf16x8, pw2), __builtin_bit_cast(bf16x8, pw3));
        asm volatile("s_waitcnt lgkmcnt(0)" ::: "memory");
        if (it + 1 < ntile) { p0 = n0; p1 = n1; }
    }
    { auto rr = __builtin_amdgcn_permlane32_swap(__float_as_uint(l), __float_as_uint(l), false, false); l = __uint_as_float(rr[0]) + __uint_as_float(rr[1]); }
    if (hi == 0) wsf[32 + r32] = l;
    asm volatile("s_waitcnt lgkmcnt(0)" ::: "memory");
    LAS bf16_t* stg = (LAS bf16_t*)(shm + A_OST) + wid * 2048;
#pragma unroll
    for (int r = 0; r < 16; ++r) { const int orow = crow(r, hi); const float rl = 1.f / wsf[32 + orow];
#pragma unroll
        for (int d0 = 0; d0 < 2; ++d0) stg[orow * 64 + d0 * 32 + r32] = (bf16_t)(cvt_pk_bf16(o[d0][r] * rl, 0.f) & 0xffffu); }
    asm volatile("s_waitcnt lgkmcnt(0)" ::: "memory");
#pragma unroll
    for (int i = 0; i < 4; ++i) { const int row = i * 8 + (lane >> 3), ch = lane & 7; const u32x4 v = *(const LAS u32x4*)(stg + row * 64 + ch * 8); *(u32x4*)(Ow + (long)row * opitch + ch * 8) = v; }
    asm volatile("s_waitcnt vmcnt(0) lgkmcnt(0)\n\ts_barrier" ::: "memory");
#undef DMA_K
#undef DMA_V
}

__device__ __forceinline__ void fox_unit(LAS char* shm, int b, int h, int qb, const bf16_t* proj, const float* fb, float fbias_h, bf16_t* heads) {
    const int tid = threadIdx.x, lane = tid & 63; const int wid = __builtin_amdgcn_readfirstlane(tid >> 6);
    LAS float* biasl = (LAS float*)(shm + A_BIAS); LAS float* scan = (LAS float*)(shm + A_SCAN);
    const int kend = (qb + 1) * 256;
    float v[4]; float s = 0.f;
#pragma unroll
    for (int i = 0; i < 4; ++i) { const int p = tid * 4 + i; float lf = 0.f; if (p < kend) lf = log_sigmoid_fast(fb[((size_t)b * SEQ + p) * 8 + h] + fbias_h); s += lf; v[i] = s; }
    float w = s;
#pragma unroll
    for (int o = 1; o < 64; o <<= 1) { const float t = __shfl_up(w, o); if (lane >= o) w += t; }
    if (lane == 63) scan[wid] = w;
    asm volatile("s_waitcnt lgkmcnt(0)\n\ts_barrier" ::: "memory");
    float off = w - s;
    for (int k = 0; k < 8; ++k) if (k < wid) off += scan[k];
#pragma unroll
    for (int i = 0; i < 4; ++i) biasl[tid * 4 + i] = -(v[i] + off) * LOG2E;
    asm volatile("s_waitcnt lgkmcnt(0)\n\ts_barrier" ::: "memory");
    const size_t rowb = (size_t)b * SEQ; const int q0 = qb * 256 + wid * 32;
    attn_tiles<false>(shm, proj + (rowb + q0) * NE_IN + 768 + h * 64, NE_IN, proj + rowb * NE_IN + 1280 + h * 64, proj + rowb * NE_IN + 1792 + h * 64, NE_IN,
                      heads + (rowb + q0) * 1024 + 512 + h * 64, 1024, 0, 4 * (qb + 1), q0, 0.f, 0.f);
}
__device__ __forceinline__ void swa_unit(LAS char* shm, int b, int kvh, int blk, const bf16_t* proj, const float* sinks, bf16_t* heads) {
    const int wid = __builtin_amdgcn_readfirstlane(threadIdx.x >> 6);
    const int qh = kvh * 4 + (wid >> 1), q0 = blk * 64 + (wid & 1) * 32;
    const size_t rowb = (size_t)b * SEQ;
    const int kt0 = blk >= 2 ? blk - 2 : 0, ntile = blk - kt0 + 1;
    const float sl2 = exp2f(-(float)(qh + 1)) * LOG2E, sink2 = sinks[qh] * LOG2E;
    attn_tiles<true>(shm, proj + (rowb + q0) * NE_IN + qh * 64, NE_IN, proj + rowb * NE_IN + 512 + kvh * 64, proj + rowb * NE_IN + 640 + kvh * 64, NE_IN,
                     heads + (rowb + q0) * 1024 + qh * 64, 1024, kt0, ntile, q0, sl2, sink2);
}
#undef A_WAIT_BAR
}

namespace attp {
using bf16=__hip_bfloat16;
using bf16x8=__attribute__((ext_vector_type(8)))short;
using s16x4=__attribute__((ext_vector_type(4)))short;
using f32x16=__attribute__((ext_vector_type(16)))float;
using u32x4=__attribute__((ext_vector_type(4)))unsigned;
constexpr int BATCH=8,NHEAD=8,SEQ=2048,D=64,DM=2560,OPITCH=1024;
constexpr int NW=8,QBLK=32,QB=QBLK*NW,KVBLK=64,NQB=SEQ/QB;
constexpr int ATTN_PITCH=DM, ATTN_UNIT_ROWS=QB;
__device__ __forceinline__ int crow(int r,int hi){return (r&3)+8*(r>>2)+4*hi;}
#define SBAR() __builtin_amdgcn_sched_barrier(0)
__device__ __forceinline__ void cmask(f32x16&p0,f32x16&p1,int jb,int qrel,int hi){
  const float NEG=-INFINITY; int kb=64*jb+4*hi;
  #pragma unroll
  for(int r=0;r<16;++r){int kv=kb+(r&3)+8*(r>>2); if(kv>qrel)p0[r]=NEG; if(kv+32>qrel)p1[r]=NEG;}
}

constexpr int NSLOT=3, SLOTB=8192;
constexpr int LDS_K=0, LDS_V=NSLOT*SLOTB, LDS_WS=2*NSLOT*SLOTB, LDS_OST=LDS_WS+NW*64*4, LDS_BIAS=LDS_OST+NW*4096, LDS_SCAN=LDS_BIAS+8192, LDS_BYTES=LDS_SCAN+64;
constexpr float C2=0.125f*1.4426950408889634f;
__device__ __forceinline__ void glds16(const void*gsrc,unsigned lds_dst){unsigned keep;
  asm volatile("s_mov_b32 %0, m0\n\ts_mov_b32 m0, %2\n\ts_nop 0\n\tglobal_load_lds_dwordx4 %1, off\n\ts_mov_b32 m0, %0":"=&s"(keep):"v"(gsrc),"s"(lds_dst):"memory");}
__device__ __forceinline__ float max3f(float a,float b,float c){float r;asm("v_max3_f32 %0, %1, %2, %3":"=v"(r):"v"(a),"v"(b),"v"(c));return r;}
__device__ __forceinline__ float max2f(float a,float b){float r;asm("v_max_f32_e32 %0, %1, %2":"=v"(r):"v"(a),"v"(b));return r;}
__device__ __forceinline__ float fadd_s(float a,float b){float r;asm("v_add_f32_e32 %0, %1, %2":"=v"(r):"v"(a),"v"(b));return r;}
__device__ __forceinline__ float fsub_s(float a,float b){float r;asm("v_sub_f32_e32 %0, %1, %2":"=v"(r):"v"(a),"v"(b));return r;}
typedef float f32x2_t __attribute__((ext_vector_type(2))); typedef __bf16 bf16x2_t __attribute__((ext_vector_type(2)));
__device__ __forceinline__ unsigned cvtpk_s(float lo,float hi){f32x2_t v={lo,hi};bf16x2_t b=__builtin_convertvector(v,bf16x2_t);return __builtin_bit_cast(unsigned,b);}
#define WAIT_BAR(N) asm volatile("s_waitcnt vmcnt(" #N ") lgkmcnt(0)\n\ts_barrier":::"memory")

__device__ __forceinline__ void qkt(f32x16&p0,f32x16&p1,const char*Kslot,const bf16x8*qr,int r32,int hi){ const f32x16 zc_=f32x16{};
  const char*kb=Kslot+hi*1024+r32*16;
  #pragma unroll
  for(int d0=0;d0<4;++d0){
    const bf16x8 b0=*reinterpret_cast<const bf16x8*>(kb+d0*2048);
    const bf16x8 b1=*reinterpret_cast<const bf16x8*>(kb+d0*2048+512);
    if(d0==0){p0=__builtin_amdgcn_mfma_f32_32x32x16_bf16(b0,qr[0],zc_,0,0,0);p1=__builtin_amdgcn_mfma_f32_32x32x16_bf16(b1,qr[0],zc_,0,0,0);}
    else{p0=__builtin_amdgcn_mfma_f32_32x32x16_bf16(b0,qr[d0],p0,0,0,0);p1=__builtin_amdgcn_mfma_f32_32x32x16_bf16(b1,qr[d0],p1,0,0,0);}}
}
typedef __attribute__((address_space(3))) const char* lds_cptr;
typedef short v4i16_t __attribute__((ext_vector_type(4)));
__device__ __forceinline__ void kload8(bf16x8*kf,lds_cptr kp){
  kf[0]=*(const __attribute__((address_space(3))) bf16x8*)(kp);      kf[1]=*(const __attribute__((address_space(3))) bf16x8*)(kp+512);
  kf[2]=*(const __attribute__((address_space(3))) bf16x8*)(kp+2048); kf[3]=*(const __attribute__((address_space(3))) bf16x8*)(kp+2560);
  kf[4]=*(const __attribute__((address_space(3))) bf16x8*)(kp+4096); kf[5]=*(const __attribute__((address_space(3))) bf16x8*)(kp+4608);
  kf[6]=*(const __attribute__((address_space(3))) bf16x8*)(kp+6144); kf[7]=*(const __attribute__((address_space(3))) bf16x8*)(kp+6656);
}
__device__ __forceinline__ void kload2(bf16x8*kf,lds_cptr kp,int j){ kf[2*j]=*(const __attribute__((address_space(3))) bf16x8*)(kp+j*2048); kf[2*j+1]=*(const __attribute__((address_space(3))) bf16x8*)(kp+j*2048+512); }
__device__ __forceinline__ s16x4 vtr(lds_cptr p){ return __builtin_bit_cast(s16x4,__builtin_amdgcn_ds_read_tr16_b64_v4i16((__attribute__((address_space(3))) v4i16_t*)p)); }
__device__ __forceinline__ float rowmax(const f32x16&p0,const f32x16&p1){
  float a=max3f(p0[0],p0[1],p1[0]),b=max3f(p0[2],p0[3],p1[1]);a=max3f(a,p1[2],p1[3]);
  #pragma unroll
  for(int r=4;r<16;r+=4){a=max3f(a,p0[r],p0[r+1]);b=max3f(b,p0[r+2],p0[r+3]);a=max3f(a,p1[r],p1[r+1]);b=max3f(b,p1[r+2],p1[r+3]);}
  const float m=max2f(a,b);
  auto rr=__builtin_amdgcn_permlane32_swap(__float_as_uint(m),__float_as_uint(m),false,false);
  return max2f(__uint_as_float(rr[0]),__uint_as_float(rr[1]));
}
__device__ __forceinline__ void pv(f32x16*o,int vb,bf16x8 pa0,bf16x8 pa1,bf16x8 pa2,bf16x8 pa3){
  #pragma unroll
  for(int d0=0;d0<2;++d0){s16x4 lo[4],hi[4];
    #pragma unroll
    for(int ks=0;ks<4;++ks){
      asm volatile("ds_read_b64_tr_b16 %0,%1 offset:%c2":"=&v"(lo[ks]):"v"(vb),"i"(d0*4096+ks*1024):"memory");
      asm volatile("ds_read_b64_tr_b16 %0,%1 offset:%c2":"=&v"(hi[ks]):"v"(vb),"i"(d0*4096+ks*1024+512):"memory");}
    asm volatile("s_waitcnt lgkmcnt(0)":::"memory");SBAR();
    #define PK(k) (bf16x8){lo[k][0],lo[k][1],lo[k][2],lo[k][3],hi[k][0],hi[k][1],hi[k][2],hi[k][3]}
    o[d0]=__builtin_amdgcn_mfma_f32_32x32x16_bf16(pa0,PK(0),o[d0],0,0,0);
    o[d0]=__builtin_amdgcn_mfma_f32_32x32x16_bf16(pa1,PK(1),o[d0],0,0,0);
    o[d0]=__builtin_amdgcn_mfma_f32_32x32x16_bf16(pa2,PK(2),o[d0],0,0,0);
    o[d0]=__builtin_amdgcn_mfma_f32_32x32x16_bf16(pa3,PK(3),o[d0],0,0,0);
    #undef PK
  }
}

#ifndef ATTN_STORE16
#define ATTN_STORE16(p,v) (*(u32x4*)(p)=(v))
#endif
template<int THRL,bool CHECK> __device__ __forceinline__ void attn_unit(int b,int h,int qb,const bf16*Q,const bf16*__restrict__ K,const bf16*__restrict__ V,bf16*O,char*shm,unsigned*mism){
  const int tid=threadIdx.x,lane=tid&63,r32=lane&31,hi=lane>>5; const int wid=__builtin_amdgcn_readfirstlane(tid>>6);
  const long rowbase=(long)b*SEQ; const int q0=qb*QB;
  const bf16*Qw=Q+(rowbase+q0+wid*QBLK)*DM+h*D;
  const bf16*Kh=K+rowbase*DM+h*D,*Vh=V+rowbase*DM+h*D;
  const unsigned lds0=(unsigned)(uintptr_t)shm;
  float*wsf=(float*)(shm+LDS_WS)+wid*64;
  const bf16*ksrc=Kh+(long)lane*DM+wid*8;
  const bf16*vsrc=Vh+(long)(16*(wid&3)+(lane>>2))*DM+(wid>>2)*32+(lane&3)*8;
  const unsigned kdst=lds0+LDS_K+wid*1024, vdst=lds0+LDS_V+wid*1024;
  #define DMA_K(t,slot) glds16(ksrc+(long)(t)*KVBLK*DM,(unsigned)__builtin_amdgcn_readfirstlane(kdst+(slot)))
  #define DMA_V(t,slot) glds16(vsrc+(long)(t)*KVBLK*DM,(unsigned)__builtin_amdgcn_readfirstlane(vdst+(slot)))
  const int vb0=(int)(lds0+LDS_V)+((lane>>4)&1)*32+(lane&3)*8+(4*hi+((lane&15)>>2))*64;
  const char*Kbase=shm+LDS_K; bf16x8 kf[8];
  const lds_cptr shm3=(lds_cptr)shm; const lds_cptr kp0=shm3+LDS_K+hi*1024+r32*16; const lds_cptr vp0=shm3+LDS_V+((lane>>4)&1)*32+(lane&3)*8+(4*hi+((lane&15)>>2))*64;
  const int NT=(q0+QB)/KVBLK;
  DMA_K(0,0);DMA_V(0,0);DMA_K(1,SLOTB);
  bf16x8 qr[4];
  #pragma unroll
  for(int d0=0;d0<4;++d0)qr[d0]=*reinterpret_cast<const bf16x8*>(&Qw[(long)r32*DM+d0*16+hi*8]);
  float mhat=0.f,l_reg=0.f;f32x16 o[2];o[0]=f32x16{};o[1]=f32x16{};u32x4 qaw={hi==0?0x3f803f80u:0u,0u,0u,0u};
  const int qrel=wid*QBLK+r32;
  #define CMASK(P0,P1,t) do{int jb_=(t)-(NT-4); if(jb_>=0)cmask(P0,P1,jb_,qrel,hi);}while(0)
  const __attribute__((address_space(3))) unsigned* biasw=(const __attribute__((address_space(3))) unsigned*)(shm3+LDS_BIAS)+r32;
  #define SETM() do{ const float nm_=-mhat; const unsigned h_=cvtpk_s(nm_,0.f)&0xffffu; const unsigned l_=cvtpk_s(nm_-__uint_as_float(h_<<16),0.f)&0xffffu; qaw[1]=(hi==0)?(h_|(l_<<16)):0u; }while(0)
  #define AUG(P0,P1,t) do{ const unsigned w0_=biasw[64*(t)], w1_=biasw[64*(t)+32]; const u32x4 ka0_={w0_,0x3f803f80u,0u,0u}, ka1_={w1_,0x3f803f80u,0u,0u}; \
      P0=__builtin_amdgcn_mfma_f32_32x32x16_bf16(__builtin_bit_cast(bf16x8,ka0_),__builtin_bit_cast(bf16x8,qaw),P0,0,0,0); \
      P1=__builtin_amdgcn_mfma_f32_32x32x16_bf16(__builtin_bit_cast(bf16x8,ka1_),__builtin_bit_cast(bf16x8,qaw),P1,0,0,0); }while(0)
  bool resc=false;
  #define START(P0,P1) do{ const float rm=rowmax(P0,P1); resc=false; \
    { const float dl=rm; mhat=fadd_s(mhat,dl); \
      _Pragma("unroll") for(int r=0;r<16;++r){P0[r]=fsub_s(P0[r],dl);P1[r]=fsub_s(P1[r],dl);} \
      SETM(); } \
    _Pragma("unroll") for(int r=0;r<16;++r)P0[r]=__builtin_amdgcn_exp2f(P0[r]); }while(0)
  #define RESC() do{ if(resc){ asm volatile("s_waitcnt lgkmcnt(0)":::"memory"); \
      _Pragma("unroll") for(int d_=0;d_<2;++d_) _Pragma("unroll") for(int r=0;r<16;++r)o[d_][r]*=wsf[crow(r,hi)]; } }while(0)
  f32x16 pA0,pA1,pB0,pB1;
  int sl_prev=0,sl_cur=0,sl_next=SLOTB;
  #define ROT() do{sl_prev=sl_cur;sl_cur=sl_next;sl_next=(sl_next==(NSLOT-1)*SLOTB)?0:sl_next+SLOTB;}while(0)
  DMA_K(2,2*SLOTB);
  WAIT_BAR(3);
  qkt(pA0,pA1,Kbase,qr,r32,hi);AUG(pA0,pA1,0);asm volatile("s_nop 15\n\ts_nop 7":"+v"(pA0),"+v"(pA1));CMASK(pA0,pA1,0);
  START(pA0,pA1);
  _Pragma("unroll") for(int r=0;r<16;++r)pA1[r]=__builtin_amdgcn_exp2f(pA1[r]);
  WAIT_BAR(0);
  DMA_K(3,0);DMA_V(1,SLOTB);
  ROT();
  kload8(kf,kp0+sl_cur);
  WAIT_BAR(2);
  s16x4 vlo[8],vhi[8]; u32x4 pw0,pw1,pw2,pw3; const f32x16 zc16=f32x16{};
  #define PKW(P,B) cvtpk_s(P[B],P[B+1])
  #define PAF(k) __builtin_bit_cast(bf16x8,pw##k)
  #define VFR(i) (bf16x8){vlo[i][0],vlo[i][1],vlo[i][2],vlo[i][3],vhi[i][0],vhi[i][1],vhi[i][2],vhi[i][3]}
  #define PIN(x) asm volatile("":"+v"(x))
  #define MX3(a,b,c) __builtin_fmaxf(__builtin_fmaxf((a),(b)),(c))
  #define GAPA(MF,A0,A1,A2,A3,W0,W1,PW) do{ MF; sacc+=A0; sacc+=A1; sacc+=A2; sacc+=A3; PIN(sacc); W0; W1; PIN(PW); SBAR(); }while(0)
  #define EX(v) __builtin_amdgcn_exp2f(v)
  #define GAPB(MF,X,B) do{ MF; X[B]=EX(X[B]); X[B+1]=EX(X[B+1]); X[B+2]=EX(X[B+2]); X[B+3]=EX(X[B+3]); PIN(X); SBAR(); }while(0)
  #define VRD(i) do{ vlo[i]=vtr(vp_+(((i)>>2)*4096+((i)&3)*1024)); vhi[i]=vtr(vp_+(((i)>>2)*4096+((i)&3)*1024+512)); }while(0)
  #define KRD(G,j) do{ if(G){ kload2(kf,kp0+sl_next,j); SBAR(); } }while(0)
  #define STEP(C0,C1,P0,P1,t,GK,GV,GL) do{ SBAR(); \
    const lds_cptr vp_=vp0+sl_prev; \
    VRD(0); SBAR(); float sacc=(P0[0]+P0[1]); \
    GAPA(C0=__builtin_amdgcn_mfma_f32_32x32x16_bf16(kf[0],qr[0],zc16,0,0,0), P0[2],P0[3],P0[4],P0[5],     pw0[0]=PKW(P0,0), pw0[1]=PKW(P0,2), pw0); \
    VRD(4); SBAR(); GAPA(C1=__builtin_amdgcn_mfma_f32_32x32x16_bf16(kf[1],qr[0],zc16,0,0,0), P0[6],P0[7],P0[8],P0[9],     pw0[2]=PKW(P0,4), pw0[3]=PKW(P0,6), pw0); \
    VRD(1); SBAR(); GAPA(C0=__builtin_amdgcn_mfma_f32_32x32x16_bf16(kf[2],qr[1],C0,0,0,0),   P0[10],P0[11],P0[12],P0[13], pw1[0]=PKW(P0,8), pw1[1]=PKW(P0,10), pw1); \
    VRD(5); SBAR(); GAPA(C1=__builtin_amdgcn_mfma_f32_32x32x16_bf16(kf[3],qr[1],C1,0,0,0),   P0[14],P0[15],P1[0],P1[1],   pw1[2]=PKW(P0,12),pw1[3]=PKW(P0,14), pw1); \
    VRD(2); SBAR(); GAPA(C0=__builtin_amdgcn_mfma_f32_32x32x16_bf16(kf[4],qr[2],C0,0,0,0),   P1[2],P1[3],P1[4],P1[5],     pw2[0]=PKW(P1,0), pw2[1]=PKW(P1,2), pw2); \
    VRD(6); SBAR(); GAPA(C1=__builtin_amdgcn_mfma_f32_32x32x16_bf16(kf[5],qr[2],C1,0,0,0),   P1[6],P1[7],P1[8],P1[9],     pw2[2]=PKW(P1,4), pw2[3]=PKW(P1,6), pw2); \
    VRD(3); SBAR(); GAPA(C0=__builtin_amdgcn_mfma_f32_32x32x16_bf16(kf[6],qr[3],C0,0,0,0),   P1[10],P1[11],P1[12],P1[13], pw3[0]=PKW(P1,8), pw3[1]=PKW(P1,10), pw3); \
    VRD(7); SBAR(); GAPA(C1=__builtin_amdgcn_mfma_f32_32x32x16_bf16(kf[7],qr[3],C1,0,0,0),   P1[14],P1[15],0.f,0.f,       pw3[2]=PKW(P1,12),pw3[3]=PKW(P1,14), pw3); \
    AUG(C0,C1,t); l_reg+=sacc; \
    if(GK){DMA_K((t)+3,sl_cur);} if(GV){DMA_V((t)+1,sl_next);} \
    CMASK(C0,C1,t); \
    { float a=MX3(C0[0],C0[1],C1[0]),b=MX3(C0[2],C0[3],C1[1]); a=MX3(a,C1[2],C1[3]); \
      _Pragma("unroll") for(int r=4;r<16;r+=4){a=MX3(a,C0[r],C0[r+1]);b=MX3(b,C0[r+2],C0[r+3]);a=MX3(a,C1[r],C1[r+1]);b=MX3(b,C1[r+2],C1[r+3]);} \
      float rm=__builtin_fmaxf(a,b); { auto rr=__builtin_amdgcn_permlane32_swap(__float_as_uint(rm),__float_as_uint(rm),false,false); rm=__builtin_fmaxf(__uint_as_float(rr[0]),__uint_as_float(rr[1])); } \
      resc=false; \
      if(__builtin_expect(__any(rm>(float)THRL),0)){ const float dl=__builtin_fmaxf(rm,0.f); mhat+=dl; \
        _Pragma("unroll") for(int r=0;r<16;++r){C0[r]-=dl;C1[r]-=dl;} \
        SETM(); \
        const float f=__builtin_amdgcn_exp2f(-dl); l_reg*=f; if(hi==0)wsf[r32]=f; resc=true; } } \
    SBAR(); \
    GAPB(o[0]=__builtin_amdgcn_mfma_f32_32x32x16_bf16(PAF(0),VFR(0),o[0],0,0,0), C0,0); \
    GAPB(o[1]=__builtin_amdgcn_mfma_f32_32x32x16_bf16(PAF(0),VFR(4),o[1],0,0,0), C0,4); \
    KRD(GL,0); GAPB(o[0]=__builtin_amdgcn_mfma_f32_32x32x16_bf16(PAF(1),VFR(1),o[0],0,0,0), C0,8); \
    KRD(GL,1); GAPB(o[1]=__builtin_amdgcn_mfma_f32_32x32x16_bf16(PAF(1),VFR(5),o[1],0,0,0), C0,12); \
    KRD(GL,2); GAPB(o[0]=__builtin_amdgcn_mfma_f32_32x32x16_bf16(PAF(2),VFR(2),o[0],0,0,0), C1,0); \
    KRD(GL,3); GAPB(o[1]=__builtin_amdgcn_mfma_f32_32x32x16_bf16(PAF(2),VFR(6),o[1],0,0,0), C1,4); \
    GAPB(o[0]=__builtin_amdgcn_mfma_f32_32x32x16_bf16(PAF(3),VFR(3),o[0],0,0,0), C1,8); \
    GAPB(o[1]=__builtin_amdgcn_mfma_f32_32x32x16_bf16(PAF(3),VFR(7),o[1],0,0,0), C1,12); \
    }while(0)
  int t=1;
  #undef CMASK
  #define CMASK(P0,P1,t) do{}while(0)
  for(;t+5<NT;t+=2){
    STEP(pB0,pB1,pA0,pA1,t,true,true,true);     WAIT_BAR(2); RESC(); ROT();
    STEP(pA0,pA1,pB0,pB1,t+1,true,true,true);   WAIT_BAR(2); RESC(); ROT();
  }
  #undef CMASK
  #define CMASK(P0,P1,t) do{int jb_=(t)-(NT-4); if(jb_>=0)cmask(P0,P1,jb_,qrel,hi);}while(0)
  #define ENDW(tt) do{ if((tt)+3<NT){WAIT_BAR(2);} else if((tt)+2<NT){WAIT_BAR(1);} else {WAIT_BAR(0);} }while(0)
  for(;t+1<NT;t+=2){
    STEP(pB0,pB1,pA0,pA1,t,(t+3<NT),(t+1<NT),(t+1<NT));       ENDW(t);   RESC(); ROT();
    STEP(pA0,pA1,pB0,pB1,t+1,(t+4<NT),(t+2<NT),(t+2<NT));     ENDW(t+1); RESC(); ROT();
  }
  STEP(pB0,pB1,pA0,pA1,NT-1,false,false,false); RESC();
  { float sacc=pB0[0]+pB0[1]; _Pragma("unroll") for(int r=2;r<16;++r)sacc+=pB0[r]; _Pragma("unroll") for(int r=0;r<16;++r)sacc+=pB1[r]; l_reg+=sacc;
    pw0=(u32x4){PKW(pB0,0),PKW(pB0,2),PKW(pB0,4),PKW(pB0,6)};pw1=(u32x4){PKW(pB0,8),PKW(pB0,10),PKW(pB0,12),PKW(pB0,14)};pw2=(u32x4){PKW(pB1,0),PKW(pB1,2),PKW(pB1,4),PKW(pB1,6)};pw3=(u32x4){PKW(pB1,8),PKW(pB1,10),PKW(pB1,12),PKW(pB1,14)};
    SBAR(); pv(o,vb0+sl_cur,PAF(0),PAF(1),PAF(2),PAF(3)); }
  #undef PKW
  #undef PAF
  #undef VFR
  #undef PIN
  #undef MX3
  #undef GAPA
  #undef GAPB
  #undef EX
  #undef VRD
  #undef KRD
  #undef STEP
  #undef ENDW
  {auto rr=__builtin_amdgcn_permlane32_swap(__float_as_uint(l_reg),__float_as_uint(l_reg),false,false);l_reg=__uint_as_float(rr[0])+__uint_as_float(rr[1]);}
  if(hi==0)wsf[32+r32]=l_reg;asm volatile("s_waitcnt lgkmcnt(0)":::"memory");
  float rli[16];
  #pragma unroll
  for(int r=0;r<16;++r)rli[r]=__builtin_amdgcn_rcpf(wsf[32+crow(r,hi)]);
  bf16*Ow=O+(rowbase+q0+wid*QBLK)*OPITCH+h*D;
  { bf16*stg=(bf16*)(shm+LDS_OST)+wid*2048;
    #pragma unroll
    for(int r=0;r<16;++r){const int orow=crow(r,hi);
      #pragma unroll
      for(int d0=0;d0<2;++d0)stg[orow*64+d0*32+r32]=__float2bfloat16(o[d0][r]*rli[r]);}
    asm volatile("s_waitcnt lgkmcnt(0)":::"memory");
    #pragma unroll
    for(int i=0;i<4;++i){const int row=i*8+(lane>>3),ch=lane&7; const u32x4 v=*(const u32x4*)(stg+row*64+ch*8); ATTN_STORE16(Ow+(long)row*OPITCH+ch*8,v);} }
  asm volatile("s_waitcnt lgkmcnt(0)\n\ts_barrier":::"memory");
  #undef DMA_K
  #undef DMA_V
  #undef CMASK
  #undef AUG
  #undef SETM
  #undef START
  #undef RESC
  #undef ROT
}
constexpr int ATTN_LDS_BYTES=LDS_BYTES;
#undef SBAR
#undef WAIT_BAR
}

namespace att {
template <bool CHECK> __device__ __forceinline__ void fox_unit_p(char* shm_g, LAS char* shm, int b, int h, int qb, const bf16_t* proj, const float* fb, float fbias_h, bf16_t* heads, unsigned* mism, bool do_scan) {
    const int tid = threadIdx.x, lane = tid & 63; const int wid = __builtin_amdgcn_readfirstlane(tid >> 6);
    if (do_scan) {
    LAS unsigned* biasw = (LAS unsigned*)(shm + attp::LDS_BIAS); LAS float* scan = (LAS float*)(shm + attp::LDS_SCAN);
    const int kend = (qb + 1) * 256;
    float v[4]; float s = 0.f;
#pragma unroll
    for (int i = 0; i < 4; ++i) { const int p = tid * 4 + i; float lf = 0.f; if (p < kend) lf = log_sigmoid_fast(fb[((size_t)b * SEQ + p) * 8 + h] + fbias_h); s += lf; v[i] = s; }
    float w = s;
#pragma unroll
    for (int o = 1; o < 64; o <<= 1) { const float t = __shfl_up(w, o); if (lane >= o) w += t; }
    if (lane == 63) scan[wid] = w;
    asm volatile("s_waitcnt lgkmcnt(0)\n\ts_barrier" ::: "memory");
    float off = w - s;
    for (int k = 0; k < 8; ++k) if (k < wid) off += scan[k];
#pragma unroll
    for (int i = 0; i < 4; ++i) { const float bv = -(v[i] + off) * LOG2E; const unsigned hb = cvt_pk_bf16(bv, 0.f) & 0xffffu; const unsigned lb = cvt_pk_bf16(bv - __uint_as_float(hb << 16), 0.f) & 0xffffu; biasw[tid * 4 + i] = hb | (lb << 16); }
    asm volatile("s_waitcnt vmcnt(0) lgkmcnt(0)\n\ts_barrier" ::: "memory");
    }
    attp::attn_unit<8, CHECK>(b, h, qb, (const attp::bf16*)(proj + 768), (const attp::bf16*)(proj + 1280), (const attp::bf16*)(proj + 1792), (attp::bf16*)(heads + 512), shm_g, mism);
    asm volatile("s_waitcnt vmcnt(0)" ::: "memory");
}
}
namespace mx {
using namespace mk;
constexpr size_t WS_QD = WS_XN, WS_KI = WS_XN + 16 * MiB, WS_DTV = 456 * MiB, WS_ACS = 457 * MiB, WS_KE = 458 * MiB, WS_DEC = 474 * MiB;
constexpr int XROW = 144;
__device__ __forceinline__ s16x4 tr_read(unsigned addr) { s16x4 r; asm volatile("ds_read_b64_tr_b16 %0, %1" : "=v"(r) : "v"(addr) : "memory"); return r; }
template <int OFF> __device__ __forceinline__ s16x4 tr_read_o(unsigned addr) { s16x4 r; asm volatile("ds_read_b64_tr_b16 %0, %1 offset:%2" : "=v"(r) : "v"(addr), "i"(OFF) : "memory"); return r; }
#define MX_LGKM0() do { asm volatile("s_waitcnt lgkmcnt(0)" ::: "memory"); __builtin_amdgcn_sched_barrier(0); } while (0)
#define MX_BAR() asm volatile("s_waitcnt vmcnt(0) lgkmcnt(0)\n\ts_barrier" ::: "memory")
#define MX_BAR_L() asm volatile("s_waitcnt lgkmcnt(0)\n\ts_barrier" ::: "memory")
__device__ __forceinline__ bf16x8 cat8(s16x4 lo, s16x4 hi) { return (bf16x8){lo[0], lo[1], lo[2], lo[3], hi[0], hi[1], hi[2], hi[3]}; }
__device__ __forceinline__ unsigned sw256(int row, int ch) { return (unsigned)(row * 256 + ((ch ^ (row & 15)) << 4)); }

__device__ __forceinline__ void prep_conv(const bf16_t* PROJ, bf16_t* CONV, const float* conv_w, const float* conv_b, int vcu, int G, int tid) {
    for (int item = vcu * NTHR + tid; item < (T / 16) * 192; item += G * NTHR) {
        const int cg = item % 192, rb = item / 192, ch0 = cg * 8, row0 = rb * 16, t0 = row0 & (SEQ - 1);
        float w[4][8], bs[8], xw[3][8];
#pragma unroll
        for (int j = 0; j < 4; ++j) { const f32x4 a = *(const f32x4*)(conv_w + j * 1536 + ch0), b = *(const f32x4*)(conv_w + j * 1536 + ch0 + 4);
#pragma unroll
            for (int i = 0; i < 4; ++i) { w[j][i] = a[i]; w[j][4 + i] = b[i]; } }
        { const f32x4 a = *(const f32x4*)(conv_b + ch0), b = *(const f32x4*)(conv_b + ch0 + 4);
#pragma unroll
          for (int i = 0; i < 4; ++i) { bs[i] = a[i]; bs[4 + i] = b[i]; } }
#pragma unroll
        for (int j = 0; j < 3; ++j) { const int tt = t0 - 3 + j;
            u32x4 v = {0u, 0u, 0u, 0u}; if (tt >= 0) v = *(const u32x4*)(PROJ + (size_t)(row0 - 3 + j) * NO_IN + 1024 + ch0);
#pragma unroll
            for (int i = 0; i < 4; ++i) { xw[j][2 * i] = __uint_as_float(v[i] << 16); xw[j][2 * i + 1] = __uint_as_float(v[i] & 0xffff0000u); } }
#pragma unroll 4
        for (int r = 0; r < 16; ++r) {
            const u32x4 v = __builtin_nontemporal_load((const u32x4*)(PROJ + (size_t)(row0 + r) * NO_IN + 1024 + ch0));
            float x3[8], o[8];
#pragma unroll
            for (int i = 0; i < 4; ++i) { x3[2 * i] = __uint_as_float(v[i] << 16); x3[2 * i + 1] = __uint_as_float(v[i] & 0xffff0000u); }
#pragma unroll
            for (int i = 0; i < 8; ++i) { const float a = bs[i] + w[0][i] * xw[0][i] + w[1][i] * xw[1][i] + w[2][i] * xw[2][i] + w[3][i] * x3[i]; o[i] = siluf(a);
                xw[0][i] = xw[1][i]; xw[1][i] = xw[2][i]; xw[2][i] = x3[i]; }
            u32x4 ov; ov.x = cvt_pk_bf16(o[0], o[1]); ov.y = cvt_pk_bf16(o[2], o[3]); ov.z = cvt_pk_bf16(o[4], o[5]); ov.w = cvt_pk_bf16(o[6], o[7]);
            *(u32x4*)(CONV + (size_t)(row0 + r) * 1536 + ch0) = ov;
        }
    }
}
__device__ __forceinline__ void prep_ssd(const float* DTG, float* DTV, float* ACS, const float* dt_bias, const float* a_log, int vcu, int G, int lane, int wave) {
    const int gw = vcu * NWAVES + wave, ngw = G * NWAVES;
    for (int item = gw; item < NBATCH * 32 * 16; item += ngw) {
        const int h = item & 15, c = (item >> 4) & 31, b = item >> 9; const size_t r0 = (size_t)b * SEQ + c * 64 + lane;
        const float a = -expf(a_log[h]), db = dt_bias[h];
        const float d0 = softplusf(DTG[r0 * 32 + h] + db);
        float w = a * d0;
#pragma unroll
        for (int o = 1; o < 64; o <<= 1) { const float t = __shfl_up(w, o); if (lane >= o) w += t; }
        ACS[r0 * 16 + h] = w; DTV[r0 * 16 + h] = d0;
    }
}
__device__ __forceinline__ void prep_gla(const bf16_t* PROJ, const float* DTG, bf16_t* QD, bf16_t* KI, bf16_t* KE, float* DEC, const float* gk_w, const float* gk_b, int vcu, int G, int tid, int lane, int wave, LAS char* shm) {
    {
        LAS float* gl = (LAS float*)(shm);
        LAS float* tot = (LAS float*)(shm + 8192);
        const int half = wave >> 2, rq = wave & 3, t256 = tid & 255;
        for (int pair = vcu; pair < NBATCH * 32 * 4 / 2; pair += G) {
            const int item = pair * 2 + half; const int h = item & 3, c = (item >> 2) & 31, b = item >> 7; const size_t r0 = (size_t)b * SEQ + c * 64;
            unsigned short qv[16][2], kv[16][2];
#pragma unroll
            for (int r = 0; r < 16; ++r) { const bf16_t* pr = PROJ + (r0 + rq * 16 + r) * NO_IN;
                qv[r][0] = pr[2560 + h * 128 + lane]; qv[r][1] = pr[2560 + h * 128 + 64 + lane]; kv[r][0] = pr[3072 + h * 128 + lane]; kv[r][1] = pr[3072 + h * 128 + 64 + lane]; }
            float w0[16], w1[16];
#pragma unroll
            for (int j = 0; j < 16; ++j) { w0[j] = gk_w[j * 512 + h * 128 + lane]; w1[j] = gk_w[j * 512 + h * 128 + 64 + lane]; }
            const float b0 = gk_b[h * 128 + lane], b1 = gk_b[h * 128 + 64 + lane];
            { const int rr = t256 >> 2, q4 = t256 & 3; *(LAS f32x4*)(gl + half * 1024 + rr * 16 + q4 * 4) = *(const f32x4*)(DTG + (r0 + rr) * 32 + 16 + q4 * 4); }
            asm volatile("s_waitcnt vmcnt(0) lgkmcnt(0)\n\ts_barrier" ::: "memory");
            float c0[16], c1[16]; float run0 = 0.f, run1 = 0.f;
#pragma unroll
            for (int r = 0; r < 16; ++r) {
                const LAS f32x4* gp = (const LAS f32x4*)(gl + half * 1024 + (rq * 16 + r) * 16); float a0 = b0, a1 = b1;
#pragma unroll
                for (int q = 0; q < 4; ++q) { const f32x4 g = gp[q];
#pragma unroll
                    for (int i = 0; i < 4; ++i) { a0 += g[i] * w0[4 * q + i]; a1 += g[i] * w1[4 * q + i]; } }
                run0 += log_sigmoid_fast(a0) * (1.f / 16.f); run1 += log_sigmoid_fast(a1) * (1.f / 16.f); c0[r] = run0; c1[r] = run1;
            }
            tot[(half * 4 + rq) * 128 + lane] = run0; tot[(half * 4 + rq) * 128 + 64 + lane] = run1;
            asm volatile("s_waitcnt lgkmcnt(0)\n\ts_barrier" ::: "memory");
            float pre0 = 0.f, pre1 = 0.f, last0 = 0.f, last1 = 0.f;
#pragma unroll
            for (int q = 0; q < 4; ++q) { const float t0 = tot[(half * 4 + q) * 128 + lane], t1 = tot[(half * 4 + q) * 128 + 64 + lane]; if (q < rq) { pre0 += t0; pre1 += t1; } last0 += t0; last1 += t1; }
            const float scale = 0.08838834764831845f;
#pragma unroll
            for (int r = 0; r < 16; ++r) {
                const float g0 = pre0 + c0[r], g1 = pre1 + c1[r];
                const float q0 = bf2f(qv[r][0]), q1 = bf2f(qv[r][1]), k0 = bf2f(kv[r][0]), k1 = bf2f(kv[r][1]);
                const size_t o = (r0 + rq * 16 + r) * 512 + h * 128 + lane;
                QD[o] = (bf16_t)(cvt_pk_bf16(q0 * scale * __expf(g0), 0.f) & 0xffffu); QD[o + 64] = (bf16_t)(cvt_pk_bf16(q1 * scale * __expf(g1), 0.f) & 0xffffu);
                KI[o] = (bf16_t)(cvt_pk_bf16(k0 * __expf(-g0), 0.f) & 0xffffu); KI[o + 64] = (bf16_t)(cvt_pk_bf16(k1 * __expf(-g1), 0.f) & 0xffffu);
            }
            if (rq == 0) { DEC[((size_t)b * 32 + c) * 512 + h * 128 + lane] = __expf(last0); DEC[((size_t)b * 32 + c) * 512 + h * 128 + 64 + lane] = __expf(last1); }
            asm volatile("s_waitcnt lgkmcnt(0)\n\ts_barrier" ::: "memory");
        }
    }
}

constexpr int S_C = 0, S_B = 32768, S_X = 65536, S_XW = S_X + 128 * XROW, S_PREV = S_XW + 128 * XROW, S_ACS = S_PREV + 16384, S_DT = S_ACS + 512, S_YST = S_DT + 512, S_END = S_YST + 8 * 2304;
static_assert(S_END <= RING_BYTES, "SSD LDS");
__device__ __forceinline__ void ssd_unit(LAS char* shm, int b, int h, const bf16_t* CONV, const float* ACS, const float* DTV, float dsk, bf16_t* MIX) {
    const int tid = threadIdx.x, lane = tid & 63, fr = lane & 15, fq = lane >> 4; const int w = __builtin_amdgcn_readfirstlane(tid >> 6);
    const int g = h >> 3, row = tid >> 2, qd = tid & 3, l0 = 16 * w;
    const unsigned lds0 = (unsigned)(uintptr_t)shm;
    LAS float* acsl = (LAS float*)(shm + S_ACS); LAS float* dtl = (LAS float*)(shm + S_DT);
    f32x4 st[4];
#pragma unroll
    for (int i = 0; i < 4; ++i) st[i] = (f32x4){0.f, 0.f, 0.f, 0.f};
    u32x4 rc[4], rb[4], rx[2]; float racs, rdt, rend;
    const size_t seq0 = (size_t)b * SEQ;
#define SSD_LOAD(c) do { const size_t gr = seq0 + (size_t)(c) * 128 + row; const bf16_t* p = CONV + gr * 1536; \
        _Pragma("unroll") for (int i = 0; i < 4; ++i) { rc[i] = *(const u32x4*)(p + 1280 + g * 128 + qd * 32 + 8 * i); rb[i] = *(const u32x4*)(p + 1024 + g * 128 + qd * 32 + 8 * i); } \
        _Pragma("unroll") for (int i = 0; i < 2; ++i) rx[i] = *(const u32x4*)(p + h * 64 + qd * 16 + 8 * i); \
        racs = ACS[gr * 16 + h]; rdt = DTV[gr * 16 + h]; rend = ACS[(seq0 + (size_t)(c) * 128 + 127) * 16 + h]; } while (0)
#ifdef SSD_DUMMY
    SSD_LOAD(0);
    for (int c = 0; c < 16; ++c) {
#pragma unroll
        for (int i = 0; i < 4; ++i) { *(LAS u32x4*)(shm + S_C + sw256(row, qd * 4 + i)) = rc[i]; *(LAS u32x4*)(shm + S_B + sw256(row, qd * 4 + i)) = rb[i]; }
        const float wr = rdt * __expf(rend - racs);
#pragma unroll
        for (int i = 0; i < 2; ++i) { *(LAS u32x4*)(shm + S_X + row * XROW + qd * 32 + 16 * i) = rx[i];
            u32x4 o;
#pragma unroll
            for (int k = 0; k < 4; ++k) o[k] = cvt_pk_bf16(__uint_as_float(rx[i][k] << 16) * wr, __uint_as_float(rx[i][k] & 0xffff0000u) * wr);
            *(LAS u32x4*)(shm + S_XW + row * XROW + qd * 32 + 16 * i) = o; }
        if (qd == 0) { acsl[row] = racs; dtl[row] = rdt; }
        MX_BAR_L();
        if (c + 1 < 16) SSD_LOAD(c + 1);
        MX_BAR_L();
    }
#endif
#ifndef SSD_NOPREF
    SSD_LOAD(0);
#endif
    const unsigned xtr = lds0 + (unsigned)(((lane & 15) >> 2) * XROW + (lane & 3) * 8);
    for (int c = 0; c < 16; ++c) {
#ifdef SSD_NOPREF
        SSD_LOAD(c);
#endif
#ifdef SSD_REP_WR
        for (int rep_ = 0; rep_ < 2; ++rep_)
#endif
        {
#pragma unroll
            for (int i = 0; i < 4; ++i) { *(LAS u32x4*)(shm + S_C + sw256(row, qd * 4 + i)) = rc[i]; *(LAS u32x4*)(shm + S_B + sw256(row, qd * 4 + i)) = rb[i]; }
            const float wr = rdt * __expf(rend - racs);
#pragma unroll
            for (int i = 0; i < 2; ++i) { *(LAS u32x4*)(shm + S_X + row * XROW + qd * 32 + 16 * i) = rx[i];
                u32x4 o;
#pragma unroll
                for (int k = 0; k < 4; ++k) o[k] = cvt_pk_bf16(__uint_as_float(rx[i][k] << 16) * wr, __uint_as_float(rx[i][k] & 0xffff0000u) * wr);
                *(LAS u32x4*)(shm + S_XW + row * XROW + qd * 32 + 16 * i) = o; }
            if (qd == 0) { acsl[row] = racs; dtl[row] = rdt; }
#pragma unroll
            for (int pt = 0; pt < 4; ++pt) { u32x2 v; v.x = cvt_pk_bf16(st[pt][0], st[pt][1]); v.y = cvt_pk_bf16(st[pt][2], st[pt][3]);
                const int p = 16 * pt + fr; *(LAS u32x2*)(shm + S_PREV + sw256(p, 2 * w + (fq >> 1)) + (fq & 1) * 8) = v; }
        }
        MX_BAR_L();
#ifndef SSD_NOPREF
        if (c + 1 < 16) SSD_LOAD(c + 1);
#endif
        bf16x8 cf[4];
#pragma unroll
        for (int ks = 0; ks < 4; ++ks) cf[ks] = *(const LAS bf16x8*)(shm + S_C + sw256(l0 + fr, 4 * ks + fq));
        f32x4 yd[4], yo[4];
#pragma unroll
        for (int i = 0; i < 4; ++i) { yd[i] = (f32x4){0.f, 0.f, 0.f, 0.f}; yo[i] = (f32x4){0.f, 0.f, 0.f, 0.f}; }
        const float acs_l = acsl[l0 + fr]; const int lcol = l0 + fr;
        const int nsb = (w >> 1) + 1;
#ifdef SSD_REP_SB
        for (int rep_ = 0; rep_ < 2; ++rep_) {
#pragma unroll
        for (int i = 0; i < 4; ++i) yd[i] = (f32x4){0.f, 0.f, 0.f, 0.f};
#endif
        for (int sb = 0; sb < nsb; ++sb) {
            const int s0 = 32 * sb; const bool two = (2 * sb + 1) <= w;
            s16x4 lo[4], hi[4];
#pragma unroll
            for (int pt = 0; pt < 4; ++pt) { lo[pt] = tr_read(xtr + S_X + (unsigned)((s0 + 4 * fq) * XROW + pt * 32)); hi[pt] = tr_read(xtr + S_X + (unsigned)((s0 + 16 + 4 * fq) * XROW + pt * 32)); }
            f32x4 a0 = {0.f, 0.f, 0.f, 0.f}, a1 = {0.f, 0.f, 0.f, 0.f};
#pragma unroll
            for (int ks = 0; ks < 4; ++ks) { const bf16x8 bf = *(const LAS bf16x8*)(shm + S_B + sw256(s0 + fr, 4 * ks + fq)); a0 = __builtin_amdgcn_mfma_f32_16x16x32_bf16(bf, cf[ks], a0, 0, 0, 0); }
            if (two) {
#pragma unroll
                for (int ks = 0; ks < 4; ++ks) { const bf16x8 bf = *(const LAS bf16x8*)(shm + S_B + sw256(s0 + 16 + fr, 4 * ks + fq)); a1 = __builtin_amdgcn_mfma_f32_16x16x32_bf16(bf, cf[ks], a1, 0, 0, 0); }
            }
            const f32x4 as0 = *(const LAS f32x4*)(acsl + s0 + 4 * fq), as1 = *(const LAS f32x4*)(acsl + s0 + 16 + 4 * fq);
            const f32x4 dq0 = *(const LAS f32x4*)(dtl + s0 + 4 * fq), dq1 = *(const LAS f32x4*)(dtl + s0 + 16 + 4 * fq);
            float g0[4], g1[4];
#pragma unroll
            for (int i = 0; i < 4; ++i) { const int sa = s0 + 4 * fq + i, sb2 = sa + 16;
                g0[i] = (sa <= lcol) ? a0[i] * __expf(fminf(acs_l - as0[i], 0.f)) * dq0[i] : 0.f;
                g1[i] = (two && sb2 <= lcol) ? a1[i] * __expf(fminf(acs_l - as1[i], 0.f)) * dq1[i] : 0.f; }
            u32x4 ap; ap.x = cvt_pk_bf16(g0[0], g0[1]); ap.y = cvt_pk_bf16(g0[2], g0[3]); ap.z = cvt_pk_bf16(g1[0], g1[1]); ap.w = cvt_pk_bf16(g1[2], g1[3]);
            const bf16x8 af = __builtin_bit_cast(bf16x8, ap);
            MX_LGKM0();
#pragma unroll
            for (int pt = 0; pt < 4; ++pt) yd[pt] = __builtin_amdgcn_mfma_f32_16x16x32_bf16(af, cat8(lo[pt], hi[pt]), yd[pt], 0, 0, 0);
        }
#ifdef SSD_REP_SB
        }
#endif
#ifdef SSD_REP_YO
        for (int rep_ = 0; rep_ < 2; ++rep_) {
#pragma unroll
        for (int i = 0; i < 4; ++i) yo[i] = (f32x4){0.f, 0.f, 0.f, 0.f};
#endif
#pragma unroll
        for (int pt = 0; pt < 4; ++pt)
#pragma unroll
            for (int ks = 0; ks < 4; ++ks) { const bf16x8 pf = *(const LAS bf16x8*)(shm + S_PREV + sw256(16 * pt + fr, 4 * ks + fq)); yo[pt] = __builtin_amdgcn_mfma_f32_16x16x32_bf16(cf[ks], pf, yo[pt], 0, 0, 0); }
#ifdef SSD_REP_YO
        }
#endif
#ifdef SSD_REP_CS
        for (int rep_ = 0; rep_ < 2; ++rep_)
#endif
        {
            const f32x4 al = *(const LAS f32x4*)(acsl + l0 + 4 * fq);
            float ea[4];
#pragma unroll
            for (int i = 0; i < 4; ++i) ea[i] = __expf(al[i]);
            s16x4 xs[4];
#pragma unroll
            for (int pt = 0; pt < 4; ++pt) xs[pt] = tr_read(xtr + S_X + (unsigned)((l0 + 4 * fq) * XROW + pt * 32));
            MX_LGKM0();
            LAS bf16_t* yst = (LAS bf16_t*)(shm + S_YST + w * 2304);
#pragma unroll
            for (int pt = 0; pt < 4; ++pt)
#pragma unroll
                for (int i = 0; i < 4; ++i) { const float y = yd[pt][i] + ea[i] * yo[pt][i] + dsk * bf2f((unsigned short)xs[pt][i]);
                    yst[(4 * fq + i) * 72 + pt * 16 + fr] = (bf16_t)(cvt_pk_bf16(y, 0.f) & 0xffffu); }
            asm volatile("s_waitcnt lgkmcnt(0)" ::: "memory");
            bf16_t* yp = MIX + (seq0 + (size_t)c * 128 + l0) * 2048 + h * 64;
#pragma unroll
            for (int j = 0; j < 2; ++j) { const int rr = (lane >> 3) + 8 * j, ch = lane & 7; const u32x4 v = *(const LAS u32x4*)(yst + rr * 72 + ch * 8); *(u32x4*)(yp + (size_t)rr * 2048 + ch * 8) = v; }
        }
#ifdef SSD_REP_ST
        f32x4 stsave[4];
#pragma unroll
        for (int i = 0; i < 4; ++i) stsave[i] = st[i];
        for (int rep_ = 0; rep_ < 2; ++rep_) {
#pragma unroll
        for (int i = 0; i < 4; ++i) st[i] = stsave[i];
#endif
        {
            const float cd = __expf(acsl[127]);
#pragma unroll
            for (int pt = 0; pt < 4; ++pt) st[pt] = st[pt] * cd;
#pragma unroll
            for (int ks = 0; ks < 4; ++ks) {
                const int s0 = 32 * ks, q = (lane & 15) >> 2, p = lane & 3;
                const int r1 = s0 + 8 * fq + q, r2 = r1 + 4;
                const s16x4 alo = tr_read(lds0 + S_B + sw256(r1, 2 * w + (p >> 1)) + (p & 1) * 8), ahi = tr_read(lds0 + S_B + sw256(r2, 2 * w + (p >> 1)) + (p & 1) * 8);
                s16x4 lo[4], hi[4];
#pragma unroll
                for (int pt = 0; pt < 4; ++pt) { lo[pt] = tr_read(xtr + S_XW + (unsigned)((s0 + 8 * fq) * XROW + pt * 32)); hi[pt] = tr_read(xtr + S_XW + (unsigned)((s0 + 8 * fq + 4) * XROW + pt * 32)); }
                MX_LGKM0();
                const bf16x8 af = cat8(alo, ahi);
#pragma unroll
                for (int pt = 0; pt < 4; ++pt) st[pt] = __builtin_amdgcn_mfma_f32_16x16x32_bf16(af, cat8(lo[pt], hi[pt]), st[pt], 0, 0, 0);
            }
        }
#ifdef SSD_REP_ST
        }
#endif
        MX_BAR_L();
    }
    asm volatile("s_waitcnt vmcnt(0)" ::: "memory");
#undef SSD_LOAD
}

constexpr int S2_C = 0, S2_B = 16384, S2_X = 32768, S2_XW = S2_X + 64 * XROW, S2_ACS = S2_XW + 64 * XROW, S2_DT = S2_ACS + 256, S2_BUF = 53248, S2_PREV = 2 * S2_BUF, S2_END = S2_PREV + 2 * 16384;
static_assert(S2_DT + 256 <= S2_BUF && S2_END <= RING_BYTES, "SSD64 LDS");
__device__ __forceinline__ void ssd_unit64(LAS char* shm, int b, int h, const bf16_t* CONV, const float* ACS, const float* DTV, float dsk, bf16_t* MIX) {
    const int tid = threadIdx.x, lane = tid & 63, fr = lane & 15, fq = lane >> 4; const int w = __builtin_amdgcn_readfirstlane(tid >> 6);
    const int g = h >> 3, row = tid >> 3, ec = tid & 7, lt = w >> 1, l0 = 16 * lt, pt0 = 2 * (w & 1);
    const unsigned lds0 = (unsigned)(uintptr_t)shm;
    f32x4 st[4];
#pragma unroll
    for (int i = 0; i < 4; ++i) st[i] = (f32x4){0.f, 0.f, 0.f, 0.f};
    u32x4 rc[2], rb[2], rx; float racs, rdt, rend;
    const size_t seq0 = (size_t)b * SEQ;
#define S2_LOAD(c) do { const size_t gr = seq0 + (size_t)(c) * 64 + row; const bf16_t* p = CONV + gr * 1536; \
        _Pragma("unroll") for (int i = 0; i < 2; ++i) { rc[i] = *(const u32x4*)(p + 1280 + g * 128 + ec * 16 + 8 * i); rb[i] = *(const u32x4*)(p + 1024 + g * 128 + ec * 16 + 8 * i); } \
        rx = *(const u32x4*)(p + h * 64 + ec * 8); \
        racs = ACS[gr * 16 + h]; rdt = DTV[gr * 16 + h]; rend = ACS[(seq0 + (size_t)(c) * 64 + 63) * 16 + h]; } while (0)
#define S2_WRITE(pb) do { LAS char* gb_ = shm + (pb) * S2_BUF; \
        _Pragma("unroll") for (int i = 0; i < 2; ++i) { *(LAS u32x4*)(gb_ + S2_C + sw256(row, ec * 2 + i)) = rc[i]; *(LAS u32x4*)(gb_ + S2_B + sw256(row, ec * 2 + i)) = rb[i]; } \
        *(LAS u32x4*)(gb_ + S2_X + row * XROW + ec * 16) = rx; \
        { const float wr_ = rdt * __expf(rend - racs); u32x4 o_; \
          _Pragma("unroll") for (int k = 0; k < 4; ++k) o_[k] = cvt_pk_bf16(__uint_as_float(rx[k] << 16) * wr_, __uint_as_float(rx[k] & 0xffff0000u) * wr_); \
          *(LAS u32x4*)(gb_ + S2_XW + row * XROW + ec * 16) = o_; } \
        if (ec == 0) { ((LAS float*)(gb_ + S2_ACS))[row] = racs; ((LAS float*)(gb_ + S2_DT))[row] = rdt; } \
        _Pragma("unroll") for (int pt = 0; pt < 4; ++pt) { u32x2 v; v.x = cvt_pk_bf16(st[pt][0], st[pt][1]); v.y = cvt_pk_bf16(st[pt][2], st[pt][3]); \
            const int p_ = 16 * pt + fr; *(LAS u32x2*)(shm + S2_PREV + (pb) * 16384 + sw256(p_, 2 * w + (fq >> 1)) + (fq & 1) * 8) = v; } } while (0)
    S2_LOAD(0);
    S2_WRITE(0);
    MX_BAR_L();
    unsigned swz[4];
#pragma unroll
    for (int ks = 0; ks < 4; ++ks) swz[ks] = (unsigned)(fr * 256 + (((4 * ks + fq) ^ fr) << 4));
    const int q_ = (lane & 15) >> 2, p_ = lane & 3;
    const unsigned xq4 = (unsigned)((4 * fq + q_) * XROW + p_ * 8), xq8 = (unsigned)((8 * fq + q_) * XROW + p_ * 8);
    const int ra = 8 * fq + q_, rb2 = ra + 4;
    const unsigned bt1 = (unsigned)(ra * 256 + (((2 * w + (p_ >> 1)) ^ (ra & 15)) << 4) + (p_ & 1) * 8), bt2 = (unsigned)(rb2 * 256 + (((2 * w + (p_ >> 1)) ^ (rb2 & 15)) << 4) + (p_ & 1) * 8);
    for (int c = 0; c < 32; ++c) {
        const int pb = c & 1; LAS char* gb = shm + pb * S2_BUF; const unsigned gba = lds0 + (unsigned)(pb * S2_BUF);
        const LAS float* acsl = (const LAS float*)(gb + S2_ACS); const LAS float* dtl = (const LAS float*)(gb + S2_DT);
        if (c + 1 < 32) S2_LOAD(c + 1);
        const LAS char* cbp[4]; const LAS char* pvp[4];
#pragma unroll
        for (int ks = 0; ks < 4; ++ks) { cbp[ks] = gb + swz[ks]; pvp[ks] = shm + S2_PREV + pb * 16384 + pt0 * 4096 + swz[ks]; }
        const unsigned xa4 = gba + xq4 + (unsigned)(pt0 * 32), xa8 = gba + xq8, ba1 = gba + bt1, ba2 = gba + bt2;
        bf16x8 cf[4];
#pragma unroll
        for (int ks = 0; ks < 4; ++ks) cf[ks] = *(const LAS bf16x8*)(cbp[ks] + S2_C + l0 * 256);
        f32x4 yd[2], yo[2];
#pragma unroll
        for (int i = 0; i < 2; ++i) { yd[i] = (f32x4){0.f, 0.f, 0.f, 0.f}; yo[i] = (f32x4){0.f, 0.f, 0.f, 0.f}; }
        const float acs_l = acsl[l0 + fr]; const int lcol = l0 + fr;
#pragma unroll
        for (int sb = 0; sb < 2; ++sb) if (2 * sb <= lt) {
            constexpr int dummy = 0; (void)dummy;
            const int s0 = 32 * sb; const bool two = (2 * sb + 1) <= lt;
            s16x4 lo[2], hi[2];
            if (sb == 0) { lo[0] = tr_read_o<S2_X>(xa4); lo[1] = tr_read_o<S2_X + 32>(xa4); hi[0] = tr_read_o<S2_X + 16 * XROW>(xa4); hi[1] = tr_read_o<S2_X + 16 * XROW + 32>(xa4); }
            else         { lo[0] = tr_read_o<S2_X + 32 * XROW>(xa4); lo[1] = tr_read_o<S2_X + 32 * XROW + 32>(xa4); hi[0] = tr_read_o<S2_X + 48 * XROW>(xa4); hi[1] = tr_read_o<S2_X + 48 * XROW + 32>(xa4); }
            f32x4 a0 = {0.f, 0.f, 0.f, 0.f}, a1 = {0.f, 0.f, 0.f, 0.f};
#pragma unroll
            for (int ks = 0; ks < 4; ++ks) { const bf16x8 bf = *(const LAS bf16x8*)(cbp[ks] + S2_B + s0 * 256); a0 = __builtin_amdgcn_mfma_f32_16x16x32_bf16(bf, cf[ks], a0, 0, 0, 0); }
            if (two) {
#pragma unroll
                for (int ks = 0; ks < 4; ++ks) { const bf16x8 bf = *(const LAS bf16x8*)(cbp[ks] + S2_B + (s0 + 16) * 256); a1 = __builtin_amdgcn_mfma_f32_16x16x32_bf16(bf, cf[ks], a1, 0, 0, 0); }
            }
            const f32x4 as0 = *(const LAS f32x4*)(acsl + s0 + 4 * fq), as1 = *(const LAS f32x4*)(acsl + s0 + 16 + 4 * fq);
            const f32x4 dq0 = *(const LAS f32x4*)(dtl + s0 + 4 * fq), dq1 = *(const LAS f32x4*)(dtl + s0 + 16 + 4 * fq);
            float g0[4], g1[4];
#pragma unroll
            for (int i = 0; i < 4; ++i) { g0[i] = a0[i] * __expf(acs_l - as0[i]) * dq0[i]; g1[i] = a1[i] * __expf(acs_l - as1[i]) * dq1[i]; }
            if (2 * sb == lt) {
#pragma unroll
                for (int i = 0; i < 4; ++i) { if (s0 + 4 * fq + i > lcol) g0[i] = 0.f; }
            }
            if (!two) {
#pragma unroll
                for (int i = 0; i < 4; ++i) g1[i] = 0.f;
            } else if (2 * sb + 1 == lt) {
#pragma unroll
                for (int i = 0; i < 4; ++i) { if (s0 + 16 + 4 * fq + i > lcol) g1[i] = 0.f; }
            }
            u32x4 ap; ap.x = cvt_pk_bf16(g0[0], g0[1]); ap.y = cvt_pk_bf16(g0[2], g0[3]); ap.z = cvt_pk_bf16(g1[0], g1[1]); ap.w = cvt_pk_bf16(g1[2], g1[3]);
            const bf16x8 af = __builtin_bit_cast(bf16x8, ap);
            MX_LGKM0();
#pragma unroll
            for (int vi = 0; vi < 2; ++vi) yd[vi] = __builtin_amdgcn_mfma_f32_16x16x32_bf16(af, cat8(lo[vi], hi[vi]), yd[vi], 0, 0, 0);
        }
#pragma unroll
        for (int vi = 0; vi < 2; ++vi)
#pragma unroll
            for (int ks = 0; ks < 4; ++ks) { const bf16x8 pf = *(const LAS bf16x8*)(pvp[ks] + vi * 4096); yo[vi] = __builtin_amdgcn_mfma_f32_16x16x32_bf16(cf[ks], pf, yo[vi], 0, 0, 0); }
        {
            const f32x4 al = *(const LAS f32x4*)(acsl + l0 + 4 * fq);
            float ea[4];
#pragma unroll
            for (int i = 0; i < 4; ++i) ea[i] = __expf(al[i]);
            const unsigned xl = xa4 + (unsigned)(l0 * XROW);
            s16x4 xs[2]; xs[0] = tr_read_o<S2_X>(xl); xs[1] = tr_read_o<S2_X + 32>(xl);
            MX_LGKM0();
            bf16_t* yp = MIX + (seq0 + (size_t)c * 64 + l0 + 4 * fq) * 2048 + h * 64 + pt0 * 16 + fr;
#pragma unroll
            for (int vi = 0; vi < 2; ++vi)
#pragma unroll
                for (int i = 0; i < 4; ++i) { const float y = yd[vi][i] + ea[i] * yo[vi][i] + dsk * bf2f((unsigned short)xs[vi][i]);
                    yp[(size_t)i * 2048 + vi * 16] = (bf16_t)(cvt_pk_bf16(y, 0.f) & 0xffffu); }
        }
        {
            const float cd = __expf(acsl[63]);
#pragma unroll
            for (int pt = 0; pt < 4; ++pt) st[pt] = st[pt] * cd;
            {   s16x4 lo[4], hi[4];
                const s16x4 alo = tr_read_o<S2_B>(ba1), ahi = tr_read_o<S2_B>(ba2);
                lo[0] = tr_read_o<S2_XW>(xa8); lo[1] = tr_read_o<S2_XW + 32>(xa8); lo[2] = tr_read_o<S2_XW + 64>(xa8); lo[3] = tr_read_o<S2_XW + 96>(xa8);
                hi[0] = tr_read_o<S2_XW + 4 * XROW>(xa8); hi[1] = tr_read_o<S2_XW + 4 * XROW + 32>(xa8); hi[2] = tr_read_o<S2_XW + 4 * XROW + 64>(xa8); hi[3] = tr_read_o<S2_XW + 4 * XROW + 96>(xa8);
                MX_LGKM0();
                const bf16x8 af = cat8(alo, ahi);
#pragma unroll
                for (int pt = 0; pt < 4; ++pt) st[pt] = __builtin_amdgcn_mfma_f32_16x16x32_bf16(af, cat8(lo[pt], hi[pt]), st[pt], 0, 0, 0); }
            {   s16x4 lo[4], hi[4];
                const s16x4 alo = tr_read_o<S2_B + 32 * 256>(ba1), ahi = tr_read_o<S2_B + 32 * 256>(ba2);
                lo[0] = tr_read_o<S2_XW + 32 * XROW>(xa8); lo[1] = tr_read_o<S2_XW + 32 * XROW + 32>(xa8); lo[2] = tr_read_o<S2_XW + 32 * XROW + 64>(xa8); lo[3] = tr_read_o<S2_XW + 32 * XROW + 96>(xa8);
                hi[0] = tr_read_o<S2_XW + 36 * XROW>(xa8); hi[1] = tr_read_o<S2_XW + 36 * XROW + 32>(xa8); hi[2] = tr_read_o<S2_XW + 36 * XROW + 64>(xa8); hi[3] = tr_read_o<S2_XW + 36 * XROW + 96>(xa8);
                MX_LGKM0();
                const bf16x8 af = cat8(alo, ahi);
#pragma unroll
                for (int pt = 0; pt < 4; ++pt) st[pt] = __builtin_amdgcn_mfma_f32_16x16x32_bf16(af, cat8(lo[pt], hi[pt]), st[pt], 0, 0, 0); }
        }
        if (c + 1 < 32) S2_WRITE(pb ^ 1);
        MX_BAR_L();
    }
    asm volatile("s_waitcnt vmcnt(0)" ::: "memory");
#undef S2_LOAD
#undef S2_WRITE
}

constexpr int G_QD = 0, G_KI = 16384, G_V = 32768, G_DEC = G_V + 64 * XROW, G_BUF = 45056, G_SP = 2 * G_BUF, G_END = G_SP + 2 * 16384;
static_assert(G_DEC + 512 <= G_BUF && G_END <= RING_BYTES, "GLA LDS");
template <bool CHECK> __device__ __forceinline__ void gla_unit(LAS char* shm, int b, int h, int vs, const bf16_t* PROJ, const bf16_t* QD, const bf16_t* KI, const float* DEC, bf16_t* MIX, unsigned* mismatch) {
    const int tid = threadIdx.x, lane = tid & 63, fr = lane & 15, fq = lane >> 4; const int w = __builtin_amdgcn_readfirstlane(tid >> 6);
    const int row = tid >> 3, ec = tid & 7, lt = w >> 1, l0 = 16 * lt, vt0 = 2 * (w & 1);
    const unsigned lds0 = (unsigned)(uintptr_t)shm;
    f32x4 st[4];
#pragma unroll
    for (int i = 0; i < 4; ++i) st[i] = (f32x4){0.f, 0.f, 0.f, 0.f};
    u32x4 rq[2], rk[2], rv; float rdec = 0.f;
    const size_t seq0 = (size_t)b * SEQ;
#define GLA_LOAD(c) do { const size_t gr = seq0 + (size_t)(c) * 64 + row; const size_t o = gr * 512 + h * 128 + ec * 16; \
        _Pragma("unroll") for (int i = 0; i < 2; ++i) { rq[i] = *(const u32x4*)(QD + o + 8 * i); rk[i] = *(const u32x4*)(KI + o + 8 * i); } \
        rv = *(const u32x4*)(PROJ + gr * NO_IN + 3584 + h * 256 + vs * 64 + ec * 8); \
        if (tid < 128) rdec = DEC[((size_t)b * 32 + (c)) * 512 + h * 128 + tid]; } while (0)
#define GLA_WRITE(pb) do { LAS char* gb_ = shm + (pb) * G_BUF; \
        _Pragma("unroll") for (int i = 0; i < 2; ++i) { *(LAS u32x4*)(gb_ + G_QD + sw256(row, ec * 2 + i)) = rq[i]; *(LAS u32x4*)(gb_ + G_KI + sw256(row, ec * 2 + i)) = rk[i]; } \
        *(LAS u32x4*)(gb_ + G_V + row * XROW + ec * 16) = rv; \
        if (tid < 128) ((LAS float*)(gb_ + G_DEC))[tid] = rdec; \
        _Pragma("unroll") for (int vt = 0; vt < 4; ++vt) { u32x2 v; v.x = cvt_pk_bf16(st[vt][0], st[vt][1]); v.y = cvt_pk_bf16(st[vt][2], st[vt][3]); \
            const int vv = 16 * vt + fr; *(LAS u32x2*)(shm + G_SP + (pb) * 16384 + sw256(vv, 2 * w + (fq >> 1)) + (fq & 1) * 8) = v; } } while (0)
    GLA_LOAD(0);
    GLA_WRITE(0);
    MX_BAR_L();
    const unsigned xtr = lds0 + (unsigned)(((lane & 15) >> 2) * XROW + (lane & 3) * 8);
    for (int c = 0; c < 32; ++c) {
        const int pb = c & 1; LAS char* gb = shm + pb * G_BUF; const unsigned gbo = (unsigned)(pb * G_BUF); LAS char* sp = shm + G_SP + pb * 16384;
        if (c + 1 < 32) GLA_LOAD(c + 1);
        bf16x8 qf[4];
#pragma unroll
        for (int ks = 0; ks < 4; ++ks) qf[ks] = *(const LAS bf16x8*)(gb + G_QD + sw256(l0 + fr, 4 * ks + fq));
        f32x4 o[2]; o[0] = (f32x4){0.f, 0.f, 0.f, 0.f}; o[1] = (f32x4){0.f, 0.f, 0.f, 0.f};
        const int lcol = l0 + fr; const int nsb = (lt >> 1) + 1;
        for (int sb = 0; sb < nsb; ++sb) {
            const int s0 = 32 * sb; const bool two = (2 * sb + 1) <= lt;
            f32x4 a0 = {0.f, 0.f, 0.f, 0.f}, a1 = {0.f, 0.f, 0.f, 0.f};
#pragma unroll
            for (int ks = 0; ks < 4; ++ks) { const bf16x8 kf = *(const LAS bf16x8*)(gb + G_KI + sw256(s0 + fr, 4 * ks + fq)); a0 = __builtin_amdgcn_mfma_f32_16x16x32_bf16(kf, qf[ks], a0, 0, 0, 0); }
            if (two) {
#pragma unroll
                for (int ks = 0; ks < 4; ++ks) { const bf16x8 kf = *(const LAS bf16x8*)(gb + G_KI + sw256(s0 + 16 + fr, 4 * ks + fq)); a1 = __builtin_amdgcn_mfma_f32_16x16x32_bf16(kf, qf[ks], a1, 0, 0, 0); }
            }
            float g0[4], g1[4];
#pragma unroll
            for (int i = 0; i < 4; ++i) { const int sa = s0 + 4 * fq + i; g0[i] = (sa <= lcol) ? a0[i] : 0.f; g1[i] = (two && sa + 16 <= lcol) ? a1[i] : 0.f; }
            u32x4 ap; ap.x = cvt_pk_bf16(g0[0], g0[1]); ap.y = cvt_pk_bf16(g0[2], g0[3]); ap.z = cvt_pk_bf16(g1[0], g1[1]); ap.w = cvt_pk_bf16(g1[2], g1[3]);
            const bf16x8 af = __builtin_bit_cast(bf16x8, ap);
            s16x4 lo[2], hi[2];
#pragma unroll
            for (int vi = 0; vi < 2; ++vi) { lo[vi] = tr_read(xtr + gbo + G_V + (unsigned)((s0 + 4 * fq) * XROW + (vt0 + vi) * 32)); hi[vi] = tr_read(xtr + gbo + G_V + (unsigned)((s0 + 16 + 4 * fq) * XROW + (vt0 + vi) * 32)); }
            MX_LGKM0();
#pragma unroll
            for (int vi = 0; vi < 2; ++vi) o[vi] = __builtin_amdgcn_mfma_f32_16x16x32_bf16(af, cat8(lo[vi], hi[vi]), o[vi], 0, 0, 0);
        }
#pragma unroll
        for (int vi = 0; vi < 2; ++vi)
#pragma unroll
            for (int ks = 0; ks < 4; ++ks) { const bf16x8 sf = *(const LAS bf16x8*)(sp + sw256(16 * (vt0 + vi) + fr, 4 * ks + fq)); o[vi] = __builtin_amdgcn_mfma_f32_16x16x32_bf16(qf[ks], sf, o[vi], 0, 0, 0); }
        {
            bf16_t* op = MIX + (seq0 + (size_t)c * 64 + l0 + 4 * fq) * 2048 + 1024 + h * 256 + vs * 64 + vt0 * 16 + fr;
#pragma unroll
            for (int vi = 0; vi < 2; ++vi)
#pragma unroll
                for (int i = 0; i < 4; ++i) { const bf16_t val = (bf16_t)(cvt_pk_bf16(o[vi][i], 0.f) & 0xffffu);
                    if (CHECK) { if (op[(size_t)i * 2048 + vi * 16] != val) atomicAdd(mismatch, 1u); } else op[(size_t)i * 2048 + vi * 16] = val; }
        }
        {
#pragma unroll
            for (int ks = 0; ks < 2; ++ks) {
                const int s0 = 32 * ks, q = (lane & 15) >> 2, p = lane & 3;
                const int r1 = s0 + 8 * fq + q, r2 = r1 + 4;
                const s16x4 alo = tr_read(lds0 + gbo + G_KI + sw256(r1, 2 * w + (p >> 1)) + (p & 1) * 8), ahi = tr_read(lds0 + gbo + G_KI + sw256(r2, 2 * w + (p >> 1)) + (p & 1) * 8);
                s16x4 lo[4], hi[4];
#pragma unroll
                for (int vt = 0; vt < 4; ++vt) { lo[vt] = tr_read(xtr + gbo + G_V + (unsigned)((s0 + 8 * fq) * XROW + vt * 32)); hi[vt] = tr_read(xtr + gbo + G_V + (unsigned)((s0 + 8 * fq + 4) * XROW + vt * 32)); }
                MX_LGKM0();
                const bf16x8 af = cat8(alo, ahi);
#pragma unroll
                for (int vt = 0; vt < 4; ++vt) st[vt] = __builtin_amdgcn_mfma_f32_16x16x32_bf16(af, cat8(lo[vt], hi[vt]), st[vt], 0, 0, 0);
            }
            const f32x4 d4 = *(const LAS f32x4*)((LAS float*)(gb + G_DEC) + 16 * w + 4 * fq);
#pragma unroll
            for (int vt = 0; vt < 4; ++vt) st[vt] = st[vt] * d4;
        }
        if (c + 1 < 32) GLA_WRITE(pb ^ 1);
        MX_BAR_L();
    }
    asm volatile("s_waitcnt vmcnt(0)" ::: "memory");
#undef GLA_LOAD
#undef GLA_WRITE
}

__device__ __forceinline__ void finalize_phase(bf16_t* MIX, const bf16_t* PROJ, const float* ssd_norm, const float* gla_norm, int gw, int ngw, int lane) {
    for (int m = gw; m < T; m += ngw) {
        bf16_t* mr = MIX + (size_t)m * 2048; const bf16_t* pr = PROJ + (size_t)m * NO_IN;
        float y[2][8]; float s = 0.f;
#pragma unroll
        for (int j = 0; j < 2; ++j) { const int col = 512 * j + 8 * lane; const u32x4 a = *(const u32x4*)(mr + col), z = __builtin_nontemporal_load((const u32x4*)(pr + col));
#pragma unroll
            for (int i = 0; i < 4; ++i) { const float y0 = __uint_as_float(a[i] << 16), y1 = __uint_as_float(a[i] & 0xffff0000u), z0 = __uint_as_float(z[i] << 16), z1 = __uint_as_float(z[i] & 0xffff0000u);
                y[j][2 * i] = y0 * siluf(z0); y[j][2 * i + 1] = y1 * siluf(z1); s += y[j][2 * i] * y[j][2 * i] + y[j][2 * i + 1] * y[j][2 * i + 1]; } }
        const float rs = rsqrtf(wave_sum(s) * (1.f / 1024.f) + EPS);
#pragma unroll
        for (int j = 0; j < 2; ++j) { const int col = 512 * j + 8 * lane; const f32x4 w0 = *(const f32x4*)(ssd_norm + col), w1 = *(const f32x4*)(ssd_norm + col + 4);
            u32x4 o; o.x = cvt_pk_bf16(y[j][0] * rs * w0[0], y[j][1] * rs * w0[1]); o.y = cvt_pk_bf16(y[j][2] * rs * w0[2], y[j][3] * rs * w0[3]);
            o.z = cvt_pk_bf16(y[j][4] * rs * w1[0], y[j][5] * rs * w1[1]); o.w = cvt_pk_bf16(y[j][6] * rs * w1[2], y[j][7] * rs * w1[3]);
            *(u32x4*)(mr + col) = o; }
#pragma unroll
        for (int j = 0; j < 2; ++j) { const int cc = 512 * j + 8 * lane; const u32x4 a = *(const u32x4*)(mr + 1024 + cc), r = __builtin_nontemporal_load((const u32x4*)(pr + 4608 + cc));
            float o[8]; float s2 = 0.f;
#pragma unroll
            for (int i = 0; i < 4; ++i) { o[2 * i] = __uint_as_float(a[i] << 16); o[2 * i + 1] = __uint_as_float(a[i] & 0xffff0000u); s2 += o[2 * i] * o[2 * i] + o[2 * i + 1] * o[2 * i + 1]; }
#pragma unroll
            for (int of = 1; of < 32; of <<= 1) s2 += __shfl_xor(s2, of);
            const float r2 = rsqrtf(s2 * (1.f / 256.f) + EPS); const int v0 = 8 * (lane & 31);
            const f32x4 w0 = *(const f32x4*)(gla_norm + v0), w1 = *(const f32x4*)(gla_norm + v0 + 4);
            float f[8];
#pragma unroll
            for (int i = 0; i < 4; ++i) { f[2 * i] = siluf(__uint_as_float(r[i] << 16)); f[2 * i + 1] = siluf(__uint_as_float(r[i] & 0xffff0000u)); }
            u32x4 ov; ov.x = cvt_pk_bf16(o[0] * r2 * w0[0] * f[0], o[1] * r2 * w0[1] * f[1]); ov.y = cvt_pk_bf16(o[2] * r2 * w0[2] * f[2], o[3] * r2 * w0[3] * f[3]);
            ov.z = cvt_pk_bf16(o[4] * r2 * w1[0] * f[4], o[5] * r2 * w1[1] * f[5]); ov.w = cvt_pk_bf16(o[6] * r2 * w1[2] * f[6], o[7] * r2 * w1[3] * f[7]);
            *(u32x4*)(mr + 1024 + cc) = ov; }
    }
}
#undef MX_LGKM0
#undef MX_BAR
#undef MX_BAR_L
}
namespace mk {
__device__ __forceinline__ void tp_norm_rows(const float* src, const float* g, bf16_t* xn, int gw, int ngw, int lane) {
    f32x4 gg[4];
#pragma unroll
    for (int j = 0; j < 4; ++j) gg[j] = ((const f32x4*)g)[lane + 64 * j];
    for (int m = gw; m < T; m += ngw) {
        const f32x4* p = (const f32x4*)(src + (size_t)m * DM); f32x4 v[4]; float s = 0.f;
#pragma unroll
        for (int j = 0; j < 4; ++j) { v[j] = __builtin_nontemporal_load(p + lane + 64 * j); s += (v[j][0] * v[j][0] + v[j][1] * v[j][1]) + (v[j][2] * v[j][2] + v[j][3] * v[j][3]); }
        const float r = rsqrtf(wave_sum(s) * (1.f / DM) + EPS);
        u32x2* o = (u32x2*)(xn + (size_t)m * DM);
#pragma unroll
        for (int j = 0; j < 4; ++j) { const f32x4 y = v[j] * r * gg[j]; u32x2 w; w.x = cvt_pk_bf16(y[0], y[1]); w.y = cvt_pk_bf16(y[2], y[3]); o[lane + 64 * j] = w; }
    }
}
template <bool FINAL> __device__ __forceinline__ void tp_combine_norm(bf16_t* hb, const bf16_t* Y, const float* g, bf16_t* xn, float* out, int gw, int ngw, int lane) {
    f32x4 gg[2][2];
#pragma unroll
    for (int j = 0; j < 2; ++j) { gg[j][0] = *(const f32x4*)(g + 512 * j + 8 * lane); gg[j][1] = *(const f32x4*)(g + 512 * j + 8 * lane + 4); }
    for (int m = gw; m < T; m += ngw) {
        float v[2][8]; float s = 0.f;
#pragma unroll
        for (int j = 0; j < 2; ++j) { const size_t o = (size_t)m * DM + 512 * j + 8 * lane;
            const u32x4 a = *(const u32x4*)(hb + o), y0 = __builtin_nontemporal_load((const u32x4*)(Y + o)), y1 = __builtin_nontemporal_load((const u32x4*)(Y + (size_t)T * DM + o));
#pragma unroll
            for (int i = 0; i < 4; ++i) { v[j][2 * i] = __uint_as_float(a[i] << 16) + __uint_as_float(y0[i] << 16) + __uint_as_float(y1[i] << 16);
                v[j][2 * i + 1] = __uint_as_float(a[i] & 0xffff0000u) + __uint_as_float(y0[i] & 0xffff0000u) + __uint_as_float(y1[i] & 0xffff0000u);
                s += v[j][2 * i] * v[j][2 * i] + v[j][2 * i + 1] * v[j][2 * i + 1]; } }
        const float r = rsqrtf(wave_sum(s) * (1.f / DM) + EPS);
#pragma unroll
        for (int j = 0; j < 2; ++j) { const size_t o = (size_t)m * DM + 512 * j + 8 * lane;
            if (FINAL) { f32x4 o0, o1;
#pragma unroll
                for (int i = 0; i < 4; ++i) { o0[i] = v[j][i] * r * gg[j][0][i]; o1[i] = v[j][4 + i] * r * gg[j][1][i]; }
                __builtin_nontemporal_store(o0, (f32x4*)(out + o)); __builtin_nontemporal_store(o1, (f32x4*)(out + o + 4));
            } else { u32x4 hw, xw;
#pragma unroll
                for (int i = 0; i < 4; ++i) { hw[i] = cvt_pk_bf16(v[j][2 * i], v[j][2 * i + 1]);
                    xw[i] = cvt_pk_bf16(v[j][2 * i] * r * gg[j][i >> 1][(2 * i) & 3], v[j][2 * i + 1] * r * gg[j][i >> 1][(2 * i + 1) & 3]); }
                *(u32x4*)(hb + o) = hw; *(u32x4*)(xn + o) = xw; }
        }
    }
}
template <bool DRY> __device__ __forceinline__ void tp_route_mfma(const bf16_t* hb, const float* g, bf16_t* xn, const bf16_t* whi, const bf16_t* wlo, const float* bg, const float* br,
                                                                  unsigned* counts, int* lists, float* gates, LAS char* shm, int vcu, int G, int lane, int wave) {
    const int grp = wave >> 2, wq = wave & 3, fr = lane & 15, fq = lane >> 4;
    LAS u32x4* stage = (LAS u32x4*)(shm + wave * 8192);
    LAS float* xacc = (LAS float*)(shm + 65536 + grp * 12288);
    LAS float* ltile = (LAS float*)(shm + 90112 + grp * 4096);
    LAS float* rsl = (LAS float*)(shm + 98304 + grp * 64);
    for (int blk = vcu; blk < T / 32; blk += G) {
        const int r0 = blk * 32 + grp * 16; const int kbase = wq * 256;
        const bf16_t* hp = hb + (size_t)(r0 + fr) * DM + kbase + 8 * fq; const float* gp = g + kbase + 8 * fq;
        f32x4 acc[3]; acc[0] = (f32x4){0.f, 0.f, 0.f, 0.f}; acc[1] = acc[0]; acc[2] = acc[0];
        float ss = 0.f;
#pragma unroll 4
        for (int ks = 0; ks < 8; ++ks) {
            const u32x4 hv = *(const u32x4*)(hp + 32 * ks);
            const f32x4 g0 = *(const f32x4*)(gp + 32 * ks), g1 = *(const f32x4*)(gp + 32 * ks + 4);
            f32x4 x0, x1;
            x0[0] = __uint_as_float(hv.x << 16); x0[1] = __uint_as_float(hv.x & 0xffff0000u); x0[2] = __uint_as_float(hv.y << 16); x0[3] = __uint_as_float(hv.y & 0xffff0000u);
            x1[0] = __uint_as_float(hv.z << 16); x1[1] = __uint_as_float(hv.z & 0xffff0000u); x1[2] = __uint_as_float(hv.w << 16); x1[3] = __uint_as_float(hv.w & 0xffff0000u);
            ss += (x0[0] * x0[0] + x0[1] * x0[1]) + (x0[2] * x0[2] + x0[3] * x0[3]) + (x1[0] * x1[0] + x1[1] * x1[1]) + (x1[2] * x1[2] + x1[3] * x1[3]);
            const f32x4 y0 = x0 * g0, y1 = x1 * g1;
            u32x4 hi; hi.x = cvt_pk_bf16(y0[0], y0[1]); hi.y = cvt_pk_bf16(y0[2], y0[3]); hi.z = cvt_pk_bf16(y1[0], y1[1]); hi.w = cvt_pk_bf16(y1[2], y1[3]);
            stage[ks * 64 + lane] = hi;
            u32x4 lo;
            lo.x = cvt_pk_bf16(y0[0] - __uint_as_float(hi.x << 16), y0[1] - __uint_as_float(hi.x & 0xffff0000u)); lo.y = cvt_pk_bf16(y0[2] - __uint_as_float(hi.y << 16), y0[3] - __uint_as_float(hi.y & 0xffff0000u));
            lo.z = cvt_pk_bf16(y1[0] - __uint_as_float(hi.z << 16), y1[1] - __uint_as_float(hi.z & 0xffff0000u)); lo.w = cvt_pk_bf16(y1[2] - __uint_as_float(hi.w << 16), y1[3] - __uint_as_float(hi.w & 0xffff0000u));
            const bf16x8 ah = __builtin_bit_cast(bf16x8, hi), al = __builtin_bit_cast(bf16x8, lo);
#pragma unroll
            for (int nt = 0; nt < 3; ++nt) {
                const size_t wo = (size_t)(nt * 16 + fr) * DM + kbase + 32 * ks + 8 * fq;
                const bf16x8 bh = *(const bf16x8*)(whi + wo), bl = *(const bf16x8*)(wlo + wo);
                acc[nt] = __builtin_amdgcn_mfma_f32_16x16x32_bf16(ah, bh, acc[nt], 0, 0, 0);
                acc[nt] = __builtin_amdgcn_mfma_f32_16x16x32_bf16(ah, bl, acc[nt], 0, 0, 0);
                acc[nt] = __builtin_amdgcn_mfma_f32_16x16x32_bf16(al, bh, acc[nt], 0, 0, 0);
            }
        }
        ss += __shfl_xor(ss, 16); ss += __shfl_xor(ss, 32);
        if (wq != 0) { LAS float* xa = xacc + (wq - 1) * 13 * 64;
#pragma unroll
            for (int nt = 0; nt < 3; ++nt)
#pragma unroll
                for (int i = 0; i < 4; ++i) xa[(nt * 4 + i) * 64 + lane] = acc[nt][i];
            xa[12 * 64 + lane] = ss;
        }
        asm volatile("s_waitcnt lgkmcnt(0)\n\ts_barrier" ::: "memory");
        if (wq == 0) {
#pragma unroll
            for (int nt = 0; nt < 3; ++nt)
#pragma unroll
                for (int i = 0; i < 4; ++i) { const int o = (nt * 4 + i) * 64 + lane; const float v = acc[nt][i] + xacc[o] + xacc[13 * 64 + o] + xacc[26 * 64 + o]; ltile[(4 * fq + i) * 48 + nt * 16 + fr] = v; }
            ss += xacc[12 * 64 + lane] + xacc[25 * 64 + lane] + xacc[38 * 64 + lane];
            const float rs = rsqrtf(ss * (1.f / DM) + EPS);
            if (fq == 0) rsl[fr] = rs;
        }
        asm volatile("s_waitcnt lgkmcnt(0)\n\ts_barrier" ::: "memory");
        { const float rs = rsl[fr]; bf16_t* xp = xn + (size_t)(r0 + fr) * DM + kbase + 8 * fq;
#pragma unroll
          for (int ks = 0; ks < 8; ++ks) { const u32x4 v = stage[ks * 64 + lane]; u32x4 o;
              o.x = cvt_pk_bf16(__uint_as_float(v.x << 16) * rs, __uint_as_float(v.x & 0xffff0000u) * rs); o.y = cvt_pk_bf16(__uint_as_float(v.y << 16) * rs, __uint_as_float(v.y & 0xffff0000u) * rs);
              o.z = cvt_pk_bf16(__uint_as_float(v.z << 16) * rs, __uint_as_float(v.z & 0xffff0000u) * rs); o.w = cvt_pk_bf16(__uint_as_float(v.w << 16) * rs, __uint_as_float(v.w & 0xffff0000u) * rs);
              *(u32x4*)(xp + 32 * ks) = o; } }
        if (wq == 0 && lane < 16) {
            const LAS float* lt = ltile + lane * 48; const float rsr = rsl[lane];
            float gl[4];
#pragma unroll
            for (int e = 0; e < 4; ++e) gl[e] = rsr * lt[e] + bg[e];
            int gi = 0; float gm = gl[0];
#pragma unroll
            for (int e = 1; e < 4; ++e) if (gl[e] > gm) { gm = gl[e]; gi = e; }
            float gs = 0.f;
#pragma unroll
            for (int e = 0; e < 4; ++e) gs += expf(gl[e] - gm);
            const float gwt = 1.f / gs;
            float b0 = -INFINITY, b1 = -INFINITY; int i0 = 0, i1 = 0;
#pragma unroll
            for (int i = 0; i < 8; ++i) { const float v = rsr * lt[4 + gi * 8 + i] + br[gi * 8 + i];
                if (v > b0) { b1 = b0; i1 = i0; b0 = v; i0 = i; } else if (v > b1) { b1 = v; i1 = i; } }
            const int t = r0 + lane;
            const float w0 = 1.f / (1.f + expf(b1 - b0)), w1 = 1.f - w0;
            const int e0 = gi * 8 + i0, e1 = gi * 8 + i1;
            gates[2 * t] = gwt * w0; gates[2 * t + 1] = gwt * w1;
            if (!DRY) {
                const unsigned p0 = __hip_atomic_fetch_add(counts + e0 * 64, 1u, __ATOMIC_RELAXED, __HIP_MEMORY_SCOPE_AGENT); lists[e0 * CAP + p0] = 2 * t;
                const unsigned p1 = __hip_atomic_fetch_add(counts + e1 * 64, 1u, __ATOMIC_RELAXED, __HIP_MEMORY_SCOPE_AGENT); lists[e1 * CAP + p1] = 2 * t + 1; }
        }
        asm volatile("s_waitcnt lgkmcnt(0)\n\ts_barrier" ::: "memory");
    }
}

struct Args {
    const float* in[26]; float* out; unsigned char* ws; int ph_lo, ph_hi, use_bar, li;
};
enum Phase { P_CONV0 = 0, P_G1, P_ATT, P_G2, P_TP1, P_G3, P_G4, P_TP2, P_G5, P_CONV, P_MIXER, P_FIN, P_G6, P_TP3, P_G7, P_G8, P_TP4, P_COUNT };

__device__ __forceinline__ void moe_setup(volatile LAS int* misc, unsigned* counts) {
    if (threadIdx.x == 0) {
        int run = 0;
        for (int e = 0; e < 32; ++e) { const int c = (int)__hip_atomic_load(counts + e * 64, __ATOMIC_RELAXED, __HIP_MEMORY_SCOPE_AGENT); misc[64 + e] = c; misc[16 + e] = run; run += (c + 255) >> 8; }
        misc[16 + 32] = run;
    }
    __syncthreads();
}

#ifndef CV_TAIL_ITEMS
#define CV_TAIL_ITEMS 8192
#endif
constexpr int CV_I_EIN = 16 * 80, CV_I_EOUT = 16 * 32, CV_I_OIN = 16 * 184, CV_I_OOUT = 32 * 32, CV_I_GU = 16 * 32, CV_I_D = 8 * 32;
constexpr int CV_NITEMS = CV_I_EIN + CV_I_EOUT + CV_I_OIN + CV_I_OOUT + 32 * CV_I_GU + 32 * CV_I_D;
__device__ __forceinline__ CvItem cv_decode0(const float* const* in, unsigned char* ws, int it, int lane) {
    int r = it;
    if (r < CV_I_EIN) return cv_make(SrcEvenIn{in[4]}, 2312, 1024, 80, (bf16_t*)(ws + WS_WEIN), r, lane); r -= CV_I_EIN;
    if (r < CV_I_EOUT) return cv_make(SrcPlain{in[7], 1024}, 1024, 1024, 32, (bf16_t*)(ws + WS_WEOUT), r, lane); r -= CV_I_EOUT;
    if (r < CV_I_OIN) return cv_make(SrcOddIn{in[8]}, 5664, 1024, 184, (bf16_t*)(ws + WS_WOIN), r, lane); r -= CV_I_OIN;
    if (r < CV_I_OOUT) return cv_make(SrcPlain{in[18], 1024}, 1024, 2048, 32, (bf16_t*)(ws + WS_WOOUT), r, lane); r -= CV_I_OOUT;
    if (r < 32 * CV_I_GU) { const int e = r / CV_I_GU; return cv_make_gu(in[23] + (size_t)e * 1024 * 512, in[24] + (size_t)e * 1024 * 512, (bf16_t*)(ws + WS_WGU) + (size_t)e * 1024 * 1024, r % CV_I_GU, lane); } r -= 32 * CV_I_GU;
    { const int e = r / CV_I_D; return cv_make(SrcPlain{in[25] + (size_t)e * 512 * 1024, 1024}, 1024, 512, 32, (bf16_t*)(ws + WS_WD) + (size_t)e * 1024 * 512, r % CV_I_D, lane); }
}
__device__ __forceinline__ void cv_run0(const float* const* in, unsigned char* ws, int lo, int hi, int w, int nw, LAS float* scr, int lane) {
    for (int it = lo + 2 * w; it < hi; it += 2 * nw) {
        float va[32], vb[32]; const CvItem da = cv_decode0(in, ws, it, lane); cv_load(da, va);
        const bool n1 = it + 1 < hi; CvItem db = da; if (n1) { db = cv_decode0(in, ws, it + 1, lane); cv_load(db, vb); }
        cv_finish(da, va, scr, lane);
        if (n1) cv_finish(db, vb, scr, lane);
    }
}

constexpr int CV_NIT1 = 32 * (CV_I_GU + CV_I_D);
#ifndef CV1_TAIL_G5
#define CV1_TAIL_G5 4096
#endif
#ifndef CV1_TAIL_MIX
#define CV1_TAIL_MIX 8192
#endif
#ifndef CV0_TAIL_G3
#define CV0_TAIL_G3 0
#endif
__device__ __forceinline__ CvItem cv_decode1(const float* const* in, unsigned char* ws, int it, int lane) {
    const size_t L1 = (size_t)32 * 1024 * 512; int r = it;
    if (r < 32 * CV_I_GU) { const int e = r / CV_I_GU; return cv_make_gu(in[23] + L1 + (size_t)e * 1024 * 512, in[24] + L1 + (size_t)e * 1024 * 512, (bf16_t*)(ws + WS_WGU) + (size_t)e * 1024 * 1024, r % CV_I_GU, lane); } r -= 32 * CV_I_GU;
    { const int e = r / CV_I_D; return cv_make(SrcPlain{in[25] + L1 + (size_t)e * 512 * 1024, 1024}, 1024, 512, 32, (bf16_t*)(ws + WS_WD) + (size_t)e * 1024 * 512, r % CV_I_D, lane); }
}
__device__ __forceinline__ void cv_run1(const float* const* in, unsigned char* ws, int lo, int hi, int w, int nw, LAS float* scr, int lane) {
    for (int it = lo + 2 * w; it < hi; it += 2 * nw) {
        float va[32], vb[32]; const CvItem da = cv_decode1(in, ws, it, lane); cv_load(da, va);
        const bool n1 = it + 1 < hi; CvItem db = da; if (n1) { db = cv_decode1(in, ws, it + 1, lane); cv_load(db, vb); }
        cv_finish(da, va, scr, lane);
        if (n1) cv_finish(db, vb, scr, lane);
    }
}

__global__ void __launch_bounds__(NTHR, 2) mk_fwd(Args args) {
    extern __shared__ __attribute__((aligned(16))) unsigned char lds_raw[];
    LAS unsigned char* lds = (LAS unsigned char*)lds_raw;
    volatile LAS int* misc = (volatile LAS int*)(lds + MISC_OFF);
    const int tid = threadIdx.x, lane = tid & 63, wave = __builtin_amdgcn_readfirstlane(tid >> 6);
    const int G = gridDim.x, bx = blockIdx.x;
    const int vcu = (G % 8 == 0) ? (bx % 8) * (G / 8) + bx / 8 : bx;
    const int gw = vcu * NWAVES + wave, ngw = G * NWAVES;
    unsigned char* ws = args.ws;
    unsigned* ctl = (unsigned*)(ws + WS_CTL);
    for (int u = tid; u < 256; u += NTHR) misc[u] = 0;
    __syncthreads();
    XcdBarrier bar; bar.bar = ctl + CW_BAR + args.li * XCD_BAR_WORDS; bar.x = 0; bar.st = nullptr;
    if (args.use_bar) bar = xcd_barrier_post(ctl + CW_BAR + args.li * XCD_BAR_WORDS, (volatile LAS unsigned*)misc);
#ifdef BAR_TWICE
#define GRID_BAR() do { if (args.use_bar) { xcd_barrier(bar); xcd_barrier(bar); } } while (0)
#else
#define GRID_BAR() do { if (args.use_bar) xcd_barrier(bar); } while (0)
#endif
    const int lo = args.ph_lo, hi = args.ph_hi;
#ifndef MK_PHASE_MASK
#define MK_PHASE_MASK 0xffffffffu
#endif
#define IN(k) (((MK_PHASE_MASK >> (k)) & 1u) && lo <= (k) && (k) < hi)
#ifndef MK_REP_MASK
#define MK_REP_MASK 0u
#endif
#define NREP(k) ((((MK_REP_MASK) >> (k)) & 1u) ? 2 : 1)
#define REP(k) for (int _r = 0; _r < ((((MK_REP_MASK) >> (k)) & 1u) ? 2 : 1); ++_r)
#define SEAM(k) do { if (IN(k) && IN((k) + 1)) GRID_BAR(); } while (0)
    const float* x = args.in[0];
    bf16_t* XN = (bf16_t*)(ws + WS_XN); bf16_t* PROJ = (bf16_t*)(ws + WS_PROJ); bf16_t* MIX = (bf16_t*)(ws + WS_MIX);
    float* FB = (float*)(ws + WS_FB); int* LISTS = (int*)(ws + WS_LISTS); float* GATES = (float*)(ws + WS_GATES);
    bf16_t* HB = (bf16_t*)(ws + WS_H); bf16_t* YB = (bf16_t*)(ws + WS_Y);
    float* outp = args.out; bf16_t* HBS = (bf16_t*)(ws + WS_HB);

    if (IN(P_CONV0)) REP(P_CONV0) {
        LAS float* scr = (LAS float*)(lds + wave * 16384);
        constexpr int OI_LO = CV_I_EIN + CV_I_EOUT, OI_HI = OI_LO + CV_I_OIN + CV_I_OOUT;
        if (CV0_TAIL_G3 && G == 256) { cv_run0(args.in, ws, 0, OI_LO, gw, ngw, scr, lane); cv_run0(args.in, ws, OI_HI, CV_NITEMS - CV_TAIL_ITEMS, gw, ngw, scr, lane); }
        else cv_run0(args.in, ws, 0, CV_NITEMS - CV_TAIL_ITEMS, gw, ngw, scr, lane);
        { bf16_t* wrt = (bf16_t*)(ws + WS_WRT);
          for (int i = gw * 64 + lane; i < 2 * 48 * 1024; i += ngw * 64) { const int l = i / (48 * 1024), rem = i % (48 * 1024), e = rem >> 10, k = rem & 1023;
              const float v = (e < 4) ? args.in[19][(size_t)l * 4096 + k * 4 + e] : (e < 36 ? args.in[21][(size_t)l * 32768 + k * 32 + (e - 4)] : 0.f);
              const unsigned hi = cvt_pk_bf16(v, 0.f) & 0xffffu; const unsigned lo = cvt_pk_bf16(v - __uint_as_float(hi << 16), 0.f) & 0xffffu;
              wrt[(size_t)(2 * l) * 48 * 1024 + rem] = (bf16_t)hi; wrt[(size_t)(2 * l + 1) * 48 * 1024 + rem] = (bf16_t)lo; } }
        tp_norm_rows(x, args.in[1], XN, gw, ngw, lane);
    }
    SEAM(P_CONV0);
    if (IN(P_G1)) {
        pg8::Gemm g{XN, (const bf16_t*)(ws + WS_WEIN), 1024, 0}; pg8::DenseOrder S; S.init(T, NE_IN, G, bx, NREP(P_G1));
        pg8::EpiProjEven E{PROJ, FB};
        pg8::gemm_phase<pg8::EpiProjEven, pg8::DenseOrder, true>(lds, g, S, E);
        if (CV_TAIL_ITEMS > 0 && G == 256 && bx >= 128)
            cv_run0(args.in, ws, CV_NITEMS - CV_TAIL_ITEMS, CV_NITEMS, (bx - 128) * NWAVES + wave, 128 * NWAVES, (LAS float*)(lds + wave * 16384), lane);
        else if (CV_TAIL_ITEMS > 0 && G != 256) cv_run0(args.in, ws, CV_NITEMS - CV_TAIL_ITEMS, CV_NITEMS, gw, ngw, (LAS float*)(lds + wave * 16384), lane);
    }
    SEAM(P_G1);
    if (IN(P_ATT)) REP(P_ATT) {
        if (G == 256) {
            const int bh = vcu >> 2, s = vcu & 3, b = bh >> 3, h = bh & 7;
            const float fbias = args.in[6][h];
            att::fox_unit_p<false>((char*)lds_raw, (LAS char*)lds, b, h, 7 - s, PROJ, FB, fbias, MIX, ctl + 32, true);
            att::fox_unit_p<false>((char*)lds_raw, (LAS char*)lds, b, h, s, PROJ, FB, fbias, MIX, ctl + 32, false);
            for (int i = 0; i < 2; ++i) { const int u = vcu * 2 + i; const int sb = u >> 6, kvh = (u >> 5) & 1, blk = u & 31; att::swa_unit((LAS char*)lds, sb, kvh, blk, PROJ, args.in[5], MIX); }
        }
    }
    SEAM(P_ATT);
    if (IN(P_G2)) {
        pg8::Gemm g{MIX, (const bf16_t*)(ws + WS_WEOUT), 1024, 0}; pg8::DenseOrder S; S.init(T, DM, G, bx, NREP(P_G2));
        pg8::EpiResidB<true> E{x, HBS};
        pg8::gemm_phase<pg8::EpiResidB<true>, pg8::DenseOrder, true>(lds, g, S, E);
    }
    SEAM(P_G2);
    if (IN(P_TP1)) {
#ifdef TP1_REP
        tp_route_mfma<true>(HBS, args.in[2], XN, (const bf16_t*)(ws + WS_WRT), (const bf16_t*)(ws + WS_WRT) + 48 * 1024, args.in[20], args.in[22], ctl + CW_CNT, LISTS, GATES, (LAS char*)lds, vcu, G, lane, wave);
#endif
        tp_route_mfma<false>(HBS, args.in[2], XN, (const bf16_t*)(ws + WS_WRT), (const bf16_t*)(ws + WS_WRT) + 48 * 1024, args.in[20], args.in[22], ctl + CW_CNT, LISTS, GATES, (LAS char*)lds, vcu, G, lane, wave);
    }
    SEAM(P_TP1);
    if (IN(P_G3)) {
        moe_setup(misc, ctl + CW_CNT);
        if (CV0_TAIL_G3 && G == 256) {
            const int U = misc[16 + 32] * 4, nidle = 768 - U;
            if (nidle > 0 && bx >= 256 - nidle) { constexpr int OI_LO = CV_I_EIN + CV_I_EOUT, OI_HI = OI_LO + CV_I_OIN + CV_I_OOUT;
                cv_run0(args.in, ws, OI_LO, OI_HI, (bx - (256 - nidle)) * NWAVES + wave, nidle * NWAVES, (LAS float*)(lds + wave * 16384), lane); }
            else if (nidle <= 0) { constexpr int OI_LO = CV_I_EIN + CV_I_EOUT, OI_HI = OI_LO + CV_I_OIN + CV_I_OOUT; cv_run0(args.in, ws, OI_LO, OI_HI, gw, ngw, (LAS float*)(lds + wave * 16384), lane); }
        }
        __syncthreads();
        pg8::Gemm g{XN, (const bf16_t*)(ws + WS_WGU), 1024, (size_t)1024 * 1024 * 2};
        pg8::MoeOrder S{(const volatile LAS int*)(misc + 16), (const volatile LAS int*)(misc + 64), LISTS, G, bx, true, NREP(P_G3)};
        pg8::EpiGateUp E{HB};
        pg8::gemm_phase<pg8::EpiGateUp, pg8::MoeOrder, true>(lds, g, S, E);
    }
    SEAM(P_G3);
    if (IN(P_G4)) {
        moe_setup(misc, ctl + CW_CNT);
        pg8::Gemm g{HB, (const bf16_t*)(ws + WS_WD), 512, (size_t)1024 * 512 * 2};
        pg8::MoeOrder S{(const volatile LAS int*)(misc + 16), (const volatile LAS int*)(misc + 64), LISTS, G, bx, false, NREP(P_G4)};
        pg8::EpiDown E{YB, LISTS, GATES, (const volatile LAS int*)(misc + 64)};
        pg8::gemm_phase<pg8::EpiDown, pg8::MoeOrder, true>(lds, g, S, E);
    }
    SEAM(P_G4);
    if (IN(P_TP2)) {
        tp_combine_norm<false>(HBS, YB, args.in[1] + DM, XN, nullptr, gw, ngw, lane);
        LAS float* scr = (LAS float*)(lds + wave * 16384);
        constexpr int I_GU = 16 * 32, I_D = 8 * 32; const size_t L1 = (size_t)32 * 1024 * 512;
        auto decode = [&](int it) -> CvItem {
            int r = it;
            if (r < 32 * I_GU) { const int e = r / I_GU; return cv_make_gu(args.in[23] + L1 + (size_t)e * 1024 * 512, args.in[24] + L1 + (size_t)e * 1024 * 512, (bf16_t*)(ws + WS_WGU) + (size_t)e * 1024 * 1024, r % I_GU, lane); } r -= 32 * I_GU;
            { const int e = r / I_D; return cv_make(SrcPlain{args.in[25] + L1 + (size_t)e * 512 * 1024, 1024}, 1024, 512, 32, (bf16_t*)(ws + WS_WD) + (size_t)e * 1024 * 512, r % I_D, lane); }
        };
        const int NIT1 = CV_NIT1 - ((G == 256) ? (CV1_TAIL_G5 + CV1_TAIL_MIX) : 0);
        for (int it = 2 * gw; it < NIT1; it += 2 * ngw) {
            float va[32], vb[32]; const CvItem da = decode(it); cv_load(da, va);
            const bool n1 = it + 1 < NIT1; CvItem db = da; if (n1) { db = decode(it + 1); cv_load(db, vb); }
            cv_finish(da, va, scr, lane);
            if (n1) cv_finish(db, vb, scr, lane);
        }
    }
    SEAM(P_TP2);
    if (IN(P_G5)) {
        pg8::Gemm g{XN, (const bf16_t*)(ws + WS_WOIN), 1024, 0}; pg8::DenseOrder S; S.init(T, NO_IN, G, bx, NREP(P_G5));
        pg8::EpiProjOdd E{PROJ, (float*)(ws + WS_DTG)};
        pg8::gemm_phase<pg8::EpiProjOdd, pg8::DenseOrder, true>(lds, g, S, E);
        if (CV1_TAIL_G5 > 0 && G == 256 && bx >= 192)
            cv_run1(args.in, ws, CV_NIT1 - CV1_TAIL_G5 - CV1_TAIL_MIX, CV_NIT1 - CV1_TAIL_MIX, (bx - 192) * NWAVES + wave, 64 * NWAVES, (LAS float*)(lds + wave * 16384), lane);
    }
    SEAM(P_G5);
    if (IN(P_CONV)) {
        mx::prep_conv(PROJ, (bf16_t*)(ws + WS_CONV), args.in[9], args.in[10], vcu, G, tid);
#ifdef PREP_REP_CONV
        mx::prep_conv(PROJ, (bf16_t*)(ws + WS_CONV), args.in[9], args.in[10], vcu, G, tid);
#endif
        mx::prep_ssd((const float*)(ws + WS_DTG), (float*)(ws + mx::WS_DTV), (float*)(ws + mx::WS_ACS), args.in[11], args.in[12], vcu, G, lane, wave);
#ifdef PREP_REP_SSD
        mx::prep_ssd((const float*)(ws + WS_DTG), (float*)(ws + mx::WS_DTV), (float*)(ws + mx::WS_ACS), args.in[11], args.in[12], vcu, G, lane, wave);
#endif
        mx::prep_gla(PROJ, (const float*)(ws + WS_DTG), (bf16_t*)(ws + mx::WS_QD), (bf16_t*)(ws + mx::WS_KI), (bf16_t*)(ws + mx::WS_KE), (float*)(ws + mx::WS_DEC), args.in[15], args.in[16], vcu, G, tid, lane, wave, (LAS char*)lds);
#ifdef PREP_REP_GLA
        mx::prep_gla(PROJ, (const float*)(ws + WS_DTG), (bf16_t*)(ws + mx::WS_QD), (bf16_t*)(ws + mx::WS_KI), (bf16_t*)(ws + mx::WS_KE), (float*)(ws + mx::WS_DEC), args.in[15], args.in[16], vcu, G, tid, lane, wave, (LAS char*)lds);
#endif
    }
    SEAM(P_CONV);
    if (IN(P_MIXER)) {
        if (G == 256) {
            if (vcu < 128) {
                mx::ssd_unit64((LAS char*)lds, vcu >> 4, vcu & 15, (const bf16_t*)(ws + WS_CONV), (const float*)(ws + mx::WS_ACS), (const float*)(ws + mx::WS_DTV), args.in[13][vcu & 15], MIX);
#ifdef MIX_SSD_REP
                __syncthreads(); mx::ssd_unit((LAS char*)lds, vcu >> 4, vcu & 15, (const bf16_t*)(ws + WS_CONV), (const float*)(ws + mx::WS_ACS), (const float*)(ws + mx::WS_DTV), args.in[13][vcu & 15], MIX);
#endif
            }
            else { const int u = vcu - 128; mx::gla_unit<false>((LAS char*)lds, u >> 4, (u >> 2) & 3, u & 3, PROJ, (const bf16_t*)(ws + mx::WS_QD), (const bf16_t*)(ws + mx::WS_KI),
                                                          (const float*)(ws + mx::WS_DEC), MIX, ctl + 32);
                if (CV1_TAIL_MIX > 0) { __syncthreads(); cv_run1(args.in, ws, CV_NIT1 - CV1_TAIL_MIX, CV_NIT1, (vcu - 128) * NWAVES + wave, 128 * NWAVES, (LAS float*)(lds + wave * 16384), lane); }
#ifdef MIX_GLA_REP
                __syncthreads(); mx::gla_unit<false>((LAS char*)lds, u >> 4, (u >> 2) & 3, u & 3, PROJ, (const bf16_t*)(ws + mx::WS_QD), (const bf16_t*)(ws + mx::WS_KI), (const float*)(ws + mx::WS_DEC), MIX, ctl + 32);
#endif
            }
        }
    }
    SEAM(P_MIXER);
    if (IN(P_FIN)) {
        mx::finalize_phase(MIX, PROJ, args.in[14], args.in[17], gw, ngw, lane);
    }
    SEAM(P_FIN);
    if (IN(P_G6)) {
        pg8::Gemm g{MIX, (const bf16_t*)(ws + WS_WOOUT), 2048, 0}; pg8::DenseOrder S; S.init(T, DM, G, bx, NREP(P_G6));
        pg8::EpiResidB<false> E{HBS, HBS};
        pg8::gemm_phase<pg8::EpiResidB<false>, pg8::DenseOrder, true>(lds, g, S, E);
    }
    SEAM(P_G6);
    if (IN(P_TP3)) {
        tp_route_mfma<false>(HBS, args.in[2] + DM, XN, (const bf16_t*)(ws + WS_WRT) + 2 * 48 * 1024, (const bf16_t*)(ws + WS_WRT) + 3 * 48 * 1024, args.in[20] + 4, args.in[22] + 32,
                             ctl + CW_CNT + 32 * 64, LISTS, GATES, (LAS char*)lds, vcu, G, lane, wave);
    }
    SEAM(P_TP3);
    if (IN(P_G7)) {
        moe_setup(misc, ctl + CW_CNT + 32 * 64);
        pg8::Gemm g{XN, (const bf16_t*)(ws + WS_WGU), 1024, (size_t)1024 * 1024 * 2};
        pg8::MoeOrder S{(const volatile LAS int*)(misc + 16), (const volatile LAS int*)(misc + 64), LISTS, G, bx, true, NREP(P_G7)};
        pg8::EpiGateUp E{HB};
        pg8::gemm_phase<pg8::EpiGateUp, pg8::MoeOrder, true>(lds, g, S, E);
    }
    SEAM(P_G7);
    if (IN(P_G8)) {
        moe_setup(misc, ctl + CW_CNT + 32 * 64);
        pg8::Gemm g{HB, (const bf16_t*)(ws + WS_WD), 512, (size_t)1024 * 512 * 2};
        pg8::MoeOrder S{(const volatile LAS int*)(misc + 16), (const volatile LAS int*)(misc + 64), LISTS, G, bx, false, NREP(P_G8)};
        pg8::EpiDown E{YB, LISTS, GATES, (const volatile LAS int*)(misc + 64)};
        pg8::gemm_phase<pg8::EpiDown, pg8::MoeOrder, true>(lds, g, S, E);
    }
    SEAM(P_G8);
    if (IN(P_TP4)) {
        tp_combine_norm<true>(HBS, YB, args.in[3], nullptr, outp, gw, ngw, lane);
#if defined(GLA_CHECK) || defined(ATT_CHECK)
        if (__hip_atomic_load(ctl + 32, __ATOMIC_RELAXED, __HIP_MEMORY_SCOPE_AGENT) != 0u) { for (int m = gw; m < T; m += ngw) outp[(size_t)m * DM + lane] = 1000.f; }
#endif
    }
#undef IN
#undef SEAM
#undef GRID_BAR
}
}

extern "C" void kernel_launch(void* const* d_in, const int* in_sizes, int n_in, void* d_out, int out_size, void* d_ws, size_t ws_size, hipStream_t stream) {
    static int grid = 0;
    if (grid == 0) {
        int dev = 0, cus = 0, per_cu = 0;
        (void)hipGetDevice(&dev); (void)hipDeviceGetAttribute(&cus, hipDeviceAttributeMultiprocessorCount, dev);
        if (n_in != 26 || out_size != mk::T * mk::DM || ws_size < mk::WS_TOTAL) { fprintf(stderr, "kernel_launch: unexpected shapes (n_in %d out %d ws %zu)\n", n_in, out_size, ws_size); grid = -1; return; }
        if (hipFuncSetAttribute((const void*)mk::mk_fwd, hipFuncAttributeMaxDynamicSharedMemorySize, mk::LDS_BYTES) != hipSuccess) { fprintf(stderr, "hipFuncSetAttribute failed\n"); grid = -1; return; }
        if (hipOccupancyMaxActiveBlocksPerMultiprocessor(&per_cu, (const void*)mk::mk_fwd, mk::NTHR, mk::LDS_BYTES) != hipSuccess || per_cu < 1) { fprintf(stderr, "occupancy query reports %d blocks per CU\n", per_cu); }
        (void)hipGetLastError();
        grid = cus;
        if (grid != 256) fprintf(stderr, "kernel_launch: %d CUs; the attention / mixer phases need 256\n", grid);
    }
    if (grid < 0) return;
    (void)hipMemsetAsync((char*)d_ws + mk::WS_CTL, 0, mk::CTL_ZERO_BYTES, stream);
    mk::Args a{};
    for (int i = 0; i < 26; ++i) a.in[i] = (const float*)d_in[i];
    a.out = (float*)d_out; a.ws = (unsigned char*)d_ws;
    a.ph_lo = 0; a.ph_hi = mk::P_COUNT; a.use_bar = 1; a.li = 0;
    hipLaunchKernelGGL(mk::mk_fwd, dim3(grid), dim3(mk::NTHR), mk::LDS_BYTES, stream, a);
}
```

```cpp
#include <hip/hip_runtime.h>
#include <hip/hip_bf16.h>
#include <cstdio>
#include <cstdint>
#include <cmath>
namespace mk {
#define LAS __attribute__((address_space(3)))
#define GAS __attribute__((address_space(1)))
typedef unsigned short bf16_t;
typedef short bf16x8 __attribute__((ext_vector_type(8)));
typedef short s16x4 __attribute__((ext_vector_type(4)));
typedef float f32x4 __attribute__((ext_vector_type(4)));
typedef float f32x2 __attribute__((ext_vector_type(2)));
typedef float f32x16 __attribute__((ext_vector_type(16)));
typedef unsigned u32x4 __attribute__((ext_vector_type(4)));
typedef unsigned u32x2 __attribute__((ext_vector_type(2)));

constexpr int T = 16384, DM = 1024, SEQ = 2048, NBATCH = 8;
constexpr int NE_IN = 2560, NO_IN = 5888;
constexpr int CAP = 16384;
constexpr float EPS = 1e-6f;
constexpr float LOG2E = 1.4426950408889634f;
constexpr float C2 = 0.125f * LOG2E;
constexpr int NWAVES = 8, NTHR = 512;
constexpr size_t MiB = 1u << 20;
constexpr size_t WS_CTL = 0, CTL_ZERO_BYTES = 1 * MiB;
constexpr size_t WS_WEIN = 2 * MiB, WS_WEOUT = 7 * MiB, WS_WOIN = 9 * MiB, WS_WOOUT = 21 * MiB, WS_WRT = 25 * MiB;
constexpr size_t WS_WGU = 26 * MiB, WS_WD = 90 * MiB;
constexpr size_t WS_XN = 122 * MiB;
constexpr size_t WS_PROJ = 154 * MiB;
constexpr size_t WS_H = WS_PROJ, WS_Y = WS_PROJ + 40 * MiB;
constexpr size_t WS_MIX = 338 * MiB;
constexpr size_t WS_CONV = 402 * MiB;
constexpr size_t WS_FB = 450 * MiB;
constexpr size_t WS_DTG = 451 * MiB;
constexpr size_t WS_LISTS = 453 * MiB;
constexpr size_t WS_GATES = 455 * MiB;
constexpr size_t WS_RSTD = 455 * MiB + 512 * 1024;
constexpr size_t WS_END = 456 * MiB, WS_HB = 476 * MiB, WS_TOTAL = 508 * MiB;
constexpr int CW_BAR = 4096;
constexpr int CW_CNT = 16384;
constexpr int RING_BYTES = 146432;
constexpr int MISC_OFF = RING_BYTES;
constexpr int LDS_BYTES = 147456;

typedef __bf16 bf16x2_t __attribute__((ext_vector_type(2)));
__device__ __forceinline__ unsigned cvt_pk_bf16(float lo, float hi) { f32x2 v = {lo, hi}; bf16x2_t b = __builtin_convertvector(v, bf16x2_t); return __builtin_bit_cast(unsigned, b); }
__device__ __forceinline__ float bf2f(unsigned short b) { return __uint_as_float((unsigned)b << 16); }
__device__ __forceinline__ float wave_sum(float v) {
#pragma unroll
    for (int o = 1; o < 64; o <<= 1) v += __shfl_xor(v, o);
    return v;
}
__device__ __forceinline__ float siluf(float x) { return x * __builtin_amdgcn_rcpf(1.f + __expf(-x)); }
__device__ __forceinline__ float log_sigmoidf(float x) { return fminf(x, 0.f) - log1pf(expf(-fabsf(x))); }
__device__ __forceinline__ float log_sigmoid_fast(float x) { return fminf(x, 0.f) - __logf(1.f + __expf(-fabsf(x))); }
__device__ __forceinline__ float softplusf(float x) { return fmaxf(x, 0.f) + __logf(1.f + __expf(-fabsf(x))); }

#define XB_TMO      128
#define XB_XCNT(j)  (256  + 64 * (j))
#define XB_XSUB(j)  (1280 + 64 * (j))
#define XB_XGEN(j)  (2304 + 64 * (j))
#define XB_TOP      3328
#define XB_TOPGEN   3392
#define XCD_BAR_WORDS 3456
#define XB_SPIN_CAP (1u << 18)
__device__ __forceinline__ unsigned xb_ld(unsigned* p)              { return __hip_atomic_load(p, __ATOMIC_RELAXED, __HIP_MEMORY_SCOPE_AGENT); }
__device__ __forceinline__ unsigned xb_add(unsigned* p, unsigned v) { return __hip_atomic_fetch_add(p, v, __ATOMIC_RELAXED, __HIP_MEMORY_SCOPE_AGENT); }
__device__ __forceinline__ unsigned xb_xcc_id() { return (unsigned)__builtin_amdgcn_s_getreg((3 << 11) | 20) & 0xFu; }
#define XB_SPIN(cond, bar) do { unsigned _sp = 0; while (cond) { __builtin_amdgcn_s_sleep(1); \
    if ((++_sp & 255u) == 0u) { if (xb_ld(&(bar)[XB_TMO])) break; if (_sp > XB_SPIN_CAP) { atomicAdd(&(bar)[XB_TMO], 1u); break; } } } } while (0)
struct XcdBarrier { unsigned* bar; unsigned x; volatile LAS unsigned* st; };
__device__ __forceinline__ XcdBarrier xcd_barrier_post(unsigned* bar, volatile LAS unsigned* st) {
    XcdBarrier b; b.bar = bar; b.x = xb_xcc_id(); b.st = st;
    if (threadIdx.x == 0) (void)xb_add(&bar[XB_XCNT(b.x)], 1u);
    return b;
}
__device__ __forceinline__ void xcd_barrier_complete(unsigned* bar, unsigned x, unsigned& nloc, unsigned& nx) {
    const unsigned G = gridDim.x * gridDim.y * gridDim.z;
    unsigned sum, cnt, mine, sp = 0u;
    for (;;) {
        sum = 0u; cnt = 0u; mine = 0u;
#pragma unroll
        for (unsigned j = 0; j < 16; ++j) { const unsigned c = xb_ld(&bar[XB_XCNT(j)]); sum += c; cnt += (c > 0u) ? 1u : 0u; mine = (j == x) ? c : mine; }
        if (sum == G) break;
        __builtin_amdgcn_s_sleep(1);
        if ((++sp & 255u) == 0u) { if (xb_ld(&bar[XB_TMO])) break; if (sp > XB_SPIN_CAP) { atomicAdd(&bar[XB_TMO], 1u); break; } }
    }
    nloc = mine > 0u ? mine : 1u; nx = cnt > 0u ? cnt : 1u;
}
__device__ __forceinline__ void xcd_barrier(const XcdBarrier& b) {
    asm volatile("s_waitcnt vmcnt(0)" ::: "memory");
    __syncthreads();
    if (threadIdx.x == 0) {
        unsigned* bar = b.bar;
        __builtin_amdgcn_s_waitcnt(0);
        unsigned nloc = b.st[0], nx = b.st[1];
        if (nloc == 0u) { xcd_barrier_complete(bar, b.x, nloc, nx); b.st[0] = nloc; b.st[1] = nx; }
        const unsigned old = xb_add(&bar[XB_XSUB(b.x)], 1u);
        const unsigned gen = old / nloc;
        if (old + 1u == (gen + 1u) * nloc) {
            __builtin_amdgcn_fence(__ATOMIC_RELEASE, "agent");
            asm volatile("s_waitcnt vmcnt(0)" ::: "memory");
            const unsigned og = xb_add(&bar[XB_TOP], 1u);
            const unsigned tg = og / nx;
            if (og + 1u == (tg + 1u) * nx) xb_add(&bar[XB_TOPGEN], 1u);
            else XB_SPIN(xb_ld(&bar[XB_TOPGEN]) == tg, bar);
            __builtin_amdgcn_fence(__ATOMIC_ACQUIRE, "agent");
            xb_add(&bar[XB_XGEN(b.x)], 1u);
            asm volatile("s_waitcnt vmcnt(0)" ::: "memory");
        } else {
            XB_SPIN(xb_ld(&bar[XB_XGEN(b.x)]) == gen, bar);
            __builtin_amdgcn_fence(__ATOMIC_ACQUIRE, "agent");
            asm volatile("s_waitcnt vmcnt(0)" ::: "memory");
        }
    }
    __syncthreads();
}

struct SrcPlain { const float* W; int N; __device__ __forceinline__ const float* operator()(int k, int n) const { return W + (size_t)k * N + n; } };
struct SrcEvenIn { const float* W; __device__ __forceinline__ const float* operator()(int k, int n) const { return n < 2312 ? W + (size_t)k * 2312 + n : nullptr; } };
struct SrcOddIn { const float* W;
    __device__ __forceinline__ const float* operator()(int k, int n) const {
        int s;
        if (n < 2560) s = n; else if (n < 4608) s = n + 16; else if (n < 5632) s = n + 32; else if (n < 5648) s = 2560 + (n - 5632); else if (n < 5664) s = 4624 + (n - 5648); else s = -1;
        return s >= 0 ? W + (size_t)k * 5664 + s : nullptr; } };
struct SrcGateUp { const float* Wg; const float* Wu;
    __device__ __forceinline__ const float* operator()(int k, int n) const { const int j = (n >> 5) * 16 + (n & 15); const long d = (n & 16) ? (long)(Wu - Wg) : 0l; return Wg + d + (size_t)k * 512 + j; } };
__device__ __forceinline__ struct CvItem cv_make_gu(const float* Wg, const float* Wu, bf16_t* WT, int item, int lane);
struct CvItem { const float* p; size_t stride; bf16_t* dst; int K; int gu; };
template <class Src> __device__ __forceinline__ CvItem cv_make(const Src& src, int srcN, int K, int nblk, bf16_t* WT, int item, int lane) {
    const int kb = item / nblk, nb = item % nblk, k0 = 64 * kb, n0 = 32 * nb;
    CvItem d; d.p = src(k0 + (lane >> 5), n0 + (lane & 31)); d.stride = (size_t)2 * srcN; d.dst = WT + (size_t)n0 * K + k0; d.K = K; d.gu = 0; return d;
}
__device__ __forceinline__ CvItem cv_make_gu(const float* Wg, const float* Wu, bf16_t* WT, int item, int lane) {
    const int half = item >> 8, r = item & 255, kb = r >> 4, jb = r & 15, k0 = 64 * kb, j0 = 32 * jb;
    CvItem d; d.p = (half ? Wu : Wg) + (size_t)(k0 + (lane >> 5)) * 512 + j0 + (lane & 31); d.stride = 1024; d.dst = WT + (size_t)(jb * 64 + half * 16) * 1024 + k0; d.K = 1024; d.gu = 1; return d;
}
__device__ __forceinline__ void cv_load(const CvItem& d, float (&v)[32]) {
#pragma unroll
    for (int i = 0; i < 32; ++i) v[i] = d.p ? __builtin_nontemporal_load(d.p + (size_t)i * d.stride) : 0.f;
}
__device__ __forceinline__ void cv_finish(const CvItem& d, const float (&v)[32], LAS float* scr, int lane) {
#pragma unroll
    for (int i = 0; i < 32; ++i) { const int kk = 2 * i + (lane >> 5); scr[kk * 33 + (lane & 31)] = v[i]; }
    asm volatile("s_waitcnt lgkmcnt(0)" ::: "memory");
    const int c = lane & 7;
#pragma unroll
    for (int j = 0; j < 4; ++j) { const int n = (lane >> 3) + 8 * j; const LAS float* s = scr + (8 * c) * 33 + n; const int dr = d.gu ? ((n >> 4) * 32 + (n & 15)) : n;
        u32x4 o; o.x = cvt_pk_bf16(s[0 * 33], s[1 * 33]); o.y = cvt_pk_bf16(s[2 * 33], s[3 * 33]); o.z = cvt_pk_bf16(s[4 * 33], s[5 * 33]); o.w = cvt_pk_bf16(s[6 * 33], s[7 * 33]);
        __builtin_nontemporal_store(o, (u32x4*)(d.dst + (size_t)dr * d.K + 8 * c)); }
    asm volatile("s_waitcnt lgkmcnt(0)" ::: "memory");
}

namespace pg8 {
constexpr int BM = 256, BK = 64, HALF = 128, HTB = HALF * BK * 2, STAGE_BYTES = 8 * HTB, NXCD = 8, WGM = 8;
__host__ __device__ __forceinline__ int lds_byte(int r, int c) { const int st = (r >> 4) * 2 + (c >> 5), rr = r & 15, cc = c & 31, ob = rr * 64 + cc * 2; return st * 1024 + (ob ^ (((ob >> 9) & 1) << 5)); }
__host__ __device__ __forceinline__ void stage_rc(int b, int& R, int& C) { const int st = b / 1024, sb = b % 1024, swz = sb ^ (((sb >> 9) & 1) << 5); R = (st >> 1) * 16 + swz / 64; C = (st & 1) * 32 + (swz % 64) / 2; }
__host__ __device__ __forceinline__ int perm32(int rho) { const int n = rho >> 4, i = rho & 15; return 8 * (i >> 2) + 4 * n + (i & 3); }

struct Unit { int pm, pn, e, j; };
struct Gemm { const bf16_t* A; const bf16_t* Bt; int K; size_t b_estride; };

struct DenseOrder {
    int nM, nN, nwg, G, c, rep;
    __device__ void init(int M, int N, int G_, int c_, int rep_ = 1) { nM = M / BM; nN = N / BM; nwg = nM * nN; G = G_; c = c_; rep = rep_; }
    __device__ bool next(int i, Unit& u) const {
        if (rep > 1) { const int n = (nwg - c + G - 1) / G; if (n <= 0 || i >= n * rep) return false; i = i % n; }
        const long L = (long)i * G + c; if (L >= nwg) return false;
        int wgid = (int)L; { const int q = nwg / NXCD, r = nwg % NXCD, xcd = wgid % NXCD, off = wgid / NXCD; wgid = (xcd < r ? xcd * (q + 1) : r * (q + 1) + (xcd - r) * q) + off; }
        const int nig = WGM * nN, gid = wgid / nig, fm = gid * WGM, gsz = (nM - fm) < WGM ? (nM - fm) : WGM;
        u.pm = fm + ((wgid % nig) % gsz); u.pn = (wgid % nig) / gsz; u.e = 0; u.j = 0; return true;
    }
    __device__ __forceinline__ unsigned arow(const Unit& u, int r) const { return (unsigned)(u.pm * BM + r); }
};
struct MoeOrder {
    const volatile LAS int* ts; const volatile LAS int* cnt; const int* lists; int G, c; bool gather; int rep;
    __device__ bool next(int i, Unit& u) const {
        const int U = ts[32] * 4;
        if (rep > 1) { const int n = (U - c + G - 1) / G; if (n <= 0 || i >= n * rep) return false; i = i % n; }
        const long L = (long)i * G + c; if (L >= U) return false;
        int v = (int)L; { const int q = U / NXCD, r = U % NXCD, xcd = v % NXCD, off = v / NXCD; v = (xcd < r ? xcd * (q + 1) : r * (q + 1) + (xcd - r) * q) + off; }
        const int m = v >> 2; u.pm = m; u.pn = v & 3;
        int e = 0;
        for (int k = 1; k < 32; ++k) if (ts[k] <= m) e = k;
        u.e = e; u.j = m - ts[e]; return true;
    }
    __device__ __forceinline__ unsigned arow(const Unit& u, int r) const {
        if (!gather) return (unsigned)(u.pm * BM + r);
        const int ri = u.j * BM + r; const int n = cnt[u.e];
        return ri < n ? (unsigned)(lists[u.e * CAP + ri] >> 1) : 0u;
    }
};

struct EpiProjEven {
    static constexpr bool PERM = true;
    bf16_t* O; float* fb;
    __device__ __forceinline__ void operator()(const f32x4 (&acc)[2][2][4][2], const Unit& u, int wr, int wc, int fr, int fq) const {
        const int row0 = u.pm * BM + wr * 64 + fr;
        if (u.pn == 9) {
            if (wc == 0 && fq == 0) {
#pragma unroll
                for (int ai = 0; ai < 2; ++ai)
#pragma unroll
                    for (int m = 0; m < 4; ++m) { float* p = fb + (size_t)(row0 + ai * HALF + m * 16) * 8; *(f32x4*)p = acc[ai][0][m][0]; *(f32x4*)(p + 4) = acc[ai][0][m][1]; }
            }
            return;
        }
        const float sc = (u.pn == 0 || u.pn == 1 || u.pn == 3 || u.pn == 4) ? C2 : 1.f;
        const int col0 = u.pn * BM + wc * 32 + 8 * fq;
#pragma unroll
        for (int ai = 0; ai < 2; ++ai)
#pragma unroll
            for (int m = 0; m < 4; ++m) { bf16_t* rowp = O + (size_t)(row0 + ai * HALF + m * 16) * NE_IN + col0;
#pragma unroll
                for (int bj = 0; bj < 2; ++bj) { const f32x4 v0 = acc[ai][bj][m][0] * sc, v1 = acc[ai][bj][m][1] * sc;
                    u32x4 w; w.x = cvt_pk_bf16(v0[0], v0[1]); w.y = cvt_pk_bf16(v0[2], v0[3]); w.z = cvt_pk_bf16(v1[0], v1[1]); w.w = cvt_pk_bf16(v1[2], v1[3]);
                    *(u32x4*)(rowp + bj * HALF) = w; } }
    }
};
struct EpiProjOdd {
    static constexpr bool PERM = true;
    bf16_t* O; float* dtg;
    __device__ __forceinline__ void operator()(const f32x4 (&acc)[2][2][4][2], const Unit& u, int wr, int wc, int fr, int fq) const {
        const int row0 = u.pm * BM + wr * 64 + fr;
        if (u.pn == 22) {
            if (wc == 0) {
#pragma unroll
                for (int ai = 0; ai < 2; ++ai)
#pragma unroll
                    for (int m = 0; m < 4; ++m) { float* p = dtg + (size_t)(row0 + ai * HALF + m * 16) * 32 + 8 * fq; *(f32x4*)p = acc[ai][0][m][0]; *(f32x4*)(p + 4) = acc[ai][0][m][1]; }
            }
            return;
        }
        const int col0 = u.pn * BM + wc * 32 + 8 * fq;
#pragma unroll
        for (int ai = 0; ai < 2; ++ai)
#pragma unroll
            for (int m = 0; m < 4; ++m) { bf16_t* rowp = O + (size_t)(row0 + ai * HALF + m * 16) * NO_IN + col0;
#pragma unroll
                for (int bj = 0; bj < 2; ++bj) { const f32x4 v0 = acc[ai][bj][m][0], v1 = acc[ai][bj][m][1];
                    u32x4 w; w.x = cvt_pk_bf16(v0[0], v0[1]); w.y = cvt_pk_bf16(v0[2], v0[3]); w.z = cvt_pk_bf16(v1[0], v1[1]); w.w = cvt_pk_bf16(v1[2], v1[3]);
                    *(u32x4*)(rowp + bj * HALF) = w; } }
    }
};
struct EpiResid {
    static constexpr bool PERM = false;
    const float* base; float* out;
    __device__ __forceinline__ void operator()(const f32x4 (&acc)[2][2][4][2], const Unit& u, int wr, int wc, int fr, int fq) const {
        const int col0 = u.pn * BM + wc * 32 + 4 * fq;
#pragma unroll
        for (int ai = 0; ai < 2; ++ai)
#pragma unroll
            for (int m = 0; m < 4; ++m) { const size_t off = (size_t)(u.pm * BM + ai * HALF + wr * 64 + m * 16 + fr) * DM + col0;
#pragma unroll
                for (int bj = 0; bj < 2; ++bj)
#pragma unroll
                    for (int n = 0; n < 2; ++n) { const f32x4 bs = *(const f32x4*)(base + off + bj * HALF + n * 16); *(f32x4*)(out + off + bj * HALF + n * 16) = bs + acc[ai][bj][m][n]; } }
    }
};
template <bool BASE_F32> struct EpiResidB {
    static constexpr bool PERM = true;
    const void* base; bf16_t* out;
    __device__ __forceinline__ void operator()(const f32x4 (&acc)[2][2][4][2], const Unit& u, int wr, int wc, int fr, int fq) const {
        const int row0 = u.pm * BM + wr * 64 + fr, col0 = u.pn * BM + wc * 32 + 8 * fq;
#pragma unroll
        for (int ai = 0; ai < 2; ++ai)
#pragma unroll
            for (int m = 0; m < 4; ++m) { const size_t ro = (size_t)(row0 + ai * HALF + m * 16) * DM + col0;
#pragma unroll
                for (int bj = 0; bj < 2; ++bj) { f32x4 v0 = acc[ai][bj][m][0], v1 = acc[ai][bj][m][1];
                    if (BASE_F32) { const float* b = (const float*)base + ro + bj * HALF; v0 += __builtin_nontemporal_load((const f32x4*)b); v1 += __builtin_nontemporal_load((const f32x4*)(b + 4)); }
                    else { const u32x4 bb = *(const u32x4*)((const bf16_t*)base + ro + bj * HALF);
                        v0[0] += __uint_as_float(bb.x << 16); v0[1] += __uint_as_float(bb.x & 0xffff0000u); v0[2] += __uint_as_float(bb.y << 16); v0[3] += __uint_as_float(bb.y & 0xffff0000u);
                        v1[0] += __uint_as_float(bb.z << 16); v1[1] += __uint_as_float(bb.z & 0xffff0000u); v1[2] += __uint_as_float(bb.w << 16); v1[3] += __uint_as_float(bb.w & 0xffff0000u); }
                    u32x4 w; w.x = cvt_pk_bf16(v0[0], v0[1]); w.y = cvt_pk_bf16(v0[2], v0[3]); w.z = cvt_pk_bf16(v1[0], v1[1]); w.w = cvt_pk_bf16(v1[2], v1[3]);
                    *(u32x4*)(out + ro + bj * HALF) = w; } }
    }
};
struct EpiGateUp {
    static constexpr bool PERM = false;
    bf16_t* H;
    __device__ __forceinline__ void operator()(const f32x4 (&acc)[2][2][4][2], const Unit& u, int wr, int wc, int fr, int fq) const {
#pragma unroll
        for (int ai = 0; ai < 2; ++ai)
#pragma unroll
            for (int m = 0; m < 4; ++m) { bf16_t* rowp = H + (size_t)(u.pm * BM + ai * HALF + wr * 64 + m * 16 + fr) * 512;
#pragma unroll
                for (int bj = 0; bj < 2; ++bj) { const int j0 = (u.pn * 8 + bj * 4 + wc) * 16 + 4 * fq; const f32x4 g = acc[ai][bj][m][0], up = acc[ai][bj][m][1];
                    u32x2 w; w.x = cvt_pk_bf16(siluf(g[0]) * up[0], siluf(g[1]) * up[1]); w.y = cvt_pk_bf16(siluf(g[2]) * up[2], siluf(g[3]) * up[3]);
                    *(u32x2*)(rowp + j0) = w; } }
    }
};
struct EpiDown {
    static constexpr bool PERM = true;
    bf16_t* Y; const int* lists; const float* gates; const volatile LAS int* cnt;
    __device__ __forceinline__ void operator()(const f32x4 (&acc)[2][2][4][2], const Unit& u, int wr, int wc, int fr, int fq) const {
        const int n = cnt[u.e]; const int col0 = u.pn * BM + wc * 32 + 8 * fq;
#pragma unroll
        for (int ai = 0; ai < 2; ++ai)
#pragma unroll
            for (int m = 0; m < 4; ++m) { const int ri = u.j * BM + ai * HALF + wr * 64 + m * 16 + fr;
                if (ri < n) { const int a = lists[u.e * CAP + ri]; const float g = gates[a]; bf16_t* rowp = Y + ((size_t)(a & 1) * T + (a >> 1)) * DM + col0;
#pragma unroll
                    for (int bj = 0; bj < 2; ++bj) { const f32x4 v0 = acc[ai][bj][m][0] * g, v1 = acc[ai][bj][m][1] * g;
                        u32x4 w; w.x = cvt_pk_bf16(v0[0], v0[1]); w.y = cvt_pk_bf16(v0[2], v0[3]); w.z = cvt_pk_bf16(v1[0], v1[1]); w.w = cvt_pk_bf16(v1[2], v1[3]);
                        *(u32x4*)(rowp + bj * HALF) = w; } } }
    }
};

template <class Epi, class Sched, bool ALIGN_EPI>
__device__ __forceinline__ void gemm_phase(LAS unsigned char* lds, const Gemm g, const Sched& S, const Epi& E) {
    const int tid = threadIdx.x, wid = __builtin_amdgcn_readfirstlane(tid >> 6), lane = tid & 63, wr = wid >> 2, wc = wid & 3, fr = lane & 15, fq = lane >> 4;
    const int K = g.K, nt = K / BK;
    int RA[2]; unsigned cbA[2], voffB[2];
#pragma unroll
    for (int i = 0; i < 2; ++i) { int R, C; stage_rc(tid * 16 + i * 8192, R, C); const int Rb = Epi::PERM ? ((R & ~31) + perm32(R & 31)) : R;
        RA[i] = R; cbA[i] = (unsigned)C * 2u; voffB[i] = (unsigned)(Rb * K + C) * 2u; }
    const unsigned kstep = (unsigned)(BK * 2);
    const size_t hstep = (size_t)HALF * K * 2;
    const size_t tstep = 2 * hstep;
    const unsigned rowb = (unsigned)K * 2u;
    const unsigned ldsw = (unsigned)wid * 1024u;
    const int aoff = lds_byte(wr * 64 + fr, fq * 8), boff = lds_byte(wc * 32 + fr, fq * 8);
    const char* Ab = (const char*)g.A;
#define PG8_SA(b, h) (((b) * 2 + (h)) * HTB)
#define PG8_SB(b, h) ((4 + (b) * 2 + (h)) * HTB)
#define PG8_STAGE(bufoff, gbase, voff) do { _Pragma("unroll") for (int _i = 0; _i < 2; ++_i) \
        __builtin_amdgcn_global_load_lds((const unsigned*)((const char*)(gbase) + (voff)[_i]), (LAS unsigned*)(lds + (bufoff) + ldsw + _i * 8192), 16, 0, 0); } while (0)
#define PG8_STAGE_A(bufoff, kb, o0, o1) do { \
        __builtin_amdgcn_global_load_lds((const unsigned*)(Ab + (kb) + (o0)), (LAS unsigned*)(lds + (bufoff) + ldsw), 16, 0, 0); \
        __builtin_amdgcn_global_load_lds((const unsigned*)(Ab + (kb) + (o1)), (LAS unsigned*)(lds + (bufoff) + ldsw + 8192), 16, 0, 0); } while (0)
#define PG8_LDA(dst, b, h) do { _Pragma("unroll") for (int m = 0; m < 4; ++m) _Pragma("unroll") for (int k = 0; k < 2; ++k) dst[m][k] = *(const LAS bf16x8*)(lds + PG8_SA(b, h) + aoff + m * 2048 + k * 1024); } while (0)
#define PG8_LDB(dst, b, h) do { _Pragma("unroll") for (int n = 0; n < 2; ++n) _Pragma("unroll") for (int k = 0; k < 2; ++k) dst[n][k] = *(const LAS bf16x8*)(lds + PG8_SB(b, h) + boff + n * 2048 + k * 1024); } while (0)
#define PG8_MMA(ai, bj, At, Bt) do { __builtin_amdgcn_s_setprio(1); _Pragma("unroll") for (int m = 0; m < 4; ++m) _Pragma("unroll") for (int n = 0; n < 2; ++n) _Pragma("unroll") for (int k = 0; k < 2; ++k) \
        acc[ai][bj][m][n] = __builtin_amdgcn_mfma_f32_16x16x32_bf16(Bt[n][k], At[m][k], acc[ai][bj][m][n], 0, 0, 0); __builtin_amdgcn_s_setprio(0); } while (0)
#define PG8_WAIT_V(n) asm volatile("s_waitcnt vmcnt(" #n ")" ::: "memory")
#define PG8_WAIT_L(n) asm volatile("s_waitcnt lgkmcnt(" #n ")" ::: "memory")
#define PG8_BAR __builtin_amdgcn_s_barrier()
#define PG8_SCHED __builtin_amdgcn_sched_barrier(0)
    Unit cur, nxt; int ui = 0;
    if (!S.next(0, cur)) return;
    f32x4 acc[2][2][4][2];
#pragma unroll
    for (int a = 0; a < 2; ++a)
#pragma unroll
        for (int b = 0; b < 2; ++b)
#pragma unroll
            for (int m = 0; m < 4; ++m)
#pragma unroll
                for (int n = 0; n < 2; ++n) acc[a][b][m][n] = (f32x4){0.f, 0.f, 0.f, 0.f};
    bf16x8 At[4][2], B0[2][2], B1[2][2];
    unsigned oC00 = S.arow(cur, RA[0]) * rowb + cbA[0], oC01 = S.arow(cur, RA[1]) * rowb + cbA[1];
    unsigned oC10 = S.arow(cur, HALF + RA[0]) * rowb + cbA[0], oC11 = S.arow(cur, HALF + RA[1]) * rowb + cbA[1];
    const char* cB = (const char*)g.Bt + (size_t)cur.e * g.b_estride + (size_t)cur.pn * tstep;
    PG8_STAGE(PG8_SB(0, 0), cB, voffB); PG8_STAGE(PG8_SB(0, 1), cB + hstep, voffB); PG8_STAGE_A(PG8_SA(0, 0), 0u, oC00, oC01); PG8_STAGE_A(PG8_SA(0, 1), 0u, oC10, oC11);
    if (wr == 1) PG8_BAR;
    PG8_WAIT_V(2); PG8_BAR;
    PG8_STAGE(PG8_SB(1, 0), cB + kstep, voffB); PG8_STAGE_A(PG8_SA(1, 0), kstep, oC00, oC01); PG8_STAGE(PG8_SB(1, 1), cB + hstep + kstep, voffB);
    PG8_WAIT_V(6); PG8_BAR;
    for (;;) {
        const bool has_next = S.next(ui + 1, nxt);
        unsigned oN00 = oC00, oN01 = oC01, oN10 = oC10, oN11 = oC11;
        if (has_next) { oN00 = S.arow(nxt, RA[0]) * rowb + cbA[0]; oN01 = S.arow(nxt, RA[1]) * rowb + cbA[1];
                        oN10 = S.arow(nxt, HALF + RA[0]) * rowb + cbA[0]; oN11 = S.arow(nxt, HALF + RA[1]) * rowb + cbA[1]; }
        const char* nB = has_next ? (const char*)g.Bt + (size_t)nxt.e * g.b_estride + (size_t)nxt.pn * tstep : cB;
        for (int t = 0; t < nt; t += 2) {
            const bool last = (t == nt - 2);
            const unsigned k1 = (unsigned)(t + 1) * kstep;
            const unsigned k2 = last ? 0u : (unsigned)(t + 2) * kstep, k3 = k2 + kstep;
            const unsigned o00 = last ? oN00 : oC00, o01 = last ? oN01 : oC01, o10 = last ? oN10 : oC10, o11 = last ? oN11 : oC11;
            const char* b2 = last ? nB : cB + (size_t)(t + 2) * kstep; const char* b3 = b2 + kstep;
            PG8_LDB(B0, 0, 0); PG8_LDB(B1, 0, 1); PG8_SCHED; PG8_LDA(At, 0, 0); PG8_STAGE_A(PG8_SA(1, 1), k1, oC10, oC11);
            PG8_WAIT_V(8); PG8_WAIT_L(0); PG8_BAR; PG8_MMA(0, 0, At, B0); PG8_MMA(0, 1, At, B1); PG8_BAR; PG8_SCHED;
            PG8_LDA(At, 0, 1); PG8_STAGE(PG8_SB(0, 0), b2, voffB); PG8_STAGE(PG8_SB(0, 1), b2 + hstep, voffB); PG8_STAGE_A(PG8_SA(0, 0), k2, o00, o01);
            PG8_WAIT_V(8); PG8_WAIT_L(0); PG8_BAR; PG8_MMA(1, 0, At, B0); PG8_MMA(1, 1, At, B1); PG8_BAR; PG8_SCHED;
            PG8_LDB(B0, 1, 0); PG8_LDB(B1, 1, 1); PG8_SCHED; PG8_LDA(At, 1, 0); PG8_STAGE_A(PG8_SA(0, 1), k2, o10, o11);
            PG8_WAIT_V(8); PG8_WAIT_L(0); PG8_BAR; PG8_MMA(0, 0, At, B0); PG8_MMA(0, 1, At, B1); PG8_BAR; PG8_SCHED;
            PG8_LDA(At, 1, 1); PG8_STAGE(PG8_SB(1, 0), b3, voffB); PG8_STAGE(PG8_SB(1, 1), b3 + hstep, voffB); PG8_STAGE_A(PG8_SA(1, 0), k3, o00, o01);
            PG8_WAIT_V(8); PG8_WAIT_L(0); PG8_BAR; PG8_MMA(1, 0, At, B0); PG8_MMA(1, 1, At, B1); PG8_BAR; PG8_SCHED;
        }
        if constexpr (ALIGN_EPI) { if (wr == 0) PG8_BAR; }
        E(acc, cur, wr, wc, fr, fq);
        if (!has_next) break;
#pragma unroll
        for (int a = 0; a < 2; ++a)
#pragma unroll
            for (int b = 0; b < 2; ++b)
#pragma unroll
                for (int m = 0; m < 4; ++m)
#pragma unroll
                    for (int n = 0; n < 2; ++n) acc[a][b][m][n] = (f32x4){0.f, 0.f, 0.f, 0.f};
        cur = nxt; cB = nB; oC00 = oN00; oC01 = oN01; oC10 = oN10; oC11 = oN11; ++ui;
        if constexpr (ALIGN_EPI) { if (wr == 1) PG8_BAR; }
    }
    PG8_WAIT_V(0);
    if constexpr (!ALIGN_EPI) { if (wr == 0) PG8_BAR; }
    PG8_BAR;
#undef PG8_SA
#undef PG8_SB
#undef PG8_STAGE
#undef PG8_STAGE_A
#undef PG8_LDA
#undef PG8_LDB
#undef PG8_MMA
#undef PG8_WAIT_V
#undef PG8_WAIT_L
#undef PG8_BAR
#undef PG8_SCHED
}
}
}
namespace att {
using namespace mk;
constexpr int KVBLK = 64;
constexpr int A_K = 0, A_V = 32768, A_WS = 65536, A_OST = A_WS + NWAVES * 256, A_BIAS = A_OST + NWAVES * 4096, A_SCAN = A_BIAS + 8192, A_BYTES = A_SCAN + 64;
static_assert(A_BYTES <= RING_BYTES, "attention LDS");
__device__ __forceinline__ int crow(int r, int hi) { return (r & 3) + 8 * (r >> 2) + 4 * hi; }
__device__ __forceinline__ void glds16(const void* gsrc, unsigned lds_dst) { unsigned keep;
    asm volatile("s_mov_b32 %0, m0\n\ts_mov_b32 m0, %2\n\ts_nop 0\n\tglobal_load_lds_dwordx4 %1, off\n\ts_mov_b32 m0, %0" : "=&s"(keep) : "v"(gsrc), "s"(lds_dst) : "memory"); }
__device__ __forceinline__ unsigned cvtpk(float lo, float hi) { return cvt_pk_bf16(lo, hi); }
__device__ __forceinline__ void qkt(f32x16& p0, f32x16& p1, const LAS char* Kslot, const bf16x8* qr, int r32, int hi) {
    const LAS char* kb = Kslot + hi * 1024 + r32 * 16;
    const f32x16 z = {};
#pragma unroll
    for (int d0 = 0; d0 < 4; ++d0) {
        const bf16x8 b0 = *(const LAS bf16x8*)(kb + d0 * 2048);
        const bf16x8 b1 = *(const LAS bf16x8*)(kb + d0 * 2048 + 512);
        if (d0 == 0) { p0 = __builtin_amdgcn_mfma_f32_32x32x16_bf16(b0, qr[0], z, 0, 0, 0); p1 = __builtin_amdgcn_mfma_f32_32x32x16_bf16(b1, qr[0], z, 0, 0, 0); }
        else { p0 = __builtin_amdgcn_mfma_f32_32x32x16_bf16(b0, qr[d0], p0, 0, 0, 0); p1 = __builtin_amdgcn_mfma_f32_32x32x16_bf16(b1, qr[d0], p1, 0, 0, 0); } }
}
__device__ __forceinline__ void pv(f32x16* o, int vb, bf16x8 pa0, bf16x8 pa1, bf16x8 pa2, bf16x8 pa3) {
#pragma unroll
    for (int d0 = 0; d0 < 2; ++d0) { s16x4 lo[4], hi[4];
#pragma unroll
        for (int ks = 0; ks < 4; ++ks) {
            asm volatile("ds_read_b64_tr_b16 %0,%1 offset:%c2" : "=&v"(lo[ks]) : "v"(vb), "i"(d0 * 4096 + ks * 1024) : "memory");
            asm volatile("ds_read_b64_tr_b16 %0,%1 offset:%c2" : "=&v"(hi[ks]) : "v"(vb), "i"(d0 * 4096 + ks * 1024 + 512) : "memory"); }
        asm volatile("s_waitcnt lgkmcnt(0)" ::: "memory"); __builtin_amdgcn_sched_barrier(0);
#define PK(k) (bf16x8){lo[k][0], lo[k][1], lo[k][2], lo[k][3], hi[k][0], hi[k][1], hi[k][2], hi[k][3]}
        o[d0] = __builtin_amdgcn_mfma_f32_32x32x16_bf16(pa0, PK(0), o[d0], 0, 0, 0);
        o[d0] = __builtin_amdgcn_mfma_f32_32x32x16_bf16(pa1, PK(1), o[d0], 0, 0, 0);
        o[d0] = __builtin_amdgcn_mfma_f32_32x32x16_bf16(pa2, PK(2), o[d0], 0, 0, 0);
        o[d0] = __builtin_amdgcn_mfma_f32_32x32x16_bf16(pa3, PK(3), o[d0], 0, 0, 0);
#undef PK
    }
}
__device__ __forceinline__ float rowmax32(const f32x16& p0, const f32x16& p1) {
    float a = fmaxf(p0[0], p1[0]);
#pragma unroll
    for (int r = 1; r < 16; ++r) a = fmaxf(a, fmaxf(p0[r], p1[r]));
    auto rr = __builtin_amdgcn_permlane32_swap(__float_as_uint(a), __float_as_uint(a), false, false);
    return fmaxf(__uint_as_float(rr[0]), __uint_as_float(rr[1]));
}
#define A_WAIT_BAR(N) asm volatile("s_waitcnt vmcnt(" #N ") lgkmcnt(0)\n\ts_barrier" ::: "memory")

template <bool SWA>
__device__ __forceinline__ void attn_tiles(LAS char* shm, const bf16_t* Qw, int qpitch, const bf16_t* Kh, const bf16_t* Vh, int kvpitch, bf16_t* Ow, int opitch,
                                           int kt0, int ntile, int qpos0, float sl2, float sink2) {
    const int tid = threadIdx.x, lane = tid & 63, r32 = lane & 31, hi = lane >> 5; const int wid = __builtin_amdgcn_readfirstlane(tid >> 6);
    const unsigned lds0 = (unsigned)(uintptr_t)shm;
    LAS float* wsf = (LAS float*)(shm + A_WS) + wid * 64;
    const LAS float* biasl = (const LAS float*)(shm + A_BIAS);
    const bf16_t* ksrc = Kh + (long)lane * kvpitch + wid * 8;
    const bf16_t* vsrc = Vh + (long)(16 * (wid & 3) + (lane >> 2)) * kvpitch + (wid >> 2) * 32 + (lane & 3) * 8;
    const unsigned kdst = lds0 + A_K + wid * 1024, vdst = lds0 + A_V + wid * 1024;
#define DMA_K(t, slot) glds16(ksrc + (long)(t) * KVBLK * kvpitch, (unsigned)__builtin_amdgcn_readfirstlane(kdst + (slot)))
#define DMA_V(t, slot) glds16(vsrc + (long)(t) * KVBLK * kvpitch, (unsigned)__builtin_amdgcn_readfirstlane(vdst + (slot)))
    const int vb0 = (int)(lds0 + A_V) + ((lane >> 4) & 1) * 32 + (lane & 3) * 8 + (4 * hi + ((lane & 15) >> 2)) * 64;
    DMA_K(kt0, 0); DMA_V(kt0, 0);
    if (ntile > 1) { DMA_K(kt0 + 1, 8192); DMA_V(kt0 + 1, 8192); }
    if (ntile > 2) { DMA_K(kt0 + 2, 16384); DMA_V(kt0 + 2, 16384); }
    bf16x8 qr[4];
#pragma unroll
    for (int d0 = 0; d0 < 4; ++d0) qr[d0] = *(const bf16x8*)(Qw + (long)r32 * qpitch + d0 * 16 + hi * 8);
    float m = SWA ? sink2 : -INFINITY, l = (SWA && hi == 0) ? 1.f : 0.f;
    f32x16 o[2]; o[0] = f32x16{}; o[1] = f32x16{};
    const int qpos = qpos0 + r32;
    if (ntile > 2) { A_WAIT_BAR(4); } else if (ntile > 1) { A_WAIT_BAR(2); } else { A_WAIT_BAR(0); }
    f32x16 p0, p1;
    qkt(p0, p1, shm + A_K, qr, r32, hi);
    for (int it = 0; it < ntile; ++it) {
        const int kt = kt0 + it, slot = (it & 3) * 8192;
        f32x16 n0, n1;
        if (it + 1 < ntile) {
            if (it + 2 < ntile) { A_WAIT_BAR(2); } else { A_WAIT_BAR(0); }
            if (it + 3 < ntile) { DMA_K(kt + 3, ((it + 3) & 3) * 8192); DMA_V(kt + 3, ((it + 3) & 3) * 8192); }
            qkt(n0, n1, shm + A_K + ((it + 1) & 3) * 8192, qr, r32, hi);
        }
        const int kb = kt * 64 + 4 * hi;
        if (SWA) {
#pragma unroll
            for (int r = 0; r < 16; ++r) { const int k0 = kb + (r & 3) + 8 * (r >> 2), k1 = k0 + 32;
                p0[r] = (k0 <= qpos && k0 >= qpos - 127) ? p0[r] + sl2 * (float)(k0 - qpos) : -INFINITY;
                p1[r] = (k1 <= qpos && k1 >= qpos - 127) ? p1[r] + sl2 * (float)(k1 - qpos) : -INFINITY; }
        } else {
#pragma unroll
            for (int g = 0; g < 4; ++g) { const f32x4 b0 = *(const LAS f32x4*)(biasl + kb + 8 * g), b1 = *(const LAS f32x4*)(biasl + kb + 32 + 8 * g);
#pragma unroll
                for (int i = 0; i < 4; ++i) { p0[4 * g + i] += b0[i]; p1[4 * g + i] += b1[i]; } }
            if (kt * 64 + 63 > qpos0) {
#pragma unroll
                for (int r = 0; r < 16; ++r) { const int k0 = kb + (r & 3) + 8 * (r >> 2); if (k0 > qpos) p0[r] = -INFINITY; if (k0 + 32 > qpos) p1[r] = -INFINITY; }
            }
        }
        const float rm = rowmax32(p0, p1), mn = fmaxf(m, rm), ms = (mn == -INFINITY) ? 0.f : mn;
        const float alpha = __builtin_amdgcn_exp2f(m - ms);
        float rs = 0.f;
#pragma unroll
        for (int r = 0; r < 16; ++r) { p0[r] = __builtin_amdgcn_exp2f(p0[r] - ms); p1[r] = __builtin_amdgcn_exp2f(p1[r] - ms); rs += p0[r] + p1[r]; }
        l = l * alpha + rs; m = mn;
        if (hi == 0) wsf[r32] = alpha;
        asm volatile("s_waitcnt lgkmcnt(0)" ::: "memory");
#pragma unroll
        for (int r = 0; r < 16; ++r) { const float a = wsf[crow(r, hi)]; o[0][r] *= a; o[1][r] *= a; }
        u32x4 pw0, pw1, pw2, pw3;
        pw0 = (u32x4){cvtpk(p0[0], p0[1]), cvtpk(p0[2], p0[3]), cvtpk(p0[4], p0[5]), cvtpk(p0[6], p0[7])};
        pw1 = (u32x4){cvtpk(p0[8], p0[9]), cvtpk(p0[10], p0[11]), cvtpk(p0[12], p0[13]), cvtpk(p0[14], p0[15])};
        pw2 = (u32x4){cvtpk(p1[0], p1[1]), cvtpk(p1[2], p1[3]), cvtpk(p1[4], p1[5]), cvtpk(p1[6], p1[7])};
        pw3 = (u32x4){cvtpk(p1[8], p1[9]), cvtpk(p1[10], p1[11]), cvtpk(p1[12], p1[13]), cvtpk(p1[14], p1[15])};
        pv(o, vb0 + slot, __builtin_bit_cast(bf16x8, pw0), __builtin_bit_cast(bf16x8, pw1), __builtin_bit_cast(bf16x8, pw2), __builtin_bit_cast(bf16x8, pw3));
        asm volatile("s_waitcnt lgkmcnt(0)" ::: "memory");
        if (it + 1 < ntile) { p0 = n0; p1 = n1; }
    }
    { auto rr = __builtin_amdgcn_permlane32_swap(__float_as_uint(l), __float_as_uint(l), false, false); l = __uint_as_float(rr[0]) + __uint_as_float(rr[1]); }
    if (hi == 0) wsf[32 + r32] = l;
    asm volatile("s_waitcnt lgkmcnt(0)" ::: "memory");
    LAS bf16_t* stg = (LAS bf16_t*)(shm + A_OST) + wid * 2048;
#pragma unroll
    for (int r = 0; r < 16; ++r) { const int orow = crow(r, hi); const float rl = 1.f / wsf[32 + orow];
#pragma unroll
        for (int d0 = 0; d0 < 2; ++d0) stg[orow * 64 + d0 * 32 + r32] = (bf16_t)(cvt_pk_bf16(o[d0][r] * rl, 0.f) & 0xffffu); }
    asm volatile("s_waitcnt lgkmcnt(0)" ::: "memory");
#pragma unroll
    for (int i = 0; i < 4; ++i) { const int row = i * 8 + (lane >> 3), ch = lane & 7; const u32x4 v = *(const LAS u32x4*)(stg + row * 64 + ch * 8); *(u32x4*)(Ow + (long)row * opitch + ch * 8) = v; }
    asm volatile("s_waitcnt vmcnt(0) lgkmcnt(0)\n\ts_barrier" ::: "memory");
#undef DMA_K
#undef DMA_V
}

__device__ __forceinline__ void fox_unit(LAS char* shm, int b, int h, int qb, const bf16_t* proj, const float* fb, float fbias_h, bf16_t* heads) {
    const int tid = threadIdx.x, lane = tid & 63; const int wid = __builtin_amdgcn_readfirstlane(tid >> 6);
    LAS float* biasl = (LAS float*)(shm + A_BIAS); LAS float* scan = (LAS float*)(shm + A_SCAN);
    const int kend = (qb + 1) * 256;
    float v[4]; float s = 0.f;
#pragma unroll
    for (int i = 0; i < 4; ++i) { const int p = tid * 4 + i; float lf = 0.f; if (p < kend) lf = log_sigmoid_fast(fb[((size_t)b * SEQ + p) * 8 + h] + fbias_h); s += lf; v[i] = s; }
    float w = s;
#pragma unroll
    for (int o = 1; o < 64; o <<= 1) { const float t = __shfl_up(w, o); if (lane >= o) w += t; }
    if (lane == 63) scan[wid] = w;
    asm volatile("s_waitcnt lgkmcnt(0)\n\ts_barrier" ::: "memory");
    float off = w - s;
    for (int k = 0; k < 8; ++k) if (k < wid) off += scan[k];
#pragma unroll
    for (int i = 0; i < 4; ++i) biasl[tid * 4 + i] = -(v[i] + off) * LOG2E;
    asm volatile("s_waitcnt lgkmcnt(0)\n\ts_barrier" ::: "memory");
    const size_t rowb = (size_t)b * SEQ; const int q0 = qb * 256 + wid * 32;
    attn_tiles<false>(shm, proj + (rowb + q0) * NE_IN + 768 + h * 64, NE_IN, proj + rowb * NE_IN + 1280 + h * 64, proj + rowb * NE_IN + 1792 + h * 64, NE_IN,
                      heads + (rowb + q0) * 1024 + 512 + h * 64, 1024, 0, 4 * (qb + 1), q0, 0.f, 0.f);
}
__device__ __forceinline__ void swa_unit(LAS char* shm, int b, int kvh, int blk, const bf16_t* proj, const float* sinks, bf16_t* heads) {
    const int wid = __builtin_amdgcn_readfirstlane(threadIdx.x >> 6);
    const int qh = kvh * 4 + (wid >> 1), q0 = blk * 64 + (wid & 1) * 32;
    const size_t rowb = (size_t)b * SEQ;
    const int kt0 = blk >= 2 ? blk - 2 : 0, ntile = blk - kt0 + 1;
    const float sl2 = exp2f(-(float)(qh + 1)) * LOG2E, sink2 = sinks[qh] * LOG2E;
    attn_tiles<true>(shm, proj + (rowb + q0) * NE_IN + qh * 64, NE_IN, proj + rowb * NE_IN + 512 + kvh * 64, proj + rowb * NE_IN + 640 + kvh * 64, NE_IN,
                     heads + (rowb + q0) * 1024 + qh * 64, 1024, kt0, ntile, q0, sl2, sink2);
}
#undef A_WAIT_BAR
}

namespace attp {
using bf16=__hip_bfloat16;
using bf16x8=__attribute__((ext_vector_type(8)))short;
using s16x4=__attribute__((ext_vector_type(4)))short;
using f32x16=__attribute__((ext_vector_type(16)))float;
using u32x4=__attribute__((ext_vector_type(4)))unsigned;
constexpr int BATCH=8,NHEAD=8,SEQ=2048,D=64,DM=2560,OPITCH=1024;
constexpr int NW=8,QBLK=32,QB=QBLK*NW,KVBLK=64,NQB=SEQ/QB;
constexpr int ATTN_PITCH=DM, ATTN_UNIT_ROWS=QB;
__device__ __forceinline__ int crow(int r,int hi){return (r&3)+8*(r>>2)+4*hi;}
#define SBAR() __builtin_amdgcn_sched_barrier(0)
__device__ __forceinline__ void cmask(f32x16&p0,f32x16&p1,int jb,int qrel,int hi){
  const float NEG=-INFINITY; int kb=64*jb+4*hi;
  #pragma unroll
  for(int r=0;r<16;++r){int kv=kb+(r&3)+8*(r>>2); if(kv>qrel)p0[r]=NEG; if(kv+32>qrel)p1[r]=NEG;}
}

constexpr int NSLOT=3, SLOTB=8192;
constexpr int LDS_K=0, LDS_V=NSLOT*SLOTB, LDS_WS=2*NSLOT*SLOTB, LDS_OST=LDS_WS+NW*64*4, LDS_BIAS=LDS_OST+NW*4096, LDS_SCAN=LDS_BIAS+8192, LDS_BYTES=LDS_SCAN+64;
constexpr float C2=0.125f*1.4426950408889634f;
__device__ __forceinline__ void glds16(const void*gsrc,unsigned lds_dst){unsigned keep;
  asm volatile("s_mov_b32 %0, m0\n\ts_mov_b32 m0, %2\n\ts_nop 0\n\tglobal_load_lds_dwordx4 %1, off\n\ts_mov_b32 m0, %0":"=&s"(keep):"v"(gsrc),"s"(lds_dst):"memory");}
__device__ __forceinline__ float max3f(float a,float b,float c){float r;asm("v_max3_f32 %0, %1, %2, %3":"=v"(r):"v"(a),"v"(b),"v"(c));return r;}
__device__ __forceinline__ float max2f(float a,float b){float r;asm("v_max_f32_e32 %0, %1, %2":"=v"(r):"v"(a),"v"(b));return r;}
__device__ __forceinline__ float fadd_s(float a,float b){float r;asm("v_add_f32_e32 %0, %1, %2":"=v"(r):"v"(a),"v"(b));return r;}
__device__ __forceinline__ float fsub_s(float a,float b){float r;asm("v_sub_f32_e32 %0, %1, %2":"=v"(r):"v"(a),"v"(b));return r;}
typedef float f32x2_t __attribute__((ext_vector_type(2))); typedef __bf16 bf16x2_t __attribute__((ext_vector_type(2)));
__device__ __forceinline__ unsigned cvtpk_s(float lo,float hi){f32x2_t v={lo,hi};bf16x2_t b=__builtin_convertvector(v,bf16x2_t);return __builtin_bit_cast(unsigned,b);}
#define WAIT_BAR(N) asm volatile("s_waitcnt vmcnt(" #N ") lgkmcnt(0)\n\ts_barrier":::"memory")

__device__ __forceinline__ void qkt(f32x16&p0,f32x16&p1,const char*Kslot,const bf16x8*qr,int r32,int hi){ const f32x16 zc_=f32x16{};
  const char*kb=Kslot+hi*1024+r32*16;
  #pragma unroll
  for(int d0=0;d0<4;++d0){
    const bf16x8 b0=*reinterpret_cast<const bf16x8*>(kb+d0*2048);
    const bf16x8 b1=*reinterpret_cast<const bf16x8*>(kb+d0*2048+512);
    if(d0==0){p0=__builtin_amdgcn_mfma_f32_32x32x16_bf16(b0,qr[0],zc_,0,0,0);p1=__builtin_amdgcn_mfma_f32_32x32x16_bf16(b1,qr[0],zc_,0,0,0);}
    else{p0=__builtin_amdgcn_mfma_f32_32x32x16_bf16(b0,qr[d0],p0,0,0,0);p1=__builtin_amdgcn_mfma_f32_32x32x16_bf16(b1,qr[d0],p1,0,0,0);}}
}
typedef __attribute__((address_space(3))) const char* lds_cptr;
typedef short v4i16_t __attribute__((ext_vector_type(4)));
__device__ __forceinline__ void kload8(bf16x8*kf,lds_cptr kp){
  kf[0]=*(const __attribute__((address_space(3))) bf16x8*)(kp);      kf[1]=*(const __attribute__((address_space(3))) bf16x8*)(kp+512);
  kf[2]=*(const __attribute__((address_space(3))) bf16x8*)(kp+2048); kf[3]=*(const __attribute__((address_space(3))) bf16x8*)(kp+2560);
  kf[4]=*(const __attribute__((address_space(3))) bf16x8*)(kp+4096); kf[5]=*(const __attribute__((address_space(3))) bf16x8*)(kp+4608);
  kf[6]=*(const __attribute__((address_space(3))) bf16x8*)(kp+6144); kf[7]=*(const __attribute__((address_space(3))) bf16x8*)(kp+6656);
}
__device__ __forceinline__ void kload2(bf16x8*kf,lds_cptr kp,int j){ kf[2*j]=*(const __attribute__((address_space(3))) bf16x8*)(kp+j*2048); kf[2*j+1]=*(const __attribute__((address_space(3))) bf16x8*)(kp+j*2048+512); }
__device__ __forceinline__ s16x4 vtr(lds_cptr p){ return __builtin_bit_cast(s16x4,__builtin_amdgcn_ds_read_tr16_b64_v4i16((__attribute__((address_space(3))) v4i16_t*)p)); }
__device__ __forceinline__ float rowmax(const f32x16&p0,const f32x16&p1){
  float a=max3f(p0[0],p0[1],p1[0]),b=max3f(p0[2],p0[3],p1[1]);a=max3f(a,p1[2],p1[3]);
  #pragma unroll
  for(int r=4;r<16;r+=4){a=max3f(a,p0[r],p0[r+1]);b=max3f(b,p0[r+2],p0[r+3]);a=max3f(a,p1[r],p1[r+1]);b=max3f(b,p1[r+2],p1[r+3]);}
  const float m=max2f(a,b);
  auto rr=__builtin_amdgcn_permlane32_swap(__float_as_uint(m),__float_as_uint(m),false,false);
  return max2f(__uint_as_float(rr[0]),__uint_as_float(rr[1]));
}
__device__ __forceinline__ void pv(f32x16*o,int vb,bf16x8 pa0,bf16x8 pa1,bf16x8 pa2,bf16x8 pa3){
  #pragma unroll
  for(int d0=0;d0<2;++d0){s16x4 lo[4],hi[4];
    #pragma unroll
    for(int ks=0;ks<4;++ks){
      asm volatile("ds_read_b64_tr_b16 %0,%1 offset:%c2":"=&v"(lo[ks]):"v"(vb),"i"(d0*4096+ks*1024):"memory");
      asm volatile("ds_read_b64_tr_b16 %0,%1 offset:%c2":"=&v"(hi[ks]):"v"(vb),"i"(d0*4096+ks*1024+512):"memory");}
    asm volatile("s_waitcnt lgkmcnt(0)":::"memory");SBAR();
    #define PK(k) (bf16x8){lo[k][0],lo[k][1],lo[k][2],lo[k][3],hi[k][0],hi[k][1],hi[k][2],hi[k][3]}
    o[d0]=__builtin_amdgcn_mfma_f32_32x32x16_bf16(pa0,PK(0),o[d0],0,0,0);
    o[d0]=__builtin_amdgcn_mfma_f32_32x32x16_bf16(pa1,PK(1),o[d0],0,0,0);
    o[d0]=__builtin_amdgcn_mfma_f32_32x32x16_bf16(pa2,PK(2),o[d0],0,0,0);
    o[d0]=__builtin_amdgcn_mfma_f32_32x32x16_bf16(pa3,PK(3),o[d0],0,0,0);
    #undef PK
  }
}

#ifndef ATTN_STORE16
#define ATTN_STORE16(p,v) (*(u32x4*)(p)=(v))
#endif
template<int THRL,bool CHECK> __device__ __forceinline__ void attn_unit(int b,int h,int qb,const bf16*Q,const bf16*__restrict__ K,const bf16*__restrict__ V,bf16*O,char*shm,unsigned*mism){
  const int tid=threadIdx.x,lane=tid&63,r32=lane&31,hi=lane>>5; const int wid=__builtin_amdgcn_readfirstlane(tid>>6);
  const long rowbase=(long)b*SEQ; const int q0=qb*QB;
  const bf16*Qw=Q+(rowbase+q0+wid*QBLK)*DM+h*D;
  const bf16*Kh=K+rowbase*DM+h*D,*Vh=V+rowbase*DM+h*D;
  const unsigned lds0=(unsigned)(uintptr_t)shm;
  float*wsf=(float*)(shm+LDS_WS)+wid*64;
  const bf16*ksrc=Kh+(long)lane*DM+wid*8;
  const bf16*vsrc=Vh+(long)(16*(wid&3)+(lane>>2))*DM+(wid>>2)*32+(lane&3)*8;
  const unsigned kdst=lds0+LDS_K+wid*1024, vdst=lds0+LDS_V+wid*1024;
  #define DMA_K(t,slot) glds16(ksrc+(long)(t)*KVBLK*DM,(unsigned)__builtin_amdgcn_readfirstlane(kdst+(slot)))
  #define DMA_V(t,slot) glds16(vsrc+(long)(t)*KVBLK*DM,(unsigned)__builtin_amdgcn_readfirstlane(vdst+(slot)))
  const int vb0=(int)(lds0+LDS_V)+((lane>>4)&1)*32+(lane&3)*8+(4*hi+((lane&15)>>2))*64;
  const char*Kbase=shm+LDS_K; bf16x8 kf[8];
  const lds_cptr shm3=(lds_cptr)shm; const lds_cptr kp0=shm3+LDS_K+hi*1024+r32*16; const lds_cptr vp0=shm3+LDS_V+((lane>>4)&1)*32+(lane&3)*8+(4*hi+((lane&15)>>2))*64;
  const int NT=(q0+QB)/KVBLK;
  DMA_K(0,0);DMA_V(0,0);DMA_K(1,SLOTB);
  bf16x8 qr[4];
  #pragma unroll
  for(int d0=0;d0<4;++d0)qr[d0]=*reinterpret_cast<const bf16x8*>(&Qw[(long)r32*DM+d0*16+hi*8]);
  float mhat=0.f,l_reg=0.f;f32x16 o[2];o[0]=f32x16{};o[1]=f32x16{};u32x4 qaw={hi==0?0x3f803f80u:0u,0u,0u,0u};
  const int qrel=wid*QBLK+r32;
  #define CMASK(P0,P1,t) do{int jb_=(t)-(NT-4); if(jb_>=0)cmask(P0,P1,jb_,qrel,hi);}while(0)
  const __attribute__((address_space(3))) unsigned* biasw=(const __attribute__((address_space(3))) unsigned*)(shm3+LDS_BIAS)+r32;
  #define SETM() do{ const float nm_=-mhat; const unsigned h_=cvtpk_s(nm_,0.f)&0xffffu; const unsigned l_=cvtpk_s(nm_-__uint_as_float(h_<<16),0.f)&0xffffu; qaw[1]=(hi==0)?(h_|(l_<<16)):0u; }while(0)
  #define AUG(P0,P1,t) do{ const unsigned w0_=biasw[64*(t)], w1_=biasw[64*(t)+32]; const u32x4 ka0_={w0_,0x3f803f80u,0u,0u}, ka1_={w1_,0x3f803f80u,0u,0u}; \
      P0=__builtin_amdgcn_mfma_f32_32x32x16_bf16(__builtin_bit_cast(bf16x8,ka0_),__builtin_bit_cast(bf16x8,qaw),P0,0,0,0); \
      P1=__builtin_amdgcn_mfma_f32_32x32x16_bf16(__builtin_bit_cast(bf16x8,ka1_),__builtin_bit_cast(bf16x8,qaw),P1,0,0,0); }while(0)
  bool resc=false;
  #define START(P0,P1) do{ const float rm=rowmax(P0,P1); resc=false; \
    { const float dl=rm; mhat=fadd_s(mhat,dl); \
      _Pragma("unroll") for(int r=0;r<16;++r){P0[r]=fsub_s(P0[r],dl);P1[r]=fsub_s(P1[r],dl);} \
      SETM(); } \
    _Pragma("unroll") for(int r=0;r<16;++r)P0[r]=__builtin_amdgcn_exp2f(P0[r]); }while(0)
  #define RESC() do{ if(resc){ asm volatile("s_waitcnt lgkmcnt(0)":::"memory"); \
      _Pragma("unroll") for(int d_=0;d_<2;++d_) _Pragma("unroll") for(int r=0;r<16;++r)o[d_][r]*=wsf[crow(r,hi)]; } }while(0)
  f32x16 pA0,pA1,pB0,pB1;
  int sl_prev=0,sl_cur=0,sl_next=SLOTB;
  #define ROT() do{sl_prev=sl_cur;sl_cur=sl_next;sl_next=(sl_next==(NSLOT-1)*SLOTB)?0:sl_next+SLOTB;}while(0)
  DMA_K(2,2*SLOTB);
  WAIT_BAR(3);
  qkt(pA0,pA1,Kbase,qr,r32,hi);AUG(pA0,pA1,0);asm volatile("s_nop 15\n\ts_nop 7":"+v"(pA0),"+v"(pA1));CMASK(pA0,pA1,0);
  START(pA0,pA1);
  _Pragma("unroll") for(int r=0;r<16;++r)pA1[r]=__builtin_amdgcn_exp2f(pA1[r]);
  WAIT_BAR(0);
  DMA_K(3,0);DMA_V(1,SLOTB);
  ROT();
  kload8(kf,kp0+sl_cur);
  WAIT_BAR(2);
  s16x4 vlo[8],vhi[8]; u32x4 pw0,pw1,pw2,pw3; const f32x16 zc16=f32x16{};
  #define PKW(P,B) cvtpk_s(P[B],P[B+1])
  #define PAF(k) __builtin_bit_cast(bf16x8,pw##k)
  #define VFR(i) (bf16x8){vlo[i][0],vlo[i][1],vlo[i][2],vlo[i][3],vhi[i][0],vhi[i][1],vhi[i][2],vhi[i][3]}
  #define PIN(x) asm volatile("":"+v"(x))
  #define MX3(a,b,c) __builtin_fmaxf(__builtin_fmaxf((a),(b)),(c))
  #define GAPA(MF,A0,A1,A2,A3,W0,W1,PW) do{ MF; sacc+=A0; sacc+=A1; sacc+=A2; sacc+=A3; PIN(sacc); W0; W1; PIN(PW); SBAR(); }while(0)
  #define EX(v) __builtin_amdgcn_exp2f(v)
  #define GAPB(MF,X,B) do{ MF; X[B]=EX(X[B]); X[B+1]=EX(X[B+1]); X[B+2]=EX(X[B+2]); X[B+3]=EX(X[B+3]); PIN(X); SBAR(); }while(0)
  #define VRD(i) do{ vlo[i]=vtr(vp_+(((i)>>2)*4096+((i)&3)*1024)); vhi[i]=vtr(vp_+(((i)>>2)*4096+((i)&3)*1024+512)); }while(0)
  #define KRD(G,j) do{ if(G){ kload2(kf,kp0+sl_next,j); SBAR(); } }while(0)
  #define STEP(C0,C1,P0,P1,t,GK,GV,GL) do{ SBAR(); \
    const lds_cptr vp_=vp0+sl_prev; \
    VRD(0); SBAR(); float sacc=(P0[0]+P0[1]); \
    GAPA(C0=__builtin_amdgcn_mfma_f32_32x32x16_bf16(kf[0],qr[0],zc16,0,0,0), P0[2],P0[3],P0[4],P0[5],     pw0[0]=PKW(P0,0), pw0[1]=PKW(P0,2), pw0); \
    VRD(4); SBAR(); GAPA(C1=__builtin_amdgcn_mfma_f32_32x32x16_bf16(kf[1],qr[0],zc16,0,0,0), P0[6],P0[7],P0[8],P0[9],     pw0[2]=PKW(P0,4), pw0[3]=PKW(P0,6), pw0); \
    VRD(1); SBAR(); GAPA(C0=__builtin_amdgcn_mfma_f32_32x32x16_bf16(kf[2],qr[1],C0,0,0,0),   P0[10],P0[11],P0[12],P0[13], pw1[0]=PKW(P0,8), pw1[1]=PKW(P0,10), pw1); \
    VRD(5); SBAR(); GAPA(C1=__builtin_amdgcn_mfma_f32_32x32x16_bf16(kf[3],qr[1],C1,0,0,0),   P0[14],P0[15],P1[0],P1[1],   pw1[2]=PKW(P0,12),pw1[3]=PKW(P0,14), pw1); \
    VRD(2); SBAR(); GAPA(C0=__builtin_amdgcn_mfma_f32_32x32x16_bf16(kf[4],qr[2],C0,0,0,0),   P1[2],P1[3],P1[4],P1[5],     pw2[0]=PKW(P1,0), pw2[1]=PKW(P1,2), pw2); \
    VRD(6); SBAR(); GAPA(C1=__builtin_amdgcn_mfma_f32_32x32x16_bf16(kf[5],qr[2],C1,0,0,0),   P1[6],P1[7],P1[8],P1[9],     pw2[2]=PKW(P1,4), pw2[3]=PKW(P1,6), pw2); \
    VRD(3); SBAR(); GAPA(C0=__builtin_amdgcn_mfma_f32_32x32x16_bf16(kf[6],qr[3],C0,0,0,0),   P1[10],P1[11],P1[12],P1[13], pw3[0]=PKW(P1,8), pw3[1]=PKW(P1,10), pw3); \
    VRD(7); SBAR(); GAPA(C1=__builtin_amdgcn_mfma_f32_32x32x16_bf16(kf[7],qr[3],C1,0,0,0),   P1[14],P1[15],0.f,0.f,       pw3[2]=PKW(P1,12),pw3[3]=PKW(P1,14), pw3); \
    AUG(C0,C1,t); l_reg+=sacc; \
    if(GK){DMA_K((t)+3,sl_cur);} if(GV){DMA_V((t)+1,sl_next);} \
    CMASK(C0,C1,t); \
    { float a=MX3(C0[0],C0[1],C1[0]),b=MX3(C0[2],C0[3],C1[1]); a=MX3(a,C1[2],C1[3]); \
      _Pragma("unroll") for(int r=4;r<16;r+=4){a=MX3(a,C0[r],C0[r+1]);b=MX3(b,C0[r+2],C0[r+3]);a=MX3(a,C1[r],C1[r+1]);b=MX3(b,C1[r+2],C1[r+3]);} \
      float rm=__builtin_fmaxf(a,b); { auto rr=__builtin_amdgcn_permlane32_swap(__float_as_uint(rm),__float_as_uint(rm),false,false); rm=__builtin_fmaxf(__uint_as_float(rr[0]),__uint_as_float(rr[1])); } \
      resc=false; \
      if(__builtin_expect(__any(rm>(float)THRL),0)){ const float dl=__builtin_fmaxf(rm,0.f); mhat+=dl; \
        _Pragma("unroll") for(int r=0;r<16;++r){C0[r]-=dl;C1[r]-=dl;} \
        SETM(); \
        const float f=__builtin_amdgcn_exp2f(-dl); l_reg*=f; if(hi==0)wsf[r32]=f; resc=true; } } \
    SBAR(); \
    GAPB(o[0]=__builtin_amdgcn_mfma_f32_32x32x16_bf16(PAF(0),VFR(0),o[0],0,0,0), C0,0); \
    GAPB(o[1]=__builtin_amdgcn_mfma_f32_32x32x16_bf16(PAF(0),VFR(4),o[1],0,0,0), C0,4); \
    KRD(GL,0); GAPB(o[0]=__builtin_amdgcn_mfma_f32_32x32x16_bf16(PAF(1),VFR(1),o[0],0,0,0), C0,8); \
    KRD(GL,1); GAPB(o[1]=__builtin_amdgcn_mfma_f32_32x32x16_bf16(PAF(1),VFR(5),o[1],0,0,0), C0,12); \
    KRD(GL,2); GAPB(o[0]=__builtin_amdgcn_mfma_f32_32x32x16_bf16(PAF(2),VFR(2),o[0],0,0,0), C1,0); \
    KRD(GL,3); GAPB(o[1]=__builtin_amdgcn_mfma_f32_32x32x16_bf16(PAF(2),VFR(6),o[1],0,0,0), C1,4); \
    GAPB(o[0]=__builtin_amdgcn_mfma_f32_32x32x16_bf16(PAF(3),VFR(3),o[0],0,0,0), C1,8); \
    GAPB(o[1]=__builtin_amdgcn_mfma_f32_32x32x16_bf16(PAF(3),VFR(7),o[1],0,0,0), C1,12); \
    }while(0)
  int t=1;
  #undef CMASK
  #define CMASK(P0,P1,t) do{}while(0)
  for(;t+5<NT;t+=2){
    STEP(pB0,pB1,pA0,pA1,t,true,true,true);     WAIT_BAR(2); RESC(); ROT();
    STEP(pA0,pA1,pB0,pB1,t+1,true,true,true);   WAIT_BAR(2); RESC(); ROT();
  }
  #undef CMASK
  #define CMASK(P0,P1,t) do{int jb_=(t)-(NT-4); if(jb_>=0)cmask(P0,P1,jb_,qrel,hi);}while(0)
  #define ENDW(tt) do{ if((tt)+3<NT){WAIT_BAR(2);} else if((tt)+2<NT){WAIT_BAR(1);} else {WAIT_BAR(0);} }while(0)
  for(;t+1<NT;t+=2){
    STEP(pB0,pB1,pA0,pA1,t,(t+3<NT),(t+1<NT),(t+1<NT));       ENDW(t);   RESC(); ROT();
    STEP(pA0,pA1,pB0,pB1,t+1,(t+4<NT),(t+2<NT),(t+2<NT));     ENDW(t+1); RESC(); ROT();
  }
  STEP(pB0,pB1,pA0,pA1,NT-1,false,false,false); RESC();
  { float sacc=pB0[0]+pB0[1]; _Pragma("unroll") for(int r=2;r<16;++r)sacc+=pB0[r]; _Pragma("unroll") for(int r=0;r<16;++r)sacc+=pB1[r]; l_reg+=sacc;
    pw0=(u32x4){PKW(pB0,0),PKW(pB0,2),PKW(pB0,4),PKW(pB0,6)};pw1=(u32x4){PKW(pB0,8),PKW(pB0,10),PKW(pB0,12),PKW(pB0,14)};pw2=(u32x4){PKW(pB1,0),PKW(pB1,2),PKW(pB1,4),PKW(pB1,6)};pw3=(u32x4){PKW(pB1,8),PKW(pB1,10),PKW(pB1,12),PKW(pB1,14)};
    SBAR(); pv(o,vb0+sl_cur,PAF(0),PAF(1),PAF(2),PAF(3)); }
  #undef PKW
  #undef PAF
  #undef VFR
  #undef PIN
  #undef MX3
  #undef GAPA
  #undef GAPB
  #undef EX
  #undef VRD
  #undef KRD
  #undef STEP
  #undef ENDW
  {auto rr=__builtin_amdgcn_permlane32_swap(__float_as_uint(l_reg),__float_as_uint(l_reg),false,false);l_reg=__uint_as_float(rr[0])+__uint_as_float(rr[1]);}
  if(hi==0)wsf[32+r32]=l_reg;asm volatile("s_waitcnt lgkmcnt(0)":::"memory");
  float rli[16];
  #pragma unroll
  for(int r=0;r<16;++r)rli[r]=__builtin_amdgcn_rcpf(wsf[32+crow(r,hi)]);
  bf16*Ow=O+(rowbase+q0+wid*QBLK)*OPITCH+h*D;
  { bf16*stg=(bf16*)(shm+LDS_OST)+wid*2048;
    #pragma unroll
    for(int r=0;r<16;++r){const int orow=crow(r,hi);
      #pragma unroll
      for(int d0=0;d0<2;++d0)stg[orow*64+d0*32+r32]=__float2bfloat16(o[d0][r]*rli[r]);}
    asm volatile("s_waitcnt lgkmcnt(0)":::"memory");
    #pragma unroll
    for(int i=0;i<4;++i){const int row=i*8+(lane>>3),ch=lane&7; const u32x4 v=*(const u32x4*)(stg+row*64+ch*8); ATTN_STORE16(Ow+(long)row*OPITCH+ch*8,v);} }
  asm volatile("s_waitcnt lgkmcnt(0)\n\ts_barrier":::"memory");
  #undef DMA_K
  #undef DMA_V
  #undef CMASK
  #undef AUG
  #undef SETM
  #undef START
  #undef RESC
  #undef ROT
}
constexpr int ATTN_LDS_BYTES=LDS_BYTES;
#undef SBAR
#undef WAIT_BAR
}

namespace att {
template <bool CHECK> __device__ __forceinline__ void fox_unit_p(char* shm_g, LAS char* shm, int b, int h, int qb, const bf16_t* proj, const float* fb, float fbias_h, bf16_t* heads, unsigned* mism, bool do_scan) {
    const int tid = threadIdx.x, lane = tid & 63; const int wid = __builtin_amdgcn_readfirstlane(tid >> 6);
    if (do_scan) {
    LAS unsigned* biasw = (LAS unsigned*)(shm + attp::LDS_BIAS); LAS float* scan = (LAS float*)(shm + attp::LDS_SCAN);
    const int kend = (qb + 1) * 256;
    float v[4]; float s = 0.f;
#pragma unroll
    for (int i = 0; i < 4; ++i) { const int p = tid * 4 + i; float lf = 0.f; if (p < kend) lf = log_sigmoid_fast(fb[((size_t)b * SEQ + p) * 8 + h] + fbias_h); s += lf; v[i] = s; }
    float w = s;
#pragma unroll
    for (int o = 1; o < 64; o <<= 1) { const float t = __shfl_up(w, o); if (lane >= o) w += t; }
    if (lane == 63) scan[wid] = w;
    asm volatile("s_waitcnt lgkmcnt(0)\n\ts_barrier" ::: "memory");
    float off = w - s;
    for (int k = 0; k < 8; ++k) if (k < wid) off += scan[k];
#pragma unroll
    for (int i = 0; i < 4; ++i) { const float bv = -(v[i] + off) * LOG2E; const unsigned hb = cvt_pk_bf16(bv, 0.f) & 0xffffu; const unsigned lb = cvt_pk_bf16(bv - __uint_as_float(hb << 16), 0.f) & 0xffffu; biasw[tid * 4 + i] = hb | (lb << 16); }
    asm volatile("s_waitcnt vmcnt(0) lgkmcnt(0)\n\ts_barrier" ::: "memory");
    }
    attp::attn_unit<8, CHECK>(b, h, qb, (const attp::bf16*)(proj + 768), (const attp::bf16*)(proj + 1280), (const attp::bf16*)(proj + 1792), (attp::bf16*)(heads + 512), shm_g, mism);
    asm volatile("s_waitcnt vmcnt(0)" ::: "memory");
}
}
namespace mx {
using namespace mk;
constexpr size_t WS_QD = WS_XN, WS_KI = WS_XN + 16 * MiB, WS_DTV = 456 * MiB, WS_ACS = 457 * MiB, WS_KE = 458 * MiB, WS_DEC = 474 * MiB;
constexpr int XROW = 144;
__device__ __forceinline__ s16x4 tr_read(unsigned addr) { s16x4 r; asm volatile("ds_read_b64_tr_b16 %0, %1" : "=v"(r) : "v"(addr) : "memory"); return r; }
template <int OFF> __device__ __forceinline__ s16x4 tr_read_o(unsigned addr) { s16x4 r; asm volatile("ds_read_b64_tr_b16 %0, %1 offset:%2" : "=v"(r) : "v"(addr), "i"(OFF) : "memory"); return r; }
#define MX_LGKM0() do { asm volatile("s_waitcnt lgkmcnt(0)" ::: "memory"); __builtin_amdgcn_sched_barrier(0); } while (0)
#define MX_BAR() asm volatile("s_waitcnt vmcnt(0) lgkmcnt(0)\n\ts_barrier" ::: "memory")
#define MX_BAR_L() asm volatile("s_waitcnt lgkmcnt(0)\n\ts_barrier" ::: "memory")
__device__ __forceinline__ bf16x8 cat8(s16x4 lo, s16x4 hi) { return (bf16x8){lo[0], lo[1], lo[2], lo[3], hi[0], hi[1], hi[2], hi[3]}; }
__device__ __forceinline__ unsigned sw256(int row, int ch) { return (unsigned)(row * 256 + ((ch ^ (row & 15)) << 4)); }

__device__ __forceinline__ void prep_conv(const bf16_t* PROJ, bf16_t* CONV, const float* conv_w, const float* conv_b, int vcu, int G, int tid) {
    for (int item = vcu * NTHR + tid; item < (T / 16) * 192; item += G * NTHR) {
        const int cg = item % 192, rb = item / 192, ch0 = cg * 8, row0 = rb * 16, t0 = row0 & (SEQ - 1);
        float w[4][8], bs[8], xw[3][8];
#pragma unroll
        for (int j = 0; j < 4; ++j) { const f32x4 a = *(const f32x4*)(conv_w + j * 1536 + ch0), b = *(const f32x4*)(conv_w + j * 1536 + ch0 + 4);
#pragma unroll
            for (int i = 0; i < 4; ++i) { w[j][i] = a[i]; w[j][4 + i] = b[i]; } }
        { const f32x4 a = *(const f32x4*)(conv_b + ch0), b = *(const f32x4*)(conv_b + ch0 + 4);
#pragma unroll
          for (int i = 0; i < 4; ++i) { bs[i] = a[i]; bs[4 + i] = b[i]; } }
#pragma unroll
        for (int j = 0; j < 3; ++j) { const int tt = t0 - 3 + j;
            u32x4 v = {0u, 0u, 0u, 0u}; if (tt >= 0) v = *(const u32x4*)(PROJ + (size_t)(row0 - 3 + j) * NO_IN + 1024 + ch0);
#pragma unroll
            for (int i = 0; i < 4; ++i) { xw[j][2 * i] = __uint_as_float(v[i] << 16); xw[j][2 * i + 1] = __uint_as_float(v[i] & 0xffff0000u); } }
#pragma unroll 4
        for (int r = 0; r < 16; ++r) {
            const u32x4 v = __builtin_nontemporal_load((const u32x4*)(PROJ + (size_t)(row0 + r) * NO_IN + 1024 + ch0));
            float x3[8], o[8];
#pragma unroll
            for (int i = 0; i < 4; ++i) { x3[2 * i] = __uint_as_float(v[i] << 16); x3[2 * i + 1] = __uint_as_float(v[i] & 0xffff0000u); }
#pragma unroll
            for (int i = 0; i < 8; ++i) { const float a = bs[i] + w[0][i] * xw[0][i] + w[1][i] * xw[1][i] + w[2][i] * xw[2][i] + w[3][i] * x3[i]; o[i] = siluf(a);
                xw[0][i] = xw[1][i]; xw[1][i] = xw[2][i]; xw[2][i] = x3[i]; }
            u32x4 ov; ov.x = cvt_pk_bf16(o[0], o[1]); ov.y = cvt_pk_bf16(o[2], o[3]); ov.z = cvt_pk_bf16(o[4], o[5]); ov.w = cvt_pk_bf16(o[6], o[7]);
            *(u32x4*)(CONV + (size_t)(row0 + r) * 1536 + ch0) = ov;
        }
    }
}
__device__ __forceinline__ void prep_ssd(const float* DTG, float* DTV, float* ACS, const float* dt_bias, const float* a_log, int vcu, int G, int lane, int wave) {
    const int gw = vcu * NWAVES + wave, ngw = G * NWAVES;
    for (int item = gw; item < NBATCH * 32 * 16; item += ngw) {
        const int h = item & 15, c = (item >> 4) & 31, b = item >> 9; const size_t r0 = (size_t)b * SEQ + c * 64 + lane;
        const float a = -expf(a_log[h]), db = dt_bias[h];
        const float d0 = softplusf(DTG[r0 * 32 + h] + db);
        float w = a * d0;
#pragma unroll
        for (int o = 1; o < 64; o <<= 1) { const float t = __shfl_up(w, o); if (lane >= o) w += t; }
        ACS[r0 * 16 + h] = w; DTV[r0 * 16 + h] = d0;
    }
}
__device__ __forceinline__ void prep_gla(const bf16_t* PROJ, const float* DTG, bf16_t* QD, bf16_t* KI, bf16_t* KE, float* DEC, const float* gk_w, const float* gk_b, int vcu, int G, int tid, int lane, int wave, LAS char* shm) {
    {
        LAS float* gl = (LAS float*)(shm);
        LAS float* tot = (LAS float*)(shm + 8192);
        const int half = wave >> 2, rq = wave & 3, t256 = tid & 255;
        for (int pair = vcu; pair < NBATCH * 32 * 4 / 2; pair += G) {
            const int item = pair * 2 + half; const int h = item & 3, c = (item >> 2) & 31, b = item >> 7; const size_t r0 = (size_t)b * SEQ + c * 64;
            unsigned short qv[16][2], kv[16][2];
#pragma unroll
            for (int r = 0; r < 16; ++r) { const bf16_t* pr = PROJ + (r0 + rq * 16 + r) * NO_IN;
                qv[r][0] = pr[2560 + h * 128 + lane]; qv[r][1] = pr[2560 + h * 128 + 64 + lane]; kv[r][0] = pr[3072 + h * 128 + lane]; kv[r][1] = pr[3072 + h * 128 + 64 + lane]; }
            float w0[16], w1[16];
#pragma unroll
            for (int j = 0; j < 16; ++j) { w0[j] = gk_w[j * 512 + h * 128 + lane]; w1[j] = gk_w[j * 512 + h * 128 + 64 + lane]; }
            const float b0 = gk_b[h * 128 + lane], b1 = gk_b[h * 128 + 64 + lane];
            { const int rr = t256 >> 2, q4 = t256 & 3; *(LAS f32x4*)(gl + half * 1024 + rr * 16 + q4 * 4) = *(const f32x4*)(DTG + (r0 + rr) * 32 + 16 + q4 * 4); }
            asm volatile("s_waitcnt vmcnt(0) lgkmcnt(0)\n\ts_barrier" ::: "memory");
            float c0[16], c1[16]; float run0 = 0.f, run1 = 0.f;
#pragma unroll
            for (int r = 0; r < 16; ++r) {
                const LAS f32x4* gp = (const LAS f32x4*)(gl + half * 1024 + (rq * 16 + r) * 16); float a0 = b0, a1 = b1;
#pragma unroll
                for (int q = 0; q < 4; ++q) { const f32x4 g = gp[q];
#pragma unroll
                    for (int i = 0; i < 4; ++i) { a0 += g[i] * w0[4 * q + i]; a1 += g[i] * w1[4 * q + i]; } }
                run0 += log_sigmoid_fast(a0) * (1.f / 16.f); run1 += log_sigmoid_fast(a1) * (1.f / 16.f); c0[r] = run0; c1[r] = run1;
            }
            tot[(half * 4 + rq) * 128 + lane] = run0; tot[(half * 4 + rq) * 128 + 64 + lane] = run1;
            asm volatile("s_waitcnt lgkmcnt(0)\n\ts_barrier" ::: "memory");
            float pre0 = 0.f, pre1 = 0.f, last0 = 0.f, last1 = 0.f;
#pragma unroll
            for (int q = 0; q < 4; ++q) { const float t0 = tot[(half * 4 + q) * 128 + lane], t1 = tot[(half * 4 + q) * 128 + 64 + lane]; if (q < rq) { pre0 += t0; pre1 += t1; } last0 += t0; last1 += t1; }
            const float scale = 0.08838834764831845f;
#pragma unroll
            for (int r = 0; r < 16; ++r) {
                const float g0 = pre0 + c0[r], g1 = pre1 + c1[r];
                const float q0 = bf2f(qv[r][0]), q1 = bf2f(qv[r][1]), k0 = bf2f(kv[r][0]), k1 = bf2f(kv[r][1]);
                const size_t o = (r0 + rq * 16 + r) * 512 + h * 128 + lane;
                QD[o] = (bf16_t)(cvt_pk_bf16(q0 * scale * __expf(g0), 0.f) & 0xffffu); QD[o + 64] = (bf16_t)(cvt_pk_bf16(q1 * scale * __expf(g1), 0.f) & 0xffffu);
                KI[o] = (bf16_t)(cvt_pk_bf16(k0 * __expf(-g0), 0.f) & 0xffffu); KI[o + 64] = (bf16_t)(cvt_pk_bf16(k1 * __expf(-g1), 0.f) & 0xffffu);
            }
            if (rq == 0) { DEC[((size_t)b * 32 + c) * 512 + h * 128 + lane] = __expf(last0); DEC[((size_t)b * 32 + c) * 512 + h * 128 + 64 + lane] = __expf(last1); }
            asm volatile("s_waitcnt lgkmcnt(0)\n\ts_barrier" ::: "memory");
        }
    }
}

constexpr int S_C = 0, S_B = 32768, S_X = 65536, S_XW = S_X + 128 * XROW, S_PREV = S_XW + 128 * XROW, S_ACS = S_PREV + 16384, S_DT = S_ACS + 512, S_YST = S_DT + 512, S_END = S_YST + 8 * 2304;
static_assert(S_END <= RING_BYTES, "SSD LDS");
__device__ __forceinline__ void ssd_unit(LAS char* shm, int b, int h, const bf16_t* CONV, const float* ACS, const float* DTV, float dsk, bf16_t* MIX) {
    const int tid = threadIdx.x, lane = tid & 63, fr = lane & 15, fq = lane >> 4; const int w = __builtin_amdgcn_readfirstlane(tid >> 6);
    const int g = h >> 3, row = tid >> 2, qd = tid & 3, l0 = 16 * w;
    const unsigned lds0 = (unsigned)(uintptr_t)shm;
    LAS float* acsl = (LAS float*)(shm + S_ACS); LAS float* dtl = (LAS float*)(shm + S_DT);
    f32x4 st[4];
#pragma unroll
    for (int i = 0; i < 4; ++i) st[i] = (f32x4){0.f, 0.f, 0.f, 0.f};
    u32x4 rc[4], rb[4], rx[2]; float racs, rdt, rend;
    const size_t seq0 = (size_t)b * SEQ;
#define SSD_LOAD(c) do { const size_t gr = seq0 + (size_t)(c) * 128 + row; const bf16_t* p = CONV + gr * 1536; \
        _Pragma("unroll") for (int i = 0; i < 4; ++i) { rc[i] = *(const u32x4*)(p + 1280 + g * 128 + qd * 32 + 8 * i); rb[i] = *(const u32x4*)(p + 1024 + g * 128 + qd * 32 + 8 * i); } \
        _Pragma("unroll") for (int i = 0; i < 2; ++i) rx[i] = *(const u32x4*)(p + h * 64 + qd * 16 + 8 * i); \
        racs = ACS[gr * 16 + h]; rdt = DTV[gr * 16 + h]; rend = ACS[(seq0 + (size_t)(c) * 128 + 127) * 16 + h]; } while (0)
#ifdef SSD_DUMMY
    SSD_LOAD(0);
    for (int c = 0; c < 16; ++c) {
#pragma unroll
        for (int i = 0; i < 4; ++i) { *(LAS u32x4*)(shm + S_C + sw256(row, qd * 4 + i)) = rc[i]; *(LAS u32x4*)(shm + S_B + sw256(row, qd * 4 + i)) = rb[i]; }
        const float wr = rdt * __expf(rend - racs);
#pragma unroll
        for (int i = 0; i < 2; ++i) { *(LAS u32x4*)(shm + S_X + row * XROW + qd * 32 + 16 * i) = rx[i];
            u32x4 o;
#pragma unroll
            for (int k = 0; k < 4; ++k) o[k] = cvt_pk_bf16(__uint_as_float(rx[i][k] << 16) * wr, __uint_as_float(rx[i][k] & 0xffff0000u) * wr);
            *(LAS u32x4*)(shm + S_XW + row * XROW + qd * 32 + 16 * i) = o; }
        if (qd == 0) { acsl[row] = racs; dtl[row] = rdt; }
        MX_BAR_L();
        if (c + 1 < 16) SSD_LOAD(c + 1);
        MX_BAR_L();
    }
#endif
#ifndef SSD_NOPREF
    SSD_LOAD(0);
#endif
    const unsigned xtr = lds0 + (unsigned)(((lane & 15) >> 2) * XROW + (lane & 3) * 8);
    for (int c = 0; c < 16; ++c) {
#ifdef SSD_NOPREF
        SSD_LOAD(c);
#endif
#ifdef SSD_REP_WR
        for (int rep_ = 0; rep_ < 2; ++rep_)
#endif
        {
#pragma unroll
            for (int i = 0; i < 4; ++i) { *(LAS u32x4*)(shm + S_C + sw256(row, qd * 4 + i)) = rc[i]; *(LAS u32x4*)(shm + S_B + sw256(row, qd * 4 + i)) = rb[i]; }
            const float wr = rdt * __expf(rend - racs);
#pragma unroll
            for (int i = 0; i < 2; ++i) { *(LAS u32x4*)(shm + S_X + row * XROW + qd * 32 + 16 * i) = rx[i];
                u32x4 o;
#pragma unroll
                for (int k = 0; k < 4; ++k) o[k] = cvt_pk_bf16(__uint_as_float(rx[i][k] << 16) * wr, __uint_as_float(rx[i][k] & 0xffff0000u) * wr);
                *(LAS u32x4*)(shm + S_XW + row * XROW + qd * 32 + 16 * i) = o; }
            if (qd == 0) { acsl[row] = racs; dtl[row] = rdt; }
#pragma unroll
            for (int pt = 0; pt < 4; ++pt) { u32x2 v; v.x = cvt_pk_bf16(st[pt][0], st[pt][1]); v.y = cvt_pk_bf16(st[pt][2], st[pt][3]);
                const int p = 16 * pt + fr; *(LAS u32x2*)(shm + S_PREV + sw256(p, 2 * w + (fq >> 1)) + (fq & 1) * 8) = v; }
        }
        MX_BAR_L();
#ifndef SSD_NOPREF
        if (c + 1 < 16) SSD_LOAD(c + 1);
#endif
        bf16x8 cf[4];
#pragma unroll
        for (int ks = 0; ks < 4; ++ks) cf[ks] = *(const LAS bf16x8*)(shm + S_C + sw256(l0 + fr, 4 * ks + fq));
        f32x4 yd[4], yo[4];
#pragma unroll
        for (int i = 0; i < 4; ++i) { yd[i] = (f32x4){0.f, 0.f, 0.f, 0.f}; yo[i] = (f32x4){0.f, 0.f, 0.f, 0.f}; }
        const float acs_l = acsl[l0 + fr]; const int lcol = l0 + fr;
        const int nsb = (w >> 1) + 1;
#ifdef SSD_REP_SB
        for (int rep_ = 0; rep_ < 2; ++rep_) {
#pragma unroll
        for (int i = 0; i < 4; ++i) yd[i] = (f32x4){0.f, 0.f, 0.f, 0.f};
#endif
        for (int sb = 0; sb < nsb; ++sb) {
            const int s0 = 32 * sb; const bool two = (2 * sb + 1) <= w;
            s16x4 lo[4], hi[4];
#pragma unroll
            for (int pt = 0; pt < 4; ++pt) { lo[pt] = tr_read(xtr + S_X + (unsigned)((s0 + 4 * fq) * XROW + pt * 32)); hi[pt] = tr_read(xtr + S_X + (unsigned)((s0 + 16 + 4 * fq) * XROW + pt * 32)); }
            f32x4 a0 = {0.f, 0.f, 0.f, 0.f}, a1 = {0.f, 0.f, 0.f, 0.f};
#pragma unroll
            for (int ks = 0; ks < 4; ++ks) { const bf16x8 bf = *(const LAS bf16x8*)(shm + S_B + sw256(s0 + fr, 4 * ks + fq)); a0 = __builtin_amdgcn_mfma_f32_16x16x32_bf16(bf, cf[ks], a0, 0, 0, 0); }
            if (two) {
#pragma unroll
                for (int ks = 0; ks < 4; ++ks) { const bf16x8 bf = *(const LAS bf16x8*)(shm + S_B + sw256(s0 + 16 + fr, 4 * ks + fq)); a1 = __builtin_amdgcn_mfma_f32_16x16x32_bf16(bf, cf[ks], a1, 0, 0, 0); }
            }
            const f32x4 as0 = *(const LAS f32x4*)(acsl + s0 + 4 * fq), as1 = *(const LAS f32x4*)(acsl + s0 + 16 + 4 * fq);
            const f32x4 dq0 = *(const LAS f32x4*)(dtl + s0 + 4 * fq), dq1 = *(const LAS f32x4*)(dtl + s0 + 16 + 4 * fq);
            float g0[4], g1[4];
#pragma unroll
            for (int i = 0; i < 4; ++i) { const int sa = s0 + 4 * fq + i, sb2 = sa + 16;
                g0[i] = (sa <= lcol) ? a0[i] * __expf(fminf(acs_l - as0[i], 0.f)) * dq0[i] : 0.f;
                g1[i] = (two && sb2 <= lcol) ? a1[i] * __expf(fminf(acs_l - as1[i], 0.f)) * dq1[i] : 0.f; }
            u32x4 ap; ap.x = cvt_pk_bf16(g0[0], g0[1]); ap.y = cvt_pk_bf16(g0[2], g0[3]); ap.z = cvt_pk_bf16(g1[0], g1[1]); ap.w = cvt_pk_bf16(g1[2], g1[3]);
            const bf16x8 af = __builtin_bit_cast(bf16x8, ap);
            MX_LGKM0();
#pragma unroll
            for (int pt = 0; pt < 4; ++pt) yd[pt] = __builtin_amdgcn_mfma_f32_16x16x32_bf16(af, cat8(lo[pt], hi[pt]), yd[pt], 0, 0, 0);
        }
#ifdef SSD_REP_SB
        }
#endif
#ifdef SSD_REP_YO
        for (int rep_ = 0; rep_ < 2; ++rep_) {
#pragma unroll
        for (int i = 0; i < 4; ++i) yo[i] = (f32x4){0.f, 0.f, 0.f, 0.f};
#endif
#pragma unroll
        for (int pt = 0; pt < 4; ++pt)
#pragma unroll
            for (int ks = 0; ks < 4; ++ks) { const bf16x8 pf = *(const LAS bf16x8*)(shm + S_PREV + sw256(16 * pt + fr, 4 * ks + fq)); yo[pt] = __builtin_amdgcn_mfma_f32_16x16x32_bf16(cf[ks], pf, yo[pt], 0, 0, 0); }
#ifdef SSD_REP_YO
        }
#endif
#ifdef SSD_REP_CS
        for (int rep_ = 0; rep_ < 2; ++rep_)
#endif
        {
            const f32x4 al = *(const LAS f32x4*)(acsl + l0 + 4 * fq);
            float ea[4];
#pragma unroll
            for (int i = 0; i < 4; ++i) ea[i] = __expf(al[i]);
            s16x4 xs[4];
#pragma unroll
            for (int pt = 0; pt < 4; ++pt) xs[pt] = tr_read(xtr + S_X + (unsigned)((l0 + 4 * fq) * XROW + pt * 32));
            MX_LGKM0();
            LAS bf16_t* yst = (LAS bf16_t*)(shm + S_YST + w * 2304);
#pragma unroll
            for (int pt = 0; pt < 4; ++pt)
#pragma unroll
                for (int i = 0; i < 4; ++i) { const float y = yd[pt][i] + ea[i] * yo[pt][i] + dsk * bf2f((unsigned short)xs[pt][i]);
                    yst[(4 * fq + i) * 72 + pt * 16 + fr] = (bf16_t)(cvt_pk_bf16(y, 0.f) & 0xffffu); }
            asm volatile("s_waitcnt lgkmcnt(0)" ::: "memory");
            bf16_t* yp = MIX + (seq0 + (size_t)c * 128 + l0) * 2048 + h * 64;
#pragma unroll
            for (int j = 0; j < 2; ++j) { const int rr = (lane >> 3) + 8 * j, ch = lane & 7; const u32x4 v = *(const LAS u32x4*)(yst + rr * 72 + ch * 8); *(u32x4*)(yp + (size_t)rr * 2048 + ch * 8) = v; }
        }
#ifdef SSD_REP_ST
        f32x4 stsave[4];
#pragma unroll
        for (int i = 0; i < 4; ++i) stsave[i] = st[i];
        for (int rep_ = 0; rep_ < 2; ++rep_) {
#pragma unroll
        for (int i = 0; i < 4; ++i) st[i] = stsave[i];
#endif
        {
            const float cd = __expf(acsl[127]);
#pragma unroll
            for (int pt = 0; pt < 4; ++pt) st[pt] = st[pt] * cd;
#pragma unroll
            for (int ks = 0; ks < 4; ++ks) {
                const int s0 = 32 * ks, q = (lane & 15) >> 2, p = lane & 3;
                const int r1 = s0 + 8 * fq + q, r2 = r1 + 4;
                const s16x4 alo = tr_read(lds0 + S_B + sw256(r1, 2 * w + (p >> 1)) + (p & 1) * 8), ahi = tr_read(lds0 + S_B + sw256(r2, 2 * w + (p >> 1)) + (p & 1) * 8);
                s16x4 lo[4], hi[4];
#pragma unroll
                for (int pt = 0; pt < 4; ++pt) { lo[pt] = tr_read(xtr + S_XW + (unsigned)((s0 + 8 * fq) * XROW + pt * 32)); hi[pt] = tr_read(xtr + S_XW + (unsigned)((s0 + 8 * fq + 4) * XROW + pt * 32)); }
                MX_LGKM0();
                const bf16x8 af = cat8(alo, ahi);
#pragma unroll
                for (int pt = 0; pt < 4; ++pt) st[pt] = __builtin_amdgcn_mfma_f32_16x16x32_bf16(af, cat8(lo[pt], hi[pt]), st[pt], 0, 0, 0);
            }
        }
#ifdef SSD_REP_ST
        }
#endif
        MX_BAR_L();
    }
    asm volatile("s_waitcnt vmcnt(0)" ::: "memory");
#undef SSD_LOAD
}

constexpr int S2_C = 0, S2_B = 16384, S2_X = 32768, S2_XW = S2_X + 64 * XROW, S2_ACS = S2_XW + 64 * XROW, S2_DT = S2_ACS + 256, S2_BUF = 53248, S2_PREV = 2 * S2_BUF, S2_END = S2_PREV + 2 * 16384;
static_assert(S2_DT + 256 <= S2_BUF && S2_END <= RING_BYTES, "SSD64 LDS");
__device__ __forceinline__ void ssd_unit64(LAS char* shm, int b, int h, const bf16_t* CONV, const float* ACS, const float* DTV, float dsk, bf16_t* MIX) {
    const int tid = threadIdx.x, lane = tid & 63, fr = lane & 15, fq = lane >> 4; const int w = __builtin_amdgcn_readfirstlane(tid >> 6);
    const int g = h >> 3, row = tid >> 3, ec = tid & 7, lt = w >> 1, l0 = 16 * lt, pt0 = 2 * (w & 1);
    const unsigned lds0 = (unsigned)(uintptr_t)shm;
    f32x4 st[4];
#pragma unroll
    for (int i = 0; i < 4; ++i) st[i] = (f32x4){0.f, 0.f, 0.f, 0.f};
    u32x4 rc[2], rb[2], rx; float racs, rdt, rend;
    const size_t seq0 = (size_t)b * SEQ;
#define S2_LOAD(c) do { const size_t gr = seq0 + (size_t)(c) * 64 + row; const bf16_t* p = CONV + gr * 1536; \
        _Pragma("unroll") for (int i = 0; i < 2; ++i) { rc[i] = *(const u32x4*)(p + 1280 + g * 128 + ec * 16 + 8 * i); rb[i] = *(const u32x4*)(p + 1024 + g * 128 + ec * 16 + 8 * i); } \
        rx = *(const u32x4*)(p + h * 64 + ec * 8); \
        racs = ACS[gr * 16 + h]; rdt = DTV[gr * 16 + h]; rend = ACS[(seq0 + (size_t)(c) * 64 + 63) * 16 + h]; } while (0)
#define S2_WRITE(pb) do { LAS char* gb_ = shm + (pb) * S2_BUF; \
        _Pragma("unroll") for (int i = 0; i < 2; ++i) { *(LAS u32x4*)(gb_ + S2_C + sw256(row, ec * 2 + i)) = rc[i]; *(LAS u32x4*)(gb_ + S2_B + sw256(row, ec * 2 + i)) = rb[i]; } \
        *(LAS u32x4*)(gb_ + S2_X + row * XROW + ec * 16) = rx; \
        { const float wr_ = rdt * __expf(rend - racs); u32x4 o_; \
          _Pragma("unroll") for (int k = 0; k < 4; ++k) o_[k] = cvt_pk_bf16(__uint_as_float(rx[k] << 16) * wr_, __uint_as_float(rx[k] & 0xffff0000u) * wr_); \
          *(LAS u32x4*)(gb_ + S2_XW + row * XROW + ec * 16) = o_; } \
        if (ec == 0) { ((LAS float*)(gb_ + S2_ACS))[row] = racs; ((LAS float*)(gb_ + S2_DT))[row] = rdt; } \
        _Pragma("unroll") for (int pt = 0; pt < 4; ++pt) { u32x2 v; v.x = cvt_pk_bf16(st[pt][0], st[pt][1]); v.y = cvt_pk_bf16(st[pt][2], st[pt][3]); \
            const int p_ = 16 * pt + fr; *(LAS u32x2*)(shm + S2_PREV + (pb) * 16384 + sw256(p_, 2 * w + (fq >> 1)) + (fq & 1) * 8) = v; } } while (0)
    S2_LOAD(0);
    S2_WRITE(0);
    MX_BAR_L();
    unsigned swz[4];
#pragma unroll
    for (int ks = 0; ks < 4; ++ks) swz[ks] = (unsigned)(fr * 256 + (((4 * ks + fq) ^ fr) << 4));
    const int q_ = (lane & 15) >> 2, p_ = lane & 3;
    const unsigned xq4 = (unsigned)((4 * fq + q_) * XROW + p_ * 8), xq8 = (unsigned)((8 * fq + q_) * XROW + p_ * 8);
    const int ra = 8 * fq + q_, rb2 = ra + 4;
    const unsigned bt1 = (unsigned)(ra * 256 + (((2 * w + (p_ >> 1)) ^ (ra & 15)) << 4) + (p_ & 1) * 8), bt2 = (unsigned)(rb2 * 256 + (((2 * w + (p_ >> 1)) ^ (rb2 & 15)) << 4) + (p_ & 1) * 8);
    for (int c = 0; c < 32; ++c) {
        const int pb = c & 1; LAS char* gb = shm + pb * S2_BUF; const unsigned gba = lds0 + (unsigned)(pb * S2_BUF);
        const LAS float* acsl = (const LAS float*)(gb + S2_ACS); const LAS float* dtl = (const LAS float*)(gb + S2_DT);
        if (c + 1 < 32) S2_LOAD(c + 1);
        const LAS char* cbp[4]; const LAS char* pvp[4];
#pragma unroll
        for (int ks = 0; ks < 4; ++ks) { cbp[ks] = gb + swz[ks]; pvp[ks] = shm + S2_PREV + pb * 16384 + pt0 * 4096 + swz[ks]; }
        const unsigned xa4 = gba + xq4 + (unsigned)(pt0 * 32), xa8 = gba + xq8, ba1 = gba + bt1, ba2 = gba + bt2;
        bf16x8 cf[4];
#pragma unroll
        for (int ks = 0; ks < 4; ++ks) cf[ks] = *(const LAS bf16x8*)(cbp[ks] + S2_C + l0 * 256);
        f32x4 yd[2], yo[2];
#pragma unroll
        for (int i = 0; i < 2; ++i) { yd[i] = (f32x4){0.f, 0.f, 0.f, 0.f}; yo[i] = (f32x4){0.f, 0.f, 0.f, 0.f}; }
        const float acs_l = acsl[l0 + fr]; const int lcol = l0 + fr;
#pragma unroll
        for (int sb = 0; sb < 2; ++sb) if (2 * sb <= lt) {
            constexpr int dummy = 0; (void)dummy;
            const int s0 = 32 * sb; const bool two = (2 * sb + 1) <= lt;
            s16x4 lo[2], hi[2];
            if (sb == 0) { lo[0] = tr_read_o<S2_X>(xa4); lo[1] = tr_read_o<S2_X + 32>(xa4); hi[0] = tr_read_o<S2_X + 16 * XROW>(xa4); hi[1] = tr_read_o<S2_X + 16 * XROW + 32>(xa4); }
            else         { lo[0] = tr_read_o<S2_X + 32 * XROW>(xa4); lo[1] = tr_read_o<S2_X + 32 * XROW + 32>(xa4); hi[0] = tr_read_o<S2_X + 48 * XROW>(xa4); hi[1] = tr_read_o<S2_X + 48 * XROW + 32>(xa4); }
            f32x4 a0 = {0.f, 0.f, 0.f, 0.f}, a1 = {0.f, 0.f, 0.f, 0.f};
#pragma unroll
            for (int ks = 0; ks < 4; ++ks) { const bf16x8 bf = *(const LAS bf16x8*)(cbp[ks] + S2_B + s0 * 256); a0 = __builtin_amdgcn_mfma_f32_16x16x32_bf16(bf, cf[ks], a0, 0, 0, 0); }
            if (two) {
#pragma unroll
                for (int ks = 0; ks < 4; ++ks) { const bf16x8 bf = *(const LAS bf16x8*)(cbp[ks] + S2_B + (s0 + 16) * 256); a1 = __builtin_amdgcn_mfma_f32_16x16x32_bf16(bf, cf[ks], a1, 0, 0, 0); }
            }
            const f32x4 as0 = *(const LAS f32x4*)(acsl + s0 + 4 * fq), as1 = *(const LAS f32x4*)(acsl + s0 + 16 + 4 * fq);
            const f32x4 dq0 = *(const LAS f32x4*)(dtl + s0 + 4 * fq), dq1 = *(const LAS f32x4*)(dtl + s0 + 16 + 4 * fq);
            float g0[4], g1[4];
#pragma unroll
            for (int i = 0; i < 4; ++i) { g0[i] = a0[i] * __expf(acs_l - as0[i]) * dq0[i]; g1[i] = a1[i] * __expf(acs_l - as1[i]) * dq1[i]; }
            if (2 * sb == lt) {
#pragma unroll
                for (int i = 0; i < 4; ++i) { if (s0 + 4 * fq + i > lcol) g0[i] = 0.f; }
            }
            if (!two) {
#pragma unroll
                for (int i = 0; i < 4; ++i) g1[i] = 0.f;
            } else if (2 * sb + 1 == lt) {
#pragma unroll
                for (int i = 0; i < 4; ++i) { if (s0 + 16 + 4 * fq + i > lcol) g1[i] = 0.f; }
            }
            u32x4 ap; ap.x = cvt_pk_bf16(g0[0], g0[1]); ap.y = cvt_pk_bf16(g0[2], g0[3]); ap.z = cvt_pk_bf16(g1[0], g1[1]); ap.w = cvt_pk_bf16(g1[2], g1[3]);
            const bf16x8 af = __builtin_bit_cast(bf16x8, ap);
            MX_LGKM0();
#pragma unroll
            for (int vi = 0; vi < 2; ++vi) yd[vi] = __builtin_amdgcn_mfma_f32_16x16x32_bf16(af, cat8(lo[vi], hi[vi]), yd[vi], 0, 0, 0);
        }
#pragma unroll
        for (int vi = 0; vi < 2; ++vi)
#pragma unroll
            for (int ks = 0; ks < 4; ++ks) { const bf16x8 pf = *(const LAS bf16x8*)(pvp[ks] + vi * 4096); yo[vi] = __builtin_amdgcn_mfma_f32_16x16x32_bf16(cf[ks], pf, yo[vi], 0, 0, 0); }
        {
            const f32x4 al = *(const LAS f32x4*)(acsl + l0 + 4 * fq);
            float ea[4];
#pragma unroll
            for (int i = 0; i < 4; ++i) ea[i] = __expf(al[i]);
            const unsigned xl = xa4 + (unsigned)(l0 * XROW);
            s16x4 xs[2]; xs[0] = tr_read_o<S2_X>(xl); xs[1] = tr_read_o<S2_X + 32>(xl);
            MX_LGKM0();
            bf16_t* yp = MIX + (seq0 + (size_t)c * 64 + l0 + 4 * fq) * 2048 + h * 64 + pt0 * 16 + fr;
#pragma unroll
            for (int vi = 0; vi < 2; ++vi)
#pragma unroll
                for (int i = 0; i < 4; ++i) { const float y = yd[vi][i] + ea[i] * yo[vi][i] + dsk * bf2f((unsigned short)xs[vi][i]);
                    yp[(size_t)i * 2048 + vi * 16] = (bf16_t)(cvt_pk_bf16(y, 0.f) & 0xffffu); }
        }
        {
            const float cd = __expf(acsl[63]);
#pragma unroll
            for (int pt = 0; pt < 4; ++pt) st[pt] = st[pt] * cd;
            {   s16x4 lo[4], hi[4];
                const s16x4 alo = tr_read_o<S2_B>(ba1), ahi = tr_read_o<S2_B>(ba2);
                lo[0] = tr_read_o<S2_XW>(xa8); lo[1] = tr_read_o<S2_XW + 32>(xa8); lo[2] = tr_read_o<S2_XW + 64>(xa8); lo[3] = tr_read_o<S2_XW + 96>(xa8);
                hi[0] = tr_read_o<S2_XW + 4 * XROW>(xa8); hi[1] = tr_read_o<S2_XW + 4 * XROW + 32>(xa8); hi[2] = tr_read_o<S2_XW + 4 * XROW + 64>(xa8); hi[3] = tr_read_o<S2_XW + 4 * XROW + 96>(xa8);
                MX_LGKM0();
                const bf16x8 af = cat8(alo, ahi);
#pragma unroll
                for (int pt = 0; pt < 4; ++pt) st[pt] = __builtin_amdgcn_mfma_f32_16x16x32_bf16(af, cat8(lo[pt], hi[pt]), st[pt], 0, 0, 0); }
            {   s16x4 lo[4], hi[4];
                const s16x4 alo = tr_read_o<S2_B + 32 * 256>(ba1), ahi = tr_read_o<S2_B + 32 * 256>(ba2);
                lo[0] = tr_read_o<S2_XW + 32 * XROW>(xa8); lo[1] = tr_read_o<S2_XW + 32 * XROW + 32>(xa8); lo[2] = tr_read_o<S2_XW + 32 * XROW + 64>(xa8); lo[3] = tr_read_o<S2_XW + 32 * XROW + 96>(xa8);
                hi[0] = tr_read_o<S2_XW + 36 * XROW>(xa8); hi[1] = tr_read_o<S2_XW + 36 * XROW + 32>(xa8); hi[2] = tr_read_o<S2_XW + 36 * XROW + 64>(xa8); hi[3] = tr_read_o<S2_XW + 36 * XROW + 96>(xa8);
                MX_LGKM0();
                const bf16x8 af = cat8(alo, ahi);
#pragma unroll
                for (int pt = 0; pt < 4; ++pt) st[pt] = __builtin_amdgcn_mfma_f32_16x16x32_bf16(af, cat8(lo[pt], hi[pt]), st[pt], 0, 0, 0); }
        }
        if (c + 1 < 32) S2_WRITE(pb ^ 1);
        MX_BAR_L();
    }
    asm volatile("s_waitcnt vmcnt(0)" ::: "memory");
#undef S2_LOAD
#undef S2_WRITE
}

constexpr int G_QD = 0, G_KI = 16384, G_V = 32768, G_DEC = G_V + 64 * XROW, G_BUF = 45056, G_SP = 2 * G_BUF, G_END = G_SP + 2 * 16384;
static_assert(G_DEC + 512 <= G_BUF && G_END <= RING_BYTES, "GLA LDS");
template <bool CHECK> __device__ __forceinline__ void gla_unit(LAS char* shm, int b, int h, int vs, const bf16_t* PROJ, const bf16_t* QD, const bf16_t* KI, const float* DEC, bf16_t* MIX, unsigned* mismatch) {
    const int tid = threadIdx.x, lane = tid & 63, fr = lane & 15, fq = lane >> 4; const int w = __builtin_amdgcn_readfirstlane(tid >> 6);
    const int row = tid >> 3, ec = tid & 7, lt = w >> 1, l0 = 16 * lt, vt0 = 2 * (w & 1);
    const unsigned lds0 = (unsigned)(uintptr_t)shm;
    f32x4 st[4];
#pragma unroll
    for (int i = 0; i < 4; ++i) st[i] = (f32x4){0.f, 0.f, 0.f, 0.f};
    u32x4 rq[2], rk[2], rv; float rdec = 0.f;
    const size_t seq0 = (size_t)b * SEQ;
#define GLA_LOAD(c) do { const size_t gr = seq0 + (size_t)(c) * 64 + row; const size_t o = gr * 512 + h * 128 + ec * 16; \
        _Pragma("unroll") for (int i = 0; i < 2; ++i) { rq[i] = *(const u32x4*)(QD + o + 8 * i); rk[i] = *(const u32x4*)(KI + o + 8 * i); } \
        rv = *(const u32x4*)(PROJ + gr * NO_IN + 3584 + h * 256 + vs * 64 + ec * 8); \
        if (tid < 128) rdec = DEC[((size_t)b * 32 + (c)) * 512 + h * 128 + tid]; } while (0)
#define GLA_WRITE(pb) do { LAS char* gb_ = shm + (pb) * G_BUF; \
        _Pragma("unroll") for (int i = 0; i < 2; ++i) { *(LAS u32x4*)(gb_ + G_QD + sw256(row, ec * 2 + i)) = rq[i]; *(LAS u32x4*)(gb_ + G_KI + sw256(row, ec * 2 + i)) = rk[i]; } \
        *(LAS u32x4*)(gb_ + G_V + row * XROW + ec * 16) = rv; \
        if (tid < 128) ((LAS float*)(gb_ + G_DEC))[tid] = rdec; \
        _Pragma("unroll") for (int vt = 0; vt < 4; ++vt) { u32x2 v; v.x = cvt_pk_bf16(st[vt][0], st[vt][1]); v.y = cvt_pk_bf16(st[vt][2], st[vt][3]); \
            const int vv = 16 * vt + fr; *(LAS u32x2*)(shm + G_SP + (pb) * 16384 + sw256(vv, 2 * w + (fq >> 1)) + (fq & 1) * 8) = v; } } while (0)
    GLA_LOAD(0);
    GLA_WRITE(0);
    MX_BAR_L();
    const unsigned xtr = lds0 + (unsigned)(((lane & 15) >> 2) * XROW + (lane & 3) * 8);
    for (int c = 0; c < 32; ++c) {
        const int pb = c & 1; LAS char* gb = shm + pb * G_BUF; const unsigned gbo = (unsigned)(pb * G_BUF); LAS char* sp = shm + G_SP + pb * 16384;
        if (c + 1 < 32) GLA_LOAD(c + 1);
        bf16x8 qf[4];
#pragma unroll
        for (int ks = 0; ks < 4; ++ks) qf[ks] = *(const LAS bf16x8*)(gb + G_QD + sw256(l0 + fr, 4 * ks + fq));
        f32x4 o[2]; o[0] = (f32x4){0.f, 0.f, 0.f, 0.f}; o[1] = (f32x4){0.f, 0.f, 0.f, 0.f};
        const int lcol = l0 + fr; const int nsb = (lt >> 1) + 1;
        for (int sb = 0; sb < nsb; ++sb) {
            const int s0 = 32 * sb; const bool two = (2 * sb + 1) <= lt;
            f32x4 a0 = {0.f, 0.f, 0.f, 0.f}, a1 = {0.f, 0.f, 0.f, 0.f};
#pragma unroll
            for (int ks = 0; ks < 4; ++ks) { const bf16x8 kf = *(const LAS bf16x8*)(gb + G_KI + sw256(s0 + fr, 4 * ks + fq)); a0 = __builtin_amdgcn_mfma_f32_16x16x32_bf16(kf, qf[ks], a0, 0, 0, 0); }
            if (two) {
#pragma unroll
                for (int ks = 0; ks < 4; ++ks) { const bf16x8 kf = *(const LAS bf16x8*)(gb + G_KI + sw256(s0 + 16 + fr, 4 * ks + fq)); a1 = __builtin_amdgcn_mfma_f32_16x16x32_bf16(kf, qf[ks], a1, 0, 0, 0); }
            }
            float g0[4], g1[4];
#pragma unroll
            for (int i = 0; i < 4; ++i) { const int sa = s0 + 4 * fq + i; g0[i] = (sa <= lcol) ? a0[i] : 0.f; g1[i] = (two && sa + 16 <= lcol) ? a1[i] : 0.f; }
            u32x4 ap; ap.x = cvt_pk_bf16(g0[0], g0[1]); ap.y = cvt_pk_bf16(g0[2], g0[3]); ap.z = cvt_pk_bf16(g1[0], g1[1]); ap.w = cvt_pk_bf16(g1[2], g1[3]);
            const bf16x8 af = __builtin_bit_cast(bf16x8, ap);
            s16x4 lo[2], hi[2];
#pragma unroll
            for (int vi = 0; vi < 2; ++vi) { lo[vi] = tr_read(xtr + gbo + G_V + (unsigned)((s0 + 4 * fq) * XROW + (vt0 + vi) * 32)); hi[vi] = tr_read(xtr + gbo + G_V + (unsigned)((s0 + 16 + 4 * fq) * XROW + (vt0 + vi) * 32)); }
            MX_LGKM0();
#pragma unroll
            for (int vi = 0; vi < 2; ++vi) o[vi] = __builtin_amdgcn_mfma_f32_16x16x32_bf16(af, cat8(lo[vi], hi[vi]), o[vi], 0, 0, 0);
        }
#pragma unroll
        for (int vi = 0; vi < 2; ++vi)
#pragma unroll
            for (int ks = 0; ks < 4; ++ks) { const bf16x8 sf = *(const LAS bf16x8*)(sp + sw256(16 * (vt0 + vi) + fr, 4 * ks + fq)); o[vi] = __builtin_amdgcn_mfma_f32_16x16x32_bf16(qf[ks], sf, o[vi], 0, 0, 0); }
        {
            bf16_t* op = MIX + (seq0 + (size_t)c * 64 + l0 + 4 * fq) * 2048 + 1024 + h * 256 + vs * 64 + vt0 * 16 + fr;
#pragma unroll
            for (int vi = 0; vi < 2; ++vi)
#pragma unroll
                for (int i = 0; i < 4; ++i) { const bf16_t val = (bf16_t)(cvt_pk_bf16(o[vi][i], 0.f) & 0xffffu);
                    if (CHECK) { if (op[(size_t)i * 2048 + vi * 16] != val) atomicAdd(mismatch, 1u); } else op[(size_t)i * 2048 + vi * 16] = val; }
        }
        {
#pragma unroll
            for (int ks = 0; ks < 2; ++ks) {
                const int s0 = 32 * ks, q = (lane & 15) >> 2, p = lane & 3;
                const int r1 = s0 + 8 * fq + q, r2 = r1 + 4;
                const s16x4 alo = tr_read(lds0 + gbo + G_KI + sw256(r1, 2 * w + (p >> 1)) + (p & 1) * 8), ahi = tr_read(lds0 + gbo + G_KI + sw256(r2, 2 * w + (p >> 1)) + (p & 1) * 8);
                s16x4 lo[4], hi[4];
#pragma unroll
                for (int vt = 0; vt < 4; ++vt) { lo[vt] = tr_read(xtr + gbo + G_V + (unsigned)((s0 + 8 * fq) * XROW + vt * 32)); hi[vt] = tr_read(xtr + gbo + G_V + (unsigned)((s0 + 8 * fq + 4) * XROW + vt * 32)); }
                MX_LGKM0();
                const bf16x8 af = cat8(alo, ahi);
#pragma unroll
                for (int vt = 0; vt < 4; ++vt) st[vt] = __builtin_amdgcn_mfma_f32_16x16x32_bf16(af, cat8(lo[vt], hi[vt]), st[vt], 0, 0, 0);
            }
            const f32x4 d4 = *(const LAS f32x4*)((LAS float*)(gb + G_DEC) + 16 * w + 4 * fq);
#pragma unroll
            for (int vt = 0; vt < 4; ++vt) st[vt] = st[vt] * d4;
        }
        if (c + 1 < 32) GLA_WRITE(pb ^ 1);
        MX_BAR_L();
    }
    asm volatile("s_waitcnt vmcnt(0)" ::: "memory");
#undef GLA_LOAD
#undef GLA_WRITE
}

__device__ __forceinline__ void finalize_phase(bf16_t* MIX, const bf16_t* PROJ, const float* ssd_norm, const float* gla_norm, int gw, int ngw, int lane) {
    for (int m = gw; m < T; m += ngw) {
        bf16_t* mr = MIX + (size_t)m * 2048; const bf16_t* pr = PROJ + (size_t)m * NO_IN;
        float y[2][8]; float s = 0.f;
#pragma unroll
        for (int j = 0; j < 2; ++j) { const int col = 512 * j + 8 * lane; const u32x4 a = *(const u32x4*)(mr + col), z = __builtin_nontemporal_load((const u32x4*)(pr + col));
#pragma unroll
            for (int i = 0; i < 4; ++i) { const float y0 = __uint_as_float(a[i] << 16), y1 = __uint_as_float(a[i] & 0xffff0000u), z0 = __uint_as_float(z[i] << 16), z1 = __uint_as_float(z[i] & 0xffff0000u);
                y[j][2 * i] = y0 * siluf(z0); y[j][2 * i + 1] = y1 * siluf(z1); s += y[j][2 * i] * y[j][2 * i] + y[j][2 * i + 1] * y[j][2 * i + 1]; } }
        const float rs = rsqrtf(wave_sum(s) * (1.f / 1024.f) + EPS);
#pragma unroll
        for (int j = 0; j < 2; ++j) { const int col = 512 * j + 8 * lane; const f32x4 w0 = *(const f32x4*)(ssd_norm + col), w1 = *(const f32x4*)(ssd_norm + col + 4);
            u32x4 o; o.x = cvt_pk_bf16(y[j][0] * rs * w0[0], y[j][1] * rs * w0[1]); o.y = cvt_pk_bf16(y[j][2] * rs * w0[2], y[j][3] * rs * w0[3]);
            o.z = cvt_pk_bf16(y[j][4] * rs * w1[0], y[j][5] * rs * w1[1]); o.w = cvt_pk_bf16(y[j][6] * rs * w1[2], y[j][7] * rs * w1[3]);
            *(u32x4*)(mr + col) = o; }
#pragma unroll
        for (int j = 0; j < 2; ++j) { const int cc = 512 * j + 8 * lane; const u32x4 a = *(const u32x4*)(mr + 1024 + cc), r = __builtin_nontemporal_load((const u32x4*)(pr + 4608 + cc));
            float o[8]; float s2 = 0.f;
#pragma unroll
            for (int i = 0; i < 4; ++i) { o[2 * i] = __uint_as_float(a[i] << 16); o[2 * i + 1] = __uint_as_float(a[i] & 0xffff0000u); s2 += o[2 * i] * o[2 * i] + o[2 * i + 1] * o[2 * i + 1]; }
#pragma unroll
            for (int of = 1; of < 32; of <<= 1) s2 += __shfl_xor(s2, of);
            const float r2 = rsqrtf(s2 * (1.f / 256.f) + EPS); const int v0 = 8 * (lane & 31);
            const f32x4 w0 = *(const f32x4*)(gla_norm + v0), w1 = *(const f32x4*)(gla_norm + v0 + 4);
            float f[8];
#pragma unroll
            for (int i = 0; i < 4; ++i) { f[2 * i] = siluf(__uint_as_float(r[i] << 16)); f[2 * i + 1] = siluf(__uint_as_float(r[i] & 0xffff0000u)); }
            u32x4 ov; ov.x = cvt_pk_bf16(o[0] * r2 * w0[0] * f[0], o[1] * r2 * w0[1] * f[1]); ov.y = cvt_pk_bf16(o[2] * r2 * w0[2] * f[2], o[3] * r2 * w0[3] * f[3]);
            ov.z = cvt_pk_bf16(o[4] * r2 * w1[0] * f[4], o[5] * r2 * w1[1] * f[5]); ov.w = cvt_pk_bf16(o[6] * r2 * w1[2] * f[6], o[7] * r2 * w1[3] * f[7]);
            *(u32x4*)(mr + 1024 + cc) = ov; }
    }
}
#undef MX_LGKM0
#undef MX_BAR
#undef MX_BAR_L
}
namespace mk {
__device__ __forceinline__ void tp_norm_rows(const float* src, const float* g, bf16_t* xn, int gw, int ngw, int lane) {
    f32x4 gg[4];
#pragma unroll
    for (int j = 0; j < 4; ++j) gg[j] = ((const f32x4*)g)[lane + 64 * j];
    for (int m = gw; m < T; m += ngw) {
        const f32x4* p = (const f32x4*)(src + (size_t)m * DM); f32x4 v[4]; float s = 0.f;
#pragma unroll
        for (int j = 0; j < 4; ++j) { v[j] = __builtin_nontemporal_load(p + lane + 64 * j); s += (v[j][0] * v[j][0] + v[j][1] * v[j][1]) + (v[j][2] * v[j][2] + v[j][3] * v[j][3]); }
        const float r = rsqrtf(wave_sum(s) * (1.f / DM) + EPS);
        u32x2* o = (u32x2*)(xn + (size_t)m * DM);
#pragma unroll
        for (int j = 0; j < 4; ++j) { const f32x4 y = v[j] * r * gg[j]; u32x2 w; w.x = cvt_pk_bf16(y[0], y[1]); w.y = cvt_pk_bf16(y[2], y[3]); o[lane + 64 * j] = w; }
    }
}
template <bool FINAL> __device__ __forceinline__ void tp_combine_norm(bf16_t* hb, const bf16_t* Y, const float* g, bf16_t* xn, float* out, int gw, int ngw, int lane) {
    f32x4 gg[2][2];
#pragma unroll
    for (int j = 0; j < 2; ++j) { gg[j][0] = *(const f32x4*)(g + 512 * j + 8 * lane); gg[j][1] = *(const f32x4*)(g + 512 * j + 8 * lane + 4); }
    for (int m = gw; m < T; m += ngw) {
        float v[2][8]; float s = 0.f;
#pragma unroll
        for (int j = 0; j < 2; ++j) { const size_t o = (size_t)m * DM + 512 * j + 8 * lane;
            const u32x4 a = *(const u32x4*)(hb + o), y0 = __builtin_nontemporal_load((const u32x4*)(Y + o)), y1 = __builtin_nontemporal_load((const u32x4*)(Y + (size_t)T * DM + o));
#pragma unroll
            for (int i = 0; i < 4; ++i) { v[j][2 * i] = __uint_as_float(a[i] << 16) + __uint_as_float(y0[i] << 16) + __uint_as_float(y1[i] << 16);
                v[j][2 * i + 1] = __uint_as_float(a[i] & 0xffff0000u) + __uint_as_float(y0[i] & 0xffff0000u) + __uint_as_float(y1[i] & 0xffff0000u);
                s += v[j][2 * i] * v[j][2 * i] + v[j][2 * i + 1] * v[j][2 * i + 1]; } }
        const float r = rsqrtf(wave_sum(s) * (1.f / DM) + EPS);
#pragma unroll
        for (int j = 0; j < 2; ++j) { const size_t o = (size_t)m * DM + 512 * j + 8 * lane;
            if (FINAL) { f32x4 o0, o1;
#pragma unroll
                for (int i = 0; i < 4; ++i) { o0[i] = v[j][i] * r * gg[j][0][i]; o1[i] = v[j][4 + i] * r * gg[j][1][i]; }
                __builtin_nontemporal_store(o0, (f32x4*)(out + o)); __builtin_nontemporal_store(o1, (f32x4*)(out + o + 4));
            } else { u32x4 hw, xw;
#pragma unroll
                for (int i = 0; i < 4; ++i) { hw[i] = cvt_pk_bf16(v[j][2 * i], v[j][2 * i + 1]);
                    xw[i] = cvt_pk_bf16(v[j][2 * i] * r * gg[j][i >> 1][(2 * i) & 3], v[j][2 * i + 1] * r * gg[j][i >> 1][(2 * i + 1) & 3]); }
                *(u32x4*)(hb + o) = hw; *(u32x4*)(xn + o) = xw; }
        }
    }
}
template <bool DRY> __device__ __forceinline__ void tp_route_mfma(const bf16_t* hb, const float* g, bf16_t* xn, const bf16_t* whi, const bf16_t* wlo, const float* bg, const float* br,
                                                                  unsigned* counts, int* lists, float* gates, LAS char* shm, int vcu, int G, int lane, int wave) {
    const int grp = wave >> 2, wq = wave & 3, fr = lane & 15, fq = lane >> 4;
    LAS u32x4* stage = (LAS u32x4*)(shm + wave * 8192);
    LAS float* xacc = (LAS float*)(shm + 65536 + grp * 12288);
    LAS float* ltile = (LAS float*)(shm + 90112 + grp * 4096);
    LAS float* rsl = (LAS float*)(shm + 98304 + grp * 64);
    for (int blk = vcu; blk < T / 32; blk += G) {
        const int r0 = blk * 32 + grp * 16; const int kbase = wq * 256;
        const bf16_t* hp = hb + (size_t)(r0 + fr) * DM + kbase + 8 * fq; const float* gp = g + kbase + 8 * fq;
        f32x4 acc[3]; acc[0] = (f32x4){0.f, 0.f, 0.f, 0.f}; acc[1] = acc[0]; acc[2] = acc[0];
        float ss = 0.f;
#pragma unroll 4
        for (int ks = 0; ks < 8; ++ks) {
            const u32x4 hv = *(const u32x4*)(hp + 32 * ks);
            const f32x4 g0 = *(const f32x4*)(gp + 32 * ks), g1 = *(const f32x4*)(gp + 32 * ks + 4);
            f32x4 x0, x1;
            x0[0] = __uint_as_float(hv.x << 16); x0[1] = __uint_as_float(hv.x & 0xffff0000u); x0[2] = __uint_as_float(hv.y << 16); x0[3] = __uint_as_float(hv.y & 0xffff0000u);
            x1[0] = __uint_as_float(hv.z << 16); x1[1] = __uint_as_float(hv.z & 0xffff0000u); x1[2] = __uint_as_float(hv.w << 16); x1[3] = __uint_as_float(hv.w & 0xffff0000u);
            ss += (x0[0] * x0[0] + x0[1] * x0[1]) + (x0[2] * x0[2] + x0[3] * x0[3]) + (x1[0] * x1[0] + x1[1] * x1[1]) + (x1[2] * x1[2] + x1[3] * x1[3]);
            const f32x4 y0 = x0 * g0, y1 = x1 * g1;
            u32x4 hi; hi.x = cvt_pk_bf16(y0[0], y0[1]); hi.y = cvt_pk_bf16(y0[2], y0[3]); hi.z = cvt_pk_bf16(y1[0], y1[1]); hi.w = cvt_pk_bf16(y1[2], y1[3]);
            stage[ks * 64 + lane] = hi;
            u32x4 lo;
            lo.x = cvt_pk_bf16(y0[0] - __uint_as_float(hi.x << 16), y0[1] - __uint_as_float(hi.x & 0xffff0000u)); lo.y = cvt_pk_bf16(y0[2] - __uint_as_float(hi.y << 16), y0[3] - __uint_as_float(hi.y & 0xffff0000u));
            lo.z = cvt_pk_bf16(y1[0] - __uint_as_float(hi.z << 16), y1[1] - __uint_as_float(hi.z & 0xffff0000u)); lo.w = cvt_pk_bf16(y1[2] - __uint_as_float(hi.w << 16), y1[3] - __uint_as_float(hi.w & 0xffff0000u));
            const bf16x8 ah = __builtin_bit_cast(bf16x8, hi), al = __builtin_bit_cast(bf16x8, lo);
#pragma unroll
            for (int nt = 0; nt < 3; ++nt) {
                const size_t wo = (size_t)(nt * 16 + fr) * DM + kbase + 32 * ks + 8 * fq;
                const bf16x8 bh = *(const bf16x8*)(whi + wo), bl = *(const bf16x8*)(wlo + wo);
                acc[nt] = __builtin_amdgcn_mfma_f32_16x16x32_bf16(ah, bh, acc[nt], 0, 0, 0);
                acc[nt] = __builtin_amdgcn_mfma_f32_16x16x32_bf16(ah, bl, acc[nt], 0, 0, 0);
                acc[nt] = __builtin_amdgcn_mfma_f32_16x16x32_bf16(al, bh, acc[nt], 0, 0, 0);
            }
        }
        ss += __shfl_xor(ss, 16); ss += __shfl_xor(ss, 32);
        if (wq != 0) { LAS float* xa = xacc + (wq - 1) * 13 * 64;
#pragma unroll
            for (int nt = 0; nt < 3; ++nt)
#pragma unroll
                for (int i = 0; i < 4; ++i) xa[(nt * 4 + i) * 64 + lane] = acc[nt][i];
            xa[12 * 64 + lane] = ss;
        }
        asm volatile("s_waitcnt lgkmcnt(0)\n\ts_barrier" ::: "memory");
        if (wq == 0) {
#pragma unroll
            for (int nt = 0; nt < 3; ++nt)
#pragma unroll
                for (int i = 0; i < 4; ++i) { const int o = (nt * 4 + i) * 64 + lane; const float v = acc[nt][i] + xacc[o] + xacc[13 * 64 + o] + xacc[26 * 64 + o]; ltile[(4 * fq + i) * 48 + nt * 16 + fr] = v; }
            ss += xacc[12 * 64 + lane] + xacc[25 * 64 + lane] + xacc[38 * 64 + lane];
            const float rs = rsqrtf(ss * (1.f / DM) + EPS);
            if (fq == 0) rsl[fr] = rs;
        }
        asm volatile("s_waitcnt lgkmcnt(0)\n\ts_barrier" ::: "memory");
        { const float rs = rsl[fr]; bf16_t* xp = xn + (size_t)(r0 + fr) * DM + kbase + 8 * fq;
#pragma unroll
          for (int ks = 0; ks < 8; ++ks) { const u32x4 v = stage[ks * 64 + lane]; u32x4 o;
              o.x = cvt_pk_bf16(__uint_as_float(v.x << 16) * rs, __uint_as_float(v.x & 0xffff0000u) * rs); o.y = cvt_pk_bf16(__uint_as_float(v.y << 16) * rs, __uint_as_float(v.y & 0xffff0000u) * rs);
              o.z = cvt_pk_bf16(__uint_as_float(v.z << 16) * rs, __uint_as_float(v.z & 0xffff0000u) * rs); o.w = cvt_pk_bf16(__uint_as_float(v.w << 16) * rs, __uint_as_float(v.w & 0xffff0000u) * rs);
              *(u32x4*)(xp + 32 * ks) = o; } }
        if (wq == 0 && lane < 16) {
            const LAS float* lt = ltile + lane * 48; const float rsr = rsl[lane];
            float gl[4];
#pragma unroll
            for (int e = 0; e < 4; ++e) gl[e] = rsr * lt[e] + bg[e];
            int gi = 0; float gm = gl[0];
#pragma unroll
            for (int e = 1; e < 4; ++e) if (gl[e] > gm) { gm = gl[e]; gi = e; }
            float gs = 0.f;
#pragma unroll
            for (int e = 0; e < 4; ++e) gs += expf(gl[e] - gm);
            const float gwt = 1.f / gs;
            float b0 = -INFINITY, b1 = -INFINITY; int i0 = 0, i1 = 0;
#pragma unroll
            for (int i = 0; i < 8; ++i) { const float v = rsr * lt[4 + gi * 8 + i] + br[gi * 8 + i];
                if (v > b0) { b1 = b0; i1 = i0; b0 = v; i0 = i; } else if (v > b1) { b1 = v; i1 = i; } }
            const int t = r0 + lane;
            const float w0 = 1.f / (1.f + expf(b1 - b0)), w1 = 1.f - w0;
            const int e0 = gi * 8 + i0, e1 = gi * 8 + i1;
            gates[2 * t] = gwt * w0; gates[2 * t + 1] = gwt * w1;
            if (!DRY) {
                const unsigned p0 = __hip_atomic_fetch_add(counts + e0 * 64, 1u, __ATOMIC_RELAXED, __HIP_MEMORY_SCOPE_AGENT); lists[e0 * CAP + p0] = 2 * t;
                const unsigned p1 = __hip_atomic_fetch_add(counts + e1 * 64, 1u, __ATOMIC_RELAXED, __HIP_MEMORY_SCOPE_AGENT); lists[e1 * CAP + p1] = 2 * t + 1; }
        }
        asm volatile("s_waitcnt lgkmcnt(0)\n\ts_barrier" ::: "memory");
    }
}

struct Args {
    const float* in[26]; float* out; unsigned char* ws; int ph_lo, ph_hi, use_bar, li;
};
enum Phase { P_CONV0 = 0, P_G1, P_ATT, P_G2, P_TP1, P_G3, P_G4, P_TP2, P_G5, P_CONV, P_MIXER, P_FIN, P_G6, P_TP3, P_G7, P_G8, P_TP4, P_COUNT };

__device__ __forceinline__ void moe_setup(volatile LAS int* misc, unsigned* counts) {
    if (threadIdx.x == 0) {
        int run = 0;
        for (int e = 0; e < 32; ++e) { const int c = (int)__hip_atomic_load(counts + e * 64, __ATOMIC_RELAXED, __HIP_MEMORY_SCOPE_AGENT); misc[64 + e] = c; misc[16 + e] = run; run += (c + 255) >> 8; }
        misc[16 + 32] = run;
    }
    __syncthreads();
}

typedef const float* kin_ptr_t;
__device__ __forceinline__ const float* kin(int i) { return ((const volatile kin_ptr_t __attribute__((address_space(4)))*)__builtin_amdgcn_kernarg_segment_ptr())[i]; }
#ifndef CV_TAIL_ITEMS
#define CV_TAIL_ITEMS 8192
#endif
constexpr int CV_I_EIN = 16 * 80, CV_I_EOUT = 16 * 32, CV_I_OIN = 16 * 184, CV_I_OOUT = 32 * 32, CV_I_GU = 16 * 32, CV_I_D = 8 * 32;
constexpr int CV_NITEMS = CV_I_EIN + CV_I_EOUT + CV_I_OIN + CV_I_OOUT + 32 * CV_I_GU + 32 * CV_I_D;
__device__ __forceinline__ CvItem cv_decode0(unsigned char* ws, int it, int lane) {
    int r = it;
    if (r < CV_I_EIN) return cv_make(SrcEvenIn{kin(4)}, 2312, 1024, 80, (bf16_t*)(ws + WS_WEIN), r, lane); r -= CV_I_EIN;
    if (r < CV_I_EOUT) return cv_make(SrcPlain{kin(7), 1024}, 1024, 1024, 32, (bf16_t*)(ws + WS_WEOUT), r, lane); r -= CV_I_EOUT;
    if (r < CV_I_OIN) return cv_make(SrcOddIn{kin(8)}, 5664, 1024, 184, (bf16_t*)(ws + WS_WOIN), r, lane); r -= CV_I_OIN;
    if (r < CV_I_OOUT) return cv_make(SrcPlain{kin(18), 1024}, 1024, 2048, 32, (bf16_t*)(ws + WS_WOOUT), r, lane); r -= CV_I_OOUT;
    if (r < 32 * CV_I_GU) { const int e = r / CV_I_GU; return cv_make_gu(kin(23) + (size_t)e * 1024 * 512, kin(24) + (size_t)e * 1024 * 512, (bf16_t*)(ws + WS_WGU) + (size_t)e * 1024 * 1024, r % CV_I_GU, lane); } r -= 32 * CV_I_GU;
    { const int e = r / CV_I_D; return cv_make(SrcPlain{kin(25) + (size_t)e * 512 * 1024, 1024}, 1024, 512, 32, (bf16_t*)(ws + WS_WD) + (size_t)e * 1024 * 512, r % CV_I_D, lane); }
}
__device__ __forceinline__ void cv_run0(unsigned char* ws, int lo, int hi, int w, int nw, LAS float* scr, int lane) {
    for (int it = lo + 2 * w; it < hi; it += 2 * nw) {
        float va[32], vb[32]; const CvItem da = cv_decode0(ws, it, lane); cv_load(da, va);
        const bool n1 = it + 1 < hi; CvItem db = da; if (n1) { db = cv_decode0(ws, it + 1, lane); cv_load(db, vb); }
        cv_finish(da, va, scr, lane);
        if (n1) cv_finish(db, vb, scr, lane);
    }
}

constexpr int CV_NIT1 = 32 * (CV_I_GU + CV_I_D);
#ifndef CV1_TAIL_G5
#define CV1_TAIL_G5 4096
#endif
#ifndef CV1_TAIL_MIX
#define CV1_TAIL_MIX 8192
#endif
#ifndef CV1_TAIL_G4
#define CV1_TAIL_G4 8192
#endif
#ifndef CV0_TAIL_G3
#define CV0_TAIL_G3 0
#endif
__device__ __forceinline__ CvItem cv_decode1(unsigned char* ws, int it, int lane) {
    const size_t L1 = (size_t)32 * 1024 * 512; int r = it;
    if (r < 32 * CV_I_GU) { const int e = r / CV_I_GU; return cv_make_gu(kin(23) + L1 + (size_t)e * 1024 * 512, kin(24) + L1 + (size_t)e * 1024 * 512, (bf16_t*)(ws + WS_WGU) + (size_t)e * 1024 * 1024, r % CV_I_GU, lane); } r -= 32 * CV_I_GU;
    { const int e = r / CV_I_D; return cv_make(SrcPlain{kin(25) + L1 + (size_t)e * 512 * 1024, 1024}, 1024, 512, 32, (bf16_t*)(ws + WS_WD) + (size_t)e * 1024 * 512, r % CV_I_D, lane); }
}
__device__ __forceinline__ void cv_run1(unsigned char* ws, int lo, int hi, int w, int nw, LAS float* scr, int lane) {
    for (int it = lo + 2 * w; it < hi; it += 2 * nw) {
        float va[32], vb[32]; const CvItem da = cv_decode1(ws, it, lane); cv_load(da, va);
        const bool n1 = it + 1 < hi; CvItem db = da; if (n1) { db = cv_decode1(ws, it + 1, lane); cv_load(db, vb); }
        cv_finish(da, va, scr, lane);
        if (n1) cv_finish(db, vb, scr, lane);
    }
}

__global__ void __launch_bounds__(NTHR, 2) mk_fwd(Args args) {
    extern __shared__ __attribute__((aligned(16))) unsigned char lds_raw[];
    LAS unsigned char* lds = (LAS unsigned char*)lds_raw;
    volatile LAS int* misc = (volatile LAS int*)(lds + MISC_OFF);
    const int tid = threadIdx.x, lane = tid & 63, wave = __builtin_amdgcn_readfirstlane(tid >> 6);
    const int G = gridDim.x, bx = blockIdx.x;
    const int vcu = (G % 8 == 0) ? (bx % 8) * (G / 8) + bx / 8 : bx;
    const int gw = vcu * NWAVES + wave, ngw = G * NWAVES;
    unsigned char* ws = args.ws;
    unsigned* ctl = (unsigned*)(ws + WS_CTL);
    for (int u = tid; u < 256; u += NTHR) misc[u] = 0;
    __syncthreads();
    XcdBarrier bar; bar.bar = ctl + CW_BAR + args.li * XCD_BAR_WORDS; bar.x = 0; bar.st = nullptr;
    if (args.use_bar) bar = xcd_barrier_post(ctl + CW_BAR + args.li * XCD_BAR_WORDS, (volatile LAS unsigned*)misc);
#ifdef BAR_TWICE
#define GRID_BAR() do { if (args.use_bar) { xcd_barrier(bar); xcd_barrier(bar); } } while (0)
#else
#define GRID_BAR() do { if (args.use_bar) xcd_barrier(bar); } while (0)
#endif
    const int lo = args.ph_lo, hi = args.ph_hi;
#ifndef MK_PHASE_MASK
#define MK_PHASE_MASK 0xffffffffu
#endif
#define IN(k) (((MK_PHASE_MASK >> (k)) & 1u) && lo <= (k) && (k) < hi)
#ifndef MK_REP_MASK
#define MK_REP_MASK 0u
#endif
#define NREP(k) ((((MK_REP_MASK) >> (k)) & 1u) ? 2 : 1)
#define REP(k) for (int _r = 0; _r < ((((MK_REP_MASK) >> (k)) & 1u) ? 2 : 1); ++_r)
#define SEAM(k) do { if (IN(k) && IN((k) + 1)) GRID_BAR(); } while (0)
    const float* x = kin(0);
    bf16_t* XN = (bf16_t*)(ws + WS_XN); bf16_t* PROJ = (bf16_t*)(ws + WS_PROJ); bf16_t* MIX = (bf16_t*)(ws + WS_MIX);
    float* FB = (float*)(ws + WS_FB); int* LISTS = (int*)(ws + WS_LISTS); float* GATES = (float*)(ws + WS_GATES);
    bf16_t* HB = (bf16_t*)(ws + WS_H); bf16_t* YB = (bf16_t*)(ws + WS_Y);
    float* outp = args.out; bf16_t* HBS = (bf16_t*)(ws + WS_HB);

    if (IN(P_CONV0)) REP(P_CONV0) {
        LAS float* scr = (LAS float*)(lds + wave * 16384);
        constexpr int OI_LO = CV_I_EIN + CV_I_EOUT, OI_HI = OI_LO + CV_I_OIN + CV_I_OOUT;
        if (CV0_TAIL_G3 && G == 256) { cv_run0(ws, 0, OI_LO, gw, ngw, scr, lane); cv_run0(ws, OI_HI, CV_NITEMS - CV_TAIL_ITEMS, gw, ngw, scr, lane); }
        else cv_run0(ws, 0, CV_NITEMS - CV_TAIL_ITEMS, gw, ngw, scr, lane);
        { bf16_t* wrt = (bf16_t*)(ws + WS_WRT);
          for (int i = gw * 64 + lane; i < 2 * 48 * 1024; i += ngw * 64) { const int l = i / (48 * 1024), rem = i % (48 * 1024), e = rem >> 10, k = rem & 1023;
              const float v = (e < 4) ? kin(19)[(size_t)l * 4096 + k * 4 + e] : (e < 36 ? kin(21)[(size_t)l * 32768 + k * 32 + (e - 4)] : 0.f);
              const unsigned hi = cvt_pk_bf16(v, 0.f) & 0xffffu; const unsigned lo = cvt_pk_bf16(v - __uint_as_float(hi << 16), 0.f) & 0xffffu;
              wrt[(size_t)(2 * l) * 48 * 1024 + rem] = (bf16_t)hi; wrt[(size_t)(2 * l + 1) * 48 * 1024 + rem] = (bf16_t)lo; } }
        tp_norm_rows(x, kin(1), XN, gw, ngw, lane);
    }
    SEAM(P_CONV0);
    if (IN(P_G1)) {
        pg8::Gemm g{XN, (const bf16_t*)(ws + WS_WEIN), 1024, 0}; pg8::DenseOrder S; S.init(T, NE_IN, G, bx, NREP(P_G1));
        pg8::EpiProjEven E{PROJ, FB};
        pg8::gemm_phase<pg8::EpiProjEven, pg8::DenseOrder, true>(lds, g, S, E);
        if (CV_TAIL_ITEMS > 0 && G == 256 && bx >= 128)
            cv_run0(ws, CV_NITEMS - CV_TAIL_ITEMS, CV_NITEMS, (bx - 128) * NWAVES + wave, 128 * NWAVES, (LAS float*)(lds + wave * 16384), lane);
        else if (CV_TAIL_ITEMS > 0 && G != 256) cv_run0(ws, CV_NITEMS - CV_TAIL_ITEMS, CV_NITEMS, gw, ngw, (LAS float*)(lds + wave * 16384), lane);
    }
    SEAM(P_G1);
    if (IN(P_ATT)) REP(P_ATT) {
        if (G == 256) {
            const int bh = vcu >> 2, s = vcu & 3, b = bh >> 3, h = bh & 7;
            const float fbias = kin(6)[h];
            att::fox_unit_p<false>((char*)lds_raw, (LAS char*)lds, b, h, 7 - s, PROJ, FB, fbias, MIX, ctl + 32, true);
            att::fox_unit_p<false>((char*)lds_raw, (LAS char*)lds, b, h, s, PROJ, FB, fbias, MIX, ctl + 32, false);
            for (int i = 0; i < 2; ++i) { const int u = vcu * 2 + i; const int sb = u >> 6, kvh = (u >> 5) & 1, blk = u & 31; att::swa_unit((LAS char*)lds, sb, kvh, blk, PROJ, kin(5), MIX); }
        }
    }
    SEAM(P_ATT);
    if (IN(P_G2)) {
        pg8::Gemm g{MIX, (const bf16_t*)(ws + WS_WEOUT), 1024, 0}; pg8::DenseOrder S; S.init(T, DM, G, bx, NREP(P_G2));
        pg8::EpiResidB<true> E{x, HBS};
        pg8::gemm_phase<pg8::EpiResidB<true>, pg8::DenseOrder, true>(lds, g, S, E);
    }
    SEAM(P_G2);
    if (IN(P_TP1)) {
#ifdef TP1_REP
        tp_route_mfma<true>(HBS, kin(2), XN, (const bf16_t*)(ws + WS_WRT), (const bf16_t*)(ws + WS_WRT) + 48 * 1024, kin(20), kin(22), ctl + CW_CNT, LISTS, GATES, (LAS char*)lds, vcu, G, lane, wave);
#endif
        tp_route_mfma<false>(HBS, kin(2), XN, (const bf16_t*)(ws + WS_WRT), (const bf16_t*)(ws + WS_WRT) + 48 * 1024, kin(20), kin(22), ctl + CW_CNT, LISTS, GATES, (LAS char*)lds, vcu, G, lane, wave);
    }
    SEAM(P_TP1);
    if (IN(P_G3)) {
        moe_setup(misc, ctl + CW_CNT);
        if (CV0_TAIL_G3 && G == 256) {
            const int U = misc[16 + 32] * 4, nidle = 768 - U;
            if (nidle > 0 && bx >= 256 - nidle) { constexpr int OI_LO = CV_I_EIN + CV_I_EOUT, OI_HI = OI_LO + CV_I_OIN + CV_I_OOUT;
                cv_run0(ws, OI_LO, OI_HI, (bx - (256 - nidle)) * NWAVES + wave, nidle * NWAVES, (LAS float*)(lds + wave * 16384), lane); }
            else if (nidle <= 0) { constexpr int OI_LO = CV_I_EIN + CV_I_EOUT, OI_HI = OI_LO + CV_I_OIN + CV_I_OOUT; cv_run0(ws, OI_LO, OI_HI, gw, ngw, (LAS float*)(lds + wave * 16384), lane); }
        }
        __syncthreads();
        pg8::Gemm g{XN, (const bf16_t*)(ws + WS_WGU), 1024, (size_t)1024 * 1024 * 2};
        pg8::MoeOrder S{(const volatile LAS int*)(misc + 16), (const volatile LAS int*)(misc + 64), LISTS, G, bx, true, NREP(P_G3)};
        pg8::EpiGateUp E{HB};
        pg8::gemm_phase<pg8::EpiGateUp, pg8::MoeOrder, true>(lds, g, S, E);
    }
    SEAM(P_G3);
    if (IN(P_G4)) {
        moe_setup(misc, ctl + CW_CNT);
        pg8::Gemm g{HB, (const bf16_t*)(ws + WS_WD), 512, (size_t)1024 * 512 * 2};
        pg8::MoeOrder S{(const volatile LAS int*)(misc + 16), (const volatile LAS int*)(misc + 64), LISTS, G, bx, false, NREP(P_G4)};
        pg8::EpiDown E{YB, LISTS, GATES, (const volatile LAS int*)(misc + 64)};
        pg8::gemm_phase<pg8::EpiDown, pg8::MoeOrder, true>(lds, g, S, E);
        if (CV1_TAIL_G4 > 0 && G == 256) {
            const int U = misc[16 + 32] * 4, nidle = 768 - U, lo1 = CV_NIT1 - CV1_TAIL_G5 - CV1_TAIL_MIX - CV1_TAIL_G4, hi1 = lo1 + CV1_TAIL_G4;
            if (nidle >= 32) { if (bx >= 256 - nidle) cv_run1(ws, lo1, hi1, (bx - (256 - nidle)) * NWAVES + wave, nidle * NWAVES, (LAS float*)(lds + wave * 16384), lane); }
            else cv_run1(ws, lo1, hi1, gw, ngw, (LAS float*)(lds + wave * 16384), lane);
        }
    }
    SEAM(P_G4);
    if (IN(P_TP2)) {
        tp_combine_norm<false>(HBS, YB, kin(1) + DM, XN, nullptr, gw, ngw, lane);
        LAS float* scr = (LAS float*)(lds + wave * 16384);
        constexpr int I_GU = 16 * 32, I_D = 8 * 32; const size_t L1 = (size_t)32 * 1024 * 512;
        auto decode = [&](int it) -> CvItem {
            int r = it;
            if (r < 32 * I_GU) { const int e = r / I_GU; return cv_make_gu(kin(23) + L1 + (size_t)e * 1024 * 512, kin(24) + L1 + (size_t)e * 1024 * 512, (bf16_t*)(ws + WS_WGU) + (size_t)e * 1024 * 1024, r % I_GU, lane); } r -= 32 * I_GU;
            { const int e = r / I_D; return cv_make(SrcPlain{kin(25) + L1 + (size_t)e * 512 * 1024, 1024}, 1024, 512, 32, (bf16_t*)(ws + WS_WD) + (size_t)e * 1024 * 512, r % I_D, lane); }
        };
        const int NIT1 = CV_NIT1 - ((G == 256) ? (CV1_TAIL_G5 + CV1_TAIL_MIX + CV1_TAIL_G4) : 0);
        for (int it = 2 * gw; it < NIT1; it += 2 * ngw) {
            float va[32], vb[32]; const CvItem da = decode(it); cv_load(da, va);
            const bool n1 = it + 1 < NIT1; CvItem db = da; if (n1) { db = decode(it + 1); cv_load(db, vb); }
            cv_finish(da, va, scr, lane);
            if (n1) cv_finish(db, vb, scr, lane);
        }
    }
    SEAM(P_TP2);
    if (IN(P_G5)) {
        pg8::Gemm g{XN, (const bf16_t*)(ws + WS_WOIN), 1024, 0}; pg8::DenseOrder S; S.init(T, NO_IN, G, bx, NREP(P_G5));
        pg8::EpiProjOdd E{PROJ, (float*)(ws + WS_DTG)};
        pg8::gemm_phase<pg8::EpiProjOdd, pg8::DenseOrder, true>(lds, g, S, E);
        if (CV1_TAIL_G5 > 0 && G == 256 && bx >= 192)
            cv_run1(ws, CV_NIT1 - CV1_TAIL_G5 - CV1_TAIL_MIX, CV_NIT1 - CV1_TAIL_MIX, (bx - 192) * NWAVES + wave, 64 * NWAVES, (LAS float*)(lds + wave * 16384), lane);
    }
    SEAM(P_G5);
    if (IN(P_CONV)) {
        mx::prep_conv(PROJ, (bf16_t*)(ws + WS_CONV), kin(9), kin(10), vcu, G, tid);
#ifdef PREP_REP_CONV
        mx::prep_conv(PROJ, (bf16_t*)(ws + WS_CONV), kin(9), kin(10), vcu, G, tid);
#endif
        mx::prep_ssd((const float*)(ws + WS_DTG), (float*)(ws + mx::WS_DTV), (float*)(ws + mx::WS_ACS), kin(11), kin(12), vcu, G, lane, wave);
#ifdef PREP_REP_SSD
        mx::prep_ssd((const float*)(ws + WS_DTG), (float*)(ws + mx::WS_DTV), (float*)(ws + mx::WS_ACS), kin(11), kin(12), vcu, G, lane, wave);
#endif
        mx::prep_gla(PROJ, (const float*)(ws + WS_DTG), (bf16_t*)(ws + mx::WS_QD), (bf16_t*)(ws + mx::WS_KI), (bf16_t*)(ws + mx::WS_KE), (float*)(ws + mx::WS_DEC), kin(15), kin(16), vcu, G, tid, lane, wave, (LAS char*)lds);
#ifdef PREP_REP_GLA
        mx::prep_gla(PROJ, (const float*)(ws + WS_DTG), (bf16_t*)(ws + mx::WS_QD), (bf16_t*)(ws + mx::WS_KI), (bf16_t*)(ws + mx::WS_KE), (float*)(ws + mx::WS_DEC), kin(15), kin(16), vcu, G, tid, lane, wave, (LAS char*)lds);
#endif
    }
    SEAM(P_CONV);
    if (IN(P_MIXER)) {
        if (G == 256) {
            if (vcu < 128) {
                mx::ssd_unit64((LAS char*)lds, vcu >> 4, vcu & 15, (const bf16_t*)(ws + WS_CONV), (const float*)(ws + mx::WS_ACS), (const float*)(ws + mx::WS_DTV), kin(13)[vcu & 15], MIX);
#ifdef MIX_SSD_REP
                __syncthreads(); mx::ssd_unit((LAS char*)lds, vcu >> 4, vcu & 15, (const bf16_t*)(ws + WS_CONV), (const float*)(ws + mx::WS_ACS), (const float*)(ws + mx::WS_DTV), kin(13)[vcu & 15], MIX);
#endif
            }
            else { const int u = vcu - 128; mx::gla_unit<false>((LAS char*)lds, u >> 4, (u >> 2) & 3, u & 3, PROJ, (const bf16_t*)(ws + mx::WS_QD), (const bf16_t*)(ws + mx::WS_KI),
                                                          (const float*)(ws + mx::WS_DEC), MIX, ctl + 32);
                if (CV1_TAIL_MIX > 0) { __syncthreads(); cv_run1(ws, CV_NIT1 - CV1_TAIL_MIX, CV_NIT1, (vcu - 128) * NWAVES + wave, 128 * NWAVES, (LAS float*)(lds + wave * 16384), lane); }
#ifdef MIX_GLA_REP
                __syncthreads(); mx::gla_unit<false>((LAS char*)lds, u >> 4, (u >> 2) & 3, u & 3, PROJ, (const bf16_t*)(ws + mx::WS_QD), (const bf16_t*)(ws + mx::WS_KI), (const float*)(ws + mx::WS_DEC), MIX, ctl + 32);
#endif
            }
        }
    }
    SEAM(P_MIXER);
    if (IN(P_FIN)) {
        mx::finalize_phase(MIX, PROJ, kin(14), kin(17), gw, ngw, lane);
    }
    SEAM(P_FIN);
    if (IN(P_G6)) {
        pg8::Gemm g{MIX, (const bf16_t*)(ws + WS_WOOUT), 2048, 0}; pg8::DenseOrder S; S.init(T, DM, G, bx, NREP(P_G6));
        pg8::EpiResidB<false> E{HBS, HBS};
        pg8::gemm_phase<pg8::EpiResidB<false>, pg8::DenseOrder, true>(lds, g, S, E);
    }
    SEAM(P_G6);
    if (IN(P_TP3)) {
        tp_route_mfma<false>(HBS, kin(2) + DM, XN, (const bf16_t*)(ws + WS_WRT) + 2 * 48 * 1024, (const bf16_t*)(ws + WS_WRT) + 3 * 48 * 1024, kin(20) + 4, kin(22) + 32,
                             ctl + CW_CNT + 32 * 64, LISTS, GATES, (LAS char*)lds, vcu, G, lane, wave);
    }
    SEAM(P_TP3);
    if (IN(P_G7)) {
        moe_setup(misc, ctl + CW_CNT + 32 * 64);
        pg8::Gemm g{XN, (const bf16_t*)(ws + WS_WGU), 1024, (size_t)1024 * 1024 * 2};
        pg8::MoeOrder S{(const volatile LAS int*)(misc + 16), (const volatile LAS int*)(misc + 64), LISTS, G, bx, true, NREP(P_G7)};
        pg8::EpiGateUp E{HB};
        pg8::gemm_phase<pg8::EpiGateUp, pg8::MoeOrder, true>(lds, g, S, E);
    }
    SEAM(P_G7);
    if (IN(P_G8)) {
        moe_setup(misc, ctl + CW_CNT + 32 * 64);
        pg8::Gemm g{HB, (const bf16_t*)(ws + WS_WD), 512, (size_t)1024 * 512 * 2};
        pg8::MoeOrder S{(const volatile LAS int*)(misc + 16), (const volatile LAS int*)(misc + 64), LISTS, G, bx, false, NREP(P_G8)};
        pg8::EpiDown E{YB, LISTS, GATES, (const volatile LAS int*)(misc + 64)};
        pg8::gemm_phase<pg8::EpiDown, pg8::MoeOrder, true>(lds, g, S, E);
    }
    SEAM(P_G8);
    if (IN(P_TP4)) {
        tp_combine_norm<true>(HBS, YB, kin(3), nullptr, outp, gw, ngw, lane);
#if defined(GLA_CHECK) || defined(ATT_CHECK)
        if (__hip_atomic_load(ctl + 32, __ATOMIC_RELAXED, __HIP_MEMORY_SCOPE_AGENT) != 0u) { for (int m = gw; m < T; m += ngw) outp[(size_t)m * DM + lane] = 1000.f; }
#endif
    }
#undef IN
#undef SEAM
#undef GRID_BAR
}
}

extern "C" void kernel_launch(void* const* d_in, const int* in_sizes, int n_in, void* d_out, int out_size, void* d_ws, size_t ws_size, hipStream_t stream) {
    static int grid = 0;
    if (grid == 0) {
        int dev = 0, cus = 0, per_cu = 0;
        (void)hipGetDevice(&dev); (void)hipDeviceGetAttribute(&cus, hipDeviceAttributeMultiprocessorCount, dev);
        if (n_in != 26 || out_size != mk::T * mk::DM || ws_size < mk::WS_TOTAL) { fprintf(stderr, "kernel_launch: unexpected shapes (n_in %d out %d ws %zu)\n", n_in, out_size, ws_size); grid = -1; return; }
        if (hipFuncSetAttribute((const void*)mk::mk_fwd, hipFuncAttributeMaxDynamicSharedMemorySize, mk::LDS_BYTES) != hipSuccess) { fprintf(stderr, "hipFuncSetAttribute failed\n"); grid = -1; return; }
        if (hipOccupancyMaxActiveBlocksPerMultiprocessor(&per_cu, (const void*)mk::mk_fwd, mk::NTHR, mk::LDS_BYTES) != hipSuccess || per_cu < 1) { fprintf(stderr, "occupancy query reports %d blocks per CU\n", per_cu); }
        (void)hipGetLastError();
        grid = cus;
        if (grid != 256) fprintf(stderr, "kernel_launch: %d CUs; the attention / mixer phases need 256\n", grid);
    }
    if (grid < 0) return;
    (void)hipMemsetAsync((char*)d_ws + mk::WS_CTL, 0, mk::CTL_ZERO_BYTES, stream);
    mk::Args a{};
    for (int i = 0; i < 26; ++i) a.in[i] = (const float*)d_in[i];
    a.out = (float*)d_out; a.ws = (unsigned char*)d_ws;
    a.ph_lo = 0; a.ph_hi = mk::P_COUNT; a.use_bar = 1; a.li = 0;
    hipLaunchKernelGGL(mk::mk_fwd, dim3(grid), dim3(mk::NTHR), mk::LDS_BYTES, stream, a);
}
```

```cpp
#include <hip/hip_runtime.h>
#include <hip/hip_bf16.h>
#include <cstdio>
#include <cstdint>
#include <cmath>
namespace mk {
#define LAS __attribute__((address_space(3)))
#define GAS __attribute__((address_space(1)))
typedef unsigned short bf16_t;
typedef short bf16x8 __attribute__((ext_vector_type(8)));
typedef short s16x4 __attribute__((ext_vector_type(4)));
typedef float f32x4 __attribute__((ext_vector_type(4)));
typedef float f32x2 __attribute__((ext_vector_type(2)));
typedef float f32x16 __attribute__((ext_vector_type(16)));
typedef unsigned u32x4 __attribute__((ext_vector_type(4)));
typedef unsigned u32x2 __attribute__((ext_vector_type(2)));

constexpr int T = 16384, DM = 1024, SEQ = 2048, NBATCH = 8;
constexpr int NE_IN = 2560, NO_IN = 5888;
constexpr int CAP = 16384;
constexpr float EPS = 1e-6f;
constexpr float LOG2E = 1.4426950408889634f;
constexpr float C2 = 0.125f * LOG2E;
constexpr int NWAVES = 8, NTHR = 512;
constexpr size_t MiB = 1u << 20;
constexpr size_t WS_CTL = 0, CTL_ZERO_BYTES = 1 * MiB;
constexpr size_t WS_WEIN = 2 * MiB, WS_WEOUT = 7 * MiB, WS_WOIN = 9 * MiB, WS_WOOUT = 21 * MiB, WS_WRT = 25 * MiB;
constexpr size_t WS_WGU = 26 * MiB, WS_WD = 90 * MiB;
constexpr size_t WS_XN = 122 * MiB;
constexpr size_t WS_PROJ = 154 * MiB;
constexpr size_t WS_H = WS_PROJ, WS_Y = WS_PROJ + 40 * MiB;
constexpr size_t WS_MIX = 338 * MiB;
constexpr size_t WS_CONV = 402 * MiB;
constexpr size_t WS_FB = 450 * MiB;
constexpr size_t WS_DTG = 451 * MiB;
constexpr size_t WS_LISTS = 453 * MiB;
constexpr size_t WS_GATES = 455 * MiB;
constexpr size_t WS_RSTD = 455 * MiB + 512 * 1024;
constexpr size_t WS_END = 456 * MiB, WS_HB = 476 * MiB, WS_TOTAL = 508 * MiB;
constexpr int CW_BAR = 4096;
constexpr int CW_CNT = 16384;
constexpr int RING_BYTES = 146432;
constexpr int MISC_OFF = RING_BYTES;
constexpr int LDS_BYTES = 147456;

typedef __bf16 bf16x2_t __attribute__((ext_vector_type(2)));
__device__ __forceinline__ unsigned cvt_pk_bf16(float lo, float hi) { f32x2 v = {lo, hi}; bf16x2_t b = __builtin_convertvector(v, bf16x2_t); return __builtin_bit_cast(unsigned, b); }
__device__ __forceinline__ float bf2f(unsigned short b) { return __uint_as_float((unsigned)b << 16); }
__device__ __forceinline__ float wave_sum(float v) {
#pragma unroll
    for (int o = 1; o < 64; o <<= 1) v += __shfl_xor(v, o);
    return v;
}
__device__ __forceinline__ float siluf(float x) { return x * __builtin_amdgcn_rcpf(1.f + __expf(-x)); }
__device__ __forceinline__ float log_sigmoidf(float x) { return fminf(x, 0.f) - log1pf(expf(-fabsf(x))); }
__device__ __forceinline__ float log_sigmoid_fast(float x) { return fminf(x, 0.f) - __logf(1.f + __expf(-fabsf(x))); }
__device__ __forceinline__ float softplusf(float x) { return fmaxf(x, 0.f) + __logf(1.f + __expf(-fabsf(x))); }

#define XB_TMO      128
#define XB_XCNT(j)  (256  + 64 * (j))
#define XB_XSUB(j)  (1280 + 64 * (j))
#define XB_XGEN(j)  (2304 + 64 * (j))
#define XB_TOP      3328
#define XB_TOPGEN   3392
#define XCD_BAR_WORDS 3456
#define XB_SPIN_CAP (1u << 18)
__device__ __forceinline__ unsigned xb_ld(unsigned* p)              { return __hip_atomic_load(p, __ATOMIC_RELAXED, __HIP_MEMORY_SCOPE_AGENT); }
__device__ __forceinline__ unsigned xb_add(unsigned* p, unsigned v) { return __hip_atomic_fetch_add(p, v, __ATOMIC_RELAXED, __HIP_MEMORY_SCOPE_AGENT); }
__device__ __forceinline__ unsigned xb_xcc_id() { return (unsigned)__builtin_amdgcn_s_getreg((3 << 11) | 20) & 0xFu; }
#define XB_SPIN(cond, bar) do { unsigned _sp = 0; while (cond) { __builtin_amdgcn_s_sleep(1); \
    if ((++_sp & 255u) == 0u) { if (xb_ld(&(bar)[XB_TMO])) break; if (_sp > XB_SPIN_CAP) { atomicAdd(&(bar)[XB_TMO], 1u); break; } } } } while (0)
struct XcdBarrier { unsigned* bar; unsigned x; volatile LAS unsigned* st; };
__device__ __forceinline__ XcdBarrier xcd_barrier_post(unsigned* bar, volatile LAS unsigned* st) {
    XcdBarrier b; b.bar = bar; b.x = xb_xcc_id(); b.st = st;
    if (threadIdx.x == 0) (void)xb_add(&bar[XB_XCNT(b.x)], 1u);
    return b;
}
__device__ __forceinline__ void xcd_barrier_complete(unsigned* bar, unsigned x, unsigned& nloc, unsigned& nx) {
    const unsigned G = gridDim.x * gridDim.y * gridDim.z;
    unsigned sum, cnt, mine, sp = 0u;
    for (;;) {
        sum = 0u; cnt = 0u; mine = 0u;
#pragma unroll
        for (unsigned j = 0; j < 16; ++j) { const unsigned c = xb_ld(&bar[XB_XCNT(j)]); sum += c; cnt += (c > 0u) ? 1u : 0u; mine = (j == x) ? c : mine; }
        if (sum == G) break;
        __builtin_amdgcn_s_sleep(1);
        if ((++sp & 255u) == 0u) { if (xb_ld(&bar[XB_TMO])) break; if (sp > XB_SPIN_CAP) { atomicAdd(&bar[XB_TMO], 1u); break; } }
    }
    nloc = mine > 0u ? mine : 1u; nx = cnt > 0u ? cnt : 1u;
}
__device__ __forceinline__ void xcd_barrier(const XcdBarrier& b) {
    asm volatile("s_waitcnt vmcnt(0)" ::: "memory");
    __syncthreads();
    if (threadIdx.x == 0) {
        unsigned* bar = b.bar;
        __builtin_amdgcn_s_waitcnt(0);
        unsigned nloc = b.st[0], nx = b.st[1];
        if (nloc == 0u) { xcd_barrier_complete(bar, b.x, nloc, nx); b.st[0] = nloc; b.st[1] = nx; }
        const unsigned old = xb_add(&bar[XB_XSUB(b.x)], 1u);
        const unsigned gen = old / nloc;
        if (old + 1u == (gen + 1u) * nloc) {
            __builtin_amdgcn_fence(__ATOMIC_RELEASE, "agent");
            asm volatile("s_waitcnt vmcnt(0)" ::: "memory");
            const unsigned og = xb_add(&bar[XB_TOP], 1u);
            const unsigned tg = og / nx;
            if (og + 1u == (tg + 1u) * nx) xb_add(&bar[XB_TOPGEN], 1u);
            else XB_SPIN(xb_ld(&bar[XB_TOPGEN]) == tg, bar);
            __builtin_amdgcn_fence(__ATOMIC_ACQUIRE, "agent");
            xb_add(&bar[XB_XGEN(b.x)], 1u);
            asm volatile("s_waitcnt vmcnt(0)" ::: "memory");
        } else {
            XB_SPIN(xb_ld(&bar[XB_XGEN(b.x)]) == gen, bar);
            __builtin_amdgcn_fence(__ATOMIC_ACQUIRE, "agent");
            asm volatile("s_waitcnt vmcnt(0)" ::: "memory");
        }
    }
    __syncthreads();
}

struct SrcPlain { const float* W; int N; __device__ __forceinline__ const float* operator()(int k, int n) const { return W + (size_t)k * N + n; } };
struct SrcEvenIn { const float* W; __device__ __forceinline__ const float* operator()(int k, int n) const { return n < 2312 ? W + (size_t)k * 2312 + n : nullptr; } };
struct SrcOddIn { const float* W;
    __device__ __forceinline__ const float* operator()(int k, int n) const {
        int s;
        if (n < 2560) s = n; else if (n < 4608) s = n + 16; else if (n < 5632) s = n + 32; else if (n < 5648) s = 2560 + (n - 5632); else if (n < 5664) s = 4624 + (n - 5648); else s = -1;
        return s >= 0 ? W + (size_t)k * 5664 + s : nullptr; } };
struct SrcGateUp { const float* Wg; const float* Wu;
    __device__ __forceinline__ const float* operator()(int k, int n) const { const int j = (n >> 5) * 16 + (n & 15); const long d = (n & 16) ? (long)(Wu - Wg) : 0l; return Wg + d + (size_t)k * 512 + j; } };
__device__ __forceinline__ struct CvItem cv_make_gu(const float* Wg, const float* Wu, bf16_t* WT, int item, int lane);
struct CvItem { const float* p; size_t stride; bf16_t* dst; int K; int gu; };
template <class Src> __device__ __forceinline__ CvItem cv_make(const Src& src, int srcN, int K, int nblk, bf16_t* WT, int item, int lane) {
    const int kb = item / nblk, nb = item % nblk, k0 = 64 * kb, n0 = 32 * nb;
    CvItem d; d.p = src(k0 + (lane >> 5), n0 + (lane & 31)); d.stride = (size_t)2 * srcN; d.dst = WT + (size_t)n0 * K + k0; d.K = K; d.gu = 0; return d;
}
__device__ __forceinline__ CvItem cv_make_gu(const float* Wg, const float* Wu, bf16_t* WT, int item, int lane) {
    const int half = item >> 8, r = item & 255, kb = r >> 4, jb = r & 15, k0 = 64 * kb, j0 = 32 * jb;
    CvItem d; d.p = (half ? Wu : Wg) + (size_t)(k0 + (lane >> 5)) * 512 + j0 + (lane & 31); d.stride = 1024; d.dst = WT + (size_t)(jb * 64 + half * 16) * 1024 + k0; d.K = 1024; d.gu = 1; return d;
}
__device__ __forceinline__ void cv_load(const CvItem& d, float (&v)[32]) {
#pragma unroll
    for (int i = 0; i < 32; ++i) v[i] = d.p ? __builtin_nontemporal_load(d.p + (size_t)i * d.stride) : 0.f;
}
__device__ __forceinline__ void cv_finish(const CvItem& d, const float (&v)[32], LAS float* scr, int lane) {
#pragma unroll
    for (int i = 0; i < 32; ++i) { const int kk = 2 * i + (lane >> 5); scr[kk * 33 + (lane & 31)] = v[i]; }
    asm volatile("s_waitcnt lgkmcnt(0)" ::: "memory");
    const int c = lane & 7;
#pragma unroll
    for (int j = 0; j < 4; ++j) { const int n = (lane >> 3) + 8 * j; const LAS float* s = scr + (8 * c) * 33 + n; const int dr = d.gu ? ((n >> 4) * 32 + (n & 15)) : n;
        u32x4 o; o.x = cvt_pk_bf16(s[0 * 33], s[1 * 33]); o.y = cvt_pk_bf16(s[2 * 33], s[3 * 33]); o.z = cvt_pk_bf16(s[4 * 33], s[5 * 33]); o.w = cvt_pk_bf16(s[6 * 33], s[7 * 33]);
        __builtin_nontemporal_store(o, (u32x4*)(d.dst + (size_t)dr * d.K + 8 * c)); }
    asm volatile("s_waitcnt lgkmcnt(0)" ::: "memory");
}

namespace pg8 {
constexpr int BM = 256, BK = 64, HALF = 128, HTB = HALF * BK * 2, STAGE_BYTES = 8 * HTB, NXCD = 8, WGM = 8;
__host__ __device__ __forceinline__ int lds_byte(int r, int c) { const int st = (r >> 4) * 2 + (c >> 5), rr = r & 15, cc = c & 31, ob = rr * 64 + cc * 2; return st * 1024 + (ob ^ (((ob >> 9) & 1) << 5)); }
__host__ __device__ __forceinline__ void stage_rc(int b, int& R, int& C) { const int st = b / 1024, sb = b % 1024, swz = sb ^ (((sb >> 9) & 1) << 5); R = (st >> 1) * 16 + swz / 64; C = (st & 1) * 32 + (swz % 64) / 2; }
__host__ __device__ __forceinline__ int perm32(int rho) { const int n = rho >> 4, i = rho & 15; return 8 * (i >> 2) + 4 * n + (i & 3); }

struct Unit { int pm, pn, e, j; };
struct Gemm { const bf16_t* A; const bf16_t* Bt; int K; size_t b_estride; };

struct DenseOrder {
    int nM, nN, nwg, G, c, rep;
    __device__ void init(int M, int N, int G_, int c_, int rep_ = 1) { nM = M / BM; nN = N / BM; nwg = nM * nN; G = G_; c = c_; rep = rep_; }
    __device__ bool next(int i, Unit& u) const {
        if (rep > 1) { const int n = (nwg - c + G - 1) / G; if (n <= 0 || i >= n * rep) return false; i = i % n; }
        const long L = (long)i * G + c; if (L >= nwg) return false;
        int wgid = (int)L; { const int q = nwg / NXCD, r = nwg % NXCD, xcd = wgid % NXCD, off = wgid / NXCD; wgid = (xcd < r ? xcd * (q + 1) : r * (q + 1) + (xcd - r) * q) + off; }
        const int nig = WGM * nN, gid = wgid / nig, fm = gid * WGM, gsz = (nM - fm) < WGM ? (nM - fm) : WGM;
        u.pm = fm + ((wgid % nig) % gsz); u.pn = (wgid % nig) / gsz; u.e = 0; u.j = 0; return true;
    }
    __device__ __forceinline__ unsigned arow(const Unit& u, int r) const { return (unsigned)(u.pm * BM + r); }
};
struct MoeOrder {
    const volatile LAS int* ts; const volatile LAS int* cnt; const int* lists; int G, c; bool gather; int rep;
    __device__ bool next(int i, Unit& u) const {
        const int U = ts[32] * 4;
        if (rep > 1) { const int n = (U - c + G - 1) / G; if (n <= 0 || i >= n * rep) return false; i = i % n; }
        const long L = (long)i * G + c; if (L >= U) return false;
        int v = (int)L; { const int q = U / NXCD, r = U % NXCD, xcd = v % NXCD, off = v / NXCD; v = (xcd < r ? xcd * (q + 1) : r * (q + 1) + (xcd - r) * q) + off; }
        const int m = v >> 2; u.pm = m; u.pn = v & 3;
        int e = 0;
        for (int k = 1; k < 32; ++k) if (ts[k] <= m) e = k;
        u.e = e; u.j = m - ts[e]; return true;
    }
    __device__ __forceinline__ unsigned arow(const Unit& u, int r) const {
        if (!gather) return (unsigned)(u.pm * BM + r);
        const int ri = u.j * BM + r; const int n = cnt[u.e];
        return ri < n ? (unsigned)(lists[u.e * CAP + ri] >> 1) : 0u;
    }
};

struct EpiProjEven {
    static constexpr bool PERM = true;
    bf16_t* O; float* fb;
    __device__ __forceinline__ void operator()(const f32x4 (&acc)[2][2][4][2], const Unit& u, int wr, int wc, int fr, int fq) const {
        const int row0 = u.pm * BM + wr * 64 + fr;
        if (u.pn == 9) {
            if (wc == 0 && fq == 0) {
#pragma unroll
                for (int ai = 0; ai < 2; ++ai)
#pragma unroll
                    for (int m = 0; m < 4; ++m) { float* p = fb + (size_t)(row0 + ai * HALF + m * 16) * 8; *(f32x4*)p = acc[ai][0][m][0]; *(f32x4*)(p + 4) = acc[ai][0][m][1]; }
            }
            return;
        }
        const float sc = (u.pn == 0 || u.pn == 1 || u.pn == 3 || u.pn == 4) ? C2 : 1.f;
        const int col0 = u.pn * BM + wc * 32 + 8 * fq;
#pragma unroll
        for (int ai = 0; ai < 2; ++ai)
#pragma unroll
            for (int m = 0; m < 4; ++m) { bf16_t* rowp = O + (size_t)(row0 + ai * HALF + m * 16) * NE_IN + col0;
#pragma unroll
                for (int bj = 0; bj < 2; ++bj) { const f32x4 v0 = acc[ai][bj][m][0] * sc, v1 = acc[ai][bj][m][1] * sc;
                    u32x4 w; w.x = cvt_pk_bf16(v0[0], v0[1]); w.y = cvt_pk_bf16(v0[2], v0[3]); w.z = cvt_pk_bf16(v1[0], v1[1]); w.w = cvt_pk_bf16(v1[2], v1[3]);
                    *(u32x4*)(rowp + bj * HALF) = w; } }
    }
};
struct EpiProjOdd {
    static constexpr bool PERM = true;
    bf16_t* O; float* dtg;
    __device__ __forceinline__ void operator()(const f32x4 (&acc)[2][2][4][2], const Unit& u, int wr, int wc, int fr, int fq) const {
        const int row0 = u.pm * BM + wr * 64 + fr;
        if (u.pn == 22) {
            if (wc == 0) {
#pragma unroll
                for (int ai = 0; ai < 2; ++ai)
#pragma unroll
                    for (int m = 0; m < 4; ++m) { float* p = dtg + (size_t)(row0 + ai * HALF + m * 16) * 32 + 8 * fq; *(f32x4*)p = acc[ai][0][m][0]; *(f32x4*)(p + 4) = acc[ai][0][m][1]; }
            }
            return;
        }
        const int col0 = u.pn * BM + wc * 32 + 8 * fq;
#pragma unroll
        for (int ai = 0; ai < 2; ++ai)
#pragma unroll
            for (int m = 0; m < 4; ++m) { bf16_t* rowp = O + (size_t)(row0 + ai * HALF + m * 16) * NO_IN + col0;
#pragma unroll
                for (int bj = 0; bj < 2; ++bj) { const f32x4 v0 = acc[ai][bj][m][0], v1 = acc[ai][bj][m][1];
                    u32x4 w; w.x = cvt_pk_bf16(v0[0], v0[1]); w.y = cvt_pk_bf16(v0[2], v0[3]); w.z = cvt_pk_bf16(v1[0], v1[1]); w.w = cvt_pk_bf16(v1[2], v1[3]);
                    *(u32x4*)(rowp + bj * HALF) = w; } }
    }
};
struct EpiResid {
    static constexpr bool PERM = false;
    const float* base; float* out;
    __device__ __forceinline__ void operator()(const f32x4 (&acc)[2][2][4][2], const Unit& u, int wr, int wc, int fr, int fq) const {
        const int col0 = u.pn * BM + wc * 32 + 4 * fq;
#pragma unroll
        for (int ai = 0; ai < 2; ++ai)
#pragma unroll
            for (int m = 0; m < 4; ++m) { const size_t off = (size_t)(u.pm * BM + ai * HALF + wr * 64 + m * 16 + fr) * DM + col0;
#pragma unroll
                for (int bj = 0; bj < 2; ++bj)
#pragma unroll
                    for (int n = 0; n < 2; ++n) { const f32x4 bs = *(const f32x4*)(base + off + bj * HALF + n * 16); *(f32x4*)(out + off + bj * HALF + n * 16) = bs + acc[ai][bj][m][n]; } }
    }
};
template <bool BASE_F32> struct EpiResidB {
    static constexpr bool PERM = true;
    const void* base; bf16_t* out;
    __device__ __forceinline__ void operator()(const f32x4 (&acc)[2][2][4][2], const Unit& u, int wr, int wc, int fr, int fq) const {
        const int row0 = u.pm * BM + wr * 64 + fr, col0 = u.pn * BM + wc * 32 + 8 * fq;
#pragma unroll
        for (int ai = 0; ai < 2; ++ai)
#pragma unroll
            for (int m = 0; m < 4; ++m) { const size_t ro = (size_t)(row0 + ai * HALF + m * 16) * DM + col0;
#pragma unroll
                for (int bj = 0; bj < 2; ++bj) { f32x4 v0 = acc[ai][bj][m][0], v1 = acc[ai][bj][m][1];
                    if (BASE_F32) { const float* b = (const float*)base + ro + bj * HALF; v0 += __builtin_nontemporal_load((const f32x4*)b); v1 += __builtin_nontemporal_load((const f32x4*)(b + 4)); }
                    else { const u32x4 bb = *(const u32x4*)((const bf16_t*)base + ro + bj * HALF);
                        v0[0] += __uint_as_float(bb.x << 16); v0[1] += __uint_as_float(bb.x & 0xffff0000u); v0[2] += __uint_as_float(bb.y << 16); v0[3] += __uint_as_float(bb.y & 0xffff0000u);
                        v1[0] += __uint_as_float(bb.z << 16); v1[1] += __uint_as_float(bb.z & 0xffff0000u); v1[2] += __uint_as_float(bb.w << 16); v1[3] += __uint_as_float(bb.w & 0xffff0000u); }
                    u32x4 w; w.x = cvt_pk_bf16(v0[0], v0[1]); w.y = cvt_pk_bf16(v0[2], v0[3]); w.z = cvt_pk_bf16(v1[0], v1[1]); w.w = cvt_pk_bf16(v1[2], v1[3]);
                    *(u32x4*)(out + ro + bj * HALF) = w; } }
    }
};
struct EpiGateUp {
    static constexpr bool PERM = false;
    bf16_t* H;
    __device__ __forceinline__ void operator()(const f32x4 (&acc)[2][2][4][2], const Unit& u, int wr, int wc, int fr, int fq) const {
#pragma unroll
        for (int ai = 0; ai < 2; ++ai)
#pragma unroll
            for (int m = 0; m < 4; ++m) { bf16_t* rowp = H + (size_t)(u.pm * BM + ai * HALF + wr * 64 + m * 16 + fr) * 512;
#pragma unroll
                for (int bj = 0; bj < 2; ++bj) { const int j0 = (u.pn * 8 + bj * 4 + wc) * 16 + 4 * fq; const f32x4 g = acc[ai][bj][m][0], up = acc[ai][bj][m][1];
                    u32x2 w; w.x = cvt_pk_bf16(siluf(g[0]) * up[0], siluf(g[1]) * up[1]); w.y = cvt_pk_bf16(siluf(g[2]) * up[2], siluf(g[3]) * up[3]);
                    *(u32x2*)(rowp + j0) = w; } }
    }
};
struct EpiDown {
    static constexpr bool PERM = true;
    bf16_t* Y; const int* lists; const float* gates; const volatile LAS int* cnt;
    __device__ __forceinline__ void operator()(const f32x4 (&acc)[2][2][4][2], const Unit& u, int wr, int wc, int fr, int fq) const {
        const int n = cnt[u.e]; const int col0 = u.pn * BM + wc * 32 + 8 * fq;
#pragma unroll
        for (int ai = 0; ai < 2; ++ai)
#pragma unroll
            for (int m = 0; m < 4; ++m) { const int ri = u.j * BM + ai * HALF + wr * 64 + m * 16 + fr;
                if (ri < n) { const int a = lists[u.e * CAP + ri]; const float g = gates[a]; bf16_t* rowp = Y + ((size_t)(a & 1) * T + (a >> 1)) * DM + col0;
#pragma unroll
                    for (int bj = 0; bj < 2; ++bj) { const f32x4 v0 = acc[ai][bj][m][0] * g, v1 = acc[ai][bj][m][1] * g;
                        u32x4 w; w.x = cvt_pk_bf16(v0[0], v0[1]); w.y = cvt_pk_bf16(v0[2], v0[3]); w.z = cvt_pk_bf16(v1[0], v1[1]); w.w = cvt_pk_bf16(v1[2], v1[3]);
                        *(u32x4*)(rowp + bj * HALF) = w; } } }
    }
};

template <class Epi, class Sched, bool ALIGN_EPI>
__device__ __forceinline__ void gemm_phase(LAS unsigned char* lds, const Gemm g, const Sched& S, const Epi& E) {
    const int tid = threadIdx.x, wid = __builtin_amdgcn_readfirstlane(tid >> 6), lane = tid & 63, wr = wid >> 2, wc = wid & 3, fr = lane & 15, fq = lane >> 4;
    const int K = g.K, nt = K / BK;
    int RA[2]; unsigned cbA[2], voffB[2];
#pragma unroll
    for (int i = 0; i < 2; ++i) { int R, C; stage_rc(tid * 16 + i * 8192, R, C); const int Rb = Epi::PERM ? ((R & ~31) + perm32(R & 31)) : R;
        RA[i] = R; cbA[i] = (unsigned)C * 2u; voffB[i] = (unsigned)(Rb * K + C) * 2u; }
    const unsigned kstep = (unsigned)(BK * 2);
    const size_t hstep = (size_t)HALF * K * 2;
    const size_t tstep = 2 * hstep;
    const unsigned rowb = (unsigned)K * 2u;
    const unsigned ldsw = (unsigned)wid * 1024u;
    const int aoff = lds_byte(wr * 64 + fr, fq * 8), boff = lds_byte(wc * 32 + fr, fq * 8);
    const char* Ab = (const char*)g.A;
#define PG8_SA(b, h) (((b) * 2 + (h)) * HTB)
#define PG8_SB(b, h) ((4 + (b) * 2 + (h)) * HTB)
#define PG8_STAGE(bufoff, gbase, voff) do { _Pragma("unroll") for (int _i = 0; _i < 2; ++_i) \
        __builtin_amdgcn_global_load_lds((const unsigned*)((const char*)(gbase) + (voff)[_i]), (LAS unsigned*)(lds + (bufoff) + ldsw + _i * 8192), 16, 0, 0); } while (0)
#define PG8_STAGE_A(bufoff, kb, o0, o1) do { \
        __builtin_amdgcn_global_load_lds((const unsigned*)(Ab + (kb) + (o0)), (LAS unsigned*)(lds + (bufoff) + ldsw), 16, 0, 0); \
        __builtin_amdgcn_global_load_lds((const unsigned*)(Ab + (kb) + (o1)), (LAS unsigned*)(lds + (bufoff) + ldsw + 8192), 16, 0, 0); } while (0)
#define PG8_LDA(dst, b, h) do { _Pragma("unroll") for (int m = 0; m < 4; ++m) _Pragma("unroll") for (int k = 0; k < 2; ++k) dst[m][k] = *(const LAS bf16x8*)(lds + PG8_SA(b, h) + aoff + m * 2048 + k * 1024); } while (0)
#define PG8_LDB(dst, b, h) do { _Pragma("unroll") for (int n = 0; n < 2; ++n) _Pragma("unroll") for (int k = 0; k < 2; ++k) dst[n][k] = *(const LAS bf16x8*)(lds + PG8_SB(b, h) + boff + n * 2048 + k * 1024); } while (0)
#define PG8_MMA(ai, bj, At, Bt) do { __builtin_amdgcn_s_setprio(1); _Pragma("unroll") for (int m = 0; m < 4; ++m) _Pragma("unroll") for (int n = 0; n < 2; ++n) _Pragma("unroll") for (int k = 0; k < 2; ++k) \
        acc[ai][bj][m][n] = __builtin_amdgcn_mfma_f32_16x16x32_bf16(Bt[n][k], At[m][k], acc[ai][bj][m][n], 0, 0, 0); __builtin_amdgcn_s_setprio(0); } while (0)
#define PG8_WAIT_V(n) asm volatile("s_waitcnt vmcnt(" #n ")" ::: "memory")
#define PG8_WAIT_L(n) asm volatile("s_waitcnt lgkmcnt(" #n ")" ::: "memory")
#define PG8_BAR __builtin_amdgcn_s_barrier()
#define PG8_SCHED __builtin_amdgcn_sched_barrier(0)
    Unit cur, nxt; int ui = 0;
    if (!S.next(0, cur)) return;
    f32x4 acc[2][2][4][2];
#pragma unroll
    for (int a = 0; a < 2; ++a)
#pragma unroll
        for (int b = 0; b < 2; ++b)
#pragma unroll
            for (int m = 0; m < 4; ++m)
#pragma unroll
                for (int n = 0; n < 2; ++n) acc[a][b][m][n] = (f32x4){0.f, 0.f, 0.f, 0.f};
    bf16x8 At[4][2], B0[2][2], B1[2][2];
    unsigned oC00 = S.arow(cur, RA[0]) * rowb + cbA[0], oC01 = S.arow(cur, RA[1]) * rowb + cbA[1];
    unsigned oC10 = S.arow(cur, HALF + RA[0]) * rowb + cbA[0], oC11 = S.arow(cur, HALF + RA[1]) * rowb + cbA[1];
    const char* cB = (const char*)g.Bt + (size_t)cur.e * g.b_estride + (size_t)cur.pn * tstep;
    PG8_STAGE(PG8_SB(0, 0), cB, voffB); PG8_STAGE(PG8_SB(0, 1), cB + hstep, voffB); PG8_STAGE_A(PG8_SA(0, 0), 0u, oC00, oC01); PG8_STAGE_A(PG8_SA(0, 1), 0u, oC10, oC11);
    if (wr == 1) PG8_BAR;
    PG8_WAIT_V(2); PG8_BAR;
    PG8_STAGE(PG8_SB(1, 0), cB + kstep, voffB); PG8_STAGE_A(PG8_SA(1, 0), kstep, oC00, oC01); PG8_STAGE(PG8_SB(1, 1), cB + hstep + kstep, voffB);
    PG8_WAIT_V(6); PG8_BAR;
    for (;;) {
        const bool has_next = S.next(ui + 1, nxt);
        unsigned oN00 = oC00, oN01 = oC01, oN10 = oC10, oN11 = oC11;
        if (has_next) { oN00 = S.arow(nxt, RA[0]) * rowb + cbA[0]; oN01 = S.arow(nxt, RA[1]) * rowb + cbA[1];
                        oN10 = S.arow(nxt, HALF + RA[0]) * rowb + cbA[0]; oN11 = S.arow(nxt, HALF + RA[1]) * rowb + cbA[1]; }
        const char* nB = has_next ? (const char*)g.Bt + (size_t)nxt.e * g.b_estride + (size_t)nxt.pn * tstep : cB;
        for (int t = 0; t < nt; t += 2) {
            const bool last = (t == nt - 2);
            const unsigned k1 = (unsigned)(t + 1) * kstep;
            const unsigned k2 = last ? 0u : (unsigned)(t + 2) * kstep, k3 = k2 + kstep;
            const unsigned o00 = last ? oN00 : oC00, o01 = last ? oN01 : oC01, o10 = last ? oN10 : oC10, o11 = last ? oN11 : oC11;
            const char* b2 = last ? nB : cB + (size_t)(t + 2) * kstep; const char* b3 = b2 + kstep;
            PG8_LDB(B0, 0, 0); PG8_LDB(B1, 0, 1); PG8_SCHED; PG8_LDA(At, 0, 0); PG8_STAGE_A(PG8_SA(1, 1), k1, oC10, oC11);
            PG8_WAIT_V(8); PG8_WAIT_L(0); PG8_BAR; PG8_MMA(0, 0, At, B0); PG8_MMA(0, 1, At, B1); PG8_BAR; PG8_SCHED;
            PG8_LDA(At, 0, 1); PG8_STAGE(PG8_SB(0, 0), b2, voffB); PG8_STAGE(PG8_SB(0, 1), b2 + hstep, voffB); PG8_STAGE_A(PG8_SA(0, 0), k2, o00, o01);
            PG8_WAIT_V(8); PG8_WAIT_L(0); PG8_BAR; PG8_MMA(1, 0, At, B0); PG8_MMA(1, 1, At, B1); PG8_BAR; PG8_SCHED;
            PG8_LDB(B0, 1, 0); PG8_LDB(B1, 1, 1); PG8_SCHED; PG8_LDA(At, 1, 0); PG8_STAGE_A(PG8_SA(0, 1), k2, o10, o11);
            PG8_WAIT_V(8); PG8_WAIT_L(0); PG8_BAR; PG8_MMA(0, 0, At, B0); PG8_MMA(0, 1, At, B1); PG8_BAR; PG8_SCHED;
            PG8_LDA(At, 1, 1); PG8_STAGE(PG8_SB(1, 0), b3, voffB); PG8_STAGE(PG8_SB(1, 1), b3 + hstep, voffB); PG8_STAGE_A(PG8_SA(1, 0), k3, o00, o01);
            PG8_WAIT_V(8); PG8_WAIT_L(0); PG8_BAR; PG8_MMA(1, 0, At, B0); PG8_MMA(1, 1, At, B1); PG8_BAR; PG8_SCHED;
        }
        if constexpr (ALIGN_EPI) { if (wr == 0) PG8_BAR; }
        E(acc, cur, wr, wc, fr, fq);
        if (!has_next) break;
#pragma unroll
        for (int a = 0; a < 2; ++a)
#pragma unroll
            for (int b = 0; b < 2; ++b)
#pragma unroll
                for (int m = 0; m < 4; ++m)
#pragma unroll
                    for (int n = 0; n < 2; ++n) acc[a][b][m][n] = (f32x4){0.f, 0.f, 0.f, 0.f};
        cur = nxt; cB = nB; oC00 = oN00; oC01 = oN01; oC10 = oN10; oC11 = oN11; ++ui;
        if constexpr (ALIGN_EPI) { if (wr == 1) PG8_BAR; }
    }
    PG8_WAIT_V(0);
    if constexpr (!ALIGN_EPI) { if (wr == 0) PG8_BAR; }
    PG8_BAR;
#undef PG8_SA
#undef PG8_SB
#undef PG8_STAGE
#undef PG8_STAGE_A
#undef PG8_LDA
#undef PG8_LDB
#undef PG8_MMA
#undef PG8_WAIT_V
#undef PG8_WAIT_L
#undef PG8_BAR
#undef PG8_SCHED
}
}
}
namespace att {
using namespace mk;
constexpr int KVBLK = 64;
constexpr int A_K = 0, A_V = 32768, A_WS = 65536, A_OST = A_WS + NWAVES * 256, A_BIAS = A_OST + NWAVES * 4096, A_SCAN = A_BIAS + 8192, A_BYTES = A_SCAN + 64;
static_assert(A_BYTES <= RING_BYTES, "attention LDS");
__device__ __forceinline__ int crow(int r, int hi) { return (r & 3) + 8 * (r >> 2) + 4 * hi; }
__device__ __forceinline__ void glds16(const void* gsrc, unsigned lds_dst) { unsigned keep;
    asm volatile("s_mov_b32 %0, m0\n\ts_mov_b32 m0, %2\n\ts_nop 0\n\tglobal_load_lds_dwordx4 %1, off\n\ts_mov_b32 m0, %0" : "=&s"(keep) : "v"(gsrc), "s"(lds_dst) : "memory"); }
__device__ __forceinline__ unsigned cvtpk(float lo, float hi) { return cvt_pk_bf16(lo, hi); }
__device__ __forceinline__ void qkt(f32x16& p0, f32x16& p1, const LAS char* Kslot, const bf16x8* qr, int r32, int hi) {
    const LAS char* kb = Kslot + hi * 1024 + r32 * 16;
    const f32x16 z = {};
#pragma unroll
    for (int d0 = 0; d0 < 4; ++d0) {
        const bf16x8 b0 = *(const LAS bf16x8*)(kb + d0 * 2048);
        const bf16x8 b1 = *(const LAS bf16x8*)(kb + d0 * 2048 + 512);
        if (d0 == 0) { p0 = __builtin_amdgcn_mfma_f32_32x32x16_bf16(b0, qr[0], z, 0, 0, 0); p1 = __builtin_amdgcn_mfma_f32_32x32x16_bf16(b1, qr[0], z, 0, 0, 0); }
        else { p0 = __builtin_amdgcn_mfma_f32_32x32x16_bf16(b0, qr[d0], p0, 0, 0, 0); p1 = __builtin_amdgcn_mfma_f32_32x32x16_bf16(b1, qr[d0], p1, 0, 0, 0); } }
}
__device__ __forceinline__ void pv(f32x16* o, int vb, bf16x8 pa0, bf16x8 pa1, bf16x8 pa2, bf16x8 pa3) {
#pragma unroll
    for (int d0 = 0; d0 < 2; ++d0) { s16x4 lo[4], hi[4];
#pragma unroll
        for (int ks = 0; ks < 4; ++ks) {
            asm volatile("ds_read_b64_tr_b16 %0,%1 offset:%c2" : "=&v"(lo[ks]) : "v"(vb), "i"(d0 * 4096 + ks * 1024) : "memory");
            asm volatile("ds_read_b64_tr_b16 %0,%1 offset:%c2" : "=&v"(hi[ks]) : "v"(vb), "i"(d0 * 4096 + ks * 1024 + 512) : "memory"); }
        asm volatile("s_waitcnt lgkmcnt(0)" ::: "memory"); __builtin_amdgcn_sched_barrier(0);
#define PK(k) (bf16x8){lo[k][0], lo[k][1], lo[k][2], lo[k][3], hi[k][0], hi[k][1], hi[k][2], hi[k][3]}
        o[d0] = __builtin_amdgcn_mfma_f32_32x32x16_bf16(pa0, PK(0), o[d0], 0, 0, 0);
        o[d0] = __builtin_amdgcn_mfma_f32_32x32x16_bf16(pa1, PK(1), o[d0], 0, 0, 0);
        o[d0] = __builtin_amdgcn_mfma_f32_32x32x16_bf16(pa2, PK(2), o[d0], 0, 0, 0);
        o[d0] = __builtin_amdgcn_mfma_f32_32x32x16_bf16(pa3, PK(3), o[d0], 0, 0, 0);
#undef PK
    }
}
__device__ __forceinline__ float rowmax32(const f32x16& p0, const f32x16& p1) {
    float a = fmaxf(p0[0], p1[0]);
#pragma unroll
    for (int r = 1; r < 16; ++r) a = fmaxf(a, fmaxf(p0[r], p1[r]));
    auto rr = __builtin_amdgcn_permlane32_swap(__float_as_uint(a), __float_as_uint(a), false, false);
    return fmaxf(__uint_as_float(rr[0]), __uint_as_float(rr[1]));
}
#define A_WAIT_BAR(N) asm volatile("s_waitcnt vmcnt(" #N ") lgkmcnt(0)\n\ts_barrier" ::: "memory")

template <bool SWA>
__device__ __forceinline__ void attn_tiles(LAS char* shm, const bf16_t* Qw, int qpitch, const bf16_t* Kh, const bf16_t* Vh, int kvpitch, bf16_t* Ow, int opitch,
                                           int kt0, int ntile, int qpos0, float sl2, float sink2) {
    const int tid = threadIdx.x, lane = tid & 63, r32 = lane & 31, hi = lane >> 5; const int wid = __builtin_amdgcn_readfirstlane(tid >> 6);
    const unsigned lds0 = (unsigned)(uintptr_t)shm;
    LAS float* wsf = (LAS float*)(shm + A_WS) + wid * 64;
    const LAS float* biasl = (const LAS float*)(shm + A_BIAS);
    const bf16_t* ksrc = Kh + (long)lane * kvpitch + wid * 8;
    const bf16_t* vsrc = Vh + (long)(16 * (wid & 3) + (lane >> 2)) * kvpitch + (wid >> 2) * 32 + (lane & 3) * 8;
    const unsigned kdst = lds0 + A_K + wid * 1024, vdst = lds0 + A_V + wid * 1024;
#define DMA_K(t, slot) glds16(ksrc + (long)(t) * KVBLK * kvpitch, (unsigned)__builtin_amdgcn_readfirstlane(kdst + (slot)))
#define DMA_V(t, slot) glds16(vsrc + (long)(t) * KVBLK * kvpitch, (unsigned)__builtin_amdgcn_readfirstlane(vdst + (slot)))
    const int vb0 = (int)(lds0 + A_V) + ((lane >> 4) & 1) * 32 + (lane & 3) * 8 + (4 * hi + ((lane & 15) >> 2)) * 64;
    DMA_K(kt0, 0); DMA_V(kt0, 0);
    if (ntile > 1) { DMA_K(kt0 + 1, 8192); DMA_V(kt0 + 1, 8192); }
    if (ntile > 2) { DMA_K(kt0 + 2, 16384); DMA_V(kt0 + 2, 16384); }
    bf16x8 qr[4];
#pragma unroll
    for (int d0 = 0; d0 < 4; ++d0) qr[d0] = *(const bf16x8*)(Qw + (long)r32 * qpitch + d0 * 16 + hi * 8);
    float m = SWA ? sink2 : -INFINITY, l = (SWA && hi == 0) ? 1.f : 0.f;
    f32x16 o[2]; o[0] = f32x16{}; o[1] = f32x16{};
    const int qpos = qpos0 + r32;
    if (ntile > 2) { A_WAIT_BAR(4); } else if (ntile > 1) { A_WAIT_BAR(2); } else { A_WAIT_BAR(0); }
    f32x16 p0, p1;
    qkt(p0, p1, shm + A_K, qr, r32, hi);
    for (int it = 0; it < ntile; ++it) {
        const int kt = kt0 + it, slot = (it & 3) * 8192;
        f32x16 n0, n1;
        if (it + 1 < ntile) {
            if (it + 2 < ntile) { A_WAIT_BAR(2); } else { A_WAIT_BAR(0); }
            if (it + 3 < ntile) { DMA_K(kt + 3, ((it + 3) & 3) * 8192); DMA_V(kt + 3, ((it + 3) & 3) * 8192); }
            qkt(n0, n1, shm + A_K + ((it + 1) & 3) * 8192, qr, r32, hi);
        }
        const int kb = kt * 64 + 4 * hi;
        if (SWA) {
#pragma unroll
            for (int r = 0; r < 16; ++r) { const int k0 = kb + (r & 3) + 8 * (r >> 2), k1 = k0 + 32;
                p0[r] = (k0 <= qpos && k0 >= qpos - 127) ? p0[r] + sl2 * (float)(k0 - qpos) : -INFINITY;
                p1[r] = (k1 <= qpos && k1 >= qpos - 127) ? p1[r] + sl2 * (float)(k1 - qpos) : -INFINITY; }
        } else {
#pragma unroll
            for (int g = 0; g < 4; ++g) { const f32x4 b0 = *(const LAS f32x4*)(biasl + kb + 8 * g), b1 = *(const LAS f32x4*)(biasl + kb + 32 + 8 * g);
#pragma unroll
                for (int i = 0; i < 4; ++i) { p0[4 * g + i] += b0[i]; p1[4 * g + i] += b1[i]; } }
            if (kt * 64 + 63 > qpos0) {
#pragma unroll
                for (int r = 0; r < 16; ++r) { const int k0 = kb + (r & 3) + 8 * (r >> 2); if (k0 > qpos) p0[r] = -INFINITY; if (k0 + 32 > qpos) p1[r] = -INFINITY; }
            }
        }
        const float rm = rowmax32(p0, p1), mn = fmaxf(m, rm), ms = (mn == -INFINITY) ? 0.f : mn;
        const float alpha = __builtin_amdgcn_exp2f(m - ms);
        float rs = 0.f;
#pragma unroll
        for (int r = 0; r < 16; ++r) { p0[r] = __builtin_amdgcn_exp2f(p0[r] - ms); p1[r] = __builtin_amdgcn_exp2f(p1[r] - ms); rs += p0[r] + p1[r]; }
        l = l * alpha + rs; m = mn;
        if (hi == 0) wsf[r32] = alpha;
        asm volatile("s_waitcnt lgkmcnt(0)" ::: "memory");
#pragma unroll
        for (int r = 0; r < 16; ++r) { const float a = wsf[crow(r, hi)]; o[0][r] *= a; o[1][r] *= a; }
        u32x4 pw0, pw1, pw2, pw3;
        pw0 = (u32x4){cvtpk(p0[0], p0[1]), cvtpk(p0[2], p0[3]), cvtpk(p0[4], p0[5]), cvtpk(p0[6], p0[7])};
        pw1 = (u32x4){cvtpk(p0[8], p0[9]), cvtpk(p0[10], p0[11]), cvtpk(p0[12], p0[13]), cvtpk(p0[14], p0[15])};
        pw2 = (u32x4){cvtpk(p1[0], p1[1]), cvtpk(p1[2], p1[3]), cvtpk(p1[4], p1[5]), cvtpk(p1[6], p1[7])};
        pw3 = (u32x4){cvtpk(p1[8], p1[9]), cvtpk(p1[10], p1[11]), cvtpk(p1[12], p1[13]), cvtpk(p1[14], p1[15])};
        pv(o, vb0 + slot, __builtin_bit_cast(bf16x8, pw0), __builtin_bit_cast(bf16x8, pw1), __builtin_bit_cast(bf16x8, pw2), __builtin_bit_cast(bf16x8, pw3));
        asm volatile("s_waitcnt lgkmcnt(0)" ::: "memory");
        if (it + 1 < ntile) { p0 = n0; p1 = n1; }
    }
    { auto rr = __builtin_amdgcn_permlane32_swap(__float_as_uint(l), __float_as_uint(l), false, false); l = __uint_as_float(rr[0]) + __uint_as_float(rr[1]); }
    if (hi == 0) wsf[32 + r32] = l;
    asm volatile("s_waitcnt lgkmcnt(0)" ::: "memory");
    LAS bf16_t* stg = (LAS bf16_t*)(shm + A_OST) + wid * 2048;
#pragma unroll
    for (int r = 0; r < 16; ++r) { const int orow = crow(r, hi); const float rl = 1.f / wsf[32 + orow];
#pragma unroll
        for (int d0 = 0; d0 < 2; ++d0) stg[orow * 64 + d0 * 32 + r32] = (bf16_t)(cvt_pk_bf16(o[d0][r] * rl, 0.f) & 0xffffu); }
    asm volatile("s_waitcnt lgkmcnt(0)" ::: "memory");
#pragma unroll
    for (int i = 0; i < 4; ++i) { const int row = i * 8 + (lane >> 3), ch = lane & 7; const u32x4 v = *(const LAS u32x4*)(stg + row * 64 + ch * 8); *(u32x4*)(Ow + (long)row * opitch + ch * 8) = v; }
    asm volatile("s_waitcnt vmcnt(0) lgkmcnt(0)\n\ts_barrier" ::: "memory");
#undef DMA_K
#undef DMA_V
}

__device__ __forceinline__ void fox_unit(LAS char* shm, int b, int h, int qb, const bf16_t* proj, const float* fb, float fbias_h, bf16_t* heads) {
    const int tid = threadIdx.x, lane = tid & 63; const int wid = __builtin_amdgcn_readfirstlane(tid >> 6);
    LAS float* biasl = (LAS float*)(shm + A_BIAS); LAS float* scan = (LAS float*)(shm + A_SCAN);
    const int kend = (qb + 1) * 256;
    float v[4]; float s = 0.f;
#pragma unroll
    for (int i = 0; i < 4; ++i) { const int p = tid * 4 + i; float lf = 0.f; if (p < kend) lf = log_sigmoid_fast(fb[((size_t)b * SEQ + p) * 8 + h] + fbias_h); s += lf; v[i] = s; }
    float w = s;
#pragma unroll
    for (int o = 1; o < 64; o <<= 1) { const float t = __shfl_up(w, o); if (lane >= o) w += t; }
    if (lane == 63) scan[wid] = w;
    asm volatile("s_waitcnt lgkmcnt(0)\n\ts_barrier" ::: "memory");
    float off = w - s;
    for (int k = 0; k < 8; ++k) if (k < wid) off += scan[k];
#pragma unroll
    for (int i = 0; i < 4; ++i) biasl[tid * 4 + i] = -(v[i] + off) * LOG2E;
    asm volatile("s_waitcnt lgkmcnt(0)\n\ts_barrier" ::: "memory");
    const size_t rowb = (size_t)b * SEQ; const int q0 = qb * 256 + wid * 32;
    attn_tiles<false>(shm, proj + (rowb + q0) * NE_IN + 768 + h * 64, NE_IN, proj + rowb * NE_IN + 1280 + h * 64, proj + rowb * NE_IN + 1792 + h * 64, NE_IN,
                      heads + (rowb + q0) * 1024 + 512 + h * 64, 1024, 0, 4 * (qb + 1), q0, 0.f, 0.f);
}
__device__ __forceinline__ void swa_unit(LAS char* shm, int b, int kvh, int blk, const bf16_t* proj, const float* sinks, bf16_t* heads) {
    const int wid = __builtin_amdgcn_readfirstlane(threadIdx.x >> 6);
    const int qh = kvh * 4 + (wid >> 1), q0 = blk * 64 + (wid & 1) * 32;
    const size_t rowb = (size_t)b * SEQ;
    const int kt0 = blk >= 2 ? blk - 2 : 0, ntile = blk - kt0 + 1;
    const float sl2 = exp2f(-(float)(qh + 1)) * LOG2E, sink2 = sinks[qh] * LOG2E;
    attn_tiles<true>(shm, proj + (rowb + q0) * NE_IN + qh * 64, NE_IN, proj + rowb * NE_IN + 512 + kvh * 64, proj + rowb * NE_IN + 640 + kvh * 64, NE_IN,
                     heads + (rowb + q0) * 1024 + qh * 64, 1024, kt0, ntile, q0, sl2, sink2);
}
#undef A_WAIT_BAR
}

namespace attp {
using bf16=__hip_bfloat16;
using bf16x8=__attribute__((ext_vector_type(8)))short;
using s16x4=__attribute__((ext_vector_type(4)))short;
using f32x16=__attribute__((ext_vector_type(16)))float;
using u32x4=__attribute__((ext_vector_type(4)))unsigned;
constexpr int BATCH=8,NHEAD=8,SEQ=2048,D=64,DM=2560,OPITCH=1024;
constexpr int NW=8,QBLK=32,QB=QBLK*NW,KVBLK=64,NQB=SEQ/QB;
constexpr int ATTN_PITCH=DM, ATTN_UNIT_ROWS=QB;
__device__ __forceinline__ int crow(int r,int hi){return (r&3)+8*(r>>2)+4*hi;}
#define SBAR() __builtin_amdgcn_sched_barrier(0)
__device__ __forceinline__ void cmask(f32x16&p0,f32x16&p1,int jb,int qrel,int hi){
  const float NEG=-INFINITY; int kb=64*jb+4*hi;
  #pragma unroll
  for(int r=0;r<16;++r){int kv=kb+(r&3)+8*(r>>2); if(kv>qrel)p0[r]=NEG; if(kv+32>qrel)p1[r]=NEG;}
}

constexpr int NSLOT=3, SLOTB=8192;
constexpr int LDS_K=0, LDS_V=NSLOT*SLOTB, LDS_WS=2*NSLOT*SLOTB, LDS_OST=LDS_WS+NW*64*4, LDS_BIAS=LDS_OST+NW*4096, LDS_SCAN=LDS_BIAS+8192, LDS_BYTES=LDS_SCAN+64;
constexpr float C2=0.125f*1.4426950408889634f;
__device__ __forceinline__ void glds16(const void*gsrc,unsigned lds_dst){unsigned keep;
  asm volatile("s_mov_b32 %0, m0\n\ts_mov_b32 m0, %2\n\ts_nop 0\n\tglobal_load_lds_dwordx4 %1, off\n\ts_mov_b32 m0, %0":"=&s"(keep):"v"(gsrc),"s"(lds_dst):"memory");}
__device__ __forceinline__ float max3f(float a,float b,float c){float r;asm("v_max3_f32 %0, %1, %2, %3":"=v"(r):"v"(a),"v"(b),"v"(c));return r;}
__device__ __forceinline__ float max2f(float a,float b){float r;asm("v_max_f32_e32 %0, %1, %2":"=v"(r):"v"(a),"v"(b));return r;}
__device__ __forceinline__ float fadd_s(float a,float b){float r;asm("v_add_f32_e32 %0, %1, %2":"=v"(r):"v"(a),"v"(b));return r;}
__device__ __forceinline__ float fsub_s(float a,float b){float r;asm("v_sub_f32_e32 %0, %1, %2":"=v"(r):"v"(a),"v"(b));return r;}
typedef float f32x2_t __attribute__((ext_vector_type(2))); typedef __bf16 bf16x2_t __attribute__((ext_vector_type(2)));
__device__ __forceinline__ unsigned cvtpk_s(float lo,float hi){f32x2_t v={lo,hi};bf16x2_t b=__builtin_convertvector(v,bf16x2_t);return __builtin_bit_cast(unsigned,b);}
#define WAIT_BAR(N) asm volatile("s_waitcnt vmcnt(" #N ") lgkmcnt(0)\n\ts_barrier":::"memory")

__device__ __forceinline__ void qkt(f32x16&p0,f32x16&p1,const char*Kslot,const bf16x8*qr,int r32,int hi){ const f32x16 zc_=f32x16{};
  const char*kb=Kslot+hi*1024+r32*16;
  #pragma unroll
  for(int d0=0;d0<4;++d0){
    const bf16x8 b0=*reinterpret_cast<const bf16x8*>(kb+d0*2048);
    const bf16x8 b1=*reinterpret_cast<const bf16x8*>(kb+d0*2048+512);
    if(d0==0){p0=__builtin_amdgcn_mfma_f32_32x32x16_bf16(b0,qr[0],zc_,0,0,0);p1=__builtin_amdgcn_mfma_f32_32x32x16_bf16(b1,qr[0],zc_,0,0,0);}
    else{p0=__builtin_amdgcn_mfma_f32_32x32x16_bf16(b0,qr[d0],p0,0,0,0);p1=__builtin_amdgcn_mfma_f32_32x32x16_bf16(b1,qr[d0],p1,0,0,0);}}
}
typedef __attribute__((address_space(3))) const char* lds_cptr;
typedef short v4i16_t __attribute__((ext_vector_type(4)));
__device__ __forceinline__ void kload8(bf16x8*kf,lds_cptr kp){
  kf[0]=*(const __attribute__((address_space(3))) bf16x8*)(kp);      kf[1]=*(const __attribute__((address_space(3))) bf16x8*)(kp+512);
  kf[2]=*(const __attribute__((address_space(3))) bf16x8*)(kp+2048); kf[3]=*(const __attribute__((address_space(3))) bf16x8*)(kp+2560);
  kf[4]=*(const __attribute__((address_space(3))) bf16x8*)(kp+4096); kf[5]=*(const __attribute__((address_space(3))) bf16x8*)(kp+4608);
  kf[6]=*(const __attribute__((address_space(3))) bf16x8*)(kp+6144); kf[7]=*(const __attribute__((address_space(3))) bf16x8*)(kp+6656);
}
__device__ __forceinline__ void kload2(bf16x8*kf,lds_cptr kp,int j){ kf[2*j]=*(const __attribute__((address_space(3))) bf16x8*)(kp+j*2048); kf[2*j+1]=*(const __attribute__((address_space(3))) bf16x8*)(kp+j*2048+512); }
__device__ __forceinline__ s16x4 vtr(lds_cptr p){ return __builtin_bit_cast(s16x4,__builtin_amdgcn_ds_read_tr16_b64_v4i16((__attribute__((address_space(3))) v4i16_t*)p)); }
__device__ __forceinline__ float rowmax(const f32x16&p0,const f32x16&p1){
  float a=max3f(p0[0],p0[1],p1[0]),b=max3f(p0[2],p0[3],p1[1]);a=max3f(a,p1[2],p1[3]);
  #pragma unroll
  for(int r=4;r<16;r+=4){a=max3f(a,p0[r],p0[r+1]);b=max3f(b,p0[r+2],p0[r+3]);a=max3f(a,p1[r],p1[r+1]);b=max3f(b,p1[r+2],p1[r+3]);}
  const float m=max2f(a,b);
  auto rr=__builtin_amdgcn_permlane32_swap(__float_as_uint(m),__float_as_uint(m),false,false);
  return max2f(__uint_as_float(rr[0]),__uint_as_float(rr[1]));
}
__device__ __forceinline__ void pv(f32x16*o,int vb,bf16x8 pa0,bf16x8 pa1,bf16x8 pa2,bf16x8 pa3){
  #pragma unroll
  for(int d0=0;d0<2;++d0){s16x4 lo[4],hi[4];
    #pragma unroll
    for(int ks=0;ks<4;++ks){
      asm volatile("ds_read_b64_tr_b16 %0,%1 offset:%c2":"=&v"(lo[ks]):"v"(vb),"i"(d0*4096+ks*1024):"memory");
      asm volatile("ds_read_b64_tr_b16 %0,%1 offset:%c2":"=&v"(hi[ks]):"v"(vb),"i"(d0*4096+ks*1024+512):"memory");}
    asm volatile("s_waitcnt lgkmcnt(0)":::"memory");SBAR();
    #define PK(k) (bf16x8){lo[k][0],lo[k][1],lo[k][2],lo[k][3],hi[k][0],hi[k][1],hi[k][2],hi[k][3]}
    o[d0]=__builtin_amdgcn_mfma_f32_32x32x16_bf16(pa0,PK(0),o[d0],0,0,0);
    o[d0]=__builtin_amdgcn_mfma_f32_32x32x16_bf16(pa1,PK(1),o[d0],0,0,0);
    o[d0]=__builtin_amdgcn_mfma_f32_32x32x16_bf16(pa2,PK(2),o[d0],0,0,0);
    o[d0]=__builtin_amdgcn_mfma_f32_32x32x16_bf16(pa3,PK(3),o[d0],0,0,0);
    #undef PK
  }
}

#ifndef ATTN_STORE16
#define ATTN_STORE16(p,v) (*(u32x4*)(p)=(v))
#endif
template<int THRL,bool CHECK> __device__ __forceinline__ void attn_unit(int b,int h,int qb,const bf16*Q,const bf16*__restrict__ K,const bf16*__restrict__ V,bf16*O,char*shm,unsigned*mism){
  const int tid=threadIdx.x,lane=tid&63,r32=lane&31,hi=lane>>5; const int wid=__builtin_amdgcn_readfirstlane(tid>>6);
  const long rowbase=(long)b*SEQ; const int q0=qb*QB;
  const bf16*Qw=Q+(rowbase+q0+wid*QBLK)*DM+h*D;
  const bf16*Kh=K+rowbase*DM+h*D,*Vh=V+rowbase*DM+h*D;
  const unsigned lds0=(unsigned)(uintptr_t)shm;
  float*wsf=(float*)(shm+LDS_WS)+wid*64;
  const bf16*ksrc=Kh+(long)lane*DM+wid*8;
  const bf16*vsrc=Vh+(long)(16*(wid&3)+(lane>>2))*DM+(wid>>2)*32+(lane&3)*8;
  const unsigned kdst=lds0+LDS_K+wid*1024, vdst=lds0+LDS_V+wid*1024;
  #define DMA_K(t,slot) glds16(ksrc+(long)(t)*KVBLK*DM,(unsigned)__builtin_amdgcn_readfirstlane(kdst+(slot)))
  #define DMA_V(t,slot) glds16(vsrc+(long)(t)*KVBLK*DM,(unsigned)__builtin_amdgcn_readfirstlane(vdst+(slot)))
  const int vb0=(int)(lds0+LDS_V)+((lane>>4)&1)*32+(lane&3)*8+(4*hi+((lane&15)>>2))*64;
  const char*Kbase=shm+LDS_K; bf16x8 kf[8];
  const lds_cptr shm3=(lds_cptr)shm; const lds_cptr kp0=shm3+LDS_K+hi*1024+r32*16; const lds_cptr vp0=shm3+LDS_V+((lane>>4)&1)*32+(lane&3)*8+(4*hi+((lane&15)>>2))*64;
  const int NT=(q0+QB)/KVBLK;
  DMA_K(0,0);DMA_V(0,0);DMA_K(1,SLOTB);
  bf16x8 qr[4];
  #pragma unroll
  for(int d0=0;d0<4;++d0)qr[d0]=*reinterpret_cast<const bf16x8*>(&Qw[(long)r32*DM+d0*16+hi*8]);
  float mhat=0.f,l_reg=0.f;f32x16 o[2];o[0]=f32x16{};o[1]=f32x16{};u32x4 qaw={hi==0?0x3f803f80u:0u,0u,0u,0u};
  const int qrel=wid*QBLK+r32;
  #define CMASK(P0,P1,t) do{int jb_=(t)-(NT-4); if(jb_>=0)cmask(P0,P1,jb_,qrel,hi);}while(0)
  const __attribute__((address_space(3))) unsigned* biasw=(const __attribute__((address_space(3))) unsigned*)(shm3+LDS_BIAS)+r32;
  #define SETM() do{ const float nm_=-mhat; const unsigned h_=cvtpk_s(nm_,0.f)&0xffffu; const unsigned l_=cvtpk_s(nm_-__uint_as_float(h_<<16),0.f)&0xffffu; qaw[1]=(hi==0)?(h_|(l_<<16)):0u; }while(0)
  #define AUG(P0,P1,t) do{ const unsigned w0_=biasw[64*(t)], w1_=biasw[64*(t)+32]; const u32x4 ka0_={w0_,0x3f803f80u,0u,0u}, ka1_={w1_,0x3f803f80u,0u,0u}; \
      P0=__builtin_amdgcn_mfma_f32_32x32x16_bf16(__builtin_bit_cast(bf16x8,ka0_),__builtin_bit_cast(bf16x8,qaw),P0,0,0,0); \
      P1=__builtin_amdgcn_mfma_f32_32x32x16_bf16(__builtin_bit_cast(bf16x8,ka1_),__builtin_bit_cast(bf16x8,qaw),P1,0,0,0); }while(0)
  bool resc=false;
  #define START(P0,P1) do{ const float rm=rowmax(P0,P1); resc=false; \
    { const float dl=rm; mhat=fadd_s(mhat,dl); \
      _Pragma("unroll") for(int r=0;r<16;++r){P0[r]=fsub_s(P0[r],dl);P1[r]=fsub_s(P1[r],dl);} \
      SETM(); } \
    _Pragma("unroll") for(int r=0;r<16;++r)P0[r]=__builtin_amdgcn_exp2f(P0[r]); }while(0)
  #define RESC() do{ if(resc){ asm volatile("s_waitcnt lgkmcnt(0)":::"memory"); \
      _Pragma("unroll") for(int d_=0;d_<2;++d_) _Pragma("unroll") for(int r=0;r<16;++r)o[d_][r]*=wsf[crow(r,hi)]; } }while(0)
  f32x16 pA0,pA1,pB0,pB1;
  int sl_prev=0,sl_cur=0,sl_next=SLOTB;
  #define ROT() do{sl_prev=sl_cur;sl_cur=sl_next;sl_next=(sl_next==(NSLOT-1)*SLOTB)?0:sl_next+SLOTB;}while(0)
  DMA_K(2,2*SLOTB);
  WAIT_BAR(3);
  qkt(pA0,pA1,Kbase,qr,r32,hi);AUG(pA0,pA1,0);asm volatile("s_nop 15\n\ts_nop 7":"+v"(pA0),"+v"(pA1));CMASK(pA0,pA1,0);
  START(pA0,pA1);
  _Pragma("unroll") for(int r=0;r<16;++r)pA1[r]=__builtin_amdgcn_exp2f(pA1[r]);
  WAIT_BAR(0);
  DMA_K(3,0);DMA_V(1,SLOTB);
  ROT();
  kload8(kf,kp0+sl_cur);
  WAIT_BAR(2);
  s16x4 vlo[8],vhi[8]; u32x4 pw0,pw1,pw2,pw3; const f32x16 zc16=f32x16{};
  #define PKW(P,B) cvtpk_s(P[B],P[B+1])
  #define PAF(k) __builtin_bit_cast(bf16x8,pw##k)
  #define VFR(i) (bf16x8){vlo[i][0],vlo[i][1],vlo[i][2],vlo[i][3],vhi[i][0],vhi[i][1],vhi[i][2],vhi[i][3]}
  #define PIN(x) asm volatile("":"+v"(x))
  #define MX3(a,b,c) __builtin_fmaxf(__builtin_fmaxf((a),(b)),(c))
  #define GAPA(MF,A0,A1,A2,A3,W0,W1,PW) do{ MF; sacc+=A0; sacc+=A1; sacc+=A2; sacc+=A3; PIN(sacc); W0; W1; PIN(PW); SBAR(); }while(0)
  #define EX(v) __builtin_amdgcn_exp2f(v)
  #define GAPB(MF,X,B) do{ MF; X[B]=EX(X[B]); X[B+1]=EX(X[B+1]); X[B+2]=EX(X[B+2]); X[B+3]=EX(X[B+3]); PIN(X); SBAR(); }while(0)
  #define VRD(i) do{ vlo[i]=vtr(vp_+(((i)>>2)*4096+((i)&3)*1024)); vhi[i]=vtr(vp_+(((i)>>2)*4096+((i)&3)*1024+512)); }while(0)
  #define KRD(G,j) do{ if(G){ kload2(kf,kp0+sl_next,j); SBAR(); } }while(0)
  #define STEP(C0,C1,P0,P1,t,GK,GV,GL) do{ SBAR(); \
    const lds_cptr vp_=vp0+sl_prev; \
    VRD(0); SBAR(); float sacc=(P0[0]+P0[1]); \
    GAPA(C0=__builtin_amdgcn_mfma_f32_32x32x16_bf16(kf[0],qr[0],zc16,0,0,0), P0[2],P0[3],P0[4],P0[5],     pw0[0]=PKW(P0,0), pw0[1]=PKW(P0,2), pw0); \
    VRD(4); SBAR(); GAPA(C1=__builtin_amdgcn_mfma_f32_32x32x16_bf16(kf[1],qr[0],zc16,0,0,0), P0[6],P0[7],P0[8],P0[9],     pw0[2]=PKW(P0,4), pw0[3]=PKW(P0,6), pw0); \
    VRD(1); SBAR(); GAPA(C0=__builtin_amdgcn_mfma_f32_32x32x16_bf16(kf[2],qr[1],C0,0,0,0),   P0[10],P0[11],P0[12],P0[13], pw1[0]=PKW(P0,8), pw1[1]=PKW(P0,10), pw1); \
    VRD(5); SBAR(); GAPA(C1=__builtin_amdgcn_mfma_f32_32x32x16_bf16(kf[3],qr[1],C1,0,0,0),   P0[14],P0[15],P1[0],P1[1],   pw1[2]=PKW(P0,12),pw1[3]=PKW(P0,14), pw1); \
    VRD(2); SBAR(); GAPA(C0=__builtin_amdgcn_mfma_f32_32x32x16_bf16(kf[4],qr[2],C0,0,0,0),   P1[2],P1[3],P1[4],P1[5],     pw2[0]=PKW(P1,0), pw2[1]=PKW(P1,2), pw2); \
    VRD(6); SBAR(); GAPA(C1=__builtin_amdgcn_mfma_f32_32x32x16_bf16(kf[5],qr[2],C1,0,0,0),   P1[6],P1[7],P1[8],P1[9],     pw2[2]=PKW(P1,4), pw2[3]=PKW(P1,6), pw2); \
    VRD(3); SBAR(); GAPA(C0=__builtin_amdgcn_mfma_f32_32x32x16_bf16(kf[6],qr[3],C0,0,0,0),   P1[10],P1[11],P1[12],P1[13], pw3[0]=PKW(P1,8), pw3[1]=PKW(P1,10), pw3); \
    VRD(7); SBAR(); GAPA(C1=__builtin_amdgcn_mfma_f32_32x32x16_bf16(kf[7],qr[3],C1,0,0,0),   P1[14],P1[15],0.f,0.f,       pw3[2]=PKW(P1,12),pw3[3]=PKW(P1,14), pw3); \
    AUG(C0,C1,t); l_reg+=sacc; \
    if(GK){DMA_K((t)+3,sl_cur);} if(GV){DMA_V((t)+1,sl_next);} \
    CMASK(C0,C1,t); \
    { float a=MX3(C0[0],C0[1],C1[0]),b=MX3(C0[2],C0[3],C1[1]); a=MX3(a,C1[2],C1[3]); \
      _Pragma("unroll") for(int r=4;r<16;r+=4){a=MX3(a,C0[r],C0[r+1]);b=MX3(b,C0[r+2],C0[r+3]);a=MX3(a,C1[r],C1[r+1]);b=MX3(b,C1[r+2],C1[r+3]);} \
      float rm=__builtin_fmaxf(a,b); { auto rr=__builtin_amdgcn_permlane32_swap(__float_as_uint(rm),__float_as_uint(rm),false,false); rm=__builtin_fmaxf(__uint_as_float(rr[0]),__uint_as_float(rr[1])); } \
      resc=false; \
      if(__builtin_expect(__any(rm>(float)THRL),0)){ const float dl=__builtin_fmaxf(rm,0.f); mhat+=dl; \
        _Pragma("unroll") for(int r=0;r<16;++r){C0[r]-=dl;C1[r]-=dl;} \
        SETM(); \
        const float f=__builtin_amdgcn_exp2f(-dl); l_reg*=f; if(hi==0)wsf[r32]=f; resc=true; } } \
    SBAR(); \
    GAPB(o[0]=__builtin_amdgcn_mfma_f32_32x32x16_bf16(PAF(0),VFR(0),o[0],0,0,0), C0,0); \
    GAPB(o[1]=__builtin_amdgcn_mfma_f32_32x32x16_bf16(PAF(0),VFR(4),o[1],0,0,0), C0,4); \
    KRD(GL,0); GAPB(o[0]=__builtin_amdgcn_mfma_f32_32x32x16_bf16(PAF(1),VFR(1),o[0],0,0,0), C0,8); \
    KRD(GL,1); GAPB(o[1]=__builtin_amdgcn_mfma_f32_32x32x16_bf16(PAF(1),VFR(5),o[1],0,0,0), C0,12); \
    KRD(GL,2); GAPB(o[0]=__builtin_amdgcn_mfma_f32_32x32x16_bf16(PAF(2),VFR(2),o[0],0,0,0), C1,0); \
    KRD(GL,3); GAPB(o[1]=__builtin_amdgcn_mfma_f32_32x32x16_bf16(PAF(2),VFR(6),o[1],0,0,0), C1,4); \
    GAPB(o[0]=__builtin_amdgcn_mfma_f32_32x32x16_bf16(PAF(3),VFR(3),o[0],0,0,0), C1,8); \
    GAPB(o[1]=__builtin_amdgcn_mfma_f32_32x32x16_bf16(PAF(3),VFR(7),o[1],0,0,0), C1,12); \
    }while(0)
  int t=1;
  #undef CMASK
  #define CMASK(P0,P1,t) do{}while(0)
  for(;t+5<NT;t+=2){
    STEP(pB0,pB1,pA0,pA1,t,true,true,true);     WAIT_BAR(2); RESC(); ROT();
    STEP(pA0,pA1,pB0,pB1,t+1,true,true,true);   WAIT_BAR(2); RESC(); ROT();
  }
  #undef CMASK
  #define CMASK(P0,P1,t) do{int jb_=(t)-(NT-4); if(jb_>=0)cmask(P0,P1,jb_,qrel,hi);}while(0)
  #define ENDW(tt) do{ if((tt)+3<NT){WAIT_BAR(2);} else if((tt)+2<NT){WAIT_BAR(1);} else {WAIT_BAR(0);} }while(0)
  for(;t+1<NT;t+=2){
    STEP(pB0,pB1,pA0,pA1,t,(t+3<NT),(t+1<NT),(t+1<NT));       ENDW(t);   RESC(); ROT();
    STEP(pA0,pA1,pB0,pB1,t+1,(t+4<NT),(t+2<NT),(t+2<NT));     ENDW(t+1); RESC(); ROT();
  }
  STEP(pB0,pB1,pA0,pA1,NT-1,false,false,false); RESC();
  { float sacc=pB0[0]+pB0[1]; _Pragma("unroll") for(int r=2;r<16;++r)sacc+=pB0[r]; _Pragma("unroll") for(int r=0;r<16;++r)sacc+=pB1[r]; l_reg+=sacc;
    pw0=(u32x4){PKW(pB0,0),PKW(pB0,2),PKW(pB0,4),PKW(pB0,6)};pw1=(u32x4){PKW(pB0,8),PKW(pB0,10),PKW(pB0,12),PKW(pB0,14)};pw2=(u32x4){PKW(pB1,0),PKW(pB1,2),PKW(pB1,4),PKW(pB1,6)};pw3=(u32x4){PKW(pB1,8),PKW(pB1,10),PKW(pB1,12),PKW(pB1,14)};
    SBAR(); pv(o,vb0+sl_cur,PAF(0),PAF(1),PAF(2),PAF(3)); }
  #undef PKW
  #undef PAF
  #undef VFR
  #undef PIN
  #undef MX3
  #undef GAPA
  #undef GAPB
  #undef EX
  #undef VRD
  #undef KRD
  #undef STEP
  #undef ENDW
  {auto rr=__builtin_amdgcn_permlane32_swap(__float_as_uint(l_reg),__float_as_uint(l_reg),false,false);l_reg=__uint_as_float(rr[0])+__uint_as_float(rr[1]);}
  if(hi==0)wsf[32+r32]=l_reg;asm volatile("s_waitcnt lgkmcnt(0)":::"memory");
  float rli[16];
  #pragma unroll
  for(int r=0;r<16;++r)rli[r]=__builtin_amdgcn_rcpf(wsf[32+crow(r,hi)]);
  bf16*Ow=O+(rowbase+q0+wid*QBLK)*OPITCH+h*D;
  { bf16*stg=(bf16*)(shm+LDS_OST)+wid*2048;
    #pragma unroll
    for(int r=0;r<16;++r){const int orow=crow(r,hi);
      #pragma unroll
      for(int d0=0;d0<2;++d0)stg[orow*64+d0*32+r32]=__float2bfloat16(o[d0][r]*rli[r]);}
    asm volatile("s_waitcnt lgkmcnt(0)":::"memory");
    #pragma unroll
    for(int i=0;i<4;++i){const int row=i*8+(lane>>3),ch=lane&7; const u32x4 v=*(const u32x4*)(stg+row*64+ch*8); ATTN_STORE16(Ow+(long)row*OPITCH+ch*8,v);} }
  asm volatile("s_waitcnt lgkmcnt(0)\n\ts_barrier":::"memory");
  #undef DMA_K
  #undef DMA_V
  #undef CMASK
  #undef AUG
  #undef SETM
  #undef START
  #undef RESC
  #undef ROT
}
constexpr int ATTN_LDS_BYTES=LDS_BYTES;
#undef SBAR
#undef WAIT_BAR
}

namespace att {
template <bool CHECK> __device__ __forceinline__ void fox_unit_p(char* shm_g, LAS char* shm, int b, int h, int qb, const bf16_t* proj, const float* fb, float fbias_h, bf16_t* heads, unsigned* mism, bool do_scan) {
    const int tid = threadIdx.x, lane = tid & 63; const int wid = __builtin_amdgcn_readfirstlane(tid >> 6);
    if (do_scan) {
    LAS unsigned* biasw = (LAS unsigned*)(shm + attp::LDS_BIAS); LAS float* scan = (LAS float*)(shm + attp::LDS_SCAN);
    const int kend = (qb + 1) * 256;
    float v[4]; float s = 0.f;
#pragma unroll
    for (int i = 0; i < 4; ++i) { const int p = tid * 4 + i; float lf = 0.f; if (p < kend) lf = log_sigmoid_fast(fb[((size_t)b * SEQ + p) * 8 + h] + fbias_h); s += lf; v[i] = s; }
    float w = s;
#pragma unroll
    for (int o = 1; o < 64; o <<= 1) { const float t = __shfl_up(w, o); if (lane >= o) w += t; }
    if (lane == 63) scan[wid] = w;
    asm volatile("s_waitcnt lgkmcnt(0)\n\ts_barrier" ::: "memory");
    float off = w - s;
    for (int k = 0; k < 8; ++k) if (k < wid) off += scan[k];
#pragma unroll
    for (int i = 0; i < 4; ++i) { const float bv = -(v[i] + off) * LOG2E; const unsigned hb = cvt_pk_bf16(bv, 0.f) & 0xffffu; const unsigned lb = cvt_pk_bf16(bv - __uint_as_float(hb << 16), 0.f) & 0xffffu; biasw[tid * 4 + i] = hb | (lb << 16); }
    asm volatile("s_waitcnt vmcnt(0) lgkmcnt(0)\n\ts_barrier" ::: "memory");
    }
    attp::attn_unit<8, CHECK>(b, h, qb, (const attp::bf16*)(proj + 768), (const attp::bf16*)(proj + 1280), (const attp::bf16*)(proj + 1792), (attp::bf16*)(heads + 512), shm_g, mism);
    asm volatile("s_waitcnt vmcnt(0)" ::: "memory");
}
}
namespace mx {
using namespace mk;
constexpr size_t WS_QD = WS_XN, WS_KI = WS_XN + 16 * MiB, WS_DTV = 456 * MiB, WS_ACS = 457 * MiB, WS_KE = 458 * MiB, WS_DEC = 474 * MiB;
constexpr int XROW = 144;
__device__ __forceinline__ s16x4 tr_read(unsigned addr) { s16x4 r; asm volatile("ds_read_b64_tr_b16 %0, %1" : "=v"(r) : "v"(addr) : "memory"); return r; }
template <int OFF> __device__ __forceinline__ s16x4 tr_read_o(unsigned addr) { s16x4 r; asm volatile("ds_read_b64_tr_b16 %0, %1 offset:%2" : "=v"(r) : "v"(addr), "i"(OFF) : "memory"); return r; }
#define MX_LGKM0() do { asm volatile("s_waitcnt lgkmcnt(0)" ::: "memory"); __builtin_amdgcn_sched_barrier(0); } while (0)
#define MX_BAR() asm volatile("s_waitcnt vmcnt(0) lgkmcnt(0)\n\ts_barrier" ::: "memory")
#define MX_BAR_L() asm volatile("s_waitcnt lgkmcnt(0)\n\ts_barrier" ::: "memory")
__device__ __forceinline__ bf16x8 cat8(s16x4 lo, s16x4 hi) { return (bf16x8){lo[0], lo[1], lo[2], lo[3], hi[0], hi[1], hi[2], hi[3]}; }
__device__ __forceinline__ unsigned sw256(int row, int ch) { return (unsigned)(row * 256 + ((ch ^ (row & 15)) << 4)); }

__device__ __forceinline__ void prep_conv(const bf16_t* PROJ, bf16_t* CONV, const float* conv_w, const float* conv_b, int vcu, int G, int tid) {
    for (int item = vcu * NTHR + tid; item < (T / 16) * 192; item += G * NTHR) {
        const int cg = item % 192, rb = item / 192, ch0 = cg * 8, row0 = rb * 16, t0 = row0 & (SEQ - 1);
        float w[4][8], bs[8], xw[3][8];
#pragma unroll
        for (int j = 0; j < 4; ++j) { const f32x4 a = *(const f32x4*)(conv_w + j * 1536 + ch0), b = *(const f32x4*)(conv_w + j * 1536 + ch0 + 4);
#pragma unroll
            for (int i = 0; i < 4; ++i) { w[j][i] = a[i]; w[j][4 + i] = b[i]; } }
        { const f32x4 a = *(const f32x4*)(conv_b + ch0), b = *(const f32x4*)(conv_b + ch0 + 4);
#pragma unroll
          for (int i = 0; i < 4; ++i) { bs[i] = a[i]; bs[4 + i] = b[i]; } }
#pragma unroll
        for (int j = 0; j < 3; ++j) { const int tt = t0 - 3 + j;
            u32x4 v = {0u, 0u, 0u, 0u}; if (tt >= 0) v = *(const u32x4*)(PROJ + (size_t)(row0 - 3 + j) * NO_IN + 1024 + ch0);
#pragma unroll
            for (int i = 0; i < 4; ++i) { xw[j][2 * i] = __uint_as_float(v[i] << 16); xw[j][2 * i + 1] = __uint_as_float(v[i] & 0xffff0000u); } }
#pragma unroll 4
        for (int r = 0; r < 16; ++r) {
            const u32x4 v = __builtin_nontemporal_load((const u32x4*)(PROJ + (size_t)(row0 + r) * NO_IN + 1024 + ch0));
            float x3[8], o[8];
#pragma unroll
            for (int i = 0; i < 4; ++i) { x3[2 * i] = __uint_as_float(v[i] << 16); x3[2 * i + 1] = __uint_as_float(v[i] & 0xffff0000u); }
#pragma unroll
            for (int i = 0; i < 8; ++i) { const float a = bs[i] + w[0][i] * xw[0][i] + w[1][i] * xw[1][i] + w[2][i] * xw[2][i] + w[3][i] * x3[i]; o[i] = siluf(a);
                xw[0][i] = xw[1][i]; xw[1][i] = xw[2][i]; xw[2][i] = x3[i]; }
            u32x4 ov; ov.x = cvt_pk_bf16(o[0], o[1]); ov.y = cvt_pk_bf16(o[2], o[3]); ov.z = cvt_pk_bf16(o[4], o[5]); ov.w = cvt_pk_bf16(o[6], o[7]);
            *(u32x4*)(CONV + (size_t)(row0 + r) * 1536 + ch0) = ov;
        }
    }
}
__device__ __forceinline__ void prep_ssd(const float* DTG, float* DTV, float* ACS, const float* dt_bias, const float* a_log, int vcu, int G, int lane, int wave) {
    const int gw = vcu * NWAVES + wave, ngw = G * NWAVES;
    for (int item = gw; item < NBATCH * 32 * 16; item += ngw) {
        const int h = item & 15, c = (item >> 4) & 31, b = item >> 9; const size_t r0 = (size_t)b * SEQ + c * 64 + lane;
        const float a = -expf(a_log[h]), db = dt_bias[h];
        const float d0 = softplusf(DTG[r0 * 32 + h] + db);
        float w = a * d0;
#pragma unroll
        for (int o = 1; o < 64; o <<= 1) { const float t = __shfl_up(w, o); if (lane >= o) w += t; }
        ACS[r0 * 16 + h] = w; DTV[r0 * 16 + h] = d0;
    }
}
__device__ __forceinline__ void prep_gla(const bf16_t* PROJ, const float* DTG, bf16_t* QD, bf16_t* KI, bf16_t* KE, float* DEC, const float* gk_w, const float* gk_b, int vcu, int G, int tid, int lane, int wave, LAS char* shm) {
    {
        LAS float* gl = (LAS float*)(shm);
        LAS float* tot = (LAS float*)(shm + 8192);
        const int half = wave >> 2, rq = wave & 3, t256 = tid & 255;
        for (int pair = vcu; pair < NBATCH * 32 * 4 / 2; pair += G) {
            const int item = pair * 2 + half; const int h = item & 3, c = (item >> 2) & 31, b = item >> 7; const size_t r0 = (size_t)b * SEQ + c * 64;
            unsigned short qv[16][2], kv[16][2];
#pragma unroll
            for (int r = 0; r < 16; ++r) { const bf16_t* pr = PROJ + (r0 + rq * 16 + r) * NO_IN;
                qv[r][0] = pr[2560 + h * 128 + lane]; qv[r][1] = pr[2560 + h * 128 + 64 + lane]; kv[r][0] = pr[3072 + h * 128 + lane]; kv[r][1] = pr[3072 + h * 128 + 64 + lane]; }
            float w0[16], w1[16];
#pragma unroll
            for (int j = 0; j < 16; ++j) { w0[j] = gk_w[j * 512 + h * 128 + lane]; w1[j] = gk_w[j * 512 + h * 128 + 64 + lane]; }
            const float b0 = gk_b[h * 128 + lane], b1 = gk_b[h * 128 + 64 + lane];
            { const int rr = t256 >> 2, q4 = t256 & 3; *(LAS f32x4*)(gl + half * 1024 + rr * 16 + q4 * 4) = *(const f32x4*)(DTG + (r0 + rr) * 32 + 16 + q4 * 4); }
            asm volatile("s_waitcnt vmcnt(0) lgkmcnt(0)\n\ts_barrier" ::: "memory");
            float c0[16], c1[16]; float run0 = 0.f, run1 = 0.f;
#pragma unroll
            for (int r = 0; r < 16; ++r) {
                const LAS f32x4* gp = (const LAS f32x4*)(gl + half * 1024 + (rq * 16 + r) * 16); float a0 = b0, a1 = b1;
#pragma unroll
                for (int q = 0; q < 4; ++q) { const f32x4 g = gp[q];
#pragma unroll
                    for (int i = 0; i < 4; ++i) { a0 += g[i] * w0[4 * q + i]; a1 += g[i] * w1[4 * q + i]; } }
                run0 += log_sigmoid_fast(a0) * (1.f / 16.f); run1 += log_sigmoid_fast(a1) * (1.f / 16.f); c0[r] = run0; c1[r] = run1;
            }
            tot[(half * 4 + rq) * 128 + lane] = run0; tot[(half * 4 + rq) * 128 + 64 + lane] = run1;
            asm volatile("s_waitcnt lgkmcnt(0)\n\ts_barrier" ::: "memory");
            float pre0 = 0.f, pre1 = 0.f, last0 = 0.f, last1 = 0.f;
#pragma unroll
            for (int q = 0; q < 4; ++q) { const float t0 = tot[(half * 4 + q) * 128 + lane], t1 = tot[(half * 4 + q) * 128 + 64 + lane]; if (q < rq) { pre0 += t0; pre1 += t1; } last0 += t0; last1 += t1; }
            const float scale = 0.08838834764831845f;
#pragma unroll
            for (int r = 0; r < 16; ++r) {
                const float g0 = pre0 + c0[r], g1 = pre1 + c1[r];
                const float q0 = bf2f(qv[r][0]), q1 = bf2f(qv[r][1]), k0 = bf2f(kv[r][0]), k1 = bf2f(kv[r][1]);
                const size_t o = (r0 + rq * 16 + r) * 512 + h * 128 + lane;
                QD[o] = (bf16_t)(cvt_pk_bf16(q0 * scale * __expf(g0), 0.f) & 0xffffu); QD[o + 64] = (bf16_t)(cvt_pk_bf16(q1 * scale * __expf(g1), 0.f) & 0xffffu);
                KI[o] = (bf16_t)(cvt_pk_bf16(k0 * __expf(-g0), 0.f) & 0xffffu); KI[o + 64] = (bf16_t)(cvt_pk_bf16(k1 * __expf(-g1), 0.f) & 0xffffu);
            }
            if (rq == 0) { DEC[((size_t)b * 32 + c) * 512 + h * 128 + lane] = __expf(last0); DEC[((size_t)b * 32 + c) * 512 + h * 128 + 64 + lane] = __expf(last1); }
            asm volatile("s_waitcnt lgkmcnt(0)\n\ts_barrier" ::: "memory");
        }
    }
}

constexpr int S_C = 0, S_B = 32768, S_X = 65536, S_XW = S_X + 128 * XROW, S_PREV = S_XW + 128 * XROW, S_ACS = S_PREV + 16384, S_DT = S_ACS + 512, S_YST = S_DT + 512, S_END = S_YST + 8 * 2304;
static_assert(S_END <= RING_BYTES, "SSD LDS");
__device__ __forceinline__ void ssd_unit(LAS char* shm, int b, int h, const bf16_t* CONV, const float* ACS, const float* DTV, float dsk, bf16_t* MIX) {
    const int tid = threadIdx.x, lane = tid & 63, fr = lane & 15, fq = lane >> 4; const int w = __builtin_amdgcn_readfirstlane(tid >> 6);
    const int g = h >> 3, row = tid >> 2, qd = tid & 3, l0 = 16 * w;
    const unsigned lds0 = (unsigned)(uintptr_t)shm;
    LAS float* acsl = (LAS float*)(shm + S_ACS); LAS float* dtl = (LAS float*)(shm + S_DT);
    f32x4 st[4];
#pragma unroll
    for (int i = 0; i < 4; ++i) st[i] = (f32x4){0.f, 0.f, 0.f, 0.f};
    u32x4 rc[4], rb[4], rx[2]; float racs, rdt, rend;
    const size_t seq0 = (size_t)b * SEQ;
#define SSD_LOAD(c) do { const size_t gr = seq0 + (size_t)(c) * 128 + row; const bf16_t* p = CONV + gr * 1536; \
        _Pragma("unroll") for (int i = 0; i < 4; ++i) { rc[i] = *(const u32x4*)(p + 1280 + g * 128 + qd * 32 + 8 * i); rb[i] = *(const u32x4*)(p + 1024 + g * 128 + qd * 32 + 8 * i); } \
        _Pragma("unroll") for (int i = 0; i < 2; ++i) rx[i] = *(const u32x4*)(p + h * 64 + qd * 16 + 8 * i); \
        racs = ACS[gr * 16 + h]; rdt = DTV[gr * 16 + h]; rend = ACS[(seq0 + (size_t)(c) * 128 + 127) * 16 + h]; } while (0)
#ifdef SSD_DUMMY
    SSD_LOAD(0);
    for (int c = 0; c < 16; ++c) {
#pragma unroll
        for (int i = 0; i < 4; ++i) { *(LAS u32x4*)(shm + S_C + sw256(row, qd * 4 + i)) = rc[i]; *(LAS u32x4*)(shm + S_B + sw256(row, qd * 4 + i)) = rb[i]; }
        const float wr = rdt * __expf(rend - racs);
#pragma unroll
        for (int i = 0; i < 2; ++i) { *(LAS u32x4*)(shm + S_X + row * XROW + qd * 32 + 16 * i) = rx[i];
            u32x4 o;
#pragma unroll
            for (int k = 0; k < 4; ++k) o[k] = cvt_pk_bf16(__uint_as_float(rx[i][k] << 16) * wr, __uint_as_float(rx[i][k] & 0xffff0000u) * wr);
            *(LAS u32x4*)(shm + S_XW + row * XROW + qd * 32 + 16 * i) = o; }
        if (qd == 0) { acsl[row] = racs; dtl[row] = rdt; }
        MX_BAR_L();
        if (c + 1 < 16) SSD_LOAD(c + 1);
        MX_BAR_L();
    }
#endif
#ifndef SSD_NOPREF
    SSD_LOAD(0);
#endif
    const unsigned xtr = lds0 + (unsigned)(((lane & 15) >> 2) * XROW + (lane & 3) * 8);
    for (int c = 0; c < 16; ++c) {
#ifdef SSD_NOPREF
        SSD_LOAD(c);
#endif
#ifdef SSD_REP_WR
        for (int rep_ = 0; rep_ < 2; ++rep_)
#endif
        {
#pragma unroll
            for (int i = 0; i < 4; ++i) { *(LAS u32x4*)(shm + S_C + sw256(row, qd * 4 + i)) = rc[i]; *(LAS u32x4*)(shm + S_B + sw256(row, qd * 4 + i)) = rb[i]; }
            const float wr = rdt * __expf(rend - racs);
#pragma unroll
            for (int i = 0; i < 2; ++i) { *(LAS u32x4*)(shm + S_X + row * XROW + qd * 32 + 16 * i) = rx[i];
                u32x4 o;
#pragma unroll
                for (int k = 0; k < 4; ++k) o[k] = cvt_pk_bf16(__uint_as_float(rx[i][k] << 16) * wr, __uint_as_float(rx[i][k] & 0xffff0000u) * wr);
                *(LAS u32x4*)(shm + S_XW + row * XROW + qd * 32 + 16 * i) = o; }
            if (qd == 0) { acsl[row] = racs; dtl[row] = rdt; }
#pragma unroll
            for (int pt = 0; pt < 4; ++pt) { u32x2 v; v.x = cvt_pk_bf16(st[pt][0], st[pt][1]); v.y = cvt_pk_bf16(st[pt][2], st[pt][3]);
                const int p = 16 * pt + fr; *(LAS u32x2*)(shm + S_PREV + sw256(p, 2 * w + (fq >> 1)) + (fq & 1) * 8) = v; }
        }
        MX_BAR_L();
#ifndef SSD_NOPREF
        if (c + 1 < 16) SSD_LOAD(c + 1);
#endif
        bf16x8 cf[4];
#pragma unroll
        for (int ks = 0; ks < 4; ++ks) cf[ks] = *(const LAS bf16x8*)(shm + S_C + sw256(l0 + fr, 4 * ks + fq));
        f32x4 yd[4], yo[4];
#pragma unroll
        for (int i = 0; i < 4; ++i) { yd[i] = (f32x4){0.f, 0.f, 0.f, 0.f}; yo[i] = (f32x4){0.f, 0.f, 0.f, 0.f}; }
        const float acs_l = acsl[l0 + fr]; const int lcol = l0 + fr;
        const int nsb = (w >> 1) + 1;
#ifdef SSD_REP_SB
        for (int rep_ = 0; rep_ < 2; ++rep_) {
#pragma unroll
        for (int i = 0; i < 4; ++i) yd[i] = (f32x4){0.f, 0.f, 0.f, 0.f};
#endif
        for (int sb = 0; sb < nsb; ++sb) {
            const int s0 = 32 * sb; const bool two = (2 * sb + 1) <= w;
            s16x4 lo[4], hi[4];
#pragma unroll
            for (int pt = 0; pt < 4; ++pt) { lo[pt] = tr_read(xtr + S_X + (unsigned)((s0 + 4 * fq) * XROW + pt * 32)); hi[pt] = tr_read(xtr + S_X + (unsigned)((s0 + 16 + 4 * fq) * XROW + pt * 32)); }
            f32x4 a0 = {0.f, 0.f, 0.f, 0.f}, a1 = {0.f, 0.f, 0.f, 0.f};
#pragma unroll
            for (int ks = 0; ks < 4; ++ks) { const bf16x8 bf = *(const LAS bf16x8*)(shm + S_B + sw256(s0 + fr, 4 * ks + fq)); a0 = __builtin_amdgcn_mfma_f32_16x16x32_bf16(bf, cf[ks], a0, 0, 0, 0); }
            if (two) {
#pragma unroll
                for (int ks = 0; ks < 4; ++ks) { const bf16x8 bf = *(const LAS bf16x8*)(shm + S_B + sw256(s0 + 16 + fr, 4 * ks + fq)); a1 = __builtin_amdgcn_mfma_f32_16x16x32_bf16(bf, cf[ks], a1, 0, 0, 0); }
            }
            const f32x4 as0 = *(const LAS f32x4*)(acsl + s0 + 4 * fq), as1 = *(const LAS f32x4*)(acsl + s0 + 16 + 4 * fq);
            const f32x4 dq0 = *(const LAS f32x4*)(dtl + s0 + 4 * fq), dq1 = *(const LAS f32x4*)(dtl + s0 + 16 + 4 * fq);
            float g0[4], g1[4];
#pragma unroll
            for (int i = 0; i < 4; ++i) { const int sa = s0 + 4 * fq + i, sb2 = sa + 16;
                g0[i] = (sa <= lcol) ? a0[i] * __expf(fminf(acs_l - as0[i], 0.f)) * dq0[i] : 0.f;
                g1[i] = (two && sb2 <= lcol) ? a1[i] * __expf(fminf(acs_l - as1[i], 0.f)) * dq1[i] : 0.f; }
            u32x4 ap; ap.x = cvt_pk_bf16(g0[0], g0[1]); ap.y = cvt_pk_bf16(g0[2], g0[3]); ap.z = cvt_pk_bf16(g1[0], g1[1]); ap.w = cvt_pk_bf16(g1[2], g1[3]);
            const bf16x8 af = __builtin_bit_cast(bf16x8, ap);
            MX_LGKM0();
#pragma unroll
            for (int pt = 0; pt < 4; ++pt) yd[pt] = __builtin_amdgcn_mfma_f32_16x16x32_bf16(af, cat8(lo[pt], hi[pt]), yd[pt], 0, 0, 0);
        }
#ifdef SSD_REP_SB
        }
#endif
#ifdef SSD_REP_YO
        for (int rep_ = 0; rep_ < 2; ++rep_) {
#pragma unroll
        for (int i = 0; i < 4; ++i) yo[i] = (f32x4){0.f, 0.f, 0.f, 0.f};
#endif
#pragma unroll
        for (int pt = 0; pt < 4; ++pt)
#pragma unroll
            for (int ks = 0; ks < 4; ++ks) { const bf16x8 pf = *(const LAS bf16x8*)(shm + S_PREV + sw256(16 * pt + fr, 4 * ks + fq)); yo[pt] = __builtin_amdgcn_mfma_f32_16x16x32_bf16(cf[ks], pf, yo[pt], 0, 0, 0); }
#ifdef SSD_REP_YO
        }
#endif
#ifdef SSD_REP_CS
        for (int rep_ = 0; rep_ < 2; ++rep_)
#endif
        {
            const f32x4 al = *(const LAS f32x4*)(acsl + l0 + 4 * fq);
            float ea[4];
#pragma unroll
            for (int i = 0; i < 4; ++i) ea[i] = __expf(al[i]);
            s16x4 xs[4];
#pragma unroll
            for (int pt = 0; pt < 4; ++pt) xs[pt] = tr_read(xtr + S_X + (unsigned)((l0 + 4 * fq) * XROW + pt * 32));
            MX_LGKM0();
            LAS bf16_t* yst = (LAS bf16_t*)(shm + S_YST + w * 2304);
#pragma unroll
            for (int pt = 0; pt < 4; ++pt)
#pragma unroll
                for (int i = 0; i < 4; ++i) { const float y = yd[pt][i] + ea[i] * yo[pt][i] + dsk * bf2f((unsigned short)xs[pt][i]);
                    yst[(4 * fq + i) * 72 + pt * 16 + fr] = (bf16_t)(cvt_pk_bf16(y, 0.f) & 0xffffu); }
            asm volatile("s_waitcnt lgkmcnt(0)" ::: "memory");
            bf16_t* yp = MIX + (seq0 + (size_t)c * 128 + l0) * 2048 + h * 64;
#pragma unroll
            for (int j = 0; j < 2; ++j) { const int rr = (lane >> 3) + 8 * j, ch = lane & 7; const u32x4 v = *(const LAS u32x4*)(yst + rr * 72 + ch * 8); *(u32x4*)(yp + (size_t)rr * 2048 + ch * 8) = v; }
        }
#ifdef SSD_REP_ST
        f32x4 stsave[4];
#pragma unroll
        for (int i = 0; i < 4; ++i) stsave[i] = st[i];
        for (int rep_ = 0; rep_ < 2; ++rep_) {
#pragma unroll
        for (int i = 0; i < 4; ++i) st[i] = stsave[i];
#endif
        {
            const float cd = __expf(acsl[127]);
#pragma unroll
            for (int pt = 0; pt < 4; ++pt) st[pt] = st[pt] * cd;
#pragma unroll
            for (int ks = 0; ks < 4; ++ks) {
                const int s0 = 32 * ks, q = (lane & 15) >> 2, p = lane & 3;
                const int r1 = s0 + 8 * fq + q, r2 = r1 + 4;
                const s16x4 alo = tr_read(lds0 + S_B + sw256(r1, 2 * w + (p >> 1)) + (p & 1) * 8), ahi = tr_read(lds0 + S_B + sw256(r2, 2 * w + (p >> 1)) + (p & 1) * 8);
                s16x4 lo[4], hi[4];
#pragma unroll
                for (int pt = 0; pt < 4; ++pt) { lo[pt] = tr_read(xtr + S_XW + (unsigned)((s0 + 8 * fq) * XROW + pt * 32)); hi[pt] = tr_read(xtr + S_XW + (unsigned)((s0 + 8 * fq + 4) * XROW + pt * 32)); }
                MX_LGKM0();
                const bf16x8 af = cat8(alo, ahi);
#pragma unroll
                for (int pt = 0; pt < 4; ++pt) st[pt] = __builtin_amdgcn_mfma_f32_16x16x32_bf16(af, cat8(lo[pt], hi[pt]), st[pt], 0, 0, 0);
            }
        }
#ifdef SSD_REP_ST
        }
#endif
        MX_BAR_L();
    }
    asm volatile("s_waitcnt vmcnt(0)" ::: "memory");
#undef SSD_LOAD
}

constexpr int S2_C = 0, S2_B = 16384, S2_X = 32768, S2_XW = S2_X + 64 * XROW, S2_ACS = S2_XW + 64 * XROW, S2_DT = S2_ACS + 256, S2_BUF = 53248, S2_PREV = 2 * S2_BUF, S2_END = S2_PREV + 2 * 16384;
static_assert(S2_DT + 256 <= S2_BUF && S2_END <= RING_BYTES, "SSD64 LDS");
__device__ __forceinline__ void ssd_unit64(LAS char* shm, int b, int h, const bf16_t* CONV, const float* ACS, const float* DTV, float dsk, bf16_t* MIX) {
    const int tid = threadIdx.x, lane = tid & 63, fr = lane & 15, fq = lane >> 4; const int w = __builtin_amdgcn_readfirstlane(tid >> 6);
    const int g = h >> 3, row = tid >> 3, ec = tid & 7, lt = w >> 1, l0 = 16 * lt, pt0 = 2 * (w & 1);
    const unsigned lds0 = (unsigned)(uintptr_t)shm;
    f32x4 st[4];
#pragma unroll
    for (int i = 0; i < 4; ++i) st[i] = (f32x4){0.f, 0.f, 0.f, 0.f};
    u32x4 rc[2], rb[2], rx; float racs, rdt, rend;
    const size_t seq0 = (size_t)b * SEQ;
#define S2_LOAD(c) do { const size_t gr = seq0 + (size_t)(c) * 64 + row; const bf16_t* p = CONV + gr * 1536; \
        _Pragma("unroll") for (int i = 0; i < 2; ++i) { rc[i] = *(const u32x4*)(p + 1280 + g * 128 + ec * 16 + 8 * i); rb[i] = *(const u32x4*)(p + 1024 + g * 128 + ec * 16 + 8 * i); } \
        rx = *(const u32x4*)(p + h * 64 + ec * 8); \
        racs = ACS[gr * 16 + h]; rdt = DTV[gr * 16 + h]; rend = ACS[(seq0 + (size_t)(c) * 64 + 63) * 16 + h]; } while (0)
#define S2_WRITE(pb) do { LAS char* gb_ = shm + (pb) * S2_BUF; \
        _Pragma("unroll") for (int i = 0; i < 2; ++i) { *(LAS u32x4*)(gb_ + S2_C + sw256(row, ec * 2 + i)) = rc[i]; *(LAS u32x4*)(gb_ + S2_B + sw256(row, ec * 2 + i)) = rb[i]; } \
        *(LAS u32x4*)(gb_ + S2_X + row * XROW + ec * 16) = rx; \
        { const float wr_ = rdt * __expf(rend - racs); u32x4 o_; \
          _Pragma("unroll") for (int k = 0; k < 4; ++k) o_[k] = cvt_pk_bf16(__uint_as_float(rx[k] << 16) * wr_, __uint_as_float(rx[k] & 0xffff0000u) * wr_); \
          *(LAS u32x4*)(gb_ + S2_XW + row * XROW + ec * 16) = o_; } \
        if (ec == 0) { ((LAS float*)(gb_ + S2_ACS))[row] = racs; ((LAS float*)(gb_ + S2_DT))[row] = rdt; } \
        _Pragma("unroll") for (int pt = 0; pt < 4; ++pt) { u32x2 v; v.x = cvt_pk_bf16(st[pt][0], st[pt][1]); v.y = cvt_pk_bf16(st[pt][2], st[pt][3]); \
            const int p_ = 16 * pt + fr; *(LAS u32x2*)(shm + S2_PREV + (pb) * 16384 + sw256(p_, 2 * w + (fq >> 1)) + (fq & 1) * 8) = v; } } while (0)
    S2_LOAD(0);
    S2_WRITE(0);
    MX_BAR_L();
    unsigned swz[4];
#pragma unroll
    for (int ks = 0; ks < 4; ++ks) swz[ks] = (unsigned)(fr * 256 + (((4 * ks + fq) ^ fr) << 4));
    const int q_ = (lane & 15) >> 2, p_ = lane & 3;
    const unsigned xq4 = (unsigned)((4 * fq + q_) * XROW + p_ * 8), xq8 = (unsigned)((8 * fq + q_) * XROW + p_ * 8);
    const int ra = 8 * fq + q_, rb2 = ra + 4;
    const unsigned bt1 = (unsigned)(ra * 256 + (((2 * w + (p_ >> 1)) ^ (ra & 15)) << 4) + (p_ & 1) * 8), bt2 = (unsigned)(rb2 * 256 + (((2 * w + (p_ >> 1)) ^ (rb2 & 15)) << 4) + (p_ & 1) * 8);
    for (int c = 0; c < 32; ++c) {
        const int pb = c & 1; LAS char* gb = shm + pb * S2_BUF; const unsigned gba = lds0 + (unsigned)(pb * S2_BUF);
        const LAS float* acsl = (const LAS float*)(gb + S2_ACS); const LAS float* dtl = (const LAS float*)(gb + S2_DT);
        if (c + 1 < 32) S2_LOAD(c + 1);
        const LAS char* cbp[4]; const LAS char* pvp[4];
#pragma unroll
        for (int ks = 0; ks < 4; ++ks) { cbp[ks] = gb + swz[ks]; pvp[ks] = shm + S2_PREV + pb * 16384 + pt0 * 4096 + swz[ks]; }
        const unsigned xa4 = gba + xq4 + (unsigned)(pt0 * 32), xa8 = gba + xq8, ba1 = gba + bt1, ba2 = gba + bt2;
        bf16x8 cf[4];
#pragma unroll
        for (int ks = 0; ks < 4; ++ks) cf[ks] = *(const LAS bf16x8*)(cbp[ks] + S2_C + l0 * 256);
        f32x4 yd[2], yo[2];
#pragma unroll
        for (int i = 0; i < 2; ++i) { yd[i] = (f32x4){0.f, 0.f, 0.f, 0.f}; yo[i] = (f32x4){0.f, 0.f, 0.f, 0.f}; }
        const float acs_l = acsl[l0 + fr]; const int lcol = l0 + fr;
#pragma unroll
        for (int sb = 0; sb < 2; ++sb) if (2 * sb <= lt) {
            constexpr int dummy = 0; (void)dummy;
            const int s0 = 32 * sb; const bool two = (2 * sb + 1) <= lt;
            s16x4 lo[2], hi[2];
            if (sb == 0) { lo[0] = tr_read_o<S2_X>(xa4); lo[1] = tr_read_o<S2_X + 32>(xa4); hi[0] = tr_read_o<S2_X + 16 * XROW>(xa4); hi[1] = tr_read_o<S2_X + 16 * XROW + 32>(xa4); }
            else         { lo[0] = tr_read_o<S2_X + 32 * XROW>(xa4); lo[1] = tr_read_o<S2_X + 32 * XROW + 32>(xa4); hi[0] = tr_read_o<S2_X + 48 * XROW>(xa4); hi[1] = tr_read_o<S2_X + 48 * XROW + 32>(xa4); }
            f32x4 a0 = {0.f, 0.f, 0.f, 0.f}, a1 = {0.f, 0.f, 0.f, 0.f};
#pragma unroll
            for (int ks = 0; ks < 4; ++ks) { const bf16x8 bf = *(const LAS bf16x8*)(cbp[ks] + S2_B + s0 * 256); a0 = __builtin_amdgcn_mfma_f32_16x16x32_bf16(bf, cf[ks], a0, 0, 0, 0); }
            if (two) {
#pragma unroll
                for (int ks = 0; ks < 4; ++ks) { const bf16x8 bf = *(const LAS bf16x8*)(cbp[ks] + S2_B + (s0 + 16) * 256); a1 = __builtin_amdgcn_mfma_f32_16x16x32_bf16(bf, cf[ks], a1, 0, 0, 0); }
            }
            const f32x4 as0 = *(const LAS f32x4*)(acsl + s0 + 4 * fq), as1 = *(const LAS f32x4*)(acsl + s0 + 16 + 4 * fq);
            const f32x4 dq0 = *(const LAS f32x4*)(dtl + s0 + 4 * fq), dq1 = *(const LAS f32x4*)(dtl + s0 + 16 + 4 * fq);
            float g0[4], g1[4];
#pragma unroll
            for (int i = 0; i < 4; ++i) { g0[i] = a0[i] * __expf(acs_l - as0[i]) * dq0[i]; g1[i] = a1[i] * __expf(acs_l - as1[i]) * dq1[i]; }
            if (2 * sb == lt) {
#pragma unroll
                for (int i = 0; i < 4; ++i) { if (s0 + 4 * fq + i > lcol) g0[i] = 0.f; }
            }
            if (!two) {
#pragma unroll
                for (int i = 0; i < 4; ++i) g1[i] = 0.f;
            } else if (2 * sb + 1 == lt) {
#pragma unroll
                for (int i = 0; i < 4; ++i) { if (s0 + 16 + 4 * fq + i > lcol) g1[i] = 0.f; }
            }
            u32x4 ap; ap.x = cvt_pk_bf16(g0[0], g0[1]); ap.y = cvt_pk_bf16(g0[2], g0[3]); ap.z = cvt_pk_bf16(g1[0], g1[1]); ap.w = cvt_pk_bf16(g1[2], g1[3]);
            const bf16x8 af = __builtin_bit_cast(bf16x8, ap);
            MX_LGKM0();
#pragma unroll
            for (int vi = 0; vi < 2; ++vi) yd[vi] = __builtin_amdgcn_mfma_f32_16x16x32_bf16(af, cat8(lo[vi], hi[vi]), yd[vi], 0, 0, 0);
        }
#pragma unroll
        for (int vi = 0; vi < 2; ++vi)
#pragma unroll
            for (int ks = 0; ks < 4; ++ks) { const bf16x8 pf = *(const LAS bf16x8*)(pvp[ks] + vi * 4096); yo[vi] = __builtin_amdgcn_mfma_f32_16x16x32_bf16(cf[ks], pf, yo[vi], 0, 0, 0); }
        {
            const f32x4 al = *(const LAS f32x4*)(acsl + l0 + 4 * fq);
            float ea[4];
#pragma unroll
            for (int i = 0; i < 4; ++i) ea[i] = __expf(al[i]);
            const unsigned xl = xa4 + (unsigned)(l0 * XROW);
            s16x4 xs[2]; xs[0] = tr_read_o<S2_X>(xl); xs[1] = tr_read_o<S2_X + 32>(xl);
            MX_LGKM0();
            bf16_t* yp = MIX + (seq0 + (size_t)c * 64 + l0 + 4 * fq) * 2048 + h * 64 + pt0 * 16 + fr;
#pragma unroll
            for (int vi = 0; vi < 2; ++vi)
#pragma unroll
                for (int i = 0; i < 4; ++i) { const float y = yd[vi][i] + ea[i] * yo[vi][i] + dsk * bf2f((unsigned short)xs[vi][i]);
                    yp[(size_t)i * 2048 + vi * 16] = (bf16_t)(cvt_pk_bf16(y, 0.f) & 0xffffu); }
        }
        {
            const float cd = __expf(acsl[63]);
#pragma unroll
            for (int pt = 0; pt < 4; ++pt) st[pt] = st[pt] * cd;
            {   s16x4 lo[4], hi[4];
                const s16x4 alo = tr_read_o<S2_B>(ba1), ahi = tr_read_o<S2_B>(ba2);
                lo[0] = tr_read_o<S2_XW>(xa8); lo[1] = tr_read_o<S2_XW + 32>(xa8); lo[2] = tr_read_o<S2_XW + 64>(xa8); lo[3] = tr_read_o<S2_XW + 96>(xa8);
                hi[0] = tr_read_o<S2_XW + 4 * XROW>(xa8); hi[1] = tr_read_o<S2_XW + 4 * XROW + 32>(xa8); hi[2] = tr_read_o<S2_XW + 4 * XROW + 64>(xa8); hi[3] = tr_read_o<S2_XW + 4 * XROW + 96>(xa8);
                MX_LGKM0();
                const bf16x8 af = cat8(alo, ahi);
#pragma unroll
                for (int pt = 0; pt < 4; ++pt) st[pt] = __builtin_amdgcn_mfma_f32_16x16x32_bf16(af, cat8(lo[pt], hi[pt]), st[pt], 0, 0, 0); }
            {   s16x4 lo[4], hi[4];
                const s16x4 alo = tr_read_o<S2_B + 32 * 256>(ba1), ahi = tr_read_o<S2_B + 32 * 256>(ba2);
                lo[0] = tr_read_o<S2_XW + 32 * XROW>(xa8); lo[1] = tr_read_o<S2_XW + 32 * XROW + 32>(xa8); lo[2] = tr_read_o<S2_XW + 32 * XROW + 64>(xa8); lo[3] = tr_read_o<S2_XW + 32 * XROW + 96>(xa8);
                hi[0] = tr_read_o<S2_XW + 36 * XROW>(xa8); hi[1] = tr_read_o<S2_XW + 36 * XROW + 32>(xa8); hi[2] = tr_read_o<S2_XW + 36 * XROW + 64>(xa8); hi[3] = tr_read_o<S2_XW + 36 * XROW + 96>(xa8);
                MX_LGKM0();
                const bf16x8 af = cat8(alo, ahi);
#pragma unroll
                for (int pt = 0; pt < 4; ++pt) st[pt] = __builtin_amdgcn_mfma_f32_16x16x32_bf16(af, cat8(lo[pt], hi[pt]), st[pt], 0, 0, 0); }
        }
        if (c + 1 < 32) S2_WRITE(pb ^ 1);
        MX_BAR_L();
    }
    asm volatile("s_waitcnt vmcnt(0)" ::: "memory");
#undef S2_LOAD
#undef S2_WRITE
}

constexpr int G_QD = 0, G_KI = 16384, G_V = 32768, G_DEC = G_V + 64 * XROW, G_BUF = 45056, G_SP = 2 * G_BUF, G_END = G_SP + 2 * 16384;
static_assert(G_DEC + 512 <= G_BUF && G_END <= RING_BYTES, "GLA LDS");
template <bool CHECK> __device__ __forceinline__ void gla_unit(LAS char* shm, int b, int h, int vs, const bf16_t* PROJ, const bf16_t* QD, const bf16_t* KI, const float* DEC, bf16_t* MIX, unsigned* mismatch) {
    const int tid = threadIdx.x, lane = tid & 63, fr = lane & 15, fq = lane >> 4; const int w = __builtin_amdgcn_readfirstlane(tid >> 6);
    const int row = tid >> 3, ec = tid & 7, lt = w >> 1, l0 = 16 * lt, vt0 = 2 * (w & 1);
    const unsigned lds0 = (unsigned)(uintptr_t)shm;
    f32x4 st[4];
#pragma unroll
    for (int i = 0; i < 4; ++i) st[i] = (f32x4){0.f, 0.f, 0.f, 0.f};
    u32x4 rq[2], rk[2], rv; float rdec = 0.f;
    const size_t seq0 = (size_t)b * SEQ;
#define GLA_LOAD(c) do { const size_t gr = seq0 + (size_t)(c) * 64 + row; const size_t o = gr * 512 + h * 128 + ec * 16; \
        _Pragma("unroll") for (int i = 0; i < 2; ++i) { rq[i] = *(const u32x4*)(QD + o + 8 * i); rk[i] = *(const u32x4*)(KI + o + 8 * i); } \
        rv = *(const u32x4*)(PROJ + gr * NO_IN + 3584 + h * 256 + vs * 64 + ec * 8); \
        if (tid < 128) rdec = DEC[((size_t)b * 32 + (c)) * 512 + h * 128 + tid]; } while (0)
#define GLA_WRITE(pb) do { LAS char* gb_ = shm + (pb) * G_BUF; \
        _Pragma("unroll") for (int i = 0; i < 2; ++i) { *(LAS u32x4*)(gb_ + G_QD + sw256(row, ec * 2 + i)) = rq[i]; *(LAS u32x4*)(gb_ + G_KI + sw256(row, ec * 2 + i)) = rk[i]; } \
        *(LAS u32x4*)(gb_ + G_V + row * XROW + ec * 16) = rv; \
        if (tid < 128) ((LAS float*)(gb_ + G_DEC))[tid] = rdec; \
        _Pragma("unroll") for (int vt = 0; vt < 4; ++vt) { u32x2 v; v.x = cvt_pk_bf16(st[vt][0], st[vt][1]); v.y = cvt_pk_bf16(st[vt][2], st[vt][3]); \
            const int vv = 16 * vt + fr; *(LAS u32x2*)(shm + G_SP + (pb) * 16384 + sw256(vv, 2 * w + (fq >> 1)) + (fq & 1) * 8) = v; } } while (0)
    GLA_LOAD(0);
    GLA_WRITE(0);
    MX_BAR_L();
    const unsigned xtr = lds0 + (unsigned)(((lane & 15) >> 2) * XROW + (lane & 3) * 8);
    for (int c = 0; c < 32; ++c) {
        const int pb = c & 1; LAS char* gb = shm + pb * G_BUF; const unsigned gbo = (unsigned)(pb * G_BUF); LAS char* sp = shm + G_SP + pb * 16384;
        if (c + 1 < 32) GLA_LOAD(c + 1);
        bf16x8 qf[4];
#pragma unroll
        for (int ks = 0; ks < 4; ++ks) qf[ks] = *(const LAS bf16x8*)(gb + G_QD + sw256(l0 + fr, 4 * ks + fq));
        f32x4 o[2]; o[0] = (f32x4){0.f, 0.f, 0.f, 0.f}; o[1] = (f32x4){0.f, 0.f, 0.f, 0.f};
        const int lcol = l0 + fr; const int nsb = (lt >> 1) + 1;
        for (int sb = 0; sb < nsb; ++sb) {
            const int s0 = 32 * sb; const bool two = (2 * sb + 1) <= lt;
            f32x4 a0 = {0.f, 0.f, 0.f, 0.f}, a1 = {0.f, 0.f, 0.f, 0.f};
#pragma unroll
            for (int ks = 0; ks < 4; ++ks) { const bf16x8 kf = *(const LAS bf16x8*)(gb + G_KI + sw256(s0 + fr, 4 * ks + fq)); a0 = __builtin_amdgcn_mfma_f32_16x16x32_bf16(kf, qf[ks], a0, 0, 0, 0); }
            if (two) {
#pragma unroll
                for (int ks = 0; ks < 4; ++ks) { const bf16x8 kf = *(const LAS bf16x8*)(gb + G_KI + sw256(s0 + 16 + fr, 4 * ks + fq)); a1 = __builtin_amdgcn_mfma_f32_16x16x32_bf16(kf, qf[ks], a1, 0, 0, 0); }
            }
            float g0[4], g1[4];
#pragma unroll
            for (int i = 0; i < 4; ++i) { const int sa = s0 + 4 * fq + i; g0[i] = (sa <= lcol) ? a0[i] : 0.f; g1[i] = (two && sa + 16 <= lcol) ? a1[i] : 0.f; }
            u32x4 ap; ap.x = cvt_pk_bf16(g0[0], g0[1]); ap.y = cvt_pk_bf16(g0[2], g0[3]); ap.z = cvt_pk_bf16(g1[0], g1[1]); ap.w = cvt_pk_bf16(g1[2], g1[3]);
            const bf16x8 af = __builtin_bit_cast(bf16x8, ap);
            s16x4 lo[2], hi[2];
#pragma unroll
            for (int vi = 0; vi < 2; ++vi) { lo[vi] = tr_read(xtr + gbo + G_V + (unsigned)((s0 + 4 * fq) * XROW + (vt0 + vi) * 32)); hi[vi] = tr_read(xtr + gbo + G_V + (unsigned)((s0 + 16 + 4 * fq) * XROW + (vt0 + vi) * 32)); }
            MX_LGKM0();
#pragma unroll
            for (int vi = 0; vi < 2; ++vi) o[vi] = __builtin_amdgcn_mfma_f32_16x16x32_bf16(af, cat8(lo[vi], hi[vi]), o[vi], 0, 0, 0);
        }
#pragma unroll
        for (int vi = 0; vi < 2; ++vi)
#pragma unroll
            for (int ks = 0; ks < 4; ++ks) { const bf16x8 sf = *(const LAS bf16x8*)(sp + sw256(16 * (vt0 + vi) + fr, 4 * ks + fq)); o[vi] = __builtin_amdgcn_mfma_f32_16x16x32_bf16(qf[ks], sf, o[vi], 0, 0, 0); }
        {
            bf16_t* op = MIX + (seq0 + (size_t)c * 64 + l0 + 4 * fq) * 2048 + 1024 + h * 256 + vs * 64 + vt0 * 16 + fr;
#pragma unroll
            for (int vi = 0; vi < 2; ++vi)
#pragma unroll
                for (int i = 0; i < 4; ++i) { const bf16_t val = (bf16_t)(cvt_pk_bf16(o[vi][i], 0.f) & 0xffffu);
                    if (CHECK) { if (op[(size_t)i * 2048 + vi * 16] != val) atomicAdd(mismatch, 1u); } else op[(size_t)i * 2048 + vi * 16] = val; }
        }
        {
#pragma unroll
            for (int ks = 0; ks < 2; ++ks) {
                const int s0 = 32 * ks, q = (lane & 15) >> 2, p = lane & 3;
                const int r1 = s0 + 8 * fq + q, r2 = r1 + 4;
                const s16x4 alo = tr_read(lds0 + gbo + G_KI + sw256(r1, 2 * w + (p >> 1)) + (p & 1) * 8), ahi = tr_read(lds0 + gbo + G_KI + sw256(r2, 2 * w + (p >> 1)) + (p & 1) * 8);
                s16x4 lo[4], hi[4];
#pragma unroll
                for (int vt = 0; vt < 4; ++vt) { lo[vt] = tr_read(xtr + gbo + G_V + (unsigned)((s0 + 8 * fq) * XROW + vt * 32)); hi[vt] = tr_read(xtr + gbo + G_V + (unsigned)((s0 + 8 * fq + 4) * XROW + vt * 32)); }
                MX_LGKM0();
                const bf16x8 af = cat8(alo, ahi);
#pragma unroll
                for (int vt = 0; vt < 4; ++vt) st[vt] = __builtin_amdgcn_mfma_f32_16x16x32_bf16(af, cat8(lo[vt], hi[vt]), st[vt], 0, 0, 0);
            }
            const f32x4 d4 = *(const LAS f32x4*)((LAS float*)(gb + G_DEC) + 16 * w + 4 * fq);
#pragma unroll
            for (int vt = 0; vt < 4; ++vt) st[vt] = st[vt] * d4;
        }
        if (c + 1 < 32) GLA_WRITE(pb ^ 1);
        MX_BAR_L();
    }
    asm volatile("s_waitcnt vmcnt(0)" ::: "memory");
#undef GLA_LOAD
#undef GLA_WRITE
}

__device__ __forceinline__ void finalize_phase(bf16_t* MIX, const bf16_t* PROJ, const float* ssd_norm, const float* gla_norm, int gw, int ngw, int lane) {
    for (int m = gw; m < T; m += ngw) {
        bf16_t* mr = MIX + (size_t)m * 2048; const bf16_t* pr = PROJ + (size_t)m * NO_IN;
        float y[2][8]; float s = 0.f;
#pragma unroll
        for (int j = 0; j < 2; ++j) { const int col = 512 * j + 8 * lane; const u32x4 a = *(const u32x4*)(mr + col), z = __builtin_nontemporal_load((const u32x4*)(pr + col));
#pragma unroll
            for (int i = 0; i < 4; ++i) { const float y0 = __uint_as_float(a[i] << 16), y1 = __uint_as_float(a[i] & 0xffff0000u), z0 = __uint_as_float(z[i] << 16), z1 = __uint_as_float(z[i] & 0xffff0000u);
                y[j][2 * i] = y0 * siluf(z0); y[j][2 * i + 1] = y1 * siluf(z1); s += y[j][2 * i] * y[j][2 * i] + y[j][2 * i + 1] * y[j][2 * i + 1]; } }
        const float rs = rsqrtf(wave_sum(s) * (1.f / 1024.f) + EPS);
#pragma unroll
        for (int j = 0; j < 2; ++j) { const int col = 512 * j + 8 * lane; const f32x4 w0 = *(const f32x4*)(ssd_norm + col), w1 = *(const f32x4*)(ssd_norm + col + 4);
            u32x4 o; o.x = cvt_pk_bf16(y[j][0] * rs * w0[0], y[j][1] * rs * w0[1]); o.y = cvt_pk_bf16(y[j][2] * rs * w0[2], y[j][3] * rs * w0[3]);
            o.z = cvt_pk_bf16(y[j][4] * rs * w1[0], y[j][5] * rs * w1[1]); o.w = cvt_pk_bf16(y[j][6] * rs * w1[2], y[j][7] * rs * w1[3]);
            *(u32x4*)(mr + col) = o; }
#pragma unroll
        for (int j = 0; j < 2; ++j) { const int cc = 512 * j + 8 * lane; const u32x4 a = *(const u32x4*)(mr + 1024 + cc), r = __builtin_nontemporal_load((const u32x4*)(pr + 4608 + cc));
            float o[8]; float s2 = 0.f;
#pragma unroll
            for (int i = 0; i < 4; ++i) { o[2 * i] = __uint_as_float(a[i] << 16); o[2 * i + 1] = __uint_as_float(a[i] & 0xffff0000u); s2 += o[2 * i] * o[2 * i] + o[2 * i + 1] * o[2 * i + 1]; }
#pragma unroll
            for (int of = 1; of < 32; of <<= 1) s2 += __shfl_xor(s2, of);
            const float r2 = rsqrtf(s2 * (1.f / 256.f) + EPS); const int v0 = 8 * (lane & 31);
            const f32x4 w0 = *(const f32x4*)(gla_norm + v0), w1 = *(const f32x4*)(gla_norm + v0 + 4);
            float f[8];
#pragma unroll
            for (int i = 0; i < 4; ++i) { f[2 * i] = siluf(__uint_as_float(r[i] << 16)); f[2 * i + 1] = siluf(__uint_as_float(r[i] & 0xffff0000u)); }
            u32x4 ov; ov.x = cvt_pk_bf16(o[0] * r2 * w0[0] * f[0], o[1] * r2 * w0[1] * f[1]); ov.y = cvt_pk_bf16(o[2] * r2 * w0[2] * f[2], o[3] * r2 * w0[3] * f[3]);
            ov.z = cvt_pk_bf16(o[4] * r2 * w1[0] * f[4], o[5] * r2 * w1[1] * f[5]); ov.w = cvt_pk_bf16(o[6] * r2 * w1[2] * f[6], o[7] * r2 * w1[3] * f[7]);
            *(u32x4*)(mr + 1024 + cc) = ov; }
    }
}
#undef MX_LGKM0
#undef MX_BAR
#undef MX_BAR_L
}
namespace mk {
__device__ __forceinline__ void tp_norm_rows(const float* src, const float* g, bf16_t* xn, int gw, int ngw, int lane) {
    f32x4 gg[4];
#pragma unroll
    for (int j = 0; j < 4; ++j) gg[j] = ((const f32x4*)g)[lane + 64 * j];
    for (int m = gw; m < T; m += ngw) {
        const f32x4* p = (const f32x4*)(src + (size_t)m * DM); f32x4 v[4]; float s = 0.f;
#pragma unroll
        for (int j = 0; j < 4; ++j) { v[j] = __builtin_nontemporal_load(p + lane + 64 * j); s += (v[j][0] * v[j][0] + v[j][1] * v[j][1]) + (v[j][2] * v[j][2] + v[j][3] * v[j][3]); }
        const float r = rsqrtf(wave_sum(s) * (1.f / DM) + EPS);
        u32x2* o = (u32x2*)(xn + (size_t)m * DM);
#pragma unroll
        for (int j = 0; j < 4; ++j) { const f32x4 y = v[j] * r * gg[j]; u32x2 w; w.x = cvt_pk_bf16(y[0], y[1]); w.y = cvt_pk_bf16(y[2], y[3]); o[lane + 64 * j] = w; }
    }
}
template <bool FINAL> __device__ __forceinline__ void tp_combine_norm(bf16_t* hb, const bf16_t* Y, const float* g, bf16_t* xn, float* out, int gw, int ngw, int lane) {
    f32x4 gg[2][2];
#pragma unroll
    for (int j = 0; j < 2; ++j) { gg[j][0] = *(const f32x4*)(g + 512 * j + 8 * lane); gg[j][1] = *(const f32x4*)(g + 512 * j + 8 * lane + 4); }
    for (int m = gw; m < T; m += ngw) {
        float v[2][8]; float s = 0.f;
#pragma unroll
        for (int j = 0; j < 2; ++j) { const size_t o = (size_t)m * DM + 512 * j + 8 * lane;
            const u32x4 a = *(const u32x4*)(hb + o), y0 = __builtin_nontemporal_load((const u32x4*)(Y + o)), y1 = __builtin_nontemporal_load((const u32x4*)(Y + (size_t)T * DM + o));
#pragma unroll
            for (int i = 0; i < 4; ++i) { v[j][2 * i] = __uint_as_float(a[i] << 16) + __uint_as_float(y0[i] << 16) + __uint_as_float(y1[i] << 16);
                v[j][2 * i + 1] = __uint_as_float(a[i] & 0xffff0000u) + __uint_as_float(y0[i] & 0xffff0000u) + __uint_as_float(y1[i] & 0xffff0000u);
                s += v[j][2 * i] * v[j][2 * i] + v[j][2 * i + 1] * v[j][2 * i + 1]; } }
        const float r = rsqrtf(wave_sum(s) * (1.f / DM) + EPS);
#pragma unroll
        for (int j = 0; j < 2; ++j) { const size_t o = (size_t)m * DM + 512 * j + 8 * lane;
            if (FINAL) { f32x4 o0, o1;
#pragma unroll
                for (int i = 0; i < 4; ++i) { o0[i] = v[j][i] * r * gg[j][0][i]; o1[i] = v[j][4 + i] * r * gg[j][1][i]; }
                __builtin_nontemporal_store(o0, (f32x4*)(out + o)); __builtin_nontemporal_store(o1, (f32x4*)(out + o + 4));
            } else { u32x4 hw, xw;
#pragma unroll
                for (int i = 0; i < 4; ++i) { hw[i] = cvt_pk_bf16(v[j][2 * i], v[j][2 * i + 1]);
                    xw[i] = cvt_pk_bf16(v[j][2 * i] * r * gg[j][i >> 1][(2 * i) & 3], v[j][2 * i + 1] * r * gg[j][i >> 1][(2 * i + 1) & 3]); }
                *(u32x4*)(hb + o) = hw; *(u32x4*)(xn + o) = xw; }
        }
    }
}
template <bool DRY> __device__ __forceinline__ void tp_route_mfma(const bf16_t* hb, const float* g, bf16_t* xn, const bf16_t* whi, const bf16_t* wlo, const float* bg, const float* br,
                                                                  unsigned* counts, int* lists, float* gates, LAS char* shm, int vcu, int G, int lane, int wave) {
    const int grp = wave >> 2, wq = wave & 3, fr = lane & 15, fq = lane >> 4;
    LAS u32x4* stage = (LAS u32x4*)(shm + wave * 8192);
    LAS float* xacc = (LAS float*)(shm + 65536 + grp * 12288);
    LAS float* ltile = (LAS float*)(shm + 90112 + grp * 4096);
    LAS float* rsl = (LAS float*)(shm + 98304 + grp * 64);
    for (int blk = vcu; blk < T / 32; blk += G) {
        const int r0 = blk * 32 + grp * 16; const int kbase = wq * 256;
        const bf16_t* hp = hb + (size_t)(r0 + fr) * DM + kbase + 8 * fq; const float* gp = g + kbase + 8 * fq;
        f32x4 acc[3]; acc[0] = (f32x4){0.f, 0.f, 0.f, 0.f}; acc[1] = acc[0]; acc[2] = acc[0];
        float ss = 0.f;
#pragma unroll 4
        for (int ks = 0; ks < 8; ++ks) {
            const u32x4 hv = *(const u32x4*)(hp + 32 * ks);
            const f32x4 g0 = *(const f32x4*)(gp + 32 * ks), g1 = *(const f32x4*)(gp + 32 * ks + 4);
            f32x4 x0, x1;
            x0[0] = __uint_as_float(hv.x << 16); x0[1] = __uint_as_float(hv.x & 0xffff0000u); x0[2] = __uint_as_float(hv.y << 16); x0[3] = __uint_as_float(hv.y & 0xffff0000u);
            x1[0] = __uint_as_float(hv.z << 16); x1[1] = __uint_as_float(hv.z & 0xffff0000u); x1[2] = __uint_as_float(hv.w << 16); x1[3] = __uint_as_float(hv.w & 0xffff0000u);
            ss += (x0[0] * x0[0] + x0[1] * x0[1]) + (x0[2] * x0[2] + x0[3] * x0[3]) + (x1[0] * x1[0] + x1[1] * x1[1]) + (x1[2] * x1[2] + x1[3] * x1[3]);
            const f32x4 y0 = x0 * g0, y1 = x1 * g1;
            u32x4 hi; hi.x = cvt_pk_bf16(y0[0], y0[1]); hi.y = cvt_pk_bf16(y0[2], y0[3]); hi.z = cvt_pk_bf16(y1[0], y1[1]); hi.w = cvt_pk_bf16(y1[2], y1[3]);
            stage[ks * 64 + lane] = hi;
            u32x4 lo;
            lo.x = cvt_pk_bf16(y0[0] - __uint_as_float(hi.x << 16), y0[1] - __uint_as_float(hi.x & 0xffff0000u)); lo.y = cvt_pk_bf16(y0[2] - __uint_as_float(hi.y << 16), y0[3] - __uint_as_float(hi.y & 0xffff0000u));
            lo.z = cvt_pk_bf16(y1[0] - __uint_as_float(hi.z << 16), y1[1] - __uint_as_float(hi.z & 0xffff0000u)); lo.w = cvt_pk_bf16(y1[2] - __uint_as_float(hi.w << 16), y1[3] - __uint_as_float(hi.w & 0xffff0000u));
            const bf16x8 ah = __builtin_bit_cast(bf16x8, hi), al = __builtin_bit_cast(bf16x8, lo);
#pragma unroll
            for (int nt = 0; nt < 3; ++nt) {
                const size_t wo = (size_t)(nt * 16 + fr) * DM + kbase + 32 * ks + 8 * fq;
                const bf16x8 bh = *(const bf16x8*)(whi + wo), bl = *(const bf16x8*)(wlo + wo);
                acc[nt] = __builtin_amdgcn_mfma_f32_16x16x32_bf16(ah, bh, acc[nt], 0, 0, 0);
                acc[nt] = __builtin_amdgcn_mfma_f32_16x16x32_bf16(ah, bl, acc[nt], 0, 0, 0);
                acc[nt] = __builtin_amdgcn_mfma_f32_16x16x32_bf16(al, bh, acc[nt], 0, 0, 0);
            }
        }
        ss += __shfl_xor(ss, 16); ss += __shfl_xor(ss, 32);
        if (wq != 0) { LAS float* xa = xacc + (wq - 1) * 13 * 64;
#pragma unroll
            for (int nt = 0; nt < 3; ++nt)
#pragma unroll
                for (int i = 0; i < 4; ++i) xa[(nt * 4 + i) * 64 + lane] = acc[nt][i];
            xa[12 * 64 + lane] = ss;
        }
        asm volatile("s_waitcnt lgkmcnt(0)\n\ts_barrier" ::: "memory");
        if (wq == 0) {
#pragma unroll
            for (int nt = 0; nt < 3; ++nt)
#pragma unroll
                for (int i = 0; i < 4; ++i) { const int o = (nt * 4 + i) * 64 + lane; const float v = acc[nt][i] + xacc[o] + xacc[13 * 64 + o] + xacc[26 * 64 + o]; ltile[(4 * fq + i) * 48 + nt * 16 + fr] = v; }
            ss += xacc[12 * 64 + lane] + xacc[25 * 64 + lane] + xacc[38 * 64 + lane];
            const float rs = rsqrtf(ss * (1.f / DM) + EPS);
            if (fq == 0) rsl[fr] = rs;
        }
        asm volatile("s_waitcnt lgkmcnt(0)\n\ts_barrier" ::: "memory");
        { const float rs = rsl[fr]; bf16_t* xp = xn + (size_t)(r0 + fr) * DM + kbase + 8 * fq;
#pragma unroll
          for (int ks = 0; ks < 8; ++ks) { const u32x4 v = stage[ks * 64 + lane]; u32x4 o;
              o.x = cvt_pk_bf16(__uint_as_float(v.x << 16) * rs, __uint_as_float(v.x & 0xffff0000u) * rs); o.y = cvt_pk_bf16(__uint_as_float(v.y << 16) * rs, __uint_as_float(v.y & 0xffff0000u) * rs);
              o.z = cvt_pk_bf16(__uint_as_float(v.z << 16) * rs, __uint_as_float(v.z & 0xffff0000u) * rs); o.w = cvt_pk_bf16(__uint_as_float(v.w << 16) * rs, __uint_as_float(v.w & 0xffff0000u) * rs);
              *(u32x4*)(xp + 32 * ks) = o; } }
        if (wq == 0 && lane < 16) {
            const LAS float* lt = ltile + lane * 48; const float rsr = rsl[lane];
            float gl[4];
#pragma unroll
            for (int e = 0; e < 4; ++e) gl[e] = rsr * lt[e] + bg[e];
            int gi = 0; float gm = gl[0];
#pragma unroll
            for (int e = 1; e < 4; ++e) if (gl[e] > gm) { gm = gl[e]; gi = e; }
            float gs = 0.f;
#pragma unroll
            for (int e = 0; e < 4; ++e) gs += expf(gl[e] - gm);
            const float gwt = 1.f / gs;
            float b0 = -INFINITY, b1 = -INFINITY; int i0 = 0, i1 = 0;
#pragma unroll
            for (int i = 0; i < 8; ++i) { const float v = rsr * lt[4 + gi * 8 + i] + br[gi * 8 + i];
                if (v > b0) { b1 = b0; i1 = i0; b0 = v; i0 = i; } else if (v > b1) { b1 = v; i1 = i; } }
            const int t = r0 + lane;
            const float w0 = 1.f / (1.f + expf(b1 - b0)), w1 = 1.f - w0;
            const int e0 = gi * 8 + i0, e1 = gi * 8 + i1;
            gates[2 * t] = gwt * w0; gates[2 * t + 1] = gwt * w1;
            if (!DRY) {
                const unsigned p0 = __hip_atomic_fetch_add(counts + e0 * 64, 1u, __ATOMIC_RELAXED, __HIP_MEMORY_SCOPE_AGENT); lists[e0 * CAP + p0] = 2 * t;
                const unsigned p1 = __hip_atomic_fetch_add(counts + e1 * 64, 1u, __ATOMIC_RELAXED, __HIP_MEMORY_SCOPE_AGENT); lists[e1 * CAP + p1] = 2 * t + 1; }
        }
        asm volatile("s_waitcnt lgkmcnt(0)\n\ts_barrier" ::: "memory");
    }
}

struct Args {
    const float* in[26]; float* out; unsigned char* ws; int ph_lo, ph_hi, use_bar, li;
};
enum Phase { P_CONV0 = 0, P_G1, P_ATT, P_G2, P_TP1, P_G3, P_G4, P_TP2, P_G5, P_CONV, P_MIXER, P_FIN, P_G6, P_TP3, P_G7, P_G8, P_TP4, P_COUNT };

__device__ __forceinline__ void moe_setup(volatile LAS int* misc, unsigned* counts) {
    if (threadIdx.x == 0) {
        int run = 0;
        for (int e = 0; e < 32; ++e) { const int c = (int)__hip_atomic_load(counts + e * 64, __ATOMIC_RELAXED, __HIP_MEMORY_SCOPE_AGENT); misc[64 + e] = c; misc[16 + e] = run; run += (c + 255) >> 8; }
        misc[16 + 32] = run;
    }
    __syncthreads();
}

typedef const float* kin_ptr_t;
__device__ __forceinline__ const float* kin(int i) { return ((const volatile kin_ptr_t __attribute__((address_space(4)))*)__builtin_amdgcn_kernarg_segment_ptr())[i]; }
#ifndef CV_TAIL_ITEMS
#define CV_TAIL_ITEMS 8192
#endif
constexpr int CV_I_EIN = 16 * 80, CV_I_EOUT = 16 * 32, CV_I_OIN = 16 * 184, CV_I_OOUT = 32 * 32, CV_I_GU = 16 * 32, CV_I_D = 8 * 32;
constexpr int CV_NITEMS = CV_I_EIN + CV_I_EOUT + CV_I_OIN + CV_I_OOUT + 32 * CV_I_GU + 32 * CV_I_D;
__device__ __forceinline__ CvItem cv_decode0(unsigned char* ws, int it, int lane) {
    int r = it;
    if (r < CV_I_EIN) return cv_make(SrcEvenIn{kin(4)}, 2312, 1024, 80, (bf16_t*)(ws + WS_WEIN), r, lane); r -= CV_I_EIN;
    if (r < CV_I_EOUT) return cv_make(SrcPlain{kin(7), 1024}, 1024, 1024, 32, (bf16_t*)(ws + WS_WEOUT), r, lane); r -= CV_I_EOUT;
    if (r < CV_I_OIN) return cv_make(SrcOddIn{kin(8)}, 5664, 1024, 184, (bf16_t*)(ws + WS_WOIN), r, lane); r -= CV_I_OIN;
    if (r < CV_I_OOUT) return cv_make(SrcPlain{kin(18), 1024}, 1024, 2048, 32, (bf16_t*)(ws + WS_WOOUT), r, lane); r -= CV_I_OOUT;
    if (r < 32 * CV_I_GU) { const int e = r / CV_I_GU; return cv_make_gu(kin(23) + (size_t)e * 1024 * 512, kin(24) + (size_t)e * 1024 * 512, (bf16_t*)(ws + WS_WGU) + (size_t)e * 1024 * 1024, r % CV_I_GU, lane); } r -= 32 * CV_I_GU;
    { const int e = r / CV_I_D; return cv_make(SrcPlain{kin(25) + (size_t)e * 512 * 1024, 1024}, 1024, 512, 32, (bf16_t*)(ws + WS_WD) + (size_t)e * 1024 * 512, r % CV_I_D, lane); }
}
__device__ __forceinline__ void cv_run0(unsigned char* ws, int lo, int hi, int w, int nw, LAS float* scr, int lane) {
    for (int it = lo + 2 * w; it < hi; it += 2 * nw) {
        float va[32], vb[32]; const CvItem da = cv_decode0(ws, it, lane); cv_load(da, va);
        const bool n1 = it + 1 < hi; CvItem db = da; if (n1) { db = cv_decode0(ws, it + 1, lane); cv_load(db, vb); }
        cv_finish(da, va, scr, lane);
        if (n1) cv_finish(db, vb, scr, lane);
    }
}

constexpr int CV_NIT1 = 32 * (CV_I_GU + CV_I_D);
#ifndef CV1_TAIL_G5
#define CV1_TAIL_G5 4096
#endif
#ifndef CV1_TAIL_MIX
#define CV1_TAIL_MIX 8192
#endif
#ifndef CV1_TAIL_G4
#define CV1_TAIL_G4 8192
#endif
#ifndef CV0_TAIL_G3
#define CV0_TAIL_G3 0
#endif
__device__ __forceinline__ CvItem cv_decode1(unsigned char* ws, int it, int lane) {
    const size_t L1 = (size_t)32 * 1024 * 512; int r = it;
    if (r < 32 * CV_I_GU) { const int e = r / CV_I_GU; return cv_make_gu(kin(23) + L1 + (size_t)e * 1024 * 512, kin(24) + L1 + (size_t)e * 1024 * 512, (bf16_t*)(ws + WS_WGU) + (size_t)e * 1024 * 1024, r % CV_I_GU, lane); } r -= 32 * CV_I_GU;
    { const int e = r / CV_I_D; return cv_make(SrcPlain{kin(25) + L1 + (size_t)e * 512 * 1024, 1024}, 1024, 512, 32, (bf16_t*)(ws + WS_WD) + (size_t)e * 1024 * 512, r % CV_I_D, lane); }
}
__device__ __forceinline__ void cv_run1(unsigned char* ws, int lo, int hi, int w, int nw, LAS float* scr, int lane) {
    for (int it = lo + 2 * w; it < hi; it += 2 * nw) {
        float va[32], vb[32]; const CvItem da = cv_decode1(ws, it, lane); cv_load(da, va);
        const bool n1 = it + 1 < hi; CvItem db = da; if (n1) { db = cv_decode1(ws, it + 1, lane); cv_load(db, vb); }
        cv_finish(da, va, scr, lane);
        if (n1) cv_finish(db, vb, scr, lane);
    }
}

__global__ void __launch_bounds__(NTHR, 2) mk_fwd(Args args) {
    extern __shared__ __attribute__((aligned(16))) unsigned char lds_raw[];
    LAS unsigned char* lds = (LAS unsigned char*)lds_raw;
    volatile LAS int* misc = (volatile LAS int*)(lds + MISC_OFF);
    const int tid = threadIdx.x, lane = tid & 63, wave = __builtin_amdgcn_readfirstlane(tid >> 6);
    const int G = gridDim.x, bx = blockIdx.x;
    const int vcu = (G % 8 == 0) ? (bx % 8) * (G / 8) + bx / 8 : bx;
    const int gw = vcu * NWAVES + wave, ngw = G * NWAVES;
    for (int u = tid; u < 256; u += NTHR) misc[u] = 0;
    __syncthreads();
#define ws ((unsigned char*)kin(27))
#define XN ((bf16_t*)(ws + WS_XN))
#define PROJ ((bf16_t*)(ws + WS_PROJ))
#define MIX ((bf16_t*)(ws + WS_MIX))
#define FB ((float*)(ws + WS_FB))
#define LISTS ((int*)(ws + WS_LISTS))
#define GATES ((float*)(ws + WS_GATES))
#define HB ((bf16_t*)(ws + WS_H))
#define YB ((bf16_t*)(ws + WS_Y))
#define outp ((float*)kin(26))
#define HBS ((bf16_t*)(ws + WS_HB))
#define ctl ((unsigned*)(ws + WS_CTL))
    XcdBarrier bar; bar.bar = ctl + CW_BAR + args.li * XCD_BAR_WORDS; bar.x = 0; bar.st = nullptr;
    if (args.use_bar) bar = xcd_barrier_post(ctl + CW_BAR + args.li * XCD_BAR_WORDS, (volatile LAS unsigned*)misc);
#ifdef BAR_TWICE
#define GRID_BAR() do { if (args.use_bar) { xcd_barrier(bar); xcd_barrier(bar); } } while (0)
#else
#define GRID_BAR() do { if (args.use_bar) xcd_barrier(bar); } while (0)
#endif
    const int lo = args.ph_lo, hi = args.ph_hi;
#ifndef MK_PHASE_MASK
#define MK_PHASE_MASK 0xffffffffu
#endif
#define IN(k) (((MK_PHASE_MASK >> (k)) & 1u) && lo <= (k) && (k) < hi)
#ifndef MK_REP_MASK
#define MK_REP_MASK 0u
#endif
#define NREP(k) ((((MK_REP_MASK) >> (k)) & 1u) ? 2 : 1)
#define REP(k) for (int _r = 0; _r < ((((MK_REP_MASK) >> (k)) & 1u) ? 2 : 1); ++_r)
#define SEAM(k) do { if (IN(k) && IN((k) + 1)) GRID_BAR(); } while (0)
#define XIN kin(0)

    if (IN(P_CONV0)) REP(P_CONV0) {
        LAS float* scr = (LAS float*)(lds + wave * 16384);
        constexpr int OI_LO = CV_I_EIN + CV_I_EOUT, OI_HI = OI_LO + CV_I_OIN + CV_I_OOUT;
        if (CV0_TAIL_G3 && G == 256) { cv_run0(ws, 0, OI_LO, gw, ngw, scr, lane); cv_run0(ws, OI_HI, CV_NITEMS - CV_TAIL_ITEMS, gw, ngw, scr, lane); }
        else cv_run0(ws, 0, CV_NITEMS - CV_TAIL_ITEMS, gw, ngw, scr, lane);
        { bf16_t* wrt = (bf16_t*)(ws + WS_WRT);
          for (int i = gw * 64 + lane; i < 2 * 48 * 1024; i += ngw * 64) { const int l = i / (48 * 1024), rem = i % (48 * 1024), e = rem >> 10, k = rem & 1023;
              const float v = (e < 4) ? kin(19)[(size_t)l * 4096 + k * 4 + e] : (e < 36 ? kin(21)[(size_t)l * 32768 + k * 32 + (e - 4)] : 0.f);
              const unsigned hi = cvt_pk_bf16(v, 0.f) & 0xffffu; const unsigned lo = cvt_pk_bf16(v - __uint_as_float(hi << 16), 0.f) & 0xffffu;
              wrt[(size_t)(2 * l) * 48 * 1024 + rem] = (bf16_t)hi; wrt[(size_t)(2 * l + 1) * 48 * 1024 + rem] = (bf16_t)lo; } }
        tp_norm_rows(XIN, kin(1), XN, gw, ngw, lane);
    }
    SEAM(P_CONV0);
    if (IN(P_G1)) {
        pg8::Gemm g{XN, (const bf16_t*)(ws + WS_WEIN), 1024, 0}; pg8::DenseOrder S; S.init(T, NE_IN, G, bx, NREP(P_G1));
        pg8::EpiProjEven E{PROJ, FB};
        pg8::gemm_phase<pg8::EpiProjEven, pg8::DenseOrder, true>(lds, g, S, E);
        if (CV_TAIL_ITEMS > 0 && G == 256 && bx >= 128)
            cv_run0(ws, CV_NITEMS - CV_TAIL_ITEMS, CV_NITEMS, (bx - 128) * NWAVES + wave, 128 * NWAVES, (LAS float*)(lds + wave * 16384), lane);
        else if (CV_TAIL_ITEMS > 0 && G != 256) cv_run0(ws, CV_NITEMS - CV_TAIL_ITEMS, CV_NITEMS, gw, ngw, (LAS float*)(lds + wave * 16384), lane);
    }
    SEAM(P_G1);
    if (IN(P_ATT)) REP(P_ATT) {
        if (G == 256) {
            const int bh = vcu >> 2, s = vcu & 3, b = bh >> 3, h = bh & 7;
            const float fbias = kin(6)[h];
            att::fox_unit_p<false>((char*)lds_raw, (LAS char*)lds, b, h, 7 - s, PROJ, FB, fbias, MIX, ctl + 32, true);
            att::fox_unit_p<false>((char*)lds_raw, (LAS char*)lds, b, h, s, PROJ, FB, fbias, MIX, ctl + 32, false);
            for (int i = 0; i < 2; ++i) { const int u = vcu * 2 + i; const int sb = u >> 6, kvh = (u >> 5) & 1, blk = u & 31; att::swa_unit((LAS char*)lds, sb, kvh, blk, PROJ, kin(5), MIX); }
        }
    }
    SEAM(P_ATT);
    if (IN(P_G2)) {
        pg8::Gemm g{MIX, (const bf16_t*)(ws + WS_WEOUT), 1024, 0}; pg8::DenseOrder S; S.init(T, DM, G, bx, NREP(P_G2));
        pg8::EpiResidB<true> E{XIN, HBS};
        pg8::gemm_phase<pg8::EpiResidB<true>, pg8::DenseOrder, true>(lds, g, S, E);
    }
    SEAM(P_G2);
    if (IN(P_TP1)) {
#ifdef TP1_REP
        tp_route_mfma<true>(HBS, kin(2), XN, (const bf16_t*)(ws + WS_WRT), (const bf16_t*)(ws + WS_WRT) + 48 * 1024, kin(20), kin(22), ctl + CW_CNT, LISTS, GATES, (LAS char*)lds, vcu, G, lane, wave);
#endif
        tp_route_mfma<false>(HBS, kin(2), XN, (const bf16_t*)(ws + WS_WRT), (const bf16_t*)(ws + WS_WRT) + 48 * 1024, kin(20), kin(22), ctl + CW_CNT, LISTS, GATES, (LAS char*)lds, vcu, G, lane, wave);
    }
    SEAM(P_TP1);
    if (IN(P_G3)) {
        moe_setup(misc, ctl + CW_CNT);
        if (CV0_TAIL_G3 && G == 256) {
            const int U = misc[16 + 32] * 4, nidle = 768 - U;
            if (nidle > 0 && bx >= 256 - nidle) { constexpr int OI_LO = CV_I_EIN + CV_I_EOUT, OI_HI = OI_LO + CV_I_OIN + CV_I_OOUT;
                cv_run0(ws, OI_LO, OI_HI, (bx - (256 - nidle)) * NWAVES + wave, nidle * NWAVES, (LAS float*)(lds + wave * 16384), lane); }
            else if (nidle <= 0) { constexpr int OI_LO = CV_I_EIN + CV_I_EOUT, OI_HI = OI_LO + CV_I_OIN + CV_I_OOUT; cv_run0(ws, OI_LO, OI_HI, gw, ngw, (LAS float*)(lds + wave * 16384), lane); }
        }
        __syncthreads();
        pg8::Gemm g{XN, (const bf16_t*)(ws + WS_WGU), 1024, (size_t)1024 * 1024 * 2};
        pg8::MoeOrder S{(const volatile LAS int*)(misc + 16), (const volatile LAS int*)(misc + 64), LISTS, G, bx, true, NREP(P_G3)};
        pg8::EpiGateUp E{HB};
        pg8::gemm_phase<pg8::EpiGateUp, pg8::MoeOrder, true>(lds, g, S, E);
    }
    SEAM(P_G3);
    if (IN(P_G4)) {
        moe_setup(misc, ctl + CW_CNT);
        pg8::Gemm g{HB, (const bf16_t*)(ws + WS_WD), 512, (size_t)1024 * 512 * 2};
        pg8::MoeOrder S{(const volatile LAS int*)(misc + 16), (const volatile LAS int*)(misc + 64), LISTS, G, bx, false, NREP(P_G4)};
        pg8::EpiDown E{YB, LISTS, GATES, (const volatile LAS int*)(misc + 64)};
        pg8::gemm_phase<pg8::EpiDown, pg8::MoeOrder, true>(lds, g, S, E);
        if (CV1_TAIL_G4 > 0 && G == 256) {
            const int U = misc[16 + 32] * 4, nidle = 768 - U, lo1 = CV_NIT1 - CV1_TAIL_G5 - CV1_TAIL_MIX - CV1_TAIL_G4, hi1 = lo1 + CV1_TAIL_G4;
            if (nidle >= 32) { if (bx >= 256 - nidle) cv_run1(ws, lo1, hi1, (bx - (256 - nidle)) * NWAVES + wave, nidle * NWAVES, (LAS float*)(lds + wave * 16384), lane); }
            else cv_run1(ws, lo1, hi1, gw, ngw, (LAS float*)(lds + wave * 16384), lane);
        }
    }
    SEAM(P_G4);
    if (IN(P_TP2)) {
        tp_combine_norm<false>(HBS, YB, kin(1) + DM, XN, nullptr, gw, ngw, lane);
        LAS float* scr = (LAS float*)(lds + wave * 16384);
        constexpr int I_GU = 16 * 32, I_D = 8 * 32; const size_t L1 = (size_t)32 * 1024 * 512;
        auto decode = [&](int it) -> CvItem {
            int r = it;
            if (r < 32 * I_GU) { const int e = r / I_GU; return cv_make_gu(kin(23) + L1 + (size_t)e * 1024 * 512, kin(24) + L1 + (size_t)e * 1024 * 512, (bf16_t*)(ws + WS_WGU) + (size_t)e * 1024 * 1024, r % I_GU, lane); } r -= 32 * I_GU;
            { const int e = r / I_D; return cv_make(SrcPlain{kin(25) + L1 + (size_t)e * 512 * 1024, 1024}, 1024, 512, 32, (bf16_t*)(ws + WS_WD) + (size_t)e * 1024 * 512, r % I_D, lane); }
        };
        const int NIT1 = CV_NIT1 - ((G == 256) ? (CV1_TAIL_G5 + CV1_TAIL_MIX + CV1_TAIL_G4) : 0);
        for (int it = 2 * gw; it < NIT1; it += 2 * ngw) {
            float va[32], vb[32]; const CvItem da = decode(it); cv_load(da, va);
            const bool n1 = it + 1 < NIT1; CvItem db = da; if (n1) { db = decode(it + 1); cv_load(db, vb); }
            cv_finish(da, va, scr, lane);
            if (n1) cv_finish(db, vb, scr, lane);
        }
    }
    SEAM(P_TP2);
    if (IN(P_G5)) {
        pg8::Gemm g{XN, (const bf16_t*)(ws + WS_WOIN), 1024, 0}; pg8::DenseOrder S; S.init(T, NO_IN, G, bx, NREP(P_G5));
        pg8::EpiProjOdd E{PROJ, (float*)(ws + WS_DTG)};
        pg8::gemm_phase<pg8::EpiProjOdd, pg8::DenseOrder, true>(lds, g, S, E);
        if (CV1_TAIL_G5 > 0 && G == 256 && bx >= 192)
            cv_run1(ws, CV_NIT1 - CV1_TAIL_G5 - CV1_TAIL_MIX, CV_NIT1 - CV1_TAIL_MIX, (bx - 192) * NWAVES + wave, 64 * NWAVES, (LAS float*)(lds + wave * 16384), lane);
    }
    SEAM(P_G5);
    if (IN(P_CONV)) {
        mx::prep_conv(PROJ, (bf16_t*)(ws + WS_CONV), kin(9), kin(10), vcu, G, tid);
#ifdef PREP_REP_CONV
        mx::prep_conv(PROJ, (bf16_t*)(ws + WS_CONV), kin(9), kin(10), vcu, G, tid);
#endif
        mx::prep_ssd((const float*)(ws + WS_DTG), (float*)(ws + mx::WS_DTV), (float*)(ws + mx::WS_ACS), kin(11), kin(12), vcu, G, lane, wave);
#ifdef PREP_REP_SSD
        mx::prep_ssd((const float*)(ws + WS_DTG), (float*)(ws + mx::WS_DTV), (float*)(ws + mx::WS_ACS), kin(11), kin(12), vcu, G, lane, wave);
#endif
        mx::prep_gla(PROJ, (const float*)(ws + WS_DTG), (bf16_t*)(ws + mx::WS_QD), (bf16_t*)(ws + mx::WS_KI), (bf16_t*)(ws + mx::WS_KE), (float*)(ws + mx::WS_DEC), kin(15), kin(16), vcu, G, tid, lane, wave, (LAS char*)lds);
#ifdef PREP_REP_GLA
        mx::prep_gla(PROJ, (const float*)(ws + WS_DTG), (bf16_t*)(ws + mx::WS_QD), (bf16_t*)(ws + mx::WS_KI), (bf16_t*)(ws + mx::WS_KE), (float*)(ws + mx::WS_DEC), kin(15), kin(16), vcu, G, tid, lane, wave, (LAS char*)lds);
#endif
    }
    SEAM(P_CONV);
    if (IN(P_MIXER)) {
        if (G == 256) {
            if (vcu < 128) {
                mx::ssd_unit64((LAS char*)lds, vcu >> 4, vcu & 15, (const bf16_t*)(ws + WS_CONV), (const float*)(ws + mx::WS_ACS), (const float*)(ws + mx::WS_DTV), kin(13)[vcu & 15], MIX);
#ifdef MIX_SSD_REP
                __syncthreads(); mx::ssd_unit((LAS char*)lds, vcu >> 4, vcu & 15, (const bf16_t*)(ws + WS_CONV), (const float*)(ws + mx::WS_ACS), (const float*)(ws + mx::WS_DTV), kin(13)[vcu & 15], MIX);
#endif
            }
            else { const int u = vcu - 128; mx::gla_unit<false>((LAS char*)lds, u >> 4, (u >> 2) & 3, u & 3, PROJ, (const bf16_t*)(ws + mx::WS_QD), (const bf16_t*)(ws + mx::WS_KI),
                                                          (const float*)(ws + mx::WS_DEC), MIX, ctl + 32);
                if (CV1_TAIL_MIX > 0) { __syncthreads(); cv_run1(ws, CV_NIT1 - CV1_TAIL_MIX, CV_NIT1, (vcu - 128) * NWAVES + wave, 128 * NWAVES, (LAS float*)(lds + wave * 16384), lane); }
#ifdef MIX_GLA_REP
                __syncthreads(); mx::gla_unit<false>((LAS char*)lds, u >> 4, (u >> 2) & 3, u & 3, PROJ, (const bf16_t*)(ws + mx::WS_QD), (const bf16_t*)(ws + mx::WS_KI), (const float*)(ws + mx::WS_DEC), MIX, ctl + 32);
#endif
            }
        }
    }
    SEAM(P_MIXER);
    if (IN(P_FIN)) {
        mx::finalize_phase(MIX, PROJ, kin(14), kin(17), gw, ngw, lane);
    }
    SEAM(P_FIN);
    if (IN(P_G6)) {
        pg8::Gemm g{MIX, (const bf16_t*)(ws + WS_WOOUT), 2048, 0}; pg8::DenseOrder S; S.init(T, DM, G, bx, NREP(P_G6));
        pg8::EpiResidB<false> E{HBS, HBS};
        pg8::gemm_phase<pg8::EpiResidB<false>, pg8::DenseOrder, true>(lds, g, S, E);
    }
    SEAM(P_G6);
    if (IN(P_TP3)) {
        tp_route_mfma<false>(HBS, kin(2) + DM, XN, (const bf16_t*)(ws + WS_WRT) + 2 * 48 * 1024, (const bf16_t*)(ws + WS_WRT) + 3 * 48 * 1024, kin(20) + 4, kin(22) + 32,
                             ctl + CW_CNT + 32 * 64, LISTS, GATES, (LAS char*)lds, vcu, G, lane, wave);
    }
    SEAM(P_TP3);
    if (IN(P_G7)) {
        moe_setup(misc, ctl + CW_CNT + 32 * 64);
        pg8::Gemm g{XN, (const bf16_t*)(ws + WS_WGU), 1024, (size_t)1024 * 1024 * 2};
        pg8::MoeOrder S{(const volatile LAS int*)(misc + 16), (const volatile LAS int*)(misc + 64), LISTS, G, bx, true, NREP(P_G7)};
        pg8::EpiGateUp E{HB};
        pg8::gemm_phase<pg8::EpiGateUp, pg8::MoeOrder, true>(lds, g, S, E);
    }
    SEAM(P_G7);
    if (IN(P_G8)) {
        moe_setup(misc, ctl + CW_CNT + 32 * 64);
        pg8::Gemm g{HB, (const bf16_t*)(ws + WS_WD), 512, (size_t)1024 * 512 * 2};
        pg8::MoeOrder S{(const volatile LAS int*)(misc + 16), (const volatile LAS int*)(misc + 64), LISTS, G, bx, false, NREP(P_G8)};
        pg8::EpiDown E{YB, LISTS, GATES, (const volatile LAS int*)(misc + 64)};
        pg8::gemm_phase<pg8::EpiDown, pg8::MoeOrder, true>(lds, g, S, E);
    }
    SEAM(P_G8);
    if (IN(P_TP4)) {
        tp_combine_norm<true>(HBS, YB, kin(3), nullptr, outp, gw, ngw, lane);
#if defined(GLA_CHECK) || defined(ATT_CHECK)
        if (__hip_atomic_load(ctl + 32, __ATOMIC_RELAXED, __HIP_MEMORY_SCOPE_AGENT) != 0u) { for (int m = gw; m < T; m += ngw) outp[(size_t)m * DM + lane] = 1000.f; }
#endif
    }
#undef IN
#undef SEAM
#undef GRID_BAR
#undef ws
#undef XN
#undef PROJ
#undef MIX
#undef FB
#undef LISTS
#undef GATES
#undef HB
#undef YB
#undef outp
#undef HBS
#undef ctl
#undef XIN
}
}

extern "C" void kernel_launch(void* const* d_in, const int* in_sizes, int n_in, void* d_out, int out_size, void* d_ws, size_t ws_size, hipStream_t stream) {
    static int grid = 0;
    if (grid == 0) {
        int dev = 0, cus = 0, per_cu = 0;
        (void)hipGetDevice(&dev); (void)hipDeviceGetAttribute(&cus, hipDeviceAttributeMultiprocessorCount, dev);
        if (n_in != 26 || out_size != mk::T * mk::DM || ws_size < mk::WS_TOTAL) { fprintf(stderr, "kernel_launch: unexpected shapes (n_in %d out %d ws %zu)\n", n_in, out_size, ws_size); grid = -1; return; }
        if (hipFuncSetAttribute((const void*)mk::mk_fwd, hipFuncAttributeMaxDynamicSharedMemorySize, mk::LDS_BYTES) != hipSuccess) { fprintf(stderr, "hipFuncSetAttribute failed\n"); grid = -1; return; }
        if (hipOccupancyMaxActiveBlocksPerMultiprocessor(&per_cu, (const void*)mk::mk_fwd, mk::NTHR, mk::LDS_BYTES) != hipSuccess || per_cu < 1) { fprintf(stderr, "occupancy query reports %d blocks per CU\n", per_cu); }
        (void)hipGetLastError();
        grid = cus;
        if (grid != 256) fprintf(stderr, "kernel_launch: %d CUs; the attention / mixer phases need 256\n", grid);
    }
    if (grid < 0) return;
    (void)hipMemsetAsync((char*)d_ws + mk::WS_CTL, 0, mk::CTL_ZERO_BYTES, stream);
    mk::Args a{};
    for (int i = 0; i < 26; ++i) a.in[i] = (const float*)d_in[i];
    a.out = (float*)d_out; a.ws = (unsigned char*)d_ws;
    a.ph_lo = 0; a.ph_hi = mk::P_COUNT; a.use_bar = 1; a.li = 0;
    hipLaunchKernelGGL(mk::mk_fwd, dim3(grid), dim3(mk::NTHR), mk::LDS_BYTES, stream, a);
}
```

```cpp
#include <hip/hip_runtime.h>
#include <hip/hip_bf16.h>
#include <cstdio>
#include <cstdint>
#include <cmath>
namespace mk {
#define LAS __attribute__((address_space(3)))
#define GAS __attribute__((address_space(1)))
typedef unsigned short bf16_t;
typedef short bf16x8 __attribute__((ext_vector_type(8)));
typedef short s16x4 __attribute__((ext_vector_type(4)));
typedef float f32x4 __attribute__((ext_vector_type(4)));
typedef float f32x2 __attribute__((ext_vector_type(2)));
typedef float f32x16 __attribute__((ext_vector_type(16)));
typedef unsigned u32x4 __attribute__((ext_vector_type(4)));
typedef unsigned u32x2 __attribute__((ext_vector_type(2)));

constexpr int T = 16384, DM = 1024, SEQ = 2048, NBATCH = 8;
constexpr int NE_IN = 2560, NO_IN = 5888;
constexpr int CAP = 16384;
constexpr float EPS = 1e-6f;
constexpr float LOG2E = 1.4426950408889634f;
constexpr float C2 = 0.125f * LOG2E;
constexpr int NWAVES = 8, NTHR = 512;
constexpr size_t MiB = 1u << 20;
constexpr size_t WS_CTL = 0, CTL_ZERO_BYTES = 1 * MiB;
constexpr size_t WS_WEIN = 2 * MiB, WS_WEOUT = 7 * MiB, WS_WOIN = 9 * MiB, WS_WOOUT = 21 * MiB, WS_WRT = 25 * MiB;
constexpr size_t WS_WGU = 26 * MiB, WS_WD = 90 * MiB;
constexpr size_t WS_XN = 122 * MiB;
constexpr size_t WS_PROJ = 154 * MiB;
constexpr size_t WS_H = WS_PROJ, WS_Y = WS_PROJ + 40 * MiB;
constexpr size_t WS_MIX = 338 * MiB;
constexpr size_t WS_CONV = 402 * MiB;
constexpr size_t WS_FB = 450 * MiB;
constexpr size_t WS_DTG = 451 * MiB;
constexpr size_t WS_LISTS = 453 * MiB;
constexpr size_t WS_GATES = 455 * MiB;
constexpr size_t WS_RSTD = 455 * MiB + 512 * 1024;
constexpr size_t WS_END = 456 * MiB, WS_HB = 476 * MiB, WS_TOTAL = 508 * MiB;
constexpr int CW_BAR = 4096;
constexpr int CW_CNT = 16384;
constexpr int RING_BYTES = 146432;
constexpr int MISC_OFF = RING_BYTES;
constexpr int LDS_BYTES = 147456;

typedef __bf16 bf16x2_t __attribute__((ext_vector_type(2)));
__device__ __forceinline__ unsigned cvt_pk_bf16(float lo, float hi) { f32x2 v = {lo, hi}; bf16x2_t b = __builtin_convertvector(v, bf16x2_t); return __builtin_bit_cast(unsigned, b); }
__device__ __forceinline__ float bf2f(unsigned short b) { return __uint_as_float((unsigned)b << 16); }
__device__ __forceinline__ float wave_sum(float v) {
#pragma unroll
    for (int o = 1; o < 64; o <<= 1) v += __shfl_xor(v, o);
    return v;
}
__device__ __forceinline__ float siluf(float x) { return x * __builtin_amdgcn_rcpf(1.f + __expf(-x)); }
__device__ __forceinline__ float log_sigmoidf(float x) { return fminf(x, 0.f) - log1pf(expf(-fabsf(x))); }
__device__ __forceinline__ float log_sigmoid_fast(float x) { return fminf(x, 0.f) - __logf(1.f + __expf(-fabsf(x))); }
__device__ __forceinline__ float softplusf(float x) { return fmaxf(x, 0.f) + __logf(1.f + __expf(-fabsf(x))); }

#define XB_TMO      128
#define XB_XCNT(j)  (256  + 64 * (j))
#define XB_XSUB(j)  (1280 + 64 * (j))
#define XB_XGEN(j)  (2304 + 64 * (j))
#define XB_TOP      3328
#define XB_TOPGEN   3392
#define XCD_BAR_WORDS 3456
#define XB_SPIN_CAP (1u << 18)
__device__ __forceinline__ unsigned xb_ld(unsigned* p)              { return __hip_atomic_load(p, __ATOMIC_RELAXED, __HIP_MEMORY_SCOPE_AGENT); }
__device__ __forceinline__ unsigned xb_add(unsigned* p, unsigned v) { return __hip_atomic_fetch_add(p, v, __ATOMIC_RELAXED, __HIP_MEMORY_SCOPE_AGENT); }
__device__ __forceinline__ unsigned xb_xcc_id() { return (unsigned)__builtin_amdgcn_s_getreg((3 << 11) | 20) & 0xFu; }
#define XB_SPIN(cond, bar) do { unsigned _sp = 0; while (cond) { __builtin_amdgcn_s_sleep(1); \
    if ((++_sp & 255u) == 0u) { if (xb_ld(&(bar)[XB_TMO])) break; if (_sp > XB_SPIN_CAP) { atomicAdd(&(bar)[XB_TMO], 1u); break; } } } } while (0)
struct XcdBarrier { unsigned* bar; unsigned x; volatile LAS unsigned* st; };
__device__ __forceinline__ XcdBarrier xcd_barrier_post(unsigned* bar, volatile LAS unsigned* st) {
    XcdBarrier b; b.bar = bar; b.x = xb_xcc_id(); b.st = st;
    if (threadIdx.x == 0) (void)xb_add(&bar[XB_XCNT(b.x)], 1u);
    return b;
}
__device__ __forceinline__ void xcd_barrier_complete(unsigned* bar, unsigned x, unsigned& nloc, unsigned& nx) {
    const unsigned G = gridDim.x * gridDim.y * gridDim.z;
    unsigned sum, cnt, mine, sp = 0u;
    for (;;) {
        sum = 0u; cnt = 0u; mine = 0u;
#pragma unroll
        for (unsigned j = 0; j < 16; ++j) { const unsigned c = xb_ld(&bar[XB_XCNT(j)]); sum += c; cnt += (c > 0u) ? 1u : 0u; mine = (j == x) ? c : mine; }
        if (sum == G) break;
        __builtin_amdgcn_s_sleep(1);
        if ((++sp & 255u) == 0u) { if (xb_ld(&bar[XB_TMO])) break; if (sp > XB_SPIN_CAP) { atomicAdd(&bar[XB_TMO], 1u); break; } }
    }
    nloc = mine > 0u ? mine : 1u; nx = cnt > 0u ? cnt : 1u;
}
__device__ __forceinline__ void xcd_barrier(const XcdBarrier& b) {
    asm volatile("s_waitcnt vmcnt(0)" ::: "memory");
    __syncthreads();
    if (threadIdx.x == 0) {
        unsigned* bar = b.bar;
        __builtin_amdgcn_s_waitcnt(0);
        unsigned nloc = b.st[0], nx = b.st[1];
        if (nloc == 0u) { xcd_barrier_complete(bar, b.x, nloc, nx); b.st[0] = nloc; b.st[1] = nx; }
        const unsigned old = xb_add(&bar[XB_XSUB(b.x)], 1u);
        const unsigned gen = old / nloc;
        if (old + 1u == (gen + 1u) * nloc) {
            __builtin_amdgcn_fence(__ATOMIC_RELEASE, "agent");
            asm volatile("s_waitcnt vmcnt(0)" ::: "memory");
            const unsigned og = xb_add(&bar[XB_TOP], 1u);
            const unsigned tg = og / nx;
            if (og + 1u == (tg + 1u) * nx) xb_add(&bar[XB_TOPGEN], 1u);
            else XB_SPIN(xb_ld(&bar[XB_TOPGEN]) == tg, bar);
            __builtin_amdgcn_fence(__ATOMIC_ACQUIRE, "agent");
            xb_add(&bar[XB_XGEN(b.x)], 1u);
            asm volatile("s_waitcnt vmcnt(0)" ::: "memory");
        } else {
            XB_SPIN(xb_ld(&bar[XB_XGEN(b.x)]) == gen, bar);
            __builtin_amdgcn_fence(__ATOMIC_ACQUIRE, "agent");
            asm volatile("s_waitcnt vmcnt(0)" ::: "memory");
        }
    }
    __syncthreads();
}

struct SrcPlain { const float* W; int N; __device__ __forceinline__ const float* operator()(int k, int n) const { return W + (size_t)k * N + n; } };
struct SrcEvenIn { const float* W; __device__ __forceinline__ const float* operator()(int k, int n) const { return n < 2312 ? W + (size_t)k * 2312 + n : nullptr; } };
struct SrcOddIn { const float* W;
    __device__ __forceinline__ const float* operator()(int k, int n) const {
        int s;
        if (n < 2560) s = n; else if (n < 4608) s = n + 16; else if (n < 5632) s = n + 32; else if (n < 5648) s = 2560 + (n - 5632); else if (n < 5664) s = 4624 + (n - 5648); else s = -1;
        return s >= 0 ? W + (size_t)k * 5664 + s : nullptr; } };
struct SrcGateUp { const float* Wg; const float* Wu;
    __device__ __forceinline__ const float* operator()(int k, int n) const { const int j = (n >> 5) * 16 + (n & 15); const long d = (n & 16) ? (long)(Wu - Wg) : 0l; return Wg + d + (size_t)k * 512 + j; } };
__device__ __forceinline__ struct CvItem cv_make_gu(const float* Wg, const float* Wu, bf16_t* WT, int item, int lane);
struct CvItem { const float* p; size_t stride; bf16_t* dst; int K; int gu; };
template <class Src> __device__ __forceinline__ CvItem cv_make(const Src& src, int srcN, int K, int nblk, bf16_t* WT, int item, int lane) {
    const int kb = item / nblk, nb = item % nblk, k0 = 64 * kb, n0 = 32 * nb;
    CvItem d; d.p = src(k0 + (lane >> 5), n0 + (lane & 31)); d.stride = (size_t)2 * srcN; d.dst = WT + (size_t)n0 * K + k0; d.K = K; d.gu = 0; return d;
}
__device__ __forceinline__ CvItem cv_make_gu(const float* Wg, const float* Wu, bf16_t* WT, int item, int lane) {
    const int half = item >> 8, r = item & 255, kb = r >> 4, jb = r & 15, k0 = 64 * kb, j0 = 32 * jb;
    CvItem d; d.p = (half ? Wu : Wg) + (size_t)(k0 + (lane >> 5)) * 512 + j0 + (lane & 31); d.stride = 1024; d.dst = WT + (size_t)(jb * 64 + half * 16) * 1024 + k0; d.K = 1024; d.gu = 1; return d;
}
__device__ __forceinline__ void cv_load(const CvItem& d, float (&v)[32]) {
#pragma unroll
    for (int i = 0; i < 32; ++i) v[i] = d.p ? __builtin_nontemporal_load(d.p + (size_t)i * d.stride) : 0.f;
}
__device__ __forceinline__ void cv_finish(const CvItem& d, const float (&v)[32], LAS float* scr, int lane) {
#pragma unroll
    for (int i = 0; i < 32; ++i) { const int kk = 2 * i + (lane >> 5); scr[kk * 33 + (lane & 31)] = v[i]; }
    asm volatile("s_waitcnt lgkmcnt(0)" ::: "memory");
    const int c = lane & 7;
#pragma unroll
    for (int j = 0; j < 4; ++j) { const int n = (lane >> 3) + 8 * j; const LAS float* s = scr + (8 * c) * 33 + n; const int dr = d.gu ? ((n >> 4) * 32 + (n & 15)) : n;
        u32x4 o; o.x = cvt_pk_bf16(s[0 * 33], s[1 * 33]); o.y = cvt_pk_bf16(s[2 * 33], s[3 * 33]); o.z = cvt_pk_bf16(s[4 * 33], s[5 * 33]); o.w = cvt_pk_bf16(s[6 * 33], s[7 * 33]);
        __builtin_nontemporal_store(o, (u32x4*)(d.dst + (size_t)dr * d.K + 8 * c)); }
    asm volatile("s_waitcnt lgkmcnt(0)" ::: "memory");
}

namespace pg8 {
constexpr int BM = 256, BK = 64, HALF = 128, HTB = HALF * BK * 2, STAGE_BYTES = 8 * HTB, NXCD = 8, WGM = 8;
__host__ __device__ __forceinline__ int lds_byte(int r, int c) { const int st = (r >> 4) * 2 + (c >> 5), rr = r & 15, cc = c & 31, ob = rr * 64 + cc * 2; return st * 1024 + (ob ^ (((ob >> 9) & 1) << 5)); }
__host__ __device__ __forceinline__ void stage_rc(int b, int& R, int& C) { const int st = b / 1024, sb = b % 1024, swz = sb ^ (((sb >> 9) & 1) << 5); R = (st >> 1) * 16 + swz / 64; C = (st & 1) * 32 + (swz % 64) / 2; }
__host__ __device__ __forceinline__ int perm32(int rho) { const int n = rho >> 4, i = rho & 15; return 8 * (i >> 2) + 4 * n + (i & 3); }

struct Unit { int pm, pn, e, j; };
struct Gemm { const bf16_t* A; const bf16_t* Bt; int K; size_t b_estride; };

struct DenseOrder {
    int nM, nN, nwg, G, c, rep;
    __device__ void init(int M, int N, int G_, int c_, int rep_ = 1) { nM = M / BM; nN = N / BM; nwg = nM * nN; G = G_; c = c_; rep = rep_; }
    __device__ bool next(int i, Unit& u) const {
        if (rep > 1) { const int n = (nwg - c + G - 1) / G; if (n <= 0 || i >= n * rep) return false; i = i % n; }
        const long L = (long)i * G + c; if (L >= nwg) return false;
        int wgid = (int)L; { const int q = nwg / NXCD, r = nwg % NXCD, xcd = wgid % NXCD, off = wgid / NXCD; wgid = (xcd < r ? xcd * (q + 1) : r * (q + 1) + (xcd - r) * q) + off; }
        const int nig = WGM * nN, gid = wgid / nig, fm = gid * WGM, gsz = (nM - fm) < WGM ? (nM - fm) : WGM;
        u.pm = fm + ((wgid % nig) % gsz); u.pn = (wgid % nig) / gsz; u.e = 0; u.j = 0; return true;
    }
    __device__ __forceinline__ unsigned arow(const Unit& u, int r) const { return (unsigned)(u.pm * BM + r); }
};
struct MoeOrder {
    const volatile LAS int* ts; const volatile LAS int* cnt; const int* lists; int G, c; bool gather; int rep;
    __device__ bool next(int i, Unit& u) const {
        const int U = ts[32] * 4;
        if (rep > 1) { const int n = (U - c + G - 1) / G; if (n <= 0 || i >= n * rep) return false; i = i % n; }
        const long L = (long)i * G + c; if (L >= U) return false;
        int v = (int)L; { const int q = U / NXCD, r = U % NXCD, xcd = v % NXCD, off = v / NXCD; v = (xcd < r ? xcd * (q + 1) : r * (q + 1) + (xcd - r) * q) + off; }
        const int m = v >> 2; u.pm = m; u.pn = v & 3;
        int e = 0;
        for (int k = 1; k < 32; ++k) if (ts[k] <= m) e = k;
        u.e = e; u.j = m - ts[e]; return true;
    }
    __device__ __forceinline__ unsigned arow(const Unit& u, int r) const {
        if (!gather) return (unsigned)(u.pm * BM + r);
        const int ri = u.j * BM + r; const int n = cnt[u.e];
        return ri < n ? (unsigned)(lists[u.e * CAP + ri] >> 1) : 0u;
    }
};

struct EpiProjEven {
    static constexpr bool PERM = true;
    bf16_t* O; float* fb;
    __device__ __forceinline__ void operator()(const f32x4 (&acc)[2][2][4][2], const Unit& u, int wr, int wc, int fr, int fq) const {
        const int row0 = u.pm * BM + wr * 64 + fr;
        if (u.pn == 9) {
            if (wc == 0 && fq == 0) {
#pragma unroll
                for (int ai = 0; ai < 2; ++ai)
#pragma unroll
                    for (int m = 0; m < 4; ++m) { float* p = fb + (size_t)(row0 + ai * HALF + m * 16) * 8; *(f32x4*)p = acc[ai][0][m][0]; *(f32x4*)(p + 4) = acc[ai][0][m][1]; }
            }
            return;
        }
        const float sc = (u.pn == 0 || u.pn == 1 || u.pn == 3 || u.pn == 4) ? C2 : 1.f;
        const int col0 = u.pn * BM + wc * 32 + 8 * fq;
#pragma unroll
        for (int ai = 0; ai < 2; ++ai)
#pragma unroll
            for (int m = 0; m < 4; ++m) { bf16_t* rowp = O + (size_t)(row0 + ai * HALF + m * 16) * NE_IN + col0;
#pragma unroll
                for (int bj = 0; bj < 2; ++bj) { const f32x4 v0 = acc[ai][bj][m][0] * sc, v1 = acc[ai][bj][m][1] * sc;
                    u32x4 w; w.x = cvt_pk_bf16(v0[0], v0[1]); w.y = cvt_pk_bf16(v0[2], v0[3]); w.z = cvt_pk_bf16(v1[0], v1[1]); w.w = cvt_pk_bf16(v1[2], v1[3]);
                    *(u32x4*)(rowp + bj * HALF) = w; } }
    }
};
struct EpiProjOdd {
    static constexpr bool PERM = true;
    bf16_t* O; float* dtg;
    __device__ __forceinline__ void operator()(const f32x4 (&acc)[2][2][4][2], const Unit& u, int wr, int wc, int fr, int fq) const {
        const int row0 = u.pm * BM + wr * 64 + fr;
        if (u.pn == 22) {
            if (wc == 0) {
#pragma unroll
                for (int ai = 0; ai < 2; ++ai)
#pragma unroll
                    for (int m = 0; m < 4; ++m) { float* p = dtg + (size_t)(row0 + ai * HALF + m * 16) * 32 + 8 * fq; *(f32x4*)p = acc[ai][0][m][0]; *(f32x4*)(p + 4) = acc[ai][0][m][1]; }
            }
            return;
        }
        const int col0 = u.pn * BM + wc * 32 + 8 * fq;
#pragma unroll
        for (int ai = 0; ai < 2; ++ai)
#pragma unroll
            for (int m = 0; m < 4; ++m) { bf16_t* rowp = O + (size_t)(row0 + ai * HALF + m * 16) * NO_IN + col0;
#pragma unroll
                for (int bj = 0; bj < 2; ++bj) { const f32x4 v0 = acc[ai][bj][m][0], v1 = acc[ai][bj][m][1];
                    u32x4 w; w.x = cvt_pk_bf16(v0[0], v0[1]); w.y = cvt_pk_bf16(v0[2], v0[3]); w.z = cvt_pk_bf16(v1[0], v1[1]); w.w = cvt_pk_bf16(v1[2], v1[3]);
                    *(u32x4*)(rowp + bj * HALF) = w; } }
    }
};
struct EpiResid {
    static constexpr bool PERM = false;
    const float* base; float* out;
    __device__ __forceinline__ void operator()(const f32x4 (&acc)[2][2][4][2], const Unit& u, int wr, int wc, int fr, int fq) const {
        const int col0 = u.pn * BM + wc * 32 + 4 * fq;
#pragma unroll
        for (int ai = 0; ai < 2; ++ai)
#pragma unroll
            for (int m = 0; m < 4; ++m) { const size_t off = (size_t)(u.pm * BM + ai * HALF + wr * 64 + m * 16 + fr) * DM + col0;
#pragma unroll
                for (int bj = 0; bj < 2; ++bj)
#pragma unroll
                    for (int n = 0; n < 2; ++n) { const f32x4 bs = *(const f32x4*)(base + off + bj * HALF + n * 16); *(f32x4*)(out + off + bj * HALF + n * 16) = bs + acc[ai][bj][m][n]; } }
    }
};
template <bool BASE_F32> struct EpiResidB {
    static constexpr bool PERM = true;
    const void* base; bf16_t* out;
    __device__ __forceinline__ void operator()(const f32x4 (&acc)[2][2][4][2], const Unit& u, int wr, int wc, int fr, int fq) const {
        const int row0 = u.pm * BM + wr * 64 + fr, col0 = u.pn * BM + wc * 32 + 8 * fq;
#pragma unroll
        for (int ai = 0; ai < 2; ++ai)
#pragma unroll
            for (int m = 0; m < 4; ++m) { const size_t ro = (size_t)(row0 + ai * HALF + m * 16) * DM + col0;
#pragma unroll
                for (int bj = 0; bj < 2; ++bj) { f32x4 v0 = acc[ai][bj][m][0], v1 = acc[ai][bj][m][1];
                    if (BASE_F32) { const float* b = (const float*)base + ro + bj * HALF; v0 += __builtin_nontemporal_load((const f32x4*)b); v1 += __builtin_nontemporal_load((const f32x4*)(b + 4)); }
                    else { const u32x4 bb = *(const u32x4*)((const bf16_t*)base + ro + bj * HALF);
                        v0[0] += __uint_as_float(bb.x << 16); v0[1] += __uint_as_float(bb.x & 0xffff0000u); v0[2] += __uint_as_float(bb.y << 16); v0[3] += __uint_as_float(bb.y & 0xffff0000u);
                        v1[0] += __uint_as_float(bb.z << 16); v1[1] += __uint_as_float(bb.z & 0xffff0000u); v1[2] += __uint_as_float(bb.w << 16); v1[3] += __uint_as_float(bb.w & 0xffff0000u); }
                    u32x4 w; w.x = cvt_pk_bf16(v0[0], v0[1]); w.y = cvt_pk_bf16(v0[2], v0[3]); w.z = cvt_pk_bf16(v1[0], v1[1]); w.w = cvt_pk_bf16(v1[2], v1[3]);
                    *(u32x4*)(out + ro + bj * HALF) = w; } }
    }
};
struct EpiGateUp {
    static constexpr bool PERM = false;
    bf16_t* H;
    __device__ __forceinline__ void operator()(const f32x4 (&acc)[2][2][4][2], const Unit& u, int wr, int wc, int fr, int fq) const {
#pragma unroll
        for (int ai = 0; ai < 2; ++ai)
#pragma unroll
            for (int m = 0; m < 4; ++m) { bf16_t* rowp = H + (size_t)(u.pm * BM + ai * HALF + wr * 64 + m * 16 + fr) * 512;
#pragma unroll
                for (int bj = 0; bj < 2; ++bj) { const int j0 = (u.pn * 8 + bj * 4 + wc) * 16 + 4 * fq; const f32x4 g = acc[ai][bj][m][0], up = acc[ai][bj][m][1];
                    u32x2 w; w.x = cvt_pk_bf16(siluf(g[0]) * up[0], siluf(g[1]) * up[1]); w.y = cvt_pk_bf16(siluf(g[2]) * up[2], siluf(g[3]) * up[3]);
                    *(u32x2*)(rowp + j0) = w; } }
    }
};
struct EpiDown {
    static constexpr bool PERM = true;
    bf16_t* Y; const int* lists; const float* gates; const volatile LAS int* cnt;
    __device__ __forceinline__ void operator()(const f32x4 (&acc)[2][2][4][2], const Unit& u, int wr, int wc, int fr, int fq) const {
        const int n = cnt[u.e]; const int col0 = u.pn * BM + wc * 32 + 8 * fq;
#pragma unroll
        for (int ai = 0; ai < 2; ++ai)
#pragma unroll
            for (int m = 0; m < 4; ++m) { const int ri = u.j * BM + ai * HALF + wr * 64 + m * 16 + fr;
                if (ri < n) { const int a = lists[u.e * CAP + ri]; const float g = gates[a]; bf16_t* rowp = Y + ((size_t)(a & 1) * T + (a >> 1)) * DM + col0;
#pragma unroll
                    for (int bj = 0; bj < 2; ++bj) { const f32x4 v0 = acc[ai][bj][m][0] * g, v1 = acc[ai][bj][m][1] * g;
                        u32x4 w; w.x = cvt_pk_bf16(v0[0], v0[1]); w.y = cvt_pk_bf16(v0[2], v0[3]); w.z = cvt_pk_bf16(v1[0], v1[1]); w.w = cvt_pk_bf16(v1[2], v1[3]);
                        *(u32x4*)(rowp + bj * HALF) = w; } } }
    }
};

template <class Epi, class Sched, bool ALIGN_EPI>
__device__ __forceinline__ void gemm_phase(LAS unsigned char* lds, const Gemm g, const Sched& S, const Epi& E) {
    const int tid = threadIdx.x, wid = __builtin_amdgcn_readfirstlane(tid >> 6), lane = tid & 63, wr = wid >> 2, wc = wid & 3, fr = lane & 15, fq = lane >> 4;
    const int K = g.K, nt = K / BK;
    int RA[2]; unsigned cbA[2], voffB[2];
#pragma unroll
    for (int i = 0; i < 2; ++i) { int R, C; stage_rc(tid * 16 + i * 8192, R, C); const int Rb = Epi::PERM ? ((R & ~31) + perm32(R & 31)) : R;
        RA[i] = R; cbA[i] = (unsigned)C * 2u; voffB[i] = (unsigned)(Rb * K + C) * 2u; }
    const unsigned kstep = (unsigned)(BK * 2);
    const size_t hstep = (size_t)HALF * K * 2;
    const size_t tstep = 2 * hstep;
    const unsigned rowb = (unsigned)K * 2u;
    const unsigned ldsw = (unsigned)wid * 1024u;
    const int aoff = lds_byte(wr * 64 + fr, fq * 8), boff = lds_byte(wc * 32 + fr, fq * 8);
    const char* Ab = (const char*)g.A;
#define PG8_SA(b, h) (((b) * 2 + (h)) * HTB)
#define PG8_SB(b, h) ((4 + (b) * 2 + (h)) * HTB)
#define PG8_STAGE(bufoff, gbase, voff) do { _Pragma("unroll") for (int _i = 0; _i < 2; ++_i) \
        __builtin_amdgcn_global_load_lds((const unsigned*)((const char*)(gbase) + (voff)[_i]), (LAS unsigned*)(lds + (bufoff) + ldsw + _i * 8192), 16, 0, 0); } while (0)
#define PG8_STAGE_A(bufoff, kb, o0, o1) do { \
        __builtin_amdgcn_global_load_lds((const unsigned*)(Ab + (kb) + (o0)), (LAS unsigned*)(lds + (bufoff) + ldsw), 16, 0, 0); \
        __builtin_amdgcn_global_load_lds((const unsigned*)(Ab + (kb) + (o1)), (LAS unsigned*)(lds + (bufoff) + ldsw + 8192), 16, 0, 0); } while (0)
#define PG8_LDA(dst, b, h) do { _Pragma("unroll") for (int m = 0; m < 4; ++m) _Pragma("unroll") for (int k = 0; k < 2; ++k) dst[m][k] = *(const LAS bf16x8*)(lds + PG8_SA(b, h) + aoff + m * 2048 + k * 1024); } while (0)
#define PG8_LDB(dst, b, h) do { _Pragma("unroll") for (int n = 0; n < 2; ++n) _Pragma("unroll") for (int k = 0; k < 2; ++k) dst[n][k] = *(const LAS bf16x8*)(lds + PG8_SB(b, h) + boff + n * 2048 + k * 1024); } while (0)
#define PG8_MMA(ai, bj, At, Bt) do { __builtin_amdgcn_s_setprio(1); _Pragma("unroll") for (int m = 0; m < 4; ++m) _Pragma("unroll") for (int n = 0; n < 2; ++n) _Pragma("unroll") for (int k = 0; k < 2; ++k) \
        acc[ai][bj][m][n] = __builtin_amdgcn_mfma_f32_16x16x32_bf16(Bt[n][k], At[m][k], acc[ai][bj][m][n], 0, 0, 0); __builtin_amdgcn_s_setprio(0); } while (0)
#define PG8_WAIT_V(n) asm volatile("s_waitcnt vmcnt(" #n ")" ::: "memory")
#define PG8_WAIT_L(n) asm volatile("s_waitcnt lgkmcnt(" #n ")" ::: "memory")
#define PG8_BAR __builtin_amdgcn_s_barrier()
#define PG8_SCHED __builtin_amdgcn_sched_barrier(0)
    Unit cur, nxt; int ui = 0;
    if (!S.next(0, cur)) return;
    f32x4 acc[2][2][4][2];
#pragma unroll
    for (int a = 0; a < 2; ++a)
#pragma unroll
        for (int b = 0; b < 2; ++b)
#pragma unroll
            for (int m = 0; m < 4; ++m)
#pragma unroll
                for (int n = 0; n < 2; ++n) acc[a][b][m][n] = (f32x4){0.f, 0.f, 0.f, 0.f};
    bf16x8 At[4][2], B0[2][2], B1[2][2];
    unsigned oC00 = S.arow(cur, RA[0]) * rowb + cbA[0], oC01 = S.arow(cur, RA[1]) * rowb + cbA[1];
    unsigned oC10 = S.arow(cur, HALF + RA[0]) * rowb + cbA[0], oC11 = S.arow(cur, HALF + RA[1]) * rowb + cbA[1];
    const char* cB = (const char*)g.Bt + (size_t)cur.e * g.b_estride + (size_t)cur.pn * tstep;
    PG8_STAGE(PG8_SB(0, 0), cB, voffB); PG8_STAGE(PG8_SB(0, 1), cB + hstep, voffB); PG8_STAGE_A(PG8_SA(0, 0), 0u, oC00, oC01); PG8_STAGE_A(PG8_SA(0, 1), 0u, oC10, oC11);
    if (wr == 1) PG8_BAR;
    PG8_WAIT_V(2); PG8_BAR;
    PG8_STAGE(PG8_SB(1, 0), cB + kstep, voffB); PG8_STAGE_A(PG8_SA(1, 0), kstep, oC00, oC01); PG8_STAGE(PG8_SB(1, 1), cB + hstep + kstep, voffB);
    PG8_WAIT_V(6); PG8_BAR;
    for (;;) {
        const bool has_next = S.next(ui + 1, nxt);
        unsigned oN00 = oC00, oN01 = oC01, oN10 = oC10, oN11 = oC11;
        if (has_next) { oN00 = S.arow(nxt, RA[0]) * rowb + cbA[0]; oN01 = S.arow(nxt, RA[1]) * rowb + cbA[1];
                        oN10 = S.arow(nxt, HALF + RA[0]) * rowb + cbA[0]; oN11 = S.arow(nxt, HALF + RA[1]) * rowb + cbA[1]; }
        const char* nB = has_next ? (const char*)g.Bt + (size_t)nxt.e * g.b_estride + (size_t)nxt.pn * tstep : cB;
        for (int t = 0; t < nt; t += 2) {
            const bool last = (t == nt - 2);
            const unsigned k1 = (unsigned)(t + 1) * kstep;
            const unsigned k2 = last ? 0u : (unsigned)(t + 2) * kstep, k3 = k2 + kstep;
            const unsigned o00 = last ? oN00 : oC00, o01 = last ? oN01 : oC01, o10 = last ? oN10 : oC10, o11 = last ? oN11 : oC11;
            const char* b2 = last ? nB : cB + (size_t)(t + 2) * kstep; const char* b3 = b2 + kstep;
            PG8_LDB(B0, 0, 0); PG8_LDB(B1, 0, 1); PG8_SCHED; PG8_LDA(At, 0, 0); PG8_STAGE_A(PG8_SA(1, 1), k1, oC10, oC11);
            PG8_WAIT_V(8); PG8_WAIT_L(0); PG8_BAR; PG8_MMA(0, 0, At, B0); PG8_MMA(0, 1, At, B1); PG8_BAR; PG8_SCHED;
            PG8_LDA(At, 0, 1); PG8_STAGE(PG8_SB(0, 0), b2, voffB); PG8_STAGE(PG8_SB(0, 1), b2 + hstep, voffB); PG8_STAGE_A(PG8_SA(0, 0), k2, o00, o01);
            PG8_WAIT_V(8); PG8_WAIT_L(0); PG8_BAR; PG8_MMA(1, 0, At, B0); PG8_MMA(1, 1, At, B1); PG8_BAR; PG8_SCHED;
            PG8_LDB(B0, 1, 0); PG8_LDB(B1, 1, 1); PG8_SCHED; PG8_LDA(At, 1, 0); PG8_STAGE_A(PG8_SA(0, 1), k2, o10, o11);
            PG8_WAIT_V(8); PG8_WAIT_L(0); PG8_BAR; PG8_MMA(0, 0, At, B0); PG8_MMA(0, 1, At, B1); PG8_BAR; PG8_SCHED;
            PG8_LDA(At, 1, 1); PG8_STAGE(PG8_SB(1, 0), b3, voffB); PG8_STAGE(PG8_SB(1, 1), b3 + hstep, voffB); PG8_STAGE_A(PG8_SA(1, 0), k3, o00, o01);
            PG8_WAIT_V(8); PG8_WAIT_L(0); PG8_BAR; PG8_MMA(1, 0, At, B0); PG8_MMA(1, 1, At, B1); PG8_BAR; PG8_SCHED;
        }
        if constexpr (ALIGN_EPI) { if (wr == 0) PG8_BAR; }
        E(acc, cur, wr, wc, fr, fq);
        if (!has_next) break;
#pragma unroll
        for (int a = 0; a < 2; ++a)
#pragma unroll
            for (int b = 0; b < 2; ++b)
#pragma unroll
                for (int m = 0; m < 4; ++m)
#pragma unroll
                    for (int n = 0; n < 2; ++n) acc[a][b][m][n] = (f32x4){0.f, 0.f, 0.f, 0.f};
        cur = nxt; cB = nB; oC00 = oN00; oC01 = oN01; oC10 = oN10; oC11 = oN11; ++ui;
        if constexpr (ALIGN_EPI) { if (wr == 1) PG8_BAR; }
    }
    PG8_WAIT_V(0);
    if constexpr (!ALIGN_EPI) { if (wr == 0) PG8_BAR; }
    PG8_BAR;
#undef PG8_SA
#undef PG8_SB
#undef PG8_STAGE
#undef PG8_STAGE_A
#undef PG8_LDA
#undef PG8_LDB
#undef PG8_MMA
#undef PG8_WAIT_V
#undef PG8_WAIT_L
#undef PG8_BAR
#undef PG8_SCHED
}
}
}
namespace att {
using namespace mk;
constexpr int KVBLK = 64;
constexpr int A_K = 0, A_V = 32768, A_WS = 65536, A_OST = A_WS + NWAVES * 256, A_BIAS = A_OST + NWAVES * 4096, A_SCAN = A_BIAS + 8192, A_BYTES = A_SCAN + 64;
static_assert(A_BYTES <= RING_BYTES, "attention LDS");
__device__ __forceinline__ int crow(int r, int hi) { return (r & 3) + 8 * (r >> 2) + 4 * hi; }
__device__ __forceinline__ void glds16(const void* gsrc, unsigned lds_dst) { unsigned keep;
    asm volatile("s_mov_b32 %0, m0\n\ts_mov_b32 m0, %2\n\ts_nop 0\n\tglobal_load_lds_dwordx4 %1, off\n\ts_mov_b32 m0, %0" : "=&s"(keep) : "v"(gsrc), "s"(lds_dst) : "memory"); }
__device__ __forceinline__ unsigned cvtpk(float lo, float hi) { return cvt_pk_bf16(lo, hi); }
__device__ __forceinline__ void qkt(f32x16& p0, f32x16& p1, const LAS char* Kslot, const bf16x8* qr, int r32, int hi) {
    const LAS char* kb = Kslot + hi * 1024 + r32 * 16;
    const f32x16 z = {};
#pragma unroll
    for (int d0 = 0; d0 < 4; ++d0) {
        const bf16x8 b0 = *(const LAS bf16x8*)(kb + d0 * 2048);
        const bf16x8 b1 = *(const LAS bf16x8*)(kb + d0 * 2048 + 512);
        if (d0 == 0) { p0 = __builtin_amdgcn_mfma_f32_32x32x16_bf16(b0, qr[0], z, 0, 0, 0); p1 = __builtin_amdgcn_mfma_f32_32x32x16_bf16(b1, qr[0], z, 0, 0, 0); }
        else { p0 = __builtin_amdgcn_mfma_f32_32x32x16_bf16(b0, qr[d0], p0, 0, 0, 0); p1 = __builtin_amdgcn_mfma_f32_32x32x16_bf16(b1, qr[d0], p1, 0, 0, 0); } }
}
__device__ __forceinline__ void pv(f32x16* o, int vb, bf16x8 pa0, bf16x8 pa1, bf16x8 pa2, bf16x8 pa3) {
#pragma unroll
    for (int d0 = 0; d0 < 2; ++d0) { s16x4 lo[4], hi[4];
#pragma unroll
        for (int ks = 0; ks < 4; ++ks) {
            asm volatile("ds_read_b64_tr_b16 %0,%1 offset:%c2" : "=&v"(lo[ks]) : "v"(vb), "i"(d0 * 4096 + ks * 1024) : "memory");
            asm volatile("ds_read_b64_tr_b16 %0,%1 offset:%c2" : "=&v"(hi[ks]) : "v"(vb), "i"(d0 * 4096 + ks * 1024 + 512) : "memory"); }
        asm volatile("s_waitcnt lgkmcnt(0)" ::: "memory"); __builtin_amdgcn_sched_barrier(0);
#define PK(k) (bf16x8){lo[k][0], lo[k][1], lo[k][2], lo[k][3], hi[k][0], hi[k][1], hi[k][2], hi[k][3]}
        o[d0] = __builtin_amdgcn_mfma_f32_32x32x16_bf16(pa0, PK(0), o[d0], 0, 0, 0);
        o[d0] = __builtin_amdgcn_mfma_f32_32x32x16_bf16(pa1, PK(1), o[d0], 0, 0, 0);
        o[d0] = __builtin_amdgcn_mfma_f32_32x32x16_bf16(pa2, PK(2), o[d0], 0, 0, 0);
        o[d0] = __builtin_amdgcn_mfma_f32_32x32x16_bf16(pa3, PK(3), o[d0], 0, 0, 0);
#undef PK
    }
}
__device__ __forceinline__ float rowmax32(const f32x16& p0, const f32x16& p1) {
    float a = fmaxf(p0[0], p1[0]);
#pragma unroll
    for (int r = 1; r < 16; ++r) a = fmaxf(a, fmaxf(p0[r], p1[r]));
    auto rr = __builtin_amdgcn_permlane32_swap(__float_as_uint(a), __float_as_uint(a), false, false);
    return fmaxf(__uint_as_float(rr[0]), __uint_as_float(rr[1]));
}
#define A_WAIT_BAR(N) asm volatile("s_waitcnt vmcnt(" #N ") lgkmcnt(0)\n\ts_barrier" ::: "memory")

template <bool SWA>
__device__ __forceinline__ void attn_tiles(LAS char* shm, const bf16_t* Qw, int qpitch, const bf16_t* Kh, const bf16_t* Vh, int kvpitch, bf16_t* Ow, int opitch,
                                           int kt0, int ntile, int qpos0, float sl2, float sink2) {
    const int tid = threadIdx.x, lane = tid & 63, r32 = lane & 31, hi = lane >> 5; const int wid = __builtin_amdgcn_readfirstlane(tid >> 6);
    const unsigned lds0 = (unsigned)(uintptr_t)shm;
    LAS float* wsf = (LAS float*)(shm + A_WS) + wid * 64;
    const LAS float* biasl = (const LAS float*)(shm + A_BIAS);
    const bf16_t* ksrc = Kh + (long)lane * kvpitch + wid * 8;
    const bf16_t* vsrc = Vh + (long)(16 * (wid & 3) + (lane >> 2)) * kvpitch + (wid >> 2) * 32 + (lane & 3) * 8;
    const unsigned kdst = lds0 + A_K + wid * 1024, vdst = lds0 + A_V + wid * 1024;
#define DMA_K(t, slot) glds16(ksrc + (long)(t) * KVBLK * kvpitch, (unsigned)__builtin_amdgcn_readfirstlane(kdst + (slot)))
#define DMA_V(t, slot) glds16(vsrc + (long)(t) * KVBLK * kvpitch, (unsigned)__builtin_amdgcn_readfirstlane(vdst + (slot)))
    const int vb0 = (int)(lds0 + A_V) + ((lane >> 4) & 1) * 32 + (lane & 3) * 8 + (4 * hi + ((lane & 15) >> 2)) * 64;
    DMA_K(kt0, 0); DMA_V(kt0, 0);
    if (ntile > 1) { DMA_K(kt0 + 1, 8192); DMA_V(kt0 + 1, 8192); }
    if (ntile > 2) { DMA_K(kt0 + 2, 16384); DMA_V(kt0 + 2, 16384); }
    bf16x8 qr[4];
#pragma unroll
    for (int d0 = 0; d0 < 4; ++d0) qr[d0] = *(const bf16x8*)(Qw + (long)r32 * qpitch + d0 * 16 + hi * 8);
    float m = SWA ? sink2 : -INFINITY, l = (SWA && hi == 0) ? 1.f : 0.f;
    f32x16 o[2]; o[0] = f32x16{}; o[1] = f32x16{};
    const int qpos = qpos0 + r32;
    if (ntile > 2) { A_WAIT_BAR(4); } else if (ntile > 1) { A_WAIT_BAR(2); } else { A_WAIT_BAR(0); }
    f32x16 p0, p1;
    qkt(p0, p1, shm + A_K, qr, r32, hi);
    for (int it = 0; it < ntile; ++it) {
        const int kt = kt0 + it, slot = (it & 3) * 8192;
        f32x16 n0, n1;
        if (it + 1 < ntile) {
            if (it + 2 < ntile) { A_WAIT_BAR(2); } else { A_WAIT_BAR(0); }
            if (it + 3 < ntile) { DMA_K(kt + 3, ((it + 3) & 3) * 8192); DMA_V(kt + 3, ((it + 3) & 3) * 8192); }
            qkt(n0, n1, shm + A_K + ((it + 1) & 3) * 8192, qr, r32, hi);
        }
        const int kb = kt * 64 + 4 * hi;
        if (SWA) {
#pragma unroll
            for (int r = 0; r < 16; ++r) { const int k0 = kb + (r & 3) + 8 * (r >> 2), k1 = k0 + 32;
                p0[r] = (k0 <= qpos && k0 >= qpos - 127) ? p0[r] + sl2 * (float)(k0 - qpos) : -INFINITY;
                p1[r] = (k1 <= qpos && k1 >= qpos - 127) ? p1[r] + sl2 * (float)(k1 - qpos) : -INFINITY; }
        } else {
#pragma unroll
            for (int g = 0; g < 4; ++g) { const f32x4 b0 = *(const LAS f32x4*)(biasl + kb + 8 * g), b1 = *(const LAS f32x4*)(biasl + kb + 32 + 8 * g);
#pragma unroll
                for (int i = 0; i < 4; ++i) { p0[4 * g + i] += b0[i]; p1[4 * g + i] += b1[i]; } }
            if (kt * 64 + 63 > qpos0) {
#pragma unroll
                for (int r = 0; r < 16; ++r) { const int k0 = kb + (r & 3) + 8 * (r >> 2); if (k0 > qpos) p0[r] = -INFINITY; if (k0 + 32 > qpos) p1[r] = -INFINITY; }
            }
        }
        const float rm = rowmax32(p0, p1), mn = fmaxf(m, rm), ms = (mn == -INFINITY) ? 0.f : mn;
        const float alpha = __builtin_amdgcn_exp2f(m - ms);
        float rs = 0.f;
#pragma unroll
        for (int r = 0; r < 16; ++r) { p0[r] = __builtin_amdgcn_exp2f(p0[r] - ms); p1[r] = __builtin_amdgcn_exp2f(p1[r] - ms); rs += p0[r] + p1[r]; }
        l = l * alpha + rs; m = mn;
        if (hi == 0) wsf[r32] = alpha;
        asm volatile("s_waitcnt lgkmcnt(0)" ::: "memory");
#pragma unroll
        for (int r = 0; r < 16; ++r) { const float a = wsf[crow(r, hi)]; o[0][r] *= a; o[1][r] *= a; }
        u32x4 pw0, pw1, pw2, pw3;
        pw0 = (u32x4){cvtpk(p0[0], p0[1]), cvtpk(p0[2], p0[3]), cvtpk(p0[4], p0[5]), cvtpk(p0[6], p0[7])};
        pw1 = (u32x4){cvtpk(p0[8], p0[9]), cvtpk(p0[10], p0[11]), cvtpk(p0[12], p0[13]), cvtpk(p0[14], p0[15])};
        pw2 = (u32x4){cvtpk(p1[0], p1[1]), cvtpk(p1[2], p1[3]), cvtpk(p1[4], p1[5]), cvtpk(p1[6], p1[7])};
        pw3 = (u32x4){cvtpk(p1[8], p1[9]), cvtpk(p1[10], p1[11]), cvtpk(p1[12], p1[13]), cvtpk(p1[14], p1[15])};
        pv(o, vb0 + slot, __builtin_bit_cast(bf16x8, pw0), __builtin_bit_cast(bf16x8, pw1), __builtin_bit_cast(bf16x8, pw2), __builtin_bit_cast(bf16x8, pw3));
        asm volatile("s_waitcnt lgkmcnt(0)" ::: "memory");
        if (it + 1 < ntile) { p0 = n0; p1 = n1; }
    }
    { auto rr = __builtin_amdgcn_permlane32_swap(__float_as_uint(l), __float_as_uint(l), false, false); l = __uint_as_float(rr[0]) + __uint_as_float(rr[1]); }
    if (hi == 0) wsf[32 + r32] = l;
    asm volatile("s_waitcnt lgkmcnt(0)" ::: "memory");
    LAS bf16_t* stg = (LAS bf16_t*)(shm + A_OST) + wid * 2048;
#pragma unroll
    for (int r = 0; r < 16; ++r) { const int orow = crow(r, hi); const float rl = 1.f / wsf[32 + orow];
#pragma unroll
        for (int d0 = 0; d0 < 2; ++d0) stg[orow * 64 + d0 * 32 + r32] = (bf16_t)(cvt_pk_bf16(o[d0][r] * rl, 0.f) & 0xffffu); }
    asm volatile("s_waitcnt lgkmcnt(0)" ::: "memory");
#pragma unroll
    for (int i = 0; i < 4; ++i) { const int row = i * 8 + (lane >> 3), ch = lane & 7; const u32x4 v = *(const LAS u32x4*)(stg + row * 64 + ch * 8); *(u32x4*)(Ow + (long)row * opitch + ch * 8) = v; }
    asm volatile("s_waitcnt vmcnt(0) lgkmcnt(0)\n\ts_barrier" ::: "memory");
#undef DMA_K
#undef DMA_V
}

__device__ __forceinline__ void fox_unit(LAS char* shm, int b, int h, int qb, const bf16_t* proj, const float* fb, float fbias_h, bf16_t* heads) {
    const int tid = threadIdx.x, lane = tid & 63; const int wid = __builtin_amdgcn_readfirstlane(tid >> 6);
    LAS float* biasl = (LAS float*)(shm + A_BIAS); LAS float* scan = (LAS float*)(shm + A_SCAN);
    const int kend = (qb + 1) * 256;
    float v[4]; float s = 0.f;
#pragma unroll
    for (int i = 0; i < 4; ++i) { const int p = tid * 4 + i; float lf = 0.f; if (p < kend) lf = log_sigmoid_fast(fb[((size_t)b * SEQ + p) * 8 + h] + fbias_h); s += lf; v[i] = s; }
    float w = s;
#pragma unroll
    for (int o = 1; o < 64; o <<= 1) { const float t = __shfl_up(w, o); if (lane >= o) w += t; }
    if (lane == 63) scan[wid] = w;
    asm volatile("s_waitcnt lgkmcnt(0)\n\ts_barrier" ::: "memory");
    float off = w - s;
    for (int k = 0; k < 8; ++k) if (k < wid) off += scan[k];
#pragma unroll
    for (int i = 0; i < 4; ++i) biasl[tid * 4 + i] = -(v[i] + off) * LOG2E;
    asm volatile("s_waitcnt lgkmcnt(0)\n\ts_barrier" ::: "memory");
    const size_t rowb = (size_t)b * SEQ; const int q0 = qb * 256 + wid * 32;
    attn_tiles<false>(shm, proj + (rowb + q0) * NE_IN + 768 + h * 64, NE_IN, proj + rowb * NE_IN + 1280 + h * 64, proj + rowb * NE_IN + 1792 + h * 64, NE_IN,
                      heads + (rowb + q0) * 1024 + 512 + h * 64, 1024, 0, 4 * (qb + 1), q0, 0.f, 0.f);
}
__device__ __forceinline__ void swa_unit(LAS char* shm, int b, int kvh, int blk, const bf16_t* proj, const float* sinks, bf16_t* heads) {
    const int wid = __builtin_amdgcn_readfirstlane(threadIdx.x >> 6);
    const int qh = kvh * 4 + (wid >> 1), q0 = blk * 64 + (wid & 1) * 32;
    const size_t rowb = (size_t)b * SEQ;
    const int kt0 = blk >= 2 ? blk - 2 : 0, ntile = blk - kt0 + 1;
    const float sl2 = exp2f(-(float)(qh + 1)) * LOG2E, sink2 = sinks[qh] * LOG2E;
    attn_tiles<true>(shm, proj + (rowb + q0) * NE_IN + qh * 64, NE_IN, proj + rowb * NE_IN + 512 + kvh * 64, proj + rowb * NE_IN + 640 + kvh * 64, NE_IN,
                     heads + (rowb + q0) * 1024 + qh * 64, 1024, kt0, ntile, q0, sl2, sink2);
}
#undef A_WAIT_BAR
}

namespace attp {
using bf16=__hip_bfloat16;
using bf16x8=__attribute__((ext_vector_type(8)))short;
using s16x4=__attribute__((ext_vector_type(4)))short;
using f32x16=__attribute__((ext_vector_type(16)))float;
using u32x4=__attribute__((ext_vector_type(4)))unsigned;
constexpr int BATCH=8,NHEAD=8,SEQ=2048,D=64,DM=2560,OPITCH=1024;
constexpr int NW=8,QBLK=32,QB=QBLK*NW,KVBLK=64,NQB=SEQ/QB;
constexpr int ATTN_PITCH=DM, ATTN_UNIT_ROWS=QB;
__device__ __forceinline__ int crow(int r,int hi){return (r&3)+8*(r>>2)+4*hi;}
#define SBAR() __builtin_amdgcn_sched_barrier(0)
__device__ __forceinline__ void cmask(f32x16&p0,f32x16&p1,int jb,int qrel,int hi){
  const float NEG=-INFINITY; int kb=64*jb+4*hi;
  #pragma unroll
  for(int r=0;r<16;++r){int kv=kb+(r&3)+8*(r>>2); if(kv>qrel)p0[r]=NEG; if(kv+32>qrel)p1[r]=NEG;}
}

constexpr int NSLOT=3, SLOTB=8192;
constexpr int LDS_K=0, LDS_V=NSLOT*SLOTB, LDS_WS=2*NSLOT*SLOTB, LDS_OST=LDS_WS+NW*64*4, LDS_BIAS=LDS_OST+NW*4096, LDS_SCAN=LDS_BIAS+8192, LDS_BYTES=LDS_SCAN+64;
constexpr float C2=0.125f*1.4426950408889634f;
__device__ __forceinline__ void glds16(const void*gsrc,unsigned lds_dst){unsigned keep;
  asm volatile("s_mov_b32 %0, m0\n\ts_mov_b32 m0, %2\n\ts_nop 0\n\tglobal_load_lds_dwordx4 %1, off\n\ts_mov_b32 m0, %0":"=&s"(keep):"v"(gsrc),"s"(lds_dst):"memory");}
__device__ __forceinline__ float max3f(float a,float b,float c){float r;asm("v_max3_f32 %0, %1, %2, %3":"=v"(r):"v"(a),"v"(b),"v"(c));return r;}
__device__ __forceinline__ float max2f(float a,float b){float r;asm("v_max_f32_e32 %0, %1, %2":"=v"(r):"v"(a),"v"(b));return r;}
__device__ __forceinline__ float fadd_s(float a,float b){float r;asm("v_add_f32_e32 %0, %1, %2":"=v"(r):"v"(a),"v"(b));return r;}
__device__ __forceinline__ float fsub_s(float a,float b){float r;asm("v_sub_f32_e32 %0, %1, %2":"=v"(r):"v"(a),"v"(b));return r;}
typedef float f32x2_t __attribute__((ext_vector_type(2))); typedef __bf16 bf16x2_t __attribute__((ext_vector_type(2)));
__device__ __forceinline__ unsigned cvtpk_s(float lo,float hi){f32x2_t v={lo,hi};bf16x2_t b=__builtin_convertvector(v,bf16x2_t);return __builtin_bit_cast(unsigned,b);}
#define WAIT_BAR(N) asm volatile("s_waitcnt vmcnt(" #N ") lgkmcnt(0)\n\ts_barrier":::"memory")

__device__ __forceinline__ void qkt(f32x16&p0,f32x16&p1,const char*Kslot,const bf16x8*qr,int r32,int hi){ const f32x16 zc_=f32x16{};
  const char*kb=Kslot+hi*1024+r32*16;
  #pragma unroll
  for(int d0=0;d0<4;++d0){
    const bf16x8 b0=*reinterpret_cast<const bf16x8*>(kb+d0*2048);
    const bf16x8 b1=*reinterpret_cast<const bf16x8*>(kb+d0*2048+512);
    if(d0==0){p0=__builtin_amdgcn_mfma_f32_32x32x16_bf16(b0,qr[0],zc_,0,0,0);p1=__builtin_amdgcn_mfma_f32_32x32x16_bf16(b1,qr[0],zc_,0,0,0);}
    else{p0=__builtin_amdgcn_mfma_f32_32x32x16_bf16(b0,qr[d0],p0,0,0,0);p1=__builtin_amdgcn_mfma_f32_32x32x16_bf16(b1,qr[d0],p1,0,0,0);}}
}
typedef __attribute__((address_space(3))) const char* lds_cptr;
typedef short v4i16_t __attribute__((ext_vector_type(4)));
__device__ __forceinline__ void kload8(bf16x8*kf,lds_cptr kp){
  kf[0]=*(const __attribute__((address_space(3))) bf16x8*)(kp);      kf[1]=*(const __attribute__((address_space(3))) bf16x8*)(kp+512);
  kf[2]=*(const __attribute__((address_space(3))) bf16x8*)(kp+2048); kf[3]=*(const __attribute__((address_space(3))) bf16x8*)(kp+2560);
  kf[4]=*(const __attribute__((address_space(3))) bf16x8*)(kp+4096); kf[5]=*(const __attribute__((address_space(3))) bf16x8*)(kp+4608);
  kf[6]=*(const __attribute__((address_space(3))) bf16x8*)(kp+6144); kf[7]=*(const __attribute__((address_space(3))) bf16x8*)(kp+6656);
}
__device__ __forceinline__ void kload2(bf16x8*kf,lds_cptr kp,int j){ kf[2*j]=*(const __attribute__((address_space(3))) bf16x8*)(kp+j*2048); kf[2*j+1]=*(const __attribute__((address_space(3))) bf16x8*)(kp+j*2048+512); }
__device__ __forceinline__ s16x4 vtr(lds_cptr p){ return __builtin_bit_cast(s16x4,__builtin_amdgcn_ds_read_tr16_b64_v4i16((__attribute__((address_space(3))) v4i16_t*)p)); }
__device__ __forceinline__ float rowmax(const f32x16&p0,const f32x16&p1){
  float a=max3f(p0[0],p0[1],p1[0]),b=max3f(p0[2],p0[3],p1[1]);a=max3f(a,p1[2],p1[3]);
  #pragma unroll
  for(int r=4;r<16;r+=4){a=max3f(a,p0[r],p0[r+1]);b=max3f(b,p0[r+2],p0[r+3]);a=max3f(a,p1[r],p1[r+1]);b=max3f(b,p1[r+2],p1[r+3]);}
  const float m=max2f(a,b);
  auto rr=__builtin_amdgcn_permlane32_swap(__float_as_uint(m),__float_as_uint(m),false,false);
  return max2f(__uint_as_float(rr[0]),__uint_as_float(rr[1]));
}
__device__ __forceinline__ void pv(f32x16*o,int vb,bf16x8 pa0,bf16x8 pa1,bf16x8 pa2,bf16x8 pa3){
  #pragma unroll
  for(int d0=0;d0<2;++d0){s16x4 lo[4],hi[4];
    #pragma unroll
    for(int ks=0;ks<4;++ks){
      asm volatile("ds_read_b64_tr_b16 %0,%1 offset:%c2":"=&v"(lo[ks]):"v"(vb),"i"(d0*4096+ks*1024):"memory");
      asm volatile("ds_read_b64_tr_b16 %0,%1 offset:%c2":"=&v"(hi[ks]):"v"(vb),"i"(d0*4096+ks*1024+512):"memory");}
    asm volatile("s_waitcnt lgkmcnt(0)":::"memory");SBAR();
    #define PK(k) (bf16x8){lo[k][0],lo[k][1],lo[k][2],lo[k][3],hi[k][0],hi[k][1],hi[k][2],hi[k][3]}
    o[d0]=__builtin_amdgcn_mfma_f32_32x32x16_bf16(pa0,PK(0),o[d0],0,0,0);
    o[d0]=__builtin_amdgcn_mfma_f32_32x32x16_bf16(pa1,PK(1),o[d0],0,0,0);
    o[d0]=__builtin_amdgcn_mfma_f32_32x32x16_bf16(pa2,PK(2),o[d0],0,0,0);
    o[d0]=__builtin_amdgcn_mfma_f32_32x32x16_bf16(pa3,PK(3),o[d0],0,0,0);
    #undef PK
  }
}

#ifndef ATTN_STORE16
#define ATTN_STORE16(p,v) (*(u32x4*)(p)=(v))
#endif
template<int THRL,bool CHECK> __device__ __forceinline__ void attn_unit(int b,int h,int qb,const bf16*Q,const bf16*__restrict__ K,const bf16*__restrict__ V,bf16*O,char*shm,unsigned*mism){
  const int tid=threadIdx.x,lane=tid&63,r32=lane&31,hi=lane>>5; const int wid=__builtin_amdgcn_readfirstlane(tid>>6);
  const long rowbase=(long)b*SEQ; const int q0=qb*QB;
  const bf16*Qw=Q+(rowbase+q0+wid*QBLK)*DM+h*D;
  const bf16*Kh=K+rowbase*DM+h*D,*Vh=V+rowbase*DM+h*D;
  const unsigned lds0=(unsigned)(uintptr_t)shm;
  float*wsf=(float*)(shm+LDS_WS)+wid*64;
  const bf16*ksrc=Kh+(long)lane*DM+wid*8;
  const bf16*vsrc=Vh+(long)(16*(wid&3)+(lane>>2))*DM+(wid>>2)*32+(lane&3)*8;
  const unsigned kdst=lds0+LDS_K+wid*1024, vdst=lds0+LDS_V+wid*1024;
  #define DMA_K(t,slot) glds16(ksrc+(long)(t)*KVBLK*DM,(unsigned)__builtin_amdgcn_readfirstlane(kdst+(slot)))
  #define DMA_V(t,slot) glds16(vsrc+(long)(t)*KVBLK*DM,(unsigned)__builtin_amdgcn_readfirstlane(vdst+(slot)))
  const int vb0=(int)(lds0+LDS_V)+((lane>>4)&1)*32+(lane&3)*8+(4*hi+((lane&15)>>2))*64;
  const char*Kbase=shm+LDS_K; bf16x8 kf[8];
  const lds_cptr shm3=(lds_cptr)shm; const lds_cptr kp0=shm3+LDS_K+hi*1024+r32*16; const lds_cptr vp0=shm3+LDS_V+((lane>>4)&1)*32+(lane&3)*8+(4*hi+((lane&15)>>2))*64;
  const int NT=(q0+QB)/KVBLK;
  DMA_K(0,0);DMA_V(0,0);DMA_K(1,SLOTB);
  bf16x8 qr[4];
  #pragma unroll
  for(int d0=0;d0<4;++d0)qr[d0]=*reinterpret_cast<const bf16x8*>(&Qw[(long)r32*DM+d0*16+hi*8]);
  float mhat=0.f,l_reg=0.f;f32x16 o[2];o[0]=f32x16{};o[1]=f32x16{};u32x4 qaw={hi==0?0x3f803f80u:0u,0u,0u,0u};
  const int qrel=wid*QBLK+r32;
  #define CMASK(P0,P1,t) do{int jb_=(t)-(NT-4); if(jb_>=0)cmask(P0,P1,jb_,qrel,hi);}while(0)
  const __attribute__((address_space(3))) unsigned* biasw=(const __attribute__((address_space(3))) unsigned*)(shm3+LDS_BIAS)+r32;
  #define SETM() do{ const float nm_=-mhat; const unsigned h_=cvtpk_s(nm_,0.f)&0xffffu; const unsigned l_=cvtpk_s(nm_-__uint_as_float(h_<<16),0.f)&0xffffu; qaw[1]=(hi==0)?(h_|(l_<<16)):0u; }while(0)
  #define AUG(P0,P1,t) do{ const unsigned w0_=biasw[64*(t)], w1_=biasw[64*(t)+32]; const u32x4 ka0_={w0_,0x3f803f80u,0u,0u}, ka1_={w1_,0x3f803f80u,0u,0u}; \
      P0=__builtin_amdgcn_mfma_f32_32x32x16_bf16(__builtin_bit_cast(bf16x8,ka0_),__builtin_bit_cast(bf16x8,qaw),P0,0,0,0); \
      P1=__builtin_amdgcn_mfma_f32_32x32x16_bf16(__builtin_bit_cast(bf16x8,ka1_),__builtin_bit_cast(bf16x8,qaw),P1,0,0,0); }while(0)
  bool resc=false;
  #define START(P0,P1) do{ const float rm=rowmax(P0,P1); resc=false; \
    { const float dl=rm; mhat=fadd_s(mhat,dl); \
      _Pragma("unroll") for(int r=0;r<16;++r){P0[r]=fsub_s(P0[r],dl);P1[r]=fsub_s(P1[r],dl);} \
      SETM(); } \
    _Pragma("unroll") for(int r=0;r<16;++r)P0[r]=__builtin_amdgcn_exp2f(P0[r]); }while(0)
  #define RESC() do{ if(resc){ asm volatile("s_waitcnt lgkmcnt(0)":::"memory"); \
      _Pragma("unroll") for(int d_=0;d_<2;++d_) _Pragma("unroll") for(int r=0;r<16;++r)o[d_][r]*=wsf[crow(r,hi)]; } }while(0)
  f32x16 pA0,pA1,pB0,pB1;
  int sl_prev=0,sl_cur=0,sl_next=SLOTB;
  #define ROT() do{sl_prev=sl_cur;sl_cur=sl_next;sl_next=(sl_next==(NSLOT-1)*SLOTB)?0:sl_next+SLOTB;}while(0)
  DMA_K(2,2*SLOTB);
  WAIT_BAR(3);
  qkt(pA0,pA1,Kbase,qr,r32,hi);AUG(pA0,pA1,0);asm volatile("s_nop 15\n\ts_nop 7":"+v"(pA0),"+v"(pA1));CMASK(pA0,pA1,0);
  START(pA0,pA1);
  _Pragma("unroll") for(int r=0;r<16;++r)pA1[r]=__builtin_amdgcn_exp2f(pA1[r]);
  WAIT_BAR(0);
  DMA_K(3,0);DMA_V(1,SLOTB);
  ROT();
  kload8(kf,kp0+sl_cur);
  WAIT_BAR(2);
  s16x4 vlo[8],vhi[8]; u32x4 pw0,pw1,pw2,pw3; const f32x16 zc16=f32x16{};
  #define PKW(P,B) cvtpk_s(P[B],P[B+1])
  #define PAF(k) __builtin_bit_cast(bf16x8,pw##k)
  #define VFR(i) (bf16x8){vlo[i][0],vlo[i][1],vlo[i][2],vlo[i][3],vhi[i][0],vhi[i][1],vhi[i][2],vhi[i][3]}
  #define PIN(x) asm volatile("":"+v"(x))
  #define MX3(a,b,c) __builtin_fmaxf(__builtin_fmaxf((a),(b)),(c))
  #define GAPA(MF,A0,A1,A2,A3,W0,W1,PW) do{ MF; sacc+=A0; sacc+=A1; sacc+=A2; sacc+=A3; PIN(sacc); W0; W1; PIN(PW); SBAR(); }while(0)
  #define EX(v) __builtin_amdgcn_exp2f(v)
  #define GAPB(MF,X,B) do{ MF; X[B]=EX(X[B]); X[B+1]=EX(X[B+1]); X[B+2]=EX(X[B+2]); X[B+3]=EX(X[B+3]); PIN(X); SBAR(); }while(0)
  #define VRD(i) do{ vlo[i]=vtr(vp_+(((i)>>2)*4096+((i)&3)*1024)); vhi[i]=vtr(vp_+(((i)>>2)*4096+((i)&3)*1024+512)); }while(0)
  #define KRD(G,j) do{ if(G){ kload2(kf,kp0+sl_next,j); SBAR(); } }while(0)
  #define STEP(C0,C1,P0,P1,t,GK,GV,GL) do{ SBAR(); \
    const lds_cptr vp_=vp0+sl_prev; \
    VRD(0); SBAR(); float sacc=(P0[0]+P0[1]); \
    GAPA(C0=__builtin_amdgcn_mfma_f32_32x32x16_bf16(kf[0],qr[0],zc16,0,0,0), P0[2],P0[3],P0[4],P0[5],     pw0[0]=PKW(P0,0), pw0[1]=PKW(P0,2), pw0); \
    VRD(4); SBAR(); GAPA(C1=__builtin_amdgcn_mfma_f32_32x32x16_bf16(kf[1],qr[0],zc16,0,0,0), P0[6],P0[7],P0[8],P0[9],     pw0[2]=PKW(P0,4), pw0[3]=PKW(P0,6), pw0); \
    VRD(1); SBAR(); GAPA(C0=__builtin_amdgcn_mfma_f32_32x32x16_bf16(kf[2],qr[1],C0,0,0,0),   P0[10],P0[11],P0[12],P0[13], pw1[0]=PKW(P0,8), pw1[1]=PKW(P0,10), pw1); \
    VRD(5); SBAR(); GAPA(C1=__builtin_amdgcn_mfma_f32_32x32x16_bf16(kf[3],qr[1],C1,0,0,0),   P0[14],P0[15],P1[0],P1[1],   pw1[2]=PKW(P0,12),pw1[3]=PKW(P0,14), pw1); \
    VRD(2); SBAR(); GAPA(C0=__builtin_amdgcn_mfma_f32_32x32x16_bf16(kf[4],qr[2],C0,0,0,0),   P1[2],P1[3],P1[4],P1[5],     pw2[0]=PKW(P1,0), pw2[1]=PKW(P1,2), pw2); \
    VRD(6); SBAR(); GAPA(C1=__builtin_amdgcn_mfma_f32_32x32x16_bf16(kf[5],qr[2],C1,0,0,0),   P1[6],P1[7],P1[8],P1[9],     pw2[2]=PKW(P1,4), pw2[3]=PKW(P1,6), pw2); \
    VRD(3); SBAR(); GAPA(C0=__builtin_amdgcn_mfma_f32_32x32x16_bf16(kf[6],qr[3],C0,0,0,0),   P1[10],P1[11],P1[12],P1[13], pw3[0]=PKW(P1,8), pw3[1]=PKW(P1,10), pw3); \
    VRD(7); SBAR(); GAPA(C1=__builtin_amdgcn_mfma_f32_32x32x16_bf16(kf[7],qr[3],C1,0,0,0),   P1[14],P1[15],0.f,0.f,       pw3[2]=PKW(P1,12),pw3[3]=PKW(P1,14), pw3); \
    AUG(C0,C1,t); l_reg+=sacc; \
    if(GK){DMA_K((t)+3,sl_cur);} if(GV){DMA_V((t)+1,sl_next);} \
    CMASK(C0,C1,t); \
    { float a=MX3(C0[0],C0[1],C1[0]),b=MX3(C0[2],C0[3],C1[1]); a=MX3(a,C1[2],C1[3]); \
      _Pragma("unroll") for(int r=4;r<16;r+=4){a=MX3(a,C0[r],C0[r+1]);b=MX3(b,C0[r+2],C0[r+3]);a=MX3(a,C1[r],C1[r+1]);b=MX3(b,C1[r+2],C1[r+3]);} \
      float rm=__builtin_fmaxf(a,b); { auto rr=__builtin_amdgcn_permlane32_swap(__float_as_uint(rm),__float_as_uint(rm),false,false); rm=__builtin_fmaxf(__uint_as_float(rr[0]),__uint_as_float(rr[1])); } \
      resc=false; \
      if(__builtin_expect(__any(rm>(float)THRL),0)){ const float dl=__builtin_fmaxf(rm,0.f); mhat+=dl; \
        _Pragma("unroll") for(int r=0;r<16;++r){C0[r]-=dl;C1[r]-=dl;} \
        SETM(); \
        const float f=__builtin_amdgcn_exp2f(-dl); l_reg*=f; if(hi==0)wsf[r32]=f; resc=true; } } \
    SBAR(); \
    GAPB(o[0]=__builtin_amdgcn_mfma_f32_32x32x16_bf16(PAF(0),VFR(0),o[0],0,0,0), C0,0); \
    GAPB(o[1]=__builtin_amdgcn_mfma_f32_32x32x16_bf16(PAF(0),VFR(4),o[1],0,0,0), C0,4); \
    KRD(GL,0); GAPB(o[0]=__builtin_amdgcn_mfma_f32_32x32x16_bf16(PAF(1),VFR(1),o[0],0,0,0), C0,8); \
    KRD(GL,1); GAPB(o[1]=__builtin_amdgcn_mfma_f32_32x32x16_bf16(PAF(1),VFR(5),o[1],0,0,0), C0,12); \
    KRD(GL,2); GAPB(o[0]=__builtin_amdgcn_mfma_f32_32x32x16_bf16(PAF(2),VFR(2),o[0],0,0,0), C1,0); \
    KRD(GL,3); GAPB(o[1]=__builtin_amdgcn_mfma_f32_32x32x16_bf16(PAF(2),VFR(6),o[1],0,0,0), C1,4); \
    GAPB(o[0]=__builtin_amdgcn_mfma_f32_32x32x16_bf16(PAF(3),VFR(3),o[0],0,0,0), C1,8); \
    GAPB(o[1]=__builtin_amdgcn_mfma_f32_32x32x16_bf16(PAF(3),VFR(7),o[1],0,0,0), C1,12); \
    }while(0)
  int t=1;
  #undef CMASK
  #define CMASK(P0,P1,t) do{}while(0)
  for(;t+5<NT;t+=2){
    STEP(pB0,pB1,pA0,pA1,t,true,true,true);     WAIT_BAR(2); RESC(); ROT();
    STEP(pA0,pA1,pB0,pB1,t+1,true,true,true);   WAIT_BAR(2); RESC(); ROT();
  }
  #undef CMASK
  #define CMASK(P0,P1,t) do{int jb_=(t)-(NT-4); if(jb_>=0)cmask(P0,P1,jb_,qrel,hi);}while(0)
  #define ENDW(tt) do{ if((tt)+3<NT){WAIT_BAR(2);} else if((tt)+2<NT){WAIT_BAR(1);} else {WAIT_BAR(0);} }while(0)
  for(;t+1<NT;t+=2){
    STEP(pB0,pB1,pA0,pA1,t,(t+3<NT),(t+1<NT),(t+1<NT));       ENDW(t);   RESC(); ROT();
    STEP(pA0,pA1,pB0,pB1,t+1,(t+4<NT),(t+2<NT),(t+2<NT));     ENDW(t+1); RESC(); ROT();
  }
  STEP(pB0,pB1,pA0,pA1,NT-1,false,false,false); RESC();
  { float sacc=pB0[0]+pB0[1]; _Pragma("unroll") for(int r=2;r<16;++r)sacc+=pB0[r]; _Pragma("unroll") for(int r=0;r<16;++r)sacc+=pB1[r]; l_reg+=sacc;
    pw0=(u32x4){PKW(pB0,0),PKW(pB0,2),PKW(pB0,4),PKW(pB0,6)};pw1=(u32x4){PKW(pB0,8),PKW(pB0,10),PKW(pB0,12),PKW(pB0,14)};pw2=(u32x4){PKW(pB1,0),PKW(pB1,2),PKW(pB1,4),PKW(pB1,6)};pw3=(u32x4){PKW(pB1,8),PKW(pB1,10),PKW(pB1,12),PKW(pB1,14)};
    SBAR(); pv(o,vb0+sl_cur,PAF(0),PAF(1),PAF(2),PAF(3)); }
  #undef PKW
  #undef PAF
  #undef VFR
  #undef PIN
  #undef MX3
  #undef GAPA
  #undef GAPB
  #undef EX
  #undef VRD
  #undef KRD
  #undef STEP
  #undef ENDW
  {auto rr=__builtin_amdgcn_permlane32_swap(__float_as_uint(l_reg),__float_as_uint(l_reg),false,false);l_reg=__uint_as_float(rr[0])+__uint_as_float(rr[1]);}
  if(hi==0)wsf[32+r32]=l_reg;asm volatile("s_waitcnt lgkmcnt(0)":::"memory");
  float rli[16];
  #pragma unroll
  for(int r=0;r<16;++r)rli[r]=__builtin_amdgcn_rcpf(wsf[32+crow(r,hi)]);
  bf16*Ow=O+(rowbase+q0+wid*QBLK)*OPITCH+h*D;
  { bf16*stg=(bf16*)(shm+LDS_OST)+wid*2048;
    #pragma unroll
    for(int r=0;r<16;++r){const int orow=crow(r,hi);
      #pragma unroll
      for(int d0=0;d0<2;++d0)stg[orow*64+d0*32+r32]=__float2bfloat16(o[d0][r]*rli[r]);}
    asm volatile("s_waitcnt lgkmcnt(0)":::"memory");
    #pragma unroll
    for(int i=0;i<4;++i){const int row=i*8+(lane>>3),ch=lane&7; const u32x4 v=*(const u32x4*)(stg+row*64+ch*8); ATTN_STORE16(Ow+(long)row*OPITCH+ch*8,v);} }
  asm volatile("s_waitcnt lgkmcnt(0)\n\ts_barrier":::"memory");
  #undef DMA_K
  #undef DMA_V
  #undef CMASK
  #undef AUG
  #undef SETM
  #undef START
  #undef RESC
  #undef ROT
}
constexpr int ATTN_LDS_BYTES=LDS_BYTES;
#undef SBAR
#undef WAIT_BAR
}

namespace att {
template <bool CHECK> __device__ __forceinline__ void fox_unit_p(char* shm_g, LAS char* shm, int b, int h, int qb, const bf16_t* proj, const float* fb, float fbias_h, bf16_t* heads, unsigned* mism, bool do_scan) {
    const int tid = threadIdx.x, lane = tid & 63; const int wid = __builtin_amdgcn_readfirstlane(tid >> 6);
    if (do_scan) {
    LAS unsigned* biasw = (LAS unsigned*)(shm + attp::LDS_BIAS); LAS float* scan = (LAS float*)(shm + attp::LDS_SCAN);
    const int kend = (qb + 1) * 256;
    float v[4]; float s = 0.f;
#pragma unroll
    for (int i = 0; i < 4; ++i) { const int p = tid * 4 + i; float lf = 0.f; if (p < kend) lf = log_sigmoid_fast(fb[((size_t)b * SEQ + p) * 8 + h] + fbias_h); s += lf; v[i] = s; }
    float w = s;
#pragma unroll
    for (int o = 1; o < 64; o <<= 1) { const float t = __shfl_up(w, o); if (lane >= o) w += t; }
    if (lane == 63) scan[wid] = w;
    asm volatile("s_waitcnt lgkmcnt(0)\n\ts_barrier" ::: "memory");
    float off = w - s;
    for (int k = 0; k < 8; ++k) if (k < wid) off += scan[k];
#pragma unroll
    for (int i = 0; i < 4; ++i) { const float bv = -(v[i] + off) * LOG2E; const unsigned hb = cvt_pk_bf16(bv, 0.f) & 0xffffu; const unsigned lb = cvt_pk_bf16(bv - __uint_as_float(hb << 16), 0.f) & 0xffffu; biasw[tid * 4 + i] = hb | (lb << 16); }
    asm volatile("s_waitcnt vmcnt(0) lgkmcnt(0)\n\ts_barrier" ::: "memory");
    }
    attp::attn_unit<8, CHECK>(b, h, qb, (const attp::bf16*)(proj + 768), (const attp::bf16*)(proj + 1280), (const attp::bf16*)(proj + 1792), (attp::bf16*)(heads + 512), shm_g, mism);
    asm volatile("s_waitcnt vmcnt(0)" ::: "memory");
}
}
namespace mx {
using namespace mk;
constexpr size_t WS_QD = WS_XN, WS_KI = WS_XN + 16 * MiB, WS_DTV = 456 * MiB, WS_ACS = 457 * MiB, WS_KE = 458 * MiB, WS_DEC = 474 * MiB;
constexpr int XROW = 144;
__device__ __forceinline__ s16x4 tr_read(unsigned addr) { s16x4 r; asm volatile("ds_read_b64_tr_b16 %0, %1" : "=v"(r) : "v"(addr) : "memory"); return r; }
template <int OFF> __device__ __forceinline__ s16x4 tr_read_o(unsigned addr) { s16x4 r; asm volatile("ds_read_b64_tr_b16 %0, %1 offset:%2" : "=v"(r) : "v"(addr), "i"(OFF) : "memory"); return r; }
#define MX_LGKM0() do { asm volatile("s_waitcnt lgkmcnt(0)" ::: "memory"); __builtin_amdgcn_sched_barrier(0); } while (0)
#define MX_BAR() asm volatile("s_waitcnt vmcnt(0) lgkmcnt(0)\n\ts_barrier" ::: "memory")
#define MX_BAR_L() asm volatile("s_waitcnt lgkmcnt(0)\n\ts_barrier" ::: "memory")
__device__ __forceinline__ bf16x8 cat8(s16x4 lo, s16x4 hi) { return (bf16x8){lo[0], lo[1], lo[2], lo[3], hi[0], hi[1], hi[2], hi[3]}; }
__device__ __forceinline__ unsigned sw256(int row, int ch) { return (unsigned)(row * 256 + ((ch ^ (row & 15)) << 4)); }

__device__ __forceinline__ void prep_conv(const bf16_t* PROJ, bf16_t* CONV, const float* conv_w, const float* conv_b, int vcu, int G, int tid) {
    for (int item = vcu * NTHR + tid; item < (T / 16) * 192; item += G * NTHR) {
        const int cg = item % 192, rb = item / 192, ch0 = cg * 8, row0 = rb * 16, t0 = row0 & (SEQ - 1);
        float w[4][8], bs[8], xw[3][8];
#pragma unroll
        for (int j = 0; j < 4; ++j) { const f32x4 a = *(const f32x4*)(conv_w + j * 1536 + ch0), b = *(const f32x4*)(conv_w + j * 1536 + ch0 + 4);
#pragma unroll
            for (int i = 0; i < 4; ++i) { w[j][i] = a[i]; w[j][4 + i] = b[i]; } }
        { const f32x4 a = *(const f32x4*)(conv_b + ch0), b = *(const f32x4*)(conv_b + ch0 + 4);
#pragma unroll
          for (int i = 0; i < 4; ++i) { bs[i] = a[i]; bs[4 + i] = b[i]; } }
#pragma unroll
        for (int j = 0; j < 3; ++j) { const int tt = t0 - 3 + j;
            u32x4 v = {0u, 0u, 0u, 0u}; if (tt >= 0) v = *(const u32x4*)(PROJ + (size_t)(row0 - 3 + j) * NO_IN + 1024 + ch0);
#pragma unroll
            for (int i = 0; i < 4; ++i) { xw[j][2 * i] = __uint_as_float(v[i] << 16); xw[j][2 * i + 1] = __uint_as_float(v[i] & 0xffff0000u); } }
#pragma unroll 4
        for (int r = 0; r < 16; ++r) {
            const u32x4 v = __builtin_nontemporal_load((const u32x4*)(PROJ + (size_t)(row0 + r) * NO_IN + 1024 + ch0));
            float x3[8], o[8];
#pragma unroll
            for (int i = 0; i < 4; ++i) { x3[2 * i] = __uint_as_float(v[i] << 16); x3[2 * i + 1] = __uint_as_float(v[i] & 0xffff0000u); }
#pragma unroll
            for (int i = 0; i < 8; ++i) { const float a = bs[i] + w[0][i] * xw[0][i] + w[1][i] * xw[1][i] + w[2][i] * xw[2][i] + w[3][i] * x3[i]; o[i] = siluf(a);
                xw[0][i] = xw[1][i]; xw[1][i] = xw[2][i]; xw[2][i] = x3[i]; }
            u32x4 ov; ov.x = cvt_pk_bf16(o[0], o[1]); ov.y = cvt_pk_bf16(o[2], o[3]); ov.z = cvt_pk_bf16(o[4], o[5]); ov.w = cvt_pk_bf16(o[6], o[7]);
            *(u32x4*)(CONV + (size_t)(row0 + r) * 1536 + ch0) = ov;
        }
    }
}
__device__ __forceinline__ void prep_ssd(const float* DTG, float* DTV, float* ACS, const float* dt_bias, const float* a_log, int vcu, int G, int lane, int wave) {
    const int gw = vcu * NWAVES + wave, ngw = G * NWAVES;
    for (int item = gw; item < NBATCH * 32 * 16; item += ngw) {
        const int h = item & 15, c = (item >> 4) & 31, b = item >> 9; const size_t r0 = (size_t)b * SEQ + c * 64 + lane;
        const float a = -expf(a_log[h]), db = dt_bias[h];
        const float d0 = softplusf(DTG[r0 * 32 + h] + db);
        float w = a * d0;
#pragma unroll
        for (int o = 1; o < 64; o <<= 1) { const float t = __shfl_up(w, o); if (lane >= o) w += t; }
        ACS[r0 * 16 + h] = w; DTV[r0 * 16 + h] = d0;
    }
}
__device__ __forceinline__ void prep_gla(const bf16_t* PROJ, const float* DTG, bf16_t* QD, bf16_t* KI, bf16_t* KE, float* DEC, const float* gk_w, const float* gk_b, int vcu, int G, int tid, int lane, int wave, LAS char* shm) {
    {
        LAS float* gl = (LAS float*)(shm);
        LAS float* tot = (LAS float*)(shm + 8192);
        const int half = wave >> 2, rq = wave & 3, t256 = tid & 255;
        for (int pair = vcu; pair < NBATCH * 32 * 4 / 2; pair += G) {
            const int item = pair * 2 + half; const int h = item & 3, c = (item >> 2) & 31, b = item >> 7; const size_t r0 = (size_t)b * SEQ + c * 64;
            unsigned short qv[16][2], kv[16][2];
#pragma unroll
            for (int r = 0; r < 16; ++r) { const bf16_t* pr = PROJ + (r0 + rq * 16 + r) * NO_IN;
                qv[r][0] = pr[2560 + h * 128 + lane]; qv[r][1] = pr[2560 + h * 128 + 64 + lane]; kv[r][0] = pr[3072 + h * 128 + lane]; kv[r][1] = pr[3072 + h * 128 + 64 + lane]; }
            float w0[16], w1[16];
#pragma unroll
            for (int j = 0; j < 16; ++j) { w0[j] = gk_w[j * 512 + h * 128 + lane]; w1[j] = gk_w[j * 512 + h * 128 + 64 + lane]; }
            const float b0 = gk_b[h * 128 + lane], b1 = gk_b[h * 128 + 64 + lane];
            { const int rr = t256 >> 2, q4 = t256 & 3; *(LAS f32x4*)(gl + half * 1024 + rr * 16 + q4 * 4) = *(const f32x4*)(DTG + (r0 + rr) * 32 + 16 + q4 * 4); }
            asm volatile("s_waitcnt vmcnt(0) lgkmcnt(0)\n\ts_barrier" ::: "memory");
            float c0[16], c1[16]; float run0 = 0.f, run1 = 0.f;
#pragma unroll
            for (int r = 0; r < 16; ++r) {
                const LAS f32x4* gp = (const LAS f32x4*)(gl + half * 1024 + (rq * 16 + r) * 16); float a0 = b0, a1 = b1;
#pragma unroll
                for (int q = 0; q < 4; ++q) { const f32x4 g = gp[q];
#pragma unroll
                    for (int i = 0; i < 4; ++i) { a0 += g[i] * w0[4 * q + i]; a1 += g[i] * w1[4 * q + i]; } }
                run0 += log_sigmoid_fast(a0) * (1.f / 16.f); run1 += log_sigmoid_fast(a1) * (1.f / 16.f); c0[r] = run0; c1[r] = run1;
            }
            tot[(half * 4 + rq) * 128 + lane] = run0; tot[(half * 4 + rq) * 128 + 64 + lane] = run1;
            asm volatile("s_waitcnt lgkmcnt(0)\n\ts_barrier" ::: "memory");
            float pre0 = 0.f, pre1 = 0.f, last0 = 0.f, last1 = 0.f;
#pragma unroll
            for (int q = 0; q < 4; ++q) { const float t0 = tot[(half * 4 + q) * 128 + lane], t1 = tot[(half * 4 + q) * 128 + 64 + lane]; if (q < rq) { pre0 += t0; pre1 += t1; } last0 += t0; last1 += t1; }
            const float scale = 0.08838834764831845f;
#pragma unroll
            for (int r = 0; r < 16; ++r) {
                const float g0 = pre0 + c0[r], g1 = pre1 + c1[r];
                const float q0 = bf2f(qv[r][0]), q1 = bf2f(qv[r][1]), k0 = bf2f(kv[r][0]), k1 = bf2f(kv[r][1]);
                const size_t o = (r0 + rq * 16 + r) * 512 + h * 128 + lane;
                QD[o] = (bf16_t)(cvt_pk_bf16(q0 * scale * __expf(g0), 0.f) & 0xffffu); QD[o + 64] = (bf16_t)(cvt_pk_bf16(q1 * scale * __expf(g1), 0.f) & 0xffffu);
                KI[o] = (bf16_t)(cvt_pk_bf16(k0 * __expf(-g0), 0.f) & 0xffffu); KI[o + 64] = (bf16_t)(cvt_pk_bf16(k1 * __expf(-g1), 0.f) & 0xffffu);
            }
            if (rq == 0) { DEC[((size_t)b * 32 + c) * 512 + h * 128 + lane] = __expf(last0); DEC[((size_t)b * 32 + c) * 512 + h * 128 + 64 + lane] = __expf(last1); }
            asm volatile("s_waitcnt lgkmcnt(0)\n\ts_barrier" ::: "memory");
        }
    }
}

constexpr int S_C = 0, S_B = 32768, S_X = 65536, S_XW = S_X + 128 * XROW, S_PREV = S_XW + 128 * XROW, S_ACS = S_PREV + 16384, S_DT = S_ACS + 512, S_YST = S_DT + 512, S_END = S_YST + 8 * 2304;
static_assert(S_END <= RING_BYTES, "SSD LDS");
__device__ __forceinline__ void ssd_unit(LAS char* shm, int b, int h, const bf16_t* CONV, const float* ACS, const float* DTV, float dsk, bf16_t* MIX) {
    const int tid = threadIdx.x, lane = tid & 63, fr = lane & 15, fq = lane >> 4; const int w = __builtin_amdgcn_readfirstlane(tid >> 6);
    const int g = h >> 3, row = tid >> 2, qd = tid & 3, l0 = 16 * w;
    const unsigned lds0 = (unsigned)(uintptr_t)shm;
    LAS float* acsl = (LAS float*)(shm + S_ACS); LAS float* dtl = (LAS float*)(shm + S_DT);
    f32x4 st[4];
#pragma unroll
    for (int i = 0; i < 4; ++i) st[i] = (f32x4){0.f, 0.f, 0.f, 0.f};
    u32x4 rc[4], rb[4], rx[2]; float racs, rdt, rend;
    const size_t seq0 = (size_t)b * SEQ;
#define SSD_LOAD(c) do { const size_t gr = seq0 + (size_t)(c) * 128 + row; const bf16_t* p = CONV + gr * 1536; \
        _Pragma("unroll") for (int i = 0; i < 4; ++i) { rc[i] = *(const u32x4*)(p + 1280 + g * 128 + qd * 32 + 8 * i); rb[i] = *(const u32x4*)(p + 1024 + g * 128 + qd * 32 + 8 * i); } \
        _Pragma("unroll") for (int i = 0; i < 2; ++i) rx[i] = *(const u32x4*)(p + h * 64 + qd * 16 + 8 * i); \
        racs = ACS[gr * 16 + h]; rdt = DTV[gr * 16 + h]; rend = ACS[(seq0 + (size_t)(c) * 128 + 127) * 16 + h]; } while (0)
#ifdef SSD_DUMMY
    SSD_LOAD(0);
    for (int c = 0; c < 16; ++c) {
#pragma unroll
        for (int i = 0; i < 4; ++i) { *(LAS u32x4*)(shm + S_C + sw256(row, qd * 4 + i)) = rc[i]; *(LAS u32x4*)(shm + S_B + sw256(row, qd * 4 + i)) = rb[i]; }
        const float wr = rdt * __expf(rend - racs);
#pragma unroll
        for (int i = 0; i < 2; ++i) { *(LAS u32x4*)(shm + S_X + row * XROW + qd * 32 + 16 * i) = rx[i];
            u32x4 o;
#pragma unroll
            for (int k = 0; k < 4; ++k) o[k] = cvt_pk_bf16(__uint_as_float(rx[i][k] << 16) * wr, __uint_as_float(rx[i][k] & 0xffff0000u) * wr);
            *(LAS u32x4*)(shm + S_XW + row * XROW + qd * 32 + 16 * i) = o; }
        if (qd == 0) { acsl[row] = racs; dtl[row] = rdt; }
        MX_BAR_L();
        if (c + 1 < 16) SSD_LOAD(c + 1);
        MX_BAR_L();
    }
#endif
#ifndef SSD_NOPREF
    SSD_LOAD(0);
#endif
    const unsigned xtr = lds0 + (unsigned)(((lane & 15) >> 2) * XROW + (lane & 3) * 8);
    for (int c = 0; c < 16; ++c) {
#ifdef SSD_NOPREF
        SSD_LOAD(c);
#endif
#ifdef SSD_REP_WR
        for (int rep_ = 0; rep_ < 2; ++rep_)
#endif
        {
#pragma unroll
            for (int i = 0; i < 4; ++i) { *(LAS u32x4*)(shm + S_C + sw256(row, qd * 4 + i)) = rc[i]; *(LAS u32x4*)(shm + S_B + sw256(row, qd * 4 + i)) = rb[i]; }
            const float wr = rdt * __expf(rend - racs);
#pragma unroll
            for (int i = 0; i < 2; ++i) { *(LAS u32x4*)(shm + S_X + row * XROW + qd * 32 + 16 * i) = rx[i];
                u32x4 o;
#pragma unroll
                for (int k = 0; k < 4; ++k) o[k] = cvt_pk_bf16(__uint_as_float(rx[i][k] << 16) * wr, __uint_as_float(rx[i][k] & 0xffff0000u) * wr);
                *(LAS u32x4*)(shm + S_XW + row * XROW + qd * 32 + 16 * i) = o; }
            if (qd == 0) { acsl[row] = racs; dtl[row] = rdt; }
#pragma unroll
            for (int pt = 0; pt < 4; ++pt) { u32x2 v; v.x = cvt_pk_bf16(st[pt][0], st[pt][1]); v.y = cvt_pk_bf16(st[pt][2], st[pt][3]);
                const int p = 16 * pt + fr; *(LAS u32x2*)(shm + S_PREV + sw256(p, 2 * w + (fq >> 1)) + (fq & 1) * 8) = v; }
        }
        MX_BAR_L();
#ifndef SSD_NOPREF
        if (c + 1 < 16) SSD_LOAD(c + 1);
#endif
        bf16x8 cf[4];
#pragma unroll
        for (int ks = 0; ks < 4; ++ks) cf[ks] = *(const LAS bf16x8*)(shm + S_C + sw256(l0 + fr, 4 * ks + fq));
        f32x4 yd[4], yo[4];
#pragma unroll
        for (int i = 0; i < 4; ++i) { yd[i] = (f32x4){0.f, 0.f, 0.f, 0.f}; yo[i] = (f32x4){0.f, 0.f, 0.f, 0.f}; }
        const float acs_l = acsl[l0 + fr]; const int lcol = l0 + fr;
        const int nsb = (w >> 1) + 1;
#ifdef SSD_REP_SB
        for (int rep_ = 0; rep_ < 2; ++rep_) {
#pragma unroll
        for (int i = 0; i < 4; ++i) yd[i] = (f32x4){0.f, 0.f, 0.f, 0.f};
#endif
        for (int sb = 0; sb < nsb; ++sb) {
            const int s0 = 32 * sb; const bool two = (2 * sb + 1) <= w;
            s16x4 lo[4], hi[4];
#pragma unroll
            for (int pt = 0; pt < 4; ++pt) { lo[pt] = tr_read(xtr + S_X + (unsigned)((s0 + 4 * fq) * XROW + pt * 32)); hi[pt] = tr_read(xtr + S_X + (unsigned)((s0 + 16 + 4 * fq) * XROW + pt * 32)); }
            f32x4 a0 = {0.f, 0.f, 0.f, 0.f}, a1 = {0.f, 0.f, 0.f, 0.f};
#pragma unroll
            for (int ks = 0; ks < 4; ++ks) { const bf16x8 bf = *(const LAS bf16x8*)(shm + S_B + sw256(s0 + fr, 4 * ks + fq)); a0 = __builtin_amdgcn_mfma_f32_16x16x32_bf16(bf, cf[ks], a0, 0, 0, 0); }
            if (two) {
#pragma unroll
                for (int ks = 0; ks < 4; ++ks) { const bf16x8 bf = *(const LAS bf16x8*)(shm + S_B + sw256(s0 + 16 + fr, 4 * ks + fq)); a1 = __builtin_amdgcn_mfma_f32_16x16x32_bf16(bf, cf[ks], a1, 0, 0, 0); }
            }
            const f32x4 as0 = *(const LAS f32x4*)(acsl + s0 + 4 * fq), as1 = *(const LAS f32x4*)(acsl + s0 + 16 + 4 * fq);
            const f32x4 dq0 = *(const LAS f32x4*)(dtl + s0 + 4 * fq), dq1 = *(const LAS f32x4*)(dtl + s0 + 16 + 4 * fq);
            float g0[4], g1[4];
#pragma unroll
            for (int i = 0; i < 4; ++i) { const int sa = s0 + 4 * fq + i, sb2 = sa + 16;
                g0[i] = (sa <= lcol) ? a0[i] * __expf(fminf(acs_l - as0[i], 0.f)) * dq0[i] : 0.f;
                g1[i] = (two && sb2 <= lcol) ? a1[i] * __expf(fminf(acs_l - as1[i], 0.f)) * dq1[i] : 0.f; }
            u32x4 ap; ap.x = cvt_pk_bf16(g0[0], g0[1]); ap.y = cvt_pk_bf16(g0[2], g0[3]); ap.z = cvt_pk_bf16(g1[0], g1[1]); ap.w = cvt_pk_bf16(g1[2], g1[3]);
            const bf16x8 af = __builtin_bit_cast(bf16x8, ap);
            MX_LGKM0();
#pragma unroll
            for (int pt = 0; pt < 4; ++pt) yd[pt] = __builtin_amdgcn_mfma_f32_16x16x32_bf16(af, cat8(lo[pt], hi[pt]), yd[pt], 0, 0, 0);
        }
#ifdef SSD_REP_SB
        }
#endif
#ifdef SSD_REP_YO
        for (int rep_ = 0; rep_ < 2; ++rep_) {
#pragma unroll
        for (int i = 0; i < 4; ++i) yo[i] = (f32x4){0.f, 0.f, 0.f, 0.f};
#endif
#pragma unroll
        for (int pt = 0; pt < 4; ++pt)
#pragma unroll
            for (int ks = 0; ks < 4; ++ks) { const bf16x8 pf = *(const LAS bf16x8*)(shm + S_PREV + sw256(16 * pt + fr, 4 * ks + fq)); yo[pt] = __builtin_amdgcn_mfma_f32_16x16x32_bf16(cf[ks], pf, yo[pt], 0, 0, 0); }
#ifdef SSD_REP_YO
        }
#endif
#ifdef SSD_REP_CS
        for (int rep_ = 0; rep_ < 2; ++rep_)
#endif
        {
            const f32x4 al = *(const LAS f32x4*)(acsl + l0 + 4 * fq);
            float ea[4];
#pragma unroll
            for (int i = 0; i < 4; ++i) ea[i] = __expf(al[i]);
            s16x4 xs[4];
#pragma unroll
            for (int pt = 0; pt < 4; ++pt) xs[pt] = tr_read(xtr + S_X + (unsigned)((l0 + 4 * fq) * XROW + pt * 32));
            MX_LGKM0();
            LAS bf16_t* yst = (LAS bf16_t*)(shm + S_YST + w * 2304);
#pragma unroll
            for (int pt = 0; pt < 4; ++pt)
#pragma unroll
                for (int i = 0; i < 4; ++i) { const float y = yd[pt][i] + ea[i] * yo[pt][i] + dsk * bf2f((unsigned short)xs[pt][i]);
                    yst[(4 * fq + i) * 72 + pt * 16 + fr] = (bf16_t)(cvt_pk_bf16(y, 0.f) & 0xffffu); }
            asm volatile("s_waitcnt lgkmcnt(0)" ::: "memory");
            bf16_t* yp = MIX + (seq0 + (size_t)c * 128 + l0) * 2048 + h * 64;
#pragma unroll
            for (int j = 0; j < 2; ++j) { const int rr = (lane >> 3) + 8 * j, ch = lane & 7; const u32x4 v = *(const LAS u32x4*)(yst + rr * 72 + ch * 8); *(u32x4*)(yp + (size_t)rr * 2048 + ch * 8) = v; }
        }
#ifdef SSD_REP_ST
        f32x4 stsave[4];
#pragma unroll
        for (int i = 0; i < 4; ++i) stsave[i] = st[i];
        for (int rep_ = 0; rep_ < 2; ++rep_) {
#pragma unroll
        for (int i = 0; i < 4; ++i) st[i] = stsave[i];
#endif
        {
            const float cd = __expf(acsl[127]);
#pragma unroll
            for (int pt = 0; pt < 4; ++pt) st[pt] = st[pt] * cd;
#pragma unroll
            for (int ks = 0; ks < 4; ++ks) {
                const int s0 = 32 * ks, q = (lane & 15) >> 2, p = lane & 3;
                const int r1 = s0 + 8 * fq + q, r2 = r1 + 4;
                const s16x4 alo = tr_read(lds0 + S_B + sw256(r1, 2 * w + (p >> 1)) + (p & 1) * 8), ahi = tr_read(lds0 + S_B + sw256(r2, 2 * w + (p >> 1)) + (p & 1) * 8);
                s16x4 lo[4], hi[4];
#pragma unroll
                for (int pt = 0; pt < 4; ++pt) { lo[pt] = tr_read(xtr + S_XW + (unsigned)((s0 + 8 * fq) * XROW + pt * 32)); hi[pt] = tr_read(xtr + S_XW + (unsigned)((s0 + 8 * fq + 4) * XROW + pt * 32)); }
                MX_LGKM0();
                const bf16x8 af = cat8(alo, ahi);
#pragma unroll
                for (int pt = 0; pt < 4; ++pt) st[pt] = __builtin_amdgcn_mfma_f32_16x16x32_bf16(af, cat8(lo[pt], hi[pt]), st[pt], 0, 0, 0);
            }
        }
#ifdef SSD_REP_ST
        }
#endif
        MX_BAR_L();
    }
    asm volatile("s_waitcnt vmcnt(0)" ::: "memory");
#undef SSD_LOAD
}

constexpr int S2_C = 0, S2_B = 16384, S2_X = 32768, S2_XW = S2_X + 64 * XROW, S2_ACS = S2_XW + 64 * XROW, S2_DT = S2_ACS + 256, S2_BUF = 53248, S2_PREV = 2 * S2_BUF, S2_END = S2_PREV + 2 * 16384;
static_assert(S2_DT + 256 <= S2_BUF && S2_END <= RING_BYTES, "SSD64 LDS");
__device__ __forceinline__ void ssd_unit64(LAS char* shm, int b, int h, const bf16_t* CONV, const float* ACS, const float* DTV, float dsk, bf16_t* MIX) {
    const int tid = threadIdx.x, lane = tid & 63, fr = lane & 15, fq = lane >> 4; const int w = __builtin_amdgcn_readfirstlane(tid >> 6);
    const int g = h >> 3, row = tid >> 3, ec = tid & 7, lt = w >> 1, l0 = 16 * lt, pt0 = 2 * (w & 1);
    const unsigned lds0 = (unsigned)(uintptr_t)shm;
    f32x4 st[4];
#pragma unroll
    for (int i = 0; i < 4; ++i) st[i] = (f32x4){0.f, 0.f, 0.f, 0.f};
    u32x4 rc[2], rb[2], rx; float racs, rdt, rend;
    const size_t seq0 = (size_t)b * SEQ;
#define S2_LOAD(c) do { const size_t gr = seq0 + (size_t)(c) * 64 + row; const bf16_t* p = CONV + gr * 1536; \
        _Pragma("unroll") for (int i = 0; i < 2; ++i) { rc[i] = *(const u32x4*)(p + 1280 + g * 128 + ec * 16 + 8 * i); rb[i] = *(const u32x4*)(p + 1024 + g * 128 + ec * 16 + 8 * i); } \
        rx = *(const u32x4*)(p + h * 64 + ec * 8); \
        racs = ACS[gr * 16 + h]; rdt = DTV[gr * 16 + h]; rend = ACS[(seq0 + (size_t)(c) * 64 + 63) * 16 + h]; } while (0)
#define S2_WRITE(pb) do { LAS char* gb_ = shm + (pb) * S2_BUF; \
        _Pragma("unroll") for (int i = 0; i < 2; ++i) { *(LAS u32x4*)(gb_ + S2_C + sw256(row, ec * 2 + i)) = rc[i]; *(LAS u32x4*)(gb_ + S2_B + sw256(row, ec * 2 + i)) = rb[i]; } \
        *(LAS u32x4*)(gb_ + S2_X + row * XROW + ec * 16) = rx; \
        { const float wr_ = rdt * __expf(rend - racs); u32x4 o_; \
          _Pragma("unroll") for (int k = 0; k < 4; ++k) o_[k] = cvt_pk_bf16(__uint_as_float(rx[k] << 16) * wr_, __uint_as_float(rx[k] & 0xffff0000u) * wr_); \
          *(LAS u32x4*)(gb_ + S2_XW + row * XROW + ec * 16) = o_; } \
        if (ec == 0) { ((LAS float*)(gb_ + S2_ACS))[row] = racs; ((LAS float*)(gb_ + S2_DT))[row] = rdt; } \
        _Pragma("unroll") for (int pt = 0; pt < 4; ++pt) { u32x2 v; v.x = cvt_pk_bf16(st[pt][0], st[pt][1]); v.y = cvt_pk_bf16(st[pt][2], st[pt][3]); \
            const int p_ = 16 * pt + fr; *(LAS u32x2*)(shm + S2_PREV + (pb) * 16384 + sw256(p_, 2 * w + (fq >> 1)) + (fq & 1) * 8) = v; } } while (0)
    S2_LOAD(0);
    S2_WRITE(0);
    MX_BAR_L();
    unsigned swz[4];
#pragma unroll
    for (int ks = 0; ks < 4; ++ks) swz[ks] = (unsigned)(fr * 256 + (((4 * ks + fq) ^ fr) << 4));
    const int q_ = (lane & 15) >> 2, p_ = lane & 3;
    const unsigned xq4 = (unsigned)((4 * fq + q_) * XROW + p_ * 8), xq8 = (unsigned)((8 * fq + q_) * XROW + p_ * 8);
    const int ra = 8 * fq + q_, rb2 = ra + 4;
    const unsigned bt1 = (unsigned)(ra * 256 + (((2 * w + (p_ >> 1)) ^ (ra & 15)) << 4) + (p_ & 1) * 8), bt2 = (unsigned)(rb2 * 256 + (((2 * w + (p_ >> 1)) ^ (rb2 & 15)) << 4) + (p_ & 1) * 8);
    for (int c = 0; c < 32; ++c) {
        const int pb = c & 1; LAS char* gb = shm + pb * S2_BUF; const unsigned gba = lds0 + (unsigned)(pb * S2_BUF);
        const LAS float* acsl = (const LAS float*)(gb + S2_ACS); const LAS float* dtl = (const LAS float*)(gb + S2_DT);
        if (c + 1 < 32) S2_LOAD(c + 1);
        const LAS char* cbp[4]; const LAS char* pvp[4];
#pragma unroll
        for (int ks = 0; ks < 4; ++ks) { cbp[ks] = gb + swz[ks]; pvp[ks] = shm + S2_PREV + pb * 16384 + pt0 * 4096 + swz[ks]; }
        const unsigned xa4 = gba + xq4 + (unsigned)(pt0 * 32), xa8 = gba + xq8, ba1 = gba + bt1, ba2 = gba + bt2;
        bf16x8 cf[4];
#pragma unroll
        for (int ks = 0; ks < 4; ++ks) cf[ks] = *(const LAS bf16x8*)(cbp[ks] + S2_C + l0 * 256);
        f32x4 yd[2], yo[2];
#pragma unroll
        for (int i = 0; i < 2; ++i) { yd[i] = (f32x4){0.f, 0.f, 0.f, 0.f}; yo[i] = (f32x4){0.f, 0.f, 0.f, 0.f}; }
        const float acs_l = acsl[l0 + fr]; const int lcol = l0 + fr;
#pragma unroll
        for (int sb = 0; sb < 2; ++sb) if (2 * sb <= lt) {
            constexpr int dummy = 0; (void)dummy;
            const int s0 = 32 * sb; const bool two = (2 * sb + 1) <= lt;
            s16x4 lo[2], hi[2];
            if (sb == 0) { lo[0] = tr_read_o<S2_X>(xa4); lo[1] = tr_read_o<S2_X + 32>(xa4); hi[0] = tr_read_o<S2_X + 16 * XROW>(xa4); hi[1] = tr_read_o<S2_X + 16 * XROW + 32>(xa4); }
            else         { lo[0] = tr_read_o<S2_X + 32 * XROW>(xa4); lo[1] = tr_read_o<S2_X + 32 * XROW + 32>(xa4); hi[0] = tr_read_o<S2_X + 48 * XROW>(xa4); hi[1] = tr_read_o<S2_X + 48 * XROW + 32>(xa4); }
            f32x4 a0 = {0.f, 0.f, 0.f, 0.f}, a1 = {0.f, 0.f, 0.f, 0.f};
#pragma unroll
            for (int ks = 0; ks < 4; ++ks) { const bf16x8 bf = *(const LAS bf16x8*)(cbp[ks] + S2_B + s0 * 256); a0 = __builtin_amdgcn_mfma_f32_16x16x32_bf16(bf, cf[ks], a0, 0, 0, 0); }
            if (two) {
#pragma unroll
                for (int ks = 0; ks < 4; ++ks) { const bf16x8 bf = *(const LAS bf16x8*)(cbp[ks] + S2_B + (s0 + 16) * 256); a1 = __builtin_amdgcn_mfma_f32_16x16x32_bf16(bf, cf[ks], a1, 0, 0, 0); }
            }
            const f32x4 as0 = *(const LAS f32x4*)(acsl + s0 + 4 * fq), as1 = *(const LAS f32x4*)(acsl + s0 + 16 + 4 * fq);
            const f32x4 dq0 = *(const LAS f32x4*)(dtl + s0 + 4 * fq), dq1 = *(const LAS f32x4*)(dtl + s0 + 16 + 4 * fq);
            float g0[4], g1[4];
#pragma unroll
            for (int i = 0; i < 4; ++i) { g0[i] = a0[i] * __expf(acs_l - as0[i]) * dq0[i]; g1[i] = a1[i] * __expf(acs_l - as1[i]) * dq1[i]; }
            if (2 * sb == lt) {
#pragma unroll
                for (int i = 0; i < 4; ++i) { if (s0 + 4 * fq + i > lcol) g0[i] = 0.f; }
            }
            if (!two) {
#pragma unroll
                for (int i = 0; i < 4; ++i) g1[i] = 0.f;
            } else if (2 * sb + 1 == lt) {
#pragma unroll
                for (int i = 0; i < 4; ++i) { if (s0 + 16 + 4 * fq + i > lcol) g1[i] = 0.f; }
            }
            u32x4 ap; ap.x = cvt_pk_bf16(g0[0], g0[1]); ap.y = cvt_pk_bf16(g0[2], g0[3]); ap.z = cvt_pk_bf16(g1[0], g1[1]); ap.w = cvt_pk_bf16(g1[2], g1[3]);
            const bf16x8 af = __builtin_bit_cast(bf16x8, ap);
            MX_LGKM0();
#pragma unroll
            for (int vi = 0; vi < 2; ++vi) yd[vi] = __builtin_amdgcn_mfma_f32_16x16x32_bf16(af, cat8(lo[vi], hi[vi]), yd[vi], 0, 0, 0);
        }
#pragma unroll
        for (int vi = 0; vi < 2; ++vi)
#pragma unroll
            for (int ks = 0; ks < 4; ++ks) { const bf16x8 pf = *(const LAS bf16x8*)(pvp[ks] + vi * 4096); yo[vi] = __builtin_amdgcn_mfma_f32_16x16x32_bf16(cf[ks], pf, yo[vi], 0, 0, 0); }
        {
            const f32x4 al = *(const LAS f32x4*)(acsl + l0 + 4 * fq);
            float ea[4];
#pragma unroll
            for (int i = 0; i < 4; ++i) ea[i] = __expf(al[i]);
            const unsigned xl = xa4 + (unsigned)(l0 * XROW);
            s16x4 xs[2]; xs[0] = tr_read_o<S2_X>(xl); xs[1] = tr_read_o<S2_X + 32>(xl);
            MX_LGKM0();
            bf16_t* yp = MIX + (seq0 + (size_t)c * 64 + l0 + 4 * fq) * 2048 + h * 64 + pt0 * 16 + fr;
#pragma unroll
            for (int vi = 0; vi < 2; ++vi)
#pragma unroll
                for (int i = 0; i < 4; ++i) { const float y = yd[vi][i] + ea[i] * yo[vi][i] + dsk * bf2f((unsigned short)xs[vi][i]);
                    yp[(size_t)i * 2048 + vi * 16] = (bf16_t)(cvt_pk_bf16(y, 0.f) & 0xffffu); }
        }
        {
            const float cd = __expf(acsl[63]);
#pragma unroll
            for (int pt = 0; pt < 4; ++pt) st[pt] = st[pt] * cd;
            {   s16x4 lo[4], hi[4];
                const s16x4 alo = tr_read_o<S2_B>(ba1), ahi = tr_read_o<S2_B>(ba2);
                lo[0] = tr_read_o<S2_XW>(xa8); lo[1] = tr_read_o<S2_XW + 32>(xa8); lo[2] = tr_read_o<S2_XW + 64>(xa8); lo[3] = tr_read_o<S2_XW + 96>(xa8);
                hi[0] = tr_read_o<S2_XW + 4 * XROW>(xa8); hi[1] = tr_read_o<S2_XW + 4 * XROW + 32>(xa8); hi[2] = tr_read_o<S2_XW + 4 * XROW + 64>(xa8); hi[3] = tr_read_o<S2_XW + 4 * XROW + 96>(xa8);
                MX_LGKM0();
                const bf16x8 af = cat8(alo, ahi);
#pragma unroll
                for (int pt = 0; pt < 4; ++pt) st[pt] = __builtin_amdgcn_mfma_f32_16x16x32_bf16(af, cat8(lo[pt], hi[pt]), st[pt], 0, 0, 0); }
            {   s16x4 lo[4], hi[4];
                const s16x4 alo = tr_read_o<S2_B + 32 * 256>(ba1), ahi = tr_read_o<S2_B + 32 * 256>(ba2);
                lo[0] = tr_read_o<S2_XW + 32 * XROW>(xa8); lo[1] = tr_read_o<S2_XW + 32 * XROW + 32>(xa8); lo[2] = tr_read_o<S2_XW + 32 * XROW + 64>(xa8); lo[3] = tr_read_o<S2_XW + 32 * XROW + 96>(xa8);
                hi[0] = tr_read_o<S2_XW + 36 * XROW>(xa8); hi[1] = tr_read_o<S2_XW + 36 * XROW + 32>(xa8); hi[2] = tr_read_o<S2_XW + 36 * XROW + 64>(xa8); hi[3] = tr_read_o<S2_XW + 36 * XROW + 96>(xa8);
                MX_LGKM0();
                const bf16x8 af = cat8(alo, ahi);
#pragma unroll
                for (int pt = 0; pt < 4; ++pt) st[pt] = __builtin_amdgcn_mfma_f32_16x16x32_bf16(af, cat8(lo[pt], hi[pt]), st[pt], 0, 0, 0); }
        }
        if (c + 1 < 32) S2_WRITE(pb ^ 1);
        MX_BAR_L();
    }
    asm volatile("s_waitcnt vmcnt(0)" ::: "memory");
#undef S2_LOAD
#undef S2_WRITE
}

constexpr int G_QD = 0, G_KI = 16384, G_V = 32768, G_DEC = G_V + 64 * XROW, G_BUF = 45056, G_SP = 2 * G_BUF, G_END = G_SP + 2 * 16384;
static_assert(G_DEC + 512 <= G_BUF && G_END <= RING_BYTES, "GLA LDS");
template <bool CHECK> __device__ __forceinline__ void gla_unit(LAS char* shm, int b, int h, int vs, const bf16_t* PROJ, const bf16_t* QD, const bf16_t* KI, const float* DEC, bf16_t* MIX, unsigned* mismatch) {
    const int tid = threadIdx.x, lane = tid & 63, fr = lane & 15, fq = lane >> 4; const int w = __builtin_amdgcn_readfirstlane(tid >> 6);
    const int row = tid >> 3, ec = tid & 7, lt = w >> 1, l0 = 16 * lt, vt0 = 2 * (w & 1);
    const unsigned lds0 = (unsigned)(uintptr_t)shm;
    f32x4 st[4];
#pragma unroll
    for (int i = 0; i < 4; ++i) st[i] = (f32x4){0.f, 0.f, 0.f, 0.f};
    u32x4 rq[2], rk[2], rv; float rdec = 0.f;
    const size_t seq0 = (size_t)b * SEQ;
#define GLA_LOAD(c) do { const size_t gr = seq0 + (size_t)(c) * 64 + row; const size_t o = gr * 512 + h * 128 + ec * 16; \
        _Pragma("unroll") for (int i = 0; i < 2; ++i) { rq[i] = *(const u32x4*)(QD + o + 8 * i); rk[i] = *(const u32x4*)(KI + o + 8 * i); } \
        rv = *(const u32x4*)(PROJ + gr * NO_IN + 3584 + h * 256 + vs * 64 + ec * 8); \
        if (tid < 128) rdec = DEC[((size_t)b * 32 + (c)) * 512 + h * 128 + tid]; } while (0)
#define GLA_WRITE(pb) do { LAS char* gb_ = shm + (pb) * G_BUF; \
        _Pragma("unroll") for (int i = 0; i < 2; ++i) { *(LAS u32x4*)(gb_ + G_QD + sw256(row, ec * 2 + i)) = rq[i]; *(LAS u32x4*)(gb_ + G_KI + sw256(row, ec * 2 + i)) = rk[i]; } \
        *(LAS u32x4*)(gb_ + G_V + row * XROW + ec * 16) = rv; \
        if (tid < 128) ((LAS float*)(gb_ + G_DEC))[tid] = rdec; \
        _Pragma("unroll") for (int vt = 0; vt < 4; ++vt) { u32x2 v; v.x = cvt_pk_bf16(st[vt][0], st[vt][1]); v.y = cvt_pk_bf16(st[vt][2], st[vt][3]); \
            const int vv = 16 * vt + fr; *(LAS u32x2*)(shm + G_SP + (pb) * 16384 + sw256(vv, 2 * w + (fq >> 1)) + (fq & 1) * 8) = v; } } while (0)
    GLA_LOAD(0);
    GLA_WRITE(0);
    MX_BAR_L();
    const unsigned xtr = lds0 + (unsigned)(((lane & 15) >> 2) * XROW + (lane & 3) * 8);
    for (int c = 0; c < 32; ++c) {
        const int pb = c & 1; LAS char* gb = shm + pb * G_BUF; const unsigned gbo = (unsigned)(pb * G_BUF); LAS char* sp = shm + G_SP + pb * 16384;
        if (c + 1 < 32) GLA_LOAD(c + 1);
        bf16x8 qf[4];
#pragma unroll
        for (int ks = 0; ks < 4; ++ks) qf[ks] = *(const LAS bf16x8*)(gb + G_QD + sw256(l0 + fr, 4 * ks + fq));
        f32x4 o[2]; o[0] = (f32x4){0.f, 0.f, 0.f, 0.f}; o[1] = (f32x4){0.f, 0.f, 0.f, 0.f};
        const int lcol = l0 + fr; const int nsb = (lt >> 1) + 1;
        for (int sb = 0; sb < nsb; ++sb) {
            const int s0 = 32 * sb; const bool two = (2 * sb + 1) <= lt;
            f32x4 a0 = {0.f, 0.f, 0.f, 0.f}, a1 = {0.f, 0.f, 0.f, 0.f};
#pragma unroll
            for (int ks = 0; ks < 4; ++ks) { const bf16x8 kf = *(const LAS bf16x8*)(gb + G_KI + sw256(s0 + fr, 4 * ks + fq)); a0 = __builtin_amdgcn_mfma_f32_16x16x32_bf16(kf, qf[ks], a0, 0, 0, 0); }
            if (two) {
#pragma unroll
                for (int ks = 0; ks < 4; ++ks) { const bf16x8 kf = *(const LAS bf16x8*)(gb + G_KI + sw256(s0 + 16 + fr, 4 * ks + fq)); a1 = __builtin_amdgcn_mfma_f32_16x16x32_bf16(kf, qf[ks], a1, 0, 0, 0); }
            }
            float g0[4], g1[4];
#pragma unroll
            for (int i = 0; i < 4; ++i) { const int sa = s0 + 4 * fq + i; g0[i] = (sa <= lcol) ? a0[i] : 0.f; g1[i] = (two && sa + 16 <= lcol) ? a1[i] : 0.f; }
            u32x4 ap; ap.x = cvt_pk_bf16(g0[0], g0[1]); ap.y = cvt_pk_bf16(g0[2], g0[3]); ap.z = cvt_pk_bf16(g1[0], g1[1]); ap.w = cvt_pk_bf16(g1[2], g1[3]);
            const bf16x8 af = __builtin_bit_cast(bf16x8, ap);
            s16x4 lo[2], hi[2];
#pragma unroll
            for (int vi = 0; vi < 2; ++vi) { lo[vi] = tr_read(xtr + gbo + G_V + (unsigned)((s0 + 4 * fq) * XROW + (vt0 + vi) * 32)); hi[vi] = tr_read(xtr + gbo + G_V + (unsigned)((s0 + 16 + 4 * fq) * XROW + (vt0 + vi) * 32)); }
            MX_LGKM0();
#pragma unroll
            for (int vi = 0; vi < 2; ++vi) o[vi] = __builtin_amdgcn_mfma_f32_16x16x32_bf16(af, cat8(lo[vi], hi[vi]), o[vi], 0, 0, 0);
        }
#pragma unroll
        for (int vi = 0; vi < 2; ++vi)
#pragma unroll
            for (int ks = 0; ks < 4; ++ks) { const bf16x8 sf = *(const LAS bf16x8*)(sp + sw256(16 * (vt0 + vi) + fr, 4 * ks + fq)); o[vi] = __builtin_amdgcn_mfma_f32_16x16x32_bf16(qf[ks], sf, o[vi], 0, 0, 0); }
        {
            bf16_t* op = MIX + (seq0 + (size_t)c * 64 + l0 + 4 * fq) * 2048 + 1024 + h * 256 + vs * 64 + vt0 * 16 + fr;
#pragma unroll
            for (int vi = 0; vi < 2; ++vi)
#pragma unroll
                for (int i = 0; i < 4; ++i) { const bf16_t val = (bf16_t)(cvt_pk_bf16(o[vi][i], 0.f) & 0xffffu);
                    if (CHECK) { if (op[(size_t)i * 2048 + vi * 16] != val) atomicAdd(mismatch, 1u); } else op[(size_t)i * 2048 + vi * 16] = val; }
        }
        {
#pragma unroll
            for (int ks = 0; ks < 2; ++ks) {
                const int s0 = 32 * ks, q = (lane & 15) >> 2, p = lane & 3;
                const int r1 = s0 + 8 * fq + q, r2 = r1 + 4;
                const s16x4 alo = tr_read(lds0 + gbo + G_KI + sw256(r1, 2 * w + (p >> 1)) + (p & 1) * 8), ahi = tr_read(lds0 + gbo + G_KI + sw256(r2, 2 * w + (p >> 1)) + (p & 1) * 8);
                s16x4 lo[4], hi[4];
#pragma unroll
                for (int vt = 0; vt < 4; ++vt) { lo[vt] = tr_read(xtr + gbo + G_V + (unsigned)((s0 + 8 * fq) * XROW + vt * 32)); hi[vt] = tr_read(xtr + gbo + G_V + (unsigned)((s0 + 8 * fq + 4) * XROW + vt * 32)); }
                MX_LGKM0();
                const bf16x8 af = cat8(alo, ahi);
#pragma unroll
                for (int vt = 0; vt < 4; ++vt) st[vt] = __builtin_amdgcn_mfma_f32_16x16x32_bf16(af, cat8(lo[vt], hi[vt]), st[vt], 0, 0, 0);
            }
            const f32x4 d4 = *(const LAS f32x4*)((LAS float*)(gb + G_DEC) + 16 * w + 4 * fq);
#pragma unroll
            for (int vt = 0; vt < 4; ++vt) st[vt] = st[vt] * d4;
        }
        if (c + 1 < 32) GLA_WRITE(pb ^ 1);
        MX_BAR_L();
    }
    asm volatile("s_waitcnt vmcnt(0)" ::: "memory");
#undef GLA_LOAD
#undef GLA_WRITE
}

__device__ __forceinline__ void finalize_phase(bf16_t* MIX, const bf16_t* PROJ, const float* ssd_norm, const float* gla_norm, int gw, int ngw, int lane) {
    for (int m = gw; m < T; m += ngw) {
        bf16_t* mr = MIX + (size_t)m * 2048; const bf16_t* pr = PROJ + (size_t)m * NO_IN;
        float y[2][8]; float s = 0.f;
#pragma unroll
        for (int j = 0; j < 2; ++j) { const int col = 512 * j + 8 * lane; const u32x4 a = *(const u32x4*)(mr + col), z = __builtin_nontemporal_load((const u32x4*)(pr + col));
#pragma unroll
            for (int i = 0; i < 4; ++i) { const float y0 = __uint_as_float(a[i] << 16), y1 = __uint_as_float(a[i] & 0xffff0000u), z0 = __uint_as_float(z[i] << 16), z1 = __uint_as_float(z[i] & 0xffff0000u);
                y[j][2 * i] = y0 * siluf(z0); y[j][2 * i + 1] = y1 * siluf(z1); s += y[j][2 * i] * y[j][2 * i] + y[j][2 * i + 1] * y[j][2 * i + 1]; } }
        const float rs = rsqrtf(wave_sum(s) * (1.f / 1024.f) + EPS);
#pragma unroll
        for (int j = 0; j < 2; ++j) { const int col = 512 * j + 8 * lane; const f32x4 w0 = *(const f32x4*)(ssd_norm + col), w1 = *(const f32x4*)(ssd_norm + col + 4);
            u32x4 o; o.x = cvt_pk_bf16(y[j][0] * rs * w0[0], y[j][1] * rs * w0[1]); o.y = cvt_pk_bf16(y[j][2] * rs * w0[2], y[j][3] * rs * w0[3]);
            o.z = cvt_pk_bf16(y[j][4] * rs * w1[0], y[j][5] * rs * w1[1]); o.w = cvt_pk_bf16(y[j][6] * rs * w1[2], y[j][7] * rs * w1[3]);
            *(u32x4*)(mr + col) = o; }
#pragma unroll
        for (int j = 0; j < 2; ++j) { const int cc = 512 * j + 8 * lane; const u32x4 a = *(const u32x4*)(mr + 1024 + cc), r = __builtin_nontemporal_load((const u32x4*)(pr + 4608 + cc));
            float o[8]; float s2 = 0.f;
#pragma unroll
            for (int i = 0; i < 4; ++i) { o[2 * i] = __uint_as_float(a[i] << 16); o[2 * i + 1] = __uint_as_float(a[i] & 0xffff0000u); s2 += o[2 * i] * o[2 * i] + o[2 * i + 1] * o[2 * i + 1]; }
#pragma unroll
            for (int of = 1; of < 32; of <<= 1) s2 += __shfl_xor(s2, of);
            const float r2 = rsqrtf(s2 * (1.f / 256.f) + EPS); const int v0 = 8 * (lane & 31);
            const f32x4 w0 = *(const f32x4*)(gla_norm + v0), w1 = *(const f32x4*)(gla_norm + v0 + 4);
            float f[8];
#pragma unroll
            for (int i = 0; i < 4; ++i) { f[2 * i] = siluf(__uint_as_float(r[i] << 16)); f[2 * i + 1] = siluf(__uint_as_float(r[i] & 0xffff0000u)); }
            u32x4 ov; ov.x = cvt_pk_bf16(o[0] * r2 * w0[0] * f[0], o[1] * r2 * w0[1] * f[1]); ov.y = cvt_pk_bf16(o[2] * r2 * w0[2] * f[2], o[3] * r2 * w0[3] * f[3]);
            ov.z = cvt_pk_bf16(o[4] * r2 * w1[0] * f[4], o[5] * r2 * w1[1] * f[5]); ov.w = cvt_pk_bf16(o[6] * r2 * w1[2] * f[6], o[7] * r2 * w1[3] * f[7]);
            *(u32x4*)(mr + 1024 + cc) = ov; }
    }
}
#undef MX_LGKM0
#undef MX_BAR
#undef MX_BAR_L
}
namespace mk {
__device__ __forceinline__ void tp_norm_rows(const float* src, const float* g, bf16_t* xn, int gw, int ngw, int lane) {
    f32x4 gg[4];
#pragma unroll
    for (int j = 0; j < 4; ++j) gg[j] = ((const f32x4*)g)[lane + 64 * j];
    for (int m = gw; m < T; m += ngw) {
        const f32x4* p = (const f32x4*)(src + (size_t)m * DM); f32x4 v[4]; float s = 0.f;
#pragma unroll
        for (int j = 0; j < 4; ++j) { v[j] = __builtin_nontemporal_load(p + lane + 64 * j); s += (v[j][0] * v[j][0] + v[j][1] * v[j][1]) + (v[j][2] * v[j][2] + v[j][3] * v[j][3]); }
        const float r = rsqrtf(wave_sum(s) * (1.f / DM) + EPS);
        u32x2* o = (u32x2*)(xn + (size_t)m * DM);
#pragma unroll
        for (int j = 0; j < 4; ++j) { const f32x4 y = v[j] * r * gg[j]; u32x2 w; w.x = cvt_pk_bf16(y[0], y[1]); w.y = cvt_pk_bf16(y[2], y[3]); o[lane + 64 * j] = w; }
    }
}
template <bool FINAL> __device__ __forceinline__ void tp_combine_norm(bf16_t* hb, const bf16_t* Y, const float* g, bf16_t* xn, float* out, int gw, int ngw, int lane) {
    f32x4 gg[2][2];
#pragma unroll
    for (int j = 0; j < 2; ++j) { gg[j][0] = *(const f32x4*)(g + 512 * j + 8 * lane); gg[j][1] = *(const f32x4*)(g + 512 * j + 8 * lane + 4); }
    for (int m = gw; m < T; m += ngw) {
        float v[2][8]; float s = 0.f;
#pragma unroll
        for (int j = 0; j < 2; ++j) { const size_t o = (size_t)m * DM + 512 * j + 8 * lane;
            const u32x4 a = *(const u32x4*)(hb + o), y0 = __builtin_nontemporal_load((const u32x4*)(Y + o)), y1 = __builtin_nontemporal_load((const u32x4*)(Y + (size_t)T * DM + o));
#pragma unroll
            for (int i = 0; i < 4; ++i) { v[j][2 * i] = __uint_as_float(a[i] << 16) + __uint_as_float(y0[i] << 16) + __uint_as_float(y1[i] << 16);
                v[j][2 * i + 1] = __uint_as_float(a[i] & 0xffff0000u) + __uint_as_float(y0[i] & 0xffff0000u) + __uint_as_float(y1[i] & 0xffff0000u);
                s += v[j][2 * i] * v[j][2 * i] + v[j][2 * i + 1] * v[j][2 * i + 1]; } }
        const float r = rsqrtf(wave_sum(s) * (1.f / DM) + EPS);
#pragma unroll
        for (int j = 0; j < 2; ++j) { const size_t o = (size_t)m * DM + 512 * j + 8 * lane;
            if (FINAL) { f32x4 o0, o1;
#pragma unroll
                for (int i = 0; i < 4; ++i) { o0[i] = v[j][i] * r * gg[j][0][i]; o1[i] = v[j][4 + i] * r * gg[j][1][i]; }
                __builtin_nontemporal_store(o0, (f32x4*)(out + o)); __builtin_nontemporal_store(o1, (f32x4*)(out + o + 4));
            } else { u32x4 hw, xw;
#pragma unroll
                for (int i = 0; i < 4; ++i) { hw[i] = cvt_pk_bf16(v[j][2 * i], v[j][2 * i + 1]);
                    xw[i] = cvt_pk_bf16(v[j][2 * i] * r * gg[j][i >> 1][(2 * i) & 3], v[j][2 * i + 1] * r * gg[j][i >> 1][(2 * i + 1) & 3]); }
                *(u32x4*)(hb + o) = hw; *(u32x4*)(xn + o) = xw; }
        }
    }
}
template <bool DRY> __device__ __forceinline__ void tp_route_mfma(const bf16_t* hb, const float* g, bf16_t* xn, const bf16_t* whi, const bf16_t* wlo, const float* bg, const float* br,
                                                                  unsigned* counts, int* lists, float* gates, LAS char* shm, int vcu, int G, int lane, int wave) {
    const int fr = lane & 15, fq = lane >> 4, kbase = wave * 128;
    LAS float* xacc = (LAS float*)shm;
    LAS float* ltile = (LAS float*)(shm + 106496);
    LAS float* rsl = (LAS float*)(shm + 118784);
    for (int blk = vcu; blk < T / 64; blk += G) {
        const int r0 = blk * 64;
        bf16x8 wh[3][4], wl[3][4];
#pragma unroll
        for (int nt = 0; nt < 3; ++nt)
#pragma unroll
            for (int ks = 0; ks < 4; ++ks) { const size_t wo = (size_t)(nt * 16 + fr) * DM + kbase + 32 * ks + 8 * fq; wh[nt][ks] = *(const bf16x8*)(whi + wo); wl[nt][ks] = *(const bf16x8*)(wlo + wo); }
#pragma unroll
        for (int tp = 0; tp < 2; ++tp) {
            u32x4 hq[2][4];
#pragma unroll
            for (int t2 = 0; t2 < 2; ++t2)
#pragma unroll
                for (int ks = 0; ks < 4; ++ks) hq[t2][ks] = *(const u32x4*)(hb + (size_t)(r0 + 16 * (2 * tp + t2) + fr) * DM + kbase + 32 * ks + 8 * fq);
#pragma unroll
            for (int t2 = 0; t2 < 2; ++t2) { const int t = 2 * tp + t2;
                f32x4 acc[3]; acc[0] = (f32x4){0.f, 0.f, 0.f, 0.f}; acc[1] = acc[0]; acc[2] = acc[0];
                float ss = 0.f;
#pragma unroll
                for (int ks = 0; ks < 4; ++ks) { const u32x4 v = hq[t2][ks];
                    const float x0 = __uint_as_float(v.x << 16), x1 = __uint_as_float(v.x & 0xffff0000u), x2 = __uint_as_float(v.y << 16), x3 = __uint_as_float(v.y & 0xffff0000u);
                    const float x4 = __uint_as_float(v.z << 16), x5 = __uint_as_float(v.z & 0xffff0000u), x6 = __uint_as_float(v.w << 16), x7 = __uint_as_float(v.w & 0xffff0000u);
                    ss += (x0 * x0 + x1 * x1) + (x2 * x2 + x3 * x3) + (x4 * x4 + x5 * x5) + (x6 * x6 + x7 * x7);
                    const bf16x8 a = __builtin_bit_cast(bf16x8, v);
#pragma unroll
                    for (int nt = 0; nt < 3; ++nt) { acc[nt] = __builtin_amdgcn_mfma_f32_16x16x32_bf16(a, wh[nt][ks], acc[nt], 0, 0, 0); acc[nt] = __builtin_amdgcn_mfma_f32_16x16x32_bf16(a, wl[nt][ks], acc[nt], 0, 0, 0); } }
                ss += __shfl_xor(ss, 16); ss += __shfl_xor(ss, 32);
                LAS float* xa = xacc + (t * 8 + wave) * 13 * 64;
#pragma unroll
                for (int nt = 0; nt < 3; ++nt)
#pragma unroll
                    for (int i = 0; i < 4; ++i) xa[(nt * 4 + i) * 64 + lane] = acc[nt][i];
                xa[12 * 64 + lane] = ss;
            }
            asm volatile("" ::: "memory");
        }
        u32x4 hv[4][4];
#pragma unroll
        for (int t = 0; t < 4; ++t)
#pragma unroll
            for (int ks = 0; ks < 4; ++ks) hv[t][ks] = *(const u32x4*)(hb + (size_t)(r0 + 16 * t + fr) * DM + kbase + 32 * ks + 8 * fq);
        asm volatile("s_waitcnt lgkmcnt(0)\n\ts_barrier" ::: "memory");
        float rs[4];
#pragma unroll
        for (int t = 0; t < 4; ++t) { float s = 0.f;
#pragma unroll
            for (int w2 = 0; w2 < 8; ++w2) s += xacc[(t * 8 + w2) * 13 * 64 + 12 * 64 + lane];
            rs[t] = rsqrtf(s * (1.f / DM) + EPS); }
        if (wave < 4) {
            const LAS float* xs = xacc + (wave * 8) * 13 * 64;
#pragma unroll
            for (int nt = 0; nt < 3; ++nt)
#pragma unroll
                for (int i = 0; i < 4; ++i) { float v = 0.f;
#pragma unroll
                    for (int w2 = 0; w2 < 8; ++w2) v += xs[w2 * 13 * 64 + (nt * 4 + i) * 64 + lane];
                    ltile[(16 * wave + 4 * fq + i) * 48 + nt * 16 + fr] = v; }
            float rw = rs[0];
#pragma unroll
            for (int t = 1; t < 4; ++t) if (wave == t) rw = rs[t];
            if (fq == 0) rsl[16 * wave + fr] = rw;
        }
#pragma unroll
        for (int t = 0; t < 4; ++t) { bf16_t* xp = xn + (size_t)(r0 + 16 * t + fr) * DM + kbase + 8 * fq; const float r = rs[t];
#pragma unroll
            for (int ks = 0; ks < 4; ++ks) { const u32x4 v = hv[t][ks]; const f32x4 g0 = *(const f32x4*)(g + kbase + 32 * ks + 8 * fq), g1 = *(const f32x4*)(g + kbase + 32 * ks + 8 * fq + 4); u32x4 o;
                o.x = cvt_pk_bf16(__uint_as_float(v.x << 16) * r * g0[0], __uint_as_float(v.x & 0xffff0000u) * r * g0[1]); o.y = cvt_pk_bf16(__uint_as_float(v.y << 16) * r * g0[2], __uint_as_float(v.y & 0xffff0000u) * r * g0[3]);
                o.z = cvt_pk_bf16(__uint_as_float(v.z << 16) * r * g1[0], __uint_as_float(v.z & 0xffff0000u) * r * g1[1]); o.w = cvt_pk_bf16(__uint_as_float(v.w << 16) * r * g1[2], __uint_as_float(v.w & 0xffff0000u) * r * g1[3]);
                *(u32x4*)(xp + 32 * ks) = o; } }
        asm volatile("s_waitcnt lgkmcnt(0)\n\ts_barrier" ::: "memory");
        if (wave == 0) {
            const LAS float* lt = ltile + lane * 48; const float rsr = rsl[lane];
            float gl[4];
#pragma unroll
            for (int e = 0; e < 4; ++e) gl[e] = rsr * lt[e] + bg[e];
            int gi = 0; float gm = gl[0];
#pragma unroll
            for (int e = 1; e < 4; ++e) if (gl[e] > gm) { gm = gl[e]; gi = e; }
            float gs = 0.f;
#pragma unroll
            for (int e = 0; e < 4; ++e) gs += expf(gl[e] - gm);
            const float gwt = 1.f / gs;
            float b0 = -INFINITY, b1 = -INFINITY; int i0 = 0, i1 = 0;
#pragma unroll
            for (int i = 0; i < 8; ++i) { const float v = rsr * lt[4 + gi * 8 + i] + br[gi * 8 + i];
                if (v > b0) { b1 = b0; i1 = i0; b0 = v; i0 = i; } else if (v > b1) { b1 = v; i1 = i; } }
            const int t = r0 + lane;
            const float w0 = 1.f / (1.f + expf(b1 - b0)), w1 = 1.f - w0;
            const int e0 = gi * 8 + i0, e1 = gi * 8 + i1;
            gates[2 * t] = gwt * w0; gates[2 * t + 1] = gwt * w1;
            if (!DRY) {
                const unsigned p0 = __hip_atomic_fetch_add(counts + e0 * 64, 1u, __ATOMIC_RELAXED, __HIP_MEMORY_SCOPE_AGENT);
                const unsigned p1 = __hip_atomic_fetch_add(counts + e1 * 64, 1u, __ATOMIC_RELAXED, __HIP_MEMORY_SCOPE_AGENT);
                lists[e0 * CAP + p0] = 2 * t; lists[e1 * CAP + p1] = 2 * t + 1; }
        }
    }
    asm volatile("s_waitcnt lgkmcnt(0)\n\ts_barrier" ::: "memory");
}

struct Args {
    const float* in[26]; float* out; unsigned char* ws; int ph_lo, ph_hi, use_bar, li;
};
enum Phase { P_CONV0 = 0, P_G1, P_ATT, P_G2, P_TP1, P_G3, P_G4, P_TP2, P_G5, P_CONV, P_MIXER, P_FIN, P_G6, P_TP3, P_G7, P_G8, P_TP4, P_COUNT };

__device__ __forceinline__ void moe_setup(volatile LAS int* misc, unsigned* counts) {
    if (threadIdx.x == 0) {
        int run = 0;
        for (int e = 0; e < 32; ++e) { const int c = (int)__hip_atomic_load(counts + e * 64, __ATOMIC_RELAXED, __HIP_MEMORY_SCOPE_AGENT); misc[64 + e] = c; misc[16 + e] = run; run += (c + 255) >> 8; }
        misc[16 + 32] = run;
    }
    __syncthreads();
}

typedef const float* kin_ptr_t;
__device__ __forceinline__ const float* kin(int i) { return ((const volatile kin_ptr_t __attribute__((address_space(4)))*)__builtin_amdgcn_kernarg_segment_ptr())[i]; }
#ifndef CV_TAIL_ITEMS
#define CV_TAIL_ITEMS 8192
#endif
constexpr int CV_I_EIN = 16 * 80, CV_I_EOUT = 16 * 32, CV_I_OIN = 16 * 184, CV_I_OOUT = 32 * 32, CV_I_GU = 16 * 32, CV_I_D = 8 * 32;
constexpr int CV_NITEMS = CV_I_EIN + CV_I_EOUT + CV_I_OIN + CV_I_OOUT + 32 * CV_I_GU + 32 * CV_I_D;
__device__ __forceinline__ CvItem cv_decode0(unsigned char* ws, int it, int lane) {
    int r = it;
    if (r < CV_I_EIN) return cv_make(SrcEvenIn{kin(4)}, 2312, 1024, 80, (bf16_t*)(ws + WS_WEIN), r, lane); r -= CV_I_EIN;
    if (r < CV_I_EOUT) return cv_make(SrcPlain{kin(7), 1024}, 1024, 1024, 32, (bf16_t*)(ws + WS_WEOUT), r, lane); r -= CV_I_EOUT;
    if (r < CV_I_OIN) return cv_make(SrcOddIn{kin(8)}, 5664, 1024, 184, (bf16_t*)(ws + WS_WOIN), r, lane); r -= CV_I_OIN;
    if (r < CV_I_OOUT) return cv_make(SrcPlain{kin(18), 1024}, 1024, 2048, 32, (bf16_t*)(ws + WS_WOOUT), r, lane); r -= CV_I_OOUT;
    if (r < 32 * CV_I_GU) { const int e = r / CV_I_GU; return cv_make_gu(kin(23) + (size_t)e * 1024 * 512, kin(24) + (size_t)e * 1024 * 512, (bf16_t*)(ws + WS_WGU) + (size_t)e * 1024 * 1024, r % CV_I_GU, lane); } r -= 32 * CV_I_GU;
    { const int e = r / CV_I_D; return cv_make(SrcPlain{kin(25) + (size_t)e * 512 * 1024, 1024}, 1024, 512, 32, (bf16_t*)(ws + WS_WD) + (size_t)e * 1024 * 512, r % CV_I_D, lane); }
}
__device__ __forceinline__ void cv_run0(unsigned char* ws, int lo, int hi, int w, int nw, LAS float* scr, int lane) {
    for (int it = lo + 2 * w; it < hi; it += 2 * nw) {
        float va[32], vb[32]; const CvItem da = cv_decode0(ws, it, lane); cv_load(da, va);
        const bool n1 = it + 1 < hi; CvItem db = da; if (n1) { db = cv_decode0(ws, it + 1, lane); cv_load(db, vb); }
        cv_finish(da, va, scr, lane);
        if (n1) cv_finish(db, vb, scr, lane);
    }
}

constexpr int CV_NIT1 = 32 * (CV_I_GU + CV_I_D);
#ifndef CV1_TAIL_G5
#define CV1_TAIL_G5 4096
#endif
#ifndef CV1_TAIL_MIX
#define CV1_TAIL_MIX 8192
#endif
#ifndef CV1_TAIL_G4
#define CV1_TAIL_G4 8192
#endif
#ifndef CV0_TAIL_G3
#define CV0_TAIL_G3 0
#endif
__device__ __forceinline__ CvItem cv_decode1(unsigned char* ws, int it, int lane) {
    const size_t L1 = (size_t)32 * 1024 * 512; int r = it;
    if (r < 32 * CV_I_GU) { const int e = r / CV_I_GU; return cv_make_gu(kin(23) + L1 + (size_t)e * 1024 * 512, kin(24) + L1 + (size_t)e * 1024 * 512, (bf16_t*)(ws + WS_WGU) + (size_t)e * 1024 * 1024, r % CV_I_GU, lane); } r -= 32 * CV_I_GU;
    { const int e = r / CV_I_D; return cv_make(SrcPlain{kin(25) + L1 + (size_t)e * 512 * 1024, 1024}, 1024, 512, 32, (bf16_t*)(ws + WS_WD) + (size_t)e * 1024 * 512, r % CV_I_D, lane); }
}
__device__ __forceinline__ void cv_run1(unsigned char* ws, int lo, int hi, int w, int nw, LAS float* scr, int lane) {
    for (int it = lo + 2 * w; it < hi; it += 2 * nw) {
        float va[32], vb[32]; const CvItem da = cv_decode1(ws, it, lane); cv_load(da, va);
        const bool n1 = it + 1 < hi; CvItem db = da; if (n1) { db = cv_decode1(ws, it + 1, lane); cv_load(db, vb); }
        cv_finish(da, va, scr, lane);
        if (n1) cv_finish(db, vb, scr, lane);
    }
}

__global__ void __launch_bounds__(NTHR, 2) mk_fwd(Args args) {
    extern __shared__ __attribute__((aligned(16))) unsigned char lds_raw[];
    LAS unsigned char* lds = (LAS unsigned char*)lds_raw;
    volatile LAS int* misc = (volatile LAS int*)(lds + MISC_OFF);
    const int tid = threadIdx.x, lane = tid & 63, wave = __builtin_amdgcn_readfirstlane(tid >> 6);
    const int G = gridDim.x, bx = blockIdx.x;
    const int vcu = (G % 8 == 0) ? (bx % 8) * (G / 8) + bx / 8 : bx;
    const int gw = vcu * NWAVES + wave, ngw = G * NWAVES;
    for (int u = tid; u < 256; u += NTHR) misc[u] = 0;
    __syncthreads();
#define ws ((unsigned char*)kin(27))
#define XN ((bf16_t*)(ws + WS_XN))
#define PROJ ((bf16_t*)(ws + WS_PROJ))
#define MIX ((bf16_t*)(ws + WS_MIX))
#define FB ((float*)(ws + WS_FB))
#define LISTS ((int*)(ws + WS_LISTS))
#define GATES ((float*)(ws + WS_GATES))
#define HB ((bf16_t*)(ws + WS_H))
#define YB ((bf16_t*)(ws + WS_Y))
#define outp ((float*)kin(26))
#define HBS ((bf16_t*)(ws + WS_HB))
#define ctl ((unsigned*)(ws + WS_CTL))
    XcdBarrier bar; bar.bar = ctl + CW_BAR + args.li * XCD_BAR_WORDS; bar.x = 0; bar.st = nullptr;
    if (args.use_bar) bar = xcd_barrier_post(ctl + CW_BAR + args.li * XCD_BAR_WORDS, (volatile LAS unsigned*)misc);
#ifdef BAR_TWICE
#define GRID_BAR() do { if (args.use_bar) { xcd_barrier(bar); xcd_barrier(bar); } } while (0)
#else
#define GRID_BAR() do { if (args.use_bar) xcd_barrier(bar); } while (0)
#endif
    const int lo = args.ph_lo, hi = args.ph_hi;
#ifndef MK_PHASE_MASK
#define MK_PHASE_MASK 0xffffffffu
#endif
#define IN(k) (((MK_PHASE_MASK >> (k)) & 1u) && lo <= (k) && (k) < hi)
#ifndef MK_REP_MASK
#define MK_REP_MASK 0u
#endif
#define NREP(k) ((((MK_REP_MASK) >> (k)) & 1u) ? 2 : 1)
#define REP(k) for (int _r = 0; _r < ((((MK_REP_MASK) >> (k)) & 1u) ? 2 : 1); ++_r)
#define SEAM(k) do { if (IN(k) && IN((k) + 1)) GRID_BAR(); } while (0)
#define XIN kin(0)

    if (IN(P_CONV0)) REP(P_CONV0) {
        LAS float* scr = (LAS float*)(lds + wave * 16384);
        constexpr int OI_LO = CV_I_EIN + CV_I_EOUT, OI_HI = OI_LO + CV_I_OIN + CV_I_OOUT;
        if (CV0_TAIL_G3 && G == 256) { cv_run0(ws, 0, OI_LO, gw, ngw, scr, lane); cv_run0(ws, OI_HI, CV_NITEMS - CV_TAIL_ITEMS, gw, ngw, scr, lane); }
        else cv_run0(ws, 0, CV_NITEMS - CV_TAIL_ITEMS, gw, ngw, scr, lane);
        { bf16_t* wrt = (bf16_t*)(ws + WS_WRT);
          for (int i = gw * 64 + lane; i < 2 * 48 * 1024; i += ngw * 64) { const int l = i / (48 * 1024), rem = i % (48 * 1024), e = rem >> 10, k = rem & 1023;
              const float v = ((e < 4) ? kin(19)[(size_t)l * 4096 + k * 4 + e] : (e < 36 ? kin(21)[(size_t)l * 32768 + k * 32 + (e - 4)] : 0.f)) * kin(2)[(size_t)l * DM + k];
              const unsigned hi = cvt_pk_bf16(v, 0.f) & 0xffffu; const unsigned lo = cvt_pk_bf16(v - __uint_as_float(hi << 16), 0.f) & 0xffffu;
              wrt[(size_t)(2 * l) * 48 * 1024 + rem] = (bf16_t)hi; wrt[(size_t)(2 * l + 1) * 48 * 1024 + rem] = (bf16_t)lo; } }
        tp_norm_rows(XIN, kin(1), XN, gw, ngw, lane);
    }
    SEAM(P_CONV0);
    if (IN(P_G1)) {
        pg8::Gemm g{XN, (const bf16_t*)(ws + WS_WEIN), 1024, 0}; pg8::DenseOrder S; S.init(T, NE_IN, G, bx, NREP(P_G1));
        pg8::EpiProjEven E{PROJ, FB};
        pg8::gemm_phase<pg8::EpiProjEven, pg8::DenseOrder, true>(lds, g, S, E);
        if (CV_TAIL_ITEMS > 0 && G == 256 && bx >= 128)
            cv_run0(ws, CV_NITEMS - CV_TAIL_ITEMS, CV_NITEMS, (bx - 128) * NWAVES + wave, 128 * NWAVES, (LAS float*)(lds + wave * 16384), lane);
        else if (CV_TAIL_ITEMS > 0 && G != 256) cv_run0(ws, CV_NITEMS - CV_TAIL_ITEMS, CV_NITEMS, gw, ngw, (LAS float*)(lds + wave * 16384), lane);
    }
    SEAM(P_G1);
    if (IN(P_ATT)) REP(P_ATT) {
        if (G == 256) {
            const int bh = vcu >> 2, s = vcu & 3, b = bh >> 3, h = bh & 7;
            const float fbias = kin(6)[h];
            att::fox_unit_p<false>((char*)lds_raw, (LAS char*)lds, b, h, 7 - s, PROJ, FB, fbias, MIX, ctl + 32, true);
            att::fox_unit_p<false>((char*)lds_raw, (LAS char*)lds, b, h, s, PROJ, FB, fbias, MIX, ctl + 32, false);
            for (int i = 0; i < 2; ++i) { const int u = vcu * 2 + i; const int sb = u >> 6, kvh = (u >> 5) & 1, blk = u & 31; att::swa_unit((LAS char*)lds, sb, kvh, blk, PROJ, kin(5), MIX); }
        }
    }
    SEAM(P_ATT);
    if (IN(P_G2)) {
        pg8::Gemm g{MIX, (const bf16_t*)(ws + WS_WEOUT), 1024, 0}; pg8::DenseOrder S; S.init(T, DM, G, bx, NREP(P_G2));
        pg8::EpiResidB<true> E{XIN, HBS};
        pg8::gemm_phase<pg8::EpiResidB<true>, pg8::DenseOrder, true>(lds, g, S, E);
    }
    SEAM(P_G2);
    if (IN(P_TP1)) {
#ifdef TP1_REP
        tp_route_mfma<true>(HBS, kin(2), XN, (const bf16_t*)(ws + WS_WRT), (const bf16_t*)(ws + WS_WRT) + 48 * 1024, kin(20), kin(22), ctl + CW_CNT, LISTS, GATES, (LAS char*)lds, vcu, G, lane, wave);
#endif
        tp_route_mfma<false>(HBS, kin(2), XN, (const bf16_t*)(ws + WS_WRT), (const bf16_t*)(ws + WS_WRT) + 48 * 1024, kin(20), kin(22), ctl + CW_CNT, LISTS, GATES, (LAS char*)lds, vcu, G, lane, wave);
    }
    SEAM(P_TP1);
    if (IN(P_G3)) {
        moe_setup(misc, ctl + CW_CNT);
        if (CV0_TAIL_G3 && G == 256) {
            const int U = misc[16 + 32] * 4, nidle = 768 - U;
            if (nidle > 0 && bx >= 256 - nidle) { constexpr int OI_LO = CV_I_EIN + CV_I_EOUT, OI_HI = OI_LO + CV_I_OIN + CV_I_OOUT;
                cv_run0(ws, OI_LO, OI_HI, (bx - (256 - nidle)) * NWAVES + wave, nidle * NWAVES, (LAS float*)(lds + wave * 16384), lane); }
            else if (nidle <= 0) { constexpr int OI_LO = CV_I_EIN + CV_I_EOUT, OI_HI = OI_LO + CV_I_OIN + CV_I_OOUT; cv_run0(ws, OI_LO, OI_HI, gw, ngw, (LAS float*)(lds + wave * 16384), lane); }
        }
        __syncthreads();
        pg8::Gemm g{XN, (const bf16_t*)(ws + WS_WGU), 1024, (size_t)1024 * 1024 * 2};
        pg8::MoeOrder S{(const volatile LAS int*)(misc + 16), (const volatile LAS int*)(misc + 64), LISTS, G, bx, true, NREP(P_G3)};
        pg8::EpiGateUp E{HB};
        pg8::gemm_phase<pg8::EpiGateUp, pg8::MoeOrder, true>(lds, g, S, E);
    }
    SEAM(P_G3);
    if (IN(P_G4)) {
        moe_setup(misc, ctl + CW_CNT);
        pg8::Gemm g{HB, (const bf16_t*)(ws + WS_WD), 512, (size_t)1024 * 512 * 2};
        pg8::MoeOrder S{(const volatile LAS int*)(misc + 16), (const volatile LAS int*)(misc + 64), LISTS, G, bx, false, NREP(P_G4)};
        pg8::EpiDown E{YB, LISTS, GATES, (const volatile LAS int*)(misc + 64)};
        pg8::gemm_phase<pg8::EpiDown, pg8::MoeOrder, true>(lds, g, S, E);
        if (CV1_TAIL_G4 > 0 && G == 256) {
            const int U = misc[16 + 32] * 4, nidle = 768 - U, lo1 = CV_NIT1 - CV1_TAIL_G5 - CV1_TAIL_MIX - CV1_TAIL_G4, hi1 = lo1 + CV1_TAIL_G4;
            if (nidle >= 32) { if (bx >= 256 - nidle) cv_run1(ws, lo1, hi1, (bx - (256 - nidle)) * NWAVES + wave, nidle * NWAVES, (LAS float*)(lds + wave * 16384), lane); }
            else cv_run1(ws, lo1, hi1, gw, ngw, (LAS float*)(lds + wave * 16384), lane);
        }
    }
    SEAM(P_G4);
    if (IN(P_TP2)) {
        tp_combine_norm<false>(HBS, YB, kin(1) + DM, XN, nullptr, gw, ngw, lane);
        LAS float* scr = (LAS float*)(lds + wave * 16384);
        constexpr int I_GU = 16 * 32, I_D = 8 * 32; const size_t L1 = (size_t)32 * 1024 * 512;
        auto decode = [&](int it) -> CvItem {
            int r = it;
            if (r < 32 * I_GU) { const int e = r / I_GU; return cv_make_gu(kin(23) + L1 + (size_t)e * 1024 * 512, kin(24) + L1 + (size_t)e * 1024 * 512, (bf16_t*)(ws + WS_WGU) + (size_t)e * 1024 * 1024, r % I_GU, lane); } r -= 32 * I_GU;
            { const int e = r / I_D; return cv_make(SrcPlain{kin(25) + L1 + (size_t)e * 512 * 1024, 1024}, 1024, 512, 32, (bf16_t*)(ws + WS_WD) + (size_t)e * 1024 * 512, r % I_D, lane); }
        };
        const int NIT1 = CV_NIT1 - ((G == 256) ? (CV1_TAIL_G5 + CV1_TAIL_MIX + CV1_TAIL_G4) : 0);
        for (int it = 2 * gw; it < NIT1; it += 2 * ngw) {
            float va[32], vb[32]; const CvItem da = decode(it); cv_load(da, va);
            const bool n1 = it + 1 < NIT1; CvItem db = da; if (n1) { db = decode(it + 1); cv_load(db, vb); }
            cv_finish(da, va, scr, lane);
            if (n1) cv_finish(db, vb, scr, lane);
        }
    }
    SEAM(P_TP2);
    if (IN(P_G5)) {
        pg8::Gemm g{XN, (const bf16_t*)(ws + WS_WOIN), 1024, 0}; pg8::DenseOrder S; S.init(T, NO_IN, G, bx, NREP(P_G5));
        pg8::EpiProjOdd E{PROJ, (float*)(ws + WS_DTG)};
        pg8::gemm_phase<pg8::EpiProjOdd, pg8::DenseOrder, true>(lds, g, S, E);
        if (CV1_TAIL_G5 > 0 && G == 256 && bx >= 192)
            cv_run1(ws, CV_NIT1 - CV1_TAIL_G5 - CV1_TAIL_MIX, CV_NIT1 - CV1_TAIL_MIX, (bx - 192) * NWAVES + wave, 64 * NWAVES, (LAS float*)(lds + wave * 16384), lane);
    }
    SEAM(P_G5);
    if (IN(P_CONV)) {
        mx::prep_conv(PROJ, (bf16_t*)(ws + WS_CONV), kin(9), kin(10), vcu, G, tid);
#ifdef PREP_REP_CONV
        mx::prep_conv(PROJ, (bf16_t*)(ws + WS_CONV), kin(9), kin(10), vcu, G, tid);
#endif
        mx::prep_ssd((const float*)(ws + WS_DTG), (float*)(ws + mx::WS_DTV), (float*)(ws + mx::WS_ACS), kin(11), kin(12), vcu, G, lane, wave);
#ifdef PREP_REP_SSD
        mx::prep_ssd((const float*)(ws + WS_DTG), (float*)(ws + mx::WS_DTV), (float*)(ws + mx::WS_ACS), kin(11), kin(12), vcu, G, lane, wave);
#endif
        mx::prep_gla(PROJ, (const float*)(ws + WS_DTG), (bf16_t*)(ws + mx::WS_QD), (bf16_t*)(ws + mx::WS_KI), (bf16_t*)(ws + mx::WS_KE), (float*)(ws + mx::WS_DEC), kin(15), kin(16), vcu, G, tid, lane, wave, (LAS char*)lds);
#ifdef PREP_REP_GLA
        mx::prep_gla(PROJ, (const float*)(ws + WS_DTG), (bf16_t*)(ws + mx::WS_QD), (bf16_t*)(ws + mx::WS_KI), (bf16_t*)(ws + mx::WS_KE), (float*)(ws + mx::WS_DEC), kin(15), kin(16), vcu, G, tid, lane, wave, (LAS char*)lds);
#endif
    }
    SEAM(P_CONV);
    if (IN(P_MIXER)) {
        if (G == 256) {
            if (vcu < 128) {
                mx::ssd_unit64((LAS char*)lds, vcu >> 4, vcu & 15, (const bf16_t*)(ws + WS_CONV), (const float*)(ws + mx::WS_ACS), (const float*)(ws + mx::WS_DTV), kin(13)[vcu & 15], MIX);
#ifdef MIX_SSD_REP
                __syncthreads(); mx::ssd_unit((LAS char*)lds, vcu >> 4, vcu & 15, (const bf16_t*)(ws + WS_CONV), (const float*)(ws + mx::WS_ACS), (const float*)(ws + mx::WS_DTV), kin(13)[vcu & 15], MIX);
#endif
            }
            else { const int u = vcu - 128; mx::gla_unit<false>((LAS char*)lds, u >> 4, (u >> 2) & 3, u & 3, PROJ, (const bf16_t*)(ws + mx::WS_QD), (const bf16_t*)(ws + mx::WS_KI),
                                                          (const float*)(ws + mx::WS_DEC), MIX, ctl + 32);
                if (CV1_TAIL_MIX > 0) { __syncthreads(); cv_run1(ws, CV_NIT1 - CV1_TAIL_MIX, CV_NIT1, (vcu - 128) * NWAVES + wave, 128 * NWAVES, (LAS float*)(lds + wave * 16384), lane); }
#ifdef MIX_GLA_REP
                __syncthreads(); mx::gla_unit<false>((LAS char*)lds, u >> 4, (u >> 2) & 3, u & 3, PROJ, (const bf16_t*)(ws + mx::WS_QD), (const bf16_t*)(ws + mx::WS_KI), (const float*)(ws + mx::WS_DEC), MIX, ctl + 32);
#endif
            }
        }
    }
    SEAM(P_MIXER);
    if (IN(P_FIN)) {
        mx::finalize_phase(MIX, PROJ, kin(14), kin(17), gw, ngw, lane);
    }
    SEAM(P_FIN);
    if (IN(P_G6)) {
        pg8::Gemm g{MIX, (const bf16_t*)(ws + WS_WOOUT), 2048, 0}; pg8::DenseOrder S; S.init(T, DM, G, bx, NREP(P_G6));
        pg8::EpiResidB<false> E{HBS, HBS};
        pg8::gemm_phase<pg8::EpiResidB<false>, pg8::DenseOrder, true>(lds, g, S, E);
    }
    SEAM(P_G6);
    if (IN(P_TP3)) {
        tp_route_mfma<false>(HBS, kin(2) + DM, XN, (const bf16_t*)(ws + WS_WRT) + 2 * 48 * 1024, (const bf16_t*)(ws + WS_WRT) + 3 * 48 * 1024, kin(20) + 4, kin(22) + 32,
                             ctl + CW_CNT + 32 * 64, LISTS, GATES, (LAS char*)lds, vcu, G, lane, wave);
    }
    SEAM(P_TP3);
    if (IN(P_G7)) {
        moe_setup(misc, ctl + CW_CNT + 32 * 64);
        pg8::Gemm g{XN, (const bf16_t*)(ws + WS_WGU), 1024, (size_t)1024 * 1024 * 2};
        pg8::MoeOrder S{(const volatile LAS int*)(misc + 16), (const volatile LAS int*)(misc + 64), LISTS, G, bx, true, NREP(P_G7)};
        pg8::EpiGateUp E{HB};
        pg8::gemm_phase<pg8::EpiGateUp, pg8::MoeOrder, true>(lds, g, S, E);
    }
    SEAM(P_G7);
    if (IN(P_G8)) {
        moe_setup(misc, ctl + CW_CNT + 32 * 64);
        pg8::Gemm g{HB, (const bf16_t*)(ws + WS_WD), 512, (size_t)1024 * 512 * 2};
        pg8::MoeOrder S{(const volatile LAS int*)(misc + 16), (const volatile LAS int*)(misc + 64), LISTS, G, bx, false, NREP(P_G8)};
        pg8::EpiDown E{YB, LISTS, GATES, (const volatile LAS int*)(misc + 64)};
        pg8::gemm_phase<pg8::EpiDown, pg8::MoeOrder, true>(lds, g, S, E);
    }
    SEAM(P_G8);
    if (IN(P_TP4)) {
        tp_combine_norm<true>(HBS, YB, kin(3), nullptr, outp, gw, ngw, lane);
#if defined(GLA_CHECK) || defined(ATT_CHECK)
        if (__hip_atomic_load(ctl + 32, __ATOMIC_RELAXED, __HIP_MEMORY_SCOPE_AGENT) != 0u) { for (int m = gw; m < T; m += ngw) outp[(size_t)m * DM + lane] = 1000.f; }
#endif
    }
#undef IN
#undef SEAM
#undef GRID_BAR
#undef ws
#undef XN
#undef PROJ
#undef MIX
#undef FB
#undef LISTS
#undef GATES
#undef HB
#undef YB
#undef outp
#undef HBS
#undef ctl
#undef XIN
}
}

extern "C" void kernel_launch(void* const* d_in, const int* in_sizes, int n_in, void* d_out, int out_size, void* d_ws, size_t ws_size, hipStream_t stream) {
    static int grid = 0;
    if (grid == 0) {
        int dev = 0, cus = 0, per_cu = 0;
        (void)hipGetDevice(&dev); (void)hipDeviceGetAttribute(&cus, hipDeviceAttributeMultiprocessorCount, dev);
        if (n_in != 26 || out_size != mk::T * mk::DM || ws_size < mk::WS_TOTAL) { fprintf(stderr, "kernel_launch: unexpected shapes (n_in %d out %d ws %zu)\n", n_in, out_size, ws_size); grid = -1; return; }
        if (hipFuncSetAttribute((const void*)mk::mk_fwd, hipFuncAttributeMaxDynamicSharedMemorySize, mk::LDS_BYTES) != hipSuccess) { fprintf(stderr, "hipFuncSetAttribute failed\n"); grid = -1; return; }
        if (hipOccupancyMaxActiveBlocksPerMultiprocessor(&per_cu, (const void*)mk::mk_fwd, mk::NTHR, mk::LDS_BYTES) != hipSuccess || per_cu < 1) { fprintf(stderr, "occupancy query reports %d blocks per CU\n", per_cu); }
        (void)hipGetLastError();
        grid = cus;
        if (grid != 256) fprintf(stderr, "kernel_launch: %d CUs; the attention / mixer phases need 256\n", grid);
    }
    if (grid < 0) return;
    (void)hipMemsetAsync((char*)d_ws + mk::WS_CTL, 0, mk::CTL_ZERO_BYTES, stream);
    mk::Args a{};
    for (int i = 0; i < 26; ++i) a.in[i] = (const float*)d_in[i];
    a.out = (float*)d_out; a.ws = (unsigned char*)d_ws;
    a.ph_lo = 0; a.ph_hi = mk::P_COUNT; a.use_bar = 1; a.li = 0;
    hipLaunchKernelGGL(mk::mk_fwd, dim3(grid), dim3(mk::NTHR), mk::LDS_BYTES, stream, a);
}
```

```cpp
#include <hip/hip_runtime.h>
#include <hip/hip_bf16.h>
#include <cstdio>
#include <cstdint>
#include <cmath>
namespace mk {
#define LAS __attribute__((address_space(3)))
#define GAS __attribute__((address_space(1)))
typedef unsigned short bf16_t;
typedef short bf16x8 __attribute__((ext_vector_type(8)));
typedef short s16x4 __attribute__((ext_vector_type(4)));
typedef float f32x4 __attribute__((ext_vector_type(4)));
typedef float f32x2 __attribute__((ext_vector_type(2)));
typedef float f32x16 __attribute__((ext_vector_type(16)));
typedef unsigned u32x4 __attribute__((ext_vector_type(4)));
typedef unsigned u32x2 __attribute__((ext_vector_type(2)));

constexpr int T = 16384, DM = 1024, SEQ = 2048, NBATCH = 8;
constexpr int NE_IN = 2560, NO_IN = 5888;
constexpr int CAP = 16384;
constexpr float EPS = 1e-6f;
constexpr float LOG2E = 1.4426950408889634f;
constexpr float C2 = 0.125f * LOG2E;
constexpr int NWAVES = 8, NTHR = 512;
constexpr size_t MiB = 1u << 20;
constexpr size_t WS_CTL = 0, CTL_ZERO_BYTES = 1 * MiB;
constexpr size_t WS_WEIN = 2 * MiB, WS_WEOUT = 7 * MiB, WS_WOIN = 9 * MiB, WS_WOOUT = 21 * MiB, WS_WRT = 25 * MiB;
constexpr size_t WS_WGU = 26 * MiB, WS_WD = 90 * MiB;
constexpr size_t WS_XN = 122 * MiB;
constexpr size_t WS_PROJ = 154 * MiB;
constexpr size_t WS_H = WS_PROJ, WS_Y = WS_PROJ + 40 * MiB;
constexpr size_t WS_MIX = 338 * MiB;
constexpr size_t WS_CONV = 402 * MiB;
constexpr size_t WS_FB = 450 * MiB;
constexpr size_t WS_DTG = 451 * MiB;
constexpr size_t WS_LISTS = 453 * MiB;
constexpr size_t WS_GATES = 455 * MiB;
constexpr size_t WS_RSTD = 455 * MiB + 512 * 1024;
constexpr size_t WS_END = 456 * MiB, WS_HB = 476 * MiB, WS_TOTAL = 508 * MiB;
constexpr int CW_BAR = 4096;
constexpr int CW_CNT = 16384;
constexpr int RING_BYTES = 146432;
constexpr int MISC_OFF = RING_BYTES;
constexpr int LDS_BYTES = 147456;

typedef __bf16 bf16x2_t __attribute__((ext_vector_type(2)));
__device__ __forceinline__ unsigned cvt_pk_bf16(float lo, float hi) { f32x2 v = {lo, hi}; bf16x2_t b = __builtin_convertvector(v, bf16x2_t); return __builtin_bit_cast(unsigned, b); }
__device__ __forceinline__ float bf2f(unsigned short b) { return __uint_as_float((unsigned)b << 16); }
__device__ __forceinline__ float wave_sum(float v) {
#pragma unroll
    for (int o = 1; o < 64; o <<= 1) v += __shfl_xor(v, o);
    return v;
}
__device__ __forceinline__ float siluf(float x) { return x * __builtin_amdgcn_rcpf(1.f + __expf(-x)); }
__device__ __forceinline__ float log_sigmoidf(float x) { return fminf(x, 0.f) - log1pf(expf(-fabsf(x))); }
__device__ __forceinline__ float log_sigmoid_fast(float x) { return fminf(x, 0.f) - __logf(1.f + __expf(-fabsf(x))); }
__device__ __forceinline__ float softplusf(float x) { return fmaxf(x, 0.f) + __logf(1.f + __expf(-fabsf(x))); }

#define XB_TMO      128
#define XB_XCNT(j)  (256  + 64 * (j))
#define XB_XSUB(j)  (1280 + 64 * (j))
#define XB_XGEN(j)  (2304 + 64 * (j))
#define XB_TOP      3328
#define XB_TOPGEN   3392
#define XCD_BAR_WORDS 3456
#define XB_SPIN_CAP (1u << 18)
__device__ __forceinline__ unsigned xb_ld(unsigned* p)              { return __hip_atomic_load(p, __ATOMIC_RELAXED, __HIP_MEMORY_SCOPE_AGENT); }
__device__ __forceinline__ unsigned xb_add(unsigned* p, unsigned v) { return __hip_atomic_fetch_add(p, v, __ATOMIC_RELAXED, __HIP_MEMORY_SCOPE_AGENT); }
__device__ __forceinline__ unsigned xb_xcc_id() { return (unsigned)__builtin_amdgcn_s_getreg((3 << 11) | 20) & 0xFu; }
#define XB_SPIN(cond, bar) do { unsigned _sp = 0; while (cond) { __builtin_amdgcn_s_sleep(1); \
    if ((++_sp & 255u) == 0u) { if (xb_ld(&(bar)[XB_TMO])) break; if (_sp > XB_SPIN_CAP) { atomicAdd(&(bar)[XB_TMO], 1u); break; } } } } while (0)
struct XcdBarrier { unsigned* bar; unsigned x; volatile LAS unsigned* st; };
__device__ __forceinline__ XcdBarrier xcd_barrier_post(unsigned* bar, volatile LAS unsigned* st) {
    XcdBarrier b; b.bar = bar; b.x = xb_xcc_id(); b.st = st;
    if (threadIdx.x == 0) (void)xb_add(&bar[XB_XCNT(b.x)], 1u);
    return b;
}
__device__ __forceinline__ void xcd_barrier_complete(unsigned* bar, unsigned x, unsigned& nloc, unsigned& nx) {
    const unsigned G = gridDim.x * gridDim.y * gridDim.z;
    unsigned sum, cnt, mine, sp = 0u;
    for (;;) {
        sum = 0u; cnt = 0u; mine = 0u;
#pragma unroll
        for (unsigned j = 0; j < 16; ++j) { const unsigned c = xb_ld(&bar[XB_XCNT(j)]); sum += c; cnt += (c > 0u) ? 1u : 0u; mine = (j == x) ? c : mine; }
        if (sum == G) break;
        __builtin_amdgcn_s_sleep(1);
        if ((++sp & 255u) == 0u) { if (xb_ld(&bar[XB_TMO])) break; if (sp > XB_SPIN_CAP) { atomicAdd(&bar[XB_TMO], 1u); break; } }
    }
    nloc = mine > 0u ? mine : 1u; nx = cnt > 0u ? cnt : 1u;
}
__device__ __forceinline__ void xcd_barrier(const XcdBarrier& b) {
    asm volatile("s_waitcnt vmcnt(0)" ::: "memory");
    __syncthreads();
    if (threadIdx.x == 0) {
        unsigned* bar = b.bar;
        __builtin_amdgcn_s_waitcnt(0);
        unsigned nloc = b.st[0], nx = b.st[1];
        if (nloc == 0u) { xcd_barrier_complete(bar, b.x, nloc, nx); b.st[0] = nloc; b.st[1] = nx; }
        const unsigned old = xb_add(&bar[XB_XSUB(b.x)], 1u);
        const unsigned gen = old / nloc;
        if (old + 1u == (gen + 1u) * nloc) {
            __builtin_amdgcn_fence(__ATOMIC_RELEASE, "agent");
            asm volatile("s_waitcnt vmcnt(0)" ::: "memory");
            const unsigned og = xb_add(&bar[XB_TOP], 1u);
            const unsigned tg = og / nx;
            if (og + 1u == (tg + 1u) * nx) xb_add(&bar[XB_TOPGEN], 1u);
            else XB_SPIN(xb_ld(&bar[XB_TOPGEN]) == tg, bar);
            __builtin_amdgcn_fence(__ATOMIC_ACQUIRE, "agent");
            xb_add(&bar[XB_XGEN(b.x)], 1u);
            asm volatile("s_waitcnt vmcnt(0)" ::: "memory");
        } else {
            XB_SPIN(xb_ld(&bar[XB_XGEN(b.x)]) == gen, bar);
            __builtin_amdgcn_fence(__ATOMIC_ACQUIRE, "agent");
            asm volatile("s_waitcnt vmcnt(0)" ::: "memory");
        }
    }
    __syncthreads();
}

struct SrcPlain { const float* W; int N; __device__ __forceinline__ const float* operator()(int k, int n) const { return W + (size_t)k * N + n; } };
struct SrcEvenIn { const float* W; __device__ __forceinline__ const float* operator()(int k, int n) const { return n < 2312 ? W + (size_t)k * 2312 + n : nullptr; } };
struct SrcOddIn { const float* W;
    __device__ __forceinline__ const float* operator()(int k, int n) const {
        int s;
        if (n < 2560) s = n; else if (n < 4608) s = n + 16; else if (n < 5632) s = n + 32; else if (n < 5648) s = 2560 + (n - 5632); else if (n < 5664) s = 4624 + (n - 5648); else s = -1;
        return s >= 0 ? W + (size_t)k * 5664 + s : nullptr; } };
struct SrcGateUp { const float* Wg; const float* Wu;
    __device__ __forceinline__ const float* operator()(int k, int n) const { const int j = (n >> 5) * 16 + (n & 15); const long d = (n & 16) ? (long)(Wu - Wg) : 0l; return Wg + d + (size_t)k * 512 + j; } };
__device__ __forceinline__ struct CvItem cv_make_gu(const float* Wg, const float* Wu, bf16_t* WT, int item, int lane);
struct CvItem { const float* p; size_t stride; bf16_t* dst; int K; int gu; };
template <class Src> __device__ __forceinline__ CvItem cv_make(const Src& src, int srcN, int K, int nblk, bf16_t* WT, int item, int lane) {
    const int kb = item / nblk, nb = item % nblk, k0 = 64 * kb, n0 = 32 * nb;
    CvItem d; d.p = src(k0 + (lane >> 5), n0 + (lane & 31)); d.stride = (size_t)2 * srcN; d.dst = WT + (size_t)n0 * K + k0; d.K = K; d.gu = 0; return d;
}
__device__ __forceinline__ CvItem cv_make_gu(const float* Wg, const float* Wu, bf16_t* WT, int item, int lane) {
    const int half = item >> 8, r = item & 255, kb = r >> 4, jb = r & 15, k0 = 64 * kb, j0 = 32 * jb;
    CvItem d; d.p = (half ? Wu : Wg) + (size_t)(k0 + (lane >> 5)) * 512 + j0 + (lane & 31); d.stride = 1024; d.dst = WT + (size_t)(jb * 64 + half * 16) * 1024 + k0; d.K = 1024; d.gu = 1; return d;
}
__device__ __forceinline__ void cv_load(const CvItem& d, float (&v)[32]) {
#pragma unroll
    for (int i = 0; i < 32; ++i) v[i] = d.p ? __builtin_nontemporal_load(d.p + (size_t)i * d.stride) : 0.f;
}
__device__ __forceinline__ void cv_finish(const CvItem& d, const float (&v)[32], LAS float* scr, int lane) {
#pragma unroll
    for (int i = 0; i < 32; ++i) { const int kk = 2 * i + (lane >> 5); scr[kk * 33 + (lane & 31)] = v[i]; }
    asm volatile("s_waitcnt lgkmcnt(0)" ::: "memory");
    const int c = lane & 7;
#pragma unroll
    for (int j = 0; j < 4; ++j) { const int n = (lane >> 3) + 8 * j; const LAS float* s = scr + (8 * c) * 33 + n; const int dr = d.gu ? ((n >> 4) * 32 + (n & 15)) : n;
        u32x4 o; o.x = cvt_pk_bf16(s[0 * 33], s[1 * 33]); o.y = cvt_pk_bf16(s[2 * 33], s[3 * 33]); o.z = cvt_pk_bf16(s[4 * 33], s[5 * 33]); o.w = cvt_pk_bf16(s[6 * 33], s[7 * 33]);
        __builtin_nontemporal_store(o, (u32x4*)(d.dst + (size_t)dr * d.K + 8 * c)); }
    asm volatile("s_waitcnt lgkmcnt(0)" ::: "memory");
}

namespace pg8 {
constexpr int BM = 256, BK = 64, HALF = 128, HTB = HALF * BK * 2, STAGE_BYTES = 8 * HTB, NXCD = 8, WGM = 8;
__host__ __device__ __forceinline__ int lds_byte(int r, int c) { const int st = (r >> 4) * 2 + (c >> 5), rr = r & 15, cc = c & 31, ob = rr * 64 + cc * 2; return st * 1024 + (ob ^ (((ob >> 9) & 1) << 5)); }
__host__ __device__ __forceinline__ void stage_rc(int b, int& R, int& C) { const int st = b / 1024, sb = b % 1024, swz = sb ^ (((sb >> 9) & 1) << 5); R = (st >> 1) * 16 + swz / 64; C = (st & 1) * 32 + (swz % 64) / 2; }
__host__ __device__ __forceinline__ int perm32(int rho) { const int n = rho >> 4, i = rho & 15; return 8 * (i >> 2) + 4 * n + (i & 3); }

struct Unit { int pm, pn, e, j; };
struct Gemm { const bf16_t* A; const bf16_t* Bt; int K; size_t b_estride; };

struct DenseOrder {
    int nM, nN, nwg, G, c, rep;
    __device__ void init(int M, int N, int G_, int c_, int rep_ = 1) { nM = M / BM; nN = N / BM; nwg = nM * nN; G = G_; c = c_; rep = rep_; }
    __device__ bool next(int i, Unit& u) const {
        if (rep > 1) { const int n = (nwg - c + G - 1) / G; if (n <= 0 || i >= n * rep) return false; i = i % n; }
        const long L = (long)i * G + c; if (L >= nwg) return false;
        int wgid = (int)L; { const int q = nwg / NXCD, r = nwg % NXCD, xcd = wgid % NXCD, off = wgid / NXCD; wgid = (xcd < r ? xcd * (q + 1) : r * (q + 1) + (xcd - r) * q) + off; }
        const int nig = WGM * nN, gid = wgid / nig, fm = gid * WGM, gsz = (nM - fm) < WGM ? (nM - fm) : WGM;
        u.pm = fm + ((wgid % nig) % gsz); u.pn = (wgid % nig) / gsz; u.e = 0; u.j = 0; return true;
    }
    __device__ __forceinline__ unsigned arow(const Unit& u, int r) const { return (unsigned)(u.pm * BM + r); }
};
struct MoeOrder {
    const volatile LAS int* ts; const volatile LAS int* cnt; const int* lists; int G, c; bool gather; int rep;
    __device__ bool next(int i, Unit& u) const {
        const int U = ts[32] * 4;
        if (rep > 1) { const int n = (U - c + G - 1) / G; if (n <= 0 || i >= n * rep) return false; i = i % n; }
        const long L = (long)i * G + c; if (L >= U) return false;
        int v = (int)L; { const int q = U / NXCD, r = U % NXCD, xcd = v % NXCD, off = v / NXCD; v = (xcd < r ? xcd * (q + 1) : r * (q + 1) + (xcd - r) * q) + off; }
        const int m = v >> 2; u.pm = m; u.pn = v & 3;
        int e = 0;
        for (int k = 1; k < 32; ++k) if (ts[k] <= m) e = k;
        u.e = e; u.j = m - ts[e]; return true;
    }
    __device__ __forceinline__ unsigned arow(const Unit& u, int r) const {
        if (!gather) return (unsigned)(u.pm * BM + r);
        const int ri = u.j * BM + r; const int n = cnt[u.e];
        return ri < n ? (unsigned)(lists[u.e * CAP + ri] >> 1) : 0u;
    }
};

struct EpiProjEven {
    static constexpr bool PERM = true;
    bf16_t* O; float* fb;
    __device__ __forceinline__ void operator()(const f32x4 (&acc)[2][2][4][2], const Unit& u, int wr, int wc, int fr, int fq) const {
        const int row0 = u.pm * BM + wr * 64 + fr;
        if (u.pn == 9) {
            if (wc == 0 && fq == 0) {
#pragma unroll
                for (int ai = 0; ai < 2; ++ai)
#pragma unroll
                    for (int m = 0; m < 4; ++m) { float* p = fb + (size_t)(row0 + ai * HALF + m * 16) * 8; *(f32x4*)p = acc[ai][0][m][0]; *(f32x4*)(p + 4) = acc[ai][0][m][1]; }
            }
            return;
        }
        const float sc = (u.pn == 0 || u.pn == 1 || u.pn == 3 || u.pn == 4) ? C2 : 1.f;
        const int col0 = u.pn * BM + wc * 32 + 8 * fq;
#pragma unroll
        for (int ai = 0; ai < 2; ++ai)
#pragma unroll
            for (int m = 0; m < 4; ++m) { bf16_t* rowp = O + (size_t)(row0 + ai * HALF + m * 16) * NE_IN + col0;
#pragma unroll
                for (int bj = 0; bj < 2; ++bj) { const f32x4 v0 = acc[ai][bj][m][0] * sc, v1 = acc[ai][bj][m][1] * sc;
                    u32x4 w; w.x = cvt_pk_bf16(v0[0], v0[1]); w.y = cvt_pk_bf16(v0[2], v0[3]); w.z = cvt_pk_bf16(v1[0], v1[1]); w.w = cvt_pk_bf16(v1[2], v1[3]);
                    *(u32x4*)(rowp + bj * HALF) = w; } }
    }
};
struct EpiProjOdd {
    static constexpr bool PERM = true;
    bf16_t* O; float* dtg;
    __device__ __forceinline__ void operator()(const f32x4 (&acc)[2][2][4][2], const Unit& u, int wr, int wc, int fr, int fq) const {
        const int row0 = u.pm * BM + wr * 64 + fr;
        if (u.pn == 22) {
            if (wc == 0) {
#pragma unroll
                for (int ai = 0; ai < 2; ++ai)
#pragma unroll
                    for (int m = 0; m < 4; ++m) { float* p = dtg + (size_t)(row0 + ai * HALF + m * 16) * 32 + 8 * fq; *(f32x4*)p = acc[ai][0][m][0]; *(f32x4*)(p + 4) = acc[ai][0][m][1]; }
            }
            return;
        }
        const int col0 = u.pn * BM + wc * 32 + 8 * fq;
#pragma unroll
        for (int ai = 0; ai < 2; ++ai)
#pragma unroll
            for (int m = 0; m < 4; ++m) { bf16_t* rowp = O + (size_t)(row0 + ai * HALF + m * 16) * NO_IN + col0;
#pragma unroll
                for (int bj = 0; bj < 2; ++bj) { const f32x4 v0 = acc[ai][bj][m][0], v1 = acc[ai][bj][m][1];
                    u32x4 w; w.x = cvt_pk_bf16(v0[0], v0[1]); w.y = cvt_pk_bf16(v0[2], v0[3]); w.z = cvt_pk_bf16(v1[0], v1[1]); w.w = cvt_pk_bf16(v1[2], v1[3]);
                    *(u32x4*)(rowp + bj * HALF) = w; } }
    }
};
struct EpiResid {
    static constexpr bool PERM = false;
    const float* base; float* out;
    __device__ __forceinline__ void operator()(const f32x4 (&acc)[2][2][4][2], const Unit& u, int wr, int wc, int fr, int fq) const {
        const int col0 = u.pn * BM + wc * 32 + 4 * fq;
#pragma unroll
        for (int ai = 0; ai < 2; ++ai)
#pragma unroll
            for (int m = 0; m < 4; ++m) { const size_t off = (size_t)(u.pm * BM + ai * HALF + wr * 64 + m * 16 + fr) * DM + col0;
#pragma unroll
                for (int bj = 0; bj < 2; ++bj)
#pragma unroll
                    for (int n = 0; n < 2; ++n) { const f32x4 bs = *(const f32x4*)(base + off + bj * HALF + n * 16); *(f32x4*)(out + off + bj * HALF + n * 16) = bs + acc[ai][bj][m][n]; } }
    }
};
template <bool BASE_F32> struct EpiResidB {
    static constexpr bool PERM = true;
    const void* base; bf16_t* out;
    __device__ __forceinline__ void operator()(const f32x4 (&acc)[2][2][4][2], const Unit& u, int wr, int wc, int fr, int fq) const {
        const int row0 = u.pm * BM + wr * 64 + fr, col0 = u.pn * BM + wc * 32 + 8 * fq;
#pragma unroll
        for (int ai = 0; ai < 2; ++ai)
#pragma unroll
            for (int m = 0; m < 4; ++m) { const size_t ro = (size_t)(row0 + ai * HALF + m * 16) * DM + col0;
#pragma unroll
                for (int bj = 0; bj < 2; ++bj) { f32x4 v0 = acc[ai][bj][m][0], v1 = acc[ai][bj][m][1];
                    if (BASE_F32) { const float* b = (const float*)base + ro + bj * HALF; v0 += __builtin_nontemporal_load((const f32x4*)b); v1 += __builtin_nontemporal_load((const f32x4*)(b + 4)); }
                    else { const u32x4 bb = *(const u32x4*)((const bf16_t*)base + ro + bj * HALF);
                        v0[0] += __uint_as_float(bb.x << 16); v0[1] += __uint_as_float(bb.x & 0xffff0000u); v0[2] += __uint_as_float(bb.y << 16); v0[3] += __uint_as_float(bb.y & 0xffff0000u);
                        v1[0] += __uint_as_float(bb.z << 16); v1[1] += __uint_as_float(bb.z & 0xffff0000u); v1[2] += __uint_as_float(bb.w << 16); v1[3] += __uint_as_float(bb.w & 0xffff0000u); }
                    u32x4 w; w.x = cvt_pk_bf16(v0[0], v0[1]); w.y = cvt_pk_bf16(v0[2], v0[3]); w.z = cvt_pk_bf16(v1[0], v1[1]); w.w = cvt_pk_bf16(v1[2], v1[3]);
                    *(u32x4*)(out + ro + bj * HALF) = w; } }
    }
};
struct EpiGateUp {
    static constexpr bool PERM = false;
    bf16_t* H;
    __device__ __forceinline__ void operator()(const f32x4 (&acc)[2][2][4][2], const Unit& u, int wr, int wc, int fr, int fq) const {
#pragma unroll
        for (int ai = 0; ai < 2; ++ai)
#pragma unroll
            for (int m = 0; m < 4; ++m) { bf16_t* rowp = H + (size_t)(u.pm * BM + ai * HALF + wr * 64 + m * 16 + fr) * 512;
#pragma unroll
                for (int bj = 0; bj < 2; ++bj) { const int j0 = (u.pn * 8 + bj * 4 + wc) * 16 + 4 * fq; const f32x4 g = acc[ai][bj][m][0], up = acc[ai][bj][m][1];
                    u32x2 w; w.x = cvt_pk_bf16(siluf(g[0]) * up[0], siluf(g[1]) * up[1]); w.y = cvt_pk_bf16(siluf(g[2]) * up[2], siluf(g[3]) * up[3]);
                    *(u32x2*)(rowp + j0) = w; } }
    }
};
struct EpiDown {
    static constexpr bool PERM = true;
    bf16_t* Y; const int* lists; const float* gates; const volatile LAS int* cnt;
    __device__ __forceinline__ void operator()(const f32x4 (&acc)[2][2][4][2], const Unit& u, int wr, int wc, int fr, int fq) const {
        const int n = cnt[u.e]; const int col0 = u.pn * BM + wc * 32 + 8 * fq;
#pragma unroll
        for (int ai = 0; ai < 2; ++ai)
#pragma unroll
            for (int m = 0; m < 4; ++m) { const int ri = u.j * BM + ai * HALF + wr * 64 + m * 16 + fr;
                if (ri < n) { const int a = lists[u.e * CAP + ri]; const float g = gates[a]; bf16_t* rowp = Y + ((size_t)(a & 1) * T + (a >> 1)) * DM + col0;
#pragma unroll
                    for (int bj = 0; bj < 2; ++bj) { const f32x4 v0 = acc[ai][bj][m][0] * g, v1 = acc[ai][bj][m][1] * g;
                        u32x4 w; w.x = cvt_pk_bf16(v0[0], v0[1]); w.y = cvt_pk_bf16(v0[2], v0[3]); w.z = cvt_pk_bf16(v1[0], v1[1]); w.w = cvt_pk_bf16(v1[2], v1[3]);
                        *(u32x4*)(rowp + bj * HALF) = w; } } }
    }
};

template <class Epi, class Sched, bool ALIGN_EPI>
__device__ __forceinline__ void gemm_phase(LAS unsigned char* lds, const Gemm g, const Sched& S, const Epi& E) {
    const int tid = threadIdx.x, wid = __builtin_amdgcn_readfirstlane(tid >> 6), lane = tid & 63, wr = wid >> 2, wc = wid & 3, fr = lane & 15, fq = lane >> 4;
    const int K = g.K, nt = K / BK;
    int RA[2]; unsigned cbA[2], voffB[2];
#pragma unroll
    for (int i = 0; i < 2; ++i) { int R, C; stage_rc(tid * 16 + i * 8192, R, C); const int Rb = Epi::PERM ? ((R & ~31) + perm32(R & 31)) : R;
        RA[i] = R; cbA[i] = (unsigned)C * 2u; voffB[i] = (unsigned)(Rb * K + C) * 2u; }
    const unsigned kstep = (unsigned)(BK * 2);
    const size_t hstep = (size_t)HALF * K * 2;
    const size_t tstep = 2 * hstep;
    const unsigned rowb = (unsigned)K * 2u;
    const unsigned ldsw = (unsigned)wid * 1024u;
    const int aoff = lds_byte(wr * 64 + fr, fq * 8), boff = lds_byte(wc * 32 + fr, fq * 8);
    const char* Ab = (const char*)g.A;
#define PG8_SA(b, h) (((b) * 2 + (h)) * HTB)
#define PG8_SB(b, h) ((4 + (b) * 2 + (h)) * HTB)
#define PG8_STAGE(bufoff, gbase, voff) do { _Pragma("unroll") for (int _i = 0; _i < 2; ++_i) \
        __builtin_amdgcn_global_load_lds((const unsigned*)((const char*)(gbase) + (voff)[_i]), (LAS unsigned*)(lds + (bufoff) + ldsw + _i * 8192), 16, 0, 0); } while (0)
#define PG8_STAGE_A(bufoff, kb, o0, o1) do { \
        __builtin_amdgcn_global_load_lds((const unsigned*)(Ab + (kb) + (o0)), (LAS unsigned*)(lds + (bufoff) + ldsw), 16, 0, 0); \
        __builtin_amdgcn_global_load_lds((const unsigned*)(Ab + (kb) + (o1)), (LAS unsigned*)(lds + (bufoff) + ldsw + 8192), 16, 0, 0); } while (0)
#define PG8_LDA(dst, b, h) do { _Pragma("unroll") for (int m = 0; m < 4; ++m) _Pragma("unroll") for (int k = 0; k < 2; ++k) dst[m][k] = *(const LAS bf16x8*)(lds + PG8_SA(b, h) + aoff + m * 2048 + k * 1024); } while (0)
#define PG8_LDB(dst, b, h) do { _Pragma("unroll") for (int n = 0; n < 2; ++n) _Pragma("unroll") for (int k = 0; k < 2; ++k) dst[n][k] = *(const LAS bf16x8*)(lds + PG8_SB(b, h) + boff + n * 2048 + k * 1024); } while (0)
#define PG8_MMA(ai, bj, At, Bt) do { __builtin_amdgcn_s_setprio(1); _Pragma("unroll") for (int m = 0; m < 4; ++m) _Pragma("unroll") for (int n = 0; n < 2; ++n) _Pragma("unroll") for (int k = 0; k < 2; ++k) \
        acc[ai][bj][m][n] = __builtin_amdgcn_mfma_f32_16x16x32_bf16(Bt[n][k], At[m][k], acc[ai][bj][m][n], 0, 0, 0); __builtin_amdgcn_s_setprio(0); } while (0)
#define PG8_WAIT_V(n) asm volatile("s_waitcnt vmcnt(" #n ")" ::: "memory")
#define PG8_WAIT_L(n) asm volatile("s_waitcnt lgkmcnt(" #n ")" ::: "memory")
#define PG8_BAR __builtin_amdgcn_s_barrier()
#define PG8_SCHED __builtin_amdgcn_sched_barrier(0)
    Unit cur, nxt; int ui = 0;
    if (!S.next(0, cur)) return;
    f32x4 acc[2][2][4][2];
#pragma unroll
    for (int a = 0; a < 2; ++a)
#pragma unroll
        for (int b = 0; b < 2; ++b)
#pragma unroll
            for (int m = 0; m < 4; ++m)
#pragma unroll
                for (int n = 0; n < 2; ++n) acc[a][b][m][n] = (f32x4){0.f, 0.f, 0.f, 0.f};
    bf16x8 At[4][2], B0[2][2], B1[2][2];
    unsigned oC00 = S.arow(cur, RA[0]) * rowb + cbA[0], oC01 = S.arow(cur, RA[1]) * rowb + cbA[1];
    unsigned oC10 = S.arow(cur, HALF + RA[0]) * rowb + cbA[0], oC11 = S.arow(cur, HALF + RA[1]) * rowb + cbA[1];
    const char* cB = (const char*)g.Bt + (size_t)cur.e * g.b_estride + (size_t)cur.pn * tstep;
    PG8_STAGE(PG8_SB(0, 0), cB, voffB); PG8_STAGE(PG8_SB(0, 1), cB + hstep, voffB); PG8_STAGE_A(PG8_SA(0, 0), 0u, oC00, oC01); PG8_STAGE_A(PG8_SA(0, 1), 0u, oC10, oC11);
    if (wr == 1) PG8_BAR;
    PG8_WAIT_V(2); PG8_BAR;
    PG8_STAGE(PG8_SB(1, 0), cB + kstep, voffB); PG8_STAGE_A(PG8_SA(1, 0), kstep, oC00, oC01); PG8_STAGE(PG8_SB(1, 1), cB + hstep + kstep, voffB);
    PG8_WAIT_V(6); PG8_BAR;
    for (;;) {
        const bool has_next = S.next(ui + 1, nxt);
        unsigned oN00 = oC00, oN01 = oC01, oN10 = oC10, oN11 = oC11;
        if (has_next) { oN00 = S.arow(nxt, RA[0]) * rowb + cbA[0]; oN01 = S.arow(nxt, RA[1]) * rowb + cbA[1];
                        oN10 = S.arow(nxt, HALF + RA[0]) * rowb + cbA[0]; oN11 = S.arow(nxt, HALF + RA[1]) * rowb + cbA[1]; }
        const char* nB = has_next ? (const char*)g.Bt + (size_t)nxt.e * g.b_estride + (size_t)nxt.pn * tstep : cB;
        for (int t = 0; t < nt; t += 2) {
            const bool last = (t == nt - 2);
            const unsigned k1 = (unsigned)(t + 1) * kstep;
            const unsigned k2 = last ? 0u : (unsigned)(t + 2) * kstep, k3 = k2 + kstep;
            const unsigned o00 = last ? oN00 : oC00, o01 = last ? oN01 : oC01, o10 = last ? oN10 : oC10, o11 = last ? oN11 : oC11;
            const char* b2 = last ? nB : cB + (size_t)(t + 2) * kstep; const char* b3 = b2 + kstep;
            PG8_LDB(B0, 0, 0); PG8_LDB(B1, 0, 1); PG8_SCHED; PG8_LDA(At, 0, 0); PG8_STAGE_A(PG8_SA(1, 1), k1, oC10, oC11);
            PG8_WAIT_V(8); PG8_WAIT_L(0); PG8_BAR; PG8_MMA(0, 0, At, B0); PG8_MMA(0, 1, At, B1); PG8_BAR; PG8_SCHED;
            PG8_LDA(At, 0, 1); PG8_STAGE(PG8_SB(0, 0), b2, voffB); PG8_STAGE(PG8_SB(0, 1), b2 + hstep, voffB); PG8_STAGE_A(PG8_SA(0, 0), k2, o00, o01);
            PG8_WAIT_V(8); PG8_WAIT_L(0); PG8_BAR; PG8_MMA(1, 0, At, B0); PG8_MMA(1, 1, At, B1); PG8_BAR; PG8_SCHED;
            PG8_LDB(B0, 1, 0); PG8_LDB(B1, 1, 1); PG8_SCHED; PG8_LDA(At, 1, 0); PG8_STAGE_A(PG8_SA(0, 1), k2, o10, o11);
            PG8_WAIT_V(8); PG8_WAIT_L(0); PG8_BAR; PG8_MMA(0, 0, At, B0); PG8_MMA(0, 1, At, B1); PG8_BAR; PG8_SCHED;
            PG8_LDA(At, 1, 1); PG8_STAGE(PG8_SB(1, 0), b3, voffB); PG8_STAGE(PG8_SB(1, 1), b3 + hstep, voffB); PG8_STAGE_A(PG8_SA(1, 0), k3, o00, o01);
            PG8_WAIT_V(8); PG8_WAIT_L(0); PG8_BAR; PG8_MMA(1, 0, At, B0); PG8_MMA(1, 1, At, B1); PG8_BAR; PG8_SCHED;
        }
        if constexpr (ALIGN_EPI) { if (wr == 0) PG8_BAR; }
        E(acc, cur, wr, wc, fr, fq);
        if (!has_next) break;
#pragma unroll
        for (int a = 0; a < 2; ++a)
#pragma unroll
            for (int b = 0; b < 2; ++b)
#pragma unroll
                for (int m = 0; m < 4; ++m)
#pragma unroll
                    for (int n = 0; n < 2; ++n) acc[a][b][m][n] = (f32x4){0.f, 0.f, 0.f, 0.f};
        cur = nxt; cB = nB; oC00 = oN00; oC01 = oN01; oC10 = oN10; oC11 = oN11; ++ui;
        if constexpr (ALIGN_EPI) { if (wr == 1) PG8_BAR; }
    }
    PG8_WAIT_V(0);
    if constexpr (!ALIGN_EPI) { if (wr == 0) PG8_BAR; }
    PG8_BAR;
#undef PG8_SA
#undef PG8_SB
#undef PG8_STAGE
#undef PG8_STAGE_A
#undef PG8_LDA
#undef PG8_LDB
#undef PG8_MMA
#undef PG8_WAIT_V
#undef PG8_WAIT_L
#undef PG8_BAR
#undef PG8_SCHED
}
}
}
namespace att {
using namespace mk;
constexpr int KVBLK = 64;
constexpr int A_K = 0, A_V = 32768, A_WS = 65536, A_OST = A_WS + NWAVES * 256, A_BIAS = A_OST + NWAVES * 4096, A_SCAN = A_BIAS + 8192, A_BYTES = A_SCAN + 64;
static_assert(A_BYTES <= RING_BYTES, "attention LDS");
__device__ __forceinline__ int crow(int r, int hi) { return (r & 3) + 8 * (r >> 2) + 4 * hi; }
__device__ __forceinline__ void glds16(const void* gsrc, unsigned lds_dst) { unsigned keep;
    asm volatile("s_mov_b32 %0, m0\n\ts_mov_b32 m0, %2\n\ts_nop 0\n\tglobal_load_lds_dwordx4 %1, off\n\ts_mov_b32 m0, %0" : "=&s"(keep) : "v"(gsrc), "s"(lds_dst) : "memory"); }
__device__ __forceinline__ unsigned cvtpk(float lo, float hi) { return cvt_pk_bf16(lo, hi); }
__device__ __forceinline__ void qkt(f32x16& p0, f32x16& p1, const LAS char* Kslot, const bf16x8* qr, int r32, int hi) {
    const LAS char* kb = Kslot + hi * 1024 + r32 * 16;
    const f32x16 z = {};
#pragma unroll
    for (int d0 = 0; d0 < 4; ++d0) {
        const bf16x8 b0 = *(const LAS bf16x8*)(kb + d0 * 2048);
        const bf16x8 b1 = *(const LAS bf16x8*)(kb + d0 * 2048 + 512);
        if (d0 == 0) { p0 = __builtin_amdgcn_mfma_f32_32x32x16_bf16(b0, qr[0], z, 0, 0, 0); p1 = __builtin_amdgcn_mfma_f32_32x32x16_bf16(b1, qr[0], z, 0, 0, 0); }
        else { p0 = __builtin_amdgcn_mfma_f32_32x32x16_bf16(b0, qr[d0], p0, 0, 0, 0); p1 = __builtin_amdgcn_mfma_f32_32x32x16_bf16(b1, qr[d0], p1, 0, 0, 0); } }
}
__device__ __forceinline__ void pv(f32x16* o, int vb, bf16x8 pa0, bf16x8 pa1, bf16x8 pa2, bf16x8 pa3) {
#pragma unroll
    for (int d0 = 0; d0 < 2; ++d0) { s16x4 lo[4], hi[4];
#pragma unroll
        for (int ks = 0; ks < 4; ++ks) {
            asm volatile("ds_read_b64_tr_b16 %0,%1 offset:%c2" : "=&v"(lo[ks]) : "v"(vb), "i"(d0 * 4096 + ks * 1024) : "memory");
            asm volatile("ds_read_b64_tr_b16 %0,%1 offset:%c2" : "=&v"(hi[ks]) : "v"(vb), "i"(d0 * 4096 + ks * 1024 + 512) : "memory"); }
        asm volatile("s_waitcnt lgkmcnt(0)" ::: "memory"); __builtin_amdgcn_sched_barrier(0);
#define PK(k) (bf16x8){lo[k][0], lo[k][1], lo[k][2], lo[k][3], hi[k][0], hi[k][1], hi[k][2], hi[k][3]}
        o[d0] = __builtin_amdgcn_mfma_f32_32x32x16_bf16(pa0, PK(0), o[d0], 0, 0, 0);
        o[d0] = __builtin_amdgcn_mfma_f32_32x32x16_bf16(pa1, PK(1), o[d0], 0, 0, 0);
        o[d0] = __builtin_amdgcn_mfma_f32_32x32x16_bf16(pa2, PK(2), o[d0], 0, 0, 0);
        o[d0] = __builtin_amdgcn_mfma_f32_32x32x16_bf16(pa3, PK(3), o[d0], 0, 0, 0);
#undef PK
    }
}
__device__ __forceinline__ float rowmax32(const f32x16& p0, const f32x16& p1) {
    float a = fmaxf(p0[0], p1[0]);
#pragma unroll
    for (int r = 1; r < 16; ++r) a = fmaxf(a, fmaxf(p0[r], p1[r]));
    auto rr = __builtin_amdgcn_permlane32_swap(__float_as_uint(a), __float_as_uint(a), false, false);
    return fmaxf(__uint_as_float(rr[0]), __uint_as_float(rr[1]));
}
#define A_WAIT_BAR(N) asm volatile("s_waitcnt vmcnt(" #N ") lgkmcnt(0)\n\ts_barrier" ::: "memory")

template <bool SWA>
__device__ __forceinline__ void attn_tiles(LAS char* shm, const bf16_t* Qw, int qpitch, const bf16_t* Kh, const bf16_t* Vh, int kvpitch, bf16_t* Ow, int opitch,
                                           int kt0, int ntile, int qpos0, float sl2, float sink2) {
    const int tid = threadIdx.x, lane = tid & 63, r32 = lane & 31, hi = lane >> 5; const int wid = __builtin_amdgcn_readfirstlane(tid >> 6);
    const unsigned lds0 = (unsigned)(uintptr_t)shm;
    LAS float* wsf = (LAS float*)(shm + A_WS) + wid * 64;
    const LAS float* biasl = (const LAS float*)(shm + A_BIAS);
    const bf16_t* ksrc = Kh + (long)lane * kvpitch + wid * 8;
    const bf16_t* vsrc = Vh + (long)(16 * (wid & 3) + (lane >> 2)) * kvpitch + (wid >> 2) * 32 + (lane & 3) * 8;
    const unsigned kdst = lds0 + A_K + wid * 1024, vdst = lds0 + A_V + wid * 1024;
#define DMA_K(t, slot) glds16(ksrc + (long)(t) * KVBLK * kvpitch, (unsigned)__builtin_amdgcn_readfirstlane(kdst + (slot)))
#define DMA_V(t, slot) glds16(vsrc + (long)(t) * KVBLK * kvpitch, (unsigned)__builtin_amdgcn_readfirstlane(vdst + (slot)))
    const int vb0 = (int)(lds0 + A_V) + ((lane >> 4) & 1) * 32 + (lane & 3) * 8 + (4 * hi + ((lane & 15) >> 2)) * 64;
    DMA_K(kt0, 0); DMA_V(kt0, 0);
    if (ntile > 1) { DMA_K(kt0 + 1, 8192); DMA_V(kt0 + 1, 8192); }
    if (ntile > 2) { DMA_K(kt0 + 2, 16384); DMA_V(kt0 + 2, 16384); }
    bf16x8 qr[4];
#pragma unroll
    for (int d0 = 0; d0 < 4; ++d0) qr[d0] = *(const bf16x8*)(Qw + (long)r32 * qpitch + d0 * 16 + hi * 8);
    float m = SWA ? sink2 : -INFINITY, l = (SWA && hi == 0) ? 1.f : 0.f;
    f32x16 o[2]; o[0] = f32x16{}; o[1] = f32x16{};
    const int qpos = qpos0 + r32;
    if (ntile > 2) { A_WAIT_BAR(4); } else if (ntile > 1) { A_WAIT_BAR(2); } else { A_WAIT_BAR(0); }
    f32x16 p0, p1;
    qkt(p0, p1, shm + A_K, qr, r32, hi);
    for (int it = 0; it < ntile; ++it) {
        const int kt = kt0 + it, slot = (it & 3) * 8192;
        f32x16 n0, n1;
        if (it + 1 < ntile) {
            if (it + 2 < ntile) { A_WAIT_BAR(2); } else { A_WAIT_BAR(0); }
            if (it + 3 < ntile) { DMA_K(kt + 3, ((it + 3) & 3) * 8192); DMA_V(kt + 3, ((it + 3) & 3) * 8192); }
            qkt(n0, n1, shm + A_K + ((it + 1) & 3) * 8192, qr, r32, hi);
        }
        const int kb = kt * 64 + 4 * hi;
        if (SWA) {
#pragma unroll
            for (int r = 0; r < 16; ++r) { const int k0 = kb + (r & 3) + 8 * (r >> 2), k1 = k0 + 32;
                p0[r] = (k0 <= qpos && k0 >= qpos - 127) ? p0[r] + sl2 * (float)(k0 - qpos) : -INFINITY;
                p1[r] = (k1 <= qpos && k1 >= qpos - 127) ? p1[r] + sl2 * (float)(k1 - qpos) : -INFINITY; }
        } else {
#pragma unroll
            for (int g = 0; g < 4; ++g) { const f32x4 b0 = *(const LAS f32x4*)(biasl + kb + 8 * g), b1 = *(const LAS f32x4*)(biasl + kb + 32 + 8 * g);
#pragma unroll
                for (int i = 0; i < 4; ++i) { p0[4 * g + i] += b0[i]; p1[4 * g + i] += b1[i]; } }
            if (kt * 64 + 63 > qpos0) {
#pragma unroll
                for (int r = 0; r < 16; ++r) { const int k0 = kb + (r & 3) + 8 * (r >> 2); if (k0 > qpos) p0[r] = -INFINITY; if (k0 + 32 > qpos) p1[r] = -INFINITY; }
            }
        }
        const float rm = rowmax32(p0, p1), mn = fmaxf(m, rm), ms = (mn == -INFINITY) ? 0.f : mn;
        const float alpha = __builtin_amdgcn_exp2f(m - ms);
        float rs = 0.f;
#pragma unroll
        for (int r = 0; r < 16; ++r) { p0[r] = __builtin_amdgcn_exp2f(p0[r] - ms); p1[r] = __builtin_amdgcn_exp2f(p1[r] - ms); rs += p0[r] + p1[r]; }
        l = l * alpha + rs; m = mn;
        if (hi == 0) wsf[r32] = alpha;
        asm volatile("s_waitcnt lgkmcnt(0)" ::: "memory");
#pragma unroll
        for (int r = 0; r < 16; ++r) { const float a = wsf[crow(r, hi)]; o[0][r] *= a; o[1][r] *= a; }
        u32x4 pw0, pw1, pw2, pw3;
        pw0 = (u32x4){cvtpk(p0[0], p0[1]), cvtpk(p0[2], p0[3]), cvtpk(p0[4], p0[5]), cvtpk(p0[6], p0[7])};
        pw1 = (u32x4){cvtpk(p0[8], p0[9]), cvtpk(p0[10], p0[11]), cvtpk(p0[12], p0[13]), cvtpk(p0[14], p0[15])};
        pw2 = (u32x4){cvtpk(p1[0], p1[1]), cvtpk(p1[2], p1[3]), cvtpk(p1[4], p1[5]), cvtpk(p1[6], p1[7])};
        pw3 = (u32x4){cvtpk(p1[8], p1[9]), cvtpk(p1[10], p1[11]), cvtpk(p1[12], p1[13]), cvtpk(p1[14], p1[15])};
        pv(o, vb0 + slot, __builtin_bit_cast(bf16x8, pw0), __builtin_bit_cast(bf16x8, pw1), __builtin_bit_cast(bf16x8, pw2), __builtin_bit_cast(bf16x8, pw3));
        asm volatile("s_waitcnt lgkmcnt(0)" ::: "memory");
        if (it + 1 < ntile) { p0 = n0; p1 = n1; }
    }
    { auto rr = __builtin_amdgcn_permlane32_swap(__float_as_uint(l), __float_as_uint(l), false, false); l = __uint_as_float(rr[0]) + __uint_as_float(rr[1]); }
    if (hi == 0) wsf[32 + r32] = l;
    asm volatile("s_waitcnt lgkmcnt(0)" ::: "memory");
    LAS bf16_t* stg = (LAS bf16_t*)(shm + A_OST) + wid * 2048;
#pragma unroll
    for (int r = 0; r < 16; ++r) { const int orow = crow(r, hi); const float rl = 1.f / wsf[32 + orow];
#pragma unroll
        for (int d0 = 0; d0 < 2; ++d0) stg[orow * 64 + d0 * 32 + r32] = (bf16_t)(cvt_pk_bf16(o[d0][r] * rl, 0.f) & 0xffffu); }
    asm volatile("s_waitcnt lgkmcnt(0)" ::: "memory");
#pragma unroll
    for (int i = 0; i < 4; ++i) { const int row = i * 8 + (lane >> 3), ch = lane & 7; const u32x4 v = *(const LAS u32x4*)(stg + row * 64 + ch * 8); *(u32x4*)(Ow + (long)row * opitch + ch * 8) = v; }
    asm volatile("s_waitcnt vmcnt(0) lgkmcnt(0)\n\ts_barrier" ::: "memory");
#undef DMA_K
#undef DMA_V
}

__device__ __forceinline__ void fox_unit(LAS char* shm, int b, int h, int qb, const bf16_t* proj, const float* fb, float fbias_h, bf16_t* heads) {
    const int tid = threadIdx.x, lane = tid & 63; const int wid = __builtin_amdgcn_readfirstlane(tid >> 6);
    LAS float* biasl = (LAS float*)(shm + A_BIAS); LAS float* scan = (LAS float*)(shm + A_SCAN);
    const int kend = (qb + 1) * 256;
    float v[4]; float s = 0.f;
#pragma unroll
    for (int i = 0; i < 4; ++i) { const int p = tid * 4 + i; float lf = 0.f; if (p < kend) lf = log_sigmoid_fast(fb[((size_t)b * SEQ + p) * 8 + h] + fbias_h); s += lf; v[i] = s; }
    float w = s;
#pragma unroll
    for (int o = 1; o < 64; o <<= 1) { const float t = __shfl_up(w, o); if (lane >= o) w += t; }
    if (lane == 63) scan[wid] = w;
    asm volatile("s_waitcnt lgkmcnt(0)\n\ts_barrier" ::: "memory");
    float off = w - s;
    for (int k = 0; k < 8; ++k) if (k < wid) off += scan[k];
#pragma unroll
    for (int i = 0; i < 4; ++i) biasl[tid * 4 + i] = -(v[i] + off) * LOG2E;
    asm volatile("s_waitcnt lgkmcnt(0)\n\ts_barrier" ::: "memory");
    const size_t rowb = (size_t)b * SEQ; const int q0 = qb * 256 + wid * 32;
    attn_tiles<false>(shm, proj + (rowb + q0) * NE_IN + 768 + h * 64, NE_IN, proj + rowb * NE_IN + 1280 + h * 64, proj + rowb * NE_IN + 1792 + h * 64, NE_IN,
                      heads + (rowb + q0) * 1024 + 512 + h * 64, 1024, 0, 4 * (qb + 1), q0, 0.f, 0.f);
}
__device__ __forceinline__ void swa_unit(LAS char* shm, int b, int kvh, int blk, const bf16_t* proj, const float* sinks, bf16_t* heads) {
    const int wid = __builtin_amdgcn_readfirstlane(threadIdx.x >> 6);
    const int qh = kvh * 4 + (wid >> 1), q0 = blk * 64 + (wid & 1) * 32;
    const size_t rowb = (size_t)b * SEQ;
    const int kt0 = blk >= 2 ? blk - 2 : 0, ntile = blk - kt0 + 1;
    const float sl2 = exp2f(-(float)(qh + 1)) * LOG2E, sink2 = sinks[qh] * LOG2E;
    attn_tiles<true>(shm, proj + (rowb + q0) * NE_IN + qh * 64, NE_IN, proj + rowb * NE_IN + 512 + kvh * 64, proj + rowb * NE_IN + 640 + kvh * 64, NE_IN,
                     heads + (rowb + q0) * 1024 + qh * 64, 1024, kt0, ntile, q0, sl2, sink2);
}
#undef A_WAIT_BAR
}

namespace attp {
using bf16=__hip_bfloat16;
using bf16x8=__attribute__((ext_vector_type(8)))short;
using s16x4=__attribute__((ext_vector_type(4)))short;
using f32x16=__attribute__((ext_vector_type(16)))float;
using u32x4=__attribute__((ext_vector_type(4)))unsigned;
constexpr int BATCH=8,NHEAD=8,SEQ=2048,D=64,DM=2560,OPITCH=1024;
constexpr int NW=8,QBLK=32,QB=QBLK*NW,KVBLK=64,NQB=SEQ/QB;
constexpr int ATTN_PITCH=DM, ATTN_UNIT_ROWS=QB;
__device__ __forceinline__ int crow(int r,int hi){return (r&3)+8*(r>>2)+4*hi;}
#define SBAR() __builtin_amdgcn_sched_barrier(0)
__device__ __forceinline__ void cmask(f32x16&p0,f32x16&p1,int jb,int qrel,int hi){
  const float NEG=-INFINITY; int kb=64*jb+4*hi;
  #pragma unroll
  for(int r=0;r<16;++r){int kv=kb+(r&3)+8*(r>>2); if(kv>qrel)p0[r]=NEG; if(kv+32>qrel)p1[r]=NEG;}
}

constexpr int NSLOT=3, SLOTB=8192;
constexpr int LDS_K=0, LDS_V=NSLOT*SLOTB, LDS_WS=2*NSLOT*SLOTB, LDS_OST=LDS_WS+NW*64*4, LDS_BIAS=LDS_OST+NW*4096, LDS_SCAN=LDS_BIAS+8192, LDS_BYTES=LDS_SCAN+64;
constexpr float C2=0.125f*1.4426950408889634f;
__device__ __forceinline__ void glds16(const void*gsrc,unsigned lds_dst){unsigned keep;
  asm volatile("s_mov_b32 %0, m0\n\ts_mov_b32 m0, %2\n\ts_nop 0\n\tglobal_load_lds_dwordx4 %1, off\n\ts_mov_b32 m0, %0":"=&s"(keep):"v"(gsrc),"s"(lds_dst):"memory");}
__device__ __forceinline__ float max3f(float a,float b,float c){float r;asm("v_max3_f32 %0, %1, %2, %3":"=v"(r):"v"(a),"v"(b),"v"(c));return r;}
__device__ __forceinline__ float max2f(float a,float b){float r;asm("v_max_f32_e32 %0, %1, %2":"=v"(r):"v"(a),"v"(b));return r;}
__device__ __forceinline__ float fadd_s(float a,float b){float r;asm("v_add_f32_e32 %0, %1, %2":"=v"(r):"v"(a),"v"(b));return r;}
__device__ __forceinline__ float fsub_s(float a,float b){float r;asm("v_sub_f32_e32 %0, %1, %2":"=v"(r):"v"(a),"v"(b));return r;}
typedef float f32x2_t __attribute__((ext_vector_type(2))); typedef __bf16 bf16x2_t __attribute__((ext_vector_type(2)));
__device__ __forceinline__ unsigned cvtpk_s(float lo,float hi){f32x2_t v={lo,hi};bf16x2_t b=__builtin_convertvector(v,bf16x2_t);return __builtin_bit_cast(unsigned,b);}
#define WAIT_BAR(N) asm volatile("s_waitcnt vmcnt(" #N ") lgkmcnt(0)\n\ts_barrier":::"memory")

__device__ __forceinline__ void qkt(f32x16&p0,f32x16&p1,const char*Kslot,const bf16x8*qr,int r32,int hi){ const f32x16 zc_=f32x16{};
  const char*kb=Kslot+hi*1024+r32*16;
  #pragma unroll
  for(int d0=0;d0<4;++d0){
    const bf16x8 b0=*reinterpret_cast<const bf16x8*>(kb+d0*2048);
    const bf16x8 b1=*reinterpret_cast<const bf16x8*>(kb+d0*2048+512);
    if(d0==0){p0=__builtin_amdgcn_mfma_f32_32x32x16_bf16(b0,qr[0],zc_,0,0,0);p1=__builtin_amdgcn_mfma_f32_32x32x16_bf16(b1,qr[0],zc_,0,0,0);}
    else{p0=__builtin_amdgcn_mfma_f32_32x32x16_bf16(b0,qr[d0],p0,0,0,0);p1=__builtin_amdgcn_mfma_f32_32x32x16_bf16(b1,qr[d0],p1,0,0,0);}}
}
typedef __attribute__((address_space(3))) const char* lds_cptr;
typedef short v4i16_t __attribute__((ext_vector_type(4)));
__device__ __forceinline__ void kload8(bf16x8*kf,lds_cptr kp){
  kf[0]=*(const __attribute__((address_space(3))) bf16x8*)(kp);      kf[1]=*(const __attribute__((address_space(3))) bf16x8*)(kp+512);
  kf[2]=*(const __attribute__((address_space(3))) bf16x8*)(kp+2048); kf[3]=*(const __attribute__((address_space(3))) bf16x8*)(kp+2560);
  kf[4]=*(const __attribute__((address_space(3))) bf16x8*)(kp+4096); kf[5]=*(const __attribute__((address_space(3))) bf16x8*)(kp+4608);
  kf[6]=*(const __attribute__((address_space(3))) bf16x8*)(kp+6144); kf[7]=*(const __attribute__((address_space(3))) bf16x8*)(kp+6656);
}
__device__ __forceinline__ void kload2(bf16x8*kf,lds_cptr kp,int j){ kf[2*j]=*(const __attribute__((address_space(3))) bf16x8*)(kp+j*2048); kf[2*j+1]=*(const __attribute__((address_space(3))) bf16x8*)(kp+j*2048+512); }
__device__ __forceinline__ s16x4 vtr(lds_cptr p){ return __builtin_bit_cast(s16x4,__builtin_amdgcn_ds_read_tr16_b64_v4i16((__attribute__((address_space(3))) v4i16_t*)p)); }
__device__ __forceinline__ float rowmax(const f32x16&p0,const f32x16&p1){
  float a=max3f(p0[0],p0[1],p1[0]),b=max3f(p0[2],p0[3],p1[1]);a=max3f(a,p1[2],p1[3]);
  #pragma unroll
  for(int r=4;r<16;r+=4){a=max3f(a,p0[r],p0[r+1]);b=max3f(b,p0[r+2],p0[r+3]);a=max3f(a,p1[r],p1[r+1]);b=max3f(b,p1[r+2],p1[r+3]);}
  const float m=max2f(a,b);
  auto rr=__builtin_amdgcn_permlane32_swap(__float_as_uint(m),__float_as_uint(m),false,false);
  return max2f(__uint_as_float(rr[0]),__uint_as_float(rr[1]));
}
__device__ __forceinline__ void pv(f32x16*o,int vb,bf16x8 pa0,bf16x8 pa1,bf16x8 pa2,bf16x8 pa3){
  #pragma unroll
  for(int d0=0;d0<2;++d0){s16x4 lo[4],hi[4];
    #pragma unroll
    for(int ks=0;ks<4;++ks){
      asm volatile("ds_read_b64_tr_b16 %0,%1 offset:%c2":"=&v"(lo[ks]):"v"(vb),"i"(d0*4096+ks*1024):"memory");
      asm volatile("ds_read_b64_tr_b16 %0,%1 offset:%c2":"=&v"(hi[ks]):"v"(vb),"i"(d0*4096+ks*1024+512):"memory");}
    asm volatile("s_waitcnt lgkmcnt(0)":::"memory");SBAR();
    #define PK(k) (bf16x8){lo[k][0],lo[k][1],lo[k][2],lo[k][3],hi[k][0],hi[k][1],hi[k][2],hi[k][3]}
    o[d0]=__builtin_amdgcn_mfma_f32_32x32x16_bf16(pa0,PK(0),o[d0],0,0,0);
    o[d0]=__builtin_amdgcn_mfma_f32_32x32x16_bf16(pa1,PK(1),o[d0],0,0,0);
    o[d0]=__builtin_amdgcn_mfma_f32_32x32x16_bf16(pa2,PK(2),o[d0],0,0,0);
    o[d0]=__builtin_amdgcn_mfma_f32_32x32x16_bf16(pa3,PK(3),o[d0],0,0,0);
    #undef PK
  }
}

#ifndef ATTN_STORE16
#define ATTN_STORE16(p,v) (*(u32x4*)(p)=(v))
#endif
template<int THRL,bool CHECK> __device__ __forceinline__ void attn_unit(int b,int h,int qb,const bf16*Q,const bf16*__restrict__ K,const bf16*__restrict__ V,bf16*O,char*shm,unsigned*mism){
  const int tid=threadIdx.x,lane=tid&63,r32=lane&31,hi=lane>>5; const int wid=__builtin_amdgcn_readfirstlane(tid>>6);
  const long rowbase=(long)b*SEQ; const int q0=qb*QB;
  const bf16*Qw=Q+(rowbase+q0+wid*QBLK)*DM+h*D;
  const bf16*Kh=K+rowbase*DM+h*D,*Vh=V+rowbase*DM+h*D;
  const unsigned lds0=(unsigned)(uintptr_t)shm;
  float*wsf=(float*)(shm+LDS_WS)+wid*64;
  const bf16*ksrc=Kh+(long)lane*DM+wid*8;
  const bf16*vsrc=Vh+(long)(16*(wid&3)+(lane>>2))*DM+(wid>>2)*32+(lane&3)*8;
  const unsigned kdst=lds0+LDS_K+wid*1024, vdst=lds0+LDS_V+wid*1024;
  #define DMA_K(t,slot) glds16(ksrc+(long)(t)*KVBLK*DM,(unsigned)__builtin_amdgcn_readfirstlane(kdst+(slot)))
  #define DMA_V(t,slot) glds16(vsrc+(long)(t)*KVBLK*DM,(unsigned)__builtin_amdgcn_readfirstlane(vdst+(slot)))
  const int vb0=(int)(lds0+LDS_V)+((lane>>4)&1)*32+(lane&3)*8+(4*hi+((lane&15)>>2))*64;
  const char*Kbase=shm+LDS_K; bf16x8 kf[8];
  const lds_cptr shm3=(lds_cptr)shm; const lds_cptr kp0=shm3+LDS_K+hi*1024+r32*16; const lds_cptr vp0=shm3+LDS_V+((lane>>4)&1)*32+(lane&3)*8+(4*hi+((lane&15)>>2))*64;
  const int NT=(q0+QB)/KVBLK;
  DMA_K(0,0);DMA_V(0,0);DMA_K(1,SLOTB);
  bf16x8 qr[4];
  #pragma unroll
  for(int d0=0;d0<4;++d0)qr[d0]=*reinterpret_cast<const bf16x8*>(&Qw[(long)r32*DM+d0*16+hi*8]);
  float mhat=0.f,l_reg=0.f;f32x16 o[2];o[0]=f32x16{};o[1]=f32x16{};u32x4 qaw={hi==0?0x3f803f80u:0u,0u,0u,0u};
  const int qrel=wid*QBLK+r32;
  #define CMASK(P0,P1,t) do{int jb_=(t)-(NT-4); if(jb_>=0)cmask(P0,P1,jb_,qrel,hi);}while(0)
  const __attribute__((address_space(3))) unsigned* biasw=(const __attribute__((address_space(3))) unsigned*)(shm3+LDS_BIAS)+r32;
  #define SETM() do{ const float nm_=-mhat; const unsigned h_=cvtpk_s(nm_,0.f)&0xffffu; const unsigned l_=cvtpk_s(nm_-__uint_as_float(h_<<16),0.f)&0xffffu; qaw[1]=(hi==0)?(h_|(l_<<16)):0u; }while(0)
  #define AUG(P0,P1,t) do{ const unsigned w0_=biasw[64*(t)], w1_=biasw[64*(t)+32]; const u32x4 ka0_={w0_,0x3f803f80u,0u,0u}, ka1_={w1_,0x3f803f80u,0u,0u}; \
      P0=__builtin_amdgcn_mfma_f32_32x32x16_bf16(__builtin_bit_cast(bf16x8,ka0_),__builtin_bit_cast(bf16x8,qaw),P0,0,0,0); \
      P1=__builtin_amdgcn_mfma_f32_32x32x16_bf16(__builtin_bit_cast(bf16x8,ka1_),__builtin_bit_cast(bf16x8,qaw),P1,0,0,0); }while(0)
  bool resc=false;
  #define START(P0,P1) do{ const float rm=rowmax(P0,P1); resc=false; \
    { const float dl=rm; mhat=fadd_s(mhat,dl); \
      _Pragma("unroll") for(int r=0;r<16;++r){P0[r]=fsub_s(P0[r],dl);P1[r]=fsub_s(P1[r],dl);} \
      SETM(); } \
    _Pragma("unroll") for(int r=0;r<16;++r)P0[r]=__builtin_amdgcn_exp2f(P0[r]); }while(0)
  #define RESC() do{ if(resc){ asm volatile("s_waitcnt lgkmcnt(0)":::"memory"); \
      _Pragma("unroll") for(int d_=0;d_<2;++d_) _Pragma("unroll") for(int r=0;r<16;++r)o[d_][r]*=wsf[crow(r,hi)]; } }while(0)
  f32x16 pA0,pA1,pB0,pB1;
  int sl_prev=0,sl_cur=0,sl_next=SLOTB;
  #define ROT() do{sl_prev=sl_cur;sl_cur=sl_next;sl_next=(sl_next==(NSLOT-1)*SLOTB)?0:sl_next+SLOTB;}while(0)
  DMA_K(2,2*SLOTB);
  WAIT_BAR(3);
  qkt(pA0,pA1,Kbase,qr,r32,hi);AUG(pA0,pA1,0);asm volatile("s_nop 15\n\ts_nop 7":"+v"(pA0),"+v"(pA1));CMASK(pA0,pA1,0);
  START(pA0,pA1);
  _Pragma("unroll") for(int r=0;r<16;++r)pA1[r]=__builtin_amdgcn_exp2f(pA1[r]);
  WAIT_BAR(0);
  DMA_K(3,0);DMA_V(1,SLOTB);
  ROT();
  kload8(kf,kp0+sl_cur);
  WAIT_BAR(2);
  s16x4 vlo[8],vhi[8]; u32x4 pw0,pw1,pw2,pw3; const f32x16 zc16=f32x16{};
  #define PKW(P,B) cvtpk_s(P[B],P[B+1])
  #define PAF(k) __builtin_bit_cast(bf16x8,pw##k)
  #define VFR(i) (bf16x8){vlo[i][0],vlo[i][1],vlo[i][2],vlo[i][3],vhi[i][0],vhi[i][1],vhi[i][2],vhi[i][3]}
  #define PIN(x) asm volatile("":"+v"(x))
  #define MX3(a,b,c) __builtin_fmaxf(__builtin_fmaxf((a),(b)),(c))
  #define GAPA(MF,A0,A1,A2,A3,W0,W1,PW) do{ MF; sacc+=A0; sacc+=A1; sacc+=A2; sacc+=A3; PIN(sacc); W0; W1; PIN(PW); SBAR(); }while(0)
  #define EX(v) __builtin_amdgcn_exp2f(v)
  #define GAPB(MF,X,B) do{ MF; X[B]=EX(X[B]); X[B+1]=EX(X[B+1]); X[B+2]=EX(X[B+2]); X[B+3]=EX(X[B+3]); PIN(X); SBAR(); }while(0)
  #define VRD(i) do{ vlo[i]=vtr(vp_+(((i)>>2)*4096+((i)&3)*1024)); vhi[i]=vtr(vp_+(((i)>>2)*4096+((i)&3)*1024+512)); }while(0)
  #define KRD(G,j) do{ if(G){ kload2(kf,kp0+sl_next,j); SBAR(); } }while(0)
  #define STEP(C0,C1,P0,P1,t,GK,GV,GL) do{ SBAR(); \
    const lds_cptr vp_=vp0+sl_prev; \
    VRD(0); SBAR(); float sacc=(P0[0]+P0[1]); \
    GAPA(C0=__builtin_amdgcn_mfma_f32_32x32x16_bf16(kf[0],qr[0],zc16,0,0,0), P0[2],P0[3],P0[4],P0[5],     pw0[0]=PKW(P0,0), pw0[1]=PKW(P0,2), pw0); \
    VRD(4); SBAR(); GAPA(C1=__builtin_amdgcn_mfma_f32_32x32x16_bf16(kf[1],qr[0],zc16,0,0,0), P0[6],P0[7],P0[8],P0[9],     pw0[2]=PKW(P0,4), pw0[3]=PKW(P0,6), pw0); \
    VRD(1); SBAR(); GAPA(C0=__builtin_amdgcn_mfma_f32_32x32x16_bf16(kf[2],qr[1],C0,0,0,0),   P0[10],P0[11],P0[12],P0[13], pw1[0]=PKW(P0,8), pw1[1]=PKW(P0,10), pw1); \
    VRD(5); SBAR(); GAPA(C1=__builtin_amdgcn_mfma_f32_32x32x16_bf16(kf[3],qr[1],C1,0,0,0),   P0[14],P0[15],P1[0],P1[1],   pw1[2]=PKW(P0,12),pw1[3]=PKW(P0,14), pw1); \
    VRD(2); SBAR(); GAPA(C0=__builtin_amdgcn_mfma_f32_32x32x16_bf16(kf[4],qr[2],C0,0,0,0),   P1[2],P1[3],P1[4],P1[5],     pw2[0]=PKW(P1,0), pw2[1]=PKW(P1,2), pw2); \
    VRD(6); SBAR(); GAPA(C1=__builtin_amdgcn_mfma_f32_32x32x16_bf16(kf[5],qr[2],C1,0,0,0),   P1[6],P1[7],P1[8],P1[9],     pw2[2]=PKW(P1,4), pw2[3]=PKW(P1,6), pw2); \
    VRD(3); SBAR(); GAPA(C0=__builtin_amdgcn_mfma_f32_32x32x16_bf16(kf[6],qr[3],C0,0,0,0),   P1[10],P1[11],P1[12],P1[13], pw3[0]=PKW(P1,8), pw3[1]=PKW(P1,10), pw3); \
    VRD(7); SBAR(); GAPA(C1=__builtin_amdgcn_mfma_f32_32x32x16_bf16(kf[7],qr[3],C1,0,0,0),   P1[14],P1[15],0.f,0.f,       pw3[2]=PKW(P1,12),pw3[3]=PKW(P1,14), pw3); \
    AUG(C0,C1,t); l_reg+=sacc; \
    if(GK){DMA_K((t)+3,sl_cur);} if(GV){DMA_V((t)+1,sl_next);} \
    CMASK(C0,C1,t); \
    { float a=MX3(C0[0],C0[1],C1[0]),b=MX3(C0[2],C0[3],C1[1]); a=MX3(a,C1[2],C1[3]); \
      _Pragma("unroll") for(int r=4;r<16;r+=4){a=MX3(a,C0[r],C0[r+1]);b=MX3(b,C0[r+2],C0[r+3]);a=MX3(a,C1[r],C1[r+1]);b=MX3(b,C1[r+2],C1[r+3]);} \
      float rm=__builtin_fmaxf(a,b); { auto rr=__builtin_amdgcn_permlane32_swap(__float_as_uint(rm),__float_as_uint(rm),false,false); rm=__builtin_fmaxf(__uint_as_float(rr[0]),__uint_as_float(rr[1])); } \
      resc=false; \
      if(__builtin_expect(__any(rm>(float)THRL),0)){ const float dl=__builtin_fmaxf(rm,0.f); mhat+=dl; \
        _Pragma("unroll") for(int r=0;r<16;++r){C0[r]-=dl;C1[r]-=dl;} \
        SETM(); \
        const float f=__builtin_amdgcn_exp2f(-dl); l_reg*=f; if(hi==0)wsf[r32]=f; resc=true; } } \
    SBAR(); \
    GAPB(o[0]=__builtin_amdgcn_mfma_f32_32x32x16_bf16(PAF(0),VFR(0),o[0],0,0,0), C0,0); \
    GAPB(o[1]=__builtin_amdgcn_mfma_f32_32x32x16_bf16(PAF(0),VFR(4),o[1],0,0,0), C0,4); \
    KRD(GL,0); GAPB(o[0]=__builtin_amdgcn_mfma_f32_32x32x16_bf16(PAF(1),VFR(1),o[0],0,0,0), C0,8); \
    KRD(GL,1); GAPB(o[1]=__builtin_amdgcn_mfma_f32_32x32x16_bf16(PAF(1),VFR(5),o[1],0,0,0), C0,12); \
    KRD(GL,2); GAPB(o[0]=__builtin_amdgcn_mfma_f32_32x32x16_bf16(PAF(2),VFR(2),o[0],0,0,0), C1,0); \
    KRD(GL,3); GAPB(o[1]=__builtin_amdgcn_mfma_f32_32x32x16_bf16(PAF(2),VFR(6),o[1],0,0,0), C1,4); \
    GAPB(o[0]=__builtin_amdgcn_mfma_f32_32x32x16_bf16(PAF(3),VFR(3),o[0],0,0,0), C1,8); \
    GAPB(o[1]=__builtin_amdgcn_mfma_f32_32x32x16_bf16(PAF(3),VFR(7),o[1],0,0,0), C1,12); \
    }while(0)
  int t=1;
  #undef CMASK
  #define CMASK(P0,P1,t) do{}while(0)
  for(;t+5<NT;t+=2){
    STEP(pB0,pB1,pA0,pA1,t,true,true,true);     WAIT_BAR(2); RESC(); ROT();
    STEP(pA0,pA1,pB0,pB1,t+1,true,true,true);   WAIT_BAR(2); RESC(); ROT();
  }
  #undef CMASK
  #define CMASK(P0,P1,t) do{int jb_=(t)-(NT-4); if(jb_>=0)cmask(P0,P1,jb_,qrel,hi);}while(0)
  #define ENDW(tt) do{ if((tt)+3<NT){WAIT_BAR(2);} else if((tt)+2<NT){WAIT_BAR(1);} else {WAIT_BAR(0);} }while(0)
  for(;t+1<NT;t+=2){
    STEP(pB0,pB1,pA0,pA1,t,(t+3<NT),(t+1<NT),(t+1<NT));       ENDW(t);   RESC(); ROT();
    STEP(pA0,pA1,pB0,pB1,t+1,(t+4<NT),(t+2<NT),(t+2<NT));     ENDW(t+1); RESC(); ROT();
  }
  STEP(pB0,pB1,pA0,pA1,NT-1,false,false,false); RESC();
  { float sacc=pB0[0]+pB0[1]; _Pragma("unroll") for(int r=2;r<16;++r)sacc+=pB0[r]; _Pragma("unroll") for(int r=0;r<16;++r)sacc+=pB1[r]; l_reg+=sacc;
    pw0=(u32x4){PKW(pB0,0),PKW(pB0,2),PKW(pB0,4),PKW(pB0,6)};pw1=(u32x4){PKW(pB0,8),PKW(pB0,10),PKW(pB0,12),PKW(pB0,14)};pw2=(u32x4){PKW(pB1,0),PKW(pB1,2),PKW(pB1,4),PKW(pB1,6)};pw3=(u32x4){PKW(pB1,8),PKW(pB1,10),PKW(pB1,12),PKW(pB1,14)};
    SBAR(); pv(o,vb0+sl_cur,PAF(0),PAF(1),PAF(2),PAF(3)); }
  #undef PKW
  #undef PAF
  #undef VFR
  #undef PIN
  #undef MX3
  #undef GAPA
  #undef GAPB
  #undef EX
  #undef VRD
  #undef KRD
  #undef STEP
  #undef ENDW
  {auto rr=__builtin_amdgcn_permlane32_swap(__float_as_uint(l_reg),__float_as_uint(l_reg),false,false);l_reg=__uint_as_float(rr[0])+__uint_as_float(rr[1]);}
  if(hi==0)wsf[32+r32]=l_reg;asm volatile("s_waitcnt lgkmcnt(0)":::"memory");
  float rli[16];
  #pragma unroll
  for(int r=0;r<16;++r)rli[r]=__builtin_amdgcn_rcpf(wsf[32+crow(r,hi)]);
  bf16*Ow=O+(rowbase+q0+wid*QBLK)*OPITCH+h*D;
  { bf16*stg=(bf16*)(shm+LDS_OST)+wid*2048;
    #pragma unroll
    for(int r=0;r<16;++r){const int orow=crow(r,hi);
      #pragma unroll
      for(int d0=0;d0<2;++d0)stg[orow*64+d0*32+r32]=__float2bfloat16(o[d0][r]*rli[r]);}
    asm volatile("s_waitcnt lgkmcnt(0)":::"memory");
    #pragma unroll
    for(int i=0;i<4;++i){const int row=i*8+(lane>>3),ch=lane&7; const u32x4 v=*(const u32x4*)(stg+row*64+ch*8); ATTN_STORE16(Ow+(long)row*OPITCH+ch*8,v);} }
  asm volatile("s_waitcnt lgkmcnt(0)\n\ts_barrier":::"memory");
  #undef DMA_K
  #undef DMA_V
  #undef CMASK
  #undef AUG
  #undef SETM
  #undef START
  #undef RESC
  #undef ROT
}
constexpr int ATTN_LDS_BYTES=LDS_BYTES;
#undef SBAR
#undef WAIT_BAR
}

namespace att {
template <bool CHECK> __device__ __forceinline__ void fox_unit_p(char* shm_g, LAS char* shm, int b, int h, int qb, const bf16_t* proj, const float* fb, float fbias_h, bf16_t* heads, unsigned* mism, bool do_scan) {
    const int tid = threadIdx.x, lane = tid & 63; const int wid = __builtin_amdgcn_readfirstlane(tid >> 6);
    if (do_scan) {
    LAS unsigned* biasw = (LAS unsigned*)(shm + attp::LDS_BIAS); LAS float* scan = (LAS float*)(shm + attp::LDS_SCAN);
    const int kend = (qb + 1) * 256;
    float v[4]; float s = 0.f;
#pragma unroll
    for (int i = 0; i < 4; ++i) { const int p = tid * 4 + i; float lf = 0.f; if (p < kend) lf = log_sigmoid_fast(fb[((size_t)b * SEQ + p) * 8 + h] + fbias_h); s += lf; v[i] = s; }
    float w = s;
#pragma unroll
    for (int o = 1; o < 64; o <<= 1) { const float t = __shfl_up(w, o); if (lane >= o) w += t; }
    if (lane == 63) scan[wid] = w;
    asm volatile("s_waitcnt lgkmcnt(0)\n\ts_barrier" ::: "memory");
    float off = w - s;
    for (int k = 0; k < 8; ++k) if (k < wid) off += scan[k];
#pragma unroll
    for (int i = 0; i < 4; ++i) { const float bv = -(v[i] + off) * LOG2E; const unsigned hb = cvt_pk_bf16(bv, 0.f) & 0xffffu; const unsigned lb = cvt_pk_bf16(bv - __uint_as_float(hb << 16), 0.f) & 0xffffu; biasw[tid * 4 + i] = hb | (lb << 16); }
    asm volatile("s_waitcnt vmcnt(0) lgkmcnt(0)\n\ts_barrier" ::: "memory");
    }
    attp::attn_unit<8, CHECK>(b, h, qb, (const attp::bf16*)(proj + 768), (const attp::bf16*)(proj + 1280), (const attp::bf16*)(proj + 1792), (attp::bf16*)(heads + 512), shm_g, mism);
    asm volatile("s_waitcnt vmcnt(0)" ::: "memory");
}
}
namespace mx {
using namespace mk;
constexpr size_t WS_QD = WS_XN, WS_KI = WS_XN + 16 * MiB, WS_DTV = 456 * MiB, WS_ACS = 457 * MiB, WS_KE = 458 * MiB, WS_DEC = 474 * MiB;
constexpr int XROW = 144;
__device__ __forceinline__ s16x4 tr_read(unsigned addr) { s16x4 r; asm volatile("ds_read_b64_tr_b16 %0, %1" : "=v"(r) : "v"(addr) : "memory"); return r; }
template <int OFF> __device__ __forceinline__ s16x4 tr_read_o(unsigned addr) { s16x4 r; asm volatile("ds_read_b64_tr_b16 %0, %1 offset:%2" : "=v"(r) : "v"(addr), "i"(OFF) : "memory"); return r; }
#define MX_LGKM0() do { asm volatile("s_waitcnt lgkmcnt(0)" ::: "memory"); __builtin_amdgcn_sched_barrier(0); } while (0)
#define MX_BAR() asm volatile("s_waitcnt vmcnt(0) lgkmcnt(0)\n\ts_barrier" ::: "memory")
#define MX_BAR_L() asm volatile("s_waitcnt lgkmcnt(0)\n\ts_barrier" ::: "memory")
__device__ __forceinline__ bf16x8 cat8(s16x4 lo, s16x4 hi) { return (bf16x8){lo[0], lo[1], lo[2], lo[3], hi[0], hi[1], hi[2], hi[3]}; }
__device__ __forceinline__ unsigned sw256(int row, int ch) { return (unsigned)(row * 256 + ((ch ^ (row & 15)) << 4)); }

__device__ __forceinline__ void prep_conv(const bf16_t* PROJ, bf16_t* CONV, const float* conv_w, const float* conv_b, int vcu, int G, int tid) {
    for (int item = vcu * NTHR + tid; item < (T / 8) * 192; item += G * NTHR) {
        const int cg = item % 192, rb = item / 192, ch0 = cg * 8, row0 = rb * 8, t0 = row0 & (SEQ - 1);
        float w[4][8], bs[8], xw[3][8];
#pragma unroll
        for (int j = 0; j < 4; ++j) { const f32x4 a = *(const f32x4*)(conv_w + j * 1536 + ch0), b = *(const f32x4*)(conv_w + j * 1536 + ch0 + 4);
#pragma unroll
            for (int i = 0; i < 4; ++i) { w[j][i] = a[i]; w[j][4 + i] = b[i]; } }
        { const f32x4 a = *(const f32x4*)(conv_b + ch0), b = *(const f32x4*)(conv_b + ch0 + 4);
#pragma unroll
          for (int i = 0; i < 4; ++i) { bs[i] = a[i]; bs[4 + i] = b[i]; } }
#pragma unroll
        for (int j = 0; j < 3; ++j) { const int tt = t0 - 3 + j;
            u32x4 v = {0u, 0u, 0u, 0u}; if (tt >= 0) v = *(const u32x4*)(PROJ + (size_t)(row0 - 3 + j) * NO_IN + 1024 + ch0);
#pragma unroll
            for (int i = 0; i < 4; ++i) { xw[j][2 * i] = __uint_as_float(v[i] << 16); xw[j][2 * i + 1] = __uint_as_float(v[i] & 0xffff0000u); } }
        u32x4 vr[8];
#pragma unroll
        for (int r = 0; r < 8; ++r) vr[r] = __builtin_nontemporal_load((const u32x4*)(PROJ + (size_t)(row0 + r) * NO_IN + 1024 + ch0));
#pragma unroll
        for (int r = 0; r < 8; ++r) {
            const u32x4 v = vr[r];
            float x3[8], o[8];
#pragma unroll
            for (int i = 0; i < 4; ++i) { x3[2 * i] = __uint_as_float(v[i] << 16); x3[2 * i + 1] = __uint_as_float(v[i] & 0xffff0000u); }
#pragma unroll
            for (int i = 0; i < 8; ++i) { const float a = bs[i] + w[0][i] * xw[0][i] + w[1][i] * xw[1][i] + w[2][i] * xw[2][i] + w[3][i] * x3[i]; o[i] = siluf(a);
                xw[0][i] = xw[1][i]; xw[1][i] = xw[2][i]; xw[2][i] = x3[i]; }
            u32x4 ov; ov.x = cvt_pk_bf16(o[0], o[1]); ov.y = cvt_pk_bf16(o[2], o[3]); ov.z = cvt_pk_bf16(o[4], o[5]); ov.w = cvt_pk_bf16(o[6], o[7]);
            *(u32x4*)(CONV + (size_t)(row0 + r) * 1536 + ch0) = ov;
        }
    }
}
__device__ __forceinline__ void prep_ssd(const float* DTG, float* DTV, float* ACS, const float* dt_bias, const float* a_log, int vcu, int G, int lane, int wave) {
    const int gw = vcu * NWAVES + wave, ngw = G * NWAVES;
    for (int item = gw; item < NBATCH * 32 * 16; item += ngw) {
        const int h = item & 15, c = (item >> 4) & 31, b = item >> 9; const size_t r0 = (size_t)b * SEQ + c * 64 + lane;
        const float a = -expf(a_log[h]), db = dt_bias[h];
        const float d0 = softplusf(DTG[r0 * 32 + h] + db);
        float w = a * d0;
#pragma unroll
        for (int o = 1; o < 64; o <<= 1) { const float t = __shfl_up(w, o); if (lane >= o) w += t; }
        ACS[r0 * 16 + h] = w; DTV[r0 * 16 + h] = d0;
    }
}
__device__ __forceinline__ void prep_gla(const bf16_t* PROJ, const float* DTG, bf16_t* QD, bf16_t* KI, bf16_t* KE, float* DEC, const float* gk_w, const float* gk_b, int vcu, int G, int tid, int lane, int wave, LAS char* shm) {
    {
        LAS float* gl = (LAS float*)(shm);
        LAS float* tot = (LAS float*)(shm + 8192);
        const int half = wave >> 2, rq = wave & 3, t256 = tid & 255;
        for (int pair = vcu; pair < NBATCH * 32 * 4 / 2; pair += G) {
            const int item = pair * 2 + half; const int h = item & 3, c = (item >> 2) & 31, b = item >> 7; const size_t r0 = (size_t)b * SEQ + c * 64;
            unsigned short qv[16][2], kv[16][2];
#pragma unroll
            for (int r = 0; r < 16; ++r) { const bf16_t* pr = PROJ + (r0 + rq * 16 + r) * NO_IN;
                qv[r][0] = pr[2560 + h * 128 + lane]; qv[r][1] = pr[2560 + h * 128 + 64 + lane]; kv[r][0] = pr[3072 + h * 128 + lane]; kv[r][1] = pr[3072 + h * 128 + 64 + lane]; }
            float w0[16], w1[16];
#pragma unroll
            for (int j = 0; j < 16; ++j) { w0[j] = gk_w[j * 512 + h * 128 + lane]; w1[j] = gk_w[j * 512 + h * 128 + 64 + lane]; }
            const float b0 = gk_b[h * 128 + lane], b1 = gk_b[h * 128 + 64 + lane];
            { const int rr = t256 >> 2, q4 = t256 & 3; *(LAS f32x4*)(gl + half * 1024 + rr * 16 + q4 * 4) = *(const f32x4*)(DTG + (r0 + rr) * 32 + 16 + q4 * 4); }
            asm volatile("s_waitcnt vmcnt(0) lgkmcnt(0)\n\ts_barrier" ::: "memory");
            float c0[16], c1[16]; float run0 = 0.f, run1 = 0.f;
#pragma unroll
            for (int r = 0; r < 16; ++r) {
                const LAS f32x4* gp = (const LAS f32x4*)(gl + half * 1024 + (rq * 16 + r) * 16); float a0 = b0, a1 = b1;
#pragma unroll
                for (int q = 0; q < 4; ++q) { const f32x4 g = gp[q];
#pragma unroll
                    for (int i = 0; i < 4; ++i) { a0 += g[i] * w0[4 * q + i]; a1 += g[i] * w1[4 * q + i]; } }
                run0 += log_sigmoid_fast(a0) * (1.f / 16.f); run1 += log_sigmoid_fast(a1) * (1.f / 16.f); c0[r] = run0; c1[r] = run1;
            }
            tot[(half * 4 + rq) * 128 + lane] = run0; tot[(half * 4 + rq) * 128 + 64 + lane] = run1;
            asm volatile("s_waitcnt lgkmcnt(0)\n\ts_barrier" ::: "memory");
            float pre0 = 0.f, pre1 = 0.f, last0 = 0.f, last1 = 0.f;
#pragma unroll
            for (int q = 0; q < 4; ++q) { const float t0 = tot[(half * 4 + q) * 128 + lane], t1 = tot[(half * 4 + q) * 128 + 64 + lane]; if (q < rq) { pre0 += t0; pre1 += t1; } last0 += t0; last1 += t1; }
            const float scale = 0.08838834764831845f;
#pragma unroll
            for (int r = 0; r < 16; ++r) {
                const float g0 = pre0 + c0[r], g1 = pre1 + c1[r];
                const float q0 = bf2f(qv[r][0]), q1 = bf2f(qv[r][1]), k0 = bf2f(kv[r][0]), k1 = bf2f(kv[r][1]);
                const size_t o = (r0 + rq * 16 + r) * 512 + h * 128 + lane;
                QD[o] = (bf16_t)(cvt_pk_bf16(q0 * scale * __expf(g0), 0.f) & 0xffffu); QD[o + 64] = (bf16_t)(cvt_pk_bf16(q1 * scale * __expf(g1), 0.f) & 0xffffu);
                KI[o] = (bf16_t)(cvt_pk_bf16(k0 * __expf(-g0), 0.f) & 0xffffu); KI[o + 64] = (bf16_t)(cvt_pk_bf16(k1 * __expf(-g1), 0.f) & 0xffffu);
            }
            if (rq == 0) { DEC[((size_t)b * 32 + c) * 512 + h * 128 + lane] = __expf(last0); DEC[((size_t)b * 32 + c) * 512 + h * 128 + 64 + lane] = __expf(last1); }
            asm volatile("s_waitcnt lgkmcnt(0)\n\ts_barrier" ::: "memory");
        }
    }
}

constexpr int S_C = 0, S_B = 32768, S_X = 65536, S_XW = S_X + 128 * XROW, S_PREV = S_XW + 128 * XROW, S_ACS = S_PREV + 16384, S_DT = S_ACS + 512, S_YST = S_DT + 512, S_END = S_YST + 8 * 2304;
static_assert(S_END <= RING_BYTES, "SSD LDS");
__device__ __forceinline__ void ssd_unit(LAS char* shm, int b, int h, const bf16_t* CONV, const float* ACS, const float* DTV, float dsk, bf16_t* MIX) {
    const int tid = threadIdx.x, lane = tid & 63, fr = lane & 15, fq = lane >> 4; const int w = __builtin_amdgcn_readfirstlane(tid >> 6);
    const int g = h >> 3, row = tid >> 2, qd = tid & 3, l0 = 16 * w;
    const unsigned lds0 = (unsigned)(uintptr_t)shm;
    LAS float* acsl = (LAS float*)(shm + S_ACS); LAS float* dtl = (LAS float*)(shm + S_DT);
    f32x4 st[4];
#pragma unroll
    for (int i = 0; i < 4; ++i) st[i] = (f32x4){0.f, 0.f, 0.f, 0.f};
    u32x4 rc[4], rb[4], rx[2]; float racs, rdt, rend;
    const size_t seq0 = (size_t)b * SEQ;
#define SSD_LOAD(c) do { const size_t gr = seq0 + (size_t)(c) * 128 + row; const bf16_t* p = CONV + gr * 1536; \
        _Pragma("unroll") for (int i = 0; i < 4; ++i) { rc[i] = *(const u32x4*)(p + 1280 + g * 128 + qd * 32 + 8 * i); rb[i] = *(const u32x4*)(p + 1024 + g * 128 + qd * 32 + 8 * i); } \
        _Pragma("unroll") for (int i = 0; i < 2; ++i) rx[i] = *(const u32x4*)(p + h * 64 + qd * 16 + 8 * i); \
        racs = ACS[gr * 16 + h]; rdt = DTV[gr * 16 + h]; rend = ACS[(seq0 + (size_t)(c) * 128 + 127) * 16 + h]; } while (0)
#ifdef SSD_DUMMY
    SSD_LOAD(0);
    for (int c = 0; c < 16; ++c) {
#pragma unroll
        for (int i = 0; i < 4; ++i) { *(LAS u32x4*)(shm + S_C + sw256(row, qd * 4 + i)) = rc[i]; *(LAS u32x4*)(shm + S_B + sw256(row, qd * 4 + i)) = rb[i]; }
        const float wr = rdt * __expf(rend - racs);
#pragma unroll
        for (int i = 0; i < 2; ++i) { *(LAS u32x4*)(shm + S_X + row * XROW + qd * 32 + 16 * i) = rx[i];
            u32x4 o;
#pragma unroll
            for (int k = 0; k < 4; ++k) o[k] = cvt_pk_bf16(__uint_as_float(rx[i][k] << 16) * wr, __uint_as_float(rx[i][k] & 0xffff0000u) * wr);
            *(LAS u32x4*)(shm + S_XW + row * XROW + qd * 32 + 16 * i) = o; }
        if (qd == 0) { acsl[row] = racs; dtl[row] = rdt; }
        MX_BAR_L();
        if (c + 1 < 16) SSD_LOAD(c + 1);
        MX_BAR_L();
    }
#endif
#ifndef SSD_NOPREF
    SSD_LOAD(0);
#endif
    const unsigned xtr = lds0 + (unsigned)(((lane & 15) >> 2) * XROW + (lane & 3) * 8);
    for (int c = 0; c < 16; ++c) {
#ifdef SSD_NOPREF
        SSD_LOAD(c);
#endif
#ifdef SSD_REP_WR
        for (int rep_ = 0; rep_ < 2; ++rep_)
#endif
        {
#pragma unroll
            for (int i = 0; i < 4; ++i) { *(LAS u32x4*)(shm + S_C + sw256(row, qd * 4 + i)) = rc[i]; *(LAS u32x4*)(shm + S_B + sw256(row, qd * 4 + i)) = rb[i]; }
            const float wr = rdt * __expf(rend - racs);
#pragma unroll
            for (int i = 0; i < 2; ++i) { *(LAS u32x4*)(shm + S_X + row * XROW + qd * 32 + 16 * i) = rx[i];
                u32x4 o;
#pragma unroll
                for (int k = 0; k < 4; ++k) o[k] = cvt_pk_bf16(__uint_as_float(rx[i][k] << 16) * wr, __uint_as_float(rx[i][k] & 0xffff0000u) * wr);
                *(LAS u32x4*)(shm + S_XW + row * XROW + qd * 32 + 16 * i) = o; }
            if (qd == 0) { acsl[row] = racs; dtl[row] = rdt; }
#pragma unroll
            for (int pt = 0; pt < 4; ++pt) { u32x2 v; v.x = cvt_pk_bf16(st[pt][0], st[pt][1]); v.y = cvt_pk_bf16(st[pt][2], st[pt][3]);
                const int p = 16 * pt + fr; *(LAS u32x2*)(shm + S_PREV + sw256(p, 2 * w + (fq >> 1)) + (fq & 1) * 8) = v; }
        }
        MX_BAR_L();
#ifndef SSD_NOPREF
        if (c + 1 < 16) SSD_LOAD(c + 1);
#endif
        bf16x8 cf[4];
#pragma unroll
        for (int ks = 0; ks < 4; ++ks) cf[ks] = *(const LAS bf16x8*)(shm + S_C + sw256(l0 + fr, 4 * ks + fq));
        f32x4 yd[4], yo[4];
#pragma unroll
        for (int i = 0; i < 4; ++i) { yd[i] = (f32x4){0.f, 0.f, 0.f, 0.f}; yo[i] = (f32x4){0.f, 0.f, 0.f, 0.f}; }
        const float acs_l = acsl[l0 + fr]; const int lcol = l0 + fr;
        const int nsb = (w >> 1) + 1;
#ifdef SSD_REP_SB
        for (int rep_ = 0; rep_ < 2; ++rep_) {
#pragma unroll
        for (int i = 0; i < 4; ++i) yd[i] = (f32x4){0.f, 0.f, 0.f, 0.f};
#endif
        for (int sb = 0; sb < nsb; ++sb) {
            const int s0 = 32 * sb; const bool two = (2 * sb + 1) <= w;
            s16x4 lo[4], hi[4];
#pragma unroll
            for (int pt = 0; pt < 4; ++pt) { lo[pt] = tr_read(xtr + S_X + (unsigned)((s0 + 4 * fq) * XROW + pt * 32)); hi[pt] = tr_read(xtr + S_X + (unsigned)((s0 + 16 + 4 * fq) * XROW + pt * 32)); }
            f32x4 a0 = {0.f, 0.f, 0.f, 0.f}, a1 = {0.f, 0.f, 0.f, 0.f};
#pragma unroll
            for (int ks = 0; ks < 4; ++ks) { const bf16x8 bf = *(const LAS bf16x8*)(shm + S_B + sw256(s0 + fr, 4 * ks + fq)); a0 = __builtin_amdgcn_mfma_f32_16x16x32_bf16(bf, cf[ks], a0, 0, 0, 0); }
            if (two) {
#pragma unroll
                for (int ks = 0; ks < 4; ++ks) { const bf16x8 bf = *(const LAS bf16x8*)(shm + S_B + sw256(s0 + 16 + fr, 4 * ks + fq)); a1 = __builtin_amdgcn_mfma_f32_16x16x32_bf16(bf, cf[ks], a1, 0, 0, 0); }
            }
            const f32x4 as0 = *(const LAS f32x4*)(acsl + s0 + 4 * fq), as1 = *(const LAS f32x4*)(acsl + s0 + 16 + 4 * fq);
            const f32x4 dq0 = *(const LAS f32x4*)(dtl + s0 + 4 * fq), dq1 = *(const LAS f32x4*)(dtl + s0 + 16 + 4 * fq);
            float g0[4], g1[4];
#pragma unroll
            for (int i = 0; i < 4; ++i) { const int sa = s0 + 4 * fq + i, sb2 = sa + 16;
                g0[i] = (sa <= lcol) ? a0[i] * __expf(fminf(acs_l - as0[i], 0.f)) * dq0[i] : 0.f;
                g1[i] = (two && sb2 <= lcol) ? a1[i] * __expf(fminf(acs_l - as1[i], 0.f)) * dq1[i] : 0.f; }
            u32x4 ap; ap.x = cvt_pk_bf16(g0[0], g0[1]); ap.y = cvt_pk_bf16(g0[2], g0[3]); ap.z = cvt_pk_bf16(g1[0], g1[1]); ap.w = cvt_pk_bf16(g1[2], g1[3]);
            const bf16x8 af = __builtin_bit_cast(bf16x8, ap);
            MX_LGKM0();
#pragma unroll
            for (int pt = 0; pt < 4; ++pt) yd[pt] = __builtin_amdgcn_mfma_f32_16x16x32_bf16(af, cat8(lo[pt], hi[pt]), yd[pt], 0, 0, 0);
        }
#ifdef SSD_REP_SB
        }
#endif
#ifdef SSD_REP_YO
        for (int rep_ = 0; rep_ < 2; ++rep_) {
#pragma unroll
        for (int i = 0; i < 4; ++i) yo[i] = (f32x4){0.f, 0.f, 0.f, 0.f};
#endif
#pragma unroll
        for (int pt = 0; pt < 4; ++pt)
#pragma unroll
            for (int ks = 0; ks < 4; ++ks) { const bf16x8 pf = *(const LAS bf16x8*)(shm + S_PREV + sw256(16 * pt + fr, 4 * ks + fq)); yo[pt] = __builtin_amdgcn_mfma_f32_16x16x32_bf16(cf[ks], pf, yo[pt], 0, 0, 0); }
#ifdef SSD_REP_YO
        }
#endif
#ifdef SSD_REP_CS
        for (int rep_ = 0; rep_ < 2; ++rep_)
#endif
        {
            const f32x4 al = *(const LAS f32x4*)(acsl + l0 + 4 * fq);
            float ea[4];
#pragma unroll
            for (int i = 0; i < 4; ++i) ea[i] = __expf(al[i]);
            s16x4 xs[4];
#pragma unroll
            for (int pt = 0; pt < 4; ++pt) xs[pt] = tr_read(xtr + S_X + (unsigned)((l0 + 4 * fq) * XROW + pt * 32));
            MX_LGKM0();
            LAS bf16_t* yst = (LAS bf16_t*)(shm + S_YST + w * 2304);
#pragma unroll
            for (int pt = 0; pt < 4; ++pt)
#pragma unroll
                for (int i = 0; i < 4; ++i) { const float y = yd[pt][i] + ea[i] * yo[pt][i] + dsk * bf2f((unsigned short)xs[pt][i]);
                    yst[(4 * fq + i) * 72 + pt * 16 + fr] = (bf16_t)(cvt_pk_bf16(y, 0.f) & 0xffffu); }
            asm volatile("s_waitcnt lgkmcnt(0)" ::: "memory");
            bf16_t* yp = MIX + (seq0 + (size_t)c * 128 + l0) * 2048 + h * 64;
#pragma unroll
            for (int j = 0; j < 2; ++j) { const int rr = (lane >> 3) + 8 * j, ch = lane & 7; const u32x4 v = *(const LAS u32x4*)(yst + rr * 72 + ch * 8); *(u32x4*)(yp + (size_t)rr * 2048 + ch * 8) = v; }
        }
#ifdef SSD_REP_ST
        f32x4 stsave[4];
#pragma unroll
        for (int i = 0; i < 4; ++i) stsave[i] = st[i];
        for (int rep_ = 0; rep_ < 2; ++rep_) {
#pragma unroll
        for (int i = 0; i < 4; ++i) st[i] = stsave[i];
#endif
        {
            const float cd = __expf(acsl[127]);
#pragma unroll
            for (int pt = 0; pt < 4; ++pt) st[pt] = st[pt] * cd;
#pragma unroll
            for (int ks = 0; ks < 4; ++ks) {
                const int s0 = 32 * ks, q = (lane & 15) >> 2, p = lane & 3;
                const int r1 = s0 + 8 * fq + q, r2 = r1 + 4;
                const s16x4 alo = tr_read(lds0 + S_B + sw256(r1, 2 * w + (p >> 1)) + (p & 1) * 8), ahi = tr_read(lds0 + S_B + sw256(r2, 2 * w + (p >> 1)) + (p & 1) * 8);
                s16x4 lo[4], hi[4];
#pragma unroll
                for (int pt = 0; pt < 4; ++pt) { lo[pt] = tr_read(xtr + S_XW + (unsigned)((s0 + 8 * fq) * XROW + pt * 32)); hi[pt] = tr_read(xtr + S_XW + (unsigned)((s0 + 8 * fq + 4) * XROW + pt * 32)); }
                MX_LGKM0();
                const bf16x8 af = cat8(alo, ahi);
#pragma unroll
                for (int pt = 0; pt < 4; ++pt) st[pt] = __builtin_amdgcn_mfma_f32_16x16x32_bf16(af, cat8(lo[pt], hi[pt]), st[pt], 0, 0, 0);
            }
        }
#ifdef SSD_REP_ST
        }
#endif
        MX_BAR_L();
    }
    asm volatile("s_waitcnt vmcnt(0)" ::: "memory");
#undef SSD_LOAD
}

constexpr int S2_C = 0, S2_B = 16384, S2_X = 32768, S2_XW = S2_X + 64 * XROW, S2_ACS = S2_XW + 64 * XROW, S2_DT = S2_ACS + 256, S2_BUF = 53248, S2_PREV = 2 * S2_BUF, S2_END = S2_PREV + 2 * 16384;
static_assert(S2_DT + 256 <= S2_BUF && S2_END <= RING_BYTES, "SSD64 LDS");
__device__ __forceinline__ void ssd_unit64(LAS char* shm, int b, int h, const bf16_t* CONV, const float* ACS, const float* DTV, float dsk, bf16_t* MIX) {
    const int tid = threadIdx.x, lane = tid & 63, fr = lane & 15, fq = lane >> 4; const int w = __builtin_amdgcn_readfirstlane(tid >> 6);
    const int g = h >> 3, row = tid >> 3, ec = tid & 7, lt = w >> 1, l0 = 16 * lt, pt0 = 2 * (w & 1);
    const unsigned lds0 = (unsigned)(uintptr_t)shm;
    f32x4 st[4];
#pragma unroll
    for (int i = 0; i < 4; ++i) st[i] = (f32x4){0.f, 0.f, 0.f, 0.f};
    u32x4 rc[2], rb[2], rx; float racs, rdt, rend;
    const size_t seq0 = (size_t)b * SEQ;
#define S2_LOAD(c) do { const size_t gr = seq0 + (size_t)(c) * 64 + row; const bf16_t* p = CONV + gr * 1536; \
        _Pragma("unroll") for (int i = 0; i < 2; ++i) { rc[i] = *(const u32x4*)(p + 1280 + g * 128 + ec * 16 + 8 * i); rb[i] = *(const u32x4*)(p + 1024 + g * 128 + ec * 16 + 8 * i); } \
        rx = *(const u32x4*)(p + h * 64 + ec * 8); \
        racs = ACS[gr * 16 + h]; rdt = DTV[gr * 16 + h]; rend = ACS[(seq0 + (size_t)(c) * 64 + 63) * 16 + h]; } while (0)
#define S2_WRITE(pb) do { LAS char* gb_ = shm + (pb) * S2_BUF; \
        _Pragma("unroll") for (int i = 0; i < 2; ++i) { *(LAS u32x4*)(gb_ + S2_C + sw256(row, ec * 2 + i)) = rc[i]; *(LAS u32x4*)(gb_ + S2_B + sw256(row, ec * 2 + i)) = rb[i]; } \
        *(LAS u32x4*)(gb_ + S2_X + row * XROW + ec * 16) = rx; \
        { const float wr_ = rdt * __expf(rend - racs); u32x4 o_; \
          _Pragma("unroll") for (int k = 0; k < 4; ++k) o_[k] = cvt_pk_bf16(__uint_as_float(rx[k] << 16) * wr_, __uint_as_float(rx[k] & 0xffff0000u) * wr_); \
          *(LAS u32x4*)(gb_ + S2_XW + row * XROW + ec * 16) = o_; } \
        if (ec == 0) { ((LAS float*)(gb_ + S2_ACS))[row] = racs; ((LAS float*)(gb_ + S2_DT))[row] = rdt; } \
        _Pragma("unroll") for (int pt = 0; pt < 4; ++pt) { u32x2 v; v.x = cvt_pk_bf16(st[pt][0], st[pt][1]); v.y = cvt_pk_bf16(st[pt][2], st[pt][3]); \
            const int p_ = 16 * pt + fr; *(LAS u32x2*)(shm + S2_PREV + (pb) * 16384 + sw256(p_, 2 * w + (fq >> 1)) + (fq & 1) * 8) = v; } } while (0)
    S2_LOAD(0);
    S2_WRITE(0);
    MX_BAR_L();
    unsigned swz[4];
#pragma unroll
    for (int ks = 0; ks < 4; ++ks) swz[ks] = (unsigned)(fr * 256 + (((4 * ks + fq) ^ fr) << 4));
    const int q_ = (lane & 15) >> 2, p_ = lane & 3;
    const unsigned xq4 = (unsigned)((4 * fq + q_) * XROW + p_ * 8), xq8 = (unsigned)((8 * fq + q_) * XROW + p_ * 8);
    const int ra = 8 * fq + q_, rb2 = ra + 4;
    const unsigned bt1 = (unsigned)(ra * 256 + (((2 * w + (p_ >> 1)) ^ (ra & 15)) << 4) + (p_ & 1) * 8), bt2 = (unsigned)(rb2 * 256 + (((2 * w + (p_ >> 1)) ^ (rb2 & 15)) << 4) + (p_ & 1) * 8);
    for (int c = 0; c < 32; ++c) {
        const int pb = c & 1; LAS char* gb = shm + pb * S2_BUF; const unsigned gba = lds0 + (unsigned)(pb * S2_BUF);
        const LAS float* acsl = (const LAS float*)(gb + S2_ACS); const LAS float* dtl = (const LAS float*)(gb + S2_DT);
        if (c + 1 < 32) S2_LOAD(c + 1);
        const LAS char* cbp[4]; const LAS char* pvp[4];
#pragma unroll
        for (int ks = 0; ks < 4; ++ks) { cbp[ks] = gb + swz[ks]; pvp[ks] = shm + S2_PREV + pb * 16384 + pt0 * 4096 + swz[ks]; }
        const unsigned xa4 = gba + xq4 + (unsigned)(pt0 * 32), xa8 = gba + xq8, ba1 = gba + bt1, ba2 = gba + bt2;
        bf16x8 cf[4];
#pragma unroll
        for (int ks = 0; ks < 4; ++ks) cf[ks] = *(const LAS bf16x8*)(cbp[ks] + S2_C + l0 * 256);
        f32x4 yd[2], yo[2];
#pragma unroll
        for (int i = 0; i < 2; ++i) { yd[i] = (f32x4){0.f, 0.f, 0.f, 0.f}; yo[i] = (f32x4){0.f, 0.f, 0.f, 0.f}; }
        const float acs_l = acsl[l0 + fr]; const int lcol = l0 + fr;
#pragma unroll
        for (int sb = 0; sb < 2; ++sb) if (2 * sb <= lt) {
            constexpr int dummy = 0; (void)dummy;
            const int s0 = 32 * sb; const bool two = (2 * sb + 1) <= lt;
            s16x4 lo[2], hi[2];
            if (sb == 0) { lo[0] = tr_read_o<S2_X>(xa4); lo[1] = tr_read_o<S2_X + 32>(xa4); hi[0] = tr_read_o<S2_X + 16 * XROW>(xa4); hi[1] = tr_read_o<S2_X + 16 * XROW + 32>(xa4); }
            else         { lo[0] = tr_read_o<S2_X + 32 * XROW>(xa4); lo[1] = tr_read_o<S2_X + 32 * XROW + 32>(xa4); hi[0] = tr_read_o<S2_X + 48 * XROW>(xa4); hi[1] = tr_read_o<S2_X + 48 * XROW + 32>(xa4); }
            f32x4 a0 = {0.f, 0.f, 0.f, 0.f}, a1 = {0.f, 0.f, 0.f, 0.f};
#pragma unroll
            for (int ks = 0; ks < 4; ++ks) { const bf16x8 bf = *(const LAS bf16x8*)(cbp[ks] + S2_B + s0 * 256); a0 = __builtin_amdgcn_mfma_f32_16x16x32_bf16(bf, cf[ks], a0, 0, 0, 0); }
            if (two) {
#pragma unroll
                for (int ks = 0; ks < 4; ++ks) { const bf16x8 bf = *(const LAS bf16x8*)(cbp[ks] + S2_B + (s0 + 16) * 256); a1 = __builtin_amdgcn_mfma_f32_16x16x32_bf16(bf, cf[ks], a1, 0, 0, 0); }
            }
            const f32x4 as0 = *(const LAS f32x4*)(acsl + s0 + 4 * fq), as1 = *(const LAS f32x4*)(acsl + s0 + 16 + 4 * fq);
            const f32x4 dq0 = *(const LAS f32x4*)(dtl + s0 + 4 * fq), dq1 = *(const LAS f32x4*)(dtl + s0 + 16 + 4 * fq);
            float g0[4], g1[4];
#pragma unroll
            for (int i = 0; i < 4; ++i) { g0[i] = a0[i] * __expf(acs_l - as0[i]) * dq0[i]; g1[i] = a1[i] * __expf(acs_l - as1[i]) * dq1[i]; }
            if (2 * sb == lt) {
#pragma unroll
                for (int i = 0; i < 4; ++i) { if (s0 + 4 * fq + i > lcol) g0[i] = 0.f; }
            }
            if (!two) {
#pragma unroll
                for (int i = 0; i < 4; ++i) g1[i] = 0.f;
            } else if (2 * sb + 1 == lt) {
#pragma unroll
                for (int i = 0; i < 4; ++i) { if (s0 + 16 + 4 * fq + i > lcol) g1[i] = 0.f; }
            }
            u32x4 ap; ap.x = cvt_pk_bf16(g0[0], g0[1]); ap.y = cvt_pk_bf16(g0[2], g0[3]); ap.z = cvt_pk_bf16(g1[0], g1[1]); ap.w = cvt_pk_bf16(g1[2], g1[3]);
            const bf16x8 af = __builtin_bit_cast(bf16x8, ap);
            MX_LGKM0();
#pragma unroll
            for (int vi = 0; vi < 2; ++vi) yd[vi] = __builtin_amdgcn_mfma_f32_16x16x32_bf16(af, cat8(lo[vi], hi[vi]), yd[vi], 0, 0, 0);
        }
#pragma unroll
        for (int vi = 0; vi < 2; ++vi)
#pragma unroll
            for (int ks = 0; ks < 4; ++ks) { const bf16x8 pf = *(const LAS bf16x8*)(pvp[ks] + vi * 4096); yo[vi] = __builtin_amdgcn_mfma_f32_16x16x32_bf16(cf[ks], pf, yo[vi], 0, 0, 0); }
        {
            const f32x4 al = *(const LAS f32x4*)(acsl + l0 + 4 * fq);
            float ea[4];
#pragma unroll
            for (int i = 0; i < 4; ++i) ea[i] = __expf(al[i]);
            const unsigned xl = xa4 + (unsigned)(l0 * XROW);
            s16x4 xs[2]; xs[0] = tr_read_o<S2_X>(xl); xs[1] = tr_read_o<S2_X + 32>(xl);
            MX_LGKM0();
            bf16_t* yp = MIX + (seq0 + (size_t)c * 64 + l0 + 4 * fq) * 2048 + h * 64 + pt0 * 16 + fr;
#pragma unroll
            for (int vi = 0; vi < 2; ++vi)
#pragma unroll
                for (int i = 0; i < 4; ++i) { const float y = yd[vi][i] + ea[i] * yo[vi][i] + dsk * bf2f((unsigned short)xs[vi][i]);
                    yp[(size_t)i * 2048 + vi * 16] = (bf16_t)(cvt_pk_bf16(y, 0.f) & 0xffffu); }
        }
        {
            const float cd = __expf(acsl[63]);
#pragma unroll
            for (int pt = 0; pt < 4; ++pt) st[pt] = st[pt] * cd;
            {   s16x4 lo[4], hi[4];
                const s16x4 alo = tr_read_o<S2_B>(ba1), ahi = tr_read_o<S2_B>(ba2);
                lo[0] = tr_read_o<S2_XW>(xa8); lo[1] = tr_read_o<S2_XW + 32>(xa8); lo[2] = tr_read_o<S2_XW + 64>(xa8); lo[3] = tr_read_o<S2_XW + 96>(xa8);
                hi[0] = tr_read_o<S2_XW + 4 * XROW>(xa8); hi[1] = tr_read_o<S2_XW + 4 * XROW + 32>(xa8); hi[2] = tr_read_o<S2_XW + 4 * XROW + 64>(xa8); hi[3] = tr_read_o<S2_XW + 4 * XROW + 96>(xa8);
                MX_LGKM0();
                const bf16x8 af = cat8(alo, ahi);
#pragma unroll
                for (int pt = 0; pt < 4; ++pt) st[pt] = __builtin_amdgcn_mfma_f32_16x16x32_bf16(af, cat8(lo[pt], hi[pt]), st[pt], 0, 0, 0); }
            {   s16x4 lo[4], hi[4];
                const s16x4 alo = tr_read_o<S2_B + 32 * 256>(ba1), ahi = tr_read_o<S2_B + 32 * 256>(ba2);
                lo[0] = tr_read_o<S2_XW + 32 * XROW>(xa8); lo[1] = tr_read_o<S2_XW + 32 * XROW + 32>(xa8); lo[2] = tr_read_o<S2_XW + 32 * XROW + 64>(xa8); lo[3] = tr_read_o<S2_XW + 32 * XROW + 96>(xa8);
                hi[0] = tr_read_o<S2_XW + 36 * XROW>(xa8); hi[1] = tr_read_o<S2_XW + 36 * XROW + 32>(xa8); hi[2] = tr_read_o<S2_XW + 36 * XROW + 64>(xa8); hi[3] = tr_read_o<S2_XW + 36 * XROW + 96>(xa8);
                MX_LGKM0();
                const bf16x8 af = cat8(alo, ahi);
#pragma unroll
                for (int pt = 0; pt < 4; ++pt) st[pt] = __builtin_amdgcn_mfma_f32_16x16x32_bf16(af, cat8(lo[pt], hi[pt]), st[pt], 0, 0, 0); }
        }
        if (c + 1 < 32) S2_WRITE(pb ^ 1);
        MX_BAR_L();
    }
    asm volatile("s_waitcnt vmcnt(0)" ::: "memory");
#undef S2_LOAD
#undef S2_WRITE
}

constexpr int G_QD = 0, G_KI = 16384, G_V = 32768, G_DEC = G_V + 64 * XROW, G_BUF = 45056, G_SP = 2 * G_BUF, G_END = G_SP + 2 * 16384;
static_assert(G_DEC + 512 <= G_BUF && G_END <= RING_BYTES, "GLA LDS");
template <bool CHECK> __device__ __forceinline__ void gla_unit(LAS char* shm, int b, int h, int vs, const bf16_t* PROJ, const bf16_t* QD, const bf16_t* KI, const float* DEC, bf16_t* MIX, unsigned* mismatch) {
    const int tid = threadIdx.x, lane = tid & 63, fr = lane & 15, fq = lane >> 4; const int w = __builtin_amdgcn_readfirstlane(tid >> 6);
    const int row = tid >> 3, ec = tid & 7, lt = w >> 1, l0 = 16 * lt, vt0 = 2 * (w & 1);
    const unsigned lds0 = (unsigned)(uintptr_t)shm;
    f32x4 st[4];
#pragma unroll
    for (int i = 0; i < 4; ++i) st[i] = (f32x4){0.f, 0.f, 0.f, 0.f};
    u32x4 rq[2], rk[2], rv; float rdec = 0.f;
    const size_t seq0 = (size_t)b * SEQ;
#define GLA_LOAD(c) do { const size_t gr = seq0 + (size_t)(c) * 64 + row; const size_t o = gr * 512 + h * 128 + ec * 16; \
        _Pragma("unroll") for (int i = 0; i < 2; ++i) { rq[i] = *(const u32x4*)(QD + o + 8 * i); rk[i] = *(const u32x4*)(KI + o + 8 * i); } \
        rv = *(const u32x4*)(PROJ + gr * NO_IN + 3584 + h * 256 + vs * 64 + ec * 8); \
        if (tid < 128) rdec = DEC[((size_t)b * 32 + (c)) * 512 + h * 128 + tid]; } while (0)
#define GLA_WRITE(pb) do { LAS char* gb_ = shm + (pb) * G_BUF; \
        _Pragma("unroll") for (int i = 0; i < 2; ++i) { *(LAS u32x4*)(gb_ + G_QD + sw256(row, ec * 2 + i)) = rq[i]; *(LAS u32x4*)(gb_ + G_KI + sw256(row, ec * 2 + i)) = rk[i]; } \
        *(LAS u32x4*)(gb_ + G_V + row * XROW + ec * 16) = rv; \
        if (tid < 128) ((LAS float*)(gb_ + G_DEC))[tid] = rdec; \
        _Pragma("unroll") for (int vt = 0; vt < 4; ++vt) { u32x2 v; v.x = cvt_pk_bf16(st[vt][0], st[vt][1]); v.y = cvt_pk_bf16(st[vt][2], st[vt][3]); \
            const int vv = 16 * vt + fr; *(LAS u32x2*)(shm + G_SP + (pb) * 16384 + sw256(vv, 2 * w + (fq >> 1)) + (fq & 1) * 8) = v; } } while (0)
    GLA_LOAD(0);
    GLA_WRITE(0);
    MX_BAR_L();
    const unsigned xtr = lds0 + (unsigned)(((lane & 15) >> 2) * XROW + (lane & 3) * 8);
    for (int c = 0; c < 32; ++c) {
        const int pb = c & 1; LAS char* gb = shm + pb * G_BUF; const unsigned gbo = (unsigned)(pb * G_BUF); LAS char* sp = shm + G_SP + pb * 16384;
        if (c + 1 < 32) GLA_LOAD(c + 1);
        bf16x8 qf[4];
#pragma unroll
        for (int ks = 0; ks < 4; ++ks) qf[ks] = *(const LAS bf16x8*)(gb + G_QD + sw256(l0 + fr, 4 * ks + fq));
        f32x4 o[2]; o[0] = (f32x4){0.f, 0.f, 0.f, 0.f}; o[1] = (f32x4){0.f, 0.f, 0.f, 0.f};
        const int lcol = l0 + fr; const int nsb = (lt >> 1) + 1;
        for (int sb = 0; sb < nsb; ++sb) {
            const int s0 = 32 * sb; const bool two = (2 * sb + 1) <= lt;
            f32x4 a0 = {0.f, 0.f, 0.f, 0.f}, a1 = {0.f, 0.f, 0.f, 0.f};
#pragma unroll
            for (int ks = 0; ks < 4; ++ks) { const bf16x8 kf = *(const LAS bf16x8*)(gb + G_KI + sw256(s0 + fr, 4 * ks + fq)); a0 = __builtin_amdgcn_mfma_f32_16x16x32_bf16(kf, qf[ks], a0, 0, 0, 0); }
            if (two) {
#pragma unroll
                for (int ks = 0; ks < 4; ++ks) { const bf16x8 kf = *(const LAS bf16x8*)(gb + G_KI + sw256(s0 + 16 + fr, 4 * ks + fq)); a1 = __builtin_amdgcn_mfma_f32_16x16x32_bf16(kf, qf[ks], a1, 0, 0, 0); }
            }
            float g0[4], g1[4];
#pragma unroll
            for (int i = 0; i < 4; ++i) { const int sa = s0 + 4 * fq + i; g0[i] = (sa <= lcol) ? a0[i] : 0.f; g1[i] = (two && sa + 16 <= lcol) ? a1[i] : 0.f; }
            u32x4 ap; ap.x = cvt_pk_bf16(g0[0], g0[1]); ap.y = cvt_pk_bf16(g0[2], g0[3]); ap.z = cvt_pk_bf16(g1[0], g1[1]); ap.w = cvt_pk_bf16(g1[2], g1[3]);
            const bf16x8 af = __builtin_bit_cast(bf16x8, ap);
            s16x4 lo[2], hi[2];
#pragma unroll
            for (int vi = 0; vi < 2; ++vi) { lo[vi] = tr_read(xtr + gbo + G_V + (unsigned)((s0 + 4 * fq) * XROW + (vt0 + vi) * 32)); hi[vi] = tr_read(xtr + gbo + G_V + (unsigned)((s0 + 16 + 4 * fq) * XROW + (vt0 + vi) * 32)); }
            MX_LGKM0();
#pragma unroll
            for (int vi = 0; vi < 2; ++vi) o[vi] = __builtin_amdgcn_mfma_f32_16x16x32_bf16(af, cat8(lo[vi], hi[vi]), o[vi], 0, 0, 0);
        }
#pragma unroll
        for (int vi = 0; vi < 2; ++vi)
#pragma unroll
            for (int ks = 0; ks < 4; ++ks) { const bf16x8 sf = *(const LAS bf16x8*)(sp + sw256(16 * (vt0 + vi) + fr, 4 * ks + fq)); o[vi] = __builtin_amdgcn_mfma_f32_16x16x32_bf16(qf[ks], sf, o[vi], 0, 0, 0); }
        {
            bf16_t* op = MIX + (seq0 + (size_t)c * 64 + l0 + 4 * fq) * 2048 + 1024 + h * 256 + vs * 64 + vt0 * 16 + fr;
#pragma unroll
            for (int vi = 0; vi < 2; ++vi)
#pragma unroll
                for (int i = 0; i < 4; ++i) { const bf16_t val = (bf16_t)(cvt_pk_bf16(o[vi][i], 0.f) & 0xffffu);
                    if (CHECK) { if (op[(size_t)i * 2048 + vi * 16] != val) atomicAdd(mismatch, 1u); } else op[(size_t)i * 2048 + vi * 16] = val; }
        }
        {
#pragma unroll
            for (int ks = 0; ks < 2; ++ks) {
                const int s0 = 32 * ks, q = (lane & 15) >> 2, p = lane & 3;
                const int r1 = s0 + 8 * fq + q, r2 = r1 + 4;
                const s16x4 alo = tr_read(lds0 + gbo + G_KI + sw256(r1, 2 * w + (p >> 1)) + (p & 1) * 8), ahi = tr_read(lds0 + gbo + G_KI + sw256(r2, 2 * w + (p >> 1)) + (p & 1) * 8);
                s16x4 lo[4], hi[4];
#pragma unroll
                for (int vt = 0; vt < 4; ++vt) { lo[vt] = tr_read(xtr + gbo + G_V + (unsigned)((s0 + 8 * fq) * XROW + vt * 32)); hi[vt] = tr_read(xtr + gbo + G_V + (unsigned)((s0 + 8 * fq + 4) * XROW + vt * 32)); }
                MX_LGKM0();
                const bf16x8 af = cat8(alo, ahi);
#pragma unroll
                for (int vt = 0; vt < 4; ++vt) st[vt] = __builtin_amdgcn_mfma_f32_16x16x32_bf16(af, cat8(lo[vt], hi[vt]), st[vt], 0, 0, 0);
            }
            const f32x4 d4 = *(const LAS f32x4*)((LAS float*)(gb + G_DEC) + 16 * w + 4 * fq);
#pragma unroll
            for (int vt = 0; vt < 4; ++vt) st[vt] = st[vt] * d4;
        }
        if (c + 1 < 32) GLA_WRITE(pb ^ 1);
        MX_BAR_L();
    }
    asm volatile("s_waitcnt vmcnt(0)" ::: "memory");
#undef GLA_LOAD
#undef GLA_WRITE
}

__device__ __forceinline__ void finalize_phase(bf16_t* MIX, const bf16_t* PROJ, const float* ssd_norm, const float* gla_norm, int gw, int ngw, int lane) {
    for (int m = gw; m < T; m += ngw) {
        bf16_t* mr = MIX + (size_t)m * 2048; const bf16_t* pr = PROJ + (size_t)m * NO_IN;
        float y[2][8]; float s = 0.f;
#pragma unroll
        for (int j = 0; j < 2; ++j) { const int col = 512 * j + 8 * lane; const u32x4 a = *(const u32x4*)(mr + col), z = __builtin_nontemporal_load((const u32x4*)(pr + col));
#pragma unroll
            for (int i = 0; i < 4; ++i) { const float y0 = __uint_as_float(a[i] << 16), y1 = __uint_as_float(a[i] & 0xffff0000u), z0 = __uint_as_float(z[i] << 16), z1 = __uint_as_float(z[i] & 0xffff0000u);
                y[j][2 * i] = y0 * siluf(z0); y[j][2 * i + 1] = y1 * siluf(z1); s += y[j][2 * i] * y[j][2 * i] + y[j][2 * i + 1] * y[j][2 * i + 1]; } }
        const float rs = rsqrtf(wave_sum(s) * (1.f / 1024.f) + EPS);
#pragma unroll
        for (int j = 0; j < 2; ++j) { const int col = 512 * j + 8 * lane; const f32x4 w0 = *(const f32x4*)(ssd_norm + col), w1 = *(const f32x4*)(ssd_norm + col + 4);
            u32x4 o; o.x = cvt_pk_bf16(y[j][0] * rs * w0[0], y[j][1] * rs * w0[1]); o.y = cvt_pk_bf16(y[j][2] * rs * w0[2], y[j][3] * rs * w0[3]);
            o.z = cvt_pk_bf16(y[j][4] * rs * w1[0], y[j][5] * rs * w1[1]); o.w = cvt_pk_bf16(y[j][6] * rs * w1[2], y[j][7] * rs * w1[3]);
            *(u32x4*)(mr + col) = o; }
#pragma unroll
        for (int j = 0; j < 2; ++j) { const int cc = 512 * j + 8 * lane; const u32x4 a = *(const u32x4*)(mr + 1024 + cc), r = __builtin_nontemporal_load((const u32x4*)(pr + 4608 + cc));
            float o[8]; float s2 = 0.f;
#pragma unroll
            for (int i = 0; i < 4; ++i) { o[2 * i] = __uint_as_float(a[i] << 16); o[2 * i + 1] = __uint_as_float(a[i] & 0xffff0000u); s2 += o[2 * i] * o[2 * i] + o[2 * i + 1] * o[2 * i + 1]; }
#pragma unroll
            for (int of = 1; of < 32; of <<= 1) s2 += __shfl_xor(s2, of);
            const float r2 = rsqrtf(s2 * (1.f / 256.f) + EPS); const int v0 = 8 * (lane & 31);
            const f32x4 w0 = *(const f32x4*)(gla_norm + v0), w1 = *(const f32x4*)(gla_norm + v0 + 4);
            float f[8];
#pragma unroll
            for (int i = 0; i < 4; ++i) { f[2 * i] = siluf(__uint_as_float(r[i] << 16)); f[2 * i + 1] = siluf(__uint_as_float(r[i] & 0xffff0000u)); }
            u32x4 ov; ov.x = cvt_pk_bf16(o[0] * r2 * w0[0] * f[0], o[1] * r2 * w0[1] * f[1]); ov.y = cvt_pk_bf16(o[2] * r2 * w0[2] * f[2], o[3] * r2 * w0[3] * f[3]);
            ov.z = cvt_pk_bf16(o[4] * r2 * w1[0] * f[4], o[5] * r2 * w1[1] * f[5]); ov.w = cvt_pk_bf16(o[6] * r2 * w1[2] * f[6], o[7] * r2 * w1[3] * f[7]);
            *(u32x4*)(mr + 1024 + cc) = ov; }
    }
}
#undef MX_LGKM0
#undef MX_BAR
#undef MX_BAR_L
}
namespace mk {
__device__ __forceinline__ void tp_norm_rows(const float* src, const float* g, bf16_t* xn, int gw, int ngw, int lane) {
    f32x4 gg[4];
#pragma unroll
    for (int j = 0; j < 4; ++j) gg[j] = ((const f32x4*)g)[lane + 64 * j];
    for (int m = gw; m < T; m += ngw) {
        const f32x4* p = (const f32x4*)(src + (size_t)m * DM); f32x4 v[4]; float s = 0.f;
#pragma unroll
        for (int j = 0; j < 4; ++j) { v[j] = __builtin_nontemporal_load(p + lane + 64 * j); s += (v[j][0] * v[j][0] + v[j][1] * v[j][1]) + (v[j][2] * v[j][2] + v[j][3] * v[j][3]); }
        const float r = rsqrtf(wave_sum(s) * (1.f / DM) + EPS);
        u32x2* o = (u32x2*)(xn + (size_t)m * DM);
#pragma unroll
        for (int j = 0; j < 4; ++j) { const f32x4 y = v[j] * r * gg[j]; u32x2 w; w.x = cvt_pk_bf16(y[0], y[1]); w.y = cvt_pk_bf16(y[2], y[3]); o[lane + 64 * j] = w; }
    }
}
template <bool FINAL> __device__ __forceinline__ void tp_combine_norm(bf16_t* hb, const bf16_t* Y, const float* g, bf16_t* xn, float* out, int gw, int ngw, int lane) {
    f32x4 gg[2][2];
#pragma unroll
    for (int j = 0; j < 2; ++j) { gg[j][0] = *(const f32x4*)(g + 512 * j + 8 * lane); gg[j][1] = *(const f32x4*)(g + 512 * j + 8 * lane + 4); }
    for (int m = gw; m < T; m += ngw) {
        float v[2][8]; float s = 0.f;
#pragma unroll
        for (int j = 0; j < 2; ++j) { const size_t o = (size_t)m * DM + 512 * j + 8 * lane;
            const u32x4 a = *(const u32x4*)(hb + o), y0 = __builtin_nontemporal_load((const u32x4*)(Y + o)), y1 = __builtin_nontemporal_load((const u32x4*)(Y + (size_t)T * DM + o));
#pragma unroll
            for (int i = 0; i < 4; ++i) { v[j][2 * i] = __uint_as_float(a[i] << 16) + __uint_as_float(y0[i] << 16) + __uint_as_float(y1[i] << 16);
                v[j][2 * i + 1] = __uint_as_float(a[i] & 0xffff0000u) + __uint_as_float(y0[i] & 0xffff0000u) + __uint_as_float(y1[i] & 0xffff0000u);
                s += v[j][2 * i] * v[j][2 * i] + v[j][2 * i + 1] * v[j][2 * i + 1]; } }
        const float r = rsqrtf(wave_sum(s) * (1.f / DM) + EPS);
#pragma unroll
        for (int j = 0; j < 2; ++j) { const size_t o = (size_t)m * DM + 512 * j + 8 * lane;
            if (FINAL) { f32x4 o0, o1;
#pragma unroll
                for (int i = 0; i < 4; ++i) { o0[i] = v[j][i] * r * gg[j][0][i]; o1[i] = v[j][4 + i] * r * gg[j][1][i]; }
                __builtin_nontemporal_store(o0, (f32x4*)(out + o)); __builtin_nontemporal_store(o1, (f32x4*)(out + o + 4));
            } else { u32x4 hw, xw;
#pragma unroll
                for (int i = 0; i < 4; ++i) { hw[i] = cvt_pk_bf16(v[j][2 * i], v[j][2 * i + 1]);
                    xw[i] = cvt_pk_bf16(v[j][2 * i] * r * gg[j][i >> 1][(2 * i) & 3], v[j][2 * i + 1] * r * gg[j][i >> 1][(2 * i + 1) & 3]); }
                *(u32x4*)(hb + o) = hw; *(u32x4*)(xn + o) = xw; }
        }
    }
}
template <bool DRY> __device__ __forceinline__ void tp_route_mfma(const bf16_t* hb, const float* g, bf16_t* xn, const bf16_t* whi, const bf16_t* wlo, const float* bg, const float* br,
                                                                  unsigned* counts, int* lists, float* gates, LAS char* shm, int vcu, int G, int lane, int wave) {
    const int fr = lane & 15, fq = lane >> 4, kbase = wave * 128;
    LAS float* xacc = (LAS float*)shm;
    LAS float* ltile = (LAS float*)(shm + 106496);
    LAS float* rsl = (LAS float*)(shm + 118784);
    for (int blk = vcu; blk < T / 64; blk += G) {
        const int r0 = blk * 64;
        bf16x8 wh[3][4], wl[3][4];
#pragma unroll
        for (int nt = 0; nt < 3; ++nt)
#pragma unroll
            for (int ks = 0; ks < 4; ++ks) { const size_t wo = (size_t)(nt * 16 + fr) * DM + kbase + 32 * ks + 8 * fq; wh[nt][ks] = *(const bf16x8*)(whi + wo); wl[nt][ks] = *(const bf16x8*)(wlo + wo); }
#pragma unroll
        for (int tp = 0; tp < 2; ++tp) {
            u32x4 hq[2][4];
#pragma unroll
            for (int t2 = 0; t2 < 2; ++t2)
#pragma unroll
                for (int ks = 0; ks < 4; ++ks) hq[t2][ks] = *(const u32x4*)(hb + (size_t)(r0 + 16 * (2 * tp + t2) + fr) * DM + kbase + 32 * ks + 8 * fq);
#pragma unroll
            for (int t2 = 0; t2 < 2; ++t2) { const int t = 2 * tp + t2;
                f32x4 acc[3]; acc[0] = (f32x4){0.f, 0.f, 0.f, 0.f}; acc[1] = acc[0]; acc[2] = acc[0];
                float ss = 0.f;
#pragma unroll
                for (int ks = 0; ks < 4; ++ks) { const u32x4 v = hq[t2][ks];
                    const float x0 = __uint_as_float(v.x << 16), x1 = __uint_as_float(v.x & 0xffff0000u), x2 = __uint_as_float(v.y << 16), x3 = __uint_as_float(v.y & 0xffff0000u);
                    const float x4 = __uint_as_float(v.z << 16), x5 = __uint_as_float(v.z & 0xffff0000u), x6 = __uint_as_float(v.w << 16), x7 = __uint_as_float(v.w & 0xffff0000u);
                    ss += (x0 * x0 + x1 * x1) + (x2 * x2 + x3 * x3) + (x4 * x4 + x5 * x5) + (x6 * x6 + x7 * x7);
                    const bf16x8 a = __builtin_bit_cast(bf16x8, v);
#pragma unroll
                    for (int nt = 0; nt < 3; ++nt) { acc[nt] = __builtin_amdgcn_mfma_f32_16x16x32_bf16(a, wh[nt][ks], acc[nt], 0, 0, 0); acc[nt] = __builtin_amdgcn_mfma_f32_16x16x32_bf16(a, wl[nt][ks], acc[nt], 0, 0, 0); } }
                ss += __shfl_xor(ss, 16); ss += __shfl_xor(ss, 32);
                LAS float* xa = xacc + (t * 8 + wave) * 13 * 64;
#pragma unroll
                for (int nt = 0; nt < 3; ++nt)
#pragma unroll
                    for (int i = 0; i < 4; ++i) xa[(nt * 4 + i) * 64 + lane] = acc[nt][i];
                xa[12 * 64 + lane] = ss;
            }
            asm volatile("" ::: "memory");
        }
        u32x4 hv[4][4];
#pragma unroll
        for (int t = 0; t < 4; ++t)
#pragma unroll
            for (int ks = 0; ks < 4; ++ks) hv[t][ks] = *(const u32x4*)(hb + (size_t)(r0 + 16 * t + fr) * DM + kbase + 32 * ks + 8 * fq);
        asm volatile("s_waitcnt lgkmcnt(0)\n\ts_barrier" ::: "memory");
        float rs[4];
#pragma unroll
        for (int t = 0; t < 4; ++t) { float s = 0.f;
#pragma unroll
            for (int w2 = 0; w2 < 8; ++w2) s += xacc[(t * 8 + w2) * 13 * 64 + 12 * 64 + lane];
            rs[t] = rsqrtf(s * (1.f / DM) + EPS); }
        if (wave < 4) {
            const LAS float* xs = xacc + (wave * 8) * 13 * 64;
#pragma unroll
            for (int nt = 0; nt < 3; ++nt)
#pragma unroll
                for (int i = 0; i < 4; ++i) { float v = 0.f;
#pragma unroll
                    for (int w2 = 0; w2 < 8; ++w2) v += xs[w2 * 13 * 64 + (nt * 4 + i) * 64 + lane];
                    ltile[(16 * wave + 4 * fq + i) * 48 + nt * 16 + fr] = v; }
            float rw = rs[0];
#pragma unroll
            for (int t = 1; t < 4; ++t) if (wave == t) rw = rs[t];
            if (fq == 0) rsl[16 * wave + fr] = rw;
        }
#pragma unroll
        for (int t = 0; t < 4; ++t) { bf16_t* xp = xn + (size_t)(r0 + 16 * t + fr) * DM + kbase + 8 * fq; const float r = rs[t];
#pragma unroll
            for (int ks = 0; ks < 4; ++ks) { const u32x4 v = hv[t][ks]; const f32x4 g0 = *(const f32x4*)(g + kbase + 32 * ks + 8 * fq), g1 = *(const f32x4*)(g + kbase + 32 * ks + 8 * fq + 4); u32x4 o;
                o.x = cvt_pk_bf16(__uint_as_float(v.x << 16) * r * g0[0], __uint_as_float(v.x & 0xffff0000u) * r * g0[1]); o.y = cvt_pk_bf16(__uint_as_float(v.y << 16) * r * g0[2], __uint_as_float(v.y & 0xffff0000u) * r * g0[3]);
                o.z = cvt_pk_bf16(__uint_as_float(v.z << 16) * r * g1[0], __uint_as_float(v.z & 0xffff0000u) * r * g1[1]); o.w = cvt_pk_bf16(__uint_as_float(v.w << 16) * r * g1[2], __uint_as_float(v.w & 0xffff0000u) * r * g1[3]);
                *(u32x4*)(xp + 32 * ks) = o; } }
        asm volatile("s_waitcnt lgkmcnt(0)\n\ts_barrier" ::: "memory");
        if (wave == 0) {
            const LAS float* lt = ltile + lane * 48; const float rsr = rsl[lane];
            float gl[4];
#pragma unroll
            for (int e = 0; e < 4; ++e) gl[e] = rsr * lt[e] + bg[e];
            int gi = 0; float gm = gl[0];
#pragma unroll
            for (int e = 1; e < 4; ++e) if (gl[e] > gm) { gm = gl[e]; gi = e; }
            float gs = 0.f;
#pragma unroll
            for (int e = 0; e < 4; ++e) gs += expf(gl[e] - gm);
            const float gwt = 1.f / gs;
            float b0 = -INFINITY, b1 = -INFINITY; int i0 = 0, i1 = 0;
#pragma unroll
            for (int i = 0; i < 8; ++i) { const float v = rsr * lt[4 + gi * 8 + i] + br[gi * 8 + i];
                if (v > b0) { b1 = b0; i1 = i0; b0 = v; i0 = i; } else if (v > b1) { b1 = v; i1 = i; } }
            const int t = r0 + lane;
            const float w0 = 1.f / (1.f + expf(b1 - b0)), w1 = 1.f - w0;
            const int e0 = gi * 8 + i0, e1 = gi * 8 + i1;
            gates[2 * t] = gwt * w0; gates[2 * t + 1] = gwt * w1;
            if (!DRY) {
                const unsigned p0 = __hip_atomic_fetch_add(counts + e0 * 64, 1u, __ATOMIC_RELAXED, __HIP_MEMORY_SCOPE_AGENT);
                const unsigned p1 = __hip_atomic_fetch_add(counts + e1 * 64, 1u, __ATOMIC_RELAXED, __HIP_MEMORY_SCOPE_AGENT);
                lists[e0 * CAP + p0] = 2 * t; lists[e1 * CAP + p1] = 2 * t + 1; }
        }
    }
    asm volatile("s_waitcnt lgkmcnt(0)\n\ts_barrier" ::: "memory");
}

struct Args {
    const float* in[26]; float* out; unsigned char* ws; int ph_lo, ph_hi, use_bar, li;
};
enum Phase { P_CONV0 = 0, P_G1, P_ATT, P_G2, P_TP1, P_G3, P_G4, P_TP2, P_G5, P_CONV, P_MIXER, P_FIN, P_G6, P_TP3, P_G7, P_G8, P_TP4, P_COUNT };

__device__ __forceinline__ void moe_setup(volatile LAS int* misc, unsigned* counts) {
    if (threadIdx.x == 0) {
        int run = 0;
        for (int e = 0; e < 32; ++e) { const int c = (int)__hip_atomic_load(counts + e * 64, __ATOMIC_RELAXED, __HIP_MEMORY_SCOPE_AGENT); misc[64 + e] = c; misc[16 + e] = run; run += (c + 255) >> 8; }
        misc[16 + 32] = run;
    }
    __syncthreads();
}

typedef const float* kin_ptr_t;
__device__ __forceinline__ const float* kin(int i) { return ((const volatile kin_ptr_t __attribute__((address_space(4)))*)__builtin_amdgcn_kernarg_segment_ptr())[i]; }
#ifndef CV_TAIL_ITEMS
#define CV_TAIL_ITEMS 8192
#endif
constexpr int CV_I_EIN = 16 * 80, CV_I_EOUT = 16 * 32, CV_I_OIN = 16 * 184, CV_I_OOUT = 32 * 32, CV_I_GU = 16 * 32, CV_I_D = 8 * 32;
constexpr int CV_NITEMS = CV_I_EIN + CV_I_EOUT + CV_I_OIN + CV_I_OOUT + 32 * CV_I_GU + 32 * CV_I_D;
__device__ __forceinline__ CvItem cv_decode0(unsigned char* ws, int it, int lane) {
    int r = it;
    if (r < CV_I_EIN) return cv_make(SrcEvenIn{kin(4)}, 2312, 1024, 80, (bf16_t*)(ws + WS_WEIN), r, lane); r -= CV_I_EIN;
    if (r < CV_I_EOUT) return cv_make(SrcPlain{kin(7), 1024}, 1024, 1024, 32, (bf16_t*)(ws + WS_WEOUT), r, lane); r -= CV_I_EOUT;
    if (r < CV_I_OIN) return cv_make(SrcOddIn{kin(8)}, 5664, 1024, 184, (bf16_t*)(ws + WS_WOIN), r, lane); r -= CV_I_OIN;
    if (r < CV_I_OOUT) return cv_make(SrcPlain{kin(18), 1024}, 1024, 2048, 32, (bf16_t*)(ws + WS_WOOUT), r, lane); r -= CV_I_OOUT;
    if (r < 32 * CV_I_GU) { const int e = r / CV_I_GU; return cv_make_gu(kin(23) + (size_t)e * 1024 * 512, kin(24) + (size_t)e * 1024 * 512, (bf16_t*)(ws + WS_WGU) + (size_t)e * 1024 * 1024, r % CV_I_GU, lane); } r -= 32 * CV_I_GU;
    { const int e = r / CV_I_D; return cv_make(SrcPlain{kin(25) + (size_t)e * 512 * 1024, 1024}, 1024, 512, 32, (bf16_t*)(ws + WS_WD) + (size_t)e * 1024 * 512, r % CV_I_D, lane); }
}
__device__ __forceinline__ void cv_run0(unsigned char* ws, int lo, int hi, int w, int nw, LAS float* scr, int lane) {
    for (int it = lo + 2 * w; it < hi; it += 2 * nw) {
        float va[32], vb[32]; const CvItem da = cv_decode0(ws, it, lane); cv_load(da, va);
        const bool n1 = it + 1 < hi; CvItem db = da; if (n1) { db = cv_decode0(ws, it + 1, lane); cv_load(db, vb); }
        cv_finish(da, va, scr, lane);
        if (n1) cv_finish(db, vb, scr, lane);
    }
}

constexpr int CV_NIT1 = 32 * (CV_I_GU + CV_I_D);
#ifndef CV1_TAIL_G5
#define CV1_TAIL_G5 4096
#endif
#ifndef CV1_TAIL_MIX
#define CV1_TAIL_MIX 8192
#endif
#ifndef CV1_TAIL_G4
#define CV1_TAIL_G4 8192
#endif
#ifndef CV0_TAIL_G3
#define CV0_TAIL_G3 0
#endif
__device__ __forceinline__ CvItem cv_decode1(unsigned char* ws, int it, int lane) {
    const size_t L1 = (size_t)32 * 1024 * 512; int r = it;
    if (r < 32 * CV_I_GU) { const int e = r / CV_I_GU; return cv_make_gu(kin(23) + L1 + (size_t)e * 1024 * 512, kin(24) + L1 + (size_t)e * 1024 * 512, (bf16_t*)(ws + WS_WGU) + (size_t)e * 1024 * 1024, r % CV_I_GU, lane); } r -= 32 * CV_I_GU;
    { const int e = r / CV_I_D; return cv_make(SrcPlain{kin(25) + L1 + (size_t)e * 512 * 1024, 1024}, 1024, 512, 32, (bf16_t*)(ws + WS_WD) + (size_t)e * 1024 * 512, r % CV_I_D, lane); }
}
__device__ __forceinline__ void cv_run1(unsigned char* ws, int lo, int hi, int w, int nw, LAS float* scr, int lane) {
    for (int it = lo + 2 * w; it < hi; it += 2 * nw) {
        float va[32], vb[32]; const CvItem da = cv_decode1(ws, it, lane); cv_load(da, va);
        const bool n1 = it + 1 < hi; CvItem db = da; if (n1) { db = cv_decode1(ws, it + 1, lane); cv_load(db, vb); }
        cv_finish(da, va, scr, lane);
        if (n1) cv_finish(db, vb, scr, lane);
    }
}

__global__ void __launch_bounds__(NTHR, 2) mk_fwd(Args args) {
    extern __shared__ __attribute__((aligned(16))) unsigned char lds_raw[];
    LAS unsigned char* lds = (LAS unsigned char*)lds_raw;
    volatile LAS int* misc = (volatile LAS int*)(lds + MISC_OFF);
    const int tid = threadIdx.x, lane = tid & 63, wave = __builtin_amdgcn_readfirstlane(tid >> 6);
    const int G = gridDim.x, bx = blockIdx.x;
    const int vcu = (G % 8 == 0) ? (bx % 8) * (G / 8) + bx / 8 : bx;
    const int gw = vcu * NWAVES + wave, ngw = G * NWAVES;
    for (int u = tid; u < 256; u += NTHR) misc[u] = 0;
    __syncthreads();
#define ws ((unsigned char*)kin(27))
#define XN ((bf16_t*)(ws + WS_XN))
#define PROJ ((bf16_t*)(ws + WS_PROJ))
#define MIX ((bf16_t*)(ws + WS_MIX))
#define FB ((float*)(ws + WS_FB))
#define LISTS ((int*)(ws + WS_LISTS))
#define GATES ((float*)(ws + WS_GATES))
#define HB ((bf16_t*)(ws + WS_H))
#define YB ((bf16_t*)(ws + WS_Y))
#define outp ((float*)kin(26))
#define HBS ((bf16_t*)(ws + WS_HB))
#define ctl ((unsigned*)(ws + WS_CTL))
    XcdBarrier bar; bar.bar = ctl + CW_BAR + args.li * XCD_BAR_WORDS; bar.x = 0; bar.st = nullptr;
    if (args.use_bar) bar = xcd_barrier_post(ctl + CW_BAR + args.li * XCD_BAR_WORDS, (volatile LAS unsigned*)misc);
#ifdef BAR_TWICE
#define GRID_BAR() do { if (args.use_bar) { xcd_barrier(bar); xcd_barrier(bar); } } while (0)
#else
#define GRID_BAR() do { if (args.use_bar) xcd_barrier(bar); } while (0)
#endif
    const int lo = args.ph_lo, hi = args.ph_hi;
#ifndef MK_PHASE_MASK
#define MK_PHASE_MASK 0xffffffffu
#endif
#define IN(k) (((MK_PHASE_MASK >> (k)) & 1u) && lo <= (k) && (k) < hi)
#ifndef MK_REP_MASK
#define MK_REP_MASK 0u
#endif
#define NREP(k) ((((MK_REP_MASK) >> (k)) & 1u) ? 2 : 1)
#define REP(k) for (int _r = 0; _r < ((((MK_REP_MASK) >> (k)) & 1u) ? 2 : 1); ++_r)
#define SEAM(k) do { if (IN(k) && IN((k) + 1)) GRID_BAR(); } while (0)
#define XIN kin(0)

    if (IN(P_CONV0)) REP(P_CONV0) {
        LAS float* scr = (LAS float*)(lds + wave * 16384);
        constexpr int OI_LO = CV_I_EIN + CV_I_EOUT, OI_HI = OI_LO + CV_I_OIN + CV_I_OOUT;
        if (CV0_TAIL_G3 && G == 256) { cv_run0(ws, 0, OI_LO, gw, ngw, scr, lane); cv_run0(ws, OI_HI, CV_NITEMS - CV_TAIL_ITEMS, gw, ngw, scr, lane); }
        else cv_run0(ws, 0, CV_NITEMS - CV_TAIL_ITEMS, gw, ngw, scr, lane);
        { bf16_t* wrt = (bf16_t*)(ws + WS_WRT);
          for (int i = gw * 64 + lane; i < 2 * 48 * 1024; i += ngw * 64) { const int l = i / (48 * 1024), rem = i % (48 * 1024), e = rem >> 10, k = rem & 1023;
              const float v = ((e < 4) ? kin(19)[(size_t)l * 4096 + k * 4 + e] : (e < 36 ? kin(21)[(size_t)l * 32768 + k * 32 + (e - 4)] : 0.f)) * kin(2)[(size_t)l * DM + k];
              const unsigned hi = cvt_pk_bf16(v, 0.f) & 0xffffu; const unsigned lo = cvt_pk_bf16(v - __uint_as_float(hi << 16), 0.f) & 0xffffu;
              wrt[(size_t)(2 * l) * 48 * 1024 + rem] = (bf16_t)hi; wrt[(size_t)(2 * l + 1) * 48 * 1024 + rem] = (bf16_t)lo; } }
        tp_norm_rows(XIN, kin(1), XN, gw, ngw, lane);
    }
    SEAM(P_CONV0);
    if (IN(P_G1)) {
        pg8::Gemm g{XN, (const bf16_t*)(ws + WS_WEIN), 1024, 0}; pg8::DenseOrder S; S.init(T, NE_IN, G, bx, NREP(P_G1));
        pg8::EpiProjEven E{PROJ, FB};
        pg8::gemm_phase<pg8::EpiProjEven, pg8::DenseOrder, true>(lds, g, S, E);
        if (CV_TAIL_ITEMS > 0 && G == 256 && bx >= 128)
            cv_run0(ws, CV_NITEMS - CV_TAIL_ITEMS, CV_NITEMS, (bx - 128) * NWAVES + wave, 128 * NWAVES, (LAS float*)(lds + wave * 16384), lane);
        else if (CV_TAIL_ITEMS > 0 && G != 256) cv_run0(ws, CV_NITEMS - CV_TAIL_ITEMS, CV_NITEMS, gw, ngw, (LAS float*)(lds + wave * 16384), lane);
    }
    SEAM(P_G1);
    if (IN(P_ATT)) REP(P_ATT) {
        if (G == 256) {
            const int bh = vcu >> 2, s = vcu & 3, b = bh >> 3, h = bh & 7;
            const float fbias = kin(6)[h];
            att::fox_unit_p<false>((char*)lds_raw, (LAS char*)lds, b, h, 7 - s, PROJ, FB, fbias, MIX, ctl + 32, true);
            att::fox_unit_p<false>((char*)lds_raw, (LAS char*)lds, b, h, s, PROJ, FB, fbias, MIX, ctl + 32, false);
            for (int i = 0; i < 2; ++i) { const int u = vcu * 2 + i; const int sb = u >> 6, kvh = (u >> 5) & 1, blk = u & 31; att::swa_unit((LAS char*)lds, sb, kvh, blk, PROJ, kin(5), MIX); }
        }
    }
    SEAM(P_ATT);
    if (IN(P_G2)) {
        pg8::Gemm g{MIX, (const bf16_t*)(ws + WS_WEOUT), 1024, 0}; pg8::DenseOrder S; S.init(T, DM, G, bx, NREP(P_G2));
        pg8::EpiResidB<true> E{XIN, HBS};
        pg8::gemm_phase<pg8::EpiResidB<true>, pg8::DenseOrder, true>(lds, g, S, E);
    }
    SEAM(P_G2);
    if (IN(P_TP1)) {
#ifdef TP1_REP
        tp_route_mfma<true>(HBS, kin(2), XN, (const bf16_t*)(ws + WS_WRT), (const bf16_t*)(ws + WS_WRT) + 48 * 1024, kin(20), kin(22), ctl + CW_CNT, LISTS, GATES, (LAS char*)lds, vcu, G, lane, wave);
#endif
        tp_route_mfma<false>(HBS, kin(2), XN, (const bf16_t*)(ws + WS_WRT), (const bf16_t*)(ws + WS_WRT) + 48 * 1024, kin(20), kin(22), ctl + CW_CNT, LISTS, GATES, (LAS char*)lds, vcu, G, lane, wave);
    }
    SEAM(P_TP1);
    if (IN(P_G3)) {
        moe_setup(misc, ctl + CW_CNT);
        if (CV0_TAIL_G3 && G == 256) {
            const int U = misc[16 + 32] * 4, nidle = 768 - U;
            if (nidle > 0 && bx >= 256 - nidle) { constexpr int OI_LO = CV_I_EIN + CV_I_EOUT, OI_HI = OI_LO + CV_I_OIN + CV_I_OOUT;
                cv_run0(ws, OI_LO, OI_HI, (bx - (256 - nidle)) * NWAVES + wave, nidle * NWAVES, (LAS float*)(lds + wave * 16384), lane); }
            else if (nidle <= 0) { constexpr int OI_LO = CV_I_EIN + CV_I_EOUT, OI_HI = OI_LO + CV_I_OIN + CV_I_OOUT; cv_run0(ws, OI_LO, OI_HI, gw, ngw, (LAS float*)(lds + wave * 16384), lane); }
        }
        __syncthreads();
        pg8::Gemm g{XN, (const bf16_t*)(ws + WS_WGU), 1024, (size_t)1024 * 1024 * 2};
        pg8::MoeOrder S{(const volatile LAS int*)(misc + 16), (const volatile LAS int*)(misc + 64), LISTS, G, bx, true, NREP(P_G3)};
        pg8::EpiGateUp E{HB};
        pg8::gemm_phase<pg8::EpiGateUp, pg8::MoeOrder, true>(lds, g, S, E);
    }
    SEAM(P_G3);
    if (IN(P_G4)) {
        moe_setup(misc, ctl + CW_CNT);
        pg8::Gemm g{HB, (const bf16_t*)(ws + WS_WD), 512, (size_t)1024 * 512 * 2};
        pg8::MoeOrder S{(const volatile LAS int*)(misc + 16), (const volatile LAS int*)(misc + 64), LISTS, G, bx, false, NREP(P_G4)};
        pg8::EpiDown E{YB, LISTS, GATES, (const volatile LAS int*)(misc + 64)};
        pg8::gemm_phase<pg8::EpiDown, pg8::MoeOrder, true>(lds, g, S, E);
        if (CV1_TAIL_G4 > 0 && G == 256) {
            const int U = misc[16 + 32] * 4, nidle = 768 - U, lo1 = CV_NIT1 - CV1_TAIL_G5 - CV1_TAIL_MIX - CV1_TAIL_G4, hi1 = lo1 + CV1_TAIL_G4;
            if (nidle >= 32) { if (bx >= 256 - nidle) cv_run1(ws, lo1, hi1, (bx - (256 - nidle)) * NWAVES + wave, nidle * NWAVES, (LAS float*)(lds + wave * 16384), lane); }
            else cv_run1(ws, lo1, hi1, gw, ngw, (LAS float*)(lds + wave * 16384), lane);
        }
    }
    SEAM(P_G4);
    if (IN(P_TP2)) {
        tp_combine_norm<false>(HBS, YB, kin(1) + DM, XN, nullptr, gw, ngw, lane);
        LAS float* scr = (LAS float*)(lds + wave * 16384);
        constexpr int I_GU = 16 * 32, I_D = 8 * 32; const size_t L1 = (size_t)32 * 1024 * 512;
        auto decode = [&](int it) -> CvItem {
            int r = it;
            if (r < 32 * I_GU) { const int e = r / I_GU; return cv_make_gu(kin(23) + L1 + (size_t)e * 1024 * 512, kin(24) + L1 + (size_t)e * 1024 * 512, (bf16_t*)(ws + WS_WGU) + (size_t)e * 1024 * 1024, r % I_GU, lane); } r -= 32 * I_GU;
            { const int e = r / I_D; return cv_make(SrcPlain{kin(25) + L1 + (size_t)e * 512 * 1024, 1024}, 1024, 512, 32, (bf16_t*)(ws + WS_WD) + (size_t)e * 1024 * 512, r % I_D, lane); }
        };
        const int NIT1 = CV_NIT1 - ((G == 256) ? (CV1_TAIL_G5 + CV1_TAIL_MIX + CV1_TAIL_G4) : 0);
        for (int it = 2 * gw; it < NIT1; it += 2 * ngw) {
            float va[32], vb[32]; const CvItem da = decode(it); cv_load(da, va);
            const bool n1 = it + 1 < NIT1; CvItem db = da; if (n1) { db = decode(it + 1); cv_load(db, vb); }
            cv_finish(da, va, scr, lane);
            if (n1) cv_finish(db, vb, scr, lane);
        }
    }
    SEAM(P_TP2);
    if (IN(P_G5)) {
        pg8::Gemm g{XN, (const bf16_t*)(ws + WS_WOIN), 1024, 0}; pg8::DenseOrder S; S.init(T, NO_IN, G, bx, NREP(P_G5));
        pg8::EpiProjOdd E{PROJ, (float*)(ws + WS_DTG)};
        pg8::gemm_phase<pg8::EpiProjOdd, pg8::DenseOrder, true>(lds, g, S, E);
        if (CV1_TAIL_G5 > 0 && G == 256 && bx >= 192)
            cv_run1(ws, CV_NIT1 - CV1_TAIL_G5 - CV1_TAIL_MIX, CV_NIT1 - CV1_TAIL_MIX, (bx - 192) * NWAVES + wave, 64 * NWAVES, (LAS float*)(lds + wave * 16384), lane);
    }
    SEAM(P_G5);
    if (IN(P_CONV)) {
        mx::prep_conv(PROJ, (bf16_t*)(ws + WS_CONV), kin(9), kin(10), vcu, G, tid);
#ifdef PREP_REP_CONV
        mx::prep_conv(PROJ, (bf16_t*)(ws + WS_CONV), kin(9), kin(10), vcu, G, tid);
#endif
        mx::prep_ssd((const float*)(ws + WS_DTG), (float*)(ws + mx::WS_DTV), (float*)(ws + mx::WS_ACS), kin(11), kin(12), vcu, G, lane, wave);
#ifdef PREP_REP_SSD
        mx::prep_ssd((const float*)(ws + WS_DTG), (float*)(ws + mx::WS_DTV), (float*)(ws + mx::WS_ACS), kin(11), kin(12), vcu, G, lane, wave);
#endif
        mx::prep_gla(PROJ, (const float*)(ws + WS_DTG), (bf16_t*)(ws + mx::WS_QD), (bf16_t*)(ws + mx::WS_KI), (bf16_t*)(ws + mx::WS_KE), (float*)(ws + mx::WS_DEC), kin(15), kin(16), vcu, G, tid, lane, wave, (LAS char*)lds);
#ifdef PREP_REP_GLA
        mx::prep_gla(PROJ, (const float*)(ws + WS_DTG), (bf16_t*)(ws + mx::WS_QD), (bf16_t*)(ws + mx::WS_KI), (bf16_t*)(ws + mx::WS_KE), (float*)(ws + mx::WS_DEC), kin(15), kin(16), vcu, G, tid, lane, wave, (LAS char*)lds);
#endif
    }
    SEAM(P_CONV);
    if (IN(P_MIXER)) {
        if (G == 256) {
            if (vcu < 128) {
                mx::ssd_unit64((LAS char*)lds, vcu >> 4, vcu & 15, (const bf16_t*)(ws + WS_CONV), (const float*)(ws + mx::WS_ACS), (const float*)(ws + mx::WS_DTV), kin(13)[vcu & 15], MIX);
#ifdef MIX_SSD_REP
                __syncthreads(); mx::ssd_unit((LAS char*)lds, vcu >> 4, vcu & 15, (const bf16_t*)(ws + WS_CONV), (const float*)(ws + mx::WS_ACS), (const float*)(ws + mx::WS_DTV), kin(13)[vcu & 15], MIX);
#endif
            }
            else { const int u = vcu - 128; mx::gla_unit<false>((LAS char*)lds, u >> 4, (u >> 2) & 3, u & 3, PROJ, (const bf16_t*)(ws + mx::WS_QD), (const bf16_t*)(ws + mx::WS_KI),
                                                          (const float*)(ws + mx::WS_DEC), MIX, ctl + 32);
                if (CV1_TAIL_MIX > 0) { __syncthreads(); cv_run1(ws, CV_NIT1 - CV1_TAIL_MIX, CV_NIT1, (vcu - 128) * NWAVES + wave, 128 * NWAVES, (LAS float*)(lds + wave * 16384), lane); }
#ifdef MIX_GLA_REP
                __syncthreads(); mx::gla_unit<false>((LAS char*)lds, u >> 4, (u >> 2) & 3, u & 3, PROJ, (const bf16_t*)(ws + mx::WS_QD), (const bf16_t*)(ws + mx::WS_KI), (const float*)(ws + mx::WS_DEC), MIX, ctl + 32);
#endif
            }
        }
    }
    SEAM(P_MIXER);
    if (IN(P_FIN)) {
        mx::finalize_phase(MIX, PROJ, kin(14), kin(17), gw, ngw, lane);
    }
    SEAM(P_FIN);
    if (IN(P_G6)) {
        pg8::Gemm g{MIX, (const bf16_t*)(ws + WS_WOOUT), 2048, 0}; pg8::DenseOrder S; S.init(T, DM, G, bx, NREP(P_G6));
        pg8::EpiResidB<false> E{HBS, HBS};
        pg8::gemm_phase<pg8::EpiResidB<false>, pg8::DenseOrder, true>(lds, g, S, E);
    }
    SEAM(P_G6);
    if (IN(P_TP3)) {
        tp_route_mfma<false>(HBS, kin(2) + DM, XN, (const bf16_t*)(ws + WS_WRT) + 2 * 48 * 1024, (const bf16_t*)(ws + WS_WRT) + 3 * 48 * 1024, kin(20) + 4, kin(22) + 32,
                             ctl + CW_CNT + 32 * 64, LISTS, GATES, (LAS char*)lds, vcu, G, lane, wave);
    }
    SEAM(P_TP3);
    if (IN(P_G7)) {
        moe_setup(misc, ctl + CW_CNT + 32 * 64);
        pg8::Gemm g{XN, (const bf16_t*)(ws + WS_WGU), 1024, (size_t)1024 * 1024 * 2};
        pg8::MoeOrder S{(const volatile LAS int*)(misc + 16), (const volatile LAS int*)(misc + 64), LISTS, G, bx, true, NREP(P_G7)};
        pg8::EpiGateUp E{HB};
        pg8::gemm_phase<pg8::EpiGateUp, pg8::MoeOrder, true>(lds, g, S, E);
    }
    SEAM(P_G7);
    if (IN(P_G8)) {
        moe_setup(misc, ctl + CW_CNT + 32 * 64);
        pg8::Gemm g{HB, (const bf16_t*)(ws + WS_WD), 512, (size_t)1024 * 512 * 2};
        pg8::MoeOrder S{(const volatile LAS int*)(misc + 16), (const volatile LAS int*)(misc + 64), LISTS, G, bx, false, NREP(P_G8)};
        pg8::EpiDown E{YB, LISTS, GATES, (const volatile LAS int*)(misc + 64)};
        pg8::gemm_phase<pg8::EpiDown, pg8::MoeOrder, true>(lds, g, S, E);
    }
    SEAM(P_G8);
    if (IN(P_TP4)) {
        tp_combine_norm<true>(HBS, YB, kin(3), nullptr, outp, gw, ngw, lane);
#if defined(GLA_CHECK) || defined(ATT_CHECK)
        if (__hip_atomic_load(ctl + 32, __ATOMIC_RELAXED, __HIP_MEMORY_SCOPE_AGENT) != 0u) { for (int m = gw; m < T; m += ngw) outp[(size_t)m * DM + lane] = 1000.f; }
#endif
    }
#undef IN
#undef SEAM
#undef GRID_BAR
#undef ws
#undef XN
#undef PROJ
#undef MIX
#undef FB
#undef LISTS
#undef GATES
#undef HB
#undef YB
#undef outp
#undef HBS
#undef ctl
#undef XIN
}
}

extern "C" void kernel_launch(void* const* d_in, const int* in_sizes, int n_in, void* d_out, int out_size, void* d_ws, size_t ws_size, hipStream_t stream) {
    static int grid = 0;
    if (grid == 0) {
        int dev = 0, cus = 0, per_cu = 0;
        (void)hipGetDevice(&dev); (void)hipDeviceGetAttribute(&cus, hipDeviceAttributeMultiprocessorCount, dev);
        if (n_in != 26 || out_size != mk::T * mk::DM || ws_size < mk::WS_TOTAL) { fprintf(stderr, "kernel_launch: unexpected shapes (n_in %d out %d ws %zu)\n", n_in, out_size, ws_size); grid = -1; return; }
        if (hipFuncSetAttribute((const void*)mk::mk_fwd, hipFuncAttributeMaxDynamicSharedMemorySize, mk::LDS_BYTES) != hipSuccess) { fprintf(stderr, "hipFuncSetAttribute failed\n"); grid = -1; return; }
        if (hipOccupancyMaxActiveBlocksPerMultiprocessor(&per_cu, (const void*)mk::mk_fwd, mk::NTHR, mk::LDS_BYTES) != hipSuccess || per_cu < 1) { fprintf(stderr, "occupancy query reports %d blocks per CU\n", per_cu); }
        (void)hipGetLastError();
        grid = cus;
        if (grid != 256) fprintf(stderr, "kernel_launch: %d CUs; the attention / mixer phases need 256\n", grid);
    }
    if (grid < 0) return;
    (void)hipMemsetAsync((char*)d_ws + mk::WS_CTL, 0, mk::CTL_ZERO_BYTES, stream);
    mk::Args a{};
    for (int i = 0; i < 26; ++i) a.in[i] = (const float*)d_in[i];
    a.out = (float*)d_out; a.ws = (unsigned char*)d_ws;
    a.ph_lo = 0; a.ph_hi = mk::P_COUNT; a.use_bar = 1; a.li = 0;
    hipLaunchKernelGGL(mk::mk_fwd, dim3(grid), dim3(mk::NTHR), mk::LDS_BYTES, stream, a);
}
```

```cpp
#include <hip/hip_runtime.h>
#include <hip/hip_bf16.h>
#include <cstdio>
#include <cstdint>
#include <cmath>
namespace mk {
#define LAS __attribute__((address_space(3)))
#define GAS __attribute__((address_space(1)))
typedef unsigned short bf16_t;
typedef short bf16x8 __attribute__((ext_vector_type(8)));
typedef short s16x4 __attribute__((ext_vector_type(4)));
typedef float f32x4 __attribute__((ext_vector_type(4)));
typedef float f32x2 __attribute__((ext_vector_type(2)));
typedef float f32x16 __attribute__((ext_vector_type(16)));
typedef unsigned u32x4 __attribute__((ext_vector_type(4)));
typedef unsigned u32x2 __attribute__((ext_vector_type(2)));

constexpr int T = 16384, DM = 1024, SEQ = 2048, NBATCH = 8;
constexpr int NE_IN = 2560, NO_IN = 5888;
constexpr int CAP = 16384;
constexpr float EPS = 1e-6f;
constexpr float LOG2E = 1.4426950408889634f;
constexpr float C2 = 0.125f * LOG2E;
constexpr int NWAVES = 8, NTHR = 512;
constexpr size_t MiB = 1u << 20;
constexpr size_t WS_CTL = 0, CTL_ZERO_BYTES = 1 * MiB;
constexpr size_t WS_WEIN = 2 * MiB, WS_WEOUT = 7 * MiB, WS_WOIN = 9 * MiB, WS_WOOUT = 21 * MiB, WS_WRT = 25 * MiB;
constexpr size_t WS_WGU = 26 * MiB, WS_WD = 90 * MiB;
constexpr size_t WS_XN = 122 * MiB;
constexpr size_t WS_PROJ = 154 * MiB;
constexpr size_t WS_H = WS_PROJ, WS_Y = WS_PROJ + 40 * MiB;
constexpr size_t WS_MIX = 338 * MiB;
constexpr size_t WS_CONV = 402 * MiB;
constexpr size_t WS_FB = 450 * MiB;
constexpr size_t WS_DTG = 451 * MiB;
constexpr size_t WS_LISTS = 453 * MiB;
constexpr size_t WS_GATES = 455 * MiB;
constexpr size_t WS_RSTD = 455 * MiB + 512 * 1024;
constexpr size_t WS_END = 456 * MiB, WS_HB = 476 * MiB, WS_TOTAL = 508 * MiB;
constexpr int CW_BAR = 4096;
constexpr int CW_CNT = 16384;
constexpr int RING_BYTES = 146432;
constexpr int MISC_OFF = RING_BYTES;
constexpr int LDS_BYTES = 147456;

typedef __bf16 bf16x2_t __attribute__((ext_vector_type(2)));
__device__ __forceinline__ unsigned cvt_pk_bf16(float lo, float hi) { f32x2 v = {lo, hi}; bf16x2_t b = __builtin_convertvector(v, bf16x2_t); return __builtin_bit_cast(unsigned, b); }
__device__ __forceinline__ float bf2f(unsigned short b) { return __uint_as_float((unsigned)b << 16); }
__device__ __forceinline__ float wave_sum(float v) {
#pragma unroll
    for (int o = 1; o < 64; o <<= 1) v += __shfl_xor(v, o);
    return v;
}
__device__ __forceinline__ float siluf(float x) { return x * __builtin_amdgcn_rcpf(1.f + __expf(-x)); }
__device__ __forceinline__ float log_sigmoidf(float x) { return fminf(x, 0.f) - log1pf(expf(-fabsf(x))); }
__device__ __forceinline__ float log_sigmoid_fast(float x) { return fminf(x, 0.f) - __logf(1.f + __expf(-fabsf(x))); }
__device__ __forceinline__ float softplusf(float x) { return fmaxf(x, 0.f) + __logf(1.f + __expf(-fabsf(x))); }

#define XB_TMO      128
#define XB_XCNT(j)  (256  + 64 * (j))
#define XB_XSUB(j)  (1280 + 64 * (j))
#define XB_XGEN(j)  (2304 + 64 * (j))
#define XB_TOP      3328
#define XB_TOPGEN   3392
#define XCD_BAR_WORDS 3456
#define XB_SPIN_CAP (1u << 18)
__device__ __forceinline__ unsigned xb_ld(unsigned* p)              { return __hip_atomic_load(p, __ATOMIC_RELAXED, __HIP_MEMORY_SCOPE_AGENT); }
__device__ __forceinline__ unsigned xb_add(unsigned* p, unsigned v) { return __hip_atomic_fetch_add(p, v, __ATOMIC_RELAXED, __HIP_MEMORY_SCOPE_AGENT); }
__device__ __forceinline__ unsigned xb_xcc_id() { return (unsigned)__builtin_amdgcn_s_getreg((3 << 11) | 20) & 0xFu; }
#define XB_SPIN(cond, bar) do { unsigned _sp = 0; while (cond) { __builtin_amdgcn_s_sleep(1); \
    if ((++_sp & 255u) == 0u) { if (xb_ld(&(bar)[XB_TMO])) break; if (_sp > XB_SPIN_CAP) { atomicAdd(&(bar)[XB_TMO], 1u); break; } } } } while (0)
struct XcdBarrier { unsigned* bar; unsigned x; volatile LAS unsigned* st; };
__device__ __forceinline__ XcdBarrier xcd_barrier_post(unsigned* bar, volatile LAS unsigned* st) {
    XcdBarrier b; b.bar = bar; b.x = xb_xcc_id(); b.st = st;
    if (threadIdx.x == 0) (void)xb_add(&bar[XB_XCNT(b.x)], 1u);
    return b;
}
__device__ __forceinline__ void xcd_barrier_complete(unsigned* bar, unsigned x, unsigned& nloc, unsigned& nx) {
    const unsigned G = gridDim.x * gridDim.y * gridDim.z;
    unsigned sum, cnt, mine, sp = 0u;
    for (;;) {
        sum = 0u; cnt = 0u; mine = 0u;
#pragma unroll
        for (unsigned j = 0; j < 16; ++j) { const unsigned c = xb_ld(&bar[XB_XCNT(j)]); sum += c; cnt += (c > 0u) ? 1u : 0u; mine = (j == x) ? c : mine; }
        if (sum == G) break;
        __builtin_amdgcn_s_sleep(1);
        if ((++sp & 255u) == 0u) { if (xb_ld(&bar[XB_TMO])) break; if (sp > XB_SPIN_CAP) { atomicAdd(&bar[XB_TMO], 1u); break; } }
    }
    nloc = mine > 0u ? mine : 1u; nx = cnt > 0u ? cnt : 1u;
}
__device__ __forceinline__ void xcd_barrier(const XcdBarrier& b) {
    asm volatile("s_waitcnt vmcnt(0)" ::: "memory");
    __syncthreads();
    if (threadIdx.x == 0) {
        unsigned* bar = b.bar;
        __builtin_amdgcn_s_waitcnt(0);
        unsigned nloc = b.st[0], nx = b.st[1];
        if (nloc == 0u) { xcd_barrier_complete(bar, b.x, nloc, nx); b.st[0] = nloc; b.st[1] = nx; }
        const unsigned old = xb_add(&bar[XB_XSUB(b.x)], 1u);
        const unsigned gen = old / nloc;
        if (old + 1u == (gen + 1u) * nloc) {
            __builtin_amdgcn_fence(__ATOMIC_RELEASE, "agent");
            asm volatile("s_waitcnt vmcnt(0)" ::: "memory");
            const unsigned og = xb_add(&bar[XB_TOP], 1u);
            const unsigned tg = og / nx;
            if (og + 1u == (tg + 1u) * nx) xb_add(&bar[XB_TOPGEN], 1u);
            else XB_SPIN(xb_ld(&bar[XB_TOPGEN]) == tg, bar);
            __builtin_amdgcn_fence(__ATOMIC_ACQUIRE, "agent");
            xb_add(&bar[XB_XGEN(b.x)], 1u);
            asm volatile("s_waitcnt vmcnt(0)" ::: "memory");
        } else {
            XB_SPIN(xb_ld(&bar[XB_XGEN(b.x)]) == gen, bar);
            __builtin_amdgcn_fence(__ATOMIC_ACQUIRE, "agent");
            asm volatile("s_waitcnt vmcnt(0)" ::: "memory");
        }
    }
    __syncthreads();
}

struct SrcPlain { const float* W; int N; __device__ __forceinline__ const float* operator()(int k, int n) const { return W + (size_t)k * N + n; } };
struct SrcEvenIn { const float* W; __device__ __forceinline__ const float* operator()(int k, int n) const { return n < 2312 ? W + (size_t)k * 2312 + n : nullptr; } };
struct SrcOddIn { const float* W;
    __device__ __forceinline__ const float* operator()(int k, int n) const {
        int s;
        if (n < 2560) s = n; else if (n < 4608) s = n + 16; else if (n < 5632) s = n + 32; else if (n < 5648) s = 2560 + (n - 5632); else if (n < 5664) s = 4624 + (n - 5648); else s = -1;
        return s >= 0 ? W + (size_t)k * 5664 + s : nullptr; } };
struct SrcGateUp { const float* Wg; const float* Wu;
    __device__ __forceinline__ const float* operator()(int k, int n) const { const int j = (n >> 5) * 16 + (n & 15); const long d = (n & 16) ? (long)(Wu - Wg) : 0l; return Wg + d + (size_t)k * 512 + j; } };
__device__ __forceinline__ struct CvItem cv_make_gu(const float* Wg, const float* Wu, bf16_t* WT, int item, int lane);
struct CvItem { const float* p; size_t stride; bf16_t* dst; int K; int gu; };
template <class Src> __device__ __forceinline__ CvItem cv_make(const Src& src, int srcN, int K, int nblk, bf16_t* WT, int item, int lane) {
    const int kb = item / nblk, nb = item % nblk, k0 = 64 * kb, n0 = 32 * nb;
    CvItem d; d.p = src(k0 + (lane >> 5), n0 + (lane & 31)); d.stride = (size_t)2 * srcN; d.dst = WT + (size_t)n0 * K + k0; d.K = K; d.gu = 0; return d;
}
__device__ __forceinline__ CvItem cv_make_gu(const float* Wg, const float* Wu, bf16_t* WT, int item, int lane) {
    const int half = item >> 8, r = item & 255, kb = r >> 4, jb = r & 15, k0 = 64 * kb, j0 = 32 * jb;
    CvItem d; d.p = (half ? Wu : Wg) + (size_t)(k0 + (lane >> 5)) * 512 + j0 + (lane & 31); d.stride = 1024; d.dst = WT + (size_t)(jb * 64 + half * 16) * 1024 + k0; d.K = 1024; d.gu = 1; return d;
}
__device__ __forceinline__ void cv_load(const CvItem& d, float (&v)[32]) {
#pragma unroll
    for (int i = 0; i < 32; ++i) v[i] = d.p ? __builtin_nontemporal_load(d.p + (size_t)i * d.stride) : 0.f;
}
__device__ __forceinline__ void cv_finish(const CvItem& d, const float (&v)[32], LAS float* scr, int lane) {
#pragma unroll
    for (int i = 0; i < 32; ++i) { const int kk = 2 * i + (lane >> 5); scr[kk * 33 + (lane & 31)] = v[i]; }
    asm volatile("s_waitcnt lgkmcnt(0)" ::: "memory");
    const int c = lane & 7;
#pragma unroll
    for (int j = 0; j < 4; ++j) { const int n = (lane >> 3) + 8 * j; const LAS float* s = scr + (8 * c) * 33 + n; const int dr = d.gu ? ((n >> 4) * 32 + (n & 15)) : n;
        u32x4 o; o.x = cvt_pk_bf16(s[0 * 33], s[1 * 33]); o.y = cvt_pk_bf16(s[2 * 33], s[3 * 33]); o.z = cvt_pk_bf16(s[4 * 33], s[5 * 33]); o.w = cvt_pk_bf16(s[6 * 33], s[7 * 33]);
        __builtin_nontemporal_store(o, (u32x4*)(d.dst + (size_t)dr * d.K + 8 * c)); }
    asm volatile("s_waitcnt lgkmcnt(0)" ::: "memory");
}

namespace pg8 {
constexpr int BM = 256, BK = 64, HALF = 128, HTB = HALF * BK * 2, STAGE_BYTES = 8 * HTB, NXCD = 8, WGM = 8;
__host__ __device__ __forceinline__ int lds_byte(int r, int c) { const int st = (r >> 4) * 2 + (c >> 5), rr = r & 15, cc = c & 31, ob = rr * 64 + cc * 2; return st * 1024 + (ob ^ (((ob >> 9) & 1) << 5)); }
__host__ __device__ __forceinline__ void stage_rc(int b, int& R, int& C) { const int st = b / 1024, sb = b % 1024, swz = sb ^ (((sb >> 9) & 1) << 5); R = (st >> 1) * 16 + swz / 64; C = (st & 1) * 32 + (swz % 64) / 2; }
__host__ __device__ __forceinline__ int perm32(int rho) { const int n = rho >> 4, i = rho & 15; return 8 * (i >> 2) + 4 * n + (i & 3); }

struct Unit { int pm, pn, e, j; };
struct Gemm { const bf16_t* A; const bf16_t* Bt; int K; size_t b_estride; };

struct DenseOrder {
    int nM, nN, nwg, G, c, rep;
    __device__ void init(int M, int N, int G_, int c_, int rep_ = 1) { nM = M / BM; nN = N / BM; nwg = nM * nN; G = G_; c = c_; rep = rep_; }
    __device__ bool next(int i, Unit& u) const {
        if (rep > 1) { const int n = (nwg - c + G - 1) / G; if (n <= 0 || i >= n * rep) return false; i = i % n; }
        const long L = (long)i * G + c; if (L >= nwg) return false;
        int wgid = (int)L; { const int q = nwg / NXCD, r = nwg % NXCD, xcd = wgid % NXCD, off = wgid / NXCD; wgid = (xcd < r ? xcd * (q + 1) : r * (q + 1) + (xcd - r) * q) + off; }
        const int nig = WGM * nN, gid = wgid / nig, fm = gid * WGM, gsz = (nM - fm) < WGM ? (nM - fm) : WGM;
        u.pm = fm + ((wgid % nig) % gsz); u.pn = (wgid % nig) / gsz; u.e = 0; u.j = 0; return true;
    }
    __device__ __forceinline__ unsigned arow(const Unit& u, int r) const { return (unsigned)(u.pm * BM + r); }
    __device__ __forceinline__ void arow4(const Unit& u, int r0, int r1, unsigned (&o)[4]) const { o[0] = arow(u, r0); o[1] = arow(u, r1); o[2] = arow(u, HALF + r0); o[3] = arow(u, HALF + r1); }
};
struct MoeOrder {
    const volatile LAS int* ts; const volatile LAS int* cnt; const int* lists; int G, c; bool gather; int rep;
    __device__ bool next(int i, Unit& u) const {
        const int U = ts[32] * 4;
        if (rep > 1) { const int n = (U - c + G - 1) / G; if (n <= 0 || i >= n * rep) return false; i = i % n; }
        const long L = (long)i * G + c; if (L >= U) return false;
        int v = (int)L; { const int q = U / NXCD, r = U % NXCD, xcd = v % NXCD, off = v / NXCD; v = (xcd < r ? xcd * (q + 1) : r * (q + 1) + (xcd - r) * q) + off; }
        const int m = v >> 2; u.pm = m; u.pn = v & 3;
        int e = 0;
        for (int k = 1; k < 32; ++k) if (ts[k] <= m) e = k;
        u.e = e; u.j = m - ts[e]; return true;
    }
    __device__ __forceinline__ unsigned arow(const Unit& u, int r) const {
        if (!gather) return (unsigned)(u.pm * BM + r);
        const int ri = u.j * BM + r; const int n = cnt[u.e];
        return ri < n ? (unsigned)(lists[u.e * CAP + ri] >> 1) : 0u;
    }
    __device__ __forceinline__ void arow4(const Unit& u, int r0, int r1, unsigned (&o)[4]) const {
        if (!gather) { o[0] = (unsigned)(u.pm * BM + r0); o[1] = (unsigned)(u.pm * BM + r1); o[2] = (unsigned)(u.pm * BM + HALF + r0); o[3] = (unsigned)(u.pm * BM + HALF + r1); return; }
        const int n = cnt[u.e], last = n - 1, jb = u.j * BM; const int* lp = lists + u.e * CAP;
        const int i0 = jb + r0, i1 = jb + r1, i2 = i0 + HALF, i3 = i1 + HALF;
        const int v0 = lp[i0 < last ? i0 : last], v1 = lp[i1 < last ? i1 : last], v2 = lp[i2 < last ? i2 : last], v3 = lp[i3 < last ? i3 : last];
        o[0] = i0 < n ? (unsigned)(v0 >> 1) : 0u; o[1] = i1 < n ? (unsigned)(v1 >> 1) : 0u; o[2] = i2 < n ? (unsigned)(v2 >> 1) : 0u; o[3] = i3 < n ? (unsigned)(v3 >> 1) : 0u;
    }
};

struct EpiProjEven {
    static constexpr bool PERM = true;
    bf16_t* O; float* fb;
    __device__ __forceinline__ void operator()(const f32x4 (&acc)[2][2][4][2], const Unit& u, int wr, int wc, int fr, int fq) const {
        const int row0 = u.pm * BM + wr * 64 + fr;
        if (u.pn == 9) {
            if (wc == 0 && fq == 0) {
#pragma unroll
                for (int ai = 0; ai < 2; ++ai)
#pragma unroll
                    for (int m = 0; m < 4; ++m) { float* p = fb + (size_t)(row0 + ai * HALF + m * 16) * 8; *(f32x4*)p = acc[ai][0][m][0]; *(f32x4*)(p + 4) = acc[ai][0][m][1]; }
            }
            return;
        }
        const float sc = (u.pn == 0 || u.pn == 1 || u.pn == 3 || u.pn == 4) ? C2 : 1.f;
        const int col0 = u.pn * BM + wc * 32 + 8 * fq;
#pragma unroll
        for (int ai = 0; ai < 2; ++ai)
#pragma unroll
            for (int m = 0; m < 4; ++m) { bf16_t* rowp = O + (size_t)(row0 + ai * HALF + m * 16) * NE_IN + col0;
#pragma unroll
                for (int bj = 0; bj < 2; ++bj) { const f32x4 v0 = acc[ai][bj][m][0] * sc, v1 = acc[ai][bj][m][1] * sc;
                    u32x4 w; w.x = cvt_pk_bf16(v0[0], v0[1]); w.y = cvt_pk_bf16(v0[2], v0[3]); w.z = cvt_pk_bf16(v1[0], v1[1]); w.w = cvt_pk_bf16(v1[2], v1[3]);
                    *(u32x4*)(rowp + bj * HALF) = w; } }
    }
};
struct EpiProjOdd {
    static constexpr bool PERM = true;
    bf16_t* O; float* dtg;
    __device__ __forceinline__ void operator()(const f32x4 (&acc)[2][2][4][2], const Unit& u, int wr, int wc, int fr, int fq) const {
        const int row0 = u.pm * BM + wr * 64 + fr;
        if (u.pn == 22) {
            if (wc == 0) {
#pragma unroll
                for (int ai = 0; ai < 2; ++ai)
#pragma unroll
                    for (int m = 0; m < 4; ++m) { float* p = dtg + (size_t)(row0 + ai * HALF + m * 16) * 32 + 8 * fq; *(f32x4*)p = acc[ai][0][m][0]; *(f32x4*)(p + 4) = acc[ai][0][m][1]; }
            }
            return;
        }
        const int col0 = u.pn * BM + wc * 32 + 8 * fq;
#pragma unroll
        for (int ai = 0; ai < 2; ++ai)
#pragma unroll
            for (int m = 0; m < 4; ++m) { bf16_t* rowp = O + (size_t)(row0 + ai * HALF + m * 16) * NO_IN + col0;
#pragma unroll
                for (int bj = 0; bj < 2; ++bj) { const f32x4 v0 = acc[ai][bj][m][0], v1 = acc[ai][bj][m][1];
                    u32x4 w; w.x = cvt_pk_bf16(v0[0], v0[1]); w.y = cvt_pk_bf16(v0[2], v0[3]); w.z = cvt_pk_bf16(v1[0], v1[1]); w.w = cvt_pk_bf16(v1[2], v1[3]);
                    *(u32x4*)(rowp + bj * HALF) = w; } }
    }
};
struct EpiResid {
    static constexpr bool PERM = false;
    const float* base; float* out;
    __device__ __forceinline__ void operator()(const f32x4 (&acc)[2][2][4][2], const Unit& u, int wr, int wc, int fr, int fq) const {
        const int col0 = u.pn * BM + wc * 32 + 4 * fq;
#pragma unroll
        for (int ai = 0; ai < 2; ++ai)
#pragma unroll
            for (int m = 0; m < 4; ++m) { const size_t off = (size_t)(u.pm * BM + ai * HALF + wr * 64 + m * 16 + fr) * DM + col0;
#pragma unroll
                for (int bj = 0; bj < 2; ++bj)
#pragma unroll
                    for (int n = 0; n < 2; ++n) { const f32x4 bs = *(const f32x4*)(base + off + bj * HALF + n * 16); *(f32x4*)(out + off + bj * HALF + n * 16) = bs + acc[ai][bj][m][n]; } }
    }
};
template <bool BASE_F32> struct EpiResidB {
    static constexpr bool PERM = true;
    const void* base; bf16_t* out;
    __device__ __forceinline__ void operator()(const f32x4 (&acc)[2][2][4][2], const Unit& u, int wr, int wc, int fr, int fq) const {
        const int row0 = u.pm * BM + wr * 64 + fr, col0 = u.pn * BM + wc * 32 + 8 * fq;
#pragma unroll
        for (int ai = 0; ai < 2; ++ai)
#pragma unroll
            for (int m = 0; m < 4; ++m) { const size_t ro = (size_t)(row0 + ai * HALF + m * 16) * DM + col0;
#pragma unroll
                for (int bj = 0; bj < 2; ++bj) { f32x4 v0 = acc[ai][bj][m][0], v1 = acc[ai][bj][m][1];
                    if (BASE_F32) { const float* b = (const float*)base + ro + bj * HALF; v0 += __builtin_nontemporal_load((const f32x4*)b); v1 += __builtin_nontemporal_load((const f32x4*)(b + 4)); }
                    else { const u32x4 bb = *(const u32x4*)((const bf16_t*)base + ro + bj * HALF);
                        v0[0] += __uint_as_float(bb.x << 16); v0[1] += __uint_as_float(bb.x & 0xffff0000u); v0[2] += __uint_as_float(bb.y << 16); v0[3] += __uint_as_float(bb.y & 0xffff0000u);
                        v1[0] += __uint_as_float(bb.z << 16); v1[1] += __uint_as_float(bb.z & 0xffff0000u); v1[2] += __uint_as_float(bb.w << 16); v1[3] += __uint_as_float(bb.w & 0xffff0000u); }
                    u32x4 w; w.x = cvt_pk_bf16(v0[0], v0[1]); w.y = cvt_pk_bf16(v0[2], v0[3]); w.z = cvt_pk_bf16(v1[0], v1[1]); w.w = cvt_pk_bf16(v1[2], v1[3]);
                    *(u32x4*)(out + ro + bj * HALF) = w; } }
    }
};
struct EpiGateUp {
    static constexpr bool PERM = false;
    bf16_t* H;
    __device__ __forceinline__ void operator()(const f32x4 (&acc)[2][2][4][2], const Unit& u, int wr, int wc, int fr, int fq) const {
#pragma unroll
        for (int ai = 0; ai < 2; ++ai)
#pragma unroll
            for (int m = 0; m < 4; ++m) { bf16_t* rowp = H + (size_t)(u.pm * BM + ai * HALF + wr * 64 + m * 16 + fr) * 512;
#pragma unroll
                for (int bj = 0; bj < 2; ++bj) { const int j0 = (u.pn * 8 + bj * 4 + wc) * 16 + 4 * fq; const f32x4 g = acc[ai][bj][m][0], up = acc[ai][bj][m][1];
                    u32x2 w; w.x = cvt_pk_bf16(siluf(g[0]) * up[0], siluf(g[1]) * up[1]); w.y = cvt_pk_bf16(siluf(g[2]) * up[2], siluf(g[3]) * up[3]);
                    *(u32x2*)(rowp + j0) = w; } }
    }
};
struct EpiDown {
    static constexpr bool PERM = true;
    bf16_t* Y; const int* lists; const float* gates; const volatile LAS int* cnt;
    __device__ __forceinline__ void operator()(const f32x4 (&acc)[2][2][4][2], const Unit& u, int wr, int wc, int fr, int fq) const {
        const int n = cnt[u.e], last = n - 1; const int col0 = u.pn * BM + wc * 32 + 8 * fq; const int* lp = lists + u.e * CAP; const int rb = u.j * BM + wr * 64 + fr;
        int av[2][4]; float gv[2][4];
#pragma unroll
        for (int ai = 0; ai < 2; ++ai)
#pragma unroll
            for (int m = 0; m < 4; ++m) { const int ri = rb + ai * HALF + m * 16; av[ai][m] = lp[ri < last ? ri : last]; }
#pragma unroll
        for (int ai = 0; ai < 2; ++ai)
#pragma unroll
            for (int m = 0; m < 4; ++m) gv[ai][m] = gates[av[ai][m]];
#pragma unroll
        for (int ai = 0; ai < 2; ++ai)
#pragma unroll
            for (int m = 0; m < 4; ++m) { const int ri = rb + ai * HALF + m * 16;
                if (ri < n) { const int a = av[ai][m]; const float g = gv[ai][m]; bf16_t* rowp = Y + ((size_t)(a & 1) * T + (a >> 1)) * DM + col0;
#pragma unroll
                    for (int bj = 0; bj < 2; ++bj) { const f32x4 v0 = acc[ai][bj][m][0] * g, v1 = acc[ai][bj][m][1] * g;
                        u32x4 w; w.x = cvt_pk_bf16(v0[0], v0[1]); w.y = cvt_pk_bf16(v0[2], v0[3]); w.z = cvt_pk_bf16(v1[0], v1[1]); w.w = cvt_pk_bf16(v1[2], v1[3]);
                        *(u32x4*)(rowp + bj * HALF) = w; } } }
    }
};

template <class Epi, class Sched, bool ALIGN_EPI>
__device__ __forceinline__ void gemm_phase(LAS unsigned char* lds, const Gemm g, const Sched& S, const Epi& E) {
    const int tid = threadIdx.x, wid = __builtin_amdgcn_readfirstlane(tid >> 6), lane = tid & 63, wr = wid >> 2, wc = wid & 3, fr = lane & 15, fq = lane >> 4;
    const int K = g.K, nt = K / BK;
    int RA[2]; unsigned cbA[2], voffB[2];
#pragma unroll
    for (int i = 0; i < 2; ++i) { int R, C; stage_rc(tid * 16 + i * 8192, R, C); const int Rb = Epi::PERM ? ((R & ~31) + perm32(R & 31)) : R;
        RA[i] = R; cbA[i] = (unsigned)C * 2u; voffB[i] = (unsigned)(Rb * K + C) * 2u; }
    const unsigned kstep = (unsigned)(BK * 2);
    const size_t hstep = (size_t)HALF * K * 2;
    const size_t tstep = 2 * hstep;
    const unsigned rowb = (unsigned)K * 2u;
    const unsigned ldsw = (unsigned)wid * 1024u;
    const int aoff = lds_byte(wr * 64 + fr, fq * 8), boff = lds_byte(wc * 32 + fr, fq * 8);
    const char* Ab = (const char*)g.A;
#define PG8_SA(b, h) (((b) * 2 + (h)) * HTB)
#define PG8_SB(b, h) ((4 + (b) * 2 + (h)) * HTB)
#define PG8_STAGE(bufoff, gbase, voff) do { _Pragma("unroll") for (int _i = 0; _i < 2; ++_i) \
        __builtin_amdgcn_global_load_lds((const unsigned*)((const char*)(gbase) + (voff)[_i]), (LAS unsigned*)(lds + (bufoff) + ldsw + _i * 8192), 16, 0, 0); } while (0)
#define PG8_STAGE_A(bufoff, kb, o0, o1) do { \
        __builtin_amdgcn_global_load_lds((const unsigned*)(Ab + (kb) + (o0)), (LAS unsigned*)(lds + (bufoff) + ldsw), 16, 0, 0); \
        __builtin_amdgcn_global_load_lds((const unsigned*)(Ab + (kb) + (o1)), (LAS unsigned*)(lds + (bufoff) + ldsw + 8192), 16, 0, 0); } while (0)
#define PG8_LDA(dst, b, h) do { _Pragma("unroll") for (int m = 0; m < 4; ++m) _Pragma("unroll") for (int k = 0; k < 2; ++k) dst[m][k] = *(const LAS bf16x8*)(lds + PG8_SA(b, h) + aoff + m * 2048 + k * 1024); } while (0)
#define PG8_LDB(dst, b, h) do { _Pragma("unroll") for (int n = 0; n < 2; ++n) _Pragma("unroll") for (int k = 0; k < 2; ++k) dst[n][k] = *(const LAS bf16x8*)(lds + PG8_SB(b, h) + boff + n * 2048 + k * 1024); } while (0)
#define PG8_MMA(ai, bj, At, Bt) do { __builtin_amdgcn_s_setprio(1); _Pragma("unroll") for (int m = 0; m < 4; ++m) _Pragma("unroll") for (int n = 0; n < 2; ++n) _Pragma("unroll") for (int k = 0; k < 2; ++k) \
        acc[ai][bj][m][n] = __builtin_amdgcn_mfma_f32_16x16x32_bf16(Bt[n][k], At[m][k], acc[ai][bj][m][n], 0, 0, 0); __builtin_amdgcn_s_setprio(0); } while (0)
#define PG8_WAIT_V(n) asm volatile("s_waitcnt vmcnt(" #n ")" ::: "memory")
#define PG8_WAIT_L(n) asm volatile("s_waitcnt lgkmcnt(" #n ")" ::: "memory")
#define PG8_BAR __builtin_amdgcn_s_barrier()
#define PG8_SCHED __builtin_amdgcn_sched_barrier(0)
    Unit cur, nxt; int ui = 0;
    if (!S.next(0, cur)) return;
    f32x4 acc[2][2][4][2];
#pragma unroll
    for (int a = 0; a < 2; ++a)
#pragma unroll
        for (int b = 0; b < 2; ++b)
#pragma unroll
            for (int m = 0; m < 4; ++m)
#pragma unroll
                for (int n = 0; n < 2; ++n) acc[a][b][m][n] = (f32x4){0.f, 0.f, 0.f, 0.f};
    bf16x8 At[4][2], B0[2][2], B1[2][2];
    unsigned oC00, oC01, oC10, oC11;
    { unsigned ar[4]; S.arow4(cur, RA[0], RA[1], ar); oC00 = ar[0] * rowb + cbA[0]; oC01 = ar[1] * rowb + cbA[1]; oC10 = ar[2] * rowb + cbA[0]; oC11 = ar[3] * rowb + cbA[1]; }
    const char* cB = (const char*)g.Bt + (size_t)cur.e * g.b_estride + (size_t)cur.pn * tstep;
    PG8_STAGE(PG8_SB(0, 0), cB, voffB); PG8_STAGE(PG8_SB(0, 1), cB + hstep, voffB); PG8_STAGE_A(PG8_SA(0, 0), 0u, oC00, oC01); PG8_STAGE_A(PG8_SA(0, 1), 0u, oC10, oC11);
    if (wr == 1) PG8_BAR;
    PG8_WAIT_V(2); PG8_BAR;
    PG8_STAGE(PG8_SB(1, 0), cB + kstep, voffB); PG8_STAGE_A(PG8_SA(1, 0), kstep, oC00, oC01); PG8_STAGE(PG8_SB(1, 1), cB + hstep + kstep, voffB);
    PG8_WAIT_V(6); PG8_BAR;
    for (;;) {
        const bool has_next = S.next(ui + 1, nxt);
        unsigned oN00 = oC00, oN01 = oC01, oN10 = oC10, oN11 = oC11;
        if (has_next) { unsigned ar[4]; S.arow4(nxt, RA[0], RA[1], ar); oN00 = ar[0] * rowb + cbA[0]; oN01 = ar[1] * rowb + cbA[1]; oN10 = ar[2] * rowb + cbA[0]; oN11 = ar[3] * rowb + cbA[1]; }
        const char* nB = has_next ? (const char*)g.Bt + (size_t)nxt.e * g.b_estride + (size_t)nxt.pn * tstep : cB;
        for (int t = 0; t < nt; t += 2) {
            const bool last = (t == nt - 2);
            const unsigned k1 = (unsigned)(t + 1) * kstep;
            const unsigned k2 = last ? 0u : (unsigned)(t + 2) * kstep, k3 = k2 + kstep;
            const unsigned o00 = last ? oN00 : oC00, o01 = last ? oN01 : oC01, o10 = last ? oN10 : oC10, o11 = last ? oN11 : oC11;
            const char* b2 = last ? nB : cB + (size_t)(t + 2) * kstep; const char* b3 = b2 + kstep;
            PG8_LDB(B0, 0, 0); PG8_LDB(B1, 0, 1); PG8_SCHED; PG8_LDA(At, 0, 0); PG8_STAGE_A(PG8_SA(1, 1), k1, oC10, oC11);
            PG8_WAIT_V(8); PG8_WAIT_L(0); PG8_BAR; PG8_MMA(0, 0, At, B0); PG8_MMA(0, 1, At, B1); PG8_BAR; PG8_SCHED;
            PG8_LDA(At, 0, 1); PG8_STAGE(PG8_SB(0, 0), b2, voffB); PG8_STAGE(PG8_SB(0, 1), b2 + hstep, voffB); PG8_STAGE_A(PG8_SA(0, 0), k2, o00, o01);
            PG8_WAIT_V(8); PG8_WAIT_L(0); PG8_BAR; PG8_MMA(1, 0, At, B0); PG8_MMA(1, 1, At, B1); PG8_BAR; PG8_SCHED;
            PG8_LDB(B0, 1, 0); PG8_LDB(B1, 1, 1); PG8_SCHED; PG8_LDA(At, 1, 0); PG8_STAGE_A(PG8_SA(0, 1), k2, o10, o11);
            PG8_WAIT_V(8); PG8_WAIT_L(0); PG8_BAR; PG8_MMA(0, 0, At, B0); PG8_MMA(0, 1, At, B1); PG8_BAR; PG8_SCHED;
            PG8_LDA(At, 1, 1); PG8_STAGE(PG8_SB(1, 0), b3, voffB); PG8_STAGE(PG8_SB(1, 1), b3 + hstep, voffB); PG8_STAGE_A(PG8_SA(1, 0), k3, o00, o01);
            PG8_WAIT_V(8); PG8_WAIT_L(0); PG8_BAR; PG8_MMA(1, 0, At, B0); PG8_MMA(1, 1, At, B1); PG8_BAR; PG8_SCHED;
        }
        if constexpr (ALIGN_EPI) { if (wr == 0) PG8_BAR; }
        E(acc, cur, wr, wc, fr, fq);
        if (!has_next) break;
#pragma unroll
        for (int a = 0; a < 2; ++a)
#pragma unroll
            for (int b = 0; b < 2; ++b)
#pragma unroll
                for (int m = 0; m < 4; ++m)
#pragma unroll
                    for (int n = 0; n < 2; ++n) acc[a][b][m][n] = (f32x4){0.f, 0.f, 0.f, 0.f};
        cur = nxt; cB = nB; oC00 = oN00; oC01 = oN01; oC10 = oN10; oC11 = oN11; ++ui;
        if constexpr (ALIGN_EPI) { if (wr == 1) PG8_BAR; }
    }
    PG8_WAIT_V(0);
    if constexpr (!ALIGN_EPI) { if (wr == 0) PG8_BAR; }
    PG8_BAR;
#undef PG8_SA
#undef PG8_SB
#undef PG8_STAGE
#undef PG8_STAGE_A
#undef PG8_LDA
#undef PG8_LDB
#undef PG8_MMA
#undef PG8_WAIT_V
#undef PG8_WAIT_L
#undef PG8_BAR
#undef PG8_SCHED
}
}
}
namespace att {
using namespace mk;
constexpr int KVBLK = 64;
constexpr int A_K = 0, A_V = 32768, A_WS = 65536, A_OST = A_WS + NWAVES * 256, A_BIAS = A_OST + NWAVES * 4096, A_SCAN = A_BIAS + 8192, A_BYTES = A_SCAN + 64;
static_assert(A_BYTES <= RING_BYTES, "attention LDS");
__device__ __forceinline__ int crow(int r, int hi) { return (r & 3) + 8 * (r >> 2) + 4 * hi; }
__device__ __forceinline__ void glds16(const void* gsrc, unsigned lds_dst) { unsigned keep;
    asm volatile("s_mov_b32 %0, m0\n\ts_mov_b32 m0, %2\n\ts_nop 0\n\tglobal_load_lds_dwordx4 %1, off\n\ts_mov_b32 m0, %0" : "=&s"(keep) : "v"(gsrc), "s"(lds_dst) : "memory"); }
__device__ __forceinline__ unsigned cvtpk(float lo, float hi) { return cvt_pk_bf16(lo, hi); }
__device__ __forceinline__ void qkt(f32x16& p0, f32x16& p1, const LAS char* Kslot, const bf16x8* qr, int r32, int hi) {
    const LAS char* kb = Kslot + hi * 1024 + r32 * 16;
    const f32x16 z = {};
#pragma unroll
    for (int d0 = 0; d0 < 4; ++d0) {
        const bf16x8 b0 = *(const LAS bf16x8*)(kb + d0 * 2048);
        const bf16x8 b1 = *(const LAS bf16x8*)(kb + d0 * 2048 + 512);
        if (d0 == 0) { p0 = __builtin_amdgcn_mfma_f32_32x32x16_bf16(b0, qr[0], z, 0, 0, 0); p1 = __builtin_amdgcn_mfma_f32_32x32x16_bf16(b1, qr[0], z, 0, 0, 0); }
        else { p0 = __builtin_amdgcn_mfma_f32_32x32x16_bf16(b0, qr[d0], p0, 0, 0, 0); p1 = __builtin_amdgcn_mfma_f32_32x32x16_bf16(b1, qr[d0], p1, 0, 0, 0); } }
}
__device__ __forceinline__ void pv(f32x16* o, int vb, bf16x8 pa0, bf16x8 pa1, bf16x8 pa2, bf16x8 pa3) {
#pragma unroll
    for (int d0 = 0; d0 < 2; ++d0) { s16x4 lo[4], hi[4];
#pragma unroll
        for (int ks = 0; ks < 4; ++ks) {
            asm volatile("ds_read_b64_tr_b16 %0,%1 offset:%c2" : "=&v"(lo[ks]) : "v"(vb), "i"(d0 * 4096 + ks * 1024) : "memory");
            asm volatile("ds_read_b64_tr_b16 %0,%1 offset:%c2" : "=&v"(hi[ks]) : "v"(vb), "i"(d0 * 4096 + ks * 1024 + 512) : "memory"); }
        asm volatile("s_waitcnt lgkmcnt(0)" ::: "memory"); __builtin_amdgcn_sched_barrier(0);
#define PK(k) (bf16x8){lo[k][0], lo[k][1], lo[k][2], lo[k][3], hi[k][0], hi[k][1], hi[k][2], hi[k][3]}
        o[d0] = __builtin_amdgcn_mfma_f32_32x32x16_bf16(pa0, PK(0), o[d0], 0, 0, 0);
        o[d0] = __builtin_amdgcn_mfma_f32_32x32x16_bf16(pa1, PK(1), o[d0], 0, 0, 0);
        o[d0] = __builtin_amdgcn_mfma_f32_32x32x16_bf16(pa2, PK(2), o[d0], 0, 0, 0);
        o[d0] = __builtin_amdgcn_mfma_f32_32x32x16_bf16(pa3, PK(3), o[d0], 0, 0, 0);
#undef PK
    }
}
__device__ __forceinline__ float rowmax32(const f32x16& p0, const f32x16& p1) {
    float a = fmaxf(p0[0], p1[0]);
#pragma unroll
    for (int r = 1; r < 16; ++r) a = fmaxf(a, fmaxf(p0[r], p1[r]));
    auto rr = __builtin_amdgcn_permlane32_swap(__float_as_uint(a), __float_as_uint(a), false, false);
    return fmaxf(__uint_as_float(rr[0]), __uint_as_float(rr[1]));
}
#define A_WAIT_BAR(N) asm volatile("s_waitcnt vmcnt(" #N ") lgkmcnt(0)\n\ts_barrier" ::: "memory")

template <bool SWA>
__device__ __forceinline__ void attn_tiles(LAS char* shm, const bf16_t* Qw, int qpitch, const bf16_t* Kh, const bf16_t* Vh, int kvpitch, bf16_t* Ow, int opitch,
                                           int kt0, int ntile, int qpos0, float sl2, float sink2) {
    const int tid = threadIdx.x, lane = tid & 63, r32 = lane & 31, hi = lane >> 5; const int wid = __builtin_amdgcn_readfirstlane(tid >> 6);
    const unsigned lds0 = (unsigned)(uintptr_t)shm;
    LAS float* wsf = (LAS float*)(shm + A_WS) + wid * 64;
    const LAS float* biasl = (const LAS float*)(shm + A_BIAS);
    const bf16_t* ksrc = Kh + (long)lane * kvpitch + wid * 8;
    const bf16_t* vsrc = Vh + (long)(16 * (wid & 3) + (lane >> 2)) * kvpitch + (wid >> 2) * 32 + (lane & 3) * 8;
    const unsigned kdst = lds0 + A_K + wid * 1024, vdst = lds0 + A_V + wid * 1024;
#define DMA_K(t, slot) glds16(ksrc + (long)(t) * KVBLK * kvpitch, (unsigned)__builtin_amdgcn_readfirstlane(kdst + (slot)))
#define DMA_V(t, slot) glds16(vsrc + (long)(t) * KVBLK * kvpitch, (unsigned)__builtin_amdgcn_readfirstlane(vdst + (slot)))
    const int vb0 = (int)(lds0 + A_V) + ((lane >> 4) & 1) * 32 + (lane & 3) * 8 + (4 * hi + ((lane & 15) >> 2)) * 64;
    DMA_K(kt0, 0); DMA_V(kt0, 0);
    if (ntile > 1) { DMA_K(kt0 + 1, 8192); DMA_V(kt0 + 1, 8192); }
    if (ntile > 2) { DMA_K(kt0 + 2, 16384); DMA_V(kt0 + 2, 16384); }
    bf16x8 qr[4];
#pragma unroll
    for (int d0 = 0; d0 < 4; ++d0) qr[d0] = *(const bf16x8*)(Qw + (long)r32 * qpitch + d0 * 16 + hi * 8);
    float m = SWA ? sink2 : -INFINITY, l = (SWA && hi == 0) ? 1.f : 0.f;
    f32x16 o[2]; o[0] = f32x16{}; o[1] = f32x16{};
    const int qpos = qpos0 + r32;
    if (ntile > 2) { A_WAIT_BAR(4); } else if (ntile > 1) { A_WAIT_BAR(2); } else { A_WAIT_BAR(0); }
    f32x16 p0, p1;
    qkt(p0, p1, shm + A_K, qr, r32, hi);
    for (int it = 0; it < ntile; ++it) {
        const int kt = kt0 + it, slot = (it & 3) * 8192;
        f32x16 n0, n1;
        if (it + 1 < ntile) {
            if (it + 2 < ntile) { A_WAIT_BAR(2); } else { A_WAIT_BAR(0); }
            if (it + 3 < ntile) { DMA_K(kt + 3, ((it + 3) & 3) * 8192); DMA_V(kt + 3, ((it + 3) & 3) * 8192); }
            qkt(n0, n1, shm + A_K + ((it + 1) & 3) * 8192, qr, r32, hi);
        }
        const int kb = kt * 64 + 4 * hi;
        if (SWA) {
#pragma unroll
            for (int r = 0; r < 16; ++r) { const int k0 = kb + (r & 3) + 8 * (r >> 2), k1 = k0 + 32;
                p0[r] = (k0 <= qpos && k0 >= qpos - 127) ? p0[r] + sl2 * (float)(k0 - qpos) : -INFINITY;
                p1[r] = (k1 <= qpos && k1 >= qpos - 127) ? p1[r] + sl2 * (float)(k1 - qpos) : -INFINITY; }
        } else {
#pragma unroll
            for (int g = 0; g < 4; ++g) { const f32x4 b0 = *(const LAS f32x4*)(biasl + kb + 8 * g), b1 = *(const LAS f32x4*)(biasl + kb + 32 + 8 * g);
#pragma unroll
                for (int i = 0; i < 4; ++i) { p0[4 * g + i] += b0[i]; p1[4 * g + i] += b1[i]; } }
            if (kt * 64 + 63 > qpos0) {
#pragma unroll
                for (int r = 0; r < 16; ++r) { const int k0 = kb + (r & 3) + 8 * (r >> 2); if (k0 > qpos) p0[r] = -INFINITY; if (k0 + 32 > qpos) p1[r] = -INFINITY; }
            }
        }
        const float rm = rowmax32(p0, p1), mn = fmaxf(m, rm), ms = (mn == -INFINITY) ? 0.f : mn;
        const float alpha = __builtin_amdgcn_exp2f(m - ms);
        float rs = 0.f;
#pragma unroll
        for (int r = 0; r < 16; ++r) { p0[r] = __builtin_amdgcn_exp2f(p0[r] - ms); p1[r] = __builtin_amdgcn_exp2f(p1[r] - ms); rs += p0[r] + p1[r]; }
        l = l * alpha + rs; m = mn;
        if (hi == 0) wsf[r32] = alpha;
        asm volatile("s_waitcnt lgkmcnt(0)" ::: "memory");
#pragma unroll
        for (int r = 0; r < 16; ++r) { const float a = wsf[crow(r, hi)]; o[0][r] *= a; o[1][r] *= a; }
        u32x4 pw0, pw1, pw2, pw3;
        pw0 = (u32x4){cvtpk(p0[0], p0[1]), cvtpk(p0[2], p0[3]), cvtpk(p0[4], p0[5]), cvtpk(p0[6], p0[7])};
        pw1 = (u32x4){cvtpk(p0[8], p0[9]), cvtpk(p0[10], p0[11]), cvtpk(p0[12], p0[13]), cvtpk(p0[14], p0[15])};
        pw2 = (u32x4){cvtpk(p1[0], p1[1]), cvtpk(p1[2], p1[3]), cvtpk(p1[4], p1[5]), cvtpk(p1[6], p1[7])};
        pw3 = (u32x4){cvtpk(p1[8], p1[9]), cvtpk(p1[10], p1[11]), cvtpk(p1[12], p1[13]), cvtpk(p1[14], p1[15])};
        pv(o, vb0 + slot, __builtin_bit_cast(bf16x8, pw0), __builtin_bit_cast(bf16x8, pw1), __builtin_bit_cast(bf16x8, pw2), __builtin_bit_cast(bf16x8, pw3));
        asm volatile("s_waitcnt lgkmcnt(0)" ::: "memory");
        if (it + 1 < ntile) { p0 = n0; p1 = n1; }
    }
    { auto rr = __builtin_amdgcn_permlane32_swap(__float_as_uint(l), __float_as_uint(l), false, false); l = __uint_as_float(rr[0]) + __uint_as_float(rr[1]); }
    if (hi == 0) wsf[32 + r32] = l;
    asm volatile("s_waitcnt lgkmcnt(0)" ::: "memory");
    LAS bf16_t* stg = (LAS bf16_t*)(shm + A_OST) + wid * 2048;
#pragma unroll
    for (int r = 0; r < 16; ++r) { const int orow = crow(r, hi); const float rl = 1.f / wsf[32 + orow];
#pragma unroll
        for (int d0 = 0; d0 < 2; ++d0) stg[orow * 64 + d0 * 32 + r32] = (bf16_t)(cvt_pk_bf16(o[d0][r] * rl, 0.f) & 0xffffu); }
    asm volatile("s_waitcnt lgkmcnt(0)" ::: "memory");
#pragma unroll
    for (int i = 0; i < 4; ++i) { const int row = i * 8 + (lane >> 3), ch = lane & 7; const u32x4 v = *(const LAS u32x4*)(stg + row * 64 + ch * 8); *(u32x4*)(Ow + (long)row * opitch + ch * 8) = v; }
    asm volatile("s_waitcnt vmcnt(0) lgkmcnt(0)\n\ts_barrier" ::: "memory");
#undef DMA_K
#undef DMA_V
}

__device__ __forceinline__ void fox_unit(LAS char* shm, int b, int h, int qb, const bf16_t* proj, const float* fb, float fbias_h, bf16_t* heads) {
    const int tid = threadIdx.x, lane = tid & 63; const int wid = __builtin_amdgcn_readfirstlane(tid >> 6);
    LAS float* biasl = (LAS float*)(shm + A_BIAS); LAS float* scan = (LAS float*)(shm + A_SCAN);
    const int kend = (qb + 1) * 256;
    float v[4]; float s = 0.f;
#pragma unroll
    for (int i = 0; i < 4; ++i) { const int p = tid * 4 + i; float lf = 0.f; if (p < kend) lf = log_sigmoid_fast(fb[((size_t)b * SEQ + p) * 8 + h] + fbias_h); s += lf; v[i] = s; }
    float w = s;
#pragma unroll
    for (int o = 1; o < 64; o <<= 1) { const float t = __shfl_up(w, o); if (lane >= o) w += t; }
    if (lane == 63) scan[wid] = w;
    asm volatile("s_waitcnt lgkmcnt(0)\n\ts_barrier" ::: "memory");
    float off = w - s;
    for (int k = 0; k < 8; ++k) if (k < wid) off += scan[k];
#pragma unroll
    for (int i = 0; i < 4; ++i) biasl[tid * 4 + i] = -(v[i] + off) * LOG2E;
    asm volatile("s_waitcnt lgkmcnt(0)\n\ts_barrier" ::: "memory");
    const size_t rowb = (size_t)b * SEQ; const int q0 = qb * 256 + wid * 32;
    attn_tiles<false>(shm, proj + (rowb + q0) * NE_IN + 768 + h * 64, NE_IN, proj + rowb * NE_IN + 1280 + h * 64, proj + rowb * NE_IN + 1792 + h * 64, NE_IN,
                      heads + (rowb + q0) * 1024 + 512 + h * 64, 1024, 0, 4 * (qb + 1), q0, 0.f, 0.f);
}
__device__ __forceinline__ void swa_unit(LAS char* shm, int b, int kvh, int blk, const bf16_t* proj, const float* sinks, bf16_t* heads) {
    const int wid = __builtin_amdgcn_readfirstlane(threadIdx.x >> 6);
    const int qh = kvh * 4 + (wid >> 1), q0 = blk * 64 + (wid & 1) * 32;
    const size_t rowb = (size_t)b * SEQ;
    const int kt0 = blk >= 2 ? blk - 2 : 0, ntile = blk - kt0 + 1;
    const float sl2 = exp2f(-(float)(qh + 1)) * LOG2E, sink2 = sinks[qh] * LOG2E;
    attn_tiles<true>(shm, proj + (rowb + q0) * NE_IN + qh * 64, NE_IN, proj + rowb * NE_IN + 512 + kvh * 64, proj + rowb * NE_IN + 640 + kvh * 64, NE_IN,
                     heads + (rowb + q0) * 1024 + qh * 64, 1024, kt0, ntile, q0, sl2, sink2);
}
#undef A_WAIT_BAR
}

namespace attp {
using bf16=__hip_bfloat16;
using bf16x8=__attribute__((ext_vector_type(8)))short;
using s16x4=__attribute__((ext_vector_type(4)))short;
using f32x16=__attribute__((ext_vector_type(16)))float;
using u32x4=__attribute__((ext_vector_type(4)))unsigned;
constexpr int BATCH=8,NHEAD=8,SEQ=2048,D=64,DM=2560,OPITCH=1024;
constexpr int NW=8,QBLK=32,QB=QBLK*NW,KVBLK=64,NQB=SEQ/QB;
constexpr int ATTN_PITCH=DM, ATTN_UNIT_ROWS=QB;
__device__ __forceinline__ int crow(int r,int hi){return (r&3)+8*(r>>2)+4*hi;}
#define SBAR() __builtin_amdgcn_sched_barrier(0)
__device__ __forceinline__ void cmask(f32x16&p0,f32x16&p1,int jb,int qrel,int hi){
  const float NEG=-INFINITY; int kb=64*jb+4*hi;
  #pragma unroll
  for(int r=0;r<16;++r){int kv=kb+(r&3)+8*(r>>2); if(kv>qrel)p0[r]=NEG; if(kv+32>qrel)p1[r]=NEG;}
}

constexpr int NSLOT=3, SLOTB=8192;
constexpr int LDS_K=0, LDS_V=NSLOT*SLOTB, LDS_WS=2*NSLOT*SLOTB, LDS_OST=LDS_WS+NW*64*4, LDS_BIAS=LDS_OST+NW*4096, LDS_SCAN=LDS_BIAS+8192, LDS_BYTES=LDS_SCAN+64;
constexpr float C2=0.125f*1.4426950408889634f;
__device__ __forceinline__ void glds16(const void*gsrc,unsigned lds_dst){unsigned keep;
  asm volatile("s_mov_b32 %0, m0\n\ts_mov_b32 m0, %2\n\ts_nop 0\n\tglobal_load_lds_dwordx4 %1, off\n\ts_mov_b32 m0, %0":"=&s"(keep):"v"(gsrc),"s"(lds_dst):"memory");}
__device__ __forceinline__ float max3f(float a,float b,float c){float r;asm("v_max3_f32 %0, %1, %2, %3":"=v"(r):"v"(a),"v"(b),"v"(c));return r;}
__device__ __forceinline__ float max2f(float a,float b){float r;asm("v_max_f32_e32 %0, %1, %2":"=v"(r):"v"(a),"v"(b));return r;}
__device__ __forceinline__ float fadd_s(float a,float b){float r;asm("v_add_f32_e32 %0, %1, %2":"=v"(r):"v"(a),"v"(b));return r;}
__device__ __forceinline__ float fsub_s(float a,float b){float r;asm("v_sub_f32_e32 %0, %1, %2":"=v"(r):"v"(a),"v"(b));return r;}
typedef float f32x2_t __attribute__((ext_vector_type(2))); typedef __bf16 bf16x2_t __attribute__((ext_vector_type(2)));
__device__ __forceinline__ unsigned cvtpk_s(float lo,float hi){f32x2_t v={lo,hi};bf16x2_t b=__builtin_convertvector(v,bf16x2_t);return __builtin_bit_cast(unsigned,b);}
#define WAIT_BAR(N) asm volatile("s_waitcnt vmcnt(" #N ") lgkmcnt(0)\n\ts_barrier":::"memory")

__device__ __forceinline__ void qkt(f32x16&p0,f32x16&p1,const char*Kslot,const bf16x8*qr,int r32,int hi){ const f32x16 zc_=f32x16{};
  const char*kb=Kslot+hi*1024+r32*16;
  #pragma unroll
  for(int d0=0;d0<4;++d0){
    const bf16x8 b0=*reinterpret_cast<const bf16x8*>(kb+d0*2048);
    const bf16x8 b1=*reinterpret_cast<const bf16x8*>(kb+d0*2048+512);
    if(d0==0){p0=__builtin_amdgcn_mfma_f32_32x32x16_bf16(b0,qr[0],zc_,0,0,0);p1=__builtin_amdgcn_mfma_f32_32x32x16_bf16(b1,qr[0],zc_,0,0,0);}
    else{p0=__builtin_amdgcn_mfma_f32_32x32x16_bf16(b0,qr[d0],p0,0,0,0);p1=__builtin_amdgcn_mfma_f32_32x32x16_bf16(b1,qr[d0],p1,0,0,0);}}
}
typedef __attribute__((address_space(3))) const char* lds_cptr;
typedef short v4i16_t __attribute__((ext_vector_type(4)));
__device__ __forceinline__ void kload8(bf16x8*kf,lds_cptr kp){
  kf[0]=*(const __attribute__((address_space(3))) bf16x8*)(kp);      kf[1]=*(const __attribute__((address_space(3))) bf16x8*)(kp+512);
  kf[2]=*(const __attribute__((address_space(3))) bf16x8*)(kp+2048); kf[3]=*(const __attribute__((address_space(3))) bf16x8*)(kp+2560);
  kf[4]=*(const __attribute__((address_space(3))) bf16x8*)(kp+4096); kf[5]=*(const __attribute__((address_space(3))) bf16x8*)(kp+4608);
  kf[6]=*(const __attribute__((address_space(3))) bf16x8*)(kp+6144); kf[7]=*(const __attribute__((address_space(3))) bf16x8*)(kp+6656);
}
__device__ __forceinline__ void kload2(bf16x8*kf,lds_cptr kp,int j){ kf[2*j]=*(const __attribute__((address_space(3))) bf16x8*)(kp+j*2048); kf[2*j+1]=*(const __attribute__((address_space(3))) bf16x8*)(kp+j*2048+512); }
__device__ __forceinline__ s16x4 vtr(lds_cptr p){ return __builtin_bit_cast(s16x4,__builtin_amdgcn_ds_read_tr16_b64_v4i16((__attribute__((address_space(3))) v4i16_t*)p)); }
__device__ __forceinline__ float rowmax(const f32x16&p0,const f32x16&p1){
  float a=max3f(p0[0],p0[1],p1[0]),b=max3f(p0[2],p0[3],p1[1]);a=max3f(a,p1[2],p1[3]);
  #pragma unroll
  for(int r=4;r<16;r+=4){a=max3f(a,p0[r],p0[r+1]);b=max3f(b,p0[r+2],p0[r+3]);a=max3f(a,p1[r],p1[r+1]);b=max3f(b,p1[r+2],p1[r+3]);}
  const float m=max2f(a,b);
  auto rr=__builtin_amdgcn_permlane32_swap(__float_as_uint(m),__float_as_uint(m),false,false);
  return max2f(__uint_as_float(rr[0]),__uint_as_float(rr[1]));
}
__device__ __forceinline__ void pv(f32x16*o,int vb,bf16x8 pa0,bf16x8 pa1,bf16x8 pa2,bf16x8 pa3){
  #pragma unroll
  for(int d0=0;d0<2;++d0){s16x4 lo[4],hi[4];
    #pragma unroll
    for(int ks=0;ks<4;++ks){
      asm volatile("ds_read_b64_tr_b16 %0,%1 offset:%c2":"=&v"(lo[ks]):"v"(vb),"i"(d0*4096+ks*1024):"memory");
      asm volatile("ds_read_b64_tr_b16 %0,%1 offset:%c2":"=&v"(hi[ks]):"v"(vb),"i"(d0*4096+ks*1024+512):"memory");}
    asm volatile("s_waitcnt lgkmcnt(0)":::"memory");SBAR();
    #define PK(k) (bf16x8){lo[k][0],lo[k][1],lo[k][2],lo[k][3],hi[k][0],hi[k][1],hi[k][2],hi[k][3]}
    o[d0]=__builtin_amdgcn_mfma_f32_32x32x16_bf16(pa0,PK(0),o[d0],0,0,0);
    o[d0]=__builtin_amdgcn_mfma_f32_32x32x16_bf16(pa1,PK(1),o[d0],0,0,0);
    o[d0]=__builtin_amdgcn_mfma_f32_32x32x16_bf16(pa2,PK(2),o[d0],0,0,0);
    o[d0]=__builtin_amdgcn_mfma_f32_32x32x16_bf16(pa3,PK(3),o[d0],0,0,0);
    #undef PK
  }
}

#ifndef ATTN_STORE16
#define ATTN_STORE16(p,v) (*(u32x4*)(p)=(v))
#endif
template<int THRL,bool CHECK> __device__ __forceinline__ void attn_unit(int b,int h,int qb,const bf16*Q,const bf16*__restrict__ K,const bf16*__restrict__ V,bf16*O,char*shm,unsigned*mism){
  const int tid=threadIdx.x,lane=tid&63,r32=lane&31,hi=lane>>5; const int wid=__builtin_amdgcn_readfirstlane(tid>>6);
  const long rowbase=(long)b*SEQ; const int q0=qb*QB;
  const bf16*Qw=Q+(rowbase+q0+wid*QBLK)*DM+h*D;
  const bf16*Kh=K+rowbase*DM+h*D,*Vh=V+rowbase*DM+h*D;
  const unsigned lds0=(unsigned)(uintptr_t)shm;
  float*wsf=(float*)(shm+LDS_WS)+wid*64;
  const bf16*ksrc=Kh+(long)lane*DM+wid*8;
  const bf16*vsrc=Vh+(long)(16*(wid&3)+(lane>>2))*DM+(wid>>2)*32+(lane&3)*8;
  const unsigned kdst=lds0+LDS_K+wid*1024, vdst=lds0+LDS_V+wid*1024;
  #define DMA_K(t,slot) glds16(ksrc+(long)(t)*KVBLK*DM,(unsigned)__builtin_amdgcn_readfirstlane(kdst+(slot)))
  #define DMA_V(t,slot) glds16(vsrc+(long)(t)*KVBLK*DM,(unsigned)__builtin_amdgcn_readfirstlane(vdst+(slot)))
  const int vb0=(int)(lds0+LDS_V)+((lane>>4)&1)*32+(lane&3)*8+(4*hi+((lane&15)>>2))*64;
  const char*Kbase=shm+LDS_K; bf16x8 kf[8];
  const lds_cptr shm3=(lds_cptr)shm; const lds_cptr kp0=shm3+LDS_K+hi*1024+r32*16; const lds_cptr vp0=shm3+LDS_V+((lane>>4)&1)*32+(lane&3)*8+(4*hi+((lane&15)>>2))*64;
  const int NT=(q0+QB)/KVBLK;
  DMA_K(0,0);DMA_V(0,0);DMA_K(1,SLOTB);
  bf16x8 qr[4];
  #pragma unroll
  for(int d0=0;d0<4;++d0)qr[d0]=*reinterpret_cast<const bf16x8*>(&Qw[(long)r32*DM+d0*16+hi*8]);
  float mhat=0.f,l_reg=0.f;f32x16 o[2];o[0]=f32x16{};o[1]=f32x16{};u32x4 qaw={hi==0?0x3f803f80u:0u,0u,0u,0u};
  const int qrel=wid*QBLK+r32;
  #define CMASK(P0,P1,t) do{int jb_=(t)-(NT-4); if(jb_>=0)cmask(P0,P1,jb_,qrel,hi);}while(0)
  const __attribute__((address_space(3))) unsigned* biasw=(const __attribute__((address_space(3))) unsigned*)(shm3+LDS_BIAS)+r32;
  #define SETM() do{ const float nm_=-mhat; const unsigned h_=cvtpk_s(nm_,0.f)&0xffffu; const unsigned l_=cvtpk_s(nm_-__uint_as_float(h_<<16),0.f)&0xffffu; qaw[1]=(hi==0)?(h_|(l_<<16)):0u; }while(0)
  #define AUG(P0,P1,t) do{ const unsigned w0_=biasw[64*(t)], w1_=biasw[64*(t)+32]; const u32x4 ka0_={w0_,0x3f803f80u,0u,0u}, ka1_={w1_,0x3f803f80u,0u,0u}; \
      P0=__builtin_amdgcn_mfma_f32_32x32x16_bf16(__builtin_bit_cast(bf16x8,ka0_),__builtin_bit_cast(bf16x8,qaw),P0,0,0,0); \
      P1=__builtin_amdgcn_mfma_f32_32x32x16_bf16(__builtin_bit_cast(bf16x8,ka1_),__builtin_bit_cast(bf16x8,qaw),P1,0,0,0); }while(0)
  bool resc=false;
  #define START(P0,P1) do{ const float rm=rowmax(P0,P1); resc=false; \
    { const float dl=rm; mhat=fadd_s(mhat,dl); \
      _Pragma("unroll") for(int r=0;r<16;++r){P0[r]=fsub_s(P0[r],dl);P1[r]=fsub_s(P1[r],dl);} \
      SETM(); } \
    _Pragma("unroll") for(int r=0;r<16;++r)P0[r]=__builtin_amdgcn_exp2f(P0[r]); }while(0)
  #define RESC() do{ if(resc){ asm volatile("s_waitcnt lgkmcnt(0)":::"memory"); \
      _Pragma("unroll") for(int d_=0;d_<2;++d_) _Pragma("unroll") for(int r=0;r<16;++r)o[d_][r]*=wsf[crow(r,hi)]; } }while(0)
  f32x16 pA0,pA1,pB0,pB1;
  int sl_prev=0,sl_cur=0,sl_next=SLOTB;
  #define ROT() do{sl_prev=sl_cur;sl_cur=sl_next;sl_next=(sl_next==(NSLOT-1)*SLOTB)?0:sl_next+SLOTB;}while(0)
  DMA_K(2,2*SLOTB);
  WAIT_BAR(3);
  qkt(pA0,pA1,Kbase,qr,r32,hi);AUG(pA0,pA1,0);asm volatile("s_nop 15\n\ts_nop 7":"+v"(pA0),"+v"(pA1));CMASK(pA0,pA1,0);
  START(pA0,pA1);
  _Pragma("unroll") for(int r=0;r<16;++r)pA1[r]=__builtin_amdgcn_exp2f(pA1[r]);
  WAIT_BAR(0);
  DMA_K(3,0);DMA_V(1,SLOTB);
  ROT();
  kload8(kf,kp0+sl_cur);
  WAIT_BAR(2);
  s16x4 vlo[8],vhi[8]; u32x4 pw0,pw1,pw2,pw3; const f32x16 zc16=f32x16{};
  #define PKW(P,B) cvtpk_s(P[B],P[B+1])
  #define PAF(k) __builtin_bit_cast(bf16x8,pw##k)
  #define VFR(i) (bf16x8){vlo[i][0],vlo[i][1],vlo[i][2],vlo[i][3],vhi[i][0],vhi[i][1],vhi[i][2],vhi[i][3]}
  #define PIN(x) asm volatile("":"+v"(x))
  #define MX3(a,b,c) __builtin_fmaxf(__builtin_fmaxf((a),(b)),(c))
  #define GAPA(MF,A0,A1,A2,A3,W0,W1,PW) do{ MF; sacc+=A0; sacc+=A1; sacc+=A2; sacc+=A3; PIN(sacc); W0; W1; PIN(PW); SBAR(); }while(0)
  #define EX(v) __builtin_amdgcn_exp2f(v)
  #define GAPB(MF,X,B) do{ MF; X[B]=EX(X[B]); X[B+1]=EX(X[B+1]); X[B+2]=EX(X[B+2]); X[B+3]=EX(X[B+3]); PIN(X); SBAR(); }while(0)
  #define VRD(i) do{ vlo[i]=vtr(vp_+(((i)>>2)*4096+((i)&3)*1024)); vhi[i]=vtr(vp_+(((i)>>2)*4096+((i)&3)*1024+512)); }while(0)
  #define KRD(G,j) do{ if(G){ kload2(kf,kp0+sl_next,j); SBAR(); } }while(0)
  #define STEP(C0,C1,P0,P1,t,GK,GV,GL) do{ SBAR(); \
    const lds_cptr vp_=vp0+sl_prev; \
    VRD(0); SBAR(); float sacc=(P0[0]+P0[1]); \
    GAPA(C0=__builtin_amdgcn_mfma_f32_32x32x16_bf16(kf[0],qr[0],zc16,0,0,0), P0[2],P0[3],P0[4],P0[5],     pw0[0]=PKW(P0,0), pw0[1]=PKW(P0,2), pw0); \
    VRD(4); SBAR(); GAPA(C1=__builtin_amdgcn_mfma_f32_32x32x16_bf16(kf[1],qr[0],zc16,0,0,0), P0[6],P0[7],P0[8],P0[9],     pw0[2]=PKW(P0,4), pw0[3]=PKW(P0,6), pw0); \
    VRD(1); SBAR(); GAPA(C0=__builtin_amdgcn_mfma_f32_32x32x16_bf16(kf[2],qr[1],C0,0,0,0),   P0[10],P0[11],P0[12],P0[13], pw1[0]=PKW(P0,8), pw1[1]=PKW(P0,10), pw1); \
    VRD(5); SBAR(); GAPA(C1=__builtin_amdgcn_mfma_f32_32x32x16_bf16(kf[3],qr[1],C1,0,0,0),   P0[14],P0[15],P1[0],P1[1],   pw1[2]=PKW(P0,12),pw1[3]=PKW(P0,14), pw1); \
    VRD(2); SBAR(); GAPA(C0=__builtin_amdgcn_mfma_f32_32x32x16_bf16(kf[4],qr[2],C0,0,0,0),   P1[2],P1[3],P1[4],P1[5],     pw2[0]=PKW(P1,0), pw2[1]=PKW(P1,2), pw2); \
    VRD(6); SBAR(); GAPA(C1=__builtin_amdgcn_mfma_f32_32x32x16_bf16(kf[5],qr[2],C1,0,0,0),   P1[6],P1[7],P1[8],P1[9],     pw2[2]=PKW(P1,4), pw2[3]=PKW(P1,6), pw2); \
    VRD(3); SBAR(); GAPA(C0=__builtin_amdgcn_mfma_f32_32x32x16_bf16(kf[6],qr[3],C0,0,0,0),   P1[10],P1[11],P1[12],P1[13], pw3[0]=PKW(P1,8), pw3[1]=PKW(P1,10), pw3); \
    VRD(7); SBAR(); GAPA(C1=__builtin_amdgcn_mfma_f32_32x32x16_bf16(kf[7],qr[3],C1,0,0,0),   P1[14],P1[15],0.f,0.f,       pw3[2]=PKW(P1,12),pw3[3]=PKW(P1,14), pw3); \
    AUG(C0,C1,t); l_reg+=sacc; \
    if(GK){DMA_K((t)+3,sl_cur);} if(GV){DMA_V((t)+1,sl_next);} \
    CMASK(C0,C1,t); \
    { float a=MX3(C0[0],C0[1],C1[0]),b=MX3(C0[2],C0[3],C1[1]); a=MX3(a,C1[2],C1[3]); \
      _Pragma("unroll") for(int r=4;r<16;r+=4){a=MX3(a,C0[r],C0[r+1]);b=MX3(b,C0[r+2],C0[r+3]);a=MX3(a,C1[r],C1[r+1]);b=MX3(b,C1[r+2],C1[r+3]);} \
      float rm=__builtin_fmaxf(a,b); { auto rr=__builtin_amdgcn_permlane32_swap(__float_as_uint(rm),__float_as_uint(rm),false,false); rm=__builtin_fmaxf(__uint_as_float(rr[0]),__uint_as_float(rr[1])); } \
      resc=false; \
      if(__builtin_expect(__any(rm>(float)THRL),0)){ const float dl=__builtin_fmaxf(rm,0.f); mhat+=dl; \
        _Pragma("unroll") for(int r=0;r<16;++r){C0[r]-=dl;C1[r]-=dl;} \
        SETM(); \
        const float f=__builtin_amdgcn_exp2f(-dl); l_reg*=f; if(hi==0)wsf[r32]=f; resc=true; } } \
    SBAR(); \
    GAPB(o[0]=__builtin_amdgcn_mfma_f32_32x32x16_bf16(PAF(0),VFR(0),o[0],0,0,0), C0,0); \
    GAPB(o[1]=__builtin_amdgcn_mfma_f32_32x32x16_bf16(PAF(0),VFR(4),o[1],0,0,0), C0,4); \
    KRD(GL,0); GAPB(o[0]=__builtin_amdgcn_mfma_f32_32x32x16_bf16(PAF(1),VFR(1),o[0],0,0,0), C0,8); \
    KRD(GL,1); GAPB(o[1]=__builtin_amdgcn_mfma_f32_32x32x16_bf16(PAF(1),VFR(5),o[1],0,0,0), C0,12); \
    KRD(GL,2); GAPB(o[0]=__builtin_amdgcn_mfma_f32_32x32x16_bf16(PAF(2),VFR(2),o[0],0,0,0), C1,0); \
    KRD(GL,3); GAPB(o[1]=__builtin_amdgcn_mfma_f32_32x32x16_bf16(PAF(2),VFR(6),o[1],0,0,0), C1,4); \
    GAPB(o[0]=__builtin_amdgcn_mfma_f32_32x32x16_bf16(PAF(3),VFR(3),o[0],0,0,0), C1,8); \
    GAPB(o[1]=__builtin_amdgcn_mfma_f32_32x32x16_bf16(PAF(3),VFR(7),o[1],0,0,0), C1,12); \
    }while(0)
  int t=1;
  #undef CMASK
  #define CMASK(P0,P1,t) do{}while(0)
  for(;t+5<NT;t+=2){
    STEP(pB0,pB1,pA0,pA1,t,true,true,true);     WAIT_BAR(2); RESC(); ROT();
    STEP(pA0,pA1,pB0,pB1,t+1,true,true,true);   WAIT_BAR(2); RESC(); ROT();
  }
  #undef CMASK
  #define CMASK(P0,P1,t) do{int jb_=(t)-(NT-4); if(jb_>=0)cmask(P0,P1,jb_,qrel,hi);}while(0)
  #define ENDW(tt) do{ if((tt)+3<NT){WAIT_BAR(2);} else if((tt)+2<NT){WAIT_BAR(1);} else {WAIT_BAR(0);} }while(0)
  for(;t+1<NT;t+=2){
    STEP(pB0,pB1,pA0,pA1,t,(t+3<NT),(t+1<NT),(t+1<NT));       ENDW(t);   RESC(); ROT();
    STEP(pA0,pA1,pB0,pB1,t+1,(t+4<NT),(t+2<NT),(t+2<NT));     ENDW(t+1); RESC(); ROT();
  }
  STEP(pB0,pB1,pA0,pA1,NT-1,false,false,false); RESC();
  { float sacc=pB0[0]+pB0[1]; _Pragma("unroll") for(int r=2;r<16;++r)sacc+=pB0[r]; _Pragma("unroll") for(int r=0;r<16;++r)sacc+=pB1[r]; l_reg+=sacc;
    pw0=(u32x4){PKW(pB0,0),PKW(pB0,2),PKW(pB0,4),PKW(pB0,6)};pw1=(u32x4){PKW(pB0,8),PKW(pB0,10),PKW(pB0,12),PKW(pB0,14)};pw2=(u32x4){PKW(pB1,0),PKW(pB1,2),PKW(pB1,4),PKW(pB1,6)};pw3=(u32x4){PKW(pB1,8),PKW(pB1,10),PKW(pB1,12),PKW(pB1,14)};
    SBAR(); pv(o,vb0+sl_cur,PAF(0),PAF(1),PAF(2),PAF(3)); }
  #undef PKW
  #undef PAF
  #undef VFR
  #undef PIN
  #undef MX3
  #undef GAPA
  #undef GAPB
  #undef EX
  #undef VRD
  #undef KRD
  #undef STEP
  #undef ENDW
  {auto rr=__builtin_amdgcn_permlane32_swap(__float_as_uint(l_reg),__float_as_uint(l_reg),false,false);l_reg=__uint_as_float(rr[0])+__uint_as_float(rr[1]);}
  if(hi==0)wsf[32+r32]=l_reg;asm volatile("s_waitcnt lgkmcnt(0)":::"memory");
  float rli[16];
  #pragma unroll
  for(int r=0;r<16;++r)rli[r]=__builtin_amdgcn_rcpf(wsf[32+crow(r,hi)]);
  bf16*Ow=O+(rowbase+q0+wid*QBLK)*OPITCH+h*D;
  { bf16*stg=(bf16*)(shm+LDS_OST)+wid*2048;
    #pragma unroll
    for(int r=0;r<16;++r){const int orow=crow(r,hi);
      #pragma unroll
      for(int d0=0;d0<2;++d0)stg[orow*64+d0*32+r32]=__float2bfloat16(o[d0][r]*rli[r]);}
    asm volatile("s_waitcnt lgkmcnt(0)":::"memory");
    #pragma unroll
    for(int i=0;i<4;++i){const int row=i*8+(lane>>3),ch=lane&7; const u32x4 v=*(const u32x4*)(stg+row*64+ch*8); ATTN_STORE16(Ow+(long)row*OPITCH+ch*8,v);} }
  asm volatile("s_waitcnt lgkmcnt(0)\n\ts_barrier":::"memory");
  #undef DMA_K
  #undef DMA_V
  #undef CMASK
  #undef AUG
  #undef SETM
  #undef START
  #undef RESC
  #undef ROT
}
constexpr int ATTN_LDS_BYTES=LDS_BYTES;
#undef SBAR
#undef WAIT_BAR
}

namespace att {
template <bool CHECK> __device__ __forceinline__ void fox_unit_p(char* shm_g, LAS char* shm, int b, int h, int qb, const bf16_t* proj, const float* fb, float fbias_h, bf16_t* heads, unsigned* mism, bool do_scan) {
    const int tid = threadIdx.x, lane = tid & 63; const int wid = __builtin_amdgcn_readfirstlane(tid >> 6);
    if (do_scan) {
    LAS unsigned* biasw = (LAS unsigned*)(shm + attp::LDS_BIAS); LAS float* scan = (LAS float*)(shm + attp::LDS_SCAN);
    const int kend = (qb + 1) * 256;
    float v[4]; float s = 0.f;
#pragma unroll
    for (int i = 0; i < 4; ++i) { const int p = tid * 4 + i; float lf = 0.f; if (p < kend) lf = log_sigmoid_fast(fb[((size_t)b * SEQ + p) * 8 + h] + fbias_h); s += lf; v[i] = s; }
    float w = s;
#pragma unroll
    for (int o = 1; o < 64; o <<= 1) { const float t = __shfl_up(w, o); if (lane >= o) w += t; }
    if (lane == 63) scan[wid] = w;
    asm volatile("s_waitcnt lgkmcnt(0)\n\ts_barrier" ::: "memory");
    float off = w - s;
    for (int k = 0; k < 8; ++k) if (k < wid) off += scan[k];
#pragma unroll
    for (int i = 0; i < 4; ++i) { const float bv = -(v[i] + off) * LOG2E; const unsigned hb = cvt_pk_bf16(bv, 0.f) & 0xffffu; const unsigned lb = cvt_pk_bf16(bv - __uint_as_float(hb << 16), 0.f) & 0xffffu; biasw[tid * 4 + i] = hb | (lb << 16); }
    asm volatile("s_waitcnt vmcnt(0) lgkmcnt(0)\n\ts_barrier" ::: "memory");
    }
    attp::attn_unit<8, CHECK>(b, h, qb, (const attp::bf16*)(proj + 768), (const attp::bf16*)(proj + 1280), (const attp::bf16*)(proj + 1792), (attp::bf16*)(heads + 512), shm_g, mism);
    asm volatile("s_waitcnt vmcnt(0)" ::: "memory");
}
}
namespace mx {
using namespace mk;
constexpr size_t WS_QD = WS_XN, WS_KI = WS_XN + 16 * MiB, WS_DTV = 456 * MiB, WS_ACS = 457 * MiB, WS_KE = 458 * MiB, WS_DEC = 474 * MiB;
constexpr int XROW = 144;
__device__ __forceinline__ s16x4 tr_read(unsigned addr) { s16x4 r; asm volatile("ds_read_b64_tr_b16 %0, %1" : "=v"(r) : "v"(addr) : "memory"); return r; }
template <int OFF> __device__ __forceinline__ s16x4 tr_read_o(unsigned addr) { s16x4 r; asm volatile("ds_read_b64_tr_b16 %0, %1 offset:%2" : "=v"(r) : "v"(addr), "i"(OFF) : "memory"); return r; }
#define MX_LGKM0() do { asm volatile("s_waitcnt lgkmcnt(0)" ::: "memory"); __builtin_amdgcn_sched_barrier(0); } while (0)
#define MX_BAR() asm volatile("s_waitcnt vmcnt(0) lgkmcnt(0)\n\ts_barrier" ::: "memory")
#define MX_BAR_L() asm volatile("s_waitcnt lgkmcnt(0)\n\ts_barrier" ::: "memory")
__device__ __forceinline__ bf16x8 cat8(s16x4 lo, s16x4 hi) { return (bf16x8){lo[0], lo[1], lo[2], lo[3], hi[0], hi[1], hi[2], hi[3]}; }
__device__ __forceinline__ unsigned sw256(int row, int ch) { return (unsigned)(row * 256 + ((ch ^ (row & 15)) << 4)); }

__device__ __forceinline__ void prep_conv(const bf16_t* PROJ, bf16_t* CONV, const float* conv_w, const float* conv_b, int vcu, int G, int tid) {
    for (int item = vcu * NTHR + tid; item < (T / 8) * 192; item += G * NTHR) {
        const int cg = item % 192, rb = item / 192, ch0 = cg * 8, row0 = rb * 8, t0 = row0 & (SEQ - 1);
        float w[4][8], bs[8], xw[3][8];
#pragma unroll
        for (int j = 0; j < 4; ++j) { const f32x4 a = *(const f32x4*)(conv_w + j * 1536 + ch0), b = *(const f32x4*)(conv_w + j * 1536 + ch0 + 4);
#pragma unroll
            for (int i = 0; i < 4; ++i) { w[j][i] = a[i]; w[j][4 + i] = b[i]; } }
        { const f32x4 a = *(const f32x4*)(conv_b + ch0), b = *(const f32x4*)(conv_b + ch0 + 4);
#pragma unroll
          for (int i = 0; i < 4; ++i) { bs[i] = a[i]; bs[4 + i] = b[i]; } }
#pragma unroll
        for (int j = 0; j < 3; ++j) { const int tt = t0 - 3 + j;
            u32x4 v = {0u, 0u, 0u, 0u}; if (tt >= 0) v = *(const u32x4*)(PROJ + (size_t)(row0 - 3 + j) * NO_IN + 1024 + ch0);
#pragma unroll
            for (int i = 0; i < 4; ++i) { xw[j][2 * i] = __uint_as_float(v[i] << 16); xw[j][2 * i + 1] = __uint_as_float(v[i] & 0xffff0000u); } }
        u32x4 vr[8];
#pragma unroll
        for (int r = 0; r < 8; ++r) vr[r] = __builtin_nontemporal_load((const u32x4*)(PROJ + (size_t)(row0 + r) * NO_IN + 1024 + ch0));
#pragma unroll
        for (int r = 0; r < 8; ++r) {
            const u32x4 v = vr[r];
            float x3[8], o[8];
#pragma unroll
            for (int i = 0; i < 4; ++i) { x3[2 * i] = __uint_as_float(v[i] << 16); x3[2 * i + 1] = __uint_as_float(v[i] & 0xffff0000u); }
#pragma unroll
            for (int i = 0; i < 8; ++i) { const float a = bs[i] + w[0][i] * xw[0][i] + w[1][i] * xw[1][i] + w[2][i] * xw[2][i] + w[3][i] * x3[i]; o[i] = siluf(a);
                xw[0][i] = xw[1][i]; xw[1][i] = xw[2][i]; xw[2][i] = x3[i]; }
            u32x4 ov; ov.x = cvt_pk_bf16(o[0], o[1]); ov.y = cvt_pk_bf16(o[2], o[3]); ov.z = cvt_pk_bf16(o[4], o[5]); ov.w = cvt_pk_bf16(o[6], o[7]);
            *(u32x4*)(CONV + (size_t)(row0 + r) * 1536 + ch0) = ov;
        }
    }
}
__device__ __forceinline__ void prep_ssd(const float* DTG, float* DTV, float* ACS, const float* dt_bias, const float* a_log, int vcu, int G, int lane, int wave) {
    const int gw = vcu * NWAVES + wave, ngw = G * NWAVES;
    for (int item = gw; item < NBATCH * 32 * 16; item += ngw) {
        const int h = item & 15, c = (item >> 4) & 31, b = item >> 9; const size_t r0 = (size_t)b * SEQ + c * 64 + lane;
        const float a = -expf(a_log[h]), db = dt_bias[h];
        const float d0 = softplusf(DTG[r0 * 32 + h] + db);
        float w = a * d0;
#pragma unroll
        for (int o = 1; o < 64; o <<= 1) { const float t = __shfl_up(w, o); if (lane >= o) w += t; }
        ACS[r0 * 16 + h] = w; DTV[r0 * 16 + h] = d0;
    }
}
__device__ __forceinline__ void prep_gla(const bf16_t* PROJ, const float* DTG, bf16_t* QD, bf16_t* KI, bf16_t* KE, float* DEC, const float* gk_w, const float* gk_b, int vcu, int G, int tid, int lane, int wave, LAS char* shm) {
    {
        LAS float* gl = (LAS float*)(shm);
        LAS float* tot = (LAS float*)(shm + 8192);
        const int half = wave >> 2, rq = wave & 3, t256 = tid & 255;
        for (int pair = vcu; pair < NBATCH * 32 * 4 / 2; pair += G) {
            const int item = pair * 2 + half; const int h = item & 3, c = (item >> 2) & 31, b = item >> 7; const size_t r0 = (size_t)b * SEQ + c * 64;
            unsigned short qv[16][2], kv[16][2];
#pragma unroll
            for (int r = 0; r < 16; ++r) { const bf16_t* pr = PROJ + (r0 + rq * 16 + r) * NO_IN;
                qv[r][0] = pr[2560 + h * 128 + lane]; qv[r][1] = pr[2560 + h * 128 + 64 + lane]; kv[r][0] = pr[3072 + h * 128 + lane]; kv[r][1] = pr[3072 + h * 128 + 64 + lane]; }
            float w0[16], w1[16];
#pragma unroll
            for (int j = 0; j < 16; ++j) { w0[j] = gk_w[j * 512 + h * 128 + lane]; w1[j] = gk_w[j * 512 + h * 128 + 64 + lane]; }
            const float b0 = gk_b[h * 128 + lane], b1 = gk_b[h * 128 + 64 + lane];
            { const int rr = t256 >> 2, q4 = t256 & 3; *(LAS f32x4*)(gl + half * 1024 + rr * 16 + q4 * 4) = *(const f32x4*)(DTG + (r0 + rr) * 32 + 16 + q4 * 4); }
            asm volatile("s_waitcnt vmcnt(0) lgkmcnt(0)\n\ts_barrier" ::: "memory");
            float c0[16], c1[16]; float run0 = 0.f, run1 = 0.f;
#pragma unroll
            for (int r = 0; r < 16; ++r) {
                const LAS f32x4* gp = (const LAS f32x4*)(gl + half * 1024 + (rq * 16 + r) * 16); float a0 = b0, a1 = b1;
#pragma unroll
                for (int q = 0; q < 4; ++q) { const f32x4 g = gp[q];
#pragma unroll
                    for (int i = 0; i < 4; ++i) { a0 += g[i] * w0[4 * q + i]; a1 += g[i] * w1[4 * q + i]; } }
                run0 += log_sigmoid_fast(a0) * (1.f / 16.f); run1 += log_sigmoid_fast(a1) * (1.f / 16.f); c0[r] = run0; c1[r] = run1;
            }
            tot[(half * 4 + rq) * 128 + lane] = run0; tot[(half * 4 + rq) * 128 + 64 + lane] = run1;
            asm volatile("s_waitcnt lgkmcnt(0)\n\ts_barrier" ::: "memory");
            float pre0 = 0.f, pre1 = 0.f, last0 = 0.f, last1 = 0.f;
#pragma unroll
            for (int q = 0; q < 4; ++q) { const float t0 = tot[(half * 4 + q) * 128 + lane], t1 = tot[(half * 4 + q) * 128 + 64 + lane]; if (q < rq) { pre0 += t0; pre1 += t1; } last0 += t0; last1 += t1; }
            const float scale = 0.08838834764831845f;
#pragma unroll
            for (int r = 0; r < 16; ++r) {
                const float g0 = pre0 + c0[r], g1 = pre1 + c1[r];
                const float q0 = bf2f(qv[r][0]), q1 = bf2f(qv[r][1]), k0 = bf2f(kv[r][0]), k1 = bf2f(kv[r][1]);
                const size_t o = (r0 + rq * 16 + r) * 512 + h * 128 + lane;
                QD[o] = (bf16_t)(cvt_pk_bf16(q0 * scale * __expf(g0), 0.f) & 0xffffu); QD[o + 64] = (bf16_t)(cvt_pk_bf16(q1 * scale * __expf(g1), 0.f) & 0xffffu);
                KI[o] = (bf16_t)(cvt_pk_bf16(k0 * __expf(-g0), 0.f) & 0xffffu); KI[o + 64] = (bf16_t)(cvt_pk_bf16(k1 * __expf(-g1), 0.f) & 0xffffu);
            }
            if (rq == 0) { DEC[((size_t)b * 32 + c) * 512 + h * 128 + lane] = __expf(last0); DEC[((size_t)b * 32 + c) * 512 + h * 128 + 64 + lane] = __expf(last1); }
            asm volatile("s_waitcnt lgkmcnt(0)\n\ts_barrier" ::: "memory");
        }
    }
}

constexpr int S_C = 0, S_B = 32768, S_X = 65536, S_XW = S_X + 128 * XROW, S_PREV = S_XW + 128 * XROW, S_ACS = S_PREV + 16384, S_DT = S_ACS + 512, S_YST = S_DT + 512, S_END = S_YST + 8 * 2304;
static_assert(S_END <= RING_BYTES, "SSD LDS");
__device__ __forceinline__ void ssd_unit(LAS char* shm, int b, int h, const bf16_t* CONV, const float* ACS, const float* DTV, float dsk, bf16_t* MIX) {
    const int tid = threadIdx.x, lane = tid & 63, fr = lane & 15, fq = lane >> 4; const int w = __builtin_amdgcn_readfirstlane(tid >> 6);
    const int g = h >> 3, row = tid >> 2, qd = tid & 3, l0 = 16 * w;
    const unsigned lds0 = (unsigned)(uintptr_t)shm;
    LAS float* acsl = (LAS float*)(shm + S_ACS); LAS float* dtl = (LAS float*)(shm + S_DT);
    f32x4 st[4];
#pragma unroll
    for (int i = 0; i < 4; ++i) st[i] = (f32x4){0.f, 0.f, 0.f, 0.f};
    u32x4 rc[4], rb[4], rx[2]; float racs, rdt, rend;
    const size_t seq0 = (size_t)b * SEQ;
#define SSD_LOAD(c) do { const size_t gr = seq0 + (size_t)(c) * 128 + row; const bf16_t* p = CONV + gr * 1536; \
        _Pragma("unroll") for (int i = 0; i < 4; ++i) { rc[i] = *(const u32x4*)(p + 1280 + g * 128 + qd * 32 + 8 * i); rb[i] = *(const u32x4*)(p + 1024 + g * 128 + qd * 32 + 8 * i); } \
        _Pragma("unroll") for (int i = 0; i < 2; ++i) rx[i] = *(const u32x4*)(p + h * 64 + qd * 16 + 8 * i); \
        racs = ACS[gr * 16 + h]; rdt = DTV[gr * 16 + h]; rend = ACS[(seq0 + (size_t)(c) * 128 + 127) * 16 + h]; } while (0)
#ifdef SSD_DUMMY
    SSD_LOAD(0);
    for (int c = 0; c < 16; ++c) {
#pragma unroll
        for (int i = 0; i < 4; ++i) { *(LAS u32x4*)(shm + S_C + sw256(row, qd * 4 + i)) = rc[i]; *(LAS u32x4*)(shm + S_B + sw256(row, qd * 4 + i)) = rb[i]; }
        const float wr = rdt * __expf(rend - racs);
#pragma unroll
        for (int i = 0; i < 2; ++i) { *(LAS u32x4*)(shm + S_X + row * XROW + qd * 32 + 16 * i) = rx[i];
            u32x4 o;
#pragma unroll
            for (int k = 0; k < 4; ++k) o[k] = cvt_pk_bf16(__uint_as_float(rx[i][k] << 16) * wr, __uint_as_float(rx[i][k] & 0xffff0000u) * wr);
            *(LAS u32x4*)(shm + S_XW + row * XROW + qd * 32 + 16 * i) = o; }
        if (qd == 0) { acsl[row] = racs; dtl[row] = rdt; }
        MX_BAR_L();
        if (c + 1 < 16) SSD_LOAD(c + 1);
        MX_BAR_L();
    }
#endif
#ifndef SSD_NOPREF
    SSD_LOAD(0);
#endif
    const unsigned xtr = lds0 + (unsigned)(((lane & 15) >> 2) * XROW + (lane & 3) * 8);
    for (int c = 0; c < 16; ++c) {
#ifdef SSD_NOPREF
        SSD_LOAD(c);
#endif
#ifdef SSD_REP_WR
        for (int rep_ = 0; rep_ < 2; ++rep_)
#endif
        {
#pragma unroll
            for (int i = 0; i < 4; ++i) { *(LAS u32x4*)(shm + S_C + sw256(row, qd * 4 + i)) = rc[i]; *(LAS u32x4*)(shm + S_B + sw256(row, qd * 4 + i)) = rb[i]; }
            const float wr = rdt * __expf(rend - racs);
#pragma unroll
            for (int i = 0; i < 2; ++i) { *(LAS u32x4*)(shm + S_X + row * XROW + qd * 32 + 16 * i) = rx[i];
                u32x4 o;
#pragma unroll
                for (int k = 0; k < 4; ++k) o[k] = cvt_pk_bf16(__uint_as_float(rx[i][k] << 16) * wr, __uint_as_float(rx[i][k] & 0xffff0000u) * wr);
                *(LAS u32x4*)(shm + S_XW + row * XROW + qd * 32 + 16 * i) = o; }
            if (qd == 0) { acsl[row] = racs; dtl[row] = rdt; }
#pragma unroll
            for (int pt = 0; pt < 4; ++pt) { u32x2 v; v.x = cvt_pk_bf16(st[pt][0], st[pt][1]); v.y = cvt_pk_bf16(st[pt][2], st[pt][3]);
                const int p = 16 * pt + fr; *(LAS u32x2*)(shm + S_PREV + sw256(p, 2 * w + (fq >> 1)) + (fq & 1) * 8) = v; }
        }
        MX_BAR_L();
#ifndef SSD_NOPREF
        if (c + 1 < 16) SSD_LOAD(c + 1);
#endif
        bf16x8 cf[4];
#pragma unroll
        for (int ks = 0; ks < 4; ++ks) cf[ks] = *(const LAS bf16x8*)(shm + S_C + sw256(l0 + fr, 4 * ks + fq));
        f32x4 yd[4], yo[4];
#pragma unroll
        for (int i = 0; i < 4; ++i) { yd[i] = (f32x4){0.f, 0.f, 0.f, 0.f}; yo[i] = (f32x4){0.f, 0.f, 0.f, 0.f}; }
        const float acs_l = acsl[l0 + fr]; const int lcol = l0 + fr;
        const int nsb = (w >> 1) + 1;
#ifdef SSD_REP_SB
        for (int rep_ = 0; rep_ < 2; ++rep_) {
#pragma unroll
        for (int i = 0; i < 4; ++i) yd[i] = (f32x4){0.f, 0.f, 0.f, 0.f};
#endif
        for (int sb = 0; sb < nsb; ++sb) {
            const int s0 = 32 * sb; const bool two = (2 * sb + 1) <= w;
            s16x4 lo[4], hi[4];
#pragma unroll
            for (int pt = 0; pt < 4; ++pt) { lo[pt] = tr_read(xtr + S_X + (unsigned)((s0 + 4 * fq) * XROW + pt * 32)); hi[pt] = tr_read(xtr + S_X + (unsigned)((s0 + 16 + 4 * fq) * XROW + pt * 32)); }
            f32x4 a0 = {0.f, 0.f, 0.f, 0.f}, a1 = {0.f, 0.f, 0.f, 0.f};
#pragma unroll
            for (int ks = 0; ks < 4; ++ks) { const bf16x8 bf = *(const LAS bf16x8*)(shm + S_B + sw256(s0 + fr, 4 * ks + fq)); a0 = __builtin_amdgcn_mfma_f32_16x16x32_bf16(bf, cf[ks], a0, 0, 0, 0); }
            if (two) {
#pragma unroll
                for (int ks = 0; ks < 4; ++ks) { const bf16x8 bf = *(const LAS bf16x8*)(shm + S_B + sw256(s0 + 16 + fr, 4 * ks + fq)); a1 = __builtin_amdgcn_mfma_f32_16x16x32_bf16(bf, cf[ks], a1, 0, 0, 0); }
            }
            const f32x4 as0 = *(const LAS f32x4*)(acsl + s0 + 4 * fq), as1 = *(const LAS f32x4*)(acsl + s0 + 16 + 4 * fq);
            const f32x4 dq0 = *(const LAS f32x4*)(dtl + s0 + 4 * fq), dq1 = *(const LAS f32x4*)(dtl + s0 + 16 + 4 * fq);
            float g0[4], g1[4];
#pragma unroll
            for (int i = 0; i < 4; ++i) { const int sa = s0 + 4 * fq + i, sb2 = sa + 16;
                g0[i] = (sa <= lcol) ? a0[i] * __expf(fminf(acs_l - as0[i], 0.f)) * dq0[i] : 0.f;
                g1[i] = (two && sb2 <= lcol) ? a1[i] * __expf(fminf(acs_l - as1[i], 0.f)) * dq1[i] : 0.f; }
            u32x4 ap; ap.x = cvt_pk_bf16(g0[0], g0[1]); ap.y = cvt_pk_bf16(g0[2], g0[3]); ap.z = cvt_pk_bf16(g1[0], g1[1]); ap.w = cvt_pk_bf16(g1[2], g1[3]);
            const bf16x8 af = __builtin_bit_cast(bf16x8, ap);
            MX_LGKM0();
#pragma unroll
            for (int pt = 0; pt < 4; ++pt) yd[pt] = __builtin_amdgcn_mfma_f32_16x16x32_bf16(af, cat8(lo[pt], hi[pt]), yd[pt], 0, 0, 0);
        }
#ifdef SSD_REP_SB
        }
#endif
#ifdef SSD_REP_YO
        for (int rep_ = 0; rep_ < 2; ++rep_) {
#pragma unroll
        for (int i = 0; i < 4; ++i) yo[i] = (f32x4){0.f, 0.f, 0.f, 0.f};
#endif
#pragma unroll
        for (int pt = 0; pt < 4; ++pt)
#pragma unroll
            for (int ks = 0; ks < 4; ++ks) { const bf16x8 pf = *(const LAS bf16x8*)(shm + S_PREV + sw256(16 * pt + fr, 4 * ks + fq)); yo[pt] = __builtin_amdgcn_mfma_f32_16x16x32_bf16(cf[ks], pf, yo[pt], 0, 0, 0); }
#ifdef SSD_REP_YO
        }
#endif
#ifdef SSD_REP_CS
        for (int rep_ = 0; rep_ < 2; ++rep_)
#endif
        {
            const f32x4 al = *(const LAS f32x4*)(acsl + l0 + 4 * fq);
            float ea[4];
#pragma unroll
            for (int i = 0; i < 4; ++i) ea[i] = __expf(al[i]);
            s16x4 xs[4];
#pragma unroll
            for (int pt = 0; pt < 4; ++pt) xs[pt] = tr_read(xtr + S_X + (unsigned)((l0 + 4 * fq) * XROW + pt * 32));
            MX_LGKM0();
            LAS bf16_t* yst = (LAS bf16_t*)(shm + S_YST + w * 2304);
#pragma unroll
            for (int pt = 0; pt < 4; ++pt)
#pragma unroll
                for (int i = 0; i < 4; ++i) { const float y = yd[pt][i] + ea[i] * yo[pt][i] + dsk * bf2f((unsigned short)xs[pt][i]);
                    yst[(4 * fq + i) * 72 + pt * 16 + fr] = (bf16_t)(cvt_pk_bf16(y, 0.f) & 0xffffu); }
            asm volatile("s_waitcnt lgkmcnt(0)" ::: "memory");
            bf16_t* yp = MIX + (seq0 + (size_t)c * 128 + l0) * 2048 + h * 64;
#pragma unroll
            for (int j = 0; j < 2; ++j) { const int rr = (lane >> 3) + 8 * j, ch = lane & 7; const u32x4 v = *(const LAS u32x4*)(yst + rr * 72 + ch * 8); *(u32x4*)(yp + (size_t)rr * 2048 + ch * 8) = v; }
        }
#ifdef SSD_REP_ST
        f32x4 stsave[4];
#pragma unroll
        for (int i = 0; i < 4; ++i) stsave[i] = st[i];
        for (int rep_ = 0; rep_ < 2; ++rep_) {
#pragma unroll
        for (int i = 0; i < 4; ++i) st[i] = stsave[i];
#endif
        {
            const float cd = __expf(acsl[127]);
#pragma unroll
            for (int pt = 0; pt < 4; ++pt) st[pt] = st[pt] * cd;
#pragma unroll
            for (int ks = 0; ks < 4; ++ks) {
                const int s0 = 32 * ks, q = (lane & 15) >> 2, p = lane & 3;
                const int r1 = s0 + 8 * fq + q, r2 = r1 + 4;
                const s16x4 alo = tr_read(lds0 + S_B + sw256(r1, 2 * w + (p >> 1)) + (p & 1) * 8), ahi = tr_read(lds0 + S_B + sw256(r2, 2 * w + (p >> 1)) + (p & 1) * 8);
                s16x4 lo[4], hi[4];
#pragma unroll
                for (int pt = 0; pt < 4; ++pt) { lo[pt] = tr_read(xtr + S_XW + (unsigned)((s0 + 8 * fq) * XROW + pt * 32)); hi[pt] = tr_read(xtr + S_XW + (unsigned)((s0 + 8 * fq + 4) * XROW + pt * 32)); }
                MX_LGKM0();
                const bf16x8 af = cat8(alo, ahi);
#pragma unroll
                for (int pt = 0; pt < 4; ++pt) st[pt] = __builtin_amdgcn_mfma_f32_16x16x32_bf16(af, cat8(lo[pt], hi[pt]), st[pt], 0, 0, 0);
            }
        }
#ifdef SSD_REP_ST
        }
#endif
        MX_BAR_L();
    }
    asm volatile("s_waitcnt vmcnt(0)" ::: "memory");
#undef SSD_LOAD
}

constexpr int S2_C = 0, S2_B = 16384, S2_X = 32768, S2_XW = S2_X + 64 * XROW, S2_ACS = S2_XW + 64 * XROW, S2_DT = S2_ACS + 256, S2_BUF = 53248, S2_PREV = 2 * S2_BUF, S2_END = S2_PREV + 2 * 16384;
static_assert(S2_DT + 256 <= S2_BUF && S2_END <= RING_BYTES, "SSD64 LDS");
__device__ __forceinline__ void ssd_unit64(LAS char* shm, int b, int h, const bf16_t* CONV, const float* ACS, const float* DTV, float dsk, bf16_t* MIX) {
    const int tid = threadIdx.x, lane = tid & 63, fr = lane & 15, fq = lane >> 4; const int w = __builtin_amdgcn_readfirstlane(tid >> 6);
    const int g = h >> 3, row = tid >> 3, ec = tid & 7, lt = w >> 1, l0 = 16 * lt, pt0 = 2 * (w & 1);
    const unsigned lds0 = (unsigned)(uintptr_t)shm;
    f32x4 st[4];
#pragma unroll
    for (int i = 0; i < 4; ++i) st[i] = (f32x4){0.f, 0.f, 0.f, 0.f};
    u32x4 rc[2], rb[2], rx; float racs, rdt, rend;
    const size_t seq0 = (size_t)b * SEQ;
#define S2_LOAD(c) do { const size_t gr = seq0 + (size_t)(c) * 64 + row; const bf16_t* p = CONV + gr * 1536; \
        _Pragma("unroll") for (int i = 0; i < 2; ++i) { rc[i] = *(const u32x4*)(p + 1280 + g * 128 + ec * 16 + 8 * i); rb[i] = *(const u32x4*)(p + 1024 + g * 128 + ec * 16 + 8 * i); } \
        rx = *(const u32x4*)(p + h * 64 + ec * 8); \
        racs = ACS[gr * 16 + h]; rdt = DTV[gr * 16 + h]; rend = ACS[(seq0 + (size_t)(c) * 64 + 63) * 16 + h]; } while (0)
#define S2_WRITE(pb) do { LAS char* gb_ = shm + (pb) * S2_BUF; \
        _Pragma("unroll") for (int i = 0; i < 2; ++i) { *(LAS u32x4*)(gb_ + S2_C + sw256(row, ec * 2 + i)) = rc[i]; *(LAS u32x4*)(gb_ + S2_B + sw256(row, ec * 2 + i)) = rb[i]; } \
        *(LAS u32x4*)(gb_ + S2_X + row * XROW + ec * 16) = rx; \
        { const float wr_ = rdt * __expf(rend - racs); u32x4 o_; \
          _Pragma("unroll") for (int k = 0; k < 4; ++k) o_[k] = cvt_pk_bf16(__uint_as_float(rx[k] << 16) * wr_, __uint_as_float(rx[k] & 0xffff0000u) * wr_); \
          *(LAS u32x4*)(gb_ + S2_XW + row * XROW + ec * 16) = o_; } \
        if (ec == 0) { ((LAS float*)(gb_ + S2_ACS))[row] = racs; ((LAS float*)(gb_ + S2_DT))[row] = rdt; } \
        _Pragma("unroll") for (int pt = 0; pt < 4; ++pt) { u32x2 v; v.x = cvt_pk_bf16(st[pt][0], st[pt][1]); v.y = cvt_pk_bf16(st[pt][2], st[pt][3]); \
            const int p_ = 16 * pt + fr; *(LAS u32x2*)(shm + S2_PREV + (pb) * 16384 + sw256(p_, 2 * w + (fq >> 1)) + (fq & 1) * 8) = v; } } while (0)
    S2_LOAD(0);
    S2_WRITE(0);
    MX_BAR_L();
    unsigned swz[4];
#pragma unroll
    for (int ks = 0; ks < 4; ++ks) swz[ks] = (unsigned)(fr * 256 + (((4 * ks + fq) ^ fr) << 4));
    const int q_ = (lane & 15) >> 2, p_ = lane & 3;
    const unsigned xq4 = (unsigned)((4 * fq + q_) * XROW + p_ * 8), xq8 = (unsigned)((8 * fq + q_) * XROW + p_ * 8);
    const int ra = 8 * fq + q_, rb2 = ra + 4;
    const unsigned bt1 = (unsigned)(ra * 256 + (((2 * w + (p_ >> 1)) ^ (ra & 15)) << 4) + (p_ & 1) * 8), bt2 = (unsigned)(rb2 * 256 + (((2 * w + (p_ >> 1)) ^ (rb2 & 15)) << 4) + (p_ & 1) * 8);
    for (int c = 0; c < 32; ++c) {
        const int pb = c & 1; LAS char* gb = shm + pb * S2_BUF; const unsigned gba = lds0 + (unsigned)(pb * S2_BUF);
        const LAS float* acsl = (const LAS float*)(gb + S2_ACS); const LAS float* dtl = (const LAS float*)(gb + S2_DT);
        if (c + 1 < 32) S2_LOAD(c + 1);
        const LAS char* cbp[4]; const LAS char* pvp[4];
#pragma unroll
        for (int ks = 0; ks < 4; ++ks) { cbp[ks] = gb + swz[ks]; pvp[ks] = shm + S2_PREV + pb * 16384 + pt0 * 4096 + swz[ks]; }
        const unsigned xa4 = gba + xq4 + (unsigned)(pt0 * 32), xa8 = gba + xq8, ba1 = gba + bt1, ba2 = gba + bt2;
        bf16x8 cf[4];
#pragma unroll
        for (int ks = 0; ks < 4; ++ks) cf[ks] = *(const LAS bf16x8*)(cbp[ks] + S2_C + l0 * 256);
        f32x4 yd[2], yo[2];
#pragma unroll
        for (int i = 0; i < 2; ++i) { yd[i] = (f32x4){0.f, 0.f, 0.f, 0.f}; yo[i] = (f32x4){0.f, 0.f, 0.f, 0.f}; }
        const float acs_l = acsl[l0 + fr]; const int lcol = l0 + fr;
#pragma unroll
        for (int sb = 0; sb < 2; ++sb) if (2 * sb <= lt) {
            constexpr int dummy = 0; (void)dummy;
            const int s0 = 32 * sb; const bool two = (2 * sb + 1) <= lt;
            s16x4 lo[2], hi[2];
            if (sb == 0) { lo[0] = tr_read_o<S2_X>(xa4); lo[1] = tr_read_o<S2_X + 32>(xa4); hi[0] = tr_read_o<S2_X + 16 * XROW>(xa4); hi[1] = tr_read_o<S2_X + 16 * XROW + 32>(xa4); }
            else         { lo[0] = tr_read_o<S2_X + 32 * XROW>(xa4); lo[1] = tr_read_o<S2_X + 32 * XROW + 32>(xa4); hi[0] = tr_read_o<S2_X + 48 * XROW>(xa4); hi[1] = tr_read_o<S2_X + 48 * XROW + 32>(xa4); }
            f32x4 a0 = {0.f, 0.f, 0.f, 0.f}, a1 = {0.f, 0.f, 0.f, 0.f};
#pragma unroll
            for (int ks = 0; ks < 4; ++ks) { const bf16x8 bf = *(const LAS bf16x8*)(cbp[ks] + S2_B + s0 * 256); a0 = __builtin_amdgcn_mfma_f32_16x16x32_bf16(bf, cf[ks], a0, 0, 0, 0); }
            if (two) {
#pragma unroll
                for (int ks = 0; ks < 4; ++ks) { const bf16x8 bf = *(const LAS bf16x8*)(cbp[ks] + S2_B + (s0 + 16) * 256); a1 = __builtin_amdgcn_mfma_f32_16x16x32_bf16(bf, cf[ks], a1, 0, 0, 0); }
            }
            const f32x4 as0 = *(const LAS f32x4*)(acsl + s0 + 4 * fq), as1 = *(const LAS f32x4*)(acsl + s0 + 16 + 4 * fq);
            const f32x4 dq0 = *(const LAS f32x4*)(dtl + s0 + 4 * fq), dq1 = *(const LAS f32x4*)(dtl + s0 + 16 + 4 * fq);
            float g0[4], g1[4];
#pragma unroll
            for (int i = 0; i < 4; ++i) { g0[i] = a0[i] * __expf(acs_l - as0[i]) * dq0[i]; g1[i] = a1[i] * __expf(acs_l - as1[i]) * dq1[i]; }
            if (2 * sb == lt) {
#pragma unroll
                for (int i = 0; i < 4; ++i) { if (s0 + 4 * fq + i > lcol) g0[i] = 0.f; }
            }
            if (!two) {
#pragma unroll
                for (int i = 0; i < 4; ++i) g1[i] = 0.f;
            } else if (2 * sb + 1 == lt) {
#pragma unroll
                for (int i = 0; i < 4; ++i) { if (s0 + 16 + 4 * fq + i > lcol) g1[i] = 0.f; }
            }
            u32x4 ap; ap.x = cvt_pk_bf16(g0[0], g0[1]); ap.y = cvt_pk_bf16(g0[2], g0[3]); ap.z = cvt_pk_bf16(g1[0], g1[1]); ap.w = cvt_pk_bf16(g1[2], g1[3]);
            const bf16x8 af = __builtin_bit_cast(bf16x8, ap);
            MX_LGKM0();
#pragma unroll
            for (int vi = 0; vi < 2; ++vi) yd[vi] = __builtin_amdgcn_mfma_f32_16x16x32_bf16(af, cat8(lo[vi], hi[vi]), yd[vi], 0, 0, 0);
        }
#pragma unroll
        for (int vi = 0; vi < 2; ++vi)
#pragma unroll
            for (int ks = 0; ks < 4; ++ks) { const bf16x8 pf = *(const LAS bf16x8*)(pvp[ks] + vi * 4096); yo[vi] = __builtin_amdgcn_mfma_f32_16x16x32_bf16(cf[ks], pf, yo[vi], 0, 0, 0); }
        {
            const f32x4 al = *(const LAS f32x4*)(acsl + l0 + 4 * fq);
            float ea[4];
#pragma unroll
            for (int i = 0; i < 4; ++i) ea[i] = __expf(al[i]);
            const unsigned xl = xa4 + (unsigned)(l0 * XROW);
            s16x4 xs[2]; xs[0] = tr_read_o<S2_X>(xl); xs[1] = tr_read_o<S2_X + 32>(xl);
            MX_LGKM0();
            bf16_t* yp = MIX + (seq0 + (size_t)c * 64 + l0 + 4 * fq) * 2048 + h * 64 + pt0 * 16 + fr;
#pragma unroll
            for (int vi = 0; vi < 2; ++vi)
#pragma unroll
                for (int i = 0; i < 4; ++i) { const float y = yd[vi][i] + ea[i] * yo[vi][i] + dsk * bf2f((unsigned short)xs[vi][i]);
                    yp[(size_t)i * 2048 + vi * 16] = (bf16_t)(cvt_pk_bf16(y, 0.f) & 0xffffu); }
        }
        {
            const float cd = __expf(acsl[63]);
#pragma unroll
            for (int pt = 0; pt < 4; ++pt) st[pt] = st[pt] * cd;
            {   s16x4 lo[4], hi[4];
                const s16x4 alo = tr_read_o<S2_B>(ba1), ahi = tr_read_o<S2_B>(ba2);
                lo[0] = tr_read_o<S2_XW>(xa8); lo[1] = tr_read_o<S2_XW + 32>(xa8); lo[2] = tr_read_o<S2_XW + 64>(xa8); lo[3] = tr_read_o<S2_XW + 96>(xa8);
                hi[0] = tr_read_o<S2_XW + 4 * XROW>(xa8); hi[1] = tr_read_o<S2_XW + 4 * XROW + 32>(xa8); hi[2] = tr_read_o<S2_XW + 4 * XROW + 64>(xa8); hi[3] = tr_read_o<S2_XW + 4 * XROW + 96>(xa8);
                MX_LGKM0();
                const bf16x8 af = cat8(alo, ahi);
#pragma unroll
                for (int pt = 0; pt < 4; ++pt) st[pt] = __builtin_amdgcn_mfma_f32_16x16x32_bf16(af, cat8(lo[pt], hi[pt]), st[pt], 0, 0, 0); }
            {   s16x4 lo[4], hi[4];
                const s16x4 alo = tr_read_o<S2_B + 32 * 256>(ba1), ahi = tr_read_o<S2_B + 32 * 256>(ba2);
                lo[0] = tr_read_o<S2_XW + 32 * XROW>(xa8); lo[1] = tr_read_o<S2_XW + 32 * XROW + 32>(xa8); lo[2] = tr_read_o<S2_XW + 32 * XROW + 64>(xa8); lo[3] = tr_read_o<S2_XW + 32 * XROW + 96>(xa8);
                hi[0] = tr_read_o<S2_XW + 36 * XROW>(xa8); hi[1] = tr_read_o<S2_XW + 36 * XROW + 32>(xa8); hi[2] = tr_read_o<S2_XW + 36 * XROW + 64>(xa8); hi[3] = tr_read_o<S2_XW + 36 * XROW + 96>(xa8);
                MX_LGKM0();
                const bf16x8 af = cat8(alo, ahi);
#pragma unroll
                for (int pt = 0; pt < 4; ++pt) st[pt] = __builtin_amdgcn_mfma_f32_16x16x32_bf16(af, cat8(lo[pt], hi[pt]), st[pt], 0, 0, 0); }
        }
        if (c + 1 < 32) S2_WRITE(pb ^ 1);
        MX_BAR_L();
    }
    asm volatile("s_waitcnt vmcnt(0)" ::: "memory");
#undef S2_LOAD
#undef S2_WRITE
}

constexpr int G_QD = 0, G_KI = 16384, G_V = 32768, G_DEC = G_V + 64 * XROW, G_BUF = 45056, G_SP = 2 * G_BUF, G_END = G_SP + 2 * 16384;
static_assert(G_DEC + 512 <= G_BUF && G_END <= RING_BYTES, "GLA LDS");
template <bool CHECK> __device__ __forceinline__ void gla_unit(LAS char* shm, int b, int h, int vs, const bf16_t* PROJ, const bf16_t* QD, const bf16_t* KI, const float* DEC, bf16_t* MIX, unsigned* mismatch) {
    const int tid = threadIdx.x, lane = tid & 63, fr = lane & 15, fq = lane >> 4; const int w = __builtin_amdgcn_readfirstlane(tid >> 6);
    const int row = tid >> 3, ec = tid & 7, lt = w >> 1, l0 = 16 * lt, vt0 = 2 * (w & 1);
    const unsigned lds0 = (unsigned)(uintptr_t)shm;
    f32x4 st[4];
#pragma unroll
    for (int i = 0; i < 4; ++i) st[i] = (f32x4){0.f, 0.f, 0.f, 0.f};
    u32x4 rq[2], rk[2], rv; float rdec = 0.f;
    const size_t seq0 = (size_t)b * SEQ;
#define GLA_LOAD(c) do { const size_t gr = seq0 + (size_t)(c) * 64 + row; const size_t o = gr * 512 + h * 128 + ec * 16; \
        _Pragma("unroll") for (int i = 0; i < 2; ++i) { rq[i] = *(const u32x4*)(QD + o + 8 * i); rk[i] = *(const u32x4*)(KI + o + 8 * i); } \
        rv = *(const u32x4*)(PROJ + gr * NO_IN + 3584 + h * 256 + vs * 64 + ec * 8); \
        if (tid < 128) rdec = DEC[((size_t)b * 32 + (c)) * 512 + h * 128 + tid]; } while (0)
#define GLA_WRITE(pb) do { LAS char* gb_ = shm + (pb) * G_BUF; \
        _Pragma("unroll") for (int i = 0; i < 2; ++i) { *(LAS u32x4*)(gb_ + G_QD + sw256(row, ec * 2 + i)) = rq[i]; *(LAS u32x4*)(gb_ + G_KI + sw256(row, ec * 2 + i)) = rk[i]; } \
        *(LAS u32x4*)(gb_ + G_V + row * XROW + ec * 16) = rv; \
        if (tid < 128) ((LAS float*)(gb_ + G_DEC))[tid] = rdec; \
        _Pragma("unroll") for (int vt = 0; vt < 4; ++vt) { u32x2 v; v.x = cvt_pk_bf16(st[vt][0], st[vt][1]); v.y = cvt_pk_bf16(st[vt][2], st[vt][3]); \
            const int vv = 16 * vt + fr; *(LAS u32x2*)(shm + G_SP + (pb) * 16384 + sw256(vv, 2 * w + (fq >> 1)) + (fq & 1) * 8) = v; } } while (0)
    GLA_LOAD(0);
    GLA_WRITE(0);
    MX_BAR_L();
    const unsigned xtr = lds0 + (unsigned)(((lane & 15) >> 2) * XROW + (lane & 3) * 8);
    for (int c = 0; c < 32; ++c) {
        const int pb = c & 1; LAS char* gb = shm + pb * G_BUF; const unsigned gbo = (unsigned)(pb * G_BUF); LAS char* sp = shm + G_SP + pb * 16384;
        if (c + 1 < 32) GLA_LOAD(c + 1);
        bf16x8 qf[4];
#pragma unroll
        for (int ks = 0; ks < 4; ++ks) qf[ks] = *(const LAS bf16x8*)(gb + G_QD + sw256(l0 + fr, 4 * ks + fq));
        f32x4 o[2]; o[0] = (f32x4){0.f, 0.f, 0.f, 0.f}; o[1] = (f32x4){0.f, 0.f, 0.f, 0.f};
        const int lcol = l0 + fr; const int nsb = (lt >> 1) + 1;
        for (int sb = 0; sb < nsb; ++sb) {
            const int s0 = 32 * sb; const bool two = (2 * sb + 1) <= lt;
            f32x4 a0 = {0.f, 0.f, 0.f, 0.f}, a1 = {0.f, 0.f, 0.f, 0.f};
#pragma unroll
            for (int ks = 0; ks < 4; ++ks) { const bf16x8 kf = *(const LAS bf16x8*)(gb + G_KI + sw256(s0 + fr, 4 * ks + fq)); a0 = __builtin_amdgcn_mfma_f32_16x16x32_bf16(kf, qf[ks], a0, 0, 0, 0); }
            if (two) {
#pragma unroll
                for (int ks = 0; ks < 4; ++ks) { const bf16x8 kf = *(const LAS bf16x8*)(gb + G_KI + sw256(s0 + 16 + fr, 4 * ks + fq)); a1 = __builtin_amdgcn_mfma_f32_16x16x32_bf16(kf, qf[ks], a1, 0, 0, 0); }
            }
            float g0[4], g1[4];
#pragma unroll
            for (int i = 0; i < 4; ++i) { const int sa = s0 + 4 * fq + i; g0[i] = (sa <= lcol) ? a0[i] : 0.f; g1[i] = (two && sa + 16 <= lcol) ? a1[i] : 0.f; }
            u32x4 ap; ap.x = cvt_pk_bf16(g0[0], g0[1]); ap.y = cvt_pk_bf16(g0[2], g0[3]); ap.z = cvt_pk_bf16(g1[0], g1[1]); ap.w = cvt_pk_bf16(g1[2], g1[3]);
            const bf16x8 af = __builtin_bit_cast(bf16x8, ap);
            s16x4 lo[2], hi[2];
#pragma unroll
            for (int vi = 0; vi < 2; ++vi) { lo[vi] = tr_read(xtr + gbo + G_V + (unsigned)((s0 + 4 * fq) * XROW + (vt0 + vi) * 32)); hi[vi] = tr_read(xtr + gbo + G_V + (unsigned)((s0 + 16 + 4 * fq) * XROW + (vt0 + vi) * 32)); }
            MX_LGKM0();
#pragma unroll
            for (int vi = 0; vi < 2; ++vi) o[vi] = __builtin_amdgcn_mfma_f32_16x16x32_bf16(af, cat8(lo[vi], hi[vi]), o[vi], 0, 0, 0);
        }
#pragma unroll
        for (int vi = 0; vi < 2; ++vi)
#pragma unroll
            for (int ks = 0; ks < 4; ++ks) { const bf16x8 sf = *(const LAS bf16x8*)(sp + sw256(16 * (vt0 + vi) + fr, 4 * ks + fq)); o[vi] = __builtin_amdgcn_mfma_f32_16x16x32_bf16(qf[ks], sf, o[vi], 0, 0, 0); }
        {
            bf16_t* op = MIX + (seq0 + (size_t)c * 64 + l0 + 4 * fq) * 2048 + 1024 + h * 256 + vs * 64 + vt0 * 16 + fr;
#pragma unroll
            for (int vi = 0; vi < 2; ++vi)
#pragma unroll
                for (int i = 0; i < 4; ++i) { const bf16_t val = (bf16_t)(cvt_pk_bf16(o[vi][i], 0.f) & 0xffffu);
                    if (CHECK) { if (op[(size_t)i * 2048 + vi * 16] != val) atomicAdd(mismatch, 1u); } else op[(size_t)i * 2048 + vi * 16] = val; }
        }
        {
#pragma unroll
            for (int ks = 0; ks < 2; ++ks) {
                const int s0 = 32 * ks, q = (lane & 15) >> 2, p = lane & 3;
                const int r1 = s0 + 8 * fq + q, r2 = r1 + 4;
                const s16x4 alo = tr_read(lds0 + gbo + G_KI + sw256(r1, 2 * w + (p >> 1)) + (p & 1) * 8), ahi = tr_read(lds0 + gbo + G_KI + sw256(r2, 2 * w + (p >> 1)) + (p & 1) * 8);
                s16x4 lo[4], hi[4];
#pragma unroll
                for (int vt = 0; vt < 4; ++vt) { lo[vt] = tr_read(xtr + gbo + G_V + (unsigned)((s0 + 8 * fq) * XROW + vt * 32)); hi[vt] = tr_read(xtr + gbo + G_V + (unsigned)((s0 + 8 * fq + 4) * XROW + vt * 32)); }
                MX_LGKM0();
                const bf16x8 af = cat8(alo, ahi);
#pragma unroll
                for (int vt = 0; vt < 4; ++vt) st[vt] = __builtin_amdgcn_mfma_f32_16x16x32_bf16(af, cat8(lo[vt], hi[vt]), st[vt], 0, 0, 0);
            }
            const f32x4 d4 = *(const LAS f32x4*)((LAS float*)(gb + G_DEC) + 16 * w + 4 * fq);
#pragma unroll
            for (int vt = 0; vt < 4; ++vt) st[vt] = st[vt] * d4;
        }
        if (c + 1 < 32) GLA_WRITE(pb ^ 1);
        MX_BAR_L();
    }
    asm volatile("s_waitcnt vmcnt(0)" ::: "memory");
#undef GLA_LOAD
#undef GLA_WRITE
}

__device__ __forceinline__ void finalize_phase(bf16_t* MIX, const bf16_t* PROJ, const float* ssd_norm, const float* gla_norm, int gw, int ngw, int lane) {
    for (int m = gw; m < T; m += ngw) {
        bf16_t* mr = MIX + (size_t)m * 2048; const bf16_t* pr = PROJ + (size_t)m * NO_IN;
        float y[2][8]; float s = 0.f;
#pragma unroll
        for (int j = 0; j < 2; ++j) { const int col = 512 * j + 8 * lane; const u32x4 a = *(const u32x4*)(mr + col), z = __builtin_nontemporal_load((const u32x4*)(pr + col));
#pragma unroll
            for (int i = 0; i < 4; ++i) { const float y0 = __uint_as_float(a[i] << 16), y1 = __uint_as_float(a[i] & 0xffff0000u), z0 = __uint_as_float(z[i] << 16), z1 = __uint_as_float(z[i] & 0xffff0000u);
                y[j][2 * i] = y0 * siluf(z0); y[j][2 * i + 1] = y1 * siluf(z1); s += y[j][2 * i] * y[j][2 * i] + y[j][2 * i + 1] * y[j][2 * i + 1]; } }
        const float rs = rsqrtf(wave_sum(s) * (1.f / 1024.f) + EPS);
#pragma unroll
        for (int j = 0; j < 2; ++j) { const int col = 512 * j + 8 * lane; const f32x4 w0 = *(const f32x4*)(ssd_norm + col), w1 = *(const f32x4*)(ssd_norm + col + 4);
            u32x4 o; o.x = cvt_pk_bf16(y[j][0] * rs * w0[0], y[j][1] * rs * w0[1]); o.y = cvt_pk_bf16(y[j][2] * rs * w0[2], y[j][3] * rs * w0[3]);
            o.z = cvt_pk_bf16(y[j][4] * rs * w1[0], y[j][5] * rs * w1[1]); o.w = cvt_pk_bf16(y[j][6] * rs * w1[2], y[j][7] * rs * w1[3]);
            *(u32x4*)(mr + col) = o; }
#pragma unroll
        for (int j = 0; j < 2; ++j) { const int cc = 512 * j + 8 * lane; const u32x4 a = *(const u32x4*)(mr + 1024 + cc), r = __builtin_nontemporal_load((const u32x4*)(pr + 4608 + cc));
            float o[8]; float s2 = 0.f;
#pragma unroll
            for (int i = 0; i < 4; ++i) { o[2 * i] = __uint_as_float(a[i] << 16); o[2 * i + 1] = __uint_as_float(a[i] & 0xffff0000u); s2 += o[2 * i] * o[2 * i] + o[2 * i + 1] * o[2 * i + 1]; }
#pragma unroll
            for (int of = 1; of < 32; of <<= 1) s2 += __shfl_xor(s2, of);
            const float r2 = rsqrtf(s2 * (1.f / 256.f) + EPS); const int v0 = 8 * (lane & 31);
            const f32x4 w0 = *(const f32x4*)(gla_norm + v0), w1 = *(const f32x4*)(gla_norm + v0 + 4);
            float f[8];
#pragma unroll
            for (int i = 0; i < 4; ++i) { f[2 * i] = siluf(__uint_as_float(r[i] << 16)); f[2 * i + 1] = siluf(__uint_as_float(r[i] & 0xffff0000u)); }
            u32x4 ov; ov.x = cvt_pk_bf16(o[0] * r2 * w0[0] * f[0], o[1] * r2 * w0[1] * f[1]); ov.y = cvt_pk_bf16(o[2] * r2 * w0[2] * f[2], o[3] * r2 * w0[3] * f[3]);
            ov.z = cvt_pk_bf16(o[4] * r2 * w1[0] * f[4], o[5] * r2 * w1[1] * f[5]); ov.w = cvt_pk_bf16(o[6] * r2 * w1[2] * f[6], o[7] * r2 * w1[3] * f[7]);
            *(u32x4*)(mr + 1024 + cc) = ov; }
    }
}
#undef MX_LGKM0
#undef MX_BAR
#undef MX_BAR_L
}
namespace mk {
__device__ __forceinline__ void tp_norm_rows(const float* src, const float* g, bf16_t* xn, int gw, int ngw, int lane) {
    f32x4 gg[4];
#pragma unroll
    for (int j = 0; j < 4; ++j) gg[j] = ((const f32x4*)g)[lane + 64 * j];
    for (int m = gw; m < T; m += ngw) {
        const f32x4* p = (const f32x4*)(src + (size_t)m * DM); f32x4 v[4]; float s = 0.f;
#pragma unroll
        for (int j = 0; j < 4; ++j) { v[j] = __builtin_nontemporal_load(p + lane + 64 * j); s += (v[j][0] * v[j][0] + v[j][1] * v[j][1]) + (v[j][2] * v[j][2] + v[j][3] * v[j][3]); }
        const float r = rsqrtf(wave_sum(s) * (1.f / DM) + EPS);
        u32x2* o = (u32x2*)(xn + (size_t)m * DM);
#pragma unroll
        for (int j = 0; j < 4; ++j) { const f32x4 y = v[j] * r * gg[j]; u32x2 w; w.x = cvt_pk_bf16(y[0], y[1]); w.y = cvt_pk_bf16(y[2], y[3]); o[lane + 64 * j] = w; }
    }
}
template <bool FINAL> __device__ __forceinline__ void tp_combine_norm(bf16_t* hb, const bf16_t* Y, const float* g, bf16_t* xn, float* out, int gw, int ngw, int lane) {
    f32x4 gg[2][2];
#pragma unroll
    for (int j = 0; j < 2; ++j) { gg[j][0] = *(const f32x4*)(g + 512 * j + 8 * lane); gg[j][1] = *(const f32x4*)(g + 512 * j + 8 * lane + 4); }
    for (int m = gw; m < T; m += ngw) {
        float v[2][8]; float s = 0.f;
#pragma unroll
        for (int j = 0; j < 2; ++j) { const size_t o = (size_t)m * DM + 512 * j + 8 * lane;
            const u32x4 a = *(const u32x4*)(hb + o), y0 = __builtin_nontemporal_load((const u32x4*)(Y + o)), y1 = __builtin_nontemporal_load((const u32x4*)(Y + (size_t)T * DM + o));
#pragma unroll
            for (int i = 0; i < 4; ++i) { v[j][2 * i] = __uint_as_float(a[i] << 16) + __uint_as_float(y0[i] << 16) + __uint_as_float(y1[i] << 16);
                v[j][2 * i + 1] = __uint_as_float(a[i] & 0xffff0000u) + __uint_as_float(y0[i] & 0xffff0000u) + __uint_as_float(y1[i] & 0xffff0000u);
                s += v[j][2 * i] * v[j][2 * i] + v[j][2 * i + 1] * v[j][2 * i + 1]; } }
        const float r = rsqrtf(wave_sum(s) * (1.f / DM) + EPS);
#pragma unroll
        for (int j = 0; j < 2; ++j) { const size_t o = (size_t)m * DM + 512 * j + 8 * lane;
            if (FINAL) { f32x4 o0, o1;
#pragma unroll
                for (int i = 0; i < 4; ++i) { o0[i] = v[j][i] * r * gg[j][0][i]; o1[i] = v[j][4 + i] * r * gg[j][1][i]; }
                __builtin_nontemporal_store(o0, (f32x4*)(out + o)); __builtin_nontemporal_store(o1, (f32x4*)(out + o + 4));
            } else { u32x4 hw, xw;
#pragma unroll
                for (int i = 0; i < 4; ++i) { hw[i] = cvt_pk_bf16(v[j][2 * i], v[j][2 * i + 1]);
                    xw[i] = cvt_pk_bf16(v[j][2 * i] * r * gg[j][i >> 1][(2 * i) & 3], v[j][2 * i + 1] * r * gg[j][i >> 1][(2 * i + 1) & 3]); }
                *(u32x4*)(hb + o) = hw; *(u32x4*)(xn + o) = xw; }
        }
    }
}
template <bool DRY> __device__ __forceinline__ void tp_route_mfma(const bf16_t* hb, const float* g, bf16_t* xn, const bf16_t* whi, const bf16_t* wlo, const float* bg, const float* br,
                                                                  unsigned* counts, int* lists, float* gates, LAS char* shm, int vcu, int G, int lane, int wave) {
    const int fr = lane & 15, fq = lane >> 4, kbase = wave * 128;
    LAS float* xacc = (LAS float*)shm;
    LAS float* ltile = (LAS float*)(shm + 106496);
    LAS float* rsl = (LAS float*)(shm + 118784);
    for (int blk = vcu; blk < T / 64; blk += G) {
        const int r0 = blk * 64;
        bf16x8 wh[3][4], wl[3][4];
#pragma unroll
        for (int nt = 0; nt < 3; ++nt)
#pragma unroll
            for (int ks = 0; ks < 4; ++ks) { const size_t wo = (size_t)(nt * 16 + fr) * DM + kbase + 32 * ks + 8 * fq; wh[nt][ks] = *(const bf16x8*)(whi + wo); wl[nt][ks] = *(const bf16x8*)(wlo + wo); }
#pragma unroll
        for (int tp = 0; tp < 2; ++tp) {
            u32x4 hq[2][4];
#pragma unroll
            for (int t2 = 0; t2 < 2; ++t2)
#pragma unroll
                for (int ks = 0; ks < 4; ++ks) hq[t2][ks] = *(const u32x4*)(hb + (size_t)(r0 + 16 * (2 * tp + t2) + fr) * DM + kbase + 32 * ks + 8 * fq);
#pragma unroll
            for (int t2 = 0; t2 < 2; ++t2) { const int t = 2 * tp + t2;
                f32x4 acc[3]; acc[0] = (f32x4){0.f, 0.f, 0.f, 0.f}; acc[1] = acc[0]; acc[2] = acc[0];
                float ss = 0.f;
#pragma unroll
                for (int ks = 0; ks < 4; ++ks) { const u32x4 v = hq[t2][ks];
                    const float x0 = __uint_as_float(v.x << 16), x1 = __uint_as_float(v.x & 0xffff0000u), x2 = __uint_as_float(v.y << 16), x3 = __uint_as_float(v.y & 0xffff0000u);
                    const float x4 = __uint_as_float(v.z << 16), x5 = __uint_as_float(v.z & 0xffff0000u), x6 = __uint_as_float(v.w << 16), x7 = __uint_as_float(v.w & 0xffff0000u);
                    ss += (x0 * x0 + x1 * x1) + (x2 * x2 + x3 * x3) + (x4 * x4 + x5 * x5) + (x6 * x6 + x7 * x7);
                    const bf16x8 a = __builtin_bit_cast(bf16x8, v);
#pragma unroll
                    for (int nt = 0; nt < 3; ++nt) { acc[nt] = __builtin_amdgcn_mfma_f32_16x16x32_bf16(a, wh[nt][ks], acc[nt], 0, 0, 0); acc[nt] = __builtin_amdgcn_mfma_f32_16x16x32_bf16(a, wl[nt][ks], acc[nt], 0, 0, 0); } }
                ss += __shfl_xor(ss, 16); ss += __shfl_xor(ss, 32);
                LAS float* xa = xacc + (t * 8 + wave) * 13 * 64;
#pragma unroll
                for (int nt = 0; nt < 3; ++nt)
#pragma unroll
                    for (int i = 0; i < 4; ++i) xa[(nt * 4 + i) * 64 + lane] = acc[nt][i];
                xa[12 * 64 + lane] = ss;
            }
            asm volatile("" ::: "memory");
        }
        u32x4 hv[4][4];
#pragma unroll
        for (int t = 0; t < 4; ++t)
#pragma unroll
            for (int ks = 0; ks < 4; ++ks) hv[t][ks] = *(const u32x4*)(hb + (size_t)(r0 + 16 * t + fr) * DM + kbase + 32 * ks + 8 * fq);
        asm volatile("s_waitcnt lgkmcnt(0)\n\ts_barrier" ::: "memory");
        float rs[4];
#pragma unroll
        for (int t = 0; t < 4; ++t) { float s = 0.f;
#pragma unroll
            for (int w2 = 0; w2 < 8; ++w2) s += xacc[(t * 8 + w2) * 13 * 64 + 12 * 64 + lane];
            rs[t] = rsqrtf(s * (1.f / DM) + EPS); }
        if (wave < 4) {
            const LAS float* xs = xacc + (wave * 8) * 13 * 64;
#pragma unroll
            for (int nt = 0; nt < 3; ++nt)
#pragma unroll
                for (int i = 0; i < 4; ++i) { float v = 0.f;
#pragma unroll
                    for (int w2 = 0; w2 < 8; ++w2) v += xs[w2 * 13 * 64 + (nt * 4 + i) * 64 + lane];
                    ltile[(16 * wave + 4 * fq + i) * 48 + nt * 16 + fr] = v; }
            float rw = rs[0];
#pragma unroll
            for (int t = 1; t < 4; ++t) if (wave == t) rw = rs[t];
            if (fq == 0) rsl[16 * wave + fr] = rw;
        }
#pragma unroll
        for (int t = 0; t < 4; ++t) { bf16_t* xp = xn + (size_t)(r0 + 16 * t + fr) * DM + kbase + 8 * fq; const float r = rs[t];
#pragma unroll
            for (int ks = 0; ks < 4; ++ks) { const u32x4 v = hv[t][ks]; const f32x4 g0 = *(const f32x4*)(g + kbase + 32 * ks + 8 * fq), g1 = *(const f32x4*)(g + kbase + 32 * ks + 8 * fq + 4); u32x4 o;
                o.x = cvt_pk_bf16(__uint_as_float(v.x << 16) * r * g0[0], __uint_as_float(v.x & 0xffff0000u) * r * g0[1]); o.y = cvt_pk_bf16(__uint_as_float(v.y << 16) * r * g0[2], __uint_as_float(v.y & 0xffff0000u) * r * g0[3]);
                o.z = cvt_pk_bf16(__uint_as_float(v.z << 16) * r * g1[0], __uint_as_float(v.z & 0xffff0000u) * r * g1[1]); o.w = cvt_pk_bf16(__uint_as_float(v.w << 16) * r * g1[2], __uint_as_float(v.w & 0xffff0000u) * r * g1[3]);
                *(u32x4*)(xp + 32 * ks) = o; } }
        asm volatile("s_waitcnt lgkmcnt(0)\n\ts_barrier" ::: "memory");
        if (wave == 0) {
            const LAS float* lt = ltile + lane * 48; const float rsr = rsl[lane];
            float gl[4];
#pragma unroll
            for (int e = 0; e < 4; ++e) gl[e] = rsr * lt[e] + bg[e];
            int gi = 0; float gm = gl[0];
#pragma unroll
            for (int e = 1; e < 4; ++e) if (gl[e] > gm) { gm = gl[e]; gi = e; }
            float gs = 0.f;
#pragma unroll
            for (int e = 0; e < 4; ++e) gs += expf(gl[e] - gm);
            const float gwt = 1.f / gs;
            float b0 = -INFINITY, b1 = -INFINITY; int i0 = 0, i1 = 0;
#pragma unroll
            for (int i = 0; i < 8; ++i) { const float v = rsr * lt[4 + gi * 8 + i] + br[gi * 8 + i];
                if (v > b0) { b1 = b0; i1 = i0; b0 = v; i0 = i; } else if (v > b1) { b1 = v; i1 = i; } }
            const int t = r0 + lane;
            const float w0 = 1.f / (1.f + expf(b1 - b0)), w1 = 1.f - w0;
            const int e0 = gi * 8 + i0, e1 = gi * 8 + i1;
            gates[2 * t] = gwt * w0; gates[2 * t + 1] = gwt * w1;
            if (!DRY) {
                const unsigned p0 = __hip_atomic_fetch_add(counts + e0 * 64, 1u, __ATOMIC_RELAXED, __HIP_MEMORY_SCOPE_AGENT);
                const unsigned p1 = __hip_atomic_fetch_add(counts + e1 * 64, 1u, __ATOMIC_RELAXED, __HIP_MEMORY_SCOPE_AGENT);
                lists[e0 * CAP + p0] = 2 * t; lists[e1 * CAP + p1] = 2 * t + 1; }
        }
    }
    asm volatile("s_waitcnt lgkmcnt(0)\n\ts_barrier" ::: "memory");
}

struct Args {
    const float* in[26]; float* out; unsigned char* ws; int ph_lo, ph_hi, use_bar, li;
};
enum Phase { P_CONV0 = 0, P_G1, P_ATT, P_G2, P_TP1, P_G3, P_G4, P_TP2, P_G5, P_CONV, P_MIXER, P_FIN, P_G6, P_TP3, P_G7, P_G8, P_TP4, P_COUNT };

__device__ __forceinline__ void moe_setup(volatile LAS int* misc, unsigned* counts) {
    if (threadIdx.x == 0) {
        int run = 0;
        for (int e = 0; e < 32; ++e) { const int c = (int)__hip_atomic_load(counts + e * 64, __ATOMIC_RELAXED, __HIP_MEMORY_SCOPE_AGENT); misc[64 + e] = c; misc[16 + e] = run; run += (c + 255) >> 8; }
        misc[16 + 32] = run;
    }
    __syncthreads();
}

typedef const float* kin_ptr_t;
__device__ __forceinline__ const float* kin(int i) { return ((const volatile kin_ptr_t __attribute__((address_space(4)))*)__builtin_amdgcn_kernarg_segment_ptr())[i]; }
#ifndef CV_TAIL_ITEMS
#define CV_TAIL_ITEMS 8192
#endif
constexpr int CV_I_EIN = 16 * 80, CV_I_EOUT = 16 * 32, CV_I_OIN = 16 * 184, CV_I_OOUT = 32 * 32, CV_I_GU = 16 * 32, CV_I_D = 8 * 32;
constexpr int CV_NITEMS = CV_I_EIN + CV_I_EOUT + CV_I_OIN + CV_I_OOUT + 32 * CV_I_GU + 32 * CV_I_D;
__device__ __forceinline__ CvItem cv_decode0(unsigned char* ws, int it, int lane) {
    int r = it;
    if (r < CV_I_EIN) return cv_make(SrcEvenIn{kin(4)}, 2312, 1024, 80, (bf16_t*)(ws + WS_WEIN), r, lane); r -= CV_I_EIN;
    if (r < CV_I_EOUT) return cv_make(SrcPlain{kin(7), 1024}, 1024, 1024, 32, (bf16_t*)(ws + WS_WEOUT), r, lane); r -= CV_I_EOUT;
    if (r < CV_I_OIN) return cv_make(SrcOddIn{kin(8)}, 5664, 1024, 184, (bf16_t*)(ws + WS_WOIN), r, lane); r -= CV_I_OIN;
    if (r < CV_I_OOUT) return cv_make(SrcPlain{kin(18), 1024}, 1024, 2048, 32, (bf16_t*)(ws + WS_WOOUT), r, lane); r -= CV_I_OOUT;
    if (r < 32 * CV_I_GU) { const int e = r / CV_I_GU; return cv_make_gu(kin(23) + (size_t)e * 1024 * 512, kin(24) + (size_t)e * 1024 * 512, (bf16_t*)(ws + WS_WGU) + (size_t)e * 1024 * 1024, r % CV_I_GU, lane); } r -= 32 * CV_I_GU;
    { const int e = r / CV_I_D; return cv_make(SrcPlain{kin(25) + (size_t)e * 512 * 1024, 1024}, 1024, 512, 32, (bf16_t*)(ws + WS_WD) + (size_t)e * 1024 * 512, r % CV_I_D, lane); }
}
__device__ __forceinline__ void cv_run0(unsigned char* ws, int lo, int hi, int w, int nw, LAS float* scr, int lane) {
    for (int it = lo + 2 * w; it < hi; it += 2 * nw) {
        float va[32], vb[32]; const CvItem da = cv_decode0(ws, it, lane); cv_load(da, va);
        const bool n1 = it + 1 < hi; CvItem db = da; if (n1) { db = cv_decode0(ws, it + 1, lane); cv_load(db, vb); }
        cv_finish(da, va, scr, lane);
        if (n1) cv_finish(db, vb, scr, lane);
    }
}

constexpr int CV_NIT1 = 32 * (CV_I_GU + CV_I_D);
#ifndef CV1_TAIL_G5
#define CV1_TAIL_G5 4096
#endif
#ifndef CV1_TAIL_MIX
#define CV1_TAIL_MIX 8192
#endif
#ifndef CV1_TAIL_G4
#define CV1_TAIL_G4 8192
#endif
#ifndef CV0_TAIL_G3
#define CV0_TAIL_G3 0
#endif
__device__ __forceinline__ CvItem cv_decode1(unsigned char* ws, int it, int lane) {
    const size_t L1 = (size_t)32 * 1024 * 512; int r = it;
    if (r < 32 * CV_I_GU) { const int e = r / CV_I_GU; return cv_make_gu(kin(23) + L1 + (size_t)e * 1024 * 512, kin(24) + L1 + (size_t)e * 1024 * 512, (bf16_t*)(ws + WS_WGU) + (size_t)e * 1024 * 1024, r % CV_I_GU, lane); } r -= 32 * CV_I_GU;
    { const int e = r / CV_I_D; return cv_make(SrcPlain{kin(25) + L1 + (size_t)e * 512 * 1024, 1024}, 1024, 512, 32, (bf16_t*)(ws + WS_WD) + (size_t)e * 1024 * 512, r % CV_I_D, lane); }
}
__device__ __forceinline__ void cv_run1(unsigned char* ws, int lo, int hi, int w, int nw, LAS float* scr, int lane) {
    for (int it = lo + 2 * w; it < hi; it += 2 * nw) {
        float va[32], vb[32]; const CvItem da = cv_decode1(ws, it, lane); cv_load(da, va);
        const bool n1 = it + 1 < hi; CvItem db = da; if (n1) { db = cv_decode1(ws, it + 1, lane); cv_load(db, vb); }
        cv_finish(da, va, scr, lane);
        if (n1) cv_finish(db, vb, scr, lane);
    }
}

__global__ void __launch_bounds__(NTHR, 2) mk_fwd(Args args) {
    extern __shared__ __attribute__((aligned(16))) unsigned char lds_raw[];
    LAS unsigned char* lds = (LAS unsigned char*)lds_raw;
    volatile LAS int* misc = (volatile LAS int*)(lds + MISC_OFF);
    const int tid = threadIdx.x, lane = tid & 63, wave = __builtin_amdgcn_readfirstlane(tid >> 6);
    const int G = gridDim.x, bx = blockIdx.x;
    const int vcu = (G % 8 == 0) ? (bx % 8) * (G / 8) + bx / 8 : bx;
    const int gw = vcu * NWAVES + wave, ngw = G * NWAVES;
    for (int u = tid; u < 256; u += NTHR) misc[u] = 0;
    __syncthreads();
#define ws ((unsigned char*)kin(27))
#define XN ((bf16_t*)(ws + WS_XN))
#define PROJ ((bf16_t*)(ws + WS_PROJ))
#define MIX ((bf16_t*)(ws + WS_MIX))
#define FB ((float*)(ws + WS_FB))
#define LISTS ((int*)(ws + WS_LISTS))
#define GATES ((float*)(ws + WS_GATES))
#define HB ((bf16_t*)(ws + WS_H))
#define YB ((bf16_t*)(ws + WS_Y))
#define outp ((float*)kin(26))
#define HBS ((bf16_t*)(ws + WS_HB))
#define ctl ((unsigned*)(ws + WS_CTL))
    XcdBarrier bar; bar.bar = ctl + CW_BAR + args.li * XCD_BAR_WORDS; bar.x = 0; bar.st = nullptr;
    if (args.use_bar) bar = xcd_barrier_post(ctl + CW_BAR + args.li * XCD_BAR_WORDS, (volatile LAS unsigned*)misc);
#ifdef BAR_TWICE
#define GRID_BAR() do { if (args.use_bar) { xcd_barrier(bar); xcd_barrier(bar); } } while (0)
#else
#define GRID_BAR() do { if (args.use_bar) xcd_barrier(bar); } while (0)
#endif
    const int lo = args.ph_lo, hi = args.ph_hi;
#ifndef MK_PHASE_MASK
#define MK_PHASE_MASK 0xffffffffu
#endif
#define IN(k) (((MK_PHASE_MASK >> (k)) & 1u) && lo <= (k) && (k) < hi)
#ifndef MK_REP_MASK
#define MK_REP_MASK 0u
#endif
#define NREP(k) ((((MK_REP_MASK) >> (k)) & 1u) ? 2 : 1)
#define REP(k) for (int _r = 0; _r < ((((MK_REP_MASK) >> (k)) & 1u) ? 2 : 1); ++_r)
#define SEAM(k) do { if (IN(k) && IN((k) + 1)) GRID_BAR(); } while (0)
#define XIN kin(0)

    if (IN(P_CONV0)) REP(P_CONV0) {
        LAS float* scr = (LAS float*)(lds + wave * 16384);
        constexpr int OI_LO = CV_I_EIN + CV_I_EOUT, OI_HI = OI_LO + CV_I_OIN + CV_I_OOUT;
        if (CV0_TAIL_G3 && G == 256) { cv_run0(ws, 0, OI_LO, gw, ngw, scr, lane); cv_run0(ws, OI_HI, CV_NITEMS - CV_TAIL_ITEMS, gw, ngw, scr, lane); }
        else cv_run0(ws, 0, CV_NITEMS - CV_TAIL_ITEMS, gw, ngw, scr, lane);
        { bf16_t* wrt = (bf16_t*)(ws + WS_WRT);
          for (int i = gw * 64 + lane; i < 2 * 48 * 1024; i += ngw * 64) { const int l = i / (48 * 1024), rem = i % (48 * 1024), e = rem >> 10, k = rem & 1023;
              const float v = ((e < 4) ? kin(19)[(size_t)l * 4096 + k * 4 + e] : (e < 36 ? kin(21)[(size_t)l * 32768 + k * 32 + (e - 4)] : 0.f)) * kin(2)[(size_t)l * DM + k];
              const unsigned hi = cvt_pk_bf16(v, 0.f) & 0xffffu; const unsigned lo = cvt_pk_bf16(v - __uint_as_float(hi << 16), 0.f) & 0xffffu;
              wrt[(size_t)(2 * l) * 48 * 1024 + rem] = (bf16_t)hi; wrt[(size_t)(2 * l + 1) * 48 * 1024 + rem] = (bf16_t)lo; } }
        tp_norm_rows(XIN, kin(1), XN, gw, ngw, lane);
    }
    SEAM(P_CONV0);
    if (IN(P_G1)) {
        pg8::Gemm g{XN, (const bf16_t*)(ws + WS_WEIN), 1024, 0}; pg8::DenseOrder S; S.init(T, NE_IN, G, bx, NREP(P_G1));
        pg8::EpiProjEven E{PROJ, FB};
        pg8::gemm_phase<pg8::EpiProjEven, pg8::DenseOrder, true>(lds, g, S, E);
        if (CV_TAIL_ITEMS > 0 && G == 256 && bx >= 128)
            cv_run0(ws, CV_NITEMS - CV_TAIL_ITEMS, CV_NITEMS, (bx - 128) * NWAVES + wave, 128 * NWAVES, (LAS float*)(lds + wave * 16384), lane);
        else if (CV_TAIL_ITEMS > 0 && G != 256) cv_run0(ws, CV_NITEMS - CV_TAIL_ITEMS, CV_NITEMS, gw, ngw, (LAS float*)(lds + wave * 16384), lane);
    }
    SEAM(P_G1);
    if (IN(P_ATT)) REP(P_ATT) {
        if (G == 256) {
            const int bh = vcu >> 2, s = vcu & 3, b = bh >> 3, h = bh & 7;
            const float fbias = kin(6)[h];
            att::fox_unit_p<false>((char*)lds_raw, (LAS char*)lds, b, h, 7 - s, PROJ, FB, fbias, MIX, ctl + 32, true);
            att::fox_unit_p<false>((char*)lds_raw, (LAS char*)lds, b, h, s, PROJ, FB, fbias, MIX, ctl + 32, false);
            for (int i = 0; i < 2; ++i) { const int u = vcu * 2 + i; const int sb = u >> 6, kvh = (u >> 5) & 1, blk = u & 31; att::swa_unit((LAS char*)lds, sb, kvh, blk, PROJ, kin(5), MIX); }
        }
    }
    SEAM(P_ATT);
    if (IN(P_G2)) {
        pg8::Gemm g{MIX, (const bf16_t*)(ws + WS_WEOUT), 1024, 0}; pg8::DenseOrder S; S.init(T, DM, G, bx, NREP(P_G2));
        pg8::EpiResidB<true> E{XIN, HBS};
        pg8::gemm_phase<pg8::EpiResidB<true>, pg8::DenseOrder, true>(lds, g, S, E);
    }
    SEAM(P_G2);
    if (IN(P_TP1)) {
#ifdef TP1_REP
        tp_route_mfma<true>(HBS, kin(2), XN, (const bf16_t*)(ws + WS_WRT), (const bf16_t*)(ws + WS_WRT) + 48 * 1024, kin(20), kin(22), ctl + CW_CNT, LISTS, GATES, (LAS char*)lds, vcu, G, lane, wave);
#endif
        tp_route_mfma<false>(HBS, kin(2), XN, (const bf16_t*)(ws + WS_WRT), (const bf16_t*)(ws + WS_WRT) + 48 * 1024, kin(20), kin(22), ctl + CW_CNT, LISTS, GATES, (LAS char*)lds, vcu, G, lane, wave);
    }
    SEAM(P_TP1);
    if (IN(P_G3)) {
        moe_setup(misc, ctl + CW_CNT);
        if (CV0_TAIL_G3 && G == 256) {
            const int U = misc[16 + 32] * 4, nidle = 768 - U;
            if (nidle > 0 && bx >= 256 - nidle) { constexpr int OI_LO = CV_I_EIN + CV_I_EOUT, OI_HI = OI_LO + CV_I_OIN + CV_I_OOUT;
                cv_run0(ws, OI_LO, OI_HI, (bx - (256 - nidle)) * NWAVES + wave, nidle * NWAVES, (LAS float*)(lds + wave * 16384), lane); }
            else if (nidle <= 0) { constexpr int OI_LO = CV_I_EIN + CV_I_EOUT, OI_HI = OI_LO + CV_I_OIN + CV_I_OOUT; cv_run0(ws, OI_LO, OI_HI, gw, ngw, (LAS float*)(lds + wave * 16384), lane); }
        }
        __syncthreads();
        pg8::Gemm g{XN, (const bf16_t*)(ws + WS_WGU), 1024, (size_t)1024 * 1024 * 2};
        pg8::MoeOrder S{(const volatile LAS int*)(misc + 16), (const volatile LAS int*)(misc + 64), LISTS, G, bx, true, NREP(P_G3)};
        pg8::EpiGateUp E{HB};
        pg8::gemm_phase<pg8::EpiGateUp, pg8::MoeOrder, true>(lds, g, S, E);
    }
    SEAM(P_G3);
    if (IN(P_G4)) {
        moe_setup(misc, ctl + CW_CNT);
        pg8::Gemm g{HB, (const bf16_t*)(ws + WS_WD), 512, (size_t)1024 * 512 * 2};
        pg8::MoeOrder S{(const volatile LAS int*)(misc + 16), (const volatile LAS int*)(misc + 64), LISTS, G, bx, false, NREP(P_G4)};
        pg8::EpiDown E{YB, LISTS, GATES, (const volatile LAS int*)(misc + 64)};
        pg8::gemm_phase<pg8::EpiDown, pg8::MoeOrder, true>(lds, g, S, E);
        if (CV1_TAIL_G4 > 0 && G == 256) {
            const int U = misc[16 + 32] * 4, nidle = 768 - U, lo1 = CV_NIT1 - CV1_TAIL_G5 - CV1_TAIL_MIX - CV1_TAIL_G4, hi1 = lo1 + CV1_TAIL_G4;
            if (nidle >= 32) { if (bx >= 256 - nidle) cv_run1(ws, lo1, hi1, (bx - (256 - nidle)) * NWAVES + wave, nidle * NWAVES, (LAS float*)(lds + wave * 16384), lane); }
            else cv_run1(ws, lo1, hi1, gw, ngw, (LAS float*)(lds + wave * 16384), lane);
        }
    }
    SEAM(P_G4);
    if (IN(P_TP2)) {
        tp_combine_norm<false>(HBS, YB, kin(1) + DM, XN, nullptr, gw, ngw, lane);
        LAS float* scr = (LAS float*)(lds + wave * 16384);
        constexpr int I_GU = 16 * 32, I_D = 8 * 32; const size_t L1 = (size_t)32 * 1024 * 512;
        auto decode = [&](int it) -> CvItem {
            int r = it;
            if (r < 32 * I_GU) { const int e = r / I_GU; return cv_make_gu(kin(23) + L1 + (size_t)e * 1024 * 512, kin(24) + L1 + (size_t)e * 1024 * 512, (bf16_t*)(ws + WS_WGU) + (size_t)e * 1024 * 1024, r % I_GU, lane); } r -= 32 * I_GU;
            { const int e = r / I_D; return cv_make(SrcPlain{kin(25) + L1 + (size_t)e * 512 * 1024, 1024}, 1024, 512, 32, (bf16_t*)(ws + WS_WD) + (size_t)e * 1024 * 512, r % I_D, lane); }
        };
        const int NIT1 = CV_NIT1 - ((G == 256) ? (CV1_TAIL_G5 + CV1_TAIL_MIX + CV1_TAIL_G4) : 0);
        for (int it = 2 * gw; it < NIT1; it += 2 * ngw) {
            float va[32], vb[32]; const CvItem da = decode(it); cv_load(da, va);
            const bool n1 = it + 1 < NIT1; CvItem db = da; if (n1) { db = decode(it + 1); cv_load(db, vb); }
            cv_finish(da, va, scr, lane);
            if (n1) cv_finish(db, vb, scr, lane);
        }
    }
    SEAM(P_TP2);
    if (IN(P_G5)) {
        pg8::Gemm g{XN, (const bf16_t*)(ws + WS_WOIN), 1024, 0}; pg8::DenseOrder S; S.init(T, NO_IN, G, bx, NREP(P_G5));
        pg8::EpiProjOdd E{PROJ, (float*)(ws + WS_DTG)};
        pg8::gemm_phase<pg8::EpiProjOdd, pg8::DenseOrder, true>(lds, g, S, E);
        if (CV1_TAIL_G5 > 0 && G == 256 && bx >= 192)
            cv_run1(ws, CV_NIT1 - CV1_TAIL_G5 - CV1_TAIL_MIX, CV_NIT1 - CV1_TAIL_MIX, (bx - 192) * NWAVES + wave, 64 * NWAVES, (LAS float*)(lds + wave * 16384), lane);
    }
    SEAM(P_G5);
    if (IN(P_CONV)) {
        mx::prep_conv(PROJ, (bf16_t*)(ws + WS_CONV), kin(9), kin(10), vcu, G, tid);
#ifdef PREP_REP_CONV
        mx::prep_conv(PROJ, (bf16_t*)(ws + WS_CONV), kin(9), kin(10), vcu, G, tid);
#endif
        mx::prep_ssd((const float*)(ws + WS_DTG), (float*)(ws + mx::WS_DTV), (float*)(ws + mx::WS_ACS), kin(11), kin(12), vcu, G, lane, wave);
#ifdef PREP_REP_SSD
        mx::prep_ssd((const float*)(ws + WS_DTG), (float*)(ws + mx::WS_DTV), (float*)(ws + mx::WS_ACS), kin(11), kin(12), vcu, G, lane, wave);
#endif
        mx::prep_gla(PROJ, (const float*)(ws + WS_DTG), (bf16_t*)(ws + mx::WS_QD), (bf16_t*)(ws + mx::WS_KI), (bf16_t*)(ws + mx::WS_KE), (float*)(ws + mx::WS_DEC), kin(15), kin(16), vcu, G, tid, lane, wave, (LAS char*)lds);
#ifdef PREP_REP_GLA
        mx::prep_gla(PROJ, (const float*)(ws + WS_DTG), (bf16_t*)(ws + mx::WS_QD), (bf16_t*)(ws + mx::WS_KI), (bf16_t*)(ws + mx::WS_KE), (float*)(ws + mx::WS_DEC), kin(15), kin(16), vcu, G, tid, lane, wave, (LAS char*)lds);
#endif
    }
    SEAM(P_CONV);
    if (IN(P_MIXER)) {
        if (G == 256) {
            if (vcu < 128) {
                mx::ssd_unit64((LAS char*)lds, vcu >> 4, vcu & 15, (const bf16_t*)(ws + WS_CONV), (const float*)(ws + mx::WS_ACS), (const float*)(ws + mx::WS_DTV), kin(13)[vcu & 15], MIX);
#ifdef MIX_SSD_REP
                __syncthreads(); mx::ssd_unit((LAS char*)lds, vcu >> 4, vcu & 15, (const bf16_t*)(ws + WS_CONV), (const float*)(ws + mx::WS_ACS), (const float*)(ws + mx::WS_DTV), kin(13)[vcu & 15], MIX);
#endif
            }
            else { const int u = vcu - 128; mx::gla_unit<false>((LAS char*)lds, u >> 4, (u >> 2) & 3, u & 3, PROJ, (const bf16_t*)(ws + mx::WS_QD), (const bf16_t*)(ws + mx::WS_KI),
                                                          (const float*)(ws + mx::WS_DEC), MIX, ctl + 32);
                if (CV1_TAIL_MIX > 0) { __syncthreads(); cv_run1(ws, CV_NIT1 - CV1_TAIL_MIX, CV_NIT1, (vcu - 128) * NWAVES + wave, 128 * NWAVES, (LAS float*)(lds + wave * 16384), lane); }
#ifdef MIX_GLA_REP
                __syncthreads(); mx::gla_unit<false>((LAS char*)lds, u >> 4, (u >> 2) & 3, u & 3, PROJ, (const bf16_t*)(ws + mx::WS_QD), (const bf16_t*)(ws + mx::WS_KI), (const float*)(ws + mx::WS_DEC), MIX, ctl + 32);
#endif
            }
        }
    }
    SEAM(P_MIXER);
    if (IN(P_FIN)) {
        mx::finalize_phase(MIX, PROJ, kin(14), kin(17), gw, ngw, lane);
    }
    SEAM(P_FIN);
    if (IN(P_G6)) {
        pg8::Gemm g{MIX, (const bf16_t*)(ws + WS_WOOUT), 2048, 0}; pg8::DenseOrder S; S.init(T, DM, G, bx, NREP(P_G6));
        pg8::EpiResidB<false> E{HBS, HBS};
        pg8::gemm_phase<pg8::EpiResidB<false>, pg8::DenseOrder, true>(lds, g, S, E);
    }
    SEAM(P_G6);
    if (IN(P_TP3)) {
        tp_route_mfma<false>(HBS, kin(2) + DM, XN, (const bf16_t*)(ws + WS_WRT) + 2 * 48 * 1024, (const bf16_t*)(ws + WS_WRT) + 3 * 48 * 1024, kin(20) + 4, kin(22) + 32,
                             ctl + CW_CNT + 32 * 64, LISTS, GATES, (LAS char*)lds, vcu, G, lane, wave);
    }
    SEAM(P_TP3);
    if (IN(P_G7)) {
        moe_setup(misc, ctl + CW_CNT + 32 * 64);
        pg8::Gemm g{XN, (const bf16_t*)(ws + WS_WGU), 1024, (size_t)1024 * 1024 * 2};
        pg8::MoeOrder S{(const volatile LAS int*)(misc + 16), (const volatile LAS int*)(misc + 64), LISTS, G, bx, true, NREP(P_G7)};
        pg8::EpiGateUp E{HB};
        pg8::gemm_phase<pg8::EpiGateUp, pg8::MoeOrder, true>(lds, g, S, E);
    }
    SEAM(P_G7);
    if (IN(P_G8)) {
        moe_setup(misc, ctl + CW_CNT + 32 * 64);
        pg8::Gemm g{HB, (const bf16_t*)(ws + WS_WD), 512, (size_t)1024 * 512 * 2};
        pg8::MoeOrder S{(const volatile LAS int*)(misc + 16), (const volatile LAS int*)(misc + 64), LISTS, G, bx, false, NREP(P_G8)};
        pg8::EpiDown E{YB, LISTS, GATES, (const volatile LAS int*)(misc + 64)};
        pg8::gemm_phase<pg8::EpiDown, pg8::MoeOrder, true>(lds, g, S, E);
    }
    SEAM(P_G8);
    if (IN(P_TP4)) {
        tp_combine_norm<true>(HBS, YB, kin(3), nullptr, outp, gw, ngw, lane);
#ifdef TP4_REP
        tp_combine_norm<true>(HBS, YB, kin(3), nullptr, outp, gw, ngw, lane);
#endif
#if defined(GLA_CHECK) || defined(ATT_CHECK)
        if (__hip_atomic_load(ctl + 32, __ATOMIC_RELAXED, __HIP_MEMORY_SCOPE_AGENT) != 0u) { for (int m = gw; m < T; m += ngw) outp[(size_t)m * DM + lane] = 1000.f; }
#endif
    }
#undef IN
#undef SEAM
#undef GRID_BAR
#undef ws
#undef XN
#undef PROJ
#undef MIX
#undef FB
#undef LISTS
#undef GATES
#undef HB
#undef YB
#undef outp
#undef HBS
#undef ctl
#undef XIN
}
}

extern "C" void kernel_launch(void* const* d_in, const int* in_sizes, int n_in, void* d_out, int out_size, void* d_ws, size_t ws_size, hipStream_t stream) {
    static int grid = 0;
    if (grid == 0) {
        int dev = 0, cus = 0, per_cu = 0;
        (void)hipGetDevice(&dev); (void)hipDeviceGetAttribute(&cus, hipDeviceAttributeMultiprocessorCount, dev);
        if (n_in != 26 || out_size != mk::T * mk::DM || ws_size < mk::WS_TOTAL) { fprintf(stderr, "kernel_launch: unexpected shapes (n_in %d out %d ws %zu)\n", n_in, out_size, ws_size); grid = -1; return; }
        if (hipFuncSetAttribute((const void*)mk::mk_fwd, hipFuncAttributeMaxDynamicSharedMemorySize, mk::LDS_BYTES) != hipSuccess) { fprintf(stderr, "hipFuncSetAttribute failed\n"); grid = -1; return; }
        if (hipOccupancyMaxActiveBlocksPerMultiprocessor(&per_cu, (const void*)mk::mk_fwd, mk::NTHR, mk::LDS_BYTES) != hipSuccess || per_cu < 1) { fprintf(stderr, "occupancy query reports %d blocks per CU\n", per_cu); }
        (void)hipGetLastError();
        grid = cus;
        if (grid != 256) fprintf(stderr, "kernel_launch: %d CUs; the attention / mixer phases need 256\n", grid);
    }
    if (grid < 0) return;
    (void)hipMemsetAsync((char*)d_ws + mk::WS_CTL, 0, mk::CTL_ZERO_BYTES, stream);
    mk::Args a{};
    for (int i = 0; i < 26; ++i) a.in[i] = (const float*)d_in[i];
    a.out = (float*)d_out; a.ws = (unsigned char*)d_ws;
    a.ph_lo = 0; a.ph_hi = mk::P_COUNT; a.use_bar = 1; a.li = 0;
    hipLaunchKernelGGL(mk::mk_fwd, dim3(grid), dim3(mk::NTHR), mk::LDS_BYTES, stream, a);
}
```

```cpp
#include <hip/hip_runtime.h>
#include <hip/hip_bf16.h>
#include <cstdio>
#include <cstdint>
#include <cmath>
namespace mk {
#define LAS __attribute__((address_space(3)))
#define GAS __attribute__((address_space(1)))
typedef unsigned short bf16_t;
typedef short bf16x8 __attribute__((ext_vector_type(8)));
typedef short s16x4 __attribute__((ext_vector_type(4)));
typedef float f32x4 __attribute__((ext_vector_type(4)));
typedef float f32x2 __attribute__((ext_vector_type(2)));
typedef float f32x16 __attribute__((ext_vector_type(16)));
typedef unsigned u32x4 __attribute__((ext_vector_type(4)));
typedef unsigned u32x2 __attribute__((ext_vector_type(2)));

constexpr int T = 16384, DM = 1024, SEQ = 2048, NBATCH = 8;
constexpr int NE_IN = 2560, NO_IN = 5888;
constexpr int CAP = 16384;
constexpr float EPS = 1e-6f;
constexpr float LOG2E = 1.4426950408889634f;
constexpr float C2 = 0.125f * LOG2E;
constexpr int NWAVES = 8, NTHR = 512;
constexpr size_t MiB = 1u << 20;
constexpr size_t WS_CTL = 0, CTL_ZERO_BYTES = 1 * MiB;
constexpr size_t WS_WEIN = 2 * MiB, WS_WEOUT = 7 * MiB, WS_WOIN = 9 * MiB, WS_WOOUT = 21 * MiB, WS_WRT = 25 * MiB;
constexpr size_t WS_WGU = 26 * MiB, WS_WD = 90 * MiB;
constexpr size_t WS_XN = 122 * MiB;
constexpr size_t WS_PROJ = 154 * MiB;
constexpr size_t WS_H = WS_PROJ, WS_Y = WS_PROJ + 40 * MiB;
constexpr size_t WS_MIX = 338 * MiB;
constexpr size_t WS_CONV = 402 * MiB;
constexpr size_t WS_FB = 450 * MiB;
constexpr size_t WS_DTG = 451 * MiB;
constexpr size_t WS_LISTS = 453 * MiB;
constexpr size_t WS_GATES = 455 * MiB;
constexpr size_t WS_RSTD = 455 * MiB + 512 * 1024;
constexpr size_t WS_END = 456 * MiB, WS_HB = 476 * MiB, WS_TOTAL = 508 * MiB;
constexpr int CW_BAR = 4096;
constexpr int CW_CNT = 16384;
constexpr int RING_BYTES = 146432;
constexpr int MISC_OFF = RING_BYTES;
constexpr int LDS_BYTES = 147456;

typedef __bf16 bf16x2_t __attribute__((ext_vector_type(2)));
__device__ __forceinline__ unsigned cvt_pk_bf16(float lo, float hi) { f32x2 v = {lo, hi}; bf16x2_t b = __builtin_convertvector(v, bf16x2_t); return __builtin_bit_cast(unsigned, b); }
__device__ __forceinline__ float bf2f(unsigned short b) { return __uint_as_float((unsigned)b << 16); }
__device__ __forceinline__ float wave_sum(float v) {
#pragma unroll
    for (int o = 1; o < 64; o <<= 1) v += __shfl_xor(v, o);
    return v;
}
__device__ __forceinline__ float siluf(float x) { return x * __builtin_amdgcn_rcpf(1.f + __expf(-x)); }
__device__ __forceinline__ float log_sigmoidf(float x) { return fminf(x, 0.f) - log1pf(expf(-fabsf(x))); }
__device__ __forceinline__ float log_sigmoid_fast(float x) { return fminf(x, 0.f) - __logf(1.f + __expf(-fabsf(x))); }
__device__ __forceinline__ float softplusf(float x) { return fmaxf(x, 0.f) + __logf(1.f + __expf(-fabsf(x))); }

#define XB_TMO      128
#define XB_XCNT(j)  (256  + 64 * (j))
#define XB_XSUB(j)  (1280 + 64 * (j))
#define XB_XGEN(j)  (2304 + 64 * (j))
#define XB_TOP      3328
#define XB_TOPGEN   3392
#define XCD_BAR_WORDS 3456
#define XB_SPIN_CAP (1u << 18)
__device__ __forceinline__ unsigned xb_ld(unsigned* p)              { return __hip_atomic_load(p, __ATOMIC_RELAXED, __HIP_MEMORY_SCOPE_AGENT); }
__device__ __forceinline__ unsigned xb_add(unsigned* p, unsigned v) { return __hip_atomic_fetch_add(p, v, __ATOMIC_RELAXED, __HIP_MEMORY_SCOPE_AGENT); }
__device__ __forceinline__ unsigned xb_xcc_id() { return (unsigned)__builtin_amdgcn_s_getreg((3 << 11) | 20) & 0xFu; }
#define XB_SPIN(cond, bar) do { unsigned _sp = 0; while (cond) { __builtin_amdgcn_s_sleep(1); \
    if ((++_sp & 255u) == 0u) { if (xb_ld(&(bar)[XB_TMO])) break; if (_sp > XB_SPIN_CAP) { atomicAdd(&(bar)[XB_TMO], 1u); break; } } } } while (0)
struct XcdBarrier { unsigned* bar; unsigned x; volatile LAS unsigned* st; };
__device__ __forceinline__ XcdBarrier xcd_barrier_post(unsigned* bar, volatile LAS unsigned* st) {
    XcdBarrier b; b.bar = bar; b.x = xb_xcc_id(); b.st = st;
    if (threadIdx.x == 0) (void)xb_add(&bar[XB_XCNT(b.x)], 1u);
    return b;
}
__device__ __forceinline__ void xcd_barrier_complete(unsigned* bar, unsigned x, unsigned& nloc, unsigned& nx) {
    const unsigned G = gridDim.x * gridDim.y * gridDim.z;
    unsigned sum, cnt, mine, sp = 0u;
    for (;;) {
        sum = 0u; cnt = 0u; mine = 0u;
#pragma unroll
        for (unsigned j = 0; j < 16; ++j) { const unsigned c = xb_ld(&bar[XB_XCNT(j)]); sum += c; cnt += (c > 0u) ? 1u : 0u; mine = (j == x) ? c : mine; }
        if (sum == G) break;
        __builtin_amdgcn_s_sleep(1);
        if ((++sp & 255u) == 0u) { if (xb_ld(&bar[XB_TMO])) break; if (sp > XB_SPIN_CAP) { atomicAdd(&bar[XB_TMO], 1u); break; } }
    }
    nloc = mine > 0u ? mine : 1u; nx = cnt > 0u ? cnt : 1u;
}
__device__ __forceinline__ void xcd_barrier(const XcdBarrier& b) {
    asm volatile("s_waitcnt vmcnt(0)" ::: "memory");
    __syncthreads();
    if (threadIdx.x == 0) {
        unsigned* bar = b.bar;
        __builtin_amdgcn_s_waitcnt(0);
        unsigned nloc = b.st[0], nx = b.st[1];
        if (nloc == 0u) { xcd_barrier_complete(bar, b.x, nloc, nx); b.st[0] = nloc; b.st[1] = nx; }
        const unsigned old = xb_add(&bar[XB_XSUB(b.x)], 1u);
        const unsigned gen = old / nloc;
        if (old + 1u == (gen + 1u) * nloc) {
            __builtin_amdgcn_fence(__ATOMIC_RELEASE, "agent");
            asm volatile("s_waitcnt vmcnt(0)" ::: "memory");
            const unsigned og = xb_add(&bar[XB_TOP], 1u);
            const unsigned tg = og / nx;
            if (og + 1u == (tg + 1u) * nx) xb_add(&bar[XB_TOPGEN], 1u);
            else XB_SPIN(xb_ld(&bar[XB_TOPGEN]) == tg, bar);
            __builtin_amdgcn_fence(__ATOMIC_ACQUIRE, "agent");
            xb_add(&bar[XB_XGEN(b.x)], 1u);
            asm volatile("s_waitcnt vmcnt(0)" ::: "memory");
        } else {
            XB_SPIN(xb_ld(&bar[XB_XGEN(b.x)]) == gen, bar);
            __builtin_amdgcn_fence(__ATOMIC_ACQUIRE, "agent");
            asm volatile("s_waitcnt vmcnt(0)" ::: "memory");
        }
    }
    __syncthreads();
}

struct SrcPlain { const float* W; int N; __device__ __forceinline__ const float* operator()(int k, int n) const { return W + (size_t)k * N + n; } };
struct SrcEvenIn { const float* W; __device__ __forceinline__ const float* operator()(int k, int n) const { return n < 2312 ? W + (size_t)k * 2312 + n : nullptr; } };
struct SrcOddIn { const float* W;
    __device__ __forceinline__ const float* operator()(int k, int n) const {
        int s;
        if (n < 2560) s = n; else if (n < 4608) s = n + 16; else if (n < 5632) s = n + 32; else if (n < 5648) s = 2560 + (n - 5632); else if (n < 5664) s = 4624 + (n - 5648); else s = -1;
        return s >= 0 ? W + (size_t)k * 5664 + s : nullptr; } };
struct SrcGateUp { const float* Wg; const float* Wu;
    __device__ __forceinline__ const float* operator()(int k, int n) const { const int j = (n >> 5) * 16 + (n & 15); const long d = (n & 16) ? (long)(Wu - Wg) : 0l; return Wg + d + (size_t)k * 512 + j; } };
__device__ __forceinline__ struct CvItem cv_make_gu(const float* Wg, const float* Wu, bf16_t* WT, int item, int lane);
struct CvItem { const float* p; size_t stride; bf16_t* dst; int K; int gu; };
template <class Src> __device__ __forceinline__ CvItem cv_make(const Src& src, int srcN, int K, int nblk, bf16_t* WT, int item, int lane) {
    const int kb = item / nblk, nb = item % nblk, k0 = 64 * kb, n0 = 32 * nb;
    CvItem d; d.p = src(k0 + (lane >> 5), n0 + (lane & 31)); d.stride = (size_t)2 * srcN; d.dst = WT + (size_t)n0 * K + k0; d.K = K; d.gu = 0; return d;
}
__device__ __forceinline__ CvItem cv_make_gu(const float* Wg, const float* Wu, bf16_t* WT, int item, int lane) {
    const int half = item >> 8, r = item & 255, kb = r >> 4, jb = r & 15, k0 = 64 * kb, j0 = 32 * jb;
    CvItem d; d.p = (half ? Wu : Wg) + (size_t)(k0 + (lane >> 5)) * 512 + j0 + (lane & 31); d.stride = 1024; d.dst = WT + (size_t)(jb * 64 + half * 16) * 1024 + k0; d.K = 1024; d.gu = 1; return d;
}
__device__ __forceinline__ void cv_load(const CvItem& d, float (&v)[32]) {
#pragma unroll
    for (int i = 0; i < 32; ++i) v[i] = d.p ? __builtin_nontemporal_load(d.p + (size_t)i * d.stride) : 0.f;
}
__device__ __forceinline__ void cv_finish(const CvItem& d, const float (&v)[32], LAS float* scr, int lane) {
#pragma unroll
    for (int i = 0; i < 32; ++i) { const int kk = 2 * i + (lane >> 5); scr[kk * 33 + (lane & 31)] = v[i]; }
    asm volatile("s_waitcnt lgkmcnt(0)" ::: "memory");
    const int c = lane & 7;
#pragma unroll
    for (int j = 0; j < 4; ++j) { const int n = (lane >> 3) + 8 * j; const LAS float* s = scr + (8 * c) * 33 + n; const int dr = d.gu ? ((n >> 4) * 32 + (n & 15)) : n;
        u32x4 o; o.x = cvt_pk_bf16(s[0 * 33], s[1 * 33]); o.y = cvt_pk_bf16(s[2 * 33], s[3 * 33]); o.z = cvt_pk_bf16(s[4 * 33], s[5 * 33]); o.w = cvt_pk_bf16(s[6 * 33], s[7 * 33]);
        __builtin_nontemporal_store(o, (u32x4*)(d.dst + (size_t)dr * d.K + 8 * c)); }
    asm volatile("s_waitcnt lgkmcnt(0)" ::: "memory");
}

namespace pg8 {
constexpr int BM = 256, BK = 64, HALF = 128, HTB = HALF * BK * 2, STAGE_BYTES = 8 * HTB, NXCD = 8, WGM = 8;
__host__ __device__ __forceinline__ int lds_byte(int r, int c) { const int st = (r >> 4) * 2 + (c >> 5), rr = r & 15, cc = c & 31, ob = rr * 64 + cc * 2; return st * 1024 + (ob ^ (((ob >> 9) & 1) << 5)); }
__host__ __device__ __forceinline__ void stage_rc(int b, int& R, int& C) { const int st = b / 1024, sb = b % 1024, swz = sb ^ (((sb >> 9) & 1) << 5); R = (st >> 1) * 16 + swz / 64; C = (st & 1) * 32 + (swz % 64) / 2; }
__host__ __device__ __forceinline__ int perm32(int rho) { const int n = rho >> 4, i = rho & 15; return 8 * (i >> 2) + 4 * n + (i & 3); }

struct Unit { int pm, pn, e, j; };
struct Gemm { const bf16_t* A; const bf16_t* Bt; int K; size_t b_estride; };

struct DenseOrder {
    int nM, nN, nwg, G, c, rep;
    __device__ void init(int M, int N, int G_, int c_, int rep_ = 1) { nM = M / BM; nN = N / BM; nwg = nM * nN; G = G_; c = c_; rep = rep_; }
    __device__ bool next(int i, Unit& u) const {
        if (rep > 1) { const int n = (nwg - c + G - 1) / G; if (n <= 0 || i >= n * rep) return false; i = i % n; }
        const long L = (long)i * G + c; if (L >= nwg) return false;
        int wgid = (int)L; { const int q = nwg / NXCD, r = nwg % NXCD, xcd = wgid % NXCD, off = wgid / NXCD; wgid = (xcd < r ? xcd * (q + 1) : r * (q + 1) + (xcd - r) * q) + off; }
        const int nig = WGM * nN, gid = wgid / nig, fm = gid * WGM, gsz = (nM - fm) < WGM ? (nM - fm) : WGM;
        u.pm = fm + ((wgid % nig) % gsz); u.pn = (wgid % nig) / gsz; u.e = 0; u.j = 0; return true;
    }
    __device__ __forceinline__ unsigned arow(const Unit& u, int r) const { return (unsigned)(u.pm * BM + r); }
    __device__ __forceinline__ void arow4(const Unit& u, int r0, int r1, unsigned (&o)[4]) const { o[0] = arow(u, r0); o[1] = arow(u, r1); o[2] = arow(u, HALF + r0); o[3] = arow(u, HALF + r1); }
};
struct MoeOrder {
    const volatile LAS int* ts; const volatile LAS int* cnt; const int* lists; int G, c; bool gather; int rep;
    __device__ bool next(int i, Unit& u) const {
        const int U = ts[32] * 4;
        if (rep > 1) { const int n = (U - c + G - 1) / G; if (n <= 0 || i >= n * rep) return false; i = i % n; }
        const long L = (long)i * G + c; if (L >= U) return false;
        int v = (int)L; { const int q = U / NXCD, r = U % NXCD, xcd = v % NXCD, off = v / NXCD; v = (xcd < r ? xcd * (q + 1) : r * (q + 1) + (xcd - r) * q) + off; }
        const int m = v >> 2; u.pm = m; u.pn = v & 3;
        int e = 0;
        for (int k = 1; k < 32; ++k) if (ts[k] <= m) e = k;
        u.e = e; u.j = m - ts[e]; return true;
    }
    __device__ __forceinline__ unsigned arow(const Unit& u, int r) const {
        if (!gather) return (unsigned)(u.pm * BM + r);
        const int ri = u.j * BM + r; const int n = cnt[u.e];
        return ri < n ? (unsigned)(lists[u.e * CAP + ri] >> 1) : 0u;
    }
    __device__ __forceinline__ void arow4(const Unit& u, int r0, int r1, unsigned (&o)[4]) const {
        if (!gather) { o[0] = (unsigned)(u.pm * BM + r0); o[1] = (unsigned)(u.pm * BM + r1); o[2] = (unsigned)(u.pm * BM + HALF + r0); o[3] = (unsigned)(u.pm * BM + HALF + r1); return; }
        const int n = cnt[u.e], last = n - 1, jb = u.j * BM; const int* lp = lists + u.e * CAP;
        const int i0 = jb + r0, i1 = jb + r1, i2 = i0 + HALF, i3 = i1 + HALF;
        const int v0 = lp[i0 < last ? i0 : last], v1 = lp[i1 < last ? i1 : last], v2 = lp[i2 < last ? i2 : last], v3 = lp[i3 < last ? i3 : last];
        o[0] = i0 < n ? (unsigned)(v0 >> 1) : 0u; o[1] = i1 < n ? (unsigned)(v1 >> 1) : 0u; o[2] = i2 < n ? (unsigned)(v2 >> 1) : 0u; o[3] = i3 < n ? (unsigned)(v3 >> 1) : 0u;
    }
};

struct EpiProjEven {
    static constexpr bool PERM = true;
    bf16_t* O; float* fb;
    __device__ __forceinline__ void operator()(const f32x4 (&acc)[2][2][4][2], const Unit& u, int wr, int wc, int fr, int fq) const {
        const int row0 = u.pm * BM + wr * 64 + fr;
        if (u.pn == 9) {
            if (wc == 0 && fq == 0) {
#pragma unroll
                for (int ai = 0; ai < 2; ++ai)
#pragma unroll
                    for (int m = 0; m < 4; ++m) { float* p = fb + (size_t)(row0 + ai * HALF + m * 16) * 8; *(f32x4*)p = acc[ai][0][m][0]; *(f32x4*)(p + 4) = acc[ai][0][m][1]; }
            }
            return;
        }
        const float sc = (u.pn == 0 || u.pn == 1 || u.pn == 3 || u.pn == 4) ? C2 : 1.f;
        const int col0 = u.pn * BM + wc * 32 + 8 * fq;
#pragma unroll
        for (int ai = 0; ai < 2; ++ai)
#pragma unroll
            for (int m = 0; m < 4; ++m) { bf16_t* rowp = O + (size_t)(row0 + ai * HALF + m * 16) * NE_IN + col0;
#pragma unroll
                for (int bj = 0; bj < 2; ++bj) { const f32x4 v0 = acc[ai][bj][m][0] * sc, v1 = acc[ai][bj][m][1] * sc;
                    u32x4 w; w.x = cvt_pk_bf16(v0[0], v0[1]); w.y = cvt_pk_bf16(v0[2], v0[3]); w.z = cvt_pk_bf16(v1[0], v1[1]); w.w = cvt_pk_bf16(v1[2], v1[3]);
                    *(u32x4*)(rowp + bj * HALF) = w; } }
    }
};
struct EpiProjOdd {
    static constexpr bool PERM = true;
    bf16_t* O; float* dtg;
    __device__ __forceinline__ void operator()(const f32x4 (&acc)[2][2][4][2], const Unit& u, int wr, int wc, int fr, int fq) const {
        const int row0 = u.pm * BM + wr * 64 + fr;
        if (u.pn == 22) {
            if (wc == 0) {
#pragma unroll
                for (int ai = 0; ai < 2; ++ai)
#pragma unroll
                    for (int m = 0; m < 4; ++m) { float* p = dtg + (size_t)(row0 + ai * HALF + m * 16) * 32 + 8 * fq; *(f32x4*)p = acc[ai][0][m][0]; *(f32x4*)(p + 4) = acc[ai][0][m][1]; }
            }
            return;
        }
        const int col0 = u.pn * BM + wc * 32 + 8 * fq;
#pragma unroll
        for (int ai = 0; ai < 2; ++ai)
#pragma unroll
            for (int m = 0; m < 4; ++m) { bf16_t* rowp = O + (size_t)(row0 + ai * HALF + m * 16) * NO_IN + col0;
#pragma unroll
                for (int bj = 0; bj < 2; ++bj) { const f32x4 v0 = acc[ai][bj][m][0], v1 = acc[ai][bj][m][1];
                    u32x4 w; w.x = cvt_pk_bf16(v0[0], v0[1]); w.y = cvt_pk_bf16(v0[2], v0[3]); w.z = cvt_pk_bf16(v1[0], v1[1]); w.w = cvt_pk_bf16(v1[2], v1[3]);
                    *(u32x4*)(rowp + bj * HALF) = w; } }
    }
};
struct EpiResid {
    static constexpr bool PERM = false;
    const float* base; float* out;
    __device__ __forceinline__ void operator()(const f32x4 (&acc)[2][2][4][2], const Unit& u, int wr, int wc, int fr, int fq) const {
        const int col0 = u.pn * BM + wc * 32 + 4 * fq;
#pragma unroll
        for (int ai = 0; ai < 2; ++ai)
#pragma unroll
            for (int m = 0; m < 4; ++m) { const size_t off = (size_t)(u.pm * BM + ai * HALF + wr * 64 + m * 16 + fr) * DM + col0;
#pragma unroll
                for (int bj = 0; bj < 2; ++bj)
#pragma unroll
                    for (int n = 0; n < 2; ++n) { const f32x4 bs = *(const f32x4*)(base + off + bj * HALF + n * 16); *(f32x4*)(out + off + bj * HALF + n * 16) = bs + acc[ai][bj][m][n]; } }
    }
};
template <bool BASE_F32> struct EpiResidB {
    static constexpr bool PERM = true;
    const void* base; bf16_t* out;
    __device__ __forceinline__ void operator()(const f32x4 (&acc)[2][2][4][2], const Unit& u, int wr, int wc, int fr, int fq) const {
        const int row0 = u.pm * BM + wr * 64 + fr, col0 = u.pn * BM + wc * 32 + 8 * fq;
#pragma unroll
        for (int ai = 0; ai < 2; ++ai) {
            f32x4 bf[4][2][2]; u32x4 bb[4][2];
#pragma unroll
            for (int m = 0; m < 4; ++m) { const size_t ro = (size_t)(row0 + ai * HALF + m * 16) * DM + col0;
#pragma unroll
                for (int bj = 0; bj < 2; ++bj) {
                    if (BASE_F32) { const float* bp = (const float*)base + ro + bj * HALF; bf[m][bj][0] = __builtin_nontemporal_load((const f32x4*)bp); bf[m][bj][1] = __builtin_nontemporal_load((const f32x4*)(bp + 4)); }
                    else bb[m][bj] = *(const u32x4*)((const bf16_t*)base + ro + bj * HALF); } }
#pragma unroll
            for (int m = 0; m < 4; ++m) { const size_t ro = (size_t)(row0 + ai * HALF + m * 16) * DM + col0;
#pragma unroll
                for (int bj = 0; bj < 2; ++bj) { f32x4 v0 = acc[ai][bj][m][0], v1 = acc[ai][bj][m][1];
                    if (BASE_F32) { v0 += bf[m][bj][0]; v1 += bf[m][bj][1]; }
                    else { const u32x4 q = bb[m][bj];
                        v0[0] += __uint_as_float(q.x << 16); v0[1] += __uint_as_float(q.x & 0xffff0000u); v0[2] += __uint_as_float(q.y << 16); v0[3] += __uint_as_float(q.y & 0xffff0000u);
                        v1[0] += __uint_as_float(q.z << 16); v1[1] += __uint_as_float(q.z & 0xffff0000u); v1[2] += __uint_as_float(q.w << 16); v1[3] += __uint_as_float(q.w & 0xffff0000u); }
                    u32x4 w; w.x = cvt_pk_bf16(v0[0], v0[1]); w.y = cvt_pk_bf16(v0[2], v0[3]); w.z = cvt_pk_bf16(v1[0], v1[1]); w.w = cvt_pk_bf16(v1[2], v1[3]);
                    *(u32x4*)(out + ro + bj * HALF) = w; } }
        }
    }
};
struct EpiGateUp {
    static constexpr bool PERM = false;
    bf16_t* H;
    __device__ __forceinline__ void operator()(const f32x4 (&acc)[2][2][4][2], const Unit& u, int wr, int wc, int fr, int fq) const {
#pragma unroll
        for (int ai = 0; ai < 2; ++ai)
#pragma unroll
            for (int m = 0; m < 4; ++m) { bf16_t* rowp = H + (size_t)(u.pm * BM + ai * HALF + wr * 64 + m * 16 + fr) * 512;
#pragma unroll
                for (int bj = 0; bj < 2; ++bj) { const int j0 = (u.pn * 8 + bj * 4 + wc) * 16 + 4 * fq; const f32x4 g = acc[ai][bj][m][0], up = acc[ai][bj][m][1];
                    u32x2 w; w.x = cvt_pk_bf16(siluf(g[0]) * up[0], siluf(g[1]) * up[1]); w.y = cvt_pk_bf16(siluf(g[2]) * up[2], siluf(g[3]) * up[3]);
                    *(u32x2*)(rowp + j0) = w; } }
    }
};
struct EpiDown {
    static constexpr bool PERM = true;
    bf16_t* Y; const int* lists; const float* gates; const volatile LAS int* cnt;
    __device__ __forceinline__ void operator()(const f32x4 (&acc)[2][2][4][2], const Unit& u, int wr, int wc, int fr, int fq) const {
        const int n = cnt[u.e], last = n - 1; const int col0 = u.pn * BM + wc * 32 + 8 * fq; const int* lp = lists + u.e * CAP; const int rb = u.j * BM + wr * 64 + fr;
        int av[2][4]; float gv[2][4];
#pragma unroll
        for (int ai = 0; ai < 2; ++ai)
#pragma unroll
            for (int m = 0; m < 4; ++m) { const int ri = rb + ai * HALF + m * 16; av[ai][m] = lp[ri < last ? ri : last]; }
#pragma unroll
        for (int ai = 0; ai < 2; ++ai)
#pragma unroll
            for (int m = 0; m < 4; ++m) gv[ai][m] = gates[av[ai][m]];
#pragma unroll
        for (int ai = 0; ai < 2; ++ai)
#pragma unroll
            for (int m = 0; m < 4; ++m) { const int ri = rb + ai * HALF + m * 16;
                if (ri < n) { const int a = av[ai][m]; const float g = gv[ai][m]; bf16_t* rowp = Y + ((size_t)(a & 1) * T + (a >> 1)) * DM + col0;
#pragma unroll
                    for (int bj = 0; bj < 2; ++bj) { const f32x4 v0 = acc[ai][bj][m][0] * g, v1 = acc[ai][bj][m][1] * g;
                        u32x4 w; w.x = cvt_pk_bf16(v0[0], v0[1]); w.y = cvt_pk_bf16(v0[2], v0[3]); w.z = cvt_pk_bf16(v1[0], v1[1]); w.w = cvt_pk_bf16(v1[2], v1[3]);
                        *(u32x4*)(rowp + bj * HALF) = w; } } }
    }
};

template <class Epi, class Sched, bool ALIGN_EPI>
__device__ __forceinline__ void gemm_phase(LAS unsigned char* lds, const Gemm g, const Sched& S, const Epi& E) {
    const int tid = threadIdx.x, wid = __builtin_amdgcn_readfirstlane(tid >> 6), lane = tid & 63, wr = wid >> 2, wc = wid & 3, fr = lane & 15, fq = lane >> 4;
    const int K = g.K, nt = K / BK;
    int RA[2]; unsigned cbA[2], voffB[2];
#pragma unroll
    for (int i = 0; i < 2; ++i) { int R, C; stage_rc(tid * 16 + i * 8192, R, C); const int Rb = Epi::PERM ? ((R & ~31) + perm32(R & 31)) : R;
        RA[i] = R; cbA[i] = (unsigned)C * 2u; voffB[i] = (unsigned)(Rb * K + C) * 2u; }
    const unsigned kstep = (unsigned)(BK * 2);
    const size_t hstep = (size_t)HALF * K * 2;
    const size_t tstep = 2 * hstep;
    const unsigned rowb = (unsigned)K * 2u;
    const unsigned ldsw = (unsigned)wid * 1024u;
    const int aoff = lds_byte(wr * 64 + fr, fq * 8), boff = lds_byte(wc * 32 + fr, fq * 8);
    const char* Ab = (const char*)g.A;
#define PG8_SA(b, h) (((b) * 2 + (h)) * HTB)
#define PG8_SB(b, h) ((4 + (b) * 2 + (h)) * HTB)
#define PG8_STAGE(bufoff, gbase, voff) do { _Pragma("unroll") for (int _i = 0; _i < 2; ++_i) \
        __builtin_amdgcn_global_load_lds((const unsigned*)((const char*)(gbase) + (voff)[_i]), (LAS unsigned*)(lds + (bufoff) + ldsw + _i * 8192), 16, 0, 0); } while (0)
#define PG8_STAGE_A(bufoff, kb, o0, o1) do { \
        __builtin_amdgcn_global_load_lds((const unsigned*)(Ab + (kb) + (o0)), (LAS unsigned*)(lds + (bufoff) + ldsw), 16, 0, 0); \
        __builtin_amdgcn_global_load_lds((const unsigned*)(Ab + (kb) + (o1)), (LAS unsigned*)(lds + (bufoff) + ldsw + 8192), 16, 0, 0); } while (0)
#define PG8_LDA(dst, b, h) do { _Pragma("unroll") for (int m = 0; m < 4; ++m) _Pragma("unroll") for (int k = 0; k < 2; ++k) dst[m][k] = *(const LAS bf16x8*)(lds + PG8_SA(b, h) + aoff + m * 2048 + k * 1024); } while (0)
#define PG8_LDB(dst, b, h) do { _Pragma("unroll") for (int n = 0; n < 2; ++n) _Pragma("unroll") for (int k = 0; k < 2; ++k) dst[n][k] = *(const LAS bf16x8*)(lds + PG8_SB(b, h) + boff + n * 2048 + k * 1024); } while (0)
#define PG8_MMA(ai, bj, At, Bt) do { __builtin_amdgcn_s_setprio(1); _Pragma("unroll") for (int m = 0; m < 4; ++m) _Pragma("unroll") for (int n = 0; n < 2; ++n) _Pragma("unroll") for (int k = 0; k < 2; ++k) \
        acc[ai][bj][m][n] = __builtin_amdgcn_mfma_f32_16x16x32_bf16(Bt[n][k], At[m][k], acc[ai][bj][m][n], 0, 0, 0); __builtin_amdgcn_s_setprio(0); } while (0)
#define PG8_WAIT_V(n) asm volatile("s_waitcnt vmcnt(" #n ")" ::: "memory")
#define PG8_WAIT_L(n) asm volatile("s_waitcnt lgkmcnt(" #n ")" ::: "memory")
#define PG8_BAR __builtin_amdgcn_s_barrier()
#define PG8_SCHED __builtin_amdgcn_sched_barrier(0)
    Unit cur, nxt; int ui = 0;
    if (!S.next(0, cur)) return;
    f32x4 acc[2][2][4][2];
#pragma unroll
    for (int a = 0; a < 2; ++a)
#pragma unroll
        for (int b = 0; b < 2; ++b)
#pragma unroll
            for (int m = 0; m < 4; ++m)
#pragma unroll
                for (int n = 0; n < 2; ++n) acc[a][b][m][n] = (f32x4){0.f, 0.f, 0.f, 0.f};
    bf16x8 At[4][2], B0[2][2], B1[2][2];
    unsigned oC00, oC01, oC10, oC11;
    { unsigned ar[4]; S.arow4(cur, RA[0], RA[1], ar); oC00 = ar[0] * rowb + cbA[0]; oC01 = ar[1] * rowb + cbA[1]; oC10 = ar[2] * rowb + cbA[0]; oC11 = ar[3] * rowb + cbA[1]; }
    const char* cB = (const char*)g.Bt + (size_t)cur.e * g.b_estride + (size_t)cur.pn * tstep;
    PG8_STAGE(PG8_SB(0, 0), cB, voffB); PG8_STAGE(PG8_SB(0, 1), cB + hstep, voffB); PG8_STAGE_A(PG8_SA(0, 0), 0u, oC00, oC01); PG8_STAGE_A(PG8_SA(0, 1), 0u, oC10, oC11);
    if (wr == 1) PG8_BAR;
    PG8_WAIT_V(2); PG8_BAR;
    PG8_STAGE(PG8_SB(1, 0), cB + kstep, voffB); PG8_STAGE_A(PG8_SA(1, 0), kstep, oC00, oC01); PG8_STAGE(PG8_SB(1, 1), cB + hstep + kstep, voffB);
    PG8_WAIT_V(6); PG8_BAR;
    for (;;) {
        const bool has_next = S.next(ui + 1, nxt);
        unsigned oN00 = oC00, oN01 = oC01, oN10 = oC10, oN11 = oC11;
        if (has_next) { unsigned ar[4]; S.arow4(nxt, RA[0], RA[1], ar); oN00 = ar[0] * rowb + cbA[0]; oN01 = ar[1] * rowb + cbA[1]; oN10 = ar[2] * rowb + cbA[0]; oN11 = ar[3] * rowb + cbA[1]; }
        const char* nB = has_next ? (const char*)g.Bt + (size_t)nxt.e * g.b_estride + (size_t)nxt.pn * tstep : cB;
        for (int t = 0; t < nt; t += 2) {
            const bool last = (t == nt - 2);
            const unsigned k1 = (unsigned)(t + 1) * kstep;
            const unsigned k2 = last ? 0u : (unsigned)(t + 2) * kstep, k3 = k2 + kstep;
            const unsigned o00 = last ? oN00 : oC00, o01 = last ? oN01 : oC01, o10 = last ? oN10 : oC10, o11 = last ? oN11 : oC11;
            const char* b2 = last ? nB : cB + (size_t)(t + 2) * kstep; const char* b3 = b2 + kstep;
            PG8_LDB(B0, 0, 0); PG8_LDB(B1, 0, 1); PG8_SCHED; PG8_LDA(At, 0, 0); PG8_STAGE_A(PG8_SA(1, 1), k1, oC10, oC11);
            PG8_WAIT_V(8); PG8_WAIT_L(0); PG8_BAR; PG8_MMA(0, 0, At, B0); PG8_MMA(0, 1, At, B1); PG8_BAR; PG8_SCHED;
            PG8_LDA(At, 0, 1); PG8_STAGE(PG8_SB(0, 0), b2, voffB); PG8_STAGE(PG8_SB(0, 1), b2 + hstep, voffB); PG8_STAGE_A(PG8_SA(0, 0), k2, o00, o01);
            PG8_WAIT_V(8); PG8_WAIT_L(0); PG8_BAR; PG8_MMA(1, 0, At, B0); PG8_MMA(1, 1, At, B1); PG8_BAR; PG8_SCHED;
            PG8_LDB(B0, 1, 0); PG8_LDB(B1, 1, 1); PG8_SCHED; PG8_LDA(At, 1, 0); PG8_STAGE_A(PG8_SA(0, 1), k2, o10, o11);
            PG8_WAIT_V(8); PG8_WAIT_L(0); PG8_BAR; PG8_MMA(0, 0, At, B0); PG8_MMA(0, 1, At, B1); PG8_BAR; PG8_SCHED;
            PG8_LDA(At, 1, 1); PG8_STAGE(PG8_SB(1, 0), b3, voffB); PG8_STAGE(PG8_SB(1, 1), b3 + hstep, voffB); PG8_STAGE_A(PG8_SA(1, 0), k3, o00, o01);
            PG8_WAIT_V(8); PG8_WAIT_L(0); PG8_BAR; PG8_MMA(1, 0, At, B0); PG8_MMA(1, 1, At, B1); PG8_BAR; PG8_SCHED;
        }
        if constexpr (ALIGN_EPI) { if (wr == 0) PG8_BAR; }
        E(acc, cur, wr, wc, fr, fq);
        if (!has_next) break;
#pragma unroll
        for (int a = 0; a < 2; ++a)
#pragma unroll
            for (int b = 0; b < 2; ++b)
#pragma unroll
                for (int m = 0; m < 4; ++m)
#pragma unroll
                    for (int n = 0; n < 2; ++n) acc[a][b][m][n] = (f32x4){0.f, 0.f, 0.f, 0.f};
        cur = nxt; cB = nB; oC00 = oN00; oC01 = oN01; oC10 = oN10; oC11 = oN11; ++ui;
        if constexpr (ALIGN_EPI) { if (wr == 1) PG8_BAR; }
    }
    PG8_WAIT_V(0);
    if constexpr (!ALIGN_EPI) { if (wr == 0) PG8_BAR; }
    PG8_BAR;
#undef PG8_SA
#undef PG8_SB
#undef PG8_STAGE
#undef PG8_STAGE_A
#undef PG8_LDA
#undef PG8_LDB
#undef PG8_MMA
#undef PG8_WAIT_V
#undef PG8_WAIT_L
#undef PG8_BAR
#undef PG8_SCHED
}
}
}
namespace att {
using namespace mk;
constexpr int KVBLK = 64;
constexpr int A_K = 0, A_V = 32768, A_WS = 65536, A_OST = A_WS + NWAVES * 256, A_BIAS = A_OST + NWAVES * 4096, A_SCAN = A_BIAS + 8192, A_BYTES = A_SCAN + 64;
static_assert(A_BYTES <= RING_BYTES, "attention LDS");
__device__ __forceinline__ int crow(int r, int hi) { return (r & 3) + 8 * (r >> 2) + 4 * hi; }
__device__ __forceinline__ void glds16(const void* gsrc, unsigned lds_dst) { unsigned keep;
    asm volatile("s_mov_b32 %0, m0\n\ts_mov_b32 m0, %2\n\ts_nop 0\n\tglobal_load_lds_dwordx4 %1, off\n\ts_mov_b32 m0, %0" : "=&s"(keep) : "v"(gsrc), "s"(lds_dst) : "memory"); }
__device__ __forceinline__ unsigned cvtpk(float lo, float hi) { return cvt_pk_bf16(lo, hi); }
__device__ __forceinline__ void qkt(f32x16& p0, f32x16& p1, const LAS char* Kslot, const bf16x8* qr, int r32, int hi) {
    const LAS char* kb = Kslot + hi * 1024 + r32 * 16;
    const f32x16 z = {};
#pragma unroll
    for (int d0 = 0; d0 < 4; ++d0) {
        const bf16x8 b0 = *(const LAS bf16x8*)(kb + d0 * 2048);
        const bf16x8 b1 = *(const LAS bf16x8*)(kb + d0 * 2048 + 512);
        if (d0 == 0) { p0 = __builtin_amdgcn_mfma_f32_32x32x16_bf16(b0, qr[0], z, 0, 0, 0); p1 = __builtin_amdgcn_mfma_f32_32x32x16_bf16(b1, qr[0], z, 0, 0, 0); }
        else { p0 = __builtin_amdgcn_mfma_f32_32x32x16_bf16(b0, qr[d0], p0, 0, 0, 0); p1 = __builtin_amdgcn_mfma_f32_32x32x16_bf16(b1, qr[d0], p1, 0, 0, 0); } }
}
__device__ __forceinline__ void pv(f32x16* o, int vb, bf16x8 pa0, bf16x8 pa1, bf16x8 pa2, bf16x8 pa3) {
#pragma unroll
    for (int d0 = 0; d0 < 2; ++d0) { s16x4 lo[4], hi[4];
#pragma unroll
        for (int ks = 0; ks < 4; ++ks) {
            asm volatile("ds_read_b64_tr_b16 %0,%1 offset:%c2" : "=&v"(lo[ks]) : "v"(vb), "i"(d0 * 4096 + ks * 1024) : "memory");
            asm volatile("ds_read_b64_tr_b16 %0,%1 offset:%c2" : "=&v"(hi[ks]) : "v"(vb), "i"(d0 * 4096 + ks * 1024 + 512) : "memory"); }
        asm volatile("s_waitcnt lgkmcnt(0)" ::: "memory"); __builtin_amdgcn_sched_barrier(0);
#define PK(k) (bf16x8){lo[k][0], lo[k][1], lo[k][2], lo[k][3], hi[k][0], hi[k][1], hi[k][2], hi[k][3]}
        o[d0] = __builtin_amdgcn_mfma_f32_32x32x16_bf16(pa0, PK(0), o[d0], 0, 0, 0);
        o[d0] = __builtin_amdgcn_mfma_f32_32x32x16_bf16(pa1, PK(1), o[d0], 0, 0, 0);
        o[d0] = __builtin_amdgcn_mfma_f32_32x32x16_bf16(pa2, PK(2), o[d0], 0, 0, 0);
        o[d0] = __builtin_amdgcn_mfma_f32_32x32x16_bf16(pa3, PK(3), o[d0], 0, 0, 0);
#undef PK
    }
}
__device__ __forceinline__ float rowmax32(const f32x16& p0, const f32x16& p1) {
    float a = fmaxf(p0[0], p1[0]);
#pragma unroll
    for (int r = 1; r < 16; ++r) a = fmaxf(a, fmaxf(p0[r], p1[r]));
    auto rr = __builtin_amdgcn_permlane32_swap(__float_as_uint(a), __float_as_uint(a), false, false);
    return fmaxf(__uint_as_float(rr[0]), __uint_as_float(rr[1]));
}
#define A_WAIT_BAR(N) asm volatile("s_waitcnt vmcnt(" #N ") lgkmcnt(0)\n\ts_barrier" ::: "memory")

template <bool SWA>
__device__ __forceinline__ void attn_tiles(LAS char* shm, const bf16_t* Qw, int qpitch, const bf16_t* Kh, const bf16_t* Vh, int kvpitch, bf16_t* Ow, int opitch,
                                           int kt0, int ntile, int qpos0, float sl2, float sink2) {
    const int tid = threadIdx.x, lane = tid & 63, r32 = lane & 31, hi = lane >> 5; const int wid = __builtin_amdgcn_readfirstlane(tid >> 6);
    const unsigned lds0 = (unsigned)(uintptr_t)shm;
    LAS float* wsf = (LAS float*)(shm + A_WS) + wid * 64;
    const LAS float* biasl = (const LAS float*)(shm + A_BIAS);
    const bf16_t* ksrc = Kh + (long)lane * kvpitch + wid * 8;
    const bf16_t* vsrc = Vh + (long)(16 * (wid & 3) + (lane >> 2)) * kvpitch + (wid >> 2) * 32 + (lane & 3) * 8;
    const unsigned kdst = lds0 + A_K + wid * 1024, vdst = lds0 + A_V + wid * 1024;
#define DMA_K(t, slot) glds16(ksrc + (long)(t) * KVBLK * kvpitch, (unsigned)__builtin_amdgcn_readfirstlane(kdst + (slot)))
#define DMA_V(t, slot) glds16(vsrc + (long)(t) * KVBLK * kvpitch, (unsigned)__builtin_amdgcn_readfirstlane(vdst + (slot)))
    const int vb0 = (int)(lds0 + A_V) + ((lane >> 4) & 1) * 32 + (lane & 3) * 8 + (4 * hi + ((lane & 15) >> 2)) * 64;
    DMA_K(kt0, 0); DMA_V(kt0, 0);
    if (ntile > 1) { DMA_K(kt0 + 1, 8192); DMA_V(kt0 + 1, 8192); }
    if (ntile > 2) { DMA_K(kt0 + 2, 16384); DMA_V(kt0 + 2, 16384); }
    bf16x8 qr[4];
#pragma unroll
    for (int d0 = 0; d0 < 4; ++d0) qr[d0] = *(const bf16x8*)(Qw + (long)r32 * qpitch + d0 * 16 + hi * 8);
    float m = SWA ? sink2 : -INFINITY, l = (SWA && hi == 0) ? 1.f : 0.f;
    f32x16 o[2]; o[0] = f32x16{}; o[1] = f32x16{};
    const int qpos = qpos0 + r32;
    if (ntile > 2) { A_WAIT_BAR(4); } else if (ntile > 1) { A_WAIT_BAR(2); } else { A_WAIT_BAR(0); }
    f32x16 p0, p1;
    qkt(p0, p1, shm + A_K, qr, r32, hi);
    for (int it = 0; it < ntile; ++it) {
        const int kt = kt0 + it, slot = (it & 3) * 8192;
        f32x16 n0, n1;
        if (it + 1 < ntile) {
            if (it + 2 < ntile) { A_WAIT_BAR(2); } else { A_WAIT_BAR(0); }
            if (it + 3 < ntile) { DMA_K(kt + 3, ((it + 3) & 3) * 8192); DMA_V(kt + 3, ((it + 3) & 3) * 8192); }
            qkt(n0, n1, shm + A_K + ((it + 1) & 3) * 8192, qr, r32, hi);
        }
        const int kb = kt * 64 + 4 * hi;
        if (SWA) {
#pragma unroll
            for (int r = 0; r < 16; ++r) { const int k0 = kb + (r & 3) + 8 * (r >> 2), k1 = k0 + 32;
                p0[r] = (k0 <= qpos && k0 >= qpos - 127) ? p0[r] + sl2 * (float)(k0 - qpos) : -INFINITY;
                p1[r] = (k1 <= qpos && k1 >= qpos - 127) ? p1[r] + sl2 * (float)(k1 - qpos) : -INFINITY; }
        } else {
#pragma unroll
            for (int g = 0; g < 4; ++g) { const f32x4 b0 = *(const LAS f32x4*)(biasl + kb + 8 * g), b1 = *(const LAS f32x4*)(biasl + kb + 32 + 8 * g);
#pragma unroll
                for (int i = 0; i < 4; ++i) { p0[4 * g + i] += b0[i]; p1[4 * g + i] += b1[i]; } }
            if (kt * 64 + 63 > qpos0) {
#pragma unroll
                for (int r = 0; r < 16; ++r) { const int k0 = kb + (r & 3) + 8 * (r >> 2); if (k0 > qpos) p0[r] = -INFINITY; if (k0 + 32 > qpos) p1[r] = -INFINITY; }
            }
        }
        const float rm = rowmax32(p0, p1), mn = fmaxf(m, rm), ms = (mn == -INFINITY) ? 0.f : mn;
        const float alpha = __builtin_amdgcn_exp2f(m - ms);
        float rs = 0.f;
#pragma unroll
        for (int r = 0; r < 16; ++r) { p0[r] = __builtin_amdgcn_exp2f(p0[r] - ms); p1[r] = __builtin_amdgcn_exp2f(p1[r] - ms); rs += p0[r] + p1[r]; }
        l = l * alpha + rs; m = mn;
        if (hi == 0) wsf[r32] = alpha;
        asm volatile("s_waitcnt lgkmcnt(0)" ::: "memory");
#pragma unroll
        for (int r = 0; r < 16; ++r) { const float a = wsf[crow(r, hi)]; o[0][r] *= a; o[1][r] *= a; }
        u32x4 pw0, pw1, pw2, pw3;
        pw0 = (u32x4){cvtpk(p0[0], p0[1]), cvtpk(p0[2], p0[3]), cvtpk(p0[4], p0[5]), cvtpk(p0[6], p0[7])};
        pw1 = (u32x4){cvtpk(p0[8], p0[9]), cvtpk(p0[10], p0[11]), cvtpk(p0[12], p0[13]), cvtpk(p0[14], p0[15])};
        pw2 = (u32x4){cvtpk(p1[0], p1[1]), cvtpk(p1[2], p1[3]), cvtpk(p1[4], p1[5]), cvtpk(p1[6], p1[7])};
        pw3 = (u32x4){cvtpk(p1[8], p1[9]), cvtpk(p1[10], p1[11]), cvtpk(p1[12], p1[13]), cvtpk(p1[14], p1[15])};
        pv(o, vb0 + slot, __builtin_bit_cast(bf16x8, pw0), __builtin_bit_cast(bf16x8, pw1), __builtin_bit_cast(bf16x8, pw2), __builtin_bit_cast(bf16x8, pw3));
        asm volatile("s_waitcnt lgkmcnt(0)" ::: "memory");
        if (it + 1 < ntile) { p0 = n0; p1 = n1; }
    }
    { auto rr = __builtin_amdgcn_permlane32_swap(__float_as_uint(l), __float_as_uint(l), false, false); l = __uint_as_float(rr[0]) + __uint_as_float(rr[1]); }
    if (hi == 0) wsf[32 + r32] = l;
    asm volatile("s_waitcnt lgkmcnt(0)" ::: "memory");
    LAS bf16_t* stg = (LAS bf16_t*)(shm + A_OST) + wid * 2048;
#pragma unroll
    for (int r = 0; r < 16; ++r) { const int orow = crow(r, hi); const float rl = 1.f / wsf[32 + orow];
#pragma unroll
        for (int d0 = 0; d0 < 2; ++d0) stg[orow * 64 + d0 * 32 + r32] = (bf16_t)(cvt_pk_bf16(o[d0][r] * rl, 0.f) & 0xffffu); }
    asm volatile("s_waitcnt lgkmcnt(0)" ::: "memory");
#pragma unroll
    for (int i = 0; i < 4; ++i) { const int row = i * 8 + (lane >> 3), ch = lane & 7; const u32x4 v = *(const LAS u32x4*)(stg + row * 64 + ch * 8); *(u32x4*)(Ow + (long)row * opitch + ch * 8) = v; }
    asm volatile("s_waitcnt vmcnt(0) lgkmcnt(0)\n\ts_barrier" ::: "memory");
#undef DMA_K
#undef DMA_V
}

__device__ __forceinline__ void fox_unit(LAS char* shm, int b, int h, int qb, const bf16_t* proj, const float* fb, float fbias_h, bf16_t* heads) {
    const int tid = threadIdx.x, lane = tid & 63; const int wid = __builtin_amdgcn_readfirstlane(tid >> 6);
    LAS float* biasl = (LAS float*)(shm + A_BIAS); LAS float* scan = (LAS float*)(shm + A_SCAN);
    const int kend = (qb + 1) * 256;
    float v[4]; float s = 0.f;
#pragma unroll
    for (int i = 0; i < 4; ++i) { const int p = tid * 4 + i; const float fv = fb[((size_t)b * SEQ + (p < kend ? p : kend - 1)) * 8 + h]; const float lf = p < kend ? log_sigmoid_fast(fv + fbias_h) : 0.f; s += lf; v[i] = s; }
    float w = s;
#pragma unroll
    for (int o = 1; o < 64; o <<= 1) { const float t = __shfl_up(w, o); if (lane >= o) w += t; }
    if (lane == 63) scan[wid] = w;
    asm volatile("s_waitcnt lgkmcnt(0)\n\ts_barrier" ::: "memory");
    float off = w - s;
    for (int k = 0; k < 8; ++k) if (k < wid) off += scan[k];
#pragma unroll
    for (int i = 0; i < 4; ++i) biasl[tid * 4 + i] = -(v[i] + off) * LOG2E;
    asm volatile("s_waitcnt lgkmcnt(0)\n\ts_barrier" ::: "memory");
    const size_t rowb = (size_t)b * SEQ; const int q0 = qb * 256 + wid * 32;
    attn_tiles<false>(shm, proj + (rowb + q0) * NE_IN + 768 + h * 64, NE_IN, proj + rowb * NE_IN + 1280 + h * 64, proj + rowb * NE_IN + 1792 + h * 64, NE_IN,
                      heads + (rowb + q0) * 1024 + 512 + h * 64, 1024, 0, 4 * (qb + 1), q0, 0.f, 0.f);
}
__device__ __forceinline__ void swa_unit(LAS char* shm, int b, int kvh, int blk, const bf16_t* proj, const float* sinks, bf16_t* heads) {
    const int wid = __builtin_amdgcn_readfirstlane(threadIdx.x >> 6);
    const int qh = kvh * 4 + (wid >> 1), q0 = blk * 64 + (wid & 1) * 32;
    const size_t rowb = (size_t)b * SEQ;
    const int kt0 = blk >= 2 ? blk - 2 : 0, ntile = blk - kt0 + 1;
    const float sl2 = exp2f(-(float)(qh + 1)) * LOG2E, sink2 = sinks[qh] * LOG2E;
    attn_tiles<true>(shm, proj + (rowb + q0) * NE_IN + qh * 64, NE_IN, proj + rowb * NE_IN + 512 + kvh * 64, proj + rowb * NE_IN + 640 + kvh * 64, NE_IN,
                     heads + (rowb + q0) * 1024 + qh * 64, 1024, kt0, ntile, q0, sl2, sink2);
}
#undef A_WAIT_BAR
}

namespace attp {
using bf16=__hip_bfloat16;
using bf16x8=__attribute__((ext_vector_type(8)))short;
using s16x4=__attribute__((ext_vector_type(4)))short;
using f32x16=__attribute__((ext_vector_type(16)))float;
using u32x4=__attribute__((ext_vector_type(4)))unsigned;
constexpr int BATCH=8,NHEAD=8,SEQ=2048,D=64,DM=2560,OPITCH=1024;
constexpr int NW=8,QBLK=32,QB=QBLK*NW,KVBLK=64,NQB=SEQ/QB;
constexpr int ATTN_PITCH=DM, ATTN_UNIT_ROWS=QB;
__device__ __forceinline__ int crow(int r,int hi){return (r&3)+8*(r>>2)+4*hi;}
#define SBAR() __builtin_amdgcn_sched_barrier(0)
__device__ __forceinline__ void cmask(f32x16&p0,f32x16&p1,int jb,int qrel,int hi){
  const float NEG=-INFINITY; int kb=64*jb+4*hi;
  #pragma unroll
  for(int r=0;r<16;++r){int kv=kb+(r&3)+8*(r>>2); if(kv>qrel)p0[r]=NEG; if(kv+32>qrel)p1[r]=NEG;}
}

constexpr int NSLOT=3, SLOTB=8192;
constexpr int LDS_K=0, LDS_V=NSLOT*SLOTB, LDS_WS=2*NSLOT*SLOTB, LDS_OST=LDS_WS+NW*64*4, LDS_BIAS=LDS_OST+NW*4096, LDS_SCAN=LDS_BIAS+8192, LDS_BYTES=LDS_SCAN+64;
constexpr float C2=0.125f*1.4426950408889634f;
__device__ __forceinline__ void glds16(const void*gsrc,unsigned lds_dst){unsigned keep;
  asm volatile("s_mov_b32 %0, m0\n\ts_mov_b32 m0, %2\n\ts_nop 0\n\tglobal_load_lds_dwordx4 %1, off\n\ts_mov_b32 m0, %0":"=&s"(keep):"v"(gsrc),"s"(lds_dst):"memory");}
__device__ __forceinline__ float max3f(float a,float b,float c){float r;asm("v_max3_f32 %0, %1, %2, %3":"=v"(r):"v"(a),"v"(b),"v"(c));return r;}
__device__ __forceinline__ float max2f(float a,float b){float r;asm("v_max_f32_e32 %0, %1, %2":"=v"(r):"v"(a),"v"(b));return r;}
__device__ __forceinline__ float fadd_s(float a,float b){float r;asm("v_add_f32_e32 %0, %1, %2":"=v"(r):"v"(a),"v"(b));return r;}
__device__ __forceinline__ float fsub_s(float a,float b){float r;asm("v_sub_f32_e32 %0, %1, %2":"=v"(r):"v"(a),"v"(b));return r;}
typedef float f32x2_t __attribute__((ext_vector_type(2))); typedef __bf16 bf16x2_t __attribute__((ext_vector_type(2)));
__device__ __forceinline__ unsigned cvtpk_s(float lo,float hi){f32x2_t v={lo,hi};bf16x2_t b=__builtin_convertvector(v,bf16x2_t);return __builtin_bit_cast(unsigned,b);}
#define WAIT_BAR(N) asm volatile("s_waitcnt vmcnt(" #N ") lgkmcnt(0)\n\ts_barrier":::"memory")

__device__ __forceinline__ void qkt(f32x16&p0,f32x16&p1,const char*Kslot,const bf16x8*qr,int r32,int hi){ const f32x16 zc_=f32x16{};
  const char*kb=Kslot+hi*1024+r32*16;
  #pragma unroll
  for(int d0=0;d0<4;++d0){
    const bf16x8 b0=*reinterpret_cast<const bf16x8*>(kb+d0*2048);
    const bf16x8 b1=*reinterpret_cast<const bf16x8*>(kb+d0*2048+512);
    if(d0==0){p0=__builtin_amdgcn_mfma_f32_32x32x16_bf16(b0,qr[0],zc_,0,0,0);p1=__builtin_amdgcn_mfma_f32_32x32x16_bf16(b1,qr[0],zc_,0,0,0);}
    else{p0=__builtin_amdgcn_mfma_f32_32x32x16_bf16(b0,qr[d0],p0,0,0,0);p1=__builtin_amdgcn_mfma_f32_32x32x16_bf16(b1,qr[d0],p1,0,0,0);}}
}
typedef __attribute__((address_space(3))) const char* lds_cptr;
typedef short v4i16_t __attribute__((ext_vector_type(4)));
__device__ __forceinline__ void kload8(bf16x8*kf,lds_cptr kp){
  kf[0]=*(const __attribute__((address_space(3))) bf16x8*)(kp);      kf[1]=*(const __attribute__((address_space(3))) bf16x8*)(kp+512);
  kf[2]=*(const __attribute__((address_space(3))) bf16x8*)(kp+2048); kf[3]=*(const __attribute__((address_space(3))) bf16x8*)(kp+2560);
  kf[4]=*(const __attribute__((address_space(3))) bf16x8*)(kp+4096); kf[5]=*(const __attribute__((address_space(3))) bf16x8*)(kp+4608);
  kf[6]=*(const __attribute__((address_space(3))) bf16x8*)(kp+6144); kf[7]=*(const __attribute__((address_space(3))) bf16x8*)(kp+6656);
}
__device__ __forceinline__ void kload2(bf16x8*kf,lds_cptr kp,int j){ kf[2*j]=*(const __attribute__((address_space(3))) bf16x8*)(kp+j*2048); kf[2*j+1]=*(const __attribute__((address_space(3))) bf16x8*)(kp+j*2048+512); }
__device__ __forceinline__ s16x4 vtr(lds_cptr p){ return __builtin_bit_cast(s16x4,__builtin_amdgcn_ds_read_tr16_b64_v4i16((__attribute__((address_space(3))) v4i16_t*)p)); }
__device__ __forceinline__ float rowmax(const f32x16&p0,const f32x16&p1){
  float a=max3f(p0[0],p0[1],p1[0]),b=max3f(p0[2],p0[3],p1[1]);a=max3f(a,p1[2],p1[3]);
  #pragma unroll
  for(int r=4;r<16;r+=4){a=max3f(a,p0[r],p0[r+1]);b=max3f(b,p0[r+2],p0[r+3]);a=max3f(a,p1[r],p1[r+1]);b=max3f(b,p1[r+2],p1[r+3]);}
  const float m=max2f(a,b);
  auto rr=__builtin_amdgcn_permlane32_swap(__float_as_uint(m),__float_as_uint(m),false,false);
  return max2f(__uint_as_float(rr[0]),__uint_as_float(rr[1]));
}
__device__ __forceinline__ void pv(f32x16*o,int vb,bf16x8 pa0,bf16x8 pa1,bf16x8 pa2,bf16x8 pa3){
  #pragma unroll
  for(int d0=0;d0<2;++d0){s16x4 lo[4],hi[4];
    #pragma unroll
    for(int ks=0;ks<4;++ks){
      asm volatile("ds_read_b64_tr_b16 %0,%1 offset:%c2":"=&v"(lo[ks]):"v"(vb),"i"(d0*4096+ks*1024):"memory");
      asm volatile("ds_read_b64_tr_b16 %0,%1 offset:%c2":"=&v"(hi[ks]):"v"(vb),"i"(d0*4096+ks*1024+512):"memory");}
    asm volatile("s_waitcnt lgkmcnt(0)":::"memory");SBAR();
    #define PK(k) (bf16x8){lo[k][0],lo[k][1],lo[k][2],lo[k][3],hi[k][0],hi[k][1],hi[k][2],hi[k][3]}
    o[d0]=__builtin_amdgcn_mfma_f32_32x32x16_bf16(pa0,PK(0),o[d0],0,0,0);
    o[d0]=__builtin_amdgcn_mfma_f32_32x32x16_bf16(pa1,PK(1),o[d0],0,0,0);
    o[d0]=__builtin_amdgcn_mfma_f32_32x32x16_bf16(pa2,PK(2),o[d0],0,0,0);
    o[d0]=__builtin_amdgcn_mfma_f32_32x32x16_bf16(pa3,PK(3),o[d0],0,0,0);
    #undef PK
  }
}

#ifndef ATTN_STORE16
#define ATTN_STORE16(p,v) (*(u32x4*)(p)=(v))
#endif
template<int THRL,bool CHECK> __device__ __forceinline__ void attn_unit(int b,int h,int qb,const bf16*Q,const bf16*__restrict__ K,const bf16*__restrict__ V,bf16*O,char*shm,unsigned*mism){
  const int tid=threadIdx.x,lane=tid&63,r32=lane&31,hi=lane>>5; const int wid=__builtin_amdgcn_readfirstlane(tid>>6);
  const long rowbase=(long)b*SEQ; const int q0=qb*QB;
  const bf16*Qw=Q+(rowbase+q0+wid*QBLK)*DM+h*D;
  const bf16*Kh=K+rowbase*DM+h*D,*Vh=V+rowbase*DM+h*D;
  const unsigned lds0=(unsigned)(uintptr_t)shm;
  float*wsf=(float*)(shm+LDS_WS)+wid*64;
  const bf16*ksrc=Kh+(long)lane*DM+wid*8;
  const bf16*vsrc=Vh+(long)(16*(wid&3)+(lane>>2))*DM+(wid>>2)*32+(lane&3)*8;
  const unsigned kdst=lds0+LDS_K+wid*1024, vdst=lds0+LDS_V+wid*1024;
  #define DMA_K(t,slot) glds16(ksrc+(long)(t)*KVBLK*DM,(unsigned)__builtin_amdgcn_readfirstlane(kdst+(slot)))
  #define DMA_V(t,slot) glds16(vsrc+(long)(t)*KVBLK*DM,(unsigned)__builtin_amdgcn_readfirstlane(vdst+(slot)))
  const int vb0=(int)(lds0+LDS_V)+((lane>>4)&1)*32+(lane&3)*8+(4*hi+((lane&15)>>2))*64;
  const char*Kbase=shm+LDS_K; bf16x8 kf[8];
  const lds_cptr shm3=(lds_cptr)shm; const lds_cptr kp0=shm3+LDS_K+hi*1024+r32*16; const lds_cptr vp0=shm3+LDS_V+((lane>>4)&1)*32+(lane&3)*8+(4*hi+((lane&15)>>2))*64;
  const int NT=(q0+QB)/KVBLK;
  DMA_K(0,0);DMA_V(0,0);DMA_K(1,SLOTB);
  bf16x8 qr[4];
  #pragma unroll
  for(int d0=0;d0<4;++d0)qr[d0]=*reinterpret_cast<const bf16x8*>(&Qw[(long)r32*DM+d0*16+hi*8]);
  float mhat=0.f,l_reg=0.f;f32x16 o[2];o[0]=f32x16{};o[1]=f32x16{};u32x4 qaw={hi==0?0x3f803f80u:0u,0u,0u,0u};
  const int qrel=wid*QBLK+r32;
  #define CMASK(P0,P1,t) do{int jb_=(t)-(NT-4); if(jb_>=0)cmask(P0,P1,jb_,qrel,hi);}while(0)
  const __attribute__((address_space(3))) unsigned* biasw=(const __attribute__((address_space(3))) unsigned*)(shm3+LDS_BIAS)+r32;
  #define SETM() do{ const float nm_=-mhat; const unsigned h_=cvtpk_s(nm_,0.f)&0xffffu; const unsigned l_=cvtpk_s(nm_-__uint_as_float(h_<<16),0.f)&0xffffu; qaw[1]=(hi==0)?(h_|(l_<<16)):0u; }while(0)
  #define AUG(P0,P1,t) do{ const unsigned w0_=biasw[64*(t)], w1_=biasw[64*(t)+32]; const u32x4 ka0_={w0_,0x3f803f80u,0u,0u}, ka1_={w1_,0x3f803f80u,0u,0u}; \
      P0=__builtin_amdgcn_mfma_f32_32x32x16_bf16(__builtin_bit_cast(bf16x8,ka0_),__builtin_bit_cast(bf16x8,qaw),P0,0,0,0); \
      P1=__builtin_amdgcn_mfma_f32_32x32x16_bf16(__builtin_bit_cast(bf16x8,ka1_),__builtin_bit_cast(bf16x8,qaw),P1,0,0,0); }while(0)
  bool resc=false;
  #define START(P0,P1) do{ const float rm=rowmax(P0,P1); resc=false; \
    { const float dl=rm; mhat=fadd_s(mhat,dl); \
      _Pragma("unroll") for(int r=0;r<16;++r){P0[r]=fsub_s(P0[r],dl);P1[r]=fsub_s(P1[r],dl);} \
      SETM(); } \
    _Pragma("unroll") for(int r=0;r<16;++r)P0[r]=__builtin_amdgcn_exp2f(P0[r]); }while(0)
  #define RESC() do{ if(resc){ asm volatile("s_waitcnt lgkmcnt(0)":::"memory"); \
      _Pragma("unroll") for(int d_=0;d_<2;++d_) _Pragma("unroll") for(int r=0;r<16;++r)o[d_][r]*=wsf[crow(r,hi)]; } }while(0)
  f32x16 pA0,pA1,pB0,pB1;
  int sl_prev=0,sl_cur=0,sl_next=SLOTB;
  #define ROT() do{sl_prev=sl_cur;sl_cur=sl_next;sl_next=(sl_next==(NSLOT-1)*SLOTB)?0:sl_next+SLOTB;}while(0)
  DMA_K(2,2*SLOTB);
  WAIT_BAR(3);
  qkt(pA0,pA1,Kbase,qr,r32,hi);AUG(pA0,pA1,0);asm volatile("s_nop 15\n\ts_nop 7":"+v"(pA0),"+v"(pA1));CMASK(pA0,pA1,0);
  START(pA0,pA1);
  _Pragma("unroll") for(int r=0;r<16;++r)pA1[r]=__builtin_amdgcn_exp2f(pA1[r]);
  WAIT_BAR(0);
  DMA_K(3,0);DMA_V(1,SLOTB);
  ROT();
  kload8(kf,kp0+sl_cur);
  WAIT_BAR(2);
  s16x4 vlo[8],vhi[8]; u32x4 pw0,pw1,pw2,pw3; const f32x16 zc16=f32x16{};
  #define PKW(P,B) cvtpk_s(P[B],P[B+1])
  #define PAF(k) __builtin_bit_cast(bf16x8,pw##k)
  #define VFR(i) (bf16x8){vlo[i][0],vlo[i][1],vlo[i][2],vlo[i][3],vhi[i][0],vhi[i][1],vhi[i][2],vhi[i][3]}
  #define PIN(x) asm volatile("":"+v"(x))
  #define MX3(a,b,c) __builtin_fmaxf(__builtin_fmaxf((a),(b)),(c))
  #define GAPA(MF,A0,A1,A2,A3,W0,W1,PW) do{ MF; sacc+=A0; sacc+=A1; sacc+=A2; sacc+=A3; PIN(sacc); W0; W1; PIN(PW); SBAR(); }while(0)
  #define EX(v) __builtin_amdgcn_exp2f(v)
  #define GAPB(MF,X,B) do{ MF; X[B]=EX(X[B]); X[B+1]=EX(X[B+1]); X[B+2]=EX(X[B+2]); X[B+3]=EX(X[B+3]); PIN(X); SBAR(); }while(0)
  #define VRD(i) do{ vlo[i]=vtr(vp_+(((i)>>2)*4096+((i)&3)*1024)); vhi[i]=vtr(vp_+(((i)>>2)*4096+((i)&3)*1024+512)); }while(0)
  #define KRD(G,j) do{ if(G){ kload2(kf,kp0+sl_next,j); SBAR(); } }while(0)
  #define STEP(C0,C1,P0,P1,t,GK,GV,GL) do{ SBAR(); \
    const lds_cptr vp_=vp0+sl_prev; \
    VRD(0); SBAR(); float sacc=(P0[0]+P0[1]); \
    GAPA(C0=__builtin_amdgcn_mfma_f32_32x32x16_bf16(kf[0],qr[0],zc16,0,0,0), P0[2],P0[3],P0[4],P0[5],     pw0[0]=PKW(P0,0), pw0[1]=PKW(P0,2), pw0); \
    VRD(4); SBAR(); GAPA(C1=__builtin_amdgcn_mfma_f32_32x32x16_bf16(kf[1],qr[0],zc16,0,0,0), P0[6],P0[7],P0[8],P0[9],     pw0[2]=PKW(P0,4), pw0[3]=PKW(P0,6), pw0); \
    VRD(1); SBAR(); GAPA(C0=__builtin_amdgcn_mfma_f32_32x32x16_bf16(kf[2],qr[1],C0,0,0,0),   P0[10],P0[11],P0[12],P0[13], pw1[0]=PKW(P0,8), pw1[1]=PKW(P0,10), pw1); \
    VRD(5); SBAR(); GAPA(C1=__builtin_amdgcn_mfma_f32_32x32x16_bf16(kf[3],qr[1],C1,0,0,0),   P0[14],P0[15],P1[0],P1[1],   pw1[2]=PKW(P0,12),pw1[3]=PKW(P0,14), pw1); \
    VRD(2); SBAR(); GAPA(C0=__builtin_amdgcn_mfma_f32_32x32x16_bf16(kf[4],qr[2],C0,0,0,0),   P1[2],P1[3],P1[4],P1[5],     pw2[0]=PKW(P1,0), pw2[1]=PKW(P1,2), pw2); \
    VRD(6); SBAR(); GAPA(C1=__builtin_amdgcn_mfma_f32_32x32x16_bf16(kf[5],qr[2],C1,0,0,0),   P1[6],P1[7],P1[8],P1[9],     pw2[2]=PKW(P1,4), pw2[3]=PKW(P1,6), pw2); \
    VRD(3); SBAR(); GAPA(C0=__builtin_amdgcn_mfma_f32_32x32x16_bf16(kf[6],qr[3],C0,0,0,0),   P1[10],P1[11],P1[12],P1[13], pw3[0]=PKW(P1,8), pw3[1]=PKW(P1,10), pw3); \
    VRD(7); SBAR(); GAPA(C1=__builtin_amdgcn_mfma_f32_32x32x16_bf16(kf[7],qr[3],C1,0,0,0),   P1[14],P1[15],0.f,0.f,       pw3[2]=PKW(P1,12),pw3[3]=PKW(P1,14), pw3); \
    AUG(C0,C1,t); l_reg+=sacc; \
    if(GK){DMA_K((t)+3,sl_cur);} if(GV){DMA_V((t)+1,sl_next);} \
    CMASK(C0,C1,t); \
    { float a=MX3(C0[0],C0[1],C1[0]),b=MX3(C0[2],C0[3],C1[1]); a=MX3(a,C1[2],C1[3]); \
      _Pragma("unroll") for(int r=4;r<16;r+=4){a=MX3(a,C0[r],C0[r+1]);b=MX3(b,C0[r+2],C0[r+3]);a=MX3(a,C1[r],C1[r+1]);b=MX3(b,C1[r+2],C1[r+3]);} \
      float rm=__builtin_fmaxf(a,b); { auto rr=__builtin_amdgcn_permlane32_swap(__float_as_uint(rm),__float_as_uint(rm),false,false); rm=__builtin_fmaxf(__uint_as_float(rr[0]),__uint_as_float(rr[1])); } \
      resc=false; \
      if(__builtin_expect(__any(rm>(float)THRL),0)){ const float dl=__builtin_fmaxf(rm,0.f); mhat+=dl; \
        _Pragma("unroll") for(int r=0;r<16;++r){C0[r]-=dl;C1[r]-=dl;} \
        SETM(); \
        const float f=__builtin_amdgcn_exp2f(-dl); l_reg*=f; if(hi==0)wsf[r32]=f; resc=true; } } \
    SBAR(); \
    GAPB(o[0]=__builtin_amdgcn_mfma_f32_32x32x16_bf16(PAF(0),VFR(0),o[0],0,0,0), C0,0); \
    GAPB(o[1]=__builtin_amdgcn_mfma_f32_32x32x16_bf16(PAF(0),VFR(4),o[1],0,0,0), C0,4); \
    KRD(GL,0); GAPB(o[0]=__builtin_amdgcn_mfma_f32_32x32x16_bf16(PAF(1),VFR(1),o[0],0,0,0), C0,8); \
    KRD(GL,1); GAPB(o[1]=__builtin_amdgcn_mfma_f32_32x32x16_bf16(PAF(1),VFR(5),o[1],0,0,0), C0,12); \
    KRD(GL,2); GAPB(o[0]=__builtin_amdgcn_mfma_f32_32x32x16_bf16(PAF(2),VFR(2),o[0],0,0,0), C1,0); \
    KRD(GL,3); GAPB(o[1]=__builtin_amdgcn_mfma_f32_32x32x16_bf16(PAF(2),VFR(6),o[1],0,0,0), C1,4); \
    GAPB(o[0]=__builtin_amdgcn_mfma_f32_32x32x16_bf16(PAF(3),VFR(3),o[0],0,0,0), C1,8); \
    GAPB(o[1]=__builtin_amdgcn_mfma_f32_32x32x16_bf16(PAF(3),VFR(7),o[1],0,0,0), C1,12); \
    }while(0)
  int t=1;
  #undef CMASK
  #define CMASK(P0,P1,t) do{}while(0)
  for(;t+5<NT;t+=2){
    STEP(pB0,pB1,pA0,pA1,t,true,true,true);     WAIT_BAR(2); RESC(); ROT();
    STEP(pA0,pA1,pB0,pB1,t+1,true,true,true);   WAIT_BAR(2); RESC(); ROT();
  }
  #undef CMASK
  #define CMASK(P0,P1,t) do{int jb_=(t)-(NT-4); if(jb_>=0)cmask(P0,P1,jb_,qrel,hi);}while(0)
  #define ENDW(tt) do{ if((tt)+3<NT){WAIT_BAR(2);} else if((tt)+2<NT){WAIT_BAR(1);} else {WAIT_BAR(0);} }while(0)
  for(;t+1<NT;t+=2){
    STEP(pB0,pB1,pA0,pA1,t,(t+3<NT),(t+1<NT),(t+1<NT));       ENDW(t);   RESC(); ROT();
    STEP(pA0,pA1,pB0,pB1,t+1,(t+4<NT),(t+2<NT),(t+2<NT));     ENDW(t+1); RESC(); ROT();
  }
  STEP(pB0,pB1,pA0,pA1,NT-1,false,false,false); RESC();
  { float sacc=pB0[0]+pB0[1]; _Pragma("unroll") for(int r=2;r<16;++r)sacc+=pB0[r]; _Pragma("unroll") for(int r=0;r<16;++r)sacc+=pB1[r]; l_reg+=sacc;
    pw0=(u32x4){PKW(pB0,0),PKW(pB0,2),PKW(pB0,4),PKW(pB0,6)};pw1=(u32x4){PKW(pB0,8),PKW(pB0,10),PKW(pB0,12),PKW(pB0,14)};pw2=(u32x4){PKW(pB1,0),PKW(pB1,2),PKW(pB1,4),PKW(pB1,6)};pw3=(u32x4){PKW(pB1,8),PKW(pB1,10),PKW(pB1,12),PKW(pB1,14)};
    SBAR(); pv(o,vb0+sl_cur,PAF(0),PAF(1),PAF(2),PAF(3)); }
  #undef PKW
  #undef PAF
  #undef VFR
  #undef PIN
  #undef MX3
  #undef GAPA
  #undef GAPB
  #undef EX
  #undef VRD
  #undef KRD
  #undef STEP
  #undef ENDW
  {auto rr=__builtin_amdgcn_permlane32_swap(__float_as_uint(l_reg),__float_as_uint(l_reg),false,false);l_reg=__uint_as_float(rr[0])+__uint_as_float(rr[1]);}
  if(hi==0)wsf[32+r32]=l_reg;asm volatile("s_waitcnt lgkmcnt(0)":::"memory");
  float rli[16];
  #pragma unroll
  for(int r=0;r<16;++r)rli[r]=__builtin_amdgcn_rcpf(wsf[32+crow(r,hi)]);
  bf16*Ow=O+(rowbase+q0+wid*QBLK)*OPITCH+h*D;
  { bf16*stg=(bf16*)(shm+LDS_OST)+wid*2048;
    #pragma unroll
    for(int r=0;r<16;++r){const int orow=crow(r,hi);
      #pragma unroll
      for(int d0=0;d0<2;++d0)stg[orow*64+d0*32+r32]=__float2bfloat16(o[d0][r]*rli[r]);}
    asm volatile("s_waitcnt lgkmcnt(0)":::"memory");
    #pragma unroll
    for(int i=0;i<4;++i){const int row=i*8+(lane>>3),ch=lane&7; const u32x4 v=*(const u32x4*)(stg+row*64+ch*8); ATTN_STORE16(Ow+(long)row*OPITCH+ch*8,v);} }
  asm volatile("s_waitcnt lgkmcnt(0)\n\ts_barrier":::"memory");
  #undef DMA_K
  #undef DMA_V
  #undef CMASK
  #undef AUG
  #undef SETM
  #undef START
  #undef RESC
  #undef ROT
}
constexpr int ATTN_LDS_BYTES=LDS_BYTES;
#undef SBAR
#undef WAIT_BAR
}

namespace att {
template <bool CHECK> __device__ __forceinline__ void fox_unit_p(char* shm_g, LAS char* shm, int b, int h, int qb, const bf16_t* proj, const float* fb, float fbias_h, bf16_t* heads, unsigned* mism, bool do_scan) {
    const int tid = threadIdx.x, lane = tid & 63; const int wid = __builtin_amdgcn_readfirstlane(tid >> 6);
    if (do_scan) {
    LAS unsigned* biasw = (LAS unsigned*)(shm + attp::LDS_BIAS); LAS float* scan = (LAS float*)(shm + attp::LDS_SCAN);
    const int kend = (qb + 1) * 256;
    float v[4]; float s = 0.f;
#pragma unroll
    for (int i = 0; i < 4; ++i) { const int p = tid * 4 + i; const float fv = fb[((size_t)b * SEQ + (p < kend ? p : kend - 1)) * 8 + h]; const float lf = p < kend ? log_sigmoid_fast(fv + fbias_h) : 0.f; s += lf; v[i] = s; }
    float w = s;
#pragma unroll
    for (int o = 1; o < 64; o <<= 1) { const float t = __shfl_up(w, o); if (lane >= o) w += t; }
    if (lane == 63) scan[wid] = w;
    asm volatile("s_waitcnt lgkmcnt(0)\n\ts_barrier" ::: "memory");
    float off = w - s;
    for (int k = 0; k < 8; ++k) if (k < wid) off += scan[k];
#pragma unroll
    for (int i = 0; i < 4; ++i) { const float bv = -(v[i] + off) * LOG2E; const unsigned hb = cvt_pk_bf16(bv, 0.f) & 0xffffu; const unsigned lb = cvt_pk_bf16(bv - __uint_as_float(hb << 16), 0.f) & 0xffffu; biasw[tid * 4 + i] = hb | (lb << 16); }
    asm volatile("s_waitcnt vmcnt(0) lgkmcnt(0)\n\ts_barrier" ::: "memory");
    }
    attp::attn_unit<8, CHECK>(b, h, qb, (const attp::bf16*)(proj + 768), (const attp::bf16*)(proj + 1280), (const attp::bf16*)(proj + 1792), (attp::bf16*)(heads + 512), shm_g, mism);
    asm volatile("s_waitcnt vmcnt(0)" ::: "memory");
}
}
namespace mx {
using namespace mk;
constexpr size_t WS_QD = WS_XN, WS_KI = WS_XN + 16 * MiB, WS_DTV = 456 * MiB, WS_ACS = 457 * MiB, WS_KE = 458 * MiB, WS_DEC = 474 * MiB;
constexpr int XROW = 144;
__device__ __forceinline__ s16x4 tr_read(unsigned addr) { s16x4 r; asm volatile("ds_read_b64_tr_b16 %0, %1" : "=v"(r) : "v"(addr) : "memory"); return r; }
template <int OFF> __device__ __forceinline__ s16x4 tr_read_o(unsigned addr) { s16x4 r; asm volatile("ds_read_b64_tr_b16 %0, %1 offset:%2" : "=v"(r) : "v"(addr), "i"(OFF) : "memory"); return r; }
#define MX_LGKM0() do { asm volatile("s_waitcnt lgkmcnt(0)" ::: "memory"); __builtin_amdgcn_sched_barrier(0); } while (0)
#define MX_BAR() asm volatile("s_waitcnt vmcnt(0) lgkmcnt(0)\n\ts_barrier" ::: "memory")
#define MX_BAR_L() asm volatile("s_waitcnt lgkmcnt(0)\n\ts_barrier" ::: "memory")
__device__ __forceinline__ bf16x8 cat8(s16x4 lo, s16x4 hi) { return (bf16x8){lo[0], lo[1], lo[2], lo[3], hi[0], hi[1], hi[2], hi[3]}; }
__device__ __forceinline__ unsigned sw256(int row, int ch) { return (unsigned)(row * 256 + ((ch ^ (row & 15)) << 4)); }

__device__ __forceinline__ void prep_conv(const bf16_t* PROJ, bf16_t* CONV, const float* conv_w, const float* conv_b, int vcu, int G, int tid) {
    for (int item = vcu * NTHR + tid; item < (T / 8) * 192; item += G * NTHR) {
        const int cg = item % 192, rb = item / 192, ch0 = cg * 8, row0 = rb * 8, t0 = row0 & (SEQ - 1);
        float w[4][8], bs[8], xw[3][8];
#pragma unroll
        for (int j = 0; j < 4; ++j) { const f32x4 a = *(const f32x4*)(conv_w + j * 1536 + ch0), b = *(const f32x4*)(conv_w + j * 1536 + ch0 + 4);
#pragma unroll
            for (int i = 0; i < 4; ++i) { w[j][i] = a[i]; w[j][4 + i] = b[i]; } }
        { const f32x4 a = *(const f32x4*)(conv_b + ch0), b = *(const f32x4*)(conv_b + ch0 + 4);
#pragma unroll
          for (int i = 0; i < 4; ++i) { bs[i] = a[i]; bs[4 + i] = b[i]; } }
#pragma unroll
        for (int j = 0; j < 3; ++j) { const int tt = t0 - 3 + j;
            u32x4 v = {0u, 0u, 0u, 0u}; if (tt >= 0) v = *(const u32x4*)(PROJ + (size_t)(row0 - 3 + j) * NO_IN + 1024 + ch0);
#pragma unroll
            for (int i = 0; i < 4; ++i) { xw[j][2 * i] = __uint_as_float(v[i] << 16); xw[j][2 * i + 1] = __uint_as_float(v[i] & 0xffff0000u); } }
        u32x4 vr[8];
#pragma unroll
        for (int r = 0; r < 8; ++r) vr[r] = __builtin_nontemporal_load((const u32x4*)(PROJ + (size_t)(row0 + r) * NO_IN + 1024 + ch0));
#pragma unroll
        for (int r = 0; r < 8; ++r) {
            const u32x4 v = vr[r];
            float x3[8], o[8];
#pragma unroll
            for (int i = 0; i < 4; ++i) { x3[2 * i] = __uint_as_float(v[i] << 16); x3[2 * i + 1] = __uint_as_float(v[i] & 0xffff0000u); }
#pragma unroll
            for (int i = 0; i < 8; ++i) { const float a = bs[i] + w[0][i] * xw[0][i] + w[1][i] * xw[1][i] + w[2][i] * xw[2][i] + w[3][i] * x3[i]; o[i] = siluf(a);
                xw[0][i] = xw[1][i]; xw[1][i] = xw[2][i]; xw[2][i] = x3[i]; }
            u32x4 ov; ov.x = cvt_pk_bf16(o[0], o[1]); ov.y = cvt_pk_bf16(o[2], o[3]); ov.z = cvt_pk_bf16(o[4], o[5]); ov.w = cvt_pk_bf16(o[6], o[7]);
            *(u32x4*)(CONV + (size_t)(row0 + r) * 1536 + ch0) = ov;
        }
    }
}
__device__ __forceinline__ void prep_ssd(const float* DTG, float* DTV, float* ACS, const float* dt_bias, const float* a_log, int vcu, int G, int lane, int wave) {
    const int gw = vcu * NWAVES + wave, ngw = G * NWAVES;
    for (int item = gw; item < NBATCH * 32 * 16; item += ngw) {
        const int h = item & 15, c = (item >> 4) & 31, b = item >> 9; const size_t r0 = (size_t)b * SEQ + c * 64 + lane;
        const float a = -expf(a_log[h]), db = dt_bias[h];
        const float d0 = softplusf(DTG[r0 * 32 + h] + db);
        float w = a * d0;
#pragma unroll
        for (int o = 1; o < 64; o <<= 1) { const float t = __shfl_up(w, o); if (lane >= o) w += t; }
        ACS[r0 * 16 + h] = w; DTV[r0 * 16 + h] = d0;
    }
}
__device__ __forceinline__ void prep_gla(const bf16_t* PROJ, const float* DTG, bf16_t* QD, bf16_t* KI, bf16_t* KE, float* DEC, const float* gk_w, const float* gk_b, int vcu, int G, int tid, int lane, int wave, LAS char* shm) {
    {
        LAS float* gl = (LAS float*)(shm);
        LAS float* tot = (LAS float*)(shm + 8192);
        const int half = wave >> 2, rq = wave & 3, t256 = tid & 255;
        for (int pair = vcu; pair < NBATCH * 32 * 4 / 2; pair += G) {
            const int item = pair * 2 + half; const int h = item & 3, c = (item >> 2) & 31, b = item >> 7; const size_t r0 = (size_t)b * SEQ + c * 64;
            unsigned short qv[16][2], kv[16][2];
#pragma unroll
            for (int r = 0; r < 16; ++r) { const bf16_t* pr = PROJ + (r0 + rq * 16 + r) * NO_IN;
                qv[r][0] = pr[2560 + h * 128 + lane]; qv[r][1] = pr[2560 + h * 128 + 64 + lane]; kv[r][0] = pr[3072 + h * 128 + lane]; kv[r][1] = pr[3072 + h * 128 + 64 + lane]; }
            float w0[16], w1[16];
#pragma unroll
            for (int j = 0; j < 16; ++j) { w0[j] = gk_w[j * 512 + h * 128 + lane]; w1[j] = gk_w[j * 512 + h * 128 + 64 + lane]; }
            const float b0 = gk_b[h * 128 + lane], b1 = gk_b[h * 128 + 64 + lane];
            { const int rr = t256 >> 2, q4 = t256 & 3; *(LAS f32x4*)(gl + half * 1024 + rr * 16 + q4 * 4) = *(const f32x4*)(DTG + (r0 + rr) * 32 + 16 + q4 * 4); }
            asm volatile("s_waitcnt vmcnt(0) lgkmcnt(0)\n\ts_barrier" ::: "memory");
            float c0[16], c1[16]; float run0 = 0.f, run1 = 0.f;
#pragma unroll
            for (int r = 0; r < 16; ++r) {
                const LAS f32x4* gp = (const LAS f32x4*)(gl + half * 1024 + (rq * 16 + r) * 16); float a0 = b0, a1 = b1;
#pragma unroll
                for (int q = 0; q < 4; ++q) { const f32x4 g = gp[q];
#pragma unroll
                    for (int i = 0; i < 4; ++i) { a0 += g[i] * w0[4 * q + i]; a1 += g[i] * w1[4 * q + i]; } }
                run0 += log_sigmoid_fast(a0) * (1.f / 16.f); run1 += log_sigmoid_fast(a1) * (1.f / 16.f); c0[r] = run0; c1[r] = run1;
            }
            tot[(half * 4 + rq) * 128 + lane] = run0; tot[(half * 4 + rq) * 128 + 64 + lane] = run1;
            asm volatile("s_waitcnt lgkmcnt(0)\n\ts_barrier" ::: "memory");
            float pre0 = 0.f, pre1 = 0.f, last0 = 0.f, last1 = 0.f;
#pragma unroll
            for (int q = 0; q < 4; ++q) { const float t0 = tot[(half * 4 + q) * 128 + lane], t1 = tot[(half * 4 + q) * 128 + 64 + lane]; if (q < rq) { pre0 += t0; pre1 += t1; } last0 += t0; last1 += t1; }
            const float scale = 0.08838834764831845f;
#pragma unroll
            for (int r = 0; r < 16; ++r) {
                const float g0 = pre0 + c0[r], g1 = pre1 + c1[r];
                const float q0 = bf2f(qv[r][0]), q1 = bf2f(qv[r][1]), k0 = bf2f(kv[r][0]), k1 = bf2f(kv[r][1]);
                const size_t o = (r0 + rq * 16 + r) * 512 + h * 128 + lane;
                QD[o] = (bf16_t)(cvt_pk_bf16(q0 * scale * __expf(g0), 0.f) & 0xffffu); QD[o + 64] = (bf16_t)(cvt_pk_bf16(q1 * scale * __expf(g1), 0.f) & 0xffffu);
                KI[o] = (bf16_t)(cvt_pk_bf16(k0 * __expf(-g0), 0.f) & 0xffffu); KI[o + 64] = (bf16_t)(cvt_pk_bf16(k1 * __expf(-g1), 0.f) & 0xffffu);
            }
            if (rq == 0) { DEC[((size_t)b * 32 + c) * 512 + h * 128 + lane] = __expf(last0); DEC[((size_t)b * 32 + c) * 512 + h * 128 + 64 + lane] = __expf(last1); }
            asm volatile("s_waitcnt lgkmcnt(0)\n\ts_barrier" ::: "memory");
        }
    }
}

constexpr int S_C = 0, S_B = 32768, S_X = 65536, S_XW = S_X + 128 * XROW, S_PREV = S_XW + 128 * XROW, S_ACS = S_PREV + 16384, S_DT = S_ACS + 512, S_YST = S_DT + 512, S_END = S_YST + 8 * 2304;
static_assert(S_END <= RING_BYTES, "SSD LDS");
__device__ __forceinline__ void ssd_unit(LAS char* shm, int b, int h, const bf16_t* CONV, const float* ACS, const float* DTV, float dsk, bf16_t* MIX) {
    const int tid = threadIdx.x, lane = tid & 63, fr = lane & 15, fq = lane >> 4; const int w = __builtin_amdgcn_readfirstlane(tid >> 6);
    const int g = h >> 3, row = tid >> 2, qd = tid & 3, l0 = 16 * w;
    const unsigned lds0 = (unsigned)(uintptr_t)shm;
    LAS float* acsl = (LAS float*)(shm + S_ACS); LAS float* dtl = (LAS float*)(shm + S_DT);
    f32x4 st[4];
#pragma unroll
    for (int i = 0; i < 4; ++i) st[i] = (f32x4){0.f, 0.f, 0.f, 0.f};
    u32x4 rc[4], rb[4], rx[2]; float racs, rdt, rend;
    const size_t seq0 = (size_t)b * SEQ;
#define SSD_LOAD(c) do { const size_t gr = seq0 + (size_t)(c) * 128 + row; const bf16_t* p = CONV + gr * 1536; \
        _Pragma("unroll") for (int i = 0; i < 4; ++i) { rc[i] = *(const u32x4*)(p + 1280 + g * 128 + qd * 32 + 8 * i); rb[i] = *(const u32x4*)(p + 1024 + g * 128 + qd * 32 + 8 * i); } \
        _Pragma("unroll") for (int i = 0; i < 2; ++i) rx[i] = *(const u32x4*)(p + h * 64 + qd * 16 + 8 * i); \
        racs = ACS[gr * 16 + h]; rdt = DTV[gr * 16 + h]; rend = ACS[(seq0 + (size_t)(c) * 128 + 127) * 16 + h]; } while (0)
#ifdef SSD_DUMMY
    SSD_LOAD(0);
    for (int c = 0; c < 16; ++c) {
#pragma unroll
        for (int i = 0; i < 4; ++i) { *(LAS u32x4*)(shm + S_C + sw256(row, qd * 4 + i)) = rc[i]; *(LAS u32x4*)(shm + S_B + sw256(row, qd * 4 + i)) = rb[i]; }
        const float wr = rdt * __expf(rend - racs);
#pragma unroll
        for (int i = 0; i < 2; ++i) { *(LAS u32x4*)(shm + S_X + row * XROW + qd * 32 + 16 * i) = rx[i];
            u32x4 o;
#pragma unroll
            for (int k = 0; k < 4; ++k) o[k] = cvt_pk_bf16(__uint_as_float(rx[i][k] << 16) * wr, __uint_as_float(rx[i][k] & 0xffff0000u) * wr);
            *(LAS u32x4*)(shm + S_XW + row * XROW + qd * 32 + 16 * i) = o; }
        if (qd == 0) { acsl[row] = racs; dtl[row] = rdt; }
        MX_BAR_L();
        if (c + 1 < 16) SSD_LOAD(c + 1);
        MX_BAR_L();
    }
#endif
#ifndef SSD_NOPREF
    SSD_LOAD(0);
#endif
    const unsigned xtr = lds0 + (unsigned)(((lane & 15) >> 2) * XROW + (lane & 3) * 8);
    for (int c = 0; c < 16; ++c) {
#ifdef SSD_NOPREF
        SSD_LOAD(c);
#endif
#ifdef SSD_REP_WR
        for (int rep_ = 0; rep_ < 2; ++rep_)
#endif
        {
#pragma unroll
            for (int i = 0; i < 4; ++i) { *(LAS u32x4*)(shm + S_C + sw256(row, qd * 4 + i)) = rc[i]; *(LAS u32x4*)(shm + S_B + sw256(row, qd * 4 + i)) = rb[i]; }
            const float wr = rdt * __expf(rend - racs);
#pragma unroll
            for (int i = 0; i < 2; ++i) { *(LAS u32x4*)(shm + S_X + row * XROW + qd * 32 + 16 * i) = rx[i];
                u32x4 o;
#pragma unroll
                for (int k = 0; k < 4; ++k) o[k] = cvt_pk_bf16(__uint_as_float(rx[i][k] << 16) * wr, __uint_as_float(rx[i][k] & 0xffff0000u) * wr);
                *(LAS u32x4*)(shm + S_XW + row * XROW + qd * 32 + 16 * i) = o; }
            if (qd == 0) { acsl[row] = racs; dtl[row] = rdt; }
#pragma unroll
            for (int pt = 0; pt < 4; ++pt) { u32x2 v; v.x = cvt_pk_bf16(st[pt][0], st[pt][1]); v.y = cvt_pk_bf16(st[pt][2], st[pt][3]);
                const int p = 16 * pt + fr; *(LAS u32x2*)(shm + S_PREV + sw256(p, 2 * w + (fq >> 1)) + (fq & 1) * 8) = v; }
        }
        MX_BAR_L();
#ifndef SSD_NOPREF
        if (c + 1 < 16) SSD_LOAD(c + 1);
#endif
        bf16x8 cf[4];
#pragma unroll
        for (int ks = 0; ks < 4; ++ks) cf[ks] = *(const LAS bf16x8*)(shm + S_C + sw256(l0 + fr, 4 * ks + fq));
        f32x4 yd[4], yo[4];
#pragma unroll
        for (int i = 0; i < 4; ++i) { yd[i] = (f32x4){0.f, 0.f, 0.f, 0.f}; yo[i] = (f32x4){0.f, 0.f, 0.f, 0.f}; }
        const float acs_l = acsl[l0 + fr]; const int lcol = l0 + fr;
        const int nsb = (w >> 1) + 1;
#ifdef SSD_REP_SB
        for (int rep_ = 0; rep_ < 2; ++rep_) {
#pragma unroll
        for (int i = 0; i < 4; ++i) yd[i] = (f32x4){0.f, 0.f, 0.f, 0.f};
#endif
        for (int sb = 0; sb < nsb; ++sb) {
            const int s0 = 32 * sb; const bool two = (2 * sb + 1) <= w;
            s16x4 lo[4], hi[4];
#pragma unroll
            for (int pt = 0; pt < 4; ++pt) { lo[pt] = tr_read(xtr + S_X + (unsigned)((s0 + 4 * fq) * XROW + pt * 32)); hi[pt] = tr_read(xtr + S_X + (unsigned)((s0 + 16 + 4 * fq) * XROW + pt * 32)); }
            f32x4 a0 = {0.f, 0.f, 0.f, 0.f}, a1 = {0.f, 0.f, 0.f, 0.f};
#pragma unroll
            for (int ks = 0; ks < 4; ++ks) { const bf16x8 bf = *(const LAS bf16x8*)(shm + S_B + sw256(s0 + fr, 4 * ks + fq)); a0 = __builtin_amdgcn_mfma_f32_16x16x32_bf16(bf, cf[ks], a0, 0, 0, 0); }
            if (two) {
#pragma unroll
                for (int ks = 0; ks < 4; ++ks) { const bf16x8 bf = *(const LAS bf16x8*)(shm + S_B + sw256(s0 + 16 + fr, 4 * ks + fq)); a1 = __builtin_amdgcn_mfma_f32_16x16x32_bf16(bf, cf[ks], a1, 0, 0, 0); }
            }
            const f32x4 as0 = *(const LAS f32x4*)(acsl + s0 + 4 * fq), as1 = *(const LAS f32x4*)(acsl + s0 + 16 + 4 * fq);
            const f32x4 dq0 = *(const LAS f32x4*)(dtl + s0 + 4 * fq), dq1 = *(const LAS f32x4*)(dtl + s0 + 16 + 4 * fq);
            float g0[4], g1[4];
#pragma unroll
            for (int i = 0; i < 4; ++i) { const int sa = s0 + 4 * fq + i, sb2 = sa + 16;
                g0[i] = (sa <= lcol) ? a0[i] * __expf(fminf(acs_l - as0[i], 0.f)) * dq0[i] : 0.f;
                g1[i] = (two && sb2 <= lcol) ? a1[i] * __expf(fminf(acs_l - as1[i], 0.f)) * dq1[i] : 0.f; }
            u32x4 ap; ap.x = cvt_pk_bf16(g0[0], g0[1]); ap.y = cvt_pk_bf16(g0[2], g0[3]); ap.z = cvt_pk_bf16(g1[0], g1[1]); ap.w = cvt_pk_bf16(g1[2], g1[3]);
            const bf16x8 af = __builtin_bit_cast(bf16x8, ap);
            MX_LGKM0();
#pragma unroll
            for (int pt = 0; pt < 4; ++pt) yd[pt] = __builtin_amdgcn_mfma_f32_16x16x32_bf16(af, cat8(lo[pt], hi[pt]), yd[pt], 0, 0, 0);
        }
#ifdef SSD_REP_SB
        }
#endif
#ifdef SSD_REP_YO
        for (int rep_ = 0; rep_ < 2; ++rep_) {
#pragma unroll
        for (int i = 0; i < 4; ++i) yo[i] = (f32x4){0.f, 0.f, 0.f, 0.f};
#endif
#pragma unroll
        for (int pt = 0; pt < 4; ++pt)
#pragma unroll
            for (int ks = 0; ks < 4; ++ks) { const bf16x8 pf = *(const LAS bf16x8*)(shm + S_PREV + sw256(16 * pt + fr, 4 * ks + fq)); yo[pt] = __builtin_amdgcn_mfma_f32_16x16x32_bf16(cf[ks], pf, yo[pt], 0, 0, 0); }
#ifdef SSD_REP_YO
        }
#endif
#ifdef SSD_REP_CS
        for (int rep_ = 0; rep_ < 2; ++rep_)
#endif
        {
            const f32x4 al = *(const LAS f32x4*)(acsl + l0 + 4 * fq);
            float ea[4];
#pragma unroll
            for (int i = 0; i < 4; ++i) ea[i] = __expf(al[i]);
            s16x4 xs[4];
#pragma unroll
            for (int pt = 0; pt < 4; ++pt) xs[pt] = tr_read(xtr + S_X + (unsigned)((l0 + 4 * fq) * XROW + pt * 32));
            MX_LGKM0();
            LAS bf16_t* yst = (LAS bf16_t*)(shm + S_YST + w * 2304);
#pragma unroll
            for (int pt = 0; pt < 4; ++pt)
#pragma unroll
                for (int i = 0; i < 4; ++i) { const float y = yd[pt][i] + ea[i] * yo[pt][i] + dsk * bf2f((unsigned short)xs[pt][i]);
                    yst[(4 * fq + i) * 72 + pt * 16 + fr] = (bf16_t)(cvt_pk_bf16(y, 0.f) & 0xffffu); }
            asm volatile("s_waitcnt lgkmcnt(0)" ::: "memory");
            bf16_t* yp = MIX + (seq0 + (size_t)c * 128 + l0) * 2048 + h * 64;
#pragma unroll
            for (int j = 0; j < 2; ++j) { const int rr = (lane >> 3) + 8 * j, ch = lane & 7; const u32x4 v = *(const LAS u32x4*)(yst + rr * 72 + ch * 8); *(u32x4*)(yp + (size_t)rr * 2048 + ch * 8) = v; }
        }
#ifdef SSD_REP_ST
        f32x4 stsave[4];
#pragma unroll
        for (int i = 0; i < 4; ++i) stsave[i] = st[i];
        for (int rep_ = 0; rep_ < 2; ++rep_) {
#pragma unroll
        for (int i = 0; i < 4; ++i) st[i] = stsave[i];
#endif
        {
            const float cd = __expf(acsl[127]);
#pragma unroll
            for (int pt = 0; pt < 4; ++pt) st[pt] = st[pt] * cd;
#pragma unroll
            for (int ks = 0; ks < 4; ++ks) {
                const int s0 = 32 * ks, q = (lane & 15) >> 2, p = lane & 3;
                const int r1 = s0 + 8 * fq + q, r2 = r1 + 4;
                const s16x4 alo = tr_read(lds0 + S_B + sw256(r1, 2 * w + (p >> 1)) + (p & 1) * 8), ahi = tr_read(lds0 + S_B + sw256(r2, 2 * w + (p >> 1)) + (p & 1) * 8);
                s16x4 lo[4], hi[4];
#pragma unroll
                for (int pt = 0; pt < 4; ++pt) { lo[pt] = tr_read(xtr + S_XW + (unsigned)((s0 + 8 * fq) * XROW + pt * 32)); hi[pt] = tr_read(xtr + S_XW + (unsigned)((s0 + 8 * fq + 4) * XROW + pt * 32)); }
                MX_LGKM0();
                const bf16x8 af = cat8(alo, ahi);
#pragma unroll
                for (int pt = 0; pt < 4; ++pt) st[pt] = __builtin_amdgcn_mfma_f32_16x16x32_bf16(af, cat8(lo[pt], hi[pt]), st[pt], 0, 0, 0);
            }
        }
#ifdef SSD_REP_ST
        }
#endif
        MX_BAR_L();
    }
    asm volatile("s_waitcnt vmcnt(0)" ::: "memory");
#undef SSD_LOAD
}

constexpr int S2_C = 0, S2_B = 16384, S2_X = 32768, S2_XW = S2_X + 64 * XROW, S2_ACS = S2_XW + 64 * XROW, S2_DT = S2_ACS + 256, S2_BUF = 53248, S2_PREV = 2 * S2_BUF, S2_END = S2_PREV + 2 * 16384;
static_assert(S2_DT + 256 <= S2_BUF && S2_END <= RING_BYTES, "SSD64 LDS");
__device__ __forceinline__ void ssd_unit64(LAS char* shm, int b, int h, const bf16_t* CONV, const float* ACS, const float* DTV, float dsk, bf16_t* MIX) {
    const int tid = threadIdx.x, lane = tid & 63, fr = lane & 15, fq = lane >> 4; const int w = __builtin_amdgcn_readfirstlane(tid >> 6);
    const int g = h >> 3, row = tid >> 3, ec = tid & 7, lt = w >> 1, l0 = 16 * lt, pt0 = 2 * (w & 1);
    const unsigned lds0 = (unsigned)(uintptr_t)shm;
    f32x4 st[4];
#pragma unroll
    for (int i = 0; i < 4; ++i) st[i] = (f32x4){0.f, 0.f, 0.f, 0.f};
    u32x4 rc[2], rb[2], rx; float racs, rdt, rend;
    const size_t seq0 = (size_t)b * SEQ;
#define S2_LOAD(c) do { const size_t gr = seq0 + (size_t)(c) * 64 + row; const bf16_t* p = CONV + gr * 1536; \
        _Pragma("unroll") for (int i = 0; i < 2; ++i) { rc[i] = *(const u32x4*)(p + 1280 + g * 128 + ec * 16 + 8 * i); rb[i] = *(const u32x4*)(p + 1024 + g * 128 + ec * 16 + 8 * i); } \
        rx = *(const u32x4*)(p + h * 64 + ec * 8); \
        racs = ACS[gr * 16 + h]; rdt = DTV[gr * 16 + h]; rend = ACS[(seq0 + (size_t)(c) * 64 + 63) * 16 + h]; } while (0)
#define S2_WRITE(pb) do { LAS char* gb_ = shm + (pb) * S2_BUF; \
        _Pragma("unroll") for (int i = 0; i < 2; ++i) { *(LAS u32x4*)(gb_ + S2_C + sw256(row, ec * 2 + i)) = rc[i]; *(LAS u32x4*)(gb_ + S2_B + sw256(row, ec * 2 + i)) = rb[i]; } \
        *(LAS u32x4*)(gb_ + S2_X + row * XROW + ec * 16) = rx; \
        { const float wr_ = rdt * __expf(rend - racs); u32x4 o_; \
          _Pragma("unroll") for (int k = 0; k < 4; ++k) o_[k] = cvt_pk_bf16(__uint_as_float(rx[k] << 16) * wr_, __uint_as_float(rx[k] & 0xffff0000u) * wr_); \
          *(LAS u32x4*)(gb_ + S2_XW + row * XROW + ec * 16) = o_; } \
        if (ec == 0) { ((LAS float*)(gb_ + S2_ACS))[row] = racs; ((LAS float*)(gb_ + S2_DT))[row] = rdt; } \
        _Pragma("unroll") for (int pt = 0; pt < 4; ++pt) { u32x2 v; v.x = cvt_pk_bf16(st[pt][0], st[pt][1]); v.y = cvt_pk_bf16(st[pt][2], st[pt][3]); \
            const int p_ = 16 * pt + fr; *(LAS u32x2*)(shm + S2_PREV + (pb) * 16384 + sw256(p_, 2 * w + (fq >> 1)) + (fq & 1) * 8) = v; } } while (0)
    S2_LOAD(0);
    S2_WRITE(0);
    MX_BAR_L();
    unsigned swz[4];
#pragma unroll
    for (int ks = 0; ks < 4; ++ks) swz[ks] = (unsigned)(fr * 256 + (((4 * ks + fq) ^ fr) << 4));
    const int q_ = (lane & 15) >> 2, p_ = lane & 3;
    const unsigned xq4 = (unsigned)((4 * fq + q_) * XROW + p_ * 8), xq8 = (unsigned)((8 * fq + q_) * XROW + p_ * 8);
    const int ra = 8 * fq + q_, rb2 = ra + 4;
    const unsigned bt1 = (unsigned)(ra * 256 + (((2 * w + (p_ >> 1)) ^ (ra & 15)) << 4) + (p_ & 1) * 8), bt2 = (unsigned)(rb2 * 256 + (((2 * w + (p_ >> 1)) ^ (rb2 & 15)) << 4) + (p_ & 1) * 8);
    for (int c = 0; c < 32; ++c) {
        const int pb = c & 1; LAS char* gb = shm + pb * S2_BUF; const unsigned gba = lds0 + (unsigned)(pb * S2_BUF);
        const LAS float* acsl = (const LAS float*)(gb + S2_ACS); const LAS float* dtl = (const LAS float*)(gb + S2_DT);
        if (c + 1 < 32) S2_LOAD(c + 1);
        const LAS char* cbp[4]; const LAS char* pvp[4];
#pragma unroll
        for (int ks = 0; ks < 4; ++ks) { cbp[ks] = gb + swz[ks]; pvp[ks] = shm + S2_PREV + pb * 16384 + pt0 * 4096 + swz[ks]; }
        const unsigned xa4 = gba + xq4 + (unsigned)(pt0 * 32), xa8 = gba + xq8, ba1 = gba + bt1, ba2 = gba + bt2;
        bf16x8 cf[4];
#pragma unroll
        for (int ks = 0; ks < 4; ++ks) cf[ks] = *(const LAS bf16x8*)(cbp[ks] + S2_C + l0 * 256);
        f32x4 yd[2], yo[2];
#pragma unroll
        for (int i = 0; i < 2; ++i) { yd[i] = (f32x4){0.f, 0.f, 0.f, 0.f}; yo[i] = (f32x4){0.f, 0.f, 0.f, 0.f}; }
        const float acs_l = acsl[l0 + fr]; const int lcol = l0 + fr;
#pragma unroll
        for (int sb = 0; sb < 2; ++sb) if (2 * sb <= lt) {
            constexpr int dummy = 0; (void)dummy;
            const int s0 = 32 * sb; const bool two = (2 * sb + 1) <= lt;
            s16x4 lo[2], hi[2];
            if (sb == 0) { lo[0] = tr_read_o<S2_X>(xa4); lo[1] = tr_read_o<S2_X + 32>(xa4); hi[0] = tr_read_o<S2_X + 16 * XROW>(xa4); hi[1] = tr_read_o<S2_X + 16 * XROW + 32>(xa4); }
            else         { lo[0] = tr_read_o<S2_X + 32 * XROW>(xa4); lo[1] = tr_read_o<S2_X + 32 * XROW + 32>(xa4); hi[0] = tr_read_o<S2_X + 48 * XROW>(xa4); hi[1] = tr_read_o<S2_X + 48 * XROW + 32>(xa4); }
            f32x4 a0 = {0.f, 0.f, 0.f, 0.f}, a1 = {0.f, 0.f, 0.f, 0.f};
#pragma unroll
            for (int ks = 0; ks < 4; ++ks) { const bf16x8 bf = *(const LAS bf16x8*)(cbp[ks] + S2_B + s0 * 256); a0 = __builtin_amdgcn_mfma_f32_16x16x32_bf16(bf, cf[ks], a0, 0, 0, 0); }
            if (two) {
#pragma unroll
                for (int ks = 0; ks < 4; ++ks) { const bf16x8 bf = *(const LAS bf16x8*)(cbp[ks] + S2_B + (s0 + 16) * 256); a1 = __builtin_amdgcn_mfma_f32_16x16x32_bf16(bf, cf[ks], a1, 0, 0, 0); }
            }
            const f32x4 as0 = *(const LAS f32x4*)(acsl + s0 + 4 * fq), as1 = *(const LAS f32x4*)(acsl + s0 + 16 + 4 * fq);
            const f32x4 dq0 = *(const LAS f32x4*)(dtl + s0 + 4 * fq), dq1 = *(const LAS f32x4*)(dtl + s0 + 16 + 4 * fq);
            float g0[4], g1[4];
#pragma unroll
            for (int i = 0; i < 4; ++i) { g0[i] = a0[i] * __expf(acs_l - as0[i]) * dq0[i]; g1[i] = a1[i] * __expf(acs_l - as1[i]) * dq1[i]; }
            if (2 * sb == lt) {
#pragma unroll
                for (int i = 0; i < 4; ++i) { if (s0 + 4 * fq + i > lcol) g0[i] = 0.f; }
            }
            if (!two) {
#pragma unroll
                for (int i = 0; i < 4; ++i) g1[i] = 0.f;
            } else if (2 * sb + 1 == lt) {
#pragma unroll
                for (int i = 0; i < 4; ++i) { if (s0 + 16 + 4 * fq + i > lcol) g1[i] = 0.f; }
            }
            u32x4 ap; ap.x = cvt_pk_bf16(g0[0], g0[1]); ap.y = cvt_pk_bf16(g0[2], g0[3]); ap.z = cvt_pk_bf16(g1[0], g1[1]); ap.w = cvt_pk_bf16(g1[2], g1[3]);
            const bf16x8 af = __builtin_bit_cast(bf16x8, ap);
            MX_LGKM0();
#pragma unroll
            for (int vi = 0; vi < 2; ++vi) yd[vi] = __builtin_amdgcn_mfma_f32_16x16x32_bf16(af, cat8(lo[vi], hi[vi]), yd[vi], 0, 0, 0);
        }
#pragma unroll
        for (int vi = 0; vi < 2; ++vi)
#pragma unroll
            for (int ks = 0; ks < 4; ++ks) { const bf16x8 pf = *(const LAS bf16x8*)(pvp[ks] + vi * 4096); yo[vi] = __builtin_amdgcn_mfma_f32_16x16x32_bf16(cf[ks], pf, yo[vi], 0, 0, 0); }
        {
            const f32x4 al = *(const LAS f32x4*)(acsl + l0 + 4 * fq);
            float ea[4];
#pragma unroll
            for (int i = 0; i < 4; ++i) ea[i] = __expf(al[i]);
            const unsigned xl = xa4 + (unsigned)(l0 * XROW);
            s16x4 xs[2]; xs[0] = tr_read_o<S2_X>(xl); xs[1] = tr_read_o<S2_X + 32>(xl);
            MX_LGKM0();
            bf16_t* yp = MIX + (seq0 + (size_t)c * 64 + l0 + 4 * fq) * 2048 + h * 64 + pt0 * 16 + fr;
#pragma unroll
            for (int vi = 0; vi < 2; ++vi)
#pragma unroll
                for (int i = 0; i < 4; ++i) { const float y = yd[vi][i] + ea[i] * yo[vi][i] + dsk * bf2f((unsigned short)xs[vi][i]);
                    yp[(size_t)i * 2048 + vi * 16] = (bf16_t)(cvt_pk_bf16(y, 0.f) & 0xffffu); }
        }
        {
            const float cd = __expf(acsl[63]);
#pragma unroll
            for (int pt = 0; pt < 4; ++pt) st[pt] = st[pt] * cd;
            {   s16x4 lo[4], hi[4];
                const s16x4 alo = tr_read_o<S2_B>(ba1), ahi = tr_read_o<S2_B>(ba2);
                lo[0] = tr_read_o<S2_XW>(xa8); lo[1] = tr_read_o<S2_XW + 32>(xa8); lo[2] = tr_read_o<S2_XW + 64>(xa8); lo[3] = tr_read_o<S2_XW + 96>(xa8);
                hi[0] = tr_read_o<S2_XW + 4 * XROW>(xa8); hi[1] = tr_read_o<S2_XW + 4 * XROW + 32>(xa8); hi[2] = tr_read_o<S2_XW + 4 * XROW + 64>(xa8); hi[3] = tr_read_o<S2_XW + 4 * XROW + 96>(xa8);
                MX_LGKM0();
                const bf16x8 af = cat8(alo, ahi);
#pragma unroll
                for (int pt = 0; pt < 4; ++pt) st[pt] = __builtin_amdgcn_mfma_f32_16x16x32_bf16(af, cat8(lo[pt], hi[pt]), st[pt], 0, 0, 0); }
            {   s16x4 lo[4], hi[4];
                const s16x4 alo = tr_read_o<S2_B + 32 * 256>(ba1), ahi = tr_read_o<S2_B + 32 * 256>(ba2);
                lo[0] = tr_read_o<S2_XW + 32 * XROW>(xa8); lo[1] = tr_read_o<S2_XW + 32 * XROW + 32>(xa8); lo[2] = tr_read_o<S2_XW + 32 * XROW + 64>(xa8); lo[3] = tr_read_o<S2_XW + 32 * XROW + 96>(xa8);
                hi[0] = tr_read_o<S2_XW + 36 * XROW>(xa8); hi[1] = tr_read_o<S2_XW + 36 * XROW + 32>(xa8); hi[2] = tr_read_o<S2_XW + 36 * XROW + 64>(xa8); hi[3] = tr_read_o<S2_XW + 36 * XROW + 96>(xa8);
                MX_LGKM0();
                const bf16x8 af = cat8(alo, ahi);
#pragma unroll
                for (int pt = 0; pt < 4; ++pt) st[pt] = __builtin_amdgcn_mfma_f32_16x16x32_bf16(af, cat8(lo[pt], hi[pt]), st[pt], 0, 0, 0); }
        }
        if (c + 1 < 32) S2_WRITE(pb ^ 1);
        MX_BAR_L();
    }
    asm volatile("s_waitcnt vmcnt(0)" ::: "memory");
#undef S2_LOAD
#undef S2_WRITE
}

constexpr int G_QD = 0, G_KI = 16384, G_V = 32768, G_DEC = G_V + 64 * XROW, G_BUF = 45056, G_SP = 2 * G_BUF, G_END = G_SP + 2 * 16384;
static_assert(G_DEC + 512 <= G_BUF && G_END <= RING_BYTES, "GLA LDS");
template <bool CHECK> __device__ __forceinline__ void gla_unit(LAS char* shm, int b, int h, int vs, const bf16_t* PROJ, const bf16_t* QD, const bf16_t* KI, const float* DEC, bf16_t* MIX, unsigned* mismatch) {
    const int tid = threadIdx.x, lane = tid & 63, fr = lane & 15, fq = lane >> 4; const int w = __builtin_amdgcn_readfirstlane(tid >> 6);
    const int row = tid >> 3, ec = tid & 7, lt = w >> 1, l0 = 16 * lt, vt0 = 2 * (w & 1);
    const unsigned lds0 = (unsigned)(uintptr_t)shm;
    f32x4 st[4];
#pragma unroll
    for (int i = 0; i < 4; ++i) st[i] = (f32x4){0.f, 0.f, 0.f, 0.f};
    u32x4 rq[2], rk[2], rv; float rdec = 0.f;
    const size_t seq0 = (size_t)b * SEQ;
#define GLA_LOAD(c) do { const size_t gr = seq0 + (size_t)(c) * 64 + row; const size_t o = gr * 512 + h * 128 + ec * 16; \
        _Pragma("unroll") for (int i = 0; i < 2; ++i) { rq[i] = *(const u32x4*)(QD + o + 8 * i); rk[i] = *(const u32x4*)(KI + o + 8 * i); } \
        rv = *(const u32x4*)(PROJ + gr * NO_IN + 3584 + h * 256 + vs * 64 + ec * 8); \
        if (tid < 128) rdec = DEC[((size_t)b * 32 + (c)) * 512 + h * 128 + tid]; } while (0)
#define GLA_WRITE(pb) do { LAS char* gb_ = shm + (pb) * G_BUF; \
        _Pragma("unroll") for (int i = 0; i < 2; ++i) { *(LAS u32x4*)(gb_ + G_QD + sw256(row, ec * 2 + i)) = rq[i]; *(LAS u32x4*)(gb_ + G_KI + sw256(row, ec * 2 + i)) = rk[i]; } \
        *(LAS u32x4*)(gb_ + G_V + row * XROW + ec * 16) = rv; \
        if (tid < 128) ((LAS float*)(gb_ + G_DEC))[tid] = rdec; \
        _Pragma("unroll") for (int vt = 0; vt < 4; ++vt) { u32x2 v; v.x = cvt_pk_bf16(st[vt][0], st[vt][1]); v.y = cvt_pk_bf16(st[vt][2], st[vt][3]); \
            const int vv = 16 * vt + fr; *(LAS u32x2*)(shm + G_SP + (pb) * 16384 + sw256(vv, 2 * w + (fq >> 1)) + (fq & 1) * 8) = v; } } while (0)
    GLA_LOAD(0);
    GLA_WRITE(0);
    MX_BAR_L();
    const unsigned xtr = lds0 + (unsigned)(((lane & 15) >> 2) * XROW + (lane & 3) * 8);
    for (int c = 0; c < 32; ++c) {
        const int pb = c & 1; LAS char* gb = shm + pb * G_BUF; const unsigned gbo = (unsigned)(pb * G_BUF); LAS char* sp = shm + G_SP + pb * 16384;
        if (c + 1 < 32) GLA_LOAD(c + 1);
        bf16x8 qf[4];
#pragma unroll
        for (int ks = 0; ks < 4; ++ks) qf[ks] = *(const LAS bf16x8*)(gb + G_QD + sw256(l0 + fr, 4 * ks + fq));
        f32x4 o[2]; o[0] = (f32x4){0.f, 0.f, 0.f, 0.f}; o[1] = (f32x4){0.f, 0.f, 0.f, 0.f};
        const int lcol = l0 + fr; const int nsb = (lt >> 1) + 1;
        for (int sb = 0; sb < nsb; ++sb) {
            const int s0 = 32 * sb; const bool two = (2 * sb + 1) <= lt;
            f32x4 a0 = {0.f, 0.f, 0.f, 0.f}, a1 = {0.f, 0.f, 0.f, 0.f};
#pragma unroll
            for (int ks = 0; ks < 4; ++ks) { const bf16x8 kf = *(const LAS bf16x8*)(gb + G_KI + sw256(s0 + fr, 4 * ks + fq)); a0 = __builtin_amdgcn_mfma_f32_16x16x32_bf16(kf, qf[ks], a0, 0, 0, 0); }
            if (two) {
#pragma unroll
                for (int ks = 0; ks < 4; ++ks) { const bf16x8 kf = *(const LAS bf16x8*)(gb + G_KI + sw256(s0 + 16 + fr, 4 * ks + fq)); a1 = __builtin_amdgcn_mfma_f32_16x16x32_bf16(kf, qf[ks], a1, 0, 0, 0); }
            }
            float g0[4], g1[4];
#pragma unroll
            for (int i = 0; i < 4; ++i) { const int sa = s0 + 4 * fq + i; g0[i] = (sa <= lcol) ? a0[i] : 0.f; g1[i] = (two && sa + 16 <= lcol) ? a1[i] : 0.f; }
            u32x4 ap; ap.x = cvt_pk_bf16(g0[0], g0[1]); ap.y = cvt_pk_bf16(g0[2], g0[3]); ap.z = cvt_pk_bf16(g1[0], g1[1]); ap.w = cvt_pk_bf16(g1[2], g1[3]);
            const bf16x8 af = __builtin_bit_cast(bf16x8, ap);
            s16x4 lo[2], hi[2];
#pragma unroll
            for (int vi = 0; vi < 2; ++vi) { lo[vi] = tr_read(xtr + gbo + G_V + (unsigned)((s0 + 4 * fq) * XROW + (vt0 + vi) * 32)); hi[vi] = tr_read(xtr + gbo + G_V + (unsigned)((s0 + 16 + 4 * fq) * XROW + (vt0 + vi) * 32)); }
            MX_LGKM0();
#pragma unroll
            for (int vi = 0; vi < 2; ++vi) o[vi] = __builtin_amdgcn_mfma_f32_16x16x32_bf16(af, cat8(lo[vi], hi[vi]), o[vi], 0, 0, 0);
        }
#pragma unroll
        for (int vi = 0; vi < 2; ++vi)
#pragma unroll
            for (int ks = 0; ks < 4; ++ks) { const bf16x8 sf = *(const LAS bf16x8*)(sp + sw256(16 * (vt0 + vi) + fr, 4 * ks + fq)); o[vi] = __builtin_amdgcn_mfma_f32_16x16x32_bf16(qf[ks], sf, o[vi], 0, 0, 0); }
        {
            bf16_t* op = MIX + (seq0 + (size_t)c * 64 + l0 + 4 * fq) * 2048 + 1024 + h * 256 + vs * 64 + vt0 * 16 + fr;
#pragma unroll
            for (int vi = 0; vi < 2; ++vi)
#pragma unroll
                for (int i = 0; i < 4; ++i) { const bf16_t val = (bf16_t)(cvt_pk_bf16(o[vi][i], 0.f) & 0xffffu);
                    if (CHECK) { if (op[(size_t)i * 2048 + vi * 16] != val) atomicAdd(mismatch, 1u); } else op[(size_t)i * 2048 + vi * 16] = val; }
        }
        {
#pragma unroll
            for (int ks = 0; ks < 2; ++ks) {
                const int s0 = 32 * ks, q = (lane & 15) >> 2, p = lane & 3;
                const int r1 = s0 + 8 * fq + q, r2 = r1 + 4;
                const s16x4 alo = tr_read(lds0 + gbo + G_KI + sw256(r1, 2 * w + (p >> 1)) + (p & 1) * 8), ahi = tr_read(lds0 + gbo + G_KI + sw256(r2, 2 * w + (p >> 1)) + (p & 1) * 8);
                s16x4 lo[4], hi[4];
#pragma unroll
                for (int vt = 0; vt < 4; ++vt) { lo[vt] = tr_read(xtr + gbo + G_V + (unsigned)((s0 + 8 * fq) * XROW + vt * 32)); hi[vt] = tr_read(xtr + gbo + G_V + (unsigned)((s0 + 8 * fq + 4) * XROW + vt * 32)); }
                MX_LGKM0();
                const bf16x8 af = cat8(alo, ahi);
#pragma unroll
                for (int vt = 0; vt < 4; ++vt) st[vt] = __builtin_amdgcn_mfma_f32_16x16x32_bf16(af, cat8(lo[vt], hi[vt]), st[vt], 0, 0, 0);
            }
            const f32x4 d4 = *(const LAS f32x4*)((LAS float*)(gb + G_DEC) + 16 * w + 4 * fq);
#pragma unroll
            for (int vt = 0; vt < 4; ++vt) st[vt] = st[vt] * d4;
        }
        if (c + 1 < 32) GLA_WRITE(pb ^ 1);
        MX_BAR_L();
    }
    asm volatile("s_waitcnt vmcnt(0)" ::: "memory");
#undef GLA_LOAD
#undef GLA_WRITE
}

__device__ __forceinline__ void finalize_phase(bf16_t* MIX, const bf16_t* PROJ, const float* ssd_norm, const float* gla_norm, int gw, int ngw, int lane) {
    for (int m = gw; m < T; m += ngw) {
        bf16_t* mr = MIX + (size_t)m * 2048; const bf16_t* pr = PROJ + (size_t)m * NO_IN;
        float y[2][8]; float s = 0.f;
#pragma unroll
        for (int j = 0; j < 2; ++j) { const int col = 512 * j + 8 * lane; const u32x4 a = *(const u32x4*)(mr + col), z = __builtin_nontemporal_load((const u32x4*)(pr + col));
#pragma unroll
            for (int i = 0; i < 4; ++i) { const float y0 = __uint_as_float(a[i] << 16), y1 = __uint_as_float(a[i] & 0xffff0000u), z0 = __uint_as_float(z[i] << 16), z1 = __uint_as_float(z[i] & 0xffff0000u);
                y[j][2 * i] = y0 * siluf(z0); y[j][2 * i + 1] = y1 * siluf(z1); s += y[j][2 * i] * y[j][2 * i] + y[j][2 * i + 1] * y[j][2 * i + 1]; } }
        const float rs = rsqrtf(wave_sum(s) * (1.f / 1024.f) + EPS);
#pragma unroll
        for (int j = 0; j < 2; ++j) { const int col = 512 * j + 8 * lane; const f32x4 w0 = *(const f32x4*)(ssd_norm + col), w1 = *(const f32x4*)(ssd_norm + col + 4);
            u32x4 o; o.x = cvt_pk_bf16(y[j][0] * rs * w0[0], y[j][1] * rs * w0[1]); o.y = cvt_pk_bf16(y[j][2] * rs * w0[2], y[j][3] * rs * w0[3]);
            o.z = cvt_pk_bf16(y[j][4] * rs * w1[0], y[j][5] * rs * w1[1]); o.w = cvt_pk_bf16(y[j][6] * rs * w1[2], y[j][7] * rs * w1[3]);
            *(u32x4*)(mr + col) = o; }
#pragma unroll
        for (int j = 0; j < 2; ++j) { const int cc = 512 * j + 8 * lane; const u32x4 a = *(const u32x4*)(mr + 1024 + cc), r = __builtin_nontemporal_load((const u32x4*)(pr + 4608 + cc));
            float o[8]; float s2 = 0.f;
#pragma unroll
            for (int i = 0; i < 4; ++i) { o[2 * i] = __uint_as_float(a[i] << 16); o[2 * i + 1] = __uint_as_float(a[i] & 0xffff0000u); s2 += o[2 * i] * o[2 * i] + o[2 * i + 1] * o[2 * i + 1]; }
#pragma unroll
            for (int of = 1; of < 32; of <<= 1) s2 += __shfl_xor(s2, of);
            const float r2 = rsqrtf(s2 * (1.f / 256.f) + EPS); const int v0 = 8 * (lane & 31);
            const f32x4 w0 = *(const f32x4*)(gla_norm + v0), w1 = *(const f32x4*)(gla_norm + v0 + 4);
            float f[8];
#pragma unroll
            for (int i = 0; i < 4; ++i) { f[2 * i] = siluf(__uint_as_float(r[i] << 16)); f[2 * i + 1] = siluf(__uint_as_float(r[i] & 0xffff0000u)); }
            u32x4 ov; ov.x = cvt_pk_bf16(o[0] * r2 * w0[0] * f[0], o[1] * r2 * w0[1] * f[1]); ov.y = cvt_pk_bf16(o[2] * r2 * w0[2] * f[2], o[3] * r2 * w0[3] * f[3]);
            ov.z = cvt_pk_bf16(o[4] * r2 * w1[0] * f[4], o[5] * r2 * w1[1] * f[5]); ov.w = cvt_pk_bf16(o[6] * r2 * w1[2] * f[6], o[7] * r2 * w1[3] * f[7]);
            *(u32x4*)(mr + 1024 + cc) = ov; }
    }
}
#undef MX_LGKM0
#undef MX_BAR
#undef MX_BAR_L
}
namespace mk {
__device__ __forceinline__ void tp_norm_rows(const float* src, const float* g, bf16_t* xn, int gw, int ngw, int lane) {
    f32x4 gg[4];
#pragma unroll
    for (int j = 0; j < 4; ++j) gg[j] = ((const f32x4*)g)[lane + 64 * j];
    for (int m = gw; m < T; m += ngw) {
        const f32x4* p = (const f32x4*)(src + (size_t)m * DM); f32x4 v[4]; float s = 0.f;
#pragma unroll
        for (int j = 0; j < 4; ++j) { v[j] = __builtin_nontemporal_load(p + lane + 64 * j); s += (v[j][0] * v[j][0] + v[j][1] * v[j][1]) + (v[j][2] * v[j][2] + v[j][3] * v[j][3]); }
        const float r = rsqrtf(wave_sum(s) * (1.f / DM) + EPS);
        u32x2* o = (u32x2*)(xn + (size_t)m * DM);
#pragma unroll
        for (int j = 0; j < 4; ++j) { const f32x4 y = v[j] * r * gg[j]; u32x2 w; w.x = cvt_pk_bf16(y[0], y[1]); w.y = cvt_pk_bf16(y[2], y[3]); o[lane + 64 * j] = w; }
    }
}
template <bool FINAL> __device__ __forceinline__ void tp_combine_norm(bf16_t* hb, const bf16_t* Y, const float* g, bf16_t* xn, float* out, int gw, int ngw, int lane) {
    f32x4 gg[2][2];
#pragma unroll
    for (int j = 0; j < 2; ++j) { gg[j][0] = *(const f32x4*)(g + 512 * j + 8 * lane); gg[j][1] = *(const f32x4*)(g + 512 * j + 8 * lane + 4); }
    for (int m = gw; m < T; m += ngw) {
        float v[2][8]; float s = 0.f;
#pragma unroll
        for (int j = 0; j < 2; ++j) { const size_t o = (size_t)m * DM + 512 * j + 8 * lane;
            const u32x4 a = *(const u32x4*)(hb + o), y0 = __builtin_nontemporal_load((const u32x4*)(Y + o)), y1 = __builtin_nontemporal_load((const u32x4*)(Y + (size_t)T * DM + o));
#pragma unroll
            for (int i = 0; i < 4; ++i) { v[j][2 * i] = __uint_as_float(a[i] << 16) + __uint_as_float(y0[i] << 16) + __uint_as_float(y1[i] << 16);
                v[j][2 * i + 1] = __uint_as_float(a[i] & 0xffff0000u) + __uint_as_float(y0[i] & 0xffff0000u) + __uint_as_float(y1[i] & 0xffff0000u);
                s += v[j][2 * i] * v[j][2 * i] + v[j][2 * i + 1] * v[j][2 * i + 1]; } }
        const float r = rsqrtf(wave_sum(s) * (1.f / DM) + EPS);
#pragma unroll
        for (int j = 0; j < 2; ++j) { const size_t o = (size_t)m * DM + 512 * j + 8 * lane;
            if (FINAL) { f32x4 o0, o1;
#pragma unroll
                for (int i = 0; i < 4; ++i) { o0[i] = v[j][i] * r * gg[j][0][i]; o1[i] = v[j][4 + i] * r * gg[j][1][i]; }
                __builtin_nontemporal_store(o0, (f32x4*)(out + o)); __builtin_nontemporal_store(o1, (f32x4*)(out + o + 4));
            } else { u32x4 hw, xw;
#pragma unroll
                for (int i = 0; i < 4; ++i) { hw[i] = cvt_pk_bf16(v[j][2 * i], v[j][2 * i + 1]);
                    xw[i] = cvt_pk_bf16(v[j][2 * i] * r * gg[j][i >> 1][(2 * i) & 3], v[j][2 * i + 1] * r * gg[j][i >> 1][(2 * i + 1) & 3]); }
                *(u32x4*)(hb + o) = hw; *(u32x4*)(xn + o) = xw; }
        }
    }
}
template <bool DRY> __device__ __forceinline__ void tp_route_mfma(const bf16_t* hb, const float* g, bf16_t* xn, const bf16_t* whi, const bf16_t* wlo, const float* bg, const float* br,
                                                                  unsigned* counts, int* lists, float* gates, LAS char* shm, int vcu, int G, int lane, int wave) {
    const int fr = lane & 15, fq = lane >> 4, kbase = wave * 128;
    LAS float* xacc = (LAS float*)shm;
    LAS float* ltile = (LAS float*)(shm + 106496);
    LAS float* rsl = (LAS float*)(shm + 118784);
    for (int blk = vcu; blk < T / 64; blk += G) {
        const int r0 = blk * 64;
        bf16x8 wh[3][4], wl[3][4];
#pragma unroll
        for (int nt = 0; nt < 3; ++nt)
#pragma unroll
            for (int ks = 0; ks < 4; ++ks) { const size_t wo = (size_t)(nt * 16 + fr) * DM + kbase + 32 * ks + 8 * fq; wh[nt][ks] = *(const bf16x8*)(whi + wo); wl[nt][ks] = *(const bf16x8*)(wlo + wo); }
#pragma unroll
        for (int tp = 0; tp < 2; ++tp) {
            u32x4 hq[2][4];
#pragma unroll
            for (int t2 = 0; t2 < 2; ++t2)
#pragma unroll
                for (int ks = 0; ks < 4; ++ks) hq[t2][ks] = *(const u32x4*)(hb + (size_t)(r0 + 16 * (2 * tp + t2) + fr) * DM + kbase + 32 * ks + 8 * fq);
#pragma unroll
            for (int t2 = 0; t2 < 2; ++t2) { const int t = 2 * tp + t2;
                f32x4 acc[3]; acc[0] = (f32x4){0.f, 0.f, 0.f, 0.f}; acc[1] = acc[0]; acc[2] = acc[0];
                float ss = 0.f;
#pragma unroll
                for (int ks = 0; ks < 4; ++ks) { const u32x4 v = hq[t2][ks];
                    const float x0 = __uint_as_float(v.x << 16), x1 = __uint_as_float(v.x & 0xffff0000u), x2 = __uint_as_float(v.y << 16), x3 = __uint_as_float(v.y & 0xffff0000u);
                    const float x4 = __uint_as_float(v.z << 16), x5 = __uint_as_float(v.z & 0xffff0000u), x6 = __uint_as_float(v.w << 16), x7 = __uint_as_float(v.w & 0xffff0000u);
                    ss += (x0 * x0 + x1 * x1) + (x2 * x2 + x3 * x3) + (x4 * x4 + x5 * x5) + (x6 * x6 + x7 * x7);
                    const bf16x8 a = __builtin_bit_cast(bf16x8, v);
#pragma unroll
                    for (int nt = 0; nt < 3; ++nt) { acc[nt] = __builtin_amdgcn_mfma_f32_16x16x32_bf16(a, wh[nt][ks], acc[nt], 0, 0, 0); acc[nt] = __builtin_amdgcn_mfma_f32_16x16x32_bf16(a, wl[nt][ks], acc[nt], 0, 0, 0); } }
                ss += __shfl_xor(ss, 16); ss += __shfl_xor(ss, 32);
                LAS float* xa = xacc + (t * 8 + wave) * 13 * 64;
#pragma unroll
                for (int nt = 0; nt < 3; ++nt)
#pragma unroll
                    for (int i = 0; i < 4; ++i) xa[(nt * 4 + i) * 64 + lane] = acc[nt][i];
                xa[12 * 64 + lane] = ss;
            }
            asm volatile("" ::: "memory");
        }
        u32x4 hv[4][4];
#pragma unroll
        for (int t = 0; t < 4; ++t)
#pragma unroll
            for (int ks = 0; ks < 4; ++ks) hv[t][ks] = *(const u32x4*)(hb + (size_t)(r0 + 16 * t + fr) * DM + kbase + 32 * ks + 8 * fq);
        asm volatile("s_waitcnt lgkmcnt(0)\n\ts_barrier" ::: "memory");
        float rs[4];
#pragma unroll
        for (int t = 0; t < 4; ++t) { float s = 0.f;
#pragma unroll
            for (int w2 = 0; w2 < 8; ++w2) s += xacc[(t * 8 + w2) * 13 * 64 + 12 * 64 + lane];
            rs[t] = rsqrtf(s * (1.f / DM) + EPS); }
        if (wave < 4) {
            const LAS float* xs = xacc + (wave * 8) * 13 * 64;
#pragma unroll
            for (int nt = 0; nt < 3; ++nt)
#pragma unroll
                for (int i = 0; i < 4; ++i) { float v = 0.f;
#pragma unroll
                    for (int w2 = 0; w2 < 8; ++w2) v += xs[w2 * 13 * 64 + (nt * 4 + i) * 64 + lane];
                    ltile[(16 * wave + 4 * fq + i) * 48 + nt * 16 + fr] = v; }
            float rw = rs[0];
#pragma unroll
            for (int t = 1; t < 4; ++t) if (wave == t) rw = rs[t];
            if (fq == 0) rsl[16 * wave + fr] = rw;
        }
        f32x4 gq[4][2];
#pragma unroll
        for (int ks = 0; ks < 4; ++ks) { gq[ks][0] = *(const f32x4*)(g + kbase + 32 * ks + 8 * fq); gq[ks][1] = *(const f32x4*)(g + kbase + 32 * ks + 8 * fq + 4); }
#pragma unroll
        for (int t = 0; t < 4; ++t) { bf16_t* xp = xn + (size_t)(r0 + 16 * t + fr) * DM + kbase + 8 * fq; const float r = rs[t];
#pragma unroll
            for (int ks = 0; ks < 4; ++ks) { const u32x4 v = hv[t][ks]; const f32x4 g0 = gq[ks][0], g1 = gq[ks][1]; u32x4 o;
                o.x = cvt_pk_bf16(__uint_as_float(v.x << 16) * r * g0[0], __uint_as_float(v.x & 0xffff0000u) * r * g0[1]); o.y = cvt_pk_bf16(__uint_as_float(v.y << 16) * r * g0[2], __uint_as_float(v.y & 0xffff0000u) * r * g0[3]);
                o.z = cvt_pk_bf16(__uint_as_float(v.z << 16) * r * g1[0], __uint_as_float(v.z & 0xffff0000u) * r * g1[1]); o.w = cvt_pk_bf16(__uint_as_float(v.w << 16) * r * g1[2], __uint_as_float(v.w & 0xffff0000u) * r * g1[3]);
                *(u32x4*)(xp + 32 * ks) = o; } }
        asm volatile("s_waitcnt lgkmcnt(0)\n\ts_barrier" ::: "memory");
        if (wave == 0) {
            const LAS float* lt = ltile + lane * 48; const float rsr = rsl[lane];
            float gl[4]; const f32x4 bgv = *(const f32x4*)bg;
#pragma unroll
            for (int e = 0; e < 4; ++e) gl[e] = rsr * lt[e] + bgv[e];
            int gi = 0; float gm = gl[0];
#pragma unroll
            for (int e = 1; e < 4; ++e) if (gl[e] > gm) { gm = gl[e]; gi = e; }
            float gs = 0.f;
#pragma unroll
            for (int e = 0; e < 4; ++e) gs += expf(gl[e] - gm);
            const float gwt = 1.f / gs;
            float b0 = -INFINITY, b1 = -INFINITY; int i0 = 0, i1 = 0;
            const f32x4 brv0 = *(const f32x4*)(br + gi * 8), brv1 = *(const f32x4*)(br + gi * 8 + 4);
#pragma unroll
            for (int i = 0; i < 8; ++i) { const float v = rsr * lt[4 + gi * 8 + i] + (i < 4 ? brv0[i & 3] : brv1[i & 3]);
                if (v > b0) { b1 = b0; i1 = i0; b0 = v; i0 = i; } else if (v > b1) { b1 = v; i1 = i; } }
            const int t = r0 + lane;
            const float w0 = 1.f / (1.f + expf(b1 - b0)), w1 = 1.f - w0;
            const int e0 = gi * 8 + i0, e1 = gi * 8 + i1;
            gates[2 * t] = gwt * w0; gates[2 * t + 1] = gwt * w1;
            if (!DRY) {
                const unsigned p0 = __hip_atomic_fetch_add(counts + e0 * 64, 1u, __ATOMIC_RELAXED, __HIP_MEMORY_SCOPE_AGENT);
                const unsigned p1 = __hip_atomic_fetch_add(counts + e1 * 64, 1u, __ATOMIC_RELAXED, __HIP_MEMORY_SCOPE_AGENT);
                lists[e0 * CAP + p0] = 2 * t; lists[e1 * CAP + p1] = 2 * t + 1; }
        }
    }
    asm volatile("s_waitcnt lgkmcnt(0)\n\ts_barrier" ::: "memory");
}

struct Args {
    const float* in[26]; float* out; unsigned char* ws; int ph_lo, ph_hi, use_bar, li;
};
enum Phase { P_CONV0 = 0, P_G1, P_ATT, P_G2, P_TP1, P_G3, P_G4, P_TP2, P_G5, P_CONV, P_MIXER, P_FIN, P_G6, P_TP3, P_G7, P_G8, P_TP4, P_COUNT };

__device__ __forceinline__ void moe_setup(volatile LAS int* misc, unsigned* counts) {
    if (threadIdx.x < 64) {
        const int ln = threadIdx.x & 63, e = ln & 31;
        const int c = (int)__hip_atomic_load(counts + e * 64, __ATOMIC_RELAXED, __HIP_MEMORY_SCOPE_AGENT);
        const int tl = (c + 255) >> 8; int incl = tl;
#pragma unroll
        for (int o = 1; o < 32; o <<= 1) { const int t = __shfl_up(incl, o, 32); if (e >= o) incl += t; }
        if (ln < 32) { misc[64 + e] = c; misc[16 + e] = incl - tl; if (e == 31) misc[16 + 32] = incl; }
    }
    __syncthreads();
}

typedef const float* kin_ptr_t;
__device__ __forceinline__ const float* kin(int i) { return ((const volatile kin_ptr_t __attribute__((address_space(4)))*)__builtin_amdgcn_kernarg_segment_ptr())[i]; }
#ifndef CV_TAIL_ITEMS
#define CV_TAIL_ITEMS 8192
#endif
constexpr int CV_I_EIN = 16 * 80, CV_I_EOUT = 16 * 32, CV_I_OIN = 16 * 184, CV_I_OOUT = 32 * 32, CV_I_GU = 16 * 32, CV_I_D = 8 * 32;
constexpr int CV_NITEMS = CV_I_EIN + CV_I_EOUT + CV_I_OIN + CV_I_OOUT + 32 * CV_I_GU + 32 * CV_I_D;
__device__ __forceinline__ CvItem cv_decode0(unsigned char* ws, int it, int lane) {
    int r = it;
    if (r < CV_I_EIN) return cv_make(SrcEvenIn{kin(4)}, 2312, 1024, 80, (bf16_t*)(ws + WS_WEIN), r, lane); r -= CV_I_EIN;
    if (r < CV_I_EOUT) return cv_make(SrcPlain{kin(7), 1024}, 1024, 1024, 32, (bf16_t*)(ws + WS_WEOUT), r, lane); r -= CV_I_EOUT;
    if (r < CV_I_OIN) return cv_make(SrcOddIn{kin(8)}, 5664, 1024, 184, (bf16_t*)(ws + WS_WOIN), r, lane); r -= CV_I_OIN;
    if (r < CV_I_OOUT) return cv_make(SrcPlain{kin(18), 1024}, 1024, 2048, 32, (bf16_t*)(ws + WS_WOOUT), r, lane); r -= CV_I_OOUT;
    if (r < 32 * CV_I_GU) { const int e = r / CV_I_GU; return cv_make_gu(kin(23) + (size_t)e * 1024 * 512, kin(24) + (size_t)e * 1024 * 512, (bf16_t*)(ws + WS_WGU) + (size_t)e * 1024 * 1024, r % CV_I_GU, lane); } r -= 32 * CV_I_GU;
    { const int e = r / CV_I_D; return cv_make(SrcPlain{kin(25) + (size_t)e * 512 * 1024, 1024}, 1024, 512, 32, (bf16_t*)(ws + WS_WD) + (size_t)e * 1024 * 512, r % CV_I_D, lane); }
}
__device__ __forceinline__ void cv_run0(unsigned char* ws, int lo, int hi, int w, int nw, LAS float* scr, int lane) {
    for (int it = lo + 2 * w; it < hi; it += 2 * nw) {
        float va[32], vb[32]; const CvItem da = cv_decode0(ws, it, lane); cv_load(da, va);
        const bool n1 = it + 1 < hi; CvItem db = da; if (n1) { db = cv_decode0(ws, it + 1, lane); cv_load(db, vb); }
        cv_finish(da, va, scr, lane);
        if (n1) cv_finish(db, vb, scr, lane);
    }
}

constexpr int CV_NIT1 = 32 * (CV_I_GU + CV_I_D);
#ifndef CV1_TAIL_G5
#define CV1_TAIL_G5 4096
#endif
#ifndef CV1_TAIL_MIX
#define CV1_TAIL_MIX 8192
#endif
#ifndef CV1_TAIL_G4
#define CV1_TAIL_G4 8192
#endif
#ifndef CV0_TAIL_G3
#define CV0_TAIL_G3 0
#endif
__device__ __forceinline__ CvItem cv_decode1(unsigned char* ws, int it, int lane) {
    const size_t L1 = (size_t)32 * 1024 * 512; int r = it;
    if (r < 32 * CV_I_GU) { const int e = r / CV_I_GU; return cv_make_gu(kin(23) + L1 + (size_t)e * 1024 * 512, kin(24) + L1 + (size_t)e * 1024 * 512, (bf16_t*)(ws + WS_WGU) + (size_t)e * 1024 * 1024, r % CV_I_GU, lane); } r -= 32 * CV_I_GU;
    { const int e = r / CV_I_D; return cv_make(SrcPlain{kin(25) + L1 + (size_t)e * 512 * 1024, 1024}, 1024, 512, 32, (bf16_t*)(ws + WS_WD) + (size_t)e * 1024 * 512, r % CV_I_D, lane); }
}
__device__ __forceinline__ void cv_run1(unsigned char* ws, int lo, int hi, int w, int nw, LAS float* scr, int lane) {
    for (int it = lo + 2 * w; it < hi; it += 2 * nw) {
        float va[32], vb[32]; const CvItem da = cv_decode1(ws, it, lane); cv_load(da, va);
        const bool n1 = it + 1 < hi; CvItem db = da; if (n1) { db = cv_decode1(ws, it + 1, lane); cv_load(db, vb); }
        cv_finish(da, va, scr, lane);
        if (n1) cv_finish(db, vb, scr, lane);
    }
}

__global__ void __launch_bounds__(NTHR, 2) mk_fwd(Args args) {
    extern __shared__ __attribute__((aligned(16))) unsigned char lds_raw[];
    LAS unsigned char* lds = (LAS unsigned char*)lds_raw;
    volatile LAS int* misc = (volatile LAS int*)(lds + MISC_OFF);
    const int tid = threadIdx.x, lane = tid & 63, wave = __builtin_amdgcn_readfirstlane(tid >> 6);
    const int G = gridDim.x, bx = blockIdx.x;
    const int vcu = (G % 8 == 0) ? (bx % 8) * (G / 8) + bx / 8 : bx;
    const int gw = vcu * NWAVES + wave, ngw = G * NWAVES;
    for (int u = tid; u < 256; u += NTHR) misc[u] = 0;
    __syncthreads();
#define ws ((unsigned char*)kin(27))
#define XN ((bf16_t*)(ws + WS_XN))
#define PROJ ((bf16_t*)(ws + WS_PROJ))
#define MIX ((bf16_t*)(ws + WS_MIX))
#define FB ((float*)(ws + WS_FB))
#define LISTS ((int*)(ws + WS_LISTS))
#define GATES ((float*)(ws + WS_GATES))
#define HB ((bf16_t*)(ws + WS_H))
#define YB ((bf16_t*)(ws + WS_Y))
#define outp ((float*)kin(26))
#define HBS ((bf16_t*)(ws + WS_HB))
#define ctl ((unsigned*)(ws + WS_CTL))
    XcdBarrier bar; bar.bar = ctl + CW_BAR + args.li * XCD_BAR_WORDS; bar.x = 0; bar.st = nullptr;
    if (args.use_bar) bar = xcd_barrier_post(ctl + CW_BAR + args.li * XCD_BAR_WORDS, (volatile LAS unsigned*)misc);
#ifdef BAR_TWICE
#define GRID_BAR() do { if (args.use_bar) { xcd_barrier(bar); xcd_barrier(bar); } } while (0)
#else
#define GRID_BAR() do { if (args.use_bar) xcd_barrier(bar); } while (0)
#endif
    const int lo = args.ph_lo, hi = args.ph_hi;
#ifndef MK_PHASE_MASK
#define MK_PHASE_MASK 0xffffffffu
#endif
#define IN(k) (((MK_PHASE_MASK >> (k)) & 1u) && lo <= (k) && (k) < hi)
#ifndef MK_REP_MASK
#define MK_REP_MASK 0u
#endif
#define NREP(k) ((((MK_REP_MASK) >> (k)) & 1u) ? 2 : 1)
#define REP(k) for (int _r = 0; _r < ((((MK_REP_MASK) >> (k)) & 1u) ? 2 : 1); ++_r)
#define SEAM(k) do { if (IN(k) && IN((k) + 1)) GRID_BAR(); } while (0)
#define XIN kin(0)

    if (IN(P_CONV0)) REP(P_CONV0) {
        LAS float* scr = (LAS float*)(lds + wave * 16384);
        constexpr int OI_LO = CV_I_EIN + CV_I_EOUT, OI_HI = OI_LO + CV_I_OIN + CV_I_OOUT;
        if (CV0_TAIL_G3 && G == 256) { cv_run0(ws, 0, OI_LO, gw, ngw, scr, lane); cv_run0(ws, OI_HI, CV_NITEMS - CV_TAIL_ITEMS, gw, ngw, scr, lane); }
        else cv_run0(ws, 0, CV_NITEMS - CV_TAIL_ITEMS, gw, ngw, scr, lane);
        { bf16_t* wrt = (bf16_t*)(ws + WS_WRT);
          for (int i = gw * 64 + lane; i < 2 * 48 * 1024; i += ngw * 64) { const int l = i / (48 * 1024), rem = i % (48 * 1024), e = rem >> 10, k = rem & 1023;
              const float v = ((e < 4) ? kin(19)[(size_t)l * 4096 + k * 4 + e] : (e < 36 ? kin(21)[(size_t)l * 32768 + k * 32 + (e - 4)] : 0.f)) * kin(2)[(size_t)l * DM + k];
              const unsigned hi = cvt_pk_bf16(v, 0.f) & 0xffffu; const unsigned lo = cvt_pk_bf16(v - __uint_as_float(hi << 16), 0.f) & 0xffffu;
              wrt[(size_t)(2 * l) * 48 * 1024 + rem] = (bf16_t)hi; wrt[(size_t)(2 * l + 1) * 48 * 1024 + rem] = (bf16_t)lo; } }
        tp_norm_rows(XIN, kin(1), XN, gw, ngw, lane);
    }
    SEAM(P_CONV0);
    if (IN(P_G1)) {
        pg8::Gemm g{XN, (const bf16_t*)(ws + WS_WEIN), 1024, 0}; pg8::DenseOrder S; S.init(T, NE_IN, G, bx, NREP(P_G1));
        pg8::EpiProjEven E{PROJ, FB};
        pg8::gemm_phase<pg8::EpiProjEven, pg8::DenseOrder, true>(lds, g, S, E);
        if (CV_TAIL_ITEMS > 0 && G == 256 && bx >= 128)
            cv_run0(ws, CV_NITEMS - CV_TAIL_ITEMS, CV_NITEMS, (bx - 128) * NWAVES + wave, 128 * NWAVES, (LAS float*)(lds + wave * 16384), lane);
        else if (CV_TAIL_ITEMS > 0 && G != 256) cv_run0(ws, CV_NITEMS - CV_TAIL_ITEMS, CV_NITEMS, gw, ngw, (LAS float*)(lds + wave * 16384), lane);
    }
    SEAM(P_G1);
    if (IN(P_ATT)) REP(P_ATT) {
        if (G == 256) {
            const int bh = vcu >> 2, s = vcu & 3, b = bh >> 3, h = bh & 7;
            const float fbias = kin(6)[h];
            att::fox_unit_p<false>((char*)lds_raw, (LAS char*)lds, b, h, 7 - s, PROJ, FB, fbias, MIX, ctl + 32, true);
            att::fox_unit_p<false>((char*)lds_raw, (LAS char*)lds, b, h, s, PROJ, FB, fbias, MIX, ctl + 32, false);
            for (int i = 0; i < 2; ++i) { const int u = vcu * 2 + i; const int sb = u >> 6, kvh = (u >> 5) & 1, blk = u & 31; att::swa_unit((LAS char*)lds, sb, kvh, blk, PROJ, kin(5), MIX); }
        }
    }
    SEAM(P_ATT);
    if (IN(P_G2)) {
        pg8::Gemm g{MIX, (const bf16_t*)(ws + WS_WEOUT), 1024, 0}; pg8::DenseOrder S; S.init(T, DM, G, bx, NREP(P_G2));
        pg8::EpiResidB<true> E{XIN, HBS};
        pg8::gemm_phase<pg8::EpiResidB<true>, pg8::DenseOrder, true>(lds, g, S, E);
    }
    SEAM(P_G2);
    if (IN(P_TP1)) {
#ifdef TP1_REP
        tp_route_mfma<true>(HBS, kin(2), XN, (const bf16_t*)(ws + WS_WRT), (const bf16_t*)(ws + WS_WRT) + 48 * 1024, kin(20), kin(22), ctl + CW_CNT, LISTS, GATES, (LAS char*)lds, vcu, G, lane, wave);
#endif
        tp_route_mfma<false>(HBS, kin(2), XN, (const bf16_t*)(ws + WS_WRT), (const bf16_t*)(ws + WS_WRT) + 48 * 1024, kin(20), kin(22), ctl + CW_CNT, LISTS, GATES, (LAS char*)lds, vcu, G, lane, wave);
    }
    SEAM(P_TP1);
    if (IN(P_G3)) {
        moe_setup(misc, ctl + CW_CNT);
        if (CV0_TAIL_G3 && G == 256) {
            const int U = misc[16 + 32] * 4, nidle = 768 - U;
            if (nidle > 0 && bx >= 256 - nidle) { constexpr int OI_LO = CV_I_EIN + CV_I_EOUT, OI_HI = OI_LO + CV_I_OIN + CV_I_OOUT;
                cv_run0(ws, OI_LO, OI_HI, (bx - (256 - nidle)) * NWAVES + wave, nidle * NWAVES, (LAS float*)(lds + wave * 16384), lane); }
            else if (nidle <= 0) { constexpr int OI_LO = CV_I_EIN + CV_I_EOUT, OI_HI = OI_LO + CV_I_OIN + CV_I_OOUT; cv_run0(ws, OI_LO, OI_HI, gw, ngw, (LAS float*)(lds + wave * 16384), lane); }
        }
        __syncthreads();
        pg8::Gemm g{XN, (const bf16_t*)(ws + WS_WGU), 1024, (size_t)1024 * 1024 * 2};
        pg8::MoeOrder S{(const volatile LAS int*)(misc + 16), (const volatile LAS int*)(misc + 64), LISTS, G, bx, true, NREP(P_G3)};
        pg8::EpiGateUp E{HB};
        pg8::gemm_phase<pg8::EpiGateUp, pg8::MoeOrder, true>(lds, g, S, E);
    }
    SEAM(P_G3);
    if (IN(P_G4)) {
        moe_setup(misc, ctl + CW_CNT);
        pg8::Gemm g{HB, (const bf16_t*)(ws + WS_WD), 512, (size_t)1024 * 512 * 2};
        pg8::MoeOrder S{(const volatile LAS int*)(misc + 16), (const volatile LAS int*)(misc + 64), LISTS, G, bx, false, NREP(P_G4)};
        pg8::EpiDown E{YB, LISTS, GATES, (const volatile LAS int*)(misc + 64)};
        pg8::gemm_phase<pg8::EpiDown, pg8::MoeOrder, true>(lds, g, S, E);
        if (CV1_TAIL_G4 > 0 && G == 256) {
            const int U = misc[16 + 32] * 4, nidle = 768 - U, lo1 = CV_NIT1 - CV1_TAIL_G5 - CV1_TAIL_MIX - CV1_TAIL_G4, hi1 = lo1 + CV1_TAIL_G4;
            if (nidle >= 32) { if (bx >= 256 - nidle) cv_run1(ws, lo1, hi1, (bx - (256 - nidle)) * NWAVES + wave, nidle * NWAVES, (LAS float*)(lds + wave * 16384), lane); }
            else cv_run1(ws, lo1, hi1, gw, ngw, (LAS float*)(lds + wave * 16384), lane);
        }
    }
    SEAM(P_G4);
    if (IN(P_TP2)) {
        tp_combine_norm<false>(HBS, YB, kin(1) + DM, XN, nullptr, gw, ngw, lane);
        LAS float* scr = (LAS float*)(lds + wave * 16384);
        constexpr int I_GU = 16 * 32, I_D = 8 * 32; const size_t L1 = (size_t)32 * 1024 * 512;
        auto decode = [&](int it) -> CvItem {
            int r = it;
            if (r < 32 * I_GU) { const int e = r / I_GU; return cv_make_gu(kin(23) + L1 + (size_t)e * 1024 * 512, kin(24) + L1 + (size_t)e * 1024 * 512, (bf16_t*)(ws + WS_WGU) + (size_t)e * 1024 * 1024, r % I_GU, lane); } r -= 32 * I_GU;
            { const int e = r / I_D; return cv_make(SrcPlain{kin(25) + L1 + (size_t)e * 512 * 1024, 1024}, 1024, 512, 32, (bf16_t*)(ws + WS_WD) + (size_t)e * 1024 * 512, r % I_D, lane); }
        };
        const int NIT1 = CV_NIT1 - ((G == 256) ? (CV1_TAIL_G5 + CV1_TAIL_MIX + CV1_TAIL_G4) : 0);
        for (int it = 2 * gw; it < NIT1; it += 2 * ngw) {
            float va[32], vb[32]; const CvItem da = decode(it); cv_load(da, va);
            const bool n1 = it + 1 < NIT1; CvItem db = da; if (n1) { db = decode(it + 1); cv_load(db, vb); }
            cv_finish(da, va, scr, lane);
            if (n1) cv_finish(db, vb, scr, lane);
        }
    }
    SEAM(P_TP2);
    if (IN(P_G5)) {
        pg8::Gemm g{XN, (const bf16_t*)(ws + WS_WOIN), 1024, 0}; pg8::DenseOrder S; S.init(T, NO_IN, G, bx, NREP(P_G5));
        pg8::EpiProjOdd E{PROJ, (float*)(ws + WS_DTG)};
        pg8::gemm_phase<pg8::EpiProjOdd, pg8::DenseOrder, true>(lds, g, S, E);
        if (CV1_TAIL_G5 > 0 && G == 256 && bx >= 192)
            cv_run1(ws, CV_NIT1 - CV1_TAIL_G5 - CV1_TAIL_MIX, CV_NIT1 - CV1_TAIL_MIX, (bx - 192) * NWAVES + wave, 64 * NWAVES, (LAS float*)(lds + wave * 16384), lane);
    }
    SEAM(P_G5);
    if (IN(P_CONV)) {
        mx::prep_conv(PROJ, (bf16_t*)(ws + WS_CONV), kin(9), kin(10), vcu, G, tid);
#ifdef PREP_REP_CONV
        mx::prep_conv(PROJ, (bf16_t*)(ws + WS_CONV), kin(9), kin(10), vcu, G, tid);
#endif
        mx::prep_ssd((const float*)(ws + WS_DTG), (float*)(ws + mx::WS_DTV), (float*)(ws + mx::WS_ACS), kin(11), kin(12), vcu, G, lane, wave);
#ifdef PREP_REP_SSD
        mx::prep_ssd((const float*)(ws + WS_DTG), (float*)(ws + mx::WS_DTV), (float*)(ws + mx::WS_ACS), kin(11), kin(12), vcu, G, lane, wave);
#endif
        mx::prep_gla(PROJ, (const float*)(ws + WS_DTG), (bf16_t*)(ws + mx::WS_QD), (bf16_t*)(ws + mx::WS_KI), (bf16_t*)(ws + mx::WS_KE), (float*)(ws + mx::WS_DEC), kin(15), kin(16), vcu, G, tid, lane, wave, (LAS char*)lds);
#ifdef PREP_REP_GLA
        mx::prep_gla(PROJ, (const float*)(ws + WS_DTG), (bf16_t*)(ws + mx::WS_QD), (bf16_t*)(ws + mx::WS_KI), (bf16_t*)(ws + mx::WS_KE), (float*)(ws + mx::WS_DEC), kin(15), kin(16), vcu, G, tid, lane, wave, (LAS char*)lds);
#endif
    }
    SEAM(P_CONV);
    if (IN(P_MIXER)) {
        if (G == 256) {
            if (vcu < 128) {
                mx::ssd_unit64((LAS char*)lds, vcu >> 4, vcu & 15, (const bf16_t*)(ws + WS_CONV), (const float*)(ws + mx::WS_ACS), (const float*)(ws + mx::WS_DTV), kin(13)[vcu & 15], MIX);
#ifdef MIX_SSD_REP
                __syncthreads(); mx::ssd_unit((LAS char*)lds, vcu >> 4, vcu & 15, (const bf16_t*)(ws + WS_CONV), (const float*)(ws + mx::WS_ACS), (const float*)(ws + mx::WS_DTV), kin(13)[vcu & 15], MIX);
#endif
            }
            else { const int u = vcu - 128; mx::gla_unit<false>((LAS char*)lds, u >> 4, (u >> 2) & 3, u & 3, PROJ, (const bf16_t*)(ws + mx::WS_QD), (const bf16_t*)(ws + mx::WS_KI),
                                                          (const float*)(ws + mx::WS_DEC), MIX, ctl + 32);
                if (CV1_TAIL_MIX > 0) { __syncthreads(); cv_run1(ws, CV_NIT1 - CV1_TAIL_MIX, CV_NIT1, (vcu - 128) * NWAVES + wave, 128 * NWAVES, (LAS float*)(lds + wave * 16384), lane); }
#ifdef MIX_GLA_REP
                __syncthreads(); mx::gla_unit<false>((LAS char*)lds, u >> 4, (u >> 2) & 3, u & 3, PROJ, (const bf16_t*)(ws + mx::WS_QD), (const bf16_t*)(ws + mx::WS_KI), (const float*)(ws + mx::WS_DEC), MIX, ctl + 32);
#endif
            }
        }
    }
    SEAM(P_MIXER);
    if (IN(P_FIN)) {
        mx::finalize_phase(MIX, PROJ, kin(14), kin(17), gw, ngw, lane);
    }
    SEAM(P_FIN);
    if (IN(P_G6)) {
        pg8::Gemm g{MIX, (const bf16_t*)(ws + WS_WOOUT), 2048, 0}; pg8::DenseOrder S; S.init(T, DM, G, bx, NREP(P_G6));
        pg8::EpiResidB<false> E{HBS, HBS};
        pg8::gemm_phase<pg8::EpiResidB<false>, pg8::DenseOrder, true>(lds, g, S, E);
    }
    SEAM(P_G6);
    if (IN(P_TP3)) {
        tp_route_mfma<false>(HBS, kin(2) + DM, XN, (const bf16_t*)(ws + WS_WRT) + 2 * 48 * 1024, (const bf16_t*)(ws + WS_WRT) + 3 * 48 * 1024, kin(20) + 4, kin(22) + 32,
                             ctl + CW_CNT + 32 * 64, LISTS, GATES, (LAS char*)lds, vcu, G, lane, wave);
    }
    SEAM(P_TP3);
    if (IN(P_G7)) {
        moe_setup(misc, ctl + CW_CNT + 32 * 64);
        pg8::Gemm g{XN, (const bf16_t*)(ws + WS_WGU), 1024, (size_t)1024 * 1024 * 2};
        pg8::MoeOrder S{(const volatile LAS int*)(misc + 16), (const volatile LAS int*)(misc + 64), LISTS, G, bx, true, NREP(P_G7)};
        pg8::EpiGateUp E{HB};
        pg8::gemm_phase<pg8::EpiGateUp, pg8::MoeOrder, true>(lds, g, S, E);
    }
    SEAM(P_G7);
    if (IN(P_G8)) {
        moe_setup(misc, ctl + CW_CNT + 32 * 64);
        pg8::Gemm g{HB, (const bf16_t*)(ws + WS_WD), 512, (size_t)1024 * 512 * 2};
        pg8::MoeOrder S{(const volatile LAS int*)(misc + 16), (const volatile LAS int*)(misc + 64), LISTS, G, bx, false, NREP(P_G8)};
        pg8::EpiDown E{YB, LISTS, GATES, (const volatile LAS int*)(misc + 64)};
        pg8::gemm_phase<pg8::EpiDown, pg8::MoeOrder, true>(lds, g, S, E);
    }
    SEAM(P_G8);
    if (IN(P_TP4)) {
        tp_combine_norm<true>(HBS, YB, kin(3), nullptr, outp, gw, ngw, lane);
#ifdef TP4_REP
        tp_combine_norm<true>(HBS, YB, kin(3), nullptr, outp, gw, ngw, lane);
#endif
#if defined(GLA_CHECK) || defined(ATT_CHECK)
        if (__hip_atomic_load(ctl + 32, __ATOMIC_RELAXED, __HIP_MEMORY_SCOPE_AGENT) != 0u) { for (int m = gw; m < T; m += ngw) outp[(size_t)m * DM + lane] = 1000.f; }
#endif
    }
#undef IN
#undef SEAM
#undef GRID_BAR
#undef ws
#undef XN
#undef PROJ
#undef MIX
#undef FB
#undef LISTS
#undef GATES
#undef HB
#undef YB
#undef outp
#undef HBS
#undef ctl
#undef XIN
}
}

extern "C" void kernel_launch(void* const* d_in, const int* in_sizes, int n_in, void* d_out, int out_size, void* d_ws, size_t ws_size, hipStream_t stream) {
    static int grid = 0;
    if (grid == 0) {
        int dev = 0, cus = 0, per_cu = 0;
        (void)hipGetDevice(&dev); (void)hipDeviceGetAttribute(&cus, hipDeviceAttributeMultiprocessorCount, dev);
        if (n_in != 26 || out_size != mk::T * mk::DM || ws_size < mk::WS_TOTAL) { fprintf(stderr, "kernel_launch: unexpected shapes (n_in %d out %d ws %zu)\n", n_in, out_size, ws_size); grid = -1; return; }
        if (hipFuncSetAttribute((const void*)mk::mk_fwd, hipFuncAttributeMaxDynamicSharedMemorySize, mk::LDS_BYTES) != hipSuccess) { fprintf(stderr, "hipFuncSetAttribute failed\n"); grid = -1; return; }
        if (hipOccupancyMaxActiveBlocksPerMultiprocessor(&per_cu, (const void*)mk::mk_fwd, mk::NTHR, mk::LDS_BYTES) != hipSuccess || per_cu < 1) { fprintf(stderr, "occupancy query reports %d blocks per CU\n", per_cu); }
        (void)hipGetLastError();
        grid = cus;
        if (grid != 256) fprintf(stderr, "kernel_launch: %d CUs; the attention / mixer phases need 256\n", grid);
    }
    if (grid < 0) return;
    (void)hipMemsetAsync((char*)d_ws + mk::WS_CTL, 0, mk::CTL_ZERO_BYTES, stream);
    mk::Args a{};
    for (int i = 0; i < 26; ++i) a.in[i] = (const float*)d_in[i];
    a.out = (float*)d_out; a.ws = (unsigned char*)d_ws;
    a.ph_lo = 0; a.ph_hi = mk::P_COUNT; a.use_bar = 1; a.li = 0;
    hipLaunchKernelGGL(mk::mk_fwd, dim3(grid), dim3(mk::NTHR), mk::LDS_BYTES, stream, a);
}
```

```cpp
#include <hip/hip_runtime.h>
#include <hip/hip_bf16.h>
#include <cstdio>
#include <cstdint>
#include <cmath>
namespace mk {
#define LAS __attribute__((address_space(3)))
#define GAS __attribute__((address_space(1)))
typedef unsigned short bf16_t;
typedef short bf16x8 __attribute__((ext_vector_type(8)));
typedef short s16x4 __attribute__((ext_vector_type(4)));
typedef float f32x4 __attribute__((ext_vector_type(4)));
typedef float f32x2 __attribute__((ext_vector_type(2)));
typedef float f32x16 __attribute__((ext_vector_type(16)));
typedef unsigned u32x4 __attribute__((ext_vector_type(4)));
typedef unsigned u32x2 __attribute__((ext_vector_type(2)));

constexpr int T = 16384, DM = 1024, SEQ = 2048, NBATCH = 8;
constexpr int NE_IN = 2560, NO_IN = 5888;
constexpr int CAP = 16384;
constexpr float EPS = 1e-6f;
constexpr float LOG2E = 1.4426950408889634f;
constexpr float C2 = 0.125f * LOG2E;
constexpr int NWAVES = 8, NTHR = 512;
constexpr size_t MiB = 1u << 20;
constexpr size_t WS_CTL = 0, CTL_ZERO_BYTES = 1 * MiB;
constexpr size_t WS_WEIN = 2 * MiB, WS_WEOUT = 7 * MiB, WS_WOIN = 9 * MiB, WS_WOOUT = 21 * MiB, WS_WRT = 25 * MiB;
constexpr size_t WS_WGU = 26 * MiB, WS_WD = 90 * MiB;
constexpr size_t WS_XN = 122 * MiB;
constexpr size_t WS_PROJ = 154 * MiB;
constexpr size_t WS_H = WS_PROJ, WS_Y = WS_PROJ + 40 * MiB;
constexpr size_t WS_MIX = 338 * MiB;
constexpr size_t WS_CONV = 402 * MiB;
constexpr size_t WS_FB = 450 * MiB;
constexpr size_t WS_DTG = 451 * MiB;
constexpr size_t WS_LISTS = 453 * MiB;
constexpr size_t WS_GATES = 455 * MiB;
constexpr size_t WS_RSTD = 455 * MiB + 512 * 1024;
constexpr size_t WS_END = 456 * MiB, WS_HB = 476 * MiB, WS_TOTAL = 508 * MiB;
constexpr int CW_BAR = 4096;
constexpr int CW_CNT = 16384;
constexpr int RING_BYTES = 146432;
constexpr int MISC_OFF = RING_BYTES;
constexpr int LDS_BYTES = 147456;

typedef __bf16 bf16x2_t __attribute__((ext_vector_type(2)));
__device__ __forceinline__ unsigned cvt_pk_bf16(float lo, float hi) { f32x2 v = {lo, hi}; bf16x2_t b = __builtin_convertvector(v, bf16x2_t); return __builtin_bit_cast(unsigned, b); }
__device__ __forceinline__ float bf2f(unsigned short b) { return __uint_as_float((unsigned)b << 16); }
__device__ __forceinline__ float wave_sum(float v) {
#pragma unroll
    for (int o = 1; o < 64; o <<= 1) v += __shfl_xor(v, o);
    return v;
}
__device__ __forceinline__ float siluf(float x) { return x * __builtin_amdgcn_rcpf(1.f + __expf(-x)); }
__device__ __forceinline__ float log_sigmoidf(float x) { return fminf(x, 0.f) - log1pf(expf(-fabsf(x))); }
__device__ __forceinline__ float log_sigmoid_fast(float x) { return fminf(x, 0.f) - __logf(1.f + __expf(-fabsf(x))); }
__device__ __forceinline__ float softplusf(float x) { return fmaxf(x, 0.f) + __logf(1.f + __expf(-fabsf(x))); }

#define XB_TMO      128
#define XB_XCNT(j)  (256  + 64 * (j))
#define XB_XSUB(j)  (1280 + 64 * (j))
#define XB_XGEN(j)  (2304 + 64 * (j))
#define XB_TOP      3328
#define XB_TOPGEN   3392
#define XCD_BAR_WORDS 3456
#define XB_SPIN_CAP (1u << 18)
__device__ __forceinline__ unsigned xb_ld(unsigned* p)              { return __hip_atomic_load(p, __ATOMIC_RELAXED, __HIP_MEMORY_SCOPE_AGENT); }
__device__ __forceinline__ unsigned xb_add(unsigned* p, unsigned v) { return __hip_atomic_fetch_add(p, v, __ATOMIC_RELAXED, __HIP_MEMORY_SCOPE_AGENT); }
__device__ __forceinline__ unsigned xb_xcc_id() { return (unsigned)__builtin_amdgcn_s_getreg((3 << 11) | 20) & 0xFu; }
#define XB_SPIN(cond, bar) do { unsigned _sp = 0; while (cond) { __builtin_amdgcn_s_sleep(1); \
    if ((++_sp & 255u) == 0u) { if (xb_ld(&(bar)[XB_TMO])) break; if (_sp > XB_SPIN_CAP) { atomicAdd(&(bar)[XB_TMO], 1u); break; } } } } while (0)
struct XcdBarrier { unsigned* bar; unsigned x; volatile LAS unsigned* st; };
__device__ __forceinline__ XcdBarrier xcd_barrier_post(unsigned* bar, volatile LAS unsigned* st) {
    XcdBarrier b; b.bar = bar; b.x = xb_xcc_id(); b.st = st;
    if (threadIdx.x == 0) (void)xb_add(&bar[XB_XCNT(b.x)], 1u);
    return b;
}
__device__ __forceinline__ void xcd_barrier_complete(unsigned* bar, unsigned x, unsigned& nloc, unsigned& nx) {
    const unsigned G = gridDim.x * gridDim.y * gridDim.z;
    unsigned sum, cnt, mine, sp = 0u;
    for (;;) {
        sum = 0u; cnt = 0u; mine = 0u;
#pragma unroll
        for (unsigned j = 0; j < 16; ++j) { const unsigned c = xb_ld(&bar[XB_XCNT(j)]); sum += c; cnt += (c > 0u) ? 1u : 0u; mine = (j == x) ? c : mine; }
        if (sum == G) break;
        __builtin_amdgcn_s_sleep(1);
        if ((++sp & 255u) == 0u) { if (xb_ld(&bar[XB_TMO])) break; if (sp > XB_SPIN_CAP) { atomicAdd(&bar[XB_TMO], 1u); break; } }
    }
    nloc = mine > 0u ? mine : 1u; nx = cnt > 0u ? cnt : 1u;
}
__device__ __forceinline__ void xcd_barrier(const XcdBarrier& b) {
    asm volatile("s_waitcnt vmcnt(0)" ::: "memory");
    __syncthreads();
    if (threadIdx.x == 0) {
        unsigned* bar = b.bar;
        __builtin_amdgcn_s_waitcnt(0);
        unsigned nloc = b.st[0], nx = b.st[1];
        if (nloc == 0u) { xcd_barrier_complete(bar, b.x, nloc, nx); b.st[0] = nloc; b.st[1] = nx; }
        const unsigned old = xb_add(&bar[XB_XSUB(b.x)], 1u);
        const unsigned gen = old / nloc;
        if (old + 1u == (gen + 1u) * nloc) {
            __builtin_amdgcn_fence(__ATOMIC_RELEASE, "agent");
            asm volatile("s_waitcnt vmcnt(0)" ::: "memory");
            const unsigned og = xb_add(&bar[XB_TOP], 1u);
            const unsigned tg = og / nx;
            if (og + 1u == (tg + 1u) * nx) xb_add(&bar[XB_TOPGEN], 1u);
            else XB_SPIN(xb_ld(&bar[XB_TOPGEN]) == tg, bar);
            __builtin_amdgcn_fence(__ATOMIC_ACQUIRE, "agent");
            xb_add(&bar[XB_XGEN(b.x)], 1u);
            asm volatile("s_waitcnt vmcnt(0)" ::: "memory");
        } else {
            XB_SPIN(xb_ld(&bar[XB_XGEN(b.x)]) == gen, bar);
            __builtin_amdgcn_fence(__ATOMIC_ACQUIRE, "agent");
            asm volatile("s_waitcnt vmcnt(0)" ::: "memory");
        }
    }
    __syncthreads();
}

struct SrcPlain { const float* W; int N; __device__ __forceinline__ const float* operator()(int k, int n) const { return W + (size_t)k * N + n; } };
struct SrcEvenIn { const float* W; __device__ __forceinline__ const float* operator()(int k, int n) const { return n < 2312 ? W + (size_t)k * 2312 + n : nullptr; } };
struct SrcOddIn { const float* W;
    __device__ __forceinline__ const float* operator()(int k, int n) const {
        int s;
        if (n < 2560) s = n; else if (n < 4608) s = n + 16; else if (n < 5632) s = n + 32; else if (n < 5648) s = 2560 + (n - 5632); else if (n < 5664) s = 4624 + (n - 5648); else s = -1;
        return s >= 0 ? W + (size_t)k * 5664 + s : nullptr; } };
struct SrcGateUp { const float* Wg; const float* Wu;
    __device__ __forceinline__ const float* operator()(int k, int n) const { const int j = (n >> 5) * 16 + (n & 15); const long d = (n & 16) ? (long)(Wu - Wg) : 0l; return Wg + d + (size_t)k * 512 + j; } };
__device__ __forceinline__ struct CvItem cv_make_gu(const float* Wg, const float* Wu, bf16_t* WT, int item, int lane);
struct CvItem { const float* p; size_t stride; bf16_t* dst; int K; int gu; };
template <class Src> __device__ __forceinline__ CvItem cv_make(const Src& src, int srcN, int K, int nblk, bf16_t* WT, int item, int lane) {
    const int kb = item / nblk, nb = item % nblk, k0 = 64 * kb, n0 = 32 * nb;
    CvItem d; d.p = src(k0 + (lane >> 5), n0 + (lane & 31)); d.stride = (size_t)2 * srcN; d.dst = WT + (size_t)n0 * K + k0; d.K = K; d.gu = 0; return d;
}
__device__ __forceinline__ CvItem cv_make_gu(const float* Wg, const float* Wu, bf16_t* WT, int item, int lane) {
    const int half = item >> 8, r = item & 255, kb = r >> 4, jb = r & 15, k0 = 64 * kb, j0 = 32 * jb;
    CvItem d; d.p = (half ? Wu : Wg) + (size_t)(k0 + (lane >> 5)) * 512 + j0 + (lane & 31); d.stride = 1024; d.dst = WT + (size_t)(jb * 64 + half * 16) * 1024 + k0; d.K = 1024; d.gu = 1; return d;
}
__device__ __forceinline__ void cv_load(const CvItem& d, float (&v)[32]) {
#pragma unroll
    for (int i = 0; i < 32; ++i) v[i] = d.p ? __builtin_nontemporal_load(d.p + (size_t)i * d.stride) : 0.f;
}
__device__ __forceinline__ void cv_finish(const CvItem& d, const float (&v)[32], LAS float* scr, int lane) {
#pragma unroll
    for (int i = 0; i < 32; ++i) { const int kk = 2 * i + (lane >> 5); scr[kk * 33 + (lane & 31)] = v[i]; }
    asm volatile("s_waitcnt lgkmcnt(0)" ::: "memory");
    const int c = lane & 7;
#pragma unroll
    for (int j = 0; j < 4; ++j) { const int n = (lane >> 3) + 8 * j; const LAS float* s = scr + (8 * c) * 33 + n; const int dr = d.gu ? ((n >> 4) * 32 + (n & 15)) : n;
        u32x4 o; o.x = cvt_pk_bf16(s[0 * 33], s[1 * 33]); o.y = cvt_pk_bf16(s[2 * 33], s[3 * 33]); o.z = cvt_pk_bf16(s[4 * 33], s[5 * 33]); o.w = cvt_pk_bf16(s[6 * 33], s[7 * 33]);
        __builtin_nontemporal_store(o, (u32x4*)(d.dst + (size_t)dr * d.K + 8 * c)); }
    asm volatile("s_waitcnt lgkmcnt(0)" ::: "memory");
}

namespace pg8 {
constexpr int BM = 256, BK = 64, HALF = 128, HTB = HALF * BK * 2, STAGE_BYTES = 8 * HTB, NXCD = 8, WGM = 8;
__host__ __device__ __forceinline__ int lds_byte(int r, int c) { const int st = (r >> 4) * 2 + (c >> 5), rr = r & 15, cc = c & 31, ob = rr * 64 + cc * 2; return st * 1024 + (ob ^ (((ob >> 9) & 1) << 5)); }
__host__ __device__ __forceinline__ void stage_rc(int b, int& R, int& C) { const int st = b / 1024, sb = b % 1024, swz = sb ^ (((sb >> 9) & 1) << 5); R = (st >> 1) * 16 + swz / 64; C = (st & 1) * 32 + (swz % 64) / 2; }
__host__ __device__ __forceinline__ int perm32(int rho) { const int n = rho >> 4, i = rho & 15; return 8 * (i >> 2) + 4 * n + (i & 3); }

struct Unit { int pm, pn, e, j; };
struct Gemm { const bf16_t* A; const bf16_t* Bt; int K; size_t b_estride; };

struct DenseOrder {
    int nM, nN, nwg, G, c, rep;
    __device__ void init(int M, int N, int G_, int c_, int rep_ = 1) { nM = M / BM; nN = N / BM; nwg = nM * nN; G = G_; c = c_; rep = rep_; }
    __device__ bool next(int i, Unit& u) const {
        if (rep > 1) { const int n = (nwg - c + G - 1) / G; if (n <= 0 || i >= n * rep) return false; i = i % n; }
        const long L = (long)i * G + c; if (L >= nwg) return false;
        int wgid = (int)L; { const int q = nwg / NXCD, r = nwg % NXCD, xcd = wgid % NXCD, off = wgid / NXCD; wgid = (xcd < r ? xcd * (q + 1) : r * (q + 1) + (xcd - r) * q) + off; }
        const int nig = WGM * nN, gid = wgid / nig, fm = gid * WGM, gsz = (nM - fm) < WGM ? (nM - fm) : WGM;
        u.pm = fm + ((wgid % nig) % gsz); u.pn = (wgid % nig) / gsz; u.e = 0; u.j = 0; return true;
    }
    __device__ __forceinline__ unsigned arow(const Unit& u, int r) const { return (unsigned)(u.pm * BM + r); }
    __device__ __forceinline__ void arow4(const Unit& u, int r0, int r1, unsigned (&o)[4]) const { o[0] = arow(u, r0); o[1] = arow(u, r1); o[2] = arow(u, HALF + r0); o[3] = arow(u, HALF + r1); }
};
struct MoeOrder {
    const volatile LAS int* ts; const volatile LAS int* cnt; const int* lists; int G, c; bool gather; int rep;
    __device__ bool next(int i, Unit& u) const {
        const int U = ts[32] * 4;
        if (rep > 1) { const int n = (U - c + G - 1) / G; if (n <= 0 || i >= n * rep) return false; i = i % n; }
        const long L = (long)i * G + c; if (L >= U) return false;
        int v = (int)L; { const int q = U / NXCD, r = U % NXCD, xcd = v % NXCD, off = v / NXCD; v = (xcd < r ? xcd * (q + 1) : r * (q + 1) + (xcd - r) * q) + off; }
        const int m = v >> 2; u.pm = m; u.pn = v & 3;
        const int e = ts[80 + m];
        u.e = e; u.j = m - ts[e]; return true;
    }
    __device__ __forceinline__ unsigned arow(const Unit& u, int r) const {
        if (!gather) return (unsigned)(u.pm * BM + r);
        const int ri = u.j * BM + r; const int n = cnt[u.e];
        return ri < n ? (unsigned)(lists[u.e * CAP + ri] >> 1) : 0u;
    }
    __device__ __forceinline__ void arow4(const Unit& u, int r0, int r1, unsigned (&o)[4]) const {
        if (!gather) { o[0] = (unsigned)(u.pm * BM + r0); o[1] = (unsigned)(u.pm * BM + r1); o[2] = (unsigned)(u.pm * BM + HALF + r0); o[3] = (unsigned)(u.pm * BM + HALF + r1); return; }
        const int n = cnt[u.e], last = n - 1, jb = u.j * BM; const int* lp = lists + u.e * CAP;
        const int i0 = jb + r0, i1 = jb + r1, i2 = i0 + HALF, i3 = i1 + HALF;
        const int v0 = lp[i0 < last ? i0 : last], v1 = lp[i1 < last ? i1 : last], v2 = lp[i2 < last ? i2 : last], v3 = lp[i3 < last ? i3 : last];
        o[0] = i0 < n ? (unsigned)(v0 >> 1) : 0u; o[1] = i1 < n ? (unsigned)(v1 >> 1) : 0u; o[2] = i2 < n ? (unsigned)(v2 >> 1) : 0u; o[3] = i3 < n ? (unsigned)(v3 >> 1) : 0u;
    }
};

struct EpiProjEven {
    static constexpr bool PERM = true;
    bf16_t* O; float* fb;
    __device__ __forceinline__ void operator()(const f32x4 (&acc)[2][2][4][2], const Unit& u, int wr, int wc, int fr, int fq) const {
        const int row0 = u.pm * BM + wr * 64 + fr;
        if (u.pn == 9) {
            if (wc == 0 && fq == 0) {
#pragma unroll
                for (int ai = 0; ai < 2; ++ai)
#pragma unroll
                    for (int m = 0; m < 4; ++m) { float* p = fb + (size_t)(row0 + ai * HALF + m * 16) * 8; *(f32x4*)p = acc[ai][0][m][0]; *(f32x4*)(p + 4) = acc[ai][0][m][1]; }
            }
            return;
        }
        const float sc = (u.pn == 0 || u.pn == 1 || u.pn == 3 || u.pn == 4) ? C2 : 1.f;
        const int col0 = u.pn * BM + wc * 32 + 8 * fq;
#pragma unroll
        for (int ai = 0; ai < 2; ++ai)
#pragma unroll
            for (int m = 0; m < 4; ++m) { bf16_t* rowp = O + (size_t)(row0 + ai * HALF + m * 16) * NE_IN + col0;
#pragma unroll
                for (int bj = 0; bj < 2; ++bj) { const f32x4 v0 = acc[ai][bj][m][0] * sc, v1 = acc[ai][bj][m][1] * sc;
                    u32x4 w; w.x = cvt_pk_bf16(v0[0], v0[1]); w.y = cvt_pk_bf16(v0[2], v0[3]); w.z = cvt_pk_bf16(v1[0], v1[1]); w.w = cvt_pk_bf16(v1[2], v1[3]);
                    *(u32x4*)(rowp + bj * HALF) = w; } }
    }
};
struct EpiProjOdd {
    static constexpr bool PERM = true;
    bf16_t* O; float* dtg;
    __device__ __forceinline__ void operator()(const f32x4 (&acc)[2][2][4][2], const Unit& u, int wr, int wc, int fr, int fq) const {
        const int row0 = u.pm * BM + wr * 64 + fr;
        if (u.pn == 22) {
            if (wc == 0) {
#pragma unroll
                for (int ai = 0; ai < 2; ++ai)
#pragma unroll
                    for (int m = 0; m < 4; ++m) { float* p = dtg + (size_t)(row0 + ai * HALF + m * 16) * 32 + 8 * fq; *(f32x4*)p = acc[ai][0][m][0]; *(f32x4*)(p + 4) = acc[ai][0][m][1]; }
            }
            return;
        }
        const int col0 = u.pn * BM + wc * 32 + 8 * fq;
#pragma unroll
        for (int ai = 0; ai < 2; ++ai)
#pragma unroll
            for (int m = 0; m < 4; ++m) { bf16_t* rowp = O + (size_t)(row0 + ai * HALF + m * 16) * NO_IN + col0;
#pragma unroll
                for (int bj = 0; bj < 2; ++bj) { const f32x4 v0 = acc[ai][bj][m][0], v1 = acc[ai][bj][m][1];
                    u32x4 w; w.x = cvt_pk_bf16(v0[0], v0[1]); w.y = cvt_pk_bf16(v0[2], v0[3]); w.z = cvt_pk_bf16(v1[0], v1[1]); w.w = cvt_pk_bf16(v1[2], v1[3]);
                    *(u32x4*)(rowp + bj * HALF) = w; } }
    }
};
struct EpiResid {
    static constexpr bool PERM = false;
    const float* base; float* out;
    __device__ __forceinline__ void operator()(const f32x4 (&acc)[2][2][4][2], const Unit& u, int wr, int wc, int fr, int fq) const {
        const int col0 = u.pn * BM + wc * 32 + 4 * fq;
#pragma unroll
        for (int ai = 0; ai < 2; ++ai)
#pragma unroll
            for (int m = 0; m < 4; ++m) { const size_t off = (size_t)(u.pm * BM + ai * HALF + wr * 64 + m * 16 + fr) * DM + col0;
#pragma unroll
                for (int bj = 0; bj < 2; ++bj)
#pragma unroll
                    for (int n = 0; n < 2; ++n) { const f32x4 bs = *(const f32x4*)(base + off + bj * HALF + n * 16); *(f32x4*)(out + off + bj * HALF + n * 16) = bs + acc[ai][bj][m][n]; } }
    }
};
template <bool BASE_F32> struct EpiResidB {
    static constexpr bool PERM = true;
    const void* base; bf16_t* out;
    __device__ __forceinline__ void operator()(const f32x4 (&acc)[2][2][4][2], const Unit& u, int wr, int wc, int fr, int fq) const {
        const int row0 = u.pm * BM + wr * 64 + fr, col0 = u.pn * BM + wc * 32 + 8 * fq;
#pragma unroll
        for (int ai = 0; ai < 2; ++ai) {
            f32x4 bf[4][2][2]; u32x4 bb[4][2];
#pragma unroll
            for (int m = 0; m < 4; ++m) { const size_t ro = (size_t)(row0 + ai * HALF + m * 16) * DM + col0;
#pragma unroll
                for (int bj = 0; bj < 2; ++bj) {
                    if (BASE_F32) { const float* bp = (const float*)base + ro + bj * HALF; bf[m][bj][0] = __builtin_nontemporal_load((const f32x4*)bp); bf[m][bj][1] = __builtin_nontemporal_load((const f32x4*)(bp + 4)); }
                    else bb[m][bj] = *(const u32x4*)((const bf16_t*)base + ro + bj * HALF); } }
#pragma unroll
            for (int m = 0; m < 4; ++m) { const size_t ro = (size_t)(row0 + ai * HALF + m * 16) * DM + col0;
#pragma unroll
                for (int bj = 0; bj < 2; ++bj) { f32x4 v0 = acc[ai][bj][m][0], v1 = acc[ai][bj][m][1];
                    if (BASE_F32) { v0 += bf[m][bj][0]; v1 += bf[m][bj][1]; }
                    else { const u32x4 q = bb[m][bj];
                        v0[0] += __uint_as_float(q.x << 16); v0[1] += __uint_as_float(q.x & 0xffff0000u); v0[2] += __uint_as_float(q.y << 16); v0[3] += __uint_as_float(q.y & 0xffff0000u);
                        v1[0] += __uint_as_float(q.z << 16); v1[1] += __uint_as_float(q.z & 0xffff0000u); v1[2] += __uint_as_float(q.w << 16); v1[3] += __uint_as_float(q.w & 0xffff0000u); }
                    u32x4 w; w.x = cvt_pk_bf16(v0[0], v0[1]); w.y = cvt_pk_bf16(v0[2], v0[3]); w.z = cvt_pk_bf16(v1[0], v1[1]); w.w = cvt_pk_bf16(v1[2], v1[3]);
                    *(u32x4*)(out + ro + bj * HALF) = w; } }
        }
    }
};
struct EpiGateUp {
    static constexpr bool PERM = false;
    bf16_t* H;
    __device__ __forceinline__ void operator()(const f32x4 (&acc)[2][2][4][2], const Unit& u, int wr, int wc, int fr, int fq) const {
#pragma unroll
        for (int ai = 0; ai < 2; ++ai)
#pragma unroll
            for (int m = 0; m < 4; ++m) { bf16_t* rowp = H + (size_t)(u.pm * BM + ai * HALF + wr * 64 + m * 16 + fr) * 512;
#pragma unroll
                for (int bj = 0; bj < 2; ++bj) { const int j0 = (u.pn * 8 + bj * 4 + wc) * 16 + 4 * fq; const f32x4 g = acc[ai][bj][m][0], up = acc[ai][bj][m][1];
                    u32x2 w; w.x = cvt_pk_bf16(siluf(g[0]) * up[0], siluf(g[1]) * up[1]); w.y = cvt_pk_bf16(siluf(g[2]) * up[2], siluf(g[3]) * up[3]);
                    *(u32x2*)(rowp + j0) = w; } }
    }
};
struct EpiDown {
    static constexpr bool PERM = true;
    bf16_t* Y; const int* lists; const float* gates; const volatile LAS int* cnt;
    __device__ __forceinline__ void operator()(const f32x4 (&acc)[2][2][4][2], const Unit& u, int wr, int wc, int fr, int fq) const {
        const int n = cnt[u.e], last = n - 1; const int col0 = u.pn * BM + wc * 32 + 8 * fq; const int* lp = lists + u.e * CAP; const int rb = u.j * BM + wr * 64 + fr;
        int av[2][4]; float gv[2][4];
#pragma unroll
        for (int ai = 0; ai < 2; ++ai)
#pragma unroll
            for (int m = 0; m < 4; ++m) { const int ri = rb + ai * HALF + m * 16; av[ai][m] = lp[ri < last ? ri : last]; }
#pragma unroll
        for (int ai = 0; ai < 2; ++ai)
#pragma unroll
            for (int m = 0; m < 4; ++m) gv[ai][m] = gates[av[ai][m]];
#pragma unroll
        for (int ai = 0; ai < 2; ++ai)
#pragma unroll
            for (int m = 0; m < 4; ++m) { const int ri = rb + ai * HALF + m * 16;
                if (ri < n) { const int a = av[ai][m]; const float g = gv[ai][m]; bf16_t* rowp = Y + ((size_t)(a & 1) * T + (a >> 1)) * DM + col0;
#pragma unroll
                    for (int bj = 0; bj < 2; ++bj) { const f32x4 v0 = acc[ai][bj][m][0] * g, v1 = acc[ai][bj][m][1] * g;
                        u32x4 w; w.x = cvt_pk_bf16(v0[0], v0[1]); w.y = cvt_pk_bf16(v0[2], v0[3]); w.z = cvt_pk_bf16(v1[0], v1[1]); w.w = cvt_pk_bf16(v1[2], v1[3]);
                        *(u32x4*)(rowp + bj * HALF) = w; } } }
    }
};

template <class Epi, class Sched, bool ALIGN_EPI>
__device__ __forceinline__ void gemm_phase(LAS unsigned char* lds, const Gemm g, const Sched& S, const Epi& E) {
    const int tid = threadIdx.x, wid = __builtin_amdgcn_readfirstlane(tid >> 6), lane = tid & 63, wr = wid >> 2, wc = wid & 3, fr = lane & 15, fq = lane >> 4;
    const int K = g.K, nt = K / BK;
    int RA[2]; unsigned cbA[2], voffB[2];
#pragma unroll
    for (int i = 0; i < 2; ++i) { int R, C; stage_rc(tid * 16 + i * 8192, R, C); const int Rb = Epi::PERM ? ((R & ~31) + perm32(R & 31)) : R;
        RA[i] = R; cbA[i] = (unsigned)C * 2u; voffB[i] = (unsigned)(Rb * K + C) * 2u; }
    const unsigned kstep = (unsigned)(BK * 2);
    const size_t hstep = (size_t)HALF * K * 2;
    const size_t tstep = 2 * hstep;
    const unsigned rowb = (unsigned)K * 2u;
    const unsigned ldsw = (unsigned)wid * 1024u;
    const int aoff = lds_byte(wr * 64 + fr, fq * 8), boff = lds_byte(wc * 32 + fr, fq * 8);
    const char* Ab = (const char*)g.A;
#define PG8_SA(b, h) (((b) * 2 + (h)) * HTB)
#define PG8_SB(b, h) ((4 + (b) * 2 + (h)) * HTB)
#define PG8_STAGE(bufoff, gbase, voff) do { _Pragma("unroll") for (int _i = 0; _i < 2; ++_i) \
        __builtin_amdgcn_global_load_lds((const unsigned*)((const char*)(gbase) + (voff)[_i]), (LAS unsigned*)(lds + (bufoff) + ldsw + _i * 8192), 16, 0, 0); } while (0)
#define PG8_STAGE_A(bufoff, kb, o0, o1) do { \
        __builtin_amdgcn_global_load_lds((const unsigned*)(Ab + (kb) + (o0)), (LAS unsigned*)(lds + (bufoff) + ldsw), 16, 0, 0); \
        __builtin_amdgcn_global_load_lds((const unsigned*)(Ab + (kb) + (o1)), (LAS unsigned*)(lds + (bufoff) + ldsw + 8192), 16, 0, 0); } while (0)
#define PG8_LDA(dst, b, h) do { _Pragma("unroll") for (int m = 0; m < 4; ++m) _Pragma("unroll") for (int k = 0; k < 2; ++k) dst[m][k] = *(const LAS bf16x8*)(lds + PG8_SA(b, h) + aoff + m * 2048 + k * 1024); } while (0)
#define PG8_LDB(dst, b, h) do { _Pragma("unroll") for (int n = 0; n < 2; ++n) _Pragma("unroll") for (int k = 0; k < 2; ++k) dst[n][k] = *(const LAS bf16x8*)(lds + PG8_SB(b, h) + boff + n * 2048 + k * 1024); } while (0)
#define PG8_MMA(ai, bj, At, Bt) do { __builtin_amdgcn_s_setprio(1); _Pragma("unroll") for (int m = 0; m < 4; ++m) _Pragma("unroll") for (int n = 0; n < 2; ++n) _Pragma("unroll") for (int k = 0; k < 2; ++k) \
        acc[ai][bj][m][n] = __builtin_amdgcn_mfma_f32_16x16x32_bf16(Bt[n][k], At[m][k], acc[ai][bj][m][n], 0, 0, 0); __builtin_amdgcn_s_setprio(0); } while (0)
#define PG8_WAIT_V(n) asm volatile("s_waitcnt vmcnt(" #n ")" ::: "memory")
#define PG8_WAIT_L(n) asm volatile("s_waitcnt lgkmcnt(" #n ")" ::: "memory")
#define PG8_BAR __builtin_amdgcn_s_barrier()
#define PG8_SCHED __builtin_amdgcn_sched_barrier(0)
    Unit cur, nxt; int ui = 0;
    if (!S.next(0, cur)) return;
    f32x4 acc[2][2][4][2];
#pragma unroll
    for (int a = 0; a < 2; ++a)
#pragma unroll
        for (int b = 0; b < 2; ++b)
#pragma unroll
            for (int m = 0; m < 4; ++m)
#pragma unroll
                for (int n = 0; n < 2; ++n) acc[a][b][m][n] = (f32x4){0.f, 0.f, 0.f, 0.f};
    bf16x8 At[4][2], B0[2][2], B1[2][2];
    unsigned oC00, oC01, oC10, oC11;
    { unsigned ar[4]; S.arow4(cur, RA[0], RA[1], ar); oC00 = ar[0] * rowb + cbA[0]; oC01 = ar[1] * rowb + cbA[1]; oC10 = ar[2] * rowb + cbA[0]; oC11 = ar[3] * rowb + cbA[1]; }
    const char* cB = (const char*)g.Bt + (size_t)cur.e * g.b_estride + (size_t)cur.pn * tstep;
    PG8_STAGE(PG8_SB(0, 0), cB, voffB); PG8_STAGE(PG8_SB(0, 1), cB + hstep, voffB); PG8_STAGE_A(PG8_SA(0, 0), 0u, oC00, oC01); PG8_STAGE_A(PG8_SA(0, 1), 0u, oC10, oC11);
    if (wr == 1) PG8_BAR;
    PG8_WAIT_V(2); PG8_BAR;
    PG8_STAGE(PG8_SB(1, 0), cB + kstep, voffB); PG8_STAGE_A(PG8_SA(1, 0), kstep, oC00, oC01); PG8_STAGE(PG8_SB(1, 1), cB + hstep + kstep, voffB);
    PG8_WAIT_V(6); PG8_BAR;
    for (;;) {
        const bool has_next = S.next(ui + 1, nxt);
        unsigned oN00 = oC00, oN01 = oC01, oN10 = oC10, oN11 = oC11;
        if (has_next) { unsigned ar[4]; S.arow4(nxt, RA[0], RA[1], ar); oN00 = ar[0] * rowb + cbA[0]; oN01 = ar[1] * rowb + cbA[1]; oN10 = ar[2] * rowb + cbA[0]; oN11 = ar[3] * rowb + cbA[1]; }
        const char* nB = has_next ? (const char*)g.Bt + (size_t)nxt.e * g.b_estride + (size_t)nxt.pn * tstep : cB;
        for (int t = 0; t < nt; t += 2) {
            const bool last = (t == nt - 2);
            const unsigned k1 = (unsigned)(t + 1) * kstep;
            const unsigned k2 = last ? 0u : (unsigned)(t + 2) * kstep, k3 = k2 + kstep;
            const unsigned o00 = last ? oN00 : oC00, o01 = last ? oN01 : oC01, o10 = last ? oN10 : oC10, o11 = last ? oN11 : oC11;
            const char* b2 = last ? nB : cB + (size_t)(t + 2) * kstep; const char* b3 = b2 + kstep;
            PG8_LDB(B0, 0, 0); PG8_LDB(B1, 0, 1); PG8_SCHED; PG8_LDA(At, 0, 0); PG8_STAGE_A(PG8_SA(1, 1), k1, oC10, oC11);
            PG8_WAIT_V(8); PG8_WAIT_L(0); PG8_BAR; PG8_MMA(0, 0, At, B0); PG8_MMA(0, 1, At, B1); PG8_BAR; PG8_SCHED;
            PG8_LDA(At, 0, 1); PG8_STAGE(PG8_SB(0, 0), b2, voffB); PG8_STAGE(PG8_SB(0, 1), b2 + hstep, voffB); PG8_STAGE_A(PG8_SA(0, 0), k2, o00, o01);
            PG8_WAIT_V(8); PG8_WAIT_L(0); PG8_BAR; PG8_MMA(1, 0, At, B0); PG8_MMA(1, 1, At, B1); PG8_BAR; PG8_SCHED;
            PG8_LDB(B0, 1, 0); PG8_LDB(B1, 1, 1); PG8_SCHED; PG8_LDA(At, 1, 0); PG8_STAGE_A(PG8_SA(0, 1), k2, o10, o11);
            PG8_WAIT_V(8); PG8_WAIT_L(0); PG8_BAR; PG8_MMA(0, 0, At, B0); PG8_MMA(0, 1, At, B1); PG8_BAR; PG8_SCHED;
            PG8_LDA(At, 1, 1); PG8_STAGE(PG8_SB(1, 0), b3, voffB); PG8_STAGE(PG8_SB(1, 1), b3 + hstep, voffB); PG8_STAGE_A(PG8_SA(1, 0), k3, o00, o01);
            PG8_WAIT_V(8); PG8_WAIT_L(0); PG8_BAR; PG8_MMA(1, 0, At, B0); PG8_MMA(1, 1, At, B1); PG8_BAR; PG8_SCHED;
        }
        if constexpr (ALIGN_EPI) { if (wr == 0) PG8_BAR; }
        E(acc, cur, wr, wc, fr, fq);
        if (!has_next) break;
#pragma unroll
        for (int a = 0; a < 2; ++a)
#pragma unroll
            for (int b = 0; b < 2; ++b)
#pragma unroll
                for (int m = 0; m < 4; ++m)
#pragma unroll
                    for (int n = 0; n < 2; ++n) acc[a][b][m][n] = (f32x4){0.f, 0.f, 0.f, 0.f};
        cur = nxt; cB = nB; oC00 = oN00; oC01 = oN01; oC10 = oN10; oC11 = oN11; ++ui;
        if constexpr (ALIGN_EPI) { if (wr == 1) PG8_BAR; }
    }
    PG8_WAIT_V(0);
    if constexpr (!ALIGN_EPI) { if (wr == 0) PG8_BAR; }
    PG8_BAR;
#undef PG8_SA
#undef PG8_SB
#undef PG8_STAGE
#undef PG8_STAGE_A
#undef PG8_LDA
#undef PG8_LDB
#undef PG8_MMA
#undef PG8_WAIT_V
#undef PG8_WAIT_L
#undef PG8_BAR
#undef PG8_SCHED
}
}
}
namespace att {
using namespace mk;
constexpr int KVBLK = 64;
constexpr int A_K = 0, A_V = 32768, A_WS = 65536, A_OST = A_WS + NWAVES * 256, A_BIAS = A_OST + NWAVES * 4096, A_SCAN = A_BIAS + 8192, A_BYTES = A_SCAN + 64;
static_assert(A_BYTES <= RING_BYTES, "attention LDS");
__device__ __forceinline__ int crow(int r, int hi) { return (r & 3) + 8 * (r >> 2) + 4 * hi; }
__device__ __forceinline__ void glds16(const void* gsrc, unsigned lds_dst) { unsigned keep;
    asm volatile("s_mov_b32 %0, m0\n\ts_mov_b32 m0, %2\n\ts_nop 0\n\tglobal_load_lds_dwordx4 %1, off\n\ts_mov_b32 m0, %0" : "=&s"(keep) : "v"(gsrc), "s"(lds_dst) : "memory"); }
__device__ __forceinline__ unsigned cvtpk(float lo, float hi) { return cvt_pk_bf16(lo, hi); }
__device__ __forceinline__ void qkt(f32x16& p0, f32x16& p1, const LAS char* Kslot, const bf16x8* qr, int r32, int hi) {
    const LAS char* kb = Kslot + hi * 1024 + r32 * 16;
    const f32x16 z = {};
#pragma unroll
    for (int d0 = 0; d0 < 4; ++d0) {
        const bf16x8 b0 = *(const LAS bf16x8*)(kb + d0 * 2048);
        const bf16x8 b1 = *(const LAS bf16x8*)(kb + d0 * 2048 + 512);
        if (d0 == 0) { p0 = __builtin_amdgcn_mfma_f32_32x32x16_bf16(b0, qr[0], z, 0, 0, 0); p1 = __builtin_amdgcn_mfma_f32_32x32x16_bf16(b1, qr[0], z, 0, 0, 0); }
        else { p0 = __builtin_amdgcn_mfma_f32_32x32x16_bf16(b0, qr[d0], p0, 0, 0, 0); p1 = __builtin_amdgcn_mfma_f32_32x32x16_bf16(b1, qr[d0], p1, 0, 0, 0); } }
}
__device__ __forceinline__ void pv(f32x16* o, int vb, bf16x8 pa0, bf16x8 pa1, bf16x8 pa2, bf16x8 pa3) {
#pragma unroll
    for (int d0 = 0; d0 < 2; ++d0) { s16x4 lo[4], hi[4];
#pragma unroll
        for (int ks = 0; ks < 4; ++ks) {
            asm volatile("ds_read_b64_tr_b16 %0,%1 offset:%c2" : "=&v"(lo[ks]) : "v"(vb), "i"(d0 * 4096 + ks * 1024) : "memory");
            asm volatile("ds_read_b64_tr_b16 %0,%1 offset:%c2" : "=&v"(hi[ks]) : "v"(vb), "i"(d0 * 4096 + ks * 1024 + 512) : "memory"); }
        asm volatile("s_waitcnt lgkmcnt(0)" ::: "memory"); __builtin_amdgcn_sched_barrier(0);
#define PK(k) (bf16x8){lo[k][0], lo[k][1], lo[k][2], lo[k][3], hi[k][0], hi[k][1], hi[k][2], hi[k][3]}
        o[d0] = __builtin_amdgcn_mfma_f32_32x32x16_bf16(pa0, PK(0), o[d0], 0, 0, 0);
        o[d0] = __builtin_amdgcn_mfma_f32_32x32x16_bf16(pa1, PK(1), o[d0], 0, 0, 0);
        o[d0] = __builtin_amdgcn_mfma_f32_32x32x16_bf16(pa2, PK(2), o[d0], 0, 0, 0);
        o[d0] = __builtin_amdgcn_mfma_f32_32x32x16_bf16(pa3, PK(3), o[d0], 0, 0, 0);
#undef PK
    }
}
__device__ __forceinline__ float rowmax32(const f32x16& p0, const f32x16& p1) {
    float a = fmaxf(p0[0], p1[0]);
#pragma unroll
    for (int r = 1; r < 16; ++r) a = fmaxf(a, fmaxf(p0[r], p1[r]));
    auto rr = __builtin_amdgcn_permlane32_swap(__float_as_uint(a), __float_as_uint(a), false, false);
    return fmaxf(__uint_as_float(rr[0]), __uint_as_float(rr[1]));
}
#define A_WAIT_BAR(N) asm volatile("s_waitcnt vmcnt(" #N ") lgkmcnt(0)\n\ts_barrier" ::: "memory")

template <bool SWA>
__device__ __forceinline__ void attn_tiles(LAS char* shm, const bf16_t* Qw, int qpitch, const bf16_t* Kh, const bf16_t* Vh, int kvpitch, bf16_t* Ow, int opitch,
                                           int kt0, int ntile, int qpos0, float sl2, float sink2) {
    const int tid = threadIdx.x, lane = tid & 63, r32 = lane & 31, hi = lane >> 5; const int wid = __builtin_amdgcn_readfirstlane(tid >> 6);
    const unsigned lds0 = (unsigned)(uintptr_t)shm;
    LAS float* wsf = (LAS float*)(shm + A_WS) + wid * 64;
    const LAS float* biasl = (const LAS float*)(shm + A_BIAS);
    const bf16_t* ksrc = Kh + (long)lane * kvpitch + wid * 8;
    const bf16_t* vsrc = Vh + (long)(16 * (wid & 3) + (lane >> 2)) * kvpitch + (wid >> 2) * 32 + (lane & 3) * 8;
    const unsigned kdst = lds0 + A_K + wid * 1024, vdst = lds0 + A_V + wid * 1024;
#define DMA_K(t, slot) glds16(ksrc + (long)(t) * KVBLK * kvpitch, (unsigned)__builtin_amdgcn_readfirstlane(kdst + (slot)))
#define DMA_V(t, slot) glds16(vsrc + (long)(t) * KVBLK * kvpitch, (unsigned)__builtin_amdgcn_readfirstlane(vdst + (slot)))
    const int vb0 = (int)(lds0 + A_V) + ((lane >> 4) & 1) * 32 + (lane & 3) * 8 + (4 * hi + ((lane & 15) >> 2)) * 64;
    DMA_K(kt0, 0); DMA_V(kt0, 0);
    if (ntile > 1) { DMA_K(kt0 + 1, 8192); DMA_V(kt0 + 1, 8192); }
    if (ntile > 2) { DMA_K(kt0 + 2, 16384); DMA_V(kt0 + 2, 16384); }
    bf16x8 qr[4];
#pragma unroll
    for (int d0 = 0; d0 < 4; ++d0) qr[d0] = *(const bf16x8*)(Qw + (long)r32 * qpitch + d0 * 16 + hi * 8);
    float m = SWA ? sink2 : -INFINITY, l = (SWA && hi == 0) ? 1.f : 0.f;
    f32x16 o[2]; o[0] = f32x16{}; o[1] = f32x16{};
    const int qpos = qpos0 + r32;
    if (ntile > 2) { A_WAIT_BAR(4); } else if (ntile > 1) { A_WAIT_BAR(2); } else { A_WAIT_BAR(0); }
    f32x16 p0, p1;
    qkt(p0, p1, shm + A_K, qr, r32, hi);
    for (int it = 0; it < ntile; ++it) {
        const int kt = kt0 + it, slot = (it & 3) * 8192;
        f32x16 n0, n1;
        if (it + 1 < ntile) {
            if (it + 2 < ntile) { A_WAIT_BAR(2); } else { A_WAIT_BAR(0); }
            if (it + 3 < ntile) { DMA_K(kt + 3, ((it + 3) & 3) * 8192); DMA_V(kt + 3, ((it + 3) & 3) * 8192); }
            qkt(n0, n1, shm + A_K + ((it + 1) & 3) * 8192, qr, r32, hi);
        }
        const int kb = kt * 64 + 4 * hi;
        if (SWA) {
#pragma unroll
            for (int r = 0; r < 16; ++r) { const int k0 = kb + (r & 3) + 8 * (r >> 2), k1 = k0 + 32;
                p0[r] = (k0 <= qpos && k0 >= qpos - 127) ? p0[r] + sl2 * (float)(k0 - qpos) : -INFINITY;
                p1[r] = (k1 <= qpos && k1 >= qpos - 127) ? p1[r] + sl2 * (float)(k1 - qpos) : -INFINITY; }
        } else {
#pragma unroll
            for (int g = 0; g < 4; ++g) { const f32x4 b0 = *(const LAS f32x4*)(biasl + kb + 8 * g), b1 = *(const LAS f32x4*)(biasl + kb + 32 + 8 * g);
#pragma unroll
                for (int i = 0; i < 4; ++i) { p0[4 * g + i] += b0[i]; p1[4 * g + i] += b1[i]; } }
            if (kt * 64 + 63 > qpos0) {
#pragma unroll
                for (int r = 0; r < 16; ++r) { const int k0 = kb + (r & 3) + 8 * (r >> 2); if (k0 > qpos) p0[r] = -INFINITY; if (k0 + 32 > qpos) p1[r] = -INFINITY; }
            }
        }
        const float rm = rowmax32(p0, p1), mn = fmaxf(m, rm), ms = (mn == -INFINITY) ? 0.f : mn;
        const float alpha = __builtin_amdgcn_exp2f(m - ms);
        float rs = 0.f;
#pragma unroll
        for (int r = 0; r < 16; ++r) { p0[r] = __builtin_amdgcn_exp2f(p0[r] - ms); p1[r] = __builtin_amdgcn_exp2f(p1[r] - ms); rs += p0[r] + p1[r]; }
        l = l * alpha + rs; m = mn;
        if (hi == 0) wsf[r32] = alpha;
        asm volatile("s_waitcnt lgkmcnt(0)" ::: "memory");
#pragma unroll
        for (int r = 0; r < 16; ++r) { const float a = wsf[crow(r, hi)]; o[0][r] *= a; o[1][r] *= a; }
        u32x4 pw0, pw1, pw2, pw3;
        pw0 = (u32x4){cvtpk(p0[0], p0[1]), cvtpk(p0[2], p0[3]), cvtpk(p0[4], p0[5]), cvtpk(p0[6], p0[7])};
        pw1 = (u32x4){cvtpk(p0[8], p0[9]), cvtpk(p0[10], p0[11]), cvtpk(p0[12], p0[13]), cvtpk(p0[14], p0[15])};
        pw2 = (u32x4){cvtpk(p1[0], p1[1]), cvtpk(p1[2], p1[3]), cvtpk(p1[4], p1[5]), cvtpk(p1[6], p1[7])};
        pw3 = (u32x4){cvtpk(p1[8], p1[9]), cvtpk(p1[10], p1[11]), cvtpk(p1[12], p1[13]), cvtpk(p1[14], p1[15])};
        pv(o, vb0 + slot, __builtin_bit_cast(bf16x8, pw0), __builtin_bit_cast(bf16x8, pw1), __builtin_bit_cast(bf16x8, pw2), __builtin_bit_cast(bf16x8, pw3));
        asm volatile("s_waitcnt lgkmcnt(0)" ::: "memory");
        if (it + 1 < ntile) { p0 = n0; p1 = n1; }
    }
    { auto rr = __builtin_amdgcn_permlane32_swap(__float_as_uint(l), __float_as_uint(l), false, false); l = __uint_as_float(rr[0]) + __uint_as_float(rr[1]); }
    if (hi == 0) wsf[32 + r32] = l;
    asm volatile("s_waitcnt lgkmcnt(0)" ::: "memory");
    LAS bf16_t* stg = (LAS bf16_t*)(shm + A_OST) + wid * 2048;
#pragma unroll
    for (int r = 0; r < 16; ++r) { const int orow = crow(r, hi); const float rl = 1.f / wsf[32 + orow];
#pragma unroll
        for (int d0 = 0; d0 < 2; ++d0) stg[orow * 64 + d0 * 32 + r32] = (bf16_t)(cvt_pk_bf16(o[d0][r] * rl, 0.f) & 0xffffu); }
    asm volatile("s_waitcnt lgkmcnt(0)" ::: "memory");
#pragma unroll
    for (int i = 0; i < 4; ++i) { const int row = i * 8 + (lane >> 3), ch = lane & 7; const u32x4 v = *(const LAS u32x4*)(stg + row * 64 + ch * 8); *(u32x4*)(Ow + (long)row * opitch + ch * 8) = v; }
    asm volatile("s_waitcnt vmcnt(0) lgkmcnt(0)\n\ts_barrier" ::: "memory");
#undef DMA_K
#undef DMA_V
}

__device__ __forceinline__ void fox_unit(LAS char* shm, int b, int h, int qb, const bf16_t* proj, const float* fb, float fbias_h, bf16_t* heads) {
    const int tid = threadIdx.x, lane = tid & 63; const int wid = __builtin_amdgcn_readfirstlane(tid >> 6);
    LAS float* biasl = (LAS float*)(shm + A_BIAS); LAS float* scan = (LAS float*)(shm + A_SCAN);
    const int kend = (qb + 1) * 256;
    float v[4]; float s = 0.f;
#pragma unroll
    for (int i = 0; i < 4; ++i) { const int p = tid * 4 + i; const float fv = fb[((size_t)b * SEQ + (p < kend ? p : kend - 1)) * 8 + h]; const float lf = p < kend ? log_sigmoid_fast(fv + fbias_h) : 0.f; s += lf; v[i] = s; }
    float w = s;
#pragma unroll
    for (int o = 1; o < 64; o <<= 1) { const float t = __shfl_up(w, o); if (lane >= o) w += t; }
    if (lane == 63) scan[wid] = w;
    asm volatile("s_waitcnt lgkmcnt(0)\n\ts_barrier" ::: "memory");
    float off = w - s;
    for (int k = 0; k < 8; ++k) if (k < wid) off += scan[k];
#pragma unroll
    for (int i = 0; i < 4; ++i) biasl[tid * 4 + i] = -(v[i] + off) * LOG2E;
    asm volatile("s_waitcnt lgkmcnt(0)\n\ts_barrier" ::: "memory");
    const size_t rowb = (size_t)b * SEQ; const int q0 = qb * 256 + wid * 32;
    attn_tiles<false>(shm, proj + (rowb + q0) * NE_IN + 768 + h * 64, NE_IN, proj + rowb * NE_IN + 1280 + h * 64, proj + rowb * NE_IN + 1792 + h * 64, NE_IN,
                      heads + (rowb + q0) * 1024 + 512 + h * 64, 1024, 0, 4 * (qb + 1), q0, 0.f, 0.f);
}
__device__ __forceinline__ void swa_unit(LAS char* shm, int b, int kvh, int blk, const bf16_t* proj, const float* sinks, bf16_t* heads) {
    const int wid = __builtin_amdgcn_readfirstlane(threadIdx.x >> 6);
    const int qh = kvh * 4 + (wid >> 1), q0 = blk * 64 + (wid & 1) * 32;
    const size_t rowb = (size_t)b * SEQ;
    const int kt0 = blk >= 2 ? blk - 2 : 0, ntile = blk - kt0 + 1;
    const float sl2 = exp2f(-(float)(qh + 1)) * LOG2E, sink2 = sinks[qh] * LOG2E;
    attn_tiles<true>(shm, proj + (rowb + q0) * NE_IN + qh * 64, NE_IN, proj + rowb * NE_IN + 512 + kvh * 64, proj + rowb * NE_IN + 640 + kvh * 64, NE_IN,
                     heads + (rowb + q0) * 1024 + qh * 64, 1024, kt0, ntile, q0, sl2, sink2);
}
#undef A_WAIT_BAR
}

namespace attp {
using bf16=__hip_bfloat16;
using bf16x8=__attribute__((ext_vector_type(8)))short;
using s16x4=__attribute__((ext_vector_type(4)))short;
using f32x16=__attribute__((ext_vector_type(16)))float;
using u32x4=__attribute__((ext_vector_type(4)))unsigned;
constexpr int BATCH=8,NHEAD=8,SEQ=2048,D=64,DM=2560,OPITCH=1024;
constexpr int NW=8,QBLK=32,QB=QBLK*NW,KVBLK=64,NQB=SEQ/QB;
constexpr int ATTN_PITCH=DM, ATTN_UNIT_ROWS=QB;
__device__ __forceinline__ int crow(int r,int hi){return (r&3)+8*(r>>2)+4*hi;}
#define SBAR() __builtin_amdgcn_sched_barrier(0)
__device__ __forceinline__ void cmask(f32x16&p0,f32x16&p1,int jb,int qrel,int hi){
  const float NEG=-INFINITY; int kb=64*jb+4*hi;
  #pragma unroll
  for(int r=0;r<16;++r){int kv=kb+(r&3)+8*(r>>2); if(kv>qrel)p0[r]=NEG; if(kv+32>qrel)p1[r]=NEG;}
}

constexpr int NSLOT=3, SLOTB=8192;
constexpr int LDS_K=0, LDS_V=NSLOT*SLOTB, LDS_WS=2*NSLOT*SLOTB, LDS_OST=LDS_WS+NW*64*4, LDS_BIAS=LDS_OST+NW*4096, LDS_SCAN=LDS_BIAS+8192, LDS_BYTES=LDS_SCAN+64;
constexpr float C2=0.125f*1.4426950408889634f;
__device__ __forceinline__ void glds16(const void*gsrc,unsigned lds_dst){unsigned keep;
  asm volatile("s_mov_b32 %0, m0\n\ts_mov_b32 m0, %2\n\ts_nop 0\n\tglobal_load_lds_dwordx4 %1, off\n\ts_mov_b32 m0, %0":"=&s"(keep):"v"(gsrc),"s"(lds_dst):"memory");}
__device__ __forceinline__ float max3f(float a,float b,float c){float r;asm("v_max3_f32 %0, %1, %2, %3":"=v"(r):"v"(a),"v"(b),"v"(c));return r;}
__device__ __forceinline__ float max2f(float a,float b){float r;asm("v_max_f32_e32 %0, %1, %2":"=v"(r):"v"(a),"v"(b));return r;}
__device__ __forceinline__ float fadd_s(float a,float b){float r;asm("v_add_f32_e32 %0, %1, %2":"=v"(r):"v"(a),"v"(b));return r;}
__device__ __forceinline__ float fsub_s(float a,float b){float r;asm("v_sub_f32_e32 %0, %1, %2":"=v"(r):"v"(a),"v"(b));return r;}
typedef float f32x2_t __attribute__((ext_vector_type(2))); typedef __bf16 bf16x2_t __attribute__((ext_vector_type(2)));
__device__ __forceinline__ unsigned cvtpk_s(float lo,float hi){f32x2_t v={lo,hi};bf16x2_t b=__builtin_convertvector(v,bf16x2_t);return __builtin_bit_cast(unsigned,b);}
#define WAIT_BAR(N) asm volatile("s_waitcnt vmcnt(" #N ") lgkmcnt(0)\n\ts_barrier":::"memory")

__device__ __forceinline__ void qkt(f32x16&p0,f32x16&p1,const char*Kslot,const bf16x8*qr,int r32,int hi){ const f32x16 zc_=f32x16{};
  const char*kb=Kslot+hi*1024+r32*16;
  #pragma unroll
  for(int d0=0;d0<4;++d0){
    const bf16x8 b0=*reinterpret_cast<const bf16x8*>(kb+d0*2048);
    const bf16x8 b1=*reinterpret_cast<const bf16x8*>(kb+d0*2048+512);
    if(d0==0){p0=__builtin_amdgcn_mfma_f32_32x32x16_bf16(b0,qr[0],zc_,0,0,0);p1=__builtin_amdgcn_mfma_f32_32x32x16_bf16(b1,qr[0],zc_,0,0,0);}
    else{p0=__builtin_amdgcn_mfma_f32_32x32x16_bf16(b0,qr[d0],p0,0,0,0);p1=__builtin_amdgcn_mfma_f32_32x32x16_bf16(b1,qr[d0],p1,0,0,0);}}
}
typedef __attribute__((address_space(3))) const char* lds_cptr;
typedef short v4i16_t __attribute__((ext_vector_type(4)));
__device__ __forceinline__ void kload8(bf16x8*kf,lds_cptr kp){
  kf[0]=*(const __attribute__((address_space(3))) bf16x8*)(kp);      kf[1]=*(const __attribute__((address_space(3))) bf16x8*)(kp+512);
  kf[2]=*(const __attribute__((address_space(3))) bf16x8*)(kp+2048); kf[3]=*(const __attribute__((address_space(3))) bf16x8*)(kp+2560);
  kf[4]=*(const __attribute__((address_space(3))) bf16x8*)(kp+4096); kf[5]=*(const __attribute__((address_space(3))) bf16x8*)(kp+4608);
  kf[6]=*(const __attribute__((address_space(3))) bf16x8*)(kp+6144); kf[7]=*(const __attribute__((address_space(3))) bf16x8*)(kp+6656);
}
__device__ __forceinline__ void kload2(bf16x8*kf,lds_cptr kp,int j){ kf[2*j]=*(const __attribute__((address_space(3))) bf16x8*)(kp+j*2048); kf[2*j+1]=*(const __attribute__((address_space(3))) bf16x8*)(kp+j*2048+512); }
__device__ __forceinline__ s16x4 vtr(lds_cptr p){ return __builtin_bit_cast(s16x4,__builtin_amdgcn_ds_read_tr16_b64_v4i16((__attribute__((address_space(3))) v4i16_t*)p)); }
__device__ __forceinline__ float rowmax(const f32x16&p0,const f32x16&p1){
  float a=max3f(p0[0],p0[1],p1[0]),b=max3f(p0[2],p0[3],p1[1]);a=max3f(a,p1[2],p1[3]);
  #pragma unroll
  for(int r=4;r<16;r+=4){a=max3f(a,p0[r],p0[r+1]);b=max3f(b,p0[r+2],p0[r+3]);a=max3f(a,p1[r],p1[r+1]);b=max3f(b,p1[r+2],p1[r+3]);}
  const float m=max2f(a,b);
  auto rr=__builtin_amdgcn_permlane32_swap(__float_as_uint(m),__float_as_uint(m),false,false);
  return max2f(__uint_as_float(rr[0]),__uint_as_float(rr[1]));
}
__device__ __forceinline__ void pv(f32x16*o,int vb,bf16x8 pa0,bf16x8 pa1,bf16x8 pa2,bf16x8 pa3){
  #pragma unroll
  for(int d0=0;d0<2;++d0){s16x4 lo[4],hi[4];
    #pragma unroll
    for(int ks=0;ks<4;++ks){
      asm volatile("ds_read_b64_tr_b16 %0,%1 offset:%c2":"=&v"(lo[ks]):"v"(vb),"i"(d0*4096+ks*1024):"memory");
      asm volatile("ds_read_b64_tr_b16 %0,%1 offset:%c2":"=&v"(hi[ks]):"v"(vb),"i"(d0*4096+ks*1024+512):"memory");}
    asm volatile("s_waitcnt lgkmcnt(0)":::"memory");SBAR();
    #define PK(k) (bf16x8){lo[k][0],lo[k][1],lo[k][2],lo[k][3],hi[k][0],hi[k][1],hi[k][2],hi[k][3]}
    o[d0]=__builtin_amdgcn_mfma_f32_32x32x16_bf16(pa0,PK(0),o[d0],0,0,0);
    o[d0]=__builtin_amdgcn_mfma_f32_32x32x16_bf16(pa1,PK(1),o[d0],0,0,0);
    o[d0]=__builtin_amdgcn_mfma_f32_32x32x16_bf16(pa2,PK(2),o[d0],0,0,0);
    o[d0]=__builtin_amdgcn_mfma_f32_32x32x16_bf16(pa3,PK(3),o[d0],0,0,0);
    #undef PK
  }
}

#ifndef ATTN_STORE16
#define ATTN_STORE16(p,v) (*(u32x4*)(p)=(v))
#endif
template<int THRL,bool CHECK> __device__ __forceinline__ void attn_unit(int b,int h,int qb,const bf16*Q,const bf16*__restrict__ K,const bf16*__restrict__ V,bf16*O,char*shm,unsigned*mism){
  const int tid=threadIdx.x,lane=tid&63,r32=lane&31,hi=lane>>5; const int wid=__builtin_amdgcn_readfirstlane(tid>>6);
  const long rowbase=(long)b*SEQ; const int q0=qb*QB;
  const bf16*Qw=Q+(rowbase+q0+wid*QBLK)*DM+h*D;
  const bf16*Kh=K+rowbase*DM+h*D,*Vh=V+rowbase*DM+h*D;
  const unsigned lds0=(unsigned)(uintptr_t)shm;
  float*wsf=(float*)(shm+LDS_WS)+wid*64;
  const bf16*ksrc=Kh+(long)lane*DM+wid*8;
  const bf16*vsrc=Vh+(long)(16*(wid&3)+(lane>>2))*DM+(wid>>2)*32+(lane&3)*8;
  const unsigned kdst=lds0+LDS_K+wid*1024, vdst=lds0+LDS_V+wid*1024;
  #define DMA_K(t,slot) glds16(ksrc+(long)(t)*KVBLK*DM,(unsigned)__builtin_amdgcn_readfirstlane(kdst+(slot)))
  #define DMA_V(t,slot) glds16(vsrc+(long)(t)*KVBLK*DM,(unsigned)__builtin_amdgcn_readfirstlane(vdst+(slot)))
  const int vb0=(int)(lds0+LDS_V)+((lane>>4)&1)*32+(lane&3)*8+(4*hi+((lane&15)>>2))*64;
  const char*Kbase=shm+LDS_K; bf16x8 kf[8];
  const lds_cptr shm3=(lds_cptr)shm; const lds_cptr kp0=shm3+LDS_K+hi*1024+r32*16; const lds_cptr vp0=shm3+LDS_V+((lane>>4)&1)*32+(lane&3)*8+(4*hi+((lane&15)>>2))*64;
  const int NT=(q0+QB)/KVBLK;
  DMA_K(0,0);DMA_V(0,0);DMA_K(1,SLOTB);
  bf16x8 qr[4];
  #pragma unroll
  for(int d0=0;d0<4;++d0)qr[d0]=*reinterpret_cast<const bf16x8*>(&Qw[(long)r32*DM+d0*16+hi*8]);
  float mhat=0.f,l_reg=0.f;f32x16 o[2];o[0]=f32x16{};o[1]=f32x16{};u32x4 qaw={hi==0?0x3f803f80u:0u,0u,0u,0u};
  const int qrel=wid*QBLK+r32;
  #define CMASK(P0,P1,t) do{int jb_=(t)-(NT-4); if(jb_>=0)cmask(P0,P1,jb_,qrel,hi);}while(0)
  const __attribute__((address_space(3))) unsigned* biasw=(const __attribute__((address_space(3))) unsigned*)(shm3+LDS_BIAS)+r32;
  #define SETM() do{ const float nm_=-mhat; const unsigned h_=cvtpk_s(nm_,0.f)&0xffffu; const unsigned l_=cvtpk_s(nm_-__uint_as_float(h_<<16),0.f)&0xffffu; qaw[1]=(hi==0)?(h_|(l_<<16)):0u; }while(0)
  #define AUG(P0,P1,t) do{ const unsigned w0_=biasw[64*(t)], w1_=biasw[64*(t)+32]; const u32x4 ka0_={w0_,0x3f803f80u,0u,0u}, ka1_={w1_,0x3f803f80u,0u,0u}; \
      P0=__builtin_amdgcn_mfma_f32_32x32x16_bf16(__builtin_bit_cast(bf16x8,ka0_),__builtin_bit_cast(bf16x8,qaw),P0,0,0,0); \
      P1=__builtin_amdgcn_mfma_f32_32x32x16_bf16(__builtin_bit_cast(bf16x8,ka1_),__builtin_bit_cast(bf16x8,qaw),P1,0,0,0); }while(0)
  bool resc=false;
  #define START(P0,P1) do{ const float rm=rowmax(P0,P1); resc=false; \
    { const float dl=rm; mhat=fadd_s(mhat,dl); \
      _Pragma("unroll") for(int r=0;r<16;++r){P0[r]=fsub_s(P0[r],dl);P1[r]=fsub_s(P1[r],dl);} \
      SETM(); } \
    _Pragma("unroll") for(int r=0;r<16;++r)P0[r]=__builtin_amdgcn_exp2f(P0[r]); }while(0)
  #define RESC() do{ if(resc){ asm volatile("s_waitcnt lgkmcnt(0)":::"memory"); \
      _Pragma("unroll") for(int d_=0;d_<2;++d_) _Pragma("unroll") for(int r=0;r<16;++r)o[d_][r]*=wsf[crow(r,hi)]; } }while(0)
  f32x16 pA0,pA1,pB0,pB1;
  int sl_prev=0,sl_cur=0,sl_next=SLOTB;
  #define ROT() do{sl_prev=sl_cur;sl_cur=sl_next;sl_next=(sl_next==(NSLOT-1)*SLOTB)?0:sl_next+SLOTB;}while(0)
  DMA_K(2,2*SLOTB);
  WAIT_BAR(3);
  qkt(pA0,pA1,Kbase,qr,r32,hi);AUG(pA0,pA1,0);asm volatile("s_nop 15\n\ts_nop 7":"+v"(pA0),"+v"(pA1));CMASK(pA0,pA1,0);
  START(pA0,pA1);
  _Pragma("unroll") for(int r=0;r<16;++r)pA1[r]=__builtin_amdgcn_exp2f(pA1[r]);
  WAIT_BAR(0);
  DMA_K(3,0);DMA_V(1,SLOTB);
  ROT();
  kload8(kf,kp0+sl_cur);
  WAIT_BAR(2);
  s16x4 vlo[8],vhi[8]; u32x4 pw0,pw1,pw2,pw3; const f32x16 zc16=f32x16{};
  #define PKW(P,B) cvtpk_s(P[B],P[B+1])
  #define PAF(k) __builtin_bit_cast(bf16x8,pw##k)
  #define VFR(i) (bf16x8){vlo[i][0],vlo[i][1],vlo[i][2],vlo[i][3],vhi[i][0],vhi[i][1],vhi[i][2],vhi[i][3]}
  #define PIN(x) asm volatile("":"+v"(x))
  #define MX3(a,b,c) __builtin_fmaxf(__builtin_fmaxf((a),(b)),(c))
  #define GAPA(MF,A0,A1,A2,A3,W0,W1,PW) do{ MF; sacc+=A0; sacc+=A1; sacc+=A2; sacc+=A3; PIN(sacc); W0; W1; PIN(PW); SBAR(); }while(0)
  #define EX(v) __builtin_amdgcn_exp2f(v)
  #define GAPB(MF,X,B) do{ MF; X[B]=EX(X[B]); X[B+1]=EX(X[B+1]); X[B+2]=EX(X[B+2]); X[B+3]=EX(X[B+3]); PIN(X); SBAR(); }while(0)
  #define VRD(i) do{ vlo[i]=vtr(vp_+(((i)>>2)*4096+((i)&3)*1024)); vhi[i]=vtr(vp_+(((i)>>2)*4096+((i)&3)*1024+512)); }while(0)
  #define KRD(G,j) do{ if(G){ kload2(kf,kp0+sl_next,j); SBAR(); } }while(0)
  #define STEP(C0,C1,P0,P1,t,GK,GV,GL) do{ SBAR(); \
    const lds_cptr vp_=vp0+sl_prev; \
    VRD(0); SBAR(); float sacc=(P0[0]+P0[1]); \
    GAPA(C0=__builtin_amdgcn_mfma_f32_32x32x16_bf16(kf[0],qr[0],zc16,0,0,0), P0[2],P0[3],P0[4],P0[5],     pw0[0]=PKW(P0,0), pw0[1]=PKW(P0,2), pw0); \
    VRD(4); SBAR(); GAPA(C1=__builtin_amdgcn_mfma_f32_32x32x16_bf16(kf[1],qr[0],zc16,0,0,0), P0[6],P0[7],P0[8],P0[9],     pw0[2]=PKW(P0,4), pw0[3]=PKW(P0,6), pw0); \
    VRD(1); SBAR(); GAPA(C0=__builtin_amdgcn_mfma_f32_32x32x16_bf16(kf[2],qr[1],C0,0,0,0),   P0[10],P0[11],P0[12],P0[13], pw1[0]=PKW(P0,8), pw1[1]=PKW(P0,10), pw1); \
    VRD(5); SBAR(); GAPA(C1=__builtin_amdgcn_mfma_f32_32x32x16_bf16(kf[3],qr[1],C1,0,0,0),   P0[14],P0[15],P1[0],P1[1],   pw1[2]=PKW(P0,12),pw1[3]=PKW(P0,14), pw1); \
    VRD(2); SBAR(); GAPA(C0=__builtin_amdgcn_mfma_f32_32x32x16_bf16(kf[4],qr[2],C0,0,0,0),   P1[2],P1[3],P1[4],P1[5],     pw2[0]=PKW(P1,0), pw2[1]=PKW(P1,2), pw2); \
    VRD(6); SBAR(); GAPA(C1=__builtin_amdgcn_mfma_f32_32x32x16_bf16(kf[5],qr[2],C1,0,0,0),   P1[6],P1[7],P1[8],P1[9],     pw2[2]=PKW(P1,4), pw2[3]=PKW(P1,6), pw2); \
    VRD(3); SBAR(); GAPA(C0=__builtin_amdgcn_mfma_f32_32x32x16_bf16(kf[6],qr[3],C0,0,0,0),   P1[10],P1[11],P1[12],P1[13], pw3[0]=PKW(P1,8), pw3[1]=PKW(P1,10), pw3); \
    VRD(7); SBAR(); GAPA(C1=__builtin_amdgcn_mfma_f32_32x32x16_bf16(kf[7],qr[3],C1,0,0,0),   P1[14],P1[15],0.f,0.f,       pw3[2]=PKW(P1,12),pw3[3]=PKW(P1,14), pw3); \
    AUG(C0,C1,t); l_reg+=sacc; \
    if(GK){DMA_K((t)+3,sl_cur);} if(GV){DMA_V((t)+1,sl_next);} \
    CMASK(C0,C1,t); \
    { float a=MX3(C0[0],C0[1],C1[0]),b=MX3(C0[2],C0[3],C1[1]); a=MX3(a,C1[2],C1[3]); \
      _Pragma("unroll") for(int r=4;r<16;r+=4){a=MX3(a,C0[r],C0[r+1]);b=MX3(b,C0[r+2],C0[r+3]);a=MX3(a,C1[r],C1[r+1]);b=MX3(b,C1[r+2],C1[r+3]);} \
      float rm=__builtin_fmaxf(a,b); { auto rr=__builtin_amdgcn_permlane32_swap(__float_as_uint(rm),__float_as_uint(rm),false,false); rm=__builtin_fmaxf(__uint_as_float(rr[0]),__uint_as_float(rr[1])); } \
      resc=false; \
      if(__builtin_expect(__any(rm>(float)THRL),0)){ const float dl=__builtin_fmaxf(rm,0.f); mhat+=dl; \
        _Pragma("unroll") for(int r=0;r<16;++r){C0[r]-=dl;C1[r]-=dl;} \
        SETM(); \
        const float f=__builtin_amdgcn_exp2f(-dl); l_reg*=f; if(hi==0)wsf[r32]=f; resc=true; } } \
    SBAR(); \
    GAPB(o[0]=__builtin_amdgcn_mfma_f32_32x32x16_bf16(PAF(0),VFR(0),o[0],0,0,0), C0,0); \
    GAPB(o[1]=__builtin_amdgcn_mfma_f32_32x32x16_bf16(PAF(0),VFR(4),o[1],0,0,0), C0,4); \
    KRD(GL,0); GAPB(o[0]=__builtin_amdgcn_mfma_f32_32x32x16_bf16(PAF(1),VFR(1),o[0],0,0,0), C0,8); \
    KRD(GL,1); GAPB(o[1]=__builtin_amdgcn_mfma_f32_32x32x16_bf16(PAF(1),VFR(5),o[1],0,0,0), C0,12); \
    KRD(GL,2); GAPB(o[0]=__builtin_amdgcn_mfma_f32_32x32x16_bf16(PAF(2),VFR(2),o[0],0,0,0), C1,0); \
    KRD(GL,3); GAPB(o[1]=__builtin_amdgcn_mfma_f32_32x32x16_bf16(PAF(2),VFR(6),o[1],0,0,0), C1,4); \
    GAPB(o[0]=__builtin_amdgcn_mfma_f32_32x32x16_bf16(PAF(3),VFR(3),o[0],0,0,0), C1,8); \
    GAPB(o[1]=__builtin_amdgcn_mfma_f32_32x32x16_bf16(PAF(3),VFR(7),o[1],0,0,0), C1,12); \
    }while(0)
  int t=1;
  #undef CMASK
  #define CMASK(P0,P1,t) do{}while(0)
  for(;t+5<NT;t+=2){
    STEP(pB0,pB1,pA0,pA1,t,true,true,true);     WAIT_BAR(2); RESC(); ROT();
    STEP(pA0,pA1,pB0,pB1,t+1,true,true,true);   WAIT_BAR(2); RESC(); ROT();
  }
  #undef CMASK
  #define CMASK(P0,P1,t) do{int jb_=(t)-(NT-4); if(jb_>=0)cmask(P0,P1,jb_,qrel,hi);}while(0)
  #define ENDW(tt) do{ if((tt)+3<NT){WAIT_BAR(2);} else if((tt)+2<NT){WAIT_BAR(1);} else {WAIT_BAR(0);} }while(0)
  for(;t+1<NT;t+=2){
    STEP(pB0,pB1,pA0,pA1,t,(t+3<NT),(t+1<NT),(t+1<NT));       ENDW(t);   RESC(); ROT();
    STEP(pA0,pA1,pB0,pB1,t+1,(t+4<NT),(t+2<NT),(t+2<NT));     ENDW(t+1); RESC(); ROT();
  }
  STEP(pB0,pB1,pA0,pA1,NT-1,false,false,false); RESC();
  { float sacc=pB0[0]+pB0[1]; _Pragma("unroll") for(int r=2;r<16;++r)sacc+=pB0[r]; _Pragma("unroll") for(int r=0;r<16;++r)sacc+=pB1[r]; l_reg+=sacc;
    pw0=(u32x4){PKW(pB0,0),PKW(pB0,2),PKW(pB0,4),PKW(pB0,6)};pw1=(u32x4){PKW(pB0,8),PKW(pB0,10),PKW(pB0,12),PKW(pB0,14)};pw2=(u32x4){PKW(pB1,0),PKW(pB1,2),PKW(pB1,4),PKW(pB1,6)};pw3=(u32x4){PKW(pB1,8),PKW(pB1,10),PKW(pB1,12),PKW(pB1,14)};
    SBAR(); pv(o,vb0+sl_cur,PAF(0),PAF(1),PAF(2),PAF(3)); }
  #undef PKW
  #undef PAF
  #undef VFR
  #undef PIN
  #undef MX3
  #undef GAPA
  #undef GAPB
  #undef EX
  #undef VRD
  #undef KRD
  #undef STEP
  #undef ENDW
  {auto rr=__builtin_amdgcn_permlane32_swap(__float_as_uint(l_reg),__float_as_uint(l_reg),false,false);l_reg=__uint_as_float(rr[0])+__uint_as_float(rr[1]);}
  if(hi==0)wsf[32+r32]=l_reg;asm volatile("s_waitcnt lgkmcnt(0)":::"memory");
  float rli[16];
  #pragma unroll
  for(int r=0;r<16;++r)rli[r]=__builtin_amdgcn_rcpf(wsf[32+crow(r,hi)]);
  bf16*Ow=O+(rowbase+q0+wid*QBLK)*OPITCH+h*D;
  { bf16*stg=(bf16*)(shm+LDS_OST)+wid*2048;
    #pragma unroll
    for(int r=0;r<16;++r){const int orow=crow(r,hi);
      #pragma unroll
      for(int d0=0;d0<2;++d0)stg[orow*64+d0*32+r32]=__float2bfloat16(o[d0][r]*rli[r]);}
    asm volatile("s_waitcnt lgkmcnt(0)":::"memory");
    #pragma unroll
    for(int i=0;i<4;++i){const int row=i*8+(lane>>3),ch=lane&7; const u32x4 v=*(const u32x4*)(stg+row*64+ch*8); ATTN_STORE16(Ow+(long)row*OPITCH+ch*8,v);} }
  asm volatile("s_waitcnt lgkmcnt(0)\n\ts_barrier":::"memory");
  #undef DMA_K
  #undef DMA_V
  #undef CMASK
  #undef AUG
  #undef SETM
  #undef START
  #undef RESC
  #undef ROT
}
constexpr int ATTN_LDS_BYTES=LDS_BYTES;
#undef SBAR
#undef WAIT_BAR
}

namespace att {
template <bool CHECK> __device__ __forceinline__ void fox_unit_p(char* shm_g, LAS char* shm, int b, int h, int qb, const bf16_t* proj, const float* fb, float fbias_h, bf16_t* heads, unsigned* mism, bool do_scan) {
    const int tid = threadIdx.x, lane = tid & 63; const int wid = __builtin_amdgcn_readfirstlane(tid >> 6);
    if (do_scan) {
    LAS unsigned* biasw = (LAS unsigned*)(shm + attp::LDS_BIAS); LAS float* scan = (LAS float*)(shm + attp::LDS_SCAN);
    const int kend = (qb + 1) * 256;
    float v[4]; float s = 0.f;
#pragma unroll
    for (int i = 0; i < 4; ++i) { const int p = tid * 4 + i; const float fv = fb[((size_t)b * SEQ + (p < kend ? p : kend - 1)) * 8 + h]; const float lf = p < kend ? log_sigmoid_fast(fv + fbias_h) : 0.f; s += lf; v[i] = s; }
    float w = s;
#pragma unroll
    for (int o = 1; o < 64; o <<= 1) { const float t = __shfl_up(w, o); if (lane >= o) w += t; }
    if (lane == 63) scan[wid] = w;
    asm volatile("s_waitcnt lgkmcnt(0)\n\ts_barrier" ::: "memory");
    float off = w - s;
    for (int k = 0; k < 8; ++k) if (k < wid) off += scan[k];
#pragma unroll
    for (int i = 0; i < 4; ++i) { const float bv = -(v[i] + off) * LOG2E; const unsigned hb = cvt_pk_bf16(bv, 0.f) & 0xffffu; const unsigned lb = cvt_pk_bf16(bv - __uint_as_float(hb << 16), 0.f) & 0xffffu; biasw[tid * 4 + i] = hb | (lb << 16); }
    asm volatile("s_waitcnt vmcnt(0) lgkmcnt(0)\n\ts_barrier" ::: "memory");
    }
    attp::attn_unit<8, CHECK>(b, h, qb, (const attp::bf16*)(proj + 768), (const attp::bf16*)(proj + 1280), (const attp::bf16*)(proj + 1792), (attp::bf16*)(heads + 512), shm_g, mism);
    asm volatile("s_waitcnt vmcnt(0)" ::: "memory");
}
}
namespace mx {
using namespace mk;
constexpr size_t WS_QD = WS_XN, WS_KI = WS_XN + 16 * MiB, WS_DTV = 456 * MiB, WS_ACS = 457 * MiB, WS_KE = 458 * MiB, WS_DEC = 474 * MiB;
constexpr int XROW = 144;
__device__ __forceinline__ s16x4 tr_read(unsigned addr) { s16x4 r; asm volatile("ds_read_b64_tr_b16 %0, %1" : "=v"(r) : "v"(addr) : "memory"); return r; }
template <int OFF> __device__ __forceinline__ s16x4 tr_read_o(unsigned addr) { s16x4 r; asm volatile("ds_read_b64_tr_b16 %0, %1 offset:%2" : "=v"(r) : "v"(addr), "i"(OFF) : "memory"); return r; }
#define MX_LGKM0() do { asm volatile("s_waitcnt lgkmcnt(0)" ::: "memory"); __builtin_amdgcn_sched_barrier(0); } while (0)
#define MX_BAR() asm volatile("s_waitcnt vmcnt(0) lgkmcnt(0)\n\ts_barrier" ::: "memory")
#define MX_BAR_L() asm volatile("s_waitcnt lgkmcnt(0)\n\ts_barrier" ::: "memory")
__device__ __forceinline__ bf16x8 cat8(s16x4 lo, s16x4 hi) { return (bf16x8){lo[0], lo[1], lo[2], lo[3], hi[0], hi[1], hi[2], hi[3]}; }
__device__ __forceinline__ unsigned sw256(int row, int ch) { return (unsigned)(row * 256 + ((ch ^ (row & 15)) << 4)); }

__device__ __forceinline__ void prep_conv(const bf16_t* PROJ, bf16_t* CONV, const float* conv_w, const float* conv_b, int vcu, int G, int tid) {
    for (int item = vcu * NTHR + tid; item < (T / 8) * 192; item += G * NTHR) {
        const int cg = item % 192, rb = item / 192, ch0 = cg * 8, row0 = rb * 8, t0 = row0 & (SEQ - 1);
        float w[4][8], bs[8], xw[3][8];
#pragma unroll
        for (int j = 0; j < 4; ++j) { const f32x4 a = *(const f32x4*)(conv_w + j * 1536 + ch0), b = *(const f32x4*)(conv_w + j * 1536 + ch0 + 4);
#pragma unroll
            for (int i = 0; i < 4; ++i) { w[j][i] = a[i]; w[j][4 + i] = b[i]; } }
        { const f32x4 a = *(const f32x4*)(conv_b + ch0), b = *(const f32x4*)(conv_b + ch0 + 4);
#pragma unroll
          for (int i = 0; i < 4; ++i) { bs[i] = a[i]; bs[4 + i] = b[i]; } }
#pragma unroll
        for (int j = 0; j < 3; ++j) { const int tt = t0 - 3 + j;
            u32x4 v = {0u, 0u, 0u, 0u}; if (tt >= 0) v = *(const u32x4*)(PROJ + (size_t)(row0 - 3 + j) * NO_IN + 1024 + ch0);
#pragma unroll
            for (int i = 0; i < 4; ++i) { xw[j][2 * i] = __uint_as_float(v[i] << 16); xw[j][2 * i + 1] = __uint_as_float(v[i] & 0xffff0000u); } }
        u32x4 vr[8];
#pragma unroll
        for (int r = 0; r < 8; ++r) vr[r] = __builtin_nontemporal_load((const u32x4*)(PROJ + (size_t)(row0 + r) * NO_IN + 1024 + ch0));
#pragma unroll
        for (int r = 0; r < 8; ++r) {
            const u32x4 v = vr[r];
            float x3[8], o[8];
#pragma unroll
            for (int i = 0; i < 4; ++i) { x3[2 * i] = __uint_as_float(v[i] << 16); x3[2 * i + 1] = __uint_as_float(v[i] & 0xffff0000u); }
#pragma unroll
            for (int i = 0; i < 8; ++i) { const float a = bs[i] + w[0][i] * xw[0][i] + w[1][i] * xw[1][i] + w[2][i] * xw[2][i] + w[3][i] * x3[i]; o[i] = siluf(a);
                xw[0][i] = xw[1][i]; xw[1][i] = xw[2][i]; xw[2][i] = x3[i]; }
            u32x4 ov; ov.x = cvt_pk_bf16(o[0], o[1]); ov.y = cvt_pk_bf16(o[2], o[3]); ov.z = cvt_pk_bf16(o[4], o[5]); ov.w = cvt_pk_bf16(o[6], o[7]);
            *(u32x4*)(CONV + (size_t)(row0 + r) * 1536 + ch0) = ov;
        }
    }
}
__device__ __forceinline__ void prep_ssd(const float* DTG, float* DTV, float* ACS, const float* dt_bias, const float* a_log, int vcu, int G, int lane, int wave) {
    const int gw = vcu * NWAVES + wave, ngw = G * NWAVES;
    for (int item = gw; item < NBATCH * 32 * 16; item += ngw) {
        const int h = item & 15, c = (item >> 4) & 31, b = item >> 9; const size_t r0 = (size_t)b * SEQ + c * 64 + lane;
        const float a = -expf(a_log[h]), db = dt_bias[h];
        const float d0 = softplusf(DTG[r0 * 32 + h] + db);
        float w = a * d0;
#pragma unroll
        for (int o = 1; o < 64; o <<= 1) { const float t = __shfl_up(w, o); if (lane >= o) w += t; }
        ACS[r0 * 16 + h] = w; DTV[r0 * 16 + h] = d0;
    }
}
__device__ __forceinline__ void prep_gla(const bf16_t* PROJ, const float* DTG, bf16_t* QD, bf16_t* KI, bf16_t* KE, float* DEC, const float* gk_w, const float* gk_b, int vcu, int G, int tid, int lane, int wave, LAS char* shm) {
    {
        LAS float* gl = (LAS float*)(shm);
        LAS float* tot = (LAS float*)(shm + 8192);
        const int half = wave >> 2, rq = wave & 3, t256 = tid & 255;
        for (int pair = vcu; pair < NBATCH * 32 * 4 / 2; pair += G) {
            const int item = pair * 2 + half; const int h = item & 3, c = (item >> 2) & 31, b = item >> 7; const size_t r0 = (size_t)b * SEQ + c * 64;
            unsigned short qv[16][2], kv[16][2];
#pragma unroll
            for (int r = 0; r < 16; ++r) { const bf16_t* pr = PROJ + (r0 + rq * 16 + r) * NO_IN;
                qv[r][0] = pr[2560 + h * 128 + lane]; qv[r][1] = pr[2560 + h * 128 + 64 + lane]; kv[r][0] = pr[3072 + h * 128 + lane]; kv[r][1] = pr[3072 + h * 128 + 64 + lane]; }
            float w0[16], w1[16];
#pragma unroll
            for (int j = 0; j < 16; ++j) { w0[j] = gk_w[j * 512 + h * 128 + lane]; w1[j] = gk_w[j * 512 + h * 128 + 64 + lane]; }
            const float b0 = gk_b[h * 128 + lane], b1 = gk_b[h * 128 + 64 + lane];
            { const int rr = t256 >> 2, q4 = t256 & 3; *(LAS f32x4*)(gl + half * 1024 + rr * 16 + q4 * 4) = *(const f32x4*)(DTG + (r0 + rr) * 32 + 16 + q4 * 4); }
            asm volatile("s_waitcnt vmcnt(0) lgkmcnt(0)\n\ts_barrier" ::: "memory");
            float c0[16], c1[16]; float run0 = 0.f, run1 = 0.f;
#pragma unroll
            for (int r = 0; r < 16; ++r) {
                const LAS f32x4* gp = (const LAS f32x4*)(gl + half * 1024 + (rq * 16 + r) * 16); float a0 = b0, a1 = b1;
#pragma unroll
                for (int q = 0; q < 4; ++q) { const f32x4 g = gp[q];
#pragma unroll
                    for (int i = 0; i < 4; ++i) { a0 += g[i] * w0[4 * q + i]; a1 += g[i] * w1[4 * q + i]; } }
                run0 += log_sigmoid_fast(a0) * (1.f / 16.f); run1 += log_sigmoid_fast(a1) * (1.f / 16.f); c0[r] = run0; c1[r] = run1;
            }
            tot[(half * 4 + rq) * 128 + lane] = run0; tot[(half * 4 + rq) * 128 + 64 + lane] = run1;
            asm volatile("s_waitcnt lgkmcnt(0)\n\ts_barrier" ::: "memory");
            float pre0 = 0.f, pre1 = 0.f, last0 = 0.f, last1 = 0.f;
#pragma unroll
            for (int q = 0; q < 4; ++q) { const float t0 = tot[(half * 4 + q) * 128 + lane], t1 = tot[(half * 4 + q) * 128 + 64 + lane]; if (q < rq) { pre0 += t0; pre1 += t1; } last0 += t0; last1 += t1; }
            const float scale = 0.08838834764831845f;
#pragma unroll
            for (int r = 0; r < 16; ++r) {
                const float g0 = pre0 + c0[r], g1 = pre1 + c1[r];
                const float q0 = bf2f(qv[r][0]), q1 = bf2f(qv[r][1]), k0 = bf2f(kv[r][0]), k1 = bf2f(kv[r][1]);
                const size_t o = (r0 + rq * 16 + r) * 512 + h * 128 + lane;
                QD[o] = (bf16_t)(cvt_pk_bf16(q0 * scale * __expf(g0), 0.f) & 0xffffu); QD[o + 64] = (bf16_t)(cvt_pk_bf16(q1 * scale * __expf(g1), 0.f) & 0xffffu);
                KI[o] = (bf16_t)(cvt_pk_bf16(k0 * __expf(-g0), 0.f) & 0xffffu); KI[o + 64] = (bf16_t)(cvt_pk_bf16(k1 * __expf(-g1), 0.f) & 0xffffu);
            }
            if (rq == 0) { DEC[((size_t)b * 32 + c) * 512 + h * 128 + lane] = __expf(last0); DEC[((size_t)b * 32 + c) * 512 + h * 128 + 64 + lane] = __expf(last1); }
            asm volatile("s_waitcnt lgkmcnt(0)\n\ts_barrier" ::: "memory");
        }
    }
}

constexpr int S_C = 0, S_B = 32768, S_X = 65536, S_XW = S_X + 128 * XROW, S_PREV = S_XW + 128 * XROW, S_ACS = S_PREV + 16384, S_DT = S_ACS + 512, S_YST = S_DT + 512, S_END = S_YST + 8 * 2304;
static_assert(S_END <= RING_BYTES, "SSD LDS");
__device__ __forceinline__ void ssd_unit(LAS char* shm, int b, int h, const bf16_t* CONV, const float* ACS, const float* DTV, float dsk, bf16_t* MIX) {
    const int tid = threadIdx.x, lane = tid & 63, fr = lane & 15, fq = lane >> 4; const int w = __builtin_amdgcn_readfirstlane(tid >> 6);
    const int g = h >> 3, row = tid >> 2, qd = tid & 3, l0 = 16 * w;
    const unsigned lds0 = (unsigned)(uintptr_t)shm;
    LAS float* acsl = (LAS float*)(shm + S_ACS); LAS float* dtl = (LAS float*)(shm + S_DT);
    f32x4 st[4];
#pragma unroll
    for (int i = 0; i < 4; ++i) st[i] = (f32x4){0.f, 0.f, 0.f, 0.f};
    u32x4 rc[4], rb[4], rx[2]; float racs, rdt, rend;
    const size_t seq0 = (size_t)b * SEQ;
#define SSD_LOAD(c) do { const size_t gr = seq0 + (size_t)(c) * 128 + row; const bf16_t* p = CONV + gr * 1536; \
        _Pragma("unroll") for (int i = 0; i < 4; ++i) { rc[i] = *(const u32x4*)(p + 1280 + g * 128 + qd * 32 + 8 * i); rb[i] = *(const u32x4*)(p + 1024 + g * 128 + qd * 32 + 8 * i); } \
        _Pragma("unroll") for (int i = 0; i < 2; ++i) rx[i] = *(const u32x4*)(p + h * 64 + qd * 16 + 8 * i); \
        racs = ACS[gr * 16 + h]; rdt = DTV[gr * 16 + h]; rend = ACS[(seq0 + (size_t)(c) * 128 + 127) * 16 + h]; } while (0)
#ifdef SSD_DUMMY
    SSD_LOAD(0);
    for (int c = 0; c < 16; ++c) {
#pragma unroll
        for (int i = 0; i < 4; ++i) { *(LAS u32x4*)(shm + S_C + sw256(row, qd * 4 + i)) = rc[i]; *(LAS u32x4*)(shm + S_B + sw256(row, qd * 4 + i)) = rb[i]; }
        const float wr = rdt * __expf(rend - racs);
#pragma unroll
        for (int i = 0; i < 2; ++i) { *(LAS u32x4*)(shm + S_X + row * XROW + qd * 32 + 16 * i) = rx[i];
            u32x4 o;
#pragma unroll
            for (int k = 0; k < 4; ++k) o[k] = cvt_pk_bf16(__uint_as_float(rx[i][k] << 16) * wr, __uint_as_float(rx[i][k] & 0xffff0000u) * wr);
            *(LAS u32x4*)(shm + S_XW + row * XROW + qd * 32 + 16 * i) = o; }
        if (qd == 0) { acsl[row] = racs; dtl[row] = rdt; }
        MX_BAR_L();
        if (c + 1 < 16) SSD_LOAD(c + 1);
        MX_BAR_L();
    }
#endif
#ifndef SSD_NOPREF
    SSD_LOAD(0);
#endif
    const unsigned xtr = lds0 + (unsigned)(((lane & 15) >> 2) * XROW + (lane & 3) * 8);
    for (int c = 0; c < 16; ++c) {
#ifdef SSD_NOPREF
        SSD_LOAD(c);
#endif
#ifdef SSD_REP_WR
        for (int rep_ = 0; rep_ < 2; ++rep_)
#endif
        {
#pragma unroll
            for (int i = 0; i < 4; ++i) { *(LAS u32x4*)(shm + S_C + sw256(row, qd * 4 + i)) = rc[i]; *(LAS u32x4*)(shm + S_B + sw256(row, qd * 4 + i)) = rb[i]; }
            const float wr = rdt * __expf(rend - racs);
#pragma unroll
            for (int i = 0; i < 2; ++i) { *(LAS u32x4*)(shm + S_X + row * XROW + qd * 32 + 16 * i) = rx[i];
                u32x4 o;
#pragma unroll
                for (int k = 0; k < 4; ++k) o[k] = cvt_pk_bf16(__uint_as_float(rx[i][k] << 16) * wr, __uint_as_float(rx[i][k] & 0xffff0000u) * wr);
                *(LAS u32x4*)(shm + S_XW + row * XROW + qd * 32 + 16 * i) = o; }
            if (qd == 0) { acsl[row] = racs; dtl[row] = rdt; }
#pragma unroll
            for (int pt = 0; pt < 4; ++pt) { u32x2 v; v.x = cvt_pk_bf16(st[pt][0], st[pt][1]); v.y = cvt_pk_bf16(st[pt][2], st[pt][3]);
                const int p = 16 * pt + fr; *(LAS u32x2*)(shm + S_PREV + sw256(p, 2 * w + (fq >> 1)) + (fq & 1) * 8) = v; }
        }
        MX_BAR_L();
#ifndef SSD_NOPREF
        if (c + 1 < 16) SSD_LOAD(c + 1);
#endif
        bf16x8 cf[4];
#pragma unroll
        for (int ks = 0; ks < 4; ++ks) cf[ks] = *(const LAS bf16x8*)(shm + S_C + sw256(l0 + fr, 4 * ks + fq));
        f32x4 yd[4], yo[4];
#pragma unroll
        for (int i = 0; i < 4; ++i) { yd[i] = (f32x4){0.f, 0.f, 0.f, 0.f}; yo[i] = (f32x4){0.f, 0.f, 0.f, 0.f}; }
        const float acs_l = acsl[l0 + fr]; const int lcol = l0 + fr;
        const int nsb = (w >> 1) + 1;
#ifdef SSD_REP_SB
        for (int rep_ = 0; rep_ < 2; ++rep_) {
#pragma unroll
        for (int i = 0; i < 4; ++i) yd[i] = (f32x4){0.f, 0.f, 0.f, 0.f};
#endif
        for (int sb = 0; sb < nsb; ++sb) {
            const int s0 = 32 * sb; const bool two = (2 * sb + 1) <= w;
            s16x4 lo[4], hi[4];
#pragma unroll
            for (int pt = 0; pt < 4; ++pt) { lo[pt] = tr_read(xtr + S_X + (unsigned)((s0 + 4 * fq) * XROW + pt * 32)); hi[pt] = tr_read(xtr + S_X + (unsigned)((s0 + 16 + 4 * fq) * XROW + pt * 32)); }
            f32x4 a0 = {0.f, 0.f, 0.f, 0.f}, a1 = {0.f, 0.f, 0.f, 0.f};
#pragma unroll
            for (int ks = 0; ks < 4; ++ks) { const bf16x8 bf = *(const LAS bf16x8*)(shm + S_B + sw256(s0 + fr, 4 * ks + fq)); a0 = __builtin_amdgcn_mfma_f32_16x16x32_bf16(bf, cf[ks], a0, 0, 0, 0); }
            if (two) {
#pragma unroll
                for (int ks = 0; ks < 4; ++ks) { const bf16x8 bf = *(const LAS bf16x8*)(shm + S_B + sw256(s0 + 16 + fr, 4 * ks + fq)); a1 = __builtin_amdgcn_mfma_f32_16x16x32_bf16(bf, cf[ks], a1, 0, 0, 0); }
            }
            const f32x4 as0 = *(const LAS f32x4*)(acsl + s0 + 4 * fq), as1 = *(const LAS f32x4*)(acsl + s0 + 16 + 4 * fq);
            const f32x4 dq0 = *(const LAS f32x4*)(dtl + s0 + 4 * fq), dq1 = *(const LAS f32x4*)(dtl + s0 + 16 + 4 * fq);
            float g0[4], g1[4];
#pragma unroll
            for (int i = 0; i < 4; ++i) { const int sa = s0 + 4 * fq + i, sb2 = sa + 16;
                g0[i] = (sa <= lcol) ? a0[i] * __expf(fminf(acs_l - as0[i], 0.f)) * dq0[i] : 0.f;
                g1[i] = (two && sb2 <= lcol) ? a1[i] * __expf(fminf(acs_l - as1[i], 0.f)) * dq1[i] : 0.f; }
            u32x4 ap; ap.x = cvt_pk_bf16(g0[0], g0[1]); ap.y = cvt_pk_bf16(g0[2], g0[3]); ap.z = cvt_pk_bf16(g1[0], g1[1]); ap.w = cvt_pk_bf16(g1[2], g1[3]);
            const bf16x8 af = __builtin_bit_cast(bf16x8, ap);
            MX_LGKM0();
#pragma unroll
            for (int pt = 0; pt < 4; ++pt) yd[pt] = __builtin_amdgcn_mfma_f32_16x16x32_bf16(af, cat8(lo[pt], hi[pt]), yd[pt], 0, 0, 0);
        }
#ifdef SSD_REP_SB
        }
#endif
#ifdef SSD_REP_YO
        for (int rep_ = 0; rep_ < 2; ++rep_) {
#pragma unroll
        for (int i = 0; i < 4; ++i) yo[i] = (f32x4){0.f, 0.f, 0.f, 0.f};
#endif
#pragma unroll
        for (int pt = 0; pt < 4; ++pt)
#pragma unroll
            for (int ks = 0; ks < 4; ++ks) { const bf16x8 pf = *(const LAS bf16x8*)(shm + S_PREV + sw256(16 * pt + fr, 4 * ks + fq)); yo[pt] = __builtin_amdgcn_mfma_f32_16x16x32_bf16(cf[ks], pf, yo[pt], 0, 0, 0); }
#ifdef SSD_REP_YO
        }
#endif
#ifdef SSD_REP_CS
        for (int rep_ = 0; rep_ < 2; ++rep_)
#endif
        {
            const f32x4 al = *(const LAS f32x4*)(acsl + l0 + 4 * fq);
            float ea[4];
#pragma unroll
            for (int i = 0; i < 4; ++i) ea[i] = __expf(al[i]);
            s16x4 xs[4];
#pragma unroll
            for (int pt = 0; pt < 4; ++pt) xs[pt] = tr_read(xtr + S_X + (unsigned)((l0 + 4 * fq) * XROW + pt * 32));
            MX_LGKM0();
            LAS bf16_t* yst = (LAS bf16_t*)(shm + S_YST + w * 2304);
#pragma unroll
            for (int pt = 0; pt < 4; ++pt)
#pragma unroll
                for (int i = 0; i < 4; ++i) { const float y = yd[pt][i] + ea[i] * yo[pt][i] + dsk * bf2f((unsigned short)xs[pt][i]);
                    yst[(4 * fq + i) * 72 + pt * 16 + fr] = (bf16_t)(cvt_pk_bf16(y, 0.f) & 0xffffu); }
            asm volatile("s_waitcnt lgkmcnt(0)" ::: "memory");
            bf16_t* yp = MIX + (seq0 + (size_t)c * 128 + l0) * 2048 + h * 64;
#pragma unroll
            for (int j = 0; j < 2; ++j) { const int rr = (lane >> 3) + 8 * j, ch = lane & 7; const u32x4 v = *(const LAS u32x4*)(yst + rr * 72 + ch * 8); *(u32x4*)(yp + (size_t)rr * 2048 + ch * 8) = v; }
        }
#ifdef SSD_REP_ST
        f32x4 stsave[4];
#pragma unroll
        for (int i = 0; i < 4; ++i) stsave[i] = st[i];
        for (int rep_ = 0; rep_ < 2; ++rep_) {
#pragma unroll
        for (int i = 0; i < 4; ++i) st[i] = stsave[i];
#endif
        {
            const float cd = __expf(acsl[127]);
#pragma unroll
            for (int pt = 0; pt < 4; ++pt) st[pt] = st[pt] * cd;
#pragma unroll
            for (int ks = 0; ks < 4; ++ks) {
                const int s0 = 32 * ks, q = (lane & 15) >> 2, p = lane & 3;
                const int r1 = s0 + 8 * fq + q, r2 = r1 + 4;
                const s16x4 alo = tr_read(lds0 + S_B + sw256(r1, 2 * w + (p >> 1)) + (p & 1) * 8), ahi = tr_read(lds0 + S_B + sw256(r2, 2 * w + (p >> 1)) + (p & 1) * 8);
                s16x4 lo[4], hi[4];
#pragma unroll
                for (int pt = 0; pt < 4; ++pt) { lo[pt] = tr_read(xtr + S_XW + (unsigned)((s0 + 8 * fq) * XROW + pt * 32)); hi[pt] = tr_read(xtr + S_XW + (unsigned)((s0 + 8 * fq + 4) * XROW + pt * 32)); }
                MX_LGKM0();
                const bf16x8 af = cat8(alo, ahi);
#pragma unroll
                for (int pt = 0; pt < 4; ++pt) st[pt] = __builtin_amdgcn_mfma_f32_16x16x32_bf16(af, cat8(lo[pt], hi[pt]), st[pt], 0, 0, 0);
            }
        }
#ifdef SSD_REP_ST
        }
#endif
        MX_BAR_L();
    }
    asm volatile("s_waitcnt vmcnt(0)" ::: "memory");
#undef SSD_LOAD
}

constexpr int S2_C = 0, S2_B = 16384, S2_X = 32768, S2_XW = S2_X + 64 * XROW, S2_ACS = S2_XW + 64 * XROW, S2_DT = S2_ACS + 256, S2_BUF = 53248, S2_PREV = 2 * S2_BUF, S2_END = S2_PREV + 2 * 16384;
static_assert(S2_DT + 256 <= S2_BUF && S2_END <= RING_BYTES, "SSD64 LDS");
__device__ __forceinline__ void ssd_unit64(LAS char* shm, int b, int h, const bf16_t* CONV, const float* ACS, const float* DTV, float dsk, bf16_t* MIX) {
    const int tid = threadIdx.x, lane = tid & 63, fr = lane & 15, fq = lane >> 4; const int w = __builtin_amdgcn_readfirstlane(tid >> 6);
    const int g = h >> 3, row = tid >> 3, ec = tid & 7, lt = w >> 1, l0 = 16 * lt, pt0 = 2 * (w & 1);
    const unsigned lds0 = (unsigned)(uintptr_t)shm;
    f32x4 st[4];
#pragma unroll
    for (int i = 0; i < 4; ++i) st[i] = (f32x4){0.f, 0.f, 0.f, 0.f};
    u32x4 rc[2], rb[2], rx; float racs, rdt, rend;
    const size_t seq0 = (size_t)b * SEQ;
#define S2_LOAD(c) do { const size_t gr = seq0 + (size_t)(c) * 64 + row; const bf16_t* p = CONV + gr * 1536; \
        _Pragma("unroll") for (int i = 0; i < 2; ++i) { rc[i] = *(const u32x4*)(p + 1280 + g * 128 + ec * 16 + 8 * i); rb[i] = *(const u32x4*)(p + 1024 + g * 128 + ec * 16 + 8 * i); } \
        rx = *(const u32x4*)(p + h * 64 + ec * 8); \
        racs = ACS[gr * 16 + h]; rdt = DTV[gr * 16 + h]; rend = ACS[(seq0 + (size_t)(c) * 64 + 63) * 16 + h]; } while (0)
#define S2_WRITE(pb) do { LAS char* gb_ = shm + (pb) * S2_BUF; \
        _Pragma("unroll") for (int i = 0; i < 2; ++i) { *(LAS u32x4*)(gb_ + S2_C + sw256(row, ec * 2 + i)) = rc[i]; *(LAS u32x4*)(gb_ + S2_B + sw256(row, ec * 2 + i)) = rb[i]; } \
        *(LAS u32x4*)(gb_ + S2_X + row * XROW + ec * 16) = rx; \
        { const float wr_ = rdt * __expf(rend - racs); u32x4 o_; \
          _Pragma("unroll") for (int k = 0; k < 4; ++k) o_[k] = cvt_pk_bf16(__uint_as_float(rx[k] << 16) * wr_, __uint_as_float(rx[k] & 0xffff0000u) * wr_); \
          *(LAS u32x4*)(gb_ + S2_XW + row * XROW + ec * 16) = o_; } \
        if (ec == 0) { ((LAS float*)(gb_ + S2_ACS))[row] = racs; ((LAS float*)(gb_ + S2_DT))[row] = rdt; } \
        _Pragma("unroll") for (int pt = 0; pt < 4; ++pt) { u32x2 v; v.x = cvt_pk_bf16(st[pt][0], st[pt][1]); v.y = cvt_pk_bf16(st[pt][2], st[pt][3]); \
            const int p_ = 16 * pt + fr; *(LAS u32x2*)(shm + S2_PREV + (pb) * 16384 + sw256(p_, 2 * w + (fq >> 1)) + (fq & 1) * 8) = v; } } while (0)
    S2_LOAD(0);
    S2_WRITE(0);
    MX_BAR_L();
    unsigned swz[4];
#pragma unroll
    for (int ks = 0; ks < 4; ++ks) swz[ks] = (unsigned)(fr * 256 + (((4 * ks + fq) ^ fr) << 4));
    const int q_ = (lane & 15) >> 2, p_ = lane & 3;
    const unsigned xq4 = (unsigned)((4 * fq + q_) * XROW + p_ * 8), xq8 = (unsigned)((8 * fq + q_) * XROW + p_ * 8);
    const int ra = 8 * fq + q_, rb2 = ra + 4;
    const unsigned bt1 = (unsigned)(ra * 256 + (((2 * w + (p_ >> 1)) ^ (ra & 15)) << 4) + (p_ & 1) * 8), bt2 = (unsigned)(rb2 * 256 + (((2 * w + (p_ >> 1)) ^ (rb2 & 15)) << 4) + (p_ & 1) * 8);
    for (int c = 0; c < 32; ++c) {
        const int pb = c & 1; LAS char* gb = shm + pb * S2_BUF; const unsigned gba = lds0 + (unsigned)(pb * S2_BUF);
        const LAS float* acsl = (const LAS float*)(gb + S2_ACS); const LAS float* dtl = (const LAS float*)(gb + S2_DT);
        if (c + 1 < 32) S2_LOAD(c + 1);
        const LAS char* cbp[4]; const LAS char* pvp[4];
#pragma unroll
        for (int ks = 0; ks < 4; ++ks) { cbp[ks] = gb + swz[ks]; pvp[ks] = shm + S2_PREV + pb * 16384 + pt0 * 4096 + swz[ks]; }
        const unsigned xa4 = gba + xq4 + (unsigned)(pt0 * 32), xa8 = gba + xq8, ba1 = gba + bt1, ba2 = gba + bt2;
        bf16x8 cf[4];
#pragma unroll
        for (int ks = 0; ks < 4; ++ks) cf[ks] = *(const LAS bf16x8*)(cbp[ks] + S2_C + l0 * 256);
        f32x4 yd[2], yo[2];
#pragma unroll
        for (int i = 0; i < 2; ++i) { yd[i] = (f32x4){0.f, 0.f, 0.f, 0.f}; yo[i] = (f32x4){0.f, 0.f, 0.f, 0.f}; }
        const float acs_l = acsl[l0 + fr]; const int lcol = l0 + fr;
#pragma unroll
        for (int sb = 0; sb < 2; ++sb) if (2 * sb <= lt) {
            constexpr int dummy = 0; (void)dummy;
            const int s0 = 32 * sb; const bool two = (2 * sb + 1) <= lt;
            s16x4 lo[2], hi[2];
            if (sb == 0) { lo[0] = tr_read_o<S2_X>(xa4); lo[1] = tr_read_o<S2_X + 32>(xa4); hi[0] = tr_read_o<S2_X + 16 * XROW>(xa4); hi[1] = tr_read_o<S2_X + 16 * XROW + 32>(xa4); }
            else         { lo[0] = tr_read_o<S2_X + 32 * XROW>(xa4); lo[1] = tr_read_o<S2_X + 32 * XROW + 32>(xa4); hi[0] = tr_read_o<S2_X + 48 * XROW>(xa4); hi[1] = tr_read_o<S2_X + 48 * XROW + 32>(xa4); }
            f32x4 a0 = {0.f, 0.f, 0.f, 0.f}, a1 = {0.f, 0.f, 0.f, 0.f};
#pragma unroll
            for (int ks = 0; ks < 4; ++ks) { const bf16x8 bf = *(const LAS bf16x8*)(cbp[ks] + S2_B + s0 * 256); a0 = __builtin_amdgcn_mfma_f32_16x16x32_bf16(bf, cf[ks], a0, 0, 0, 0); }
            if (two) {
#pragma unroll
                for (int ks = 0; ks < 4; ++ks) { const bf16x8 bf = *(const LAS bf16x8*)(cbp[ks] + S2_B + (s0 + 16) * 256); a1 = __builtin_amdgcn_mfma_f32_16x16x32_bf16(bf, cf[ks], a1, 0, 0, 0); }
            }
            const f32x4 as0 = *(const LAS f32x4*)(acsl + s0 + 4 * fq), as1 = *(const LAS f32x4*)(acsl + s0 + 16 + 4 * fq);
            const f32x4 dq0 = *(const LAS f32x4*)(dtl + s0 + 4 * fq), dq1 = *(const LAS f32x4*)(dtl + s0 + 16 + 4 * fq);
            float g0[4], g1[4];
#pragma unroll
            for (int i = 0; i < 4; ++i) { g0[i] = a0[i] * __expf(acs_l - as0[i]) * dq0[i]; g1[i] = a1[i] * __expf(acs_l - as1[i]) * dq1[i]; }
            if (2 * sb == lt) {
#pragma unroll
                for (int i = 0; i < 4; ++i) { if (s0 + 4 * fq + i > lcol) g0[i] = 0.f; }
            }
            if (!two) {
#pragma unroll
                for (int i = 0; i < 4; ++i) g1[i] = 0.f;
            } else if (2 * sb + 1 == lt) {
#pragma unroll
                for (int i = 0; i < 4; ++i) { if (s0 + 16 + 4 * fq + i > lcol) g1[i] = 0.f; }
            }
            u32x4 ap; ap.x = cvt_pk_bf16(g0[0], g0[1]); ap.y = cvt_pk_bf16(g0[2], g0[3]); ap.z = cvt_pk_bf16(g1[0], g1[1]); ap.w = cvt_pk_bf16(g1[2], g1[3]);
            const bf16x8 af = __builtin_bit_cast(bf16x8, ap);
            MX_LGKM0();
#pragma unroll
            for (int vi = 0; vi < 2; ++vi) yd[vi] = __builtin_amdgcn_mfma_f32_16x16x32_bf16(af, cat8(lo[vi], hi[vi]), yd[vi], 0, 0, 0);
        }
#pragma unroll
        for (int vi = 0; vi < 2; ++vi)
#pragma unroll
            for (int ks = 0; ks < 4; ++ks) { const bf16x8 pf = *(const LAS bf16x8*)(pvp[ks] + vi * 4096); yo[vi] = __builtin_amdgcn_mfma_f32_16x16x32_bf16(cf[ks], pf, yo[vi], 0, 0, 0); }
        {
            const f32x4 al = *(const LAS f32x4*)(acsl + l0 + 4 * fq);
            float ea[4];
#pragma unroll
            for (int i = 0; i < 4; ++i) ea[i] = __expf(al[i]);
            const unsigned xl = xa4 + (unsigned)(l0 * XROW);
            s16x4 xs[2]; xs[0] = tr_read_o<S2_X>(xl); xs[1] = tr_read_o<S2_X + 32>(xl);
            MX_LGKM0();
            bf16_t* yp = MIX + (seq0 + (size_t)c * 64 + l0 + 4 * fq) * 2048 + h * 64 + pt0 * 16 + fr;
#pragma unroll
            for (int vi = 0; vi < 2; ++vi)
#pragma unroll
                for (int i = 0; i < 4; ++i) { const float y = yd[vi][i] + ea[i] * yo[vi][i] + dsk * bf2f((unsigned short)xs[vi][i]);
                    yp[(size_t)i * 2048 + vi * 16] = (bf16_t)(cvt_pk_bf16(y, 0.f) & 0xffffu); }
        }
        {
            const float cd = __expf(acsl[63]);
#pragma unroll
            for (int pt = 0; pt < 4; ++pt) st[pt] = st[pt] * cd;
            {   s16x4 lo[4], hi[4];
                const s16x4 alo = tr_read_o<S2_B>(ba1), ahi = tr_read_o<S2_B>(ba2);
                lo[0] = tr_read_o<S2_XW>(xa8); lo[1] = tr_read_o<S2_XW + 32>(xa8); lo[2] = tr_read_o<S2_XW + 64>(xa8); lo[3] = tr_read_o<S2_XW + 96>(xa8);
                hi[0] = tr_read_o<S2_XW + 4 * XROW>(xa8); hi[1] = tr_read_o<S2_XW + 4 * XROW + 32>(xa8); hi[2] = tr_read_o<S2_XW + 4 * XROW + 64>(xa8); hi[3] = tr_read_o<S2_XW + 4 * XROW + 96>(xa8);
                MX_LGKM0();
                const bf16x8 af = cat8(alo, ahi);
#pragma unroll
                for (int pt = 0; pt < 4; ++pt) st[pt] = __builtin_amdgcn_mfma_f32_16x16x32_bf16(af, cat8(lo[pt], hi[pt]), st[pt], 0, 0, 0); }
            {   s16x4 lo[4], hi[4];
                const s16x4 alo = tr_read_o<S2_B + 32 * 256>(ba1), ahi = tr_read_o<S2_B + 32 * 256>(ba2);
                lo[0] = tr_read_o<S2_XW + 32 * XROW>(xa8); lo[1] = tr_read_o<S2_XW + 32 * XROW + 32>(xa8); lo[2] = tr_read_o<S2_XW + 32 * XROW + 64>(xa8); lo[3] = tr_read_o<S2_XW + 32 * XROW + 96>(xa8);
                hi[0] = tr_read_o<S2_XW + 36 * XROW>(xa8); hi[1] = tr_read_o<S2_XW + 36 * XROW + 32>(xa8); hi[2] = tr_read_o<S2_XW + 36 * XROW + 64>(xa8); hi[3] = tr_read_o<S2_XW + 36 * XROW + 96>(xa8);
                MX_LGKM0();
                const bf16x8 af = cat8(alo, ahi);
#pragma unroll
                for (int pt = 0; pt < 4; ++pt) st[pt] = __builtin_amdgcn_mfma_f32_16x16x32_bf16(af, cat8(lo[pt], hi[pt]), st[pt], 0, 0, 0); }
        }
        if (c + 1 < 32) S2_WRITE(pb ^ 1);
        MX_BAR_L();
    }
    asm volatile("s_waitcnt vmcnt(0)" ::: "memory");
#undef S2_LOAD
#undef S2_WRITE
}

constexpr int G_QD = 0, G_KI = 16384, G_V = 32768, G_DEC = G_V + 64 * XROW, G_BUF = 45056, G_SP = 2 * G_BUF, G_END = G_SP + 2 * 16384;
static_assert(G_DEC + 512 <= G_BUF && G_END <= RING_BYTES, "GLA LDS");
template <bool CHECK> __device__ __forceinline__ void gla_unit(LAS char* shm, int b, int h, int vs, const bf16_t* PROJ, const bf16_t* QD, const bf16_t* KI, const float* DEC, bf16_t* MIX, unsigned* mismatch) {
    const int tid = threadIdx.x, lane = tid & 63, fr = lane & 15, fq = lane >> 4; const int w = __builtin_amdgcn_readfirstlane(tid >> 6);
    const int row = tid >> 3, ec = tid & 7, lt = w >> 1, l0 = 16 * lt, vt0 = 2 * (w & 1);
    const unsigned lds0 = (unsigned)(uintptr_t)shm;
    f32x4 st[4];
#pragma unroll
    for (int i = 0; i < 4; ++i) st[i] = (f32x4){0.f, 0.f, 0.f, 0.f};
    u32x4 rq[2], rk[2], rv; float rdec = 0.f;
    const size_t seq0 = (size_t)b * SEQ;
#define GLA_LOAD(c) do { const size_t gr = seq0 + (size_t)(c) * 64 + row; const size_t o = gr * 512 + h * 128 + ec * 16; \
        _Pragma("unroll") for (int i = 0; i < 2; ++i) { rq[i] = *(const u32x4*)(QD + o + 8 * i); rk[i] = *(const u32x4*)(KI + o + 8 * i); } \
        rv = *(const u32x4*)(PROJ + gr * NO_IN + 3584 + h * 256 + vs * 64 + ec * 8); \
        if (tid < 128) rdec = DEC[((size_t)b * 32 + (c)) * 512 + h * 128 + tid]; } while (0)
#define GLA_WRITE(pb) do { LAS char* gb_ = shm + (pb) * G_BUF; \
        _Pragma("unroll") for (int i = 0; i < 2; ++i) { *(LAS u32x4*)(gb_ + G_QD + sw256(row, ec * 2 + i)) = rq[i]; *(LAS u32x4*)(gb_ + G_KI + sw256(row, ec * 2 + i)) = rk[i]; } \
        *(LAS u32x4*)(gb_ + G_V + row * XROW + ec * 16) = rv; \
        if (tid < 128) ((LAS float*)(gb_ + G_DEC))[tid] = rdec; \
        _Pragma("unroll") for (int vt = 0; vt < 4; ++vt) { u32x2 v; v.x = cvt_pk_bf16(st[vt][0], st[vt][1]); v.y = cvt_pk_bf16(st[vt][2], st[vt][3]); \
            const int vv = 16 * vt + fr; *(LAS u32x2*)(shm + G_SP + (pb) * 16384 + sw256(vv, 2 * w + (fq >> 1)) + (fq & 1) * 8) = v; } } while (0)
    GLA_LOAD(0);
    GLA_WRITE(0);
    MX_BAR_L();
    const unsigned xtr = lds0 + (unsigned)(((lane & 15) >> 2) * XROW + (lane & 3) * 8);
    for (int c = 0; c < 32; ++c) {
        const int pb = c & 1; LAS char* gb = shm + pb * G_BUF; const unsigned gbo = (unsigned)(pb * G_BUF); LAS char* sp = shm + G_SP + pb * 16384;
        if (c + 1 < 32) GLA_LOAD(c + 1);
        bf16x8 qf[4];
#pragma unroll
        for (int ks = 0; ks < 4; ++ks) qf[ks] = *(const LAS bf16x8*)(gb + G_QD + sw256(l0 + fr, 4 * ks + fq));
        f32x4 o[2]; o[0] = (f32x4){0.f, 0.f, 0.f, 0.f}; o[1] = (f32x4){0.f, 0.f, 0.f, 0.f};
        const int lcol = l0 + fr; const int nsb = (lt >> 1) + 1;
        for (int sb = 0; sb < nsb; ++sb) {
            const int s0 = 32 * sb; const bool two = (2 * sb + 1) <= lt;
            f32x4 a0 = {0.f, 0.f, 0.f, 0.f}, a1 = {0.f, 0.f, 0.f, 0.f};
#pragma unroll
            for (int ks = 0; ks < 4; ++ks) { const bf16x8 kf = *(const LAS bf16x8*)(gb + G_KI + sw256(s0 + fr, 4 * ks + fq)); a0 = __builtin_amdgcn_mfma_f32_16x16x32_bf16(kf, qf[ks], a0, 0, 0, 0); }
            if (two) {
#pragma unroll
                for (int ks = 0; ks < 4; ++ks) { const bf16x8 kf = *(const LAS bf16x8*)(gb + G_KI + sw256(s0 + 16 + fr, 4 * ks + fq)); a1 = __builtin_amdgcn_mfma_f32_16x16x32_bf16(kf, qf[ks], a1, 0, 0, 0); }
            }
            float g0[4], g1[4];
#pragma unroll
            for (int i = 0; i < 4; ++i) { const int sa = s0 + 4 * fq + i; g0[i] = (sa <= lcol) ? a0[i] : 0.f; g1[i] = (two && sa + 16 <= lcol) ? a1[i] : 0.f; }
            u32x4 ap; ap.x = cvt_pk_bf16(g0[0], g0[1]); ap.y = cvt_pk_bf16(g0[2], g0[3]); ap.z = cvt_pk_bf16(g1[0], g1[1]); ap.w = cvt_pk_bf16(g1[2], g1[3]);
            const bf16x8 af = __builtin_bit_cast(bf16x8, ap);
            s16x4 lo[2], hi[2];
#pragma unroll
            for (int vi = 0; vi < 2; ++vi) { lo[vi] = tr_read(xtr + gbo + G_V + (unsigned)((s0 + 4 * fq) * XROW + (vt0 + vi) * 32)); hi[vi] = tr_read(xtr + gbo + G_V + (unsigned)((s0 + 16 + 4 * fq) * XROW + (vt0 + vi) * 32)); }
            MX_LGKM0();
#pragma unroll
            for (int vi = 0; vi < 2; ++vi) o[vi] = __builtin_amdgcn_mfma_f32_16x16x32_bf16(af, cat8(lo[vi], hi[vi]), o[vi], 0, 0, 0);
        }
#pragma unroll
        for (int vi = 0; vi < 2; ++vi)
#pragma unroll
            for (int ks = 0; ks < 4; ++ks) { const bf16x8 sf = *(const LAS bf16x8*)(sp + sw256(16 * (vt0 + vi) + fr, 4 * ks + fq)); o[vi] = __builtin_amdgcn_mfma_f32_16x16x32_bf16(qf[ks], sf, o[vi], 0, 0, 0); }
        {
            bf16_t* op = MIX + (seq0 + (size_t)c * 64 + l0 + 4 * fq) * 2048 + 1024 + h * 256 + vs * 64 + vt0 * 16 + fr;
#pragma unroll
            for (int vi = 0; vi < 2; ++vi)
#pragma unroll
                for (int i = 0; i < 4; ++i) { const bf16_t val = (bf16_t)(cvt_pk_bf16(o[vi][i], 0.f) & 0xffffu);
                    if (CHECK) { if (op[(size_t)i * 2048 + vi * 16] != val) atomicAdd(mismatch, 1u); } else op[(size_t)i * 2048 + vi * 16] = val; }
        }
        {
#pragma unroll
            for (int ks = 0; ks < 2; ++ks) {
                const int s0 = 32 * ks, q = (lane & 15) >> 2, p = lane & 3;
                const int r1 = s0 + 8 * fq + q, r2 = r1 + 4;
                const s16x4 alo = tr_read(lds0 + gbo + G_KI + sw256(r1, 2 * w + (p >> 1)) + (p & 1) * 8), ahi = tr_read(lds0 + gbo + G_KI + sw256(r2, 2 * w + (p >> 1)) + (p & 1) * 8);
                s16x4 lo[4], hi[4];
#pragma unroll
                for (int vt = 0; vt < 4; ++vt) { lo[vt] = tr_read(xtr + gbo + G_V + (unsigned)((s0 + 8 * fq) * XROW + vt * 32)); hi[vt] = tr_read(xtr + gbo + G_V + (unsigned)((s0 + 8 * fq + 4) * XROW + vt * 32)); }
                MX_LGKM0();
                const bf16x8 af = cat8(alo, ahi);
#pragma unroll
                for (int vt = 0; vt < 4; ++vt) st[vt] = __builtin_amdgcn_mfma_f32_16x16x32_bf16(af, cat8(lo[vt], hi[vt]), st[vt], 0, 0, 0);
            }
            const f32x4 d4 = *(const LAS f32x4*)((LAS float*)(gb + G_DEC) + 16 * w + 4 * fq);
#pragma unroll
            for (int vt = 0; vt < 4; ++vt) st[vt] = st[vt] * d4;
        }
        if (c + 1 < 32) GLA_WRITE(pb ^ 1);
        MX_BAR_L();
    }
    asm volatile("s_waitcnt vmcnt(0)" ::: "memory");
#undef GLA_LOAD
#undef GLA_WRITE
}

__device__ __forceinline__ void finalize_phase(bf16_t* MIX, const bf16_t* PROJ, const float* ssd_norm, const float* gla_norm, int gw, int ngw, int lane) {
    for (int m = gw; m < T; m += ngw) {
        bf16_t* mr = MIX + (size_t)m * 2048; const bf16_t* pr = PROJ + (size_t)m * NO_IN;
        float y[2][8]; float s = 0.f;
#pragma unroll
        for (int j = 0; j < 2; ++j) { const int col = 512 * j + 8 * lane; const u32x4 a = *(const u32x4*)(mr + col), z = __builtin_nontemporal_load((const u32x4*)(pr + col));
#pragma unroll
            for (int i = 0; i < 4; ++i) { const float y0 = __uint_as_float(a[i] << 16), y1 = __uint_as_float(a[i] & 0xffff0000u), z0 = __uint_as_float(z[i] << 16), z1 = __uint_as_float(z[i] & 0xffff0000u);
                y[j][2 * i] = y0 * siluf(z0); y[j][2 * i + 1] = y1 * siluf(z1); s += y[j][2 * i] * y[j][2 * i] + y[j][2 * i + 1] * y[j][2 * i + 1]; } }
        const float rs = rsqrtf(wave_sum(s) * (1.f / 1024.f) + EPS);
#pragma unroll
        for (int j = 0; j < 2; ++j) { const int col = 512 * j + 8 * lane; const f32x4 w0 = *(const f32x4*)(ssd_norm + col), w1 = *(const f32x4*)(ssd_norm + col + 4);
            u32x4 o; o.x = cvt_pk_bf16(y[j][0] * rs * w0[0], y[j][1] * rs * w0[1]); o.y = cvt_pk_bf16(y[j][2] * rs * w0[2], y[j][3] * rs * w0[3]);
            o.z = cvt_pk_bf16(y[j][4] * rs * w1[0], y[j][5] * rs * w1[1]); o.w = cvt_pk_bf16(y[j][6] * rs * w1[2], y[j][7] * rs * w1[3]);
            *(u32x4*)(mr + col) = o; }
#pragma unroll
        for (int j = 0; j < 2; ++j) { const int cc = 512 * j + 8 * lane; const u32x4 a = *(const u32x4*)(mr + 1024 + cc), r = __builtin_nontemporal_load((const u32x4*)(pr + 4608 + cc));
            float o[8]; float s2 = 0.f;
#pragma unroll
            for (int i = 0; i < 4; ++i) { o[2 * i] = __uint_as_float(a[i] << 16); o[2 * i + 1] = __uint_as_float(a[i] & 0xffff0000u); s2 += o[2 * i] * o[2 * i] + o[2 * i + 1] * o[2 * i + 1]; }
#pragma unroll
            for (int of = 1; of < 32; of <<= 1) s2 += __shfl_xor(s2, of);
            const float r2 = rsqrtf(s2 * (1.f / 256.f) + EPS); const int v0 = 8 * (lane & 31);
            const f32x4 w0 = *(const f32x4*)(gla_norm + v0), w1 = *(const f32x4*)(gla_norm + v0 + 4);
            float f[8];
#pragma unroll
            for (int i = 0; i < 4; ++i) { f[2 * i] = siluf(__uint_as_float(r[i] << 16)); f[2 * i + 1] = siluf(__uint_as_float(r[i] & 0xffff0000u)); }
            u32x4 ov; ov.x = cvt_pk_bf16(o[0] * r2 * w0[0] * f[0], o[1] * r2 * w0[1] * f[1]); ov.y = cvt_pk_bf16(o[2] * r2 * w0[2] * f[2], o[3] * r2 * w0[3] * f[3]);
            ov.z = cvt_pk_bf16(o[4] * r2 * w1[0] * f[4], o[5] * r2 * w1[1] * f[5]); ov.w = cvt_pk_bf16(o[6] * r2 * w1[2] * f[6], o[7] * r2 * w1[3] * f[7]);
            *(u32x4*)(mr + 1024 + cc) = ov; }
    }
}
#undef MX_LGKM0
#undef MX_BAR
#undef MX_BAR_L
}
namespace mk {
__device__ __forceinline__ void tp_norm_rows(const float* src, const float* g, bf16_t* xn, int gw, int ngw, int lane) {
    f32x4 gg[4];
#pragma unroll
    for (int j = 0; j < 4; ++j) gg[j] = ((const f32x4*)g)[lane + 64 * j];
    for (int m = gw; m < T; m += ngw) {
        const f32x4* p = (const f32x4*)(src + (size_t)m * DM); f32x4 v[4]; float s = 0.f;
#pragma unroll
        for (int j = 0; j < 4; ++j) { v[j] = __builtin_nontemporal_load(p + lane + 64 * j); s += (v[j][0] * v[j][0] + v[j][1] * v[j][1]) + (v[j][2] * v[j][2] + v[j][3] * v[j][3]); }
        const float r = rsqrtf(wave_sum(s) * (1.f / DM) + EPS);
        u32x2* o = (u32x2*)(xn + (size_t)m * DM);
#pragma unroll
        for (int j = 0; j < 4; ++j) { const f32x4 y = v[j] * r * gg[j]; u32x2 w; w.x = cvt_pk_bf16(y[0], y[1]); w.y = cvt_pk_bf16(y[2], y[3]); o[lane + 64 * j] = w; }
    }
}
template <bool FINAL> __device__ __forceinline__ void tp_combine_norm(bf16_t* hb, const bf16_t* Y, const float* g, bf16_t* xn, float* out, int gw, int ngw, int lane) {
    f32x4 gg[2][2];
#pragma unroll
    for (int j = 0; j < 2; ++j) { gg[j][0] = *(const f32x4*)(g + 512 * j + 8 * lane); gg[j][1] = *(const f32x4*)(g + 512 * j + 8 * lane + 4); }
    for (int m = gw; m < T; m += ngw) {
        float v[2][8]; float s = 0.f;
#pragma unroll
        for (int j = 0; j < 2; ++j) { const size_t o = (size_t)m * DM + 512 * j + 8 * lane;
            const u32x4 a = *(const u32x4*)(hb + o), y0 = __builtin_nontemporal_load((const u32x4*)(Y + o)), y1 = __builtin_nontemporal_load((const u32x4*)(Y + (size_t)T * DM + o));
#pragma unroll
            for (int i = 0; i < 4; ++i) { v[j][2 * i] = __uint_as_float(a[i] << 16) + __uint_as_float(y0[i] << 16) + __uint_as_float(y1[i] << 16);
                v[j][2 * i + 1] = __uint_as_float(a[i] & 0xffff0000u) + __uint_as_float(y0[i] & 0xffff0000u) + __uint_as_float(y1[i] & 0xffff0000u);
                s += v[j][2 * i] * v[j][2 * i] + v[j][2 * i + 1] * v[j][2 * i + 1]; } }
        const float r = rsqrtf(wave_sum(s) * (1.f / DM) + EPS);
#pragma unroll
        for (int j = 0; j < 2; ++j) { const size_t o = (size_t)m * DM + 512 * j + 8 * lane;
            if (FINAL) { f32x4 o0, o1;
#pragma unroll
                for (int i = 0; i < 4; ++i) { o0[i] = v[j][i] * r * gg[j][0][i]; o1[i] = v[j][4 + i] * r * gg[j][1][i]; }
                __builtin_nontemporal_store(o0, (f32x4*)(out + o)); __builtin_nontemporal_store(o1, (f32x4*)(out + o + 4));
            } else { u32x4 hw, xw;
#pragma unroll
                for (int i = 0; i < 4; ++i) { hw[i] = cvt_pk_bf16(v[j][2 * i], v[j][2 * i + 1]);
                    xw[i] = cvt_pk_bf16(v[j][2 * i] * r * gg[j][i >> 1][(2 * i) & 3], v[j][2 * i + 1] * r * gg[j][i >> 1][(2 * i + 1) & 3]); }
                *(u32x4*)(hb + o) = hw; *(u32x4*)(xn + o) = xw; }
        }
    }
}
template <bool DRY> __device__ __forceinline__ void tp_route_mfma(const bf16_t* hb, const float* g, bf16_t* xn, const bf16_t* whi, const bf16_t* wlo, const float* bg, const float* br,
                                                                  unsigned* counts, int* lists, float* gates, LAS char* shm, int vcu, int G, int lane, int wave) {
    const int fr = lane & 15, fq = lane >> 4, kbase = wave * 128;
    LAS float* xacc = (LAS float*)shm;
    LAS float* ltile = (LAS float*)(shm + 106496);
    LAS float* rsl = (LAS float*)(shm + 118784);
    for (int blk = vcu; blk < T / 64; blk += G) {
        const int r0 = blk * 64;
        bf16x8 wh[3][4], wl[3][4];
#pragma unroll
        for (int nt = 0; nt < 3; ++nt)
#pragma unroll
            for (int ks = 0; ks < 4; ++ks) { const size_t wo = (size_t)(nt * 16 + fr) * DM + kbase + 32 * ks + 8 * fq; wh[nt][ks] = *(const bf16x8*)(whi + wo); wl[nt][ks] = *(const bf16x8*)(wlo + wo); }
#pragma unroll
        for (int tp = 0; tp < 2; ++tp) {
            u32x4 hq[2][4];
#pragma unroll
            for (int t2 = 0; t2 < 2; ++t2)
#pragma unroll
                for (int ks = 0; ks < 4; ++ks) hq[t2][ks] = *(const u32x4*)(hb + (size_t)(r0 + 16 * (2 * tp + t2) + fr) * DM + kbase + 32 * ks + 8 * fq);
#pragma unroll
            for (int t2 = 0; t2 < 2; ++t2) { const int t = 2 * tp + t2;
                f32x4 acc[3]; acc[0] = (f32x4){0.f, 0.f, 0.f, 0.f}; acc[1] = acc[0]; acc[2] = acc[0];
                float ss = 0.f;
#pragma unroll
                for (int ks = 0; ks < 4; ++ks) { const u32x4 v = hq[t2][ks];
                    const float x0 = __uint_as_float(v.x << 16), x1 = __uint_as_float(v.x & 0xffff0000u), x2 = __uint_as_float(v.y << 16), x3 = __uint_as_float(v.y & 0xffff0000u);
                    const float x4 = __uint_as_float(v.z << 16), x5 = __uint_as_float(v.z & 0xffff0000u), x6 = __uint_as_float(v.w << 16), x7 = __uint_as_float(v.w & 0xffff0000u);
                    ss += (x0 * x0 + x1 * x1) + (x2 * x2 + x3 * x3) + (x4 * x4 + x5 * x5) + (x6 * x6 + x7 * x7);
                    const bf16x8 a = __builtin_bit_cast(bf16x8, v);
#pragma unroll
                    for (int nt = 0; nt < 3; ++nt) { acc[nt] = __builtin_amdgcn_mfma_f32_16x16x32_bf16(a, wh[nt][ks], acc[nt], 0, 0, 0); acc[nt] = __builtin_amdgcn_mfma_f32_16x16x32_bf16(a, wl[nt][ks], acc[nt], 0, 0, 0); } }
                ss += __shfl_xor(ss, 16); ss += __shfl_xor(ss, 32);
                LAS float* xa = xacc + (t * 8 + wave) * 13 * 64;
#pragma unroll
                for (int nt = 0; nt < 3; ++nt)
#pragma unroll
                    for (int i = 0; i < 4; ++i) xa[(nt * 4 + i) * 64 + lane] = acc[nt][i];
                xa[12 * 64 + lane] = ss;
            }
            asm volatile("" ::: "memory");
        }
        u32x4 hv[4][4];
#pragma unroll
        for (int t = 0; t < 4; ++t)
#pragma unroll
            for (int ks = 0; ks < 4; ++ks) hv[t][ks] = *(const u32x4*)(hb + (size_t)(r0 + 16 * t + fr) * DM + kbase + 32 * ks + 8 * fq);
        asm volatile("s_waitcnt lgkmcnt(0)\n\ts_barrier" ::: "memory");
        float rs[4];
#pragma unroll
        for (int t = 0; t < 4; ++t) { float s = 0.f;
#pragma unroll
            for (int w2 = 0; w2 < 8; ++w2) s += xacc[(t * 8 + w2) * 13 * 64 + 12 * 64 + lane];
            rs[t] = rsqrtf(s * (1.f / DM) + EPS); }
        if (wave < 4) {
            const LAS float* xs = xacc + (wave * 8) * 13 * 64;
#pragma unroll
            for (int nt = 0; nt < 3; ++nt)
#pragma unroll
                for (int i = 0; i < 4; ++i) { float v = 0.f;
#pragma unroll
                    for (int w2 = 0; w2 < 8; ++w2) v += xs[w2 * 13 * 64 + (nt * 4 + i) * 64 + lane];
                    ltile[(16 * wave + 4 * fq + i) * 48 + nt * 16 + fr] = v; }
            float rw = rs[0];
#pragma unroll
            for (int t = 1; t < 4; ++t) if (wave == t) rw = rs[t];
            if (fq == 0) rsl[16 * wave + fr] = rw;
        }
        f32x4 gq[4][2];
#pragma unroll
        for (int ks = 0; ks < 4; ++ks) { gq[ks][0] = *(const f32x4*)(g + kbase + 32 * ks + 8 * fq); gq[ks][1] = *(const f32x4*)(g + kbase + 32 * ks + 8 * fq + 4); }
#pragma unroll
        for (int t = 0; t < 4; ++t) { bf16_t* xp = xn + (size_t)(r0 + 16 * t + fr) * DM + kbase + 8 * fq; const float r = rs[t];
#pragma unroll
            for (int ks = 0; ks < 4; ++ks) { const u32x4 v = hv[t][ks]; const f32x4 g0 = gq[ks][0], g1 = gq[ks][1]; u32x4 o;
                o.x = cvt_pk_bf16(__uint_as_float(v.x << 16) * r * g0[0], __uint_as_float(v.x & 0xffff0000u) * r * g0[1]); o.y = cvt_pk_bf16(__uint_as_float(v.y << 16) * r * g0[2], __uint_as_float(v.y & 0xffff0000u) * r * g0[3]);
                o.z = cvt_pk_bf16(__uint_as_float(v.z << 16) * r * g1[0], __uint_as_float(v.z & 0xffff0000u) * r * g1[1]); o.w = cvt_pk_bf16(__uint_as_float(v.w << 16) * r * g1[2], __uint_as_float(v.w & 0xffff0000u) * r * g1[3]);
                *(u32x4*)(xp + 32 * ks) = o; } }
        asm volatile("s_waitcnt lgkmcnt(0)\n\ts_barrier" ::: "memory");
        if (wave == 0) {
            const LAS float* lt = ltile + lane * 48; const float rsr = rsl[lane];
            float gl[4]; const f32x4 bgv = *(const f32x4*)bg;
#pragma unroll
            for (int e = 0; e < 4; ++e) gl[e] = rsr * lt[e] + bgv[e];
            int gi = 0; float gm = gl[0];
#pragma unroll
            for (int e = 1; e < 4; ++e) if (gl[e] > gm) { gm = gl[e]; gi = e; }
            float gs = 0.f;
#pragma unroll
            for (int e = 0; e < 4; ++e) gs += expf(gl[e] - gm);
            const float gwt = 1.f / gs;
            float b0 = -INFINITY, b1 = -INFINITY; int i0 = 0, i1 = 0;
            const f32x4 brv0 = *(const f32x4*)(br + gi * 8), brv1 = *(const f32x4*)(br + gi * 8 + 4);
#pragma unroll
            for (int i = 0; i < 8; ++i) { const float v = rsr * lt[4 + gi * 8 + i] + (i < 4 ? brv0[i & 3] : brv1[i & 3]);
                if (v > b0) { b1 = b0; i1 = i0; b0 = v; i0 = i; } else if (v > b1) { b1 = v; i1 = i; } }
            const int t = r0 + lane;
            const float w0 = 1.f / (1.f + expf(b1 - b0)), w1 = 1.f - w0;
            const int e0 = gi * 8 + i0, e1 = gi * 8 + i1;
            gates[2 * t] = gwt * w0; gates[2 * t + 1] = gwt * w1;
            if (!DRY) {
                const unsigned p0 = __hip_atomic_fetch_add(counts + e0 * 64, 1u, __ATOMIC_RELAXED, __HIP_MEMORY_SCOPE_AGENT);
                const unsigned p1 = __hip_atomic_fetch_add(counts + e1 * 64, 1u, __ATOMIC_RELAXED, __HIP_MEMORY_SCOPE_AGENT);
                lists[e0 * CAP + p0] = 2 * t; lists[e1 * CAP + p1] = 2 * t + 1; }
        }
    }
    asm volatile("s_waitcnt lgkmcnt(0)\n\ts_barrier" ::: "memory");
}

struct Args {
    const float* in[26]; float* out; unsigned char* ws; int ph_lo, ph_hi, use_bar, li;
};
enum Phase { P_CONV0 = 0, P_G1, P_ATT, P_G2, P_TP1, P_G3, P_G4, P_TP2, P_G5, P_CONV, P_MIXER, P_FIN, P_G6, P_TP3, P_G7, P_G8, P_TP4, P_COUNT };

__device__ __forceinline__ void moe_setup(volatile LAS int* misc, unsigned* counts) {
    if (threadIdx.x < 64) {
        const int ln = threadIdx.x & 63, e = ln & 31;
        const int c = (int)__hip_atomic_load(counts + e * 64, __ATOMIC_RELAXED, __HIP_MEMORY_SCOPE_AGENT);
        const int tl = (c + 255) >> 8; int incl = tl;
#pragma unroll
        for (int o = 1; o < 32; o <<= 1) { const int t = __shfl_up(incl, o, 32); if (e >= o) incl += t; }
        if (ln < 32) { misc[64 + e] = c; misc[16 + e] = incl - tl; if (e == 31) misc[16 + 32] = incl;
            for (int i = 0; i < tl; ++i) misc[96 + (incl - tl) + i] = e; }
    }
    __syncthreads();
}

typedef const float* kin_ptr_t;
__device__ __forceinline__ const float* kin(int i) { return ((const volatile kin_ptr_t __attribute__((address_space(4)))*)__builtin_amdgcn_kernarg_segment_ptr())[i]; }
#ifndef CV_TAIL_ITEMS
#define CV_TAIL_ITEMS 8192
#endif
constexpr int CV_I_EIN = 16 * 80, CV_I_EOUT = 16 * 32, CV_I_OIN = 16 * 184, CV_I_OOUT = 32 * 32, CV_I_GU = 16 * 32, CV_I_D = 8 * 32;
constexpr int CV_NITEMS = CV_I_EIN + CV_I_EOUT + CV_I_OIN + CV_I_OOUT + 32 * CV_I_GU + 32 * CV_I_D;
__device__ __forceinline__ CvItem cv_decode0(unsigned char* ws, int it, int lane) {
    int r = it;
    if (r < CV_I_EIN) return cv_make(SrcEvenIn{kin(4)}, 2312, 1024, 80, (bf16_t*)(ws + WS_WEIN), r, lane); r -= CV_I_EIN;
    if (r < CV_I_EOUT) return cv_make(SrcPlain{kin(7), 1024}, 1024, 1024, 32, (bf16_t*)(ws + WS_WEOUT), r, lane); r -= CV_I_EOUT;
    if (r < CV_I_OIN) return cv_make(SrcOddIn{kin(8)}, 5664, 1024, 184, (bf16_t*)(ws + WS_WOIN), r, lane); r -= CV_I_OIN;
    if (r < CV_I_OOUT) return cv_make(SrcPlain{kin(18), 1024}, 1024, 2048, 32, (bf16_t*)(ws + WS_WOOUT), r, lane); r -= CV_I_OOUT;
    if (r < 32 * CV_I_GU) { const int e = r / CV_I_GU; return cv_make_gu(kin(23) + (size_t)e * 1024 * 512, kin(24) + (size_t)e * 1024 * 512, (bf16_t*)(ws + WS_WGU) + (size_t)e * 1024 * 1024, r % CV_I_GU, lane); } r -= 32 * CV_I_GU;
    { const int e = r / CV_I_D; return cv_make(SrcPlain{kin(25) + (size_t)e * 512 * 1024, 1024}, 1024, 512, 32, (bf16_t*)(ws + WS_WD) + (size_t)e * 1024 * 512, r % CV_I_D, lane); }
}
__device__ __forceinline__ void cv_run0(unsigned char* ws, int lo, int hi, int w, int nw, LAS float* scr, int lane) {
    for (int it = lo + 2 * w; it < hi; it += 2 * nw) {
        float va[32], vb[32]; const CvItem da = cv_decode0(ws, it, lane); cv_load(da, va);
        const bool n1 = it + 1 < hi; CvItem db = da; if (n1) { db = cv_decode0(ws, it + 1, lane); cv_load(db, vb); }
        cv_finish(da, va, scr, lane);
        if (n1) cv_finish(db, vb, scr, lane);
    }
}

constexpr int CV_NIT1 = 32 * (CV_I_GU + CV_I_D);
#ifndef CV1_TAIL_G5
#define CV1_TAIL_G5 4096
#endif
#ifndef CV1_TAIL_MIX
#define CV1_TAIL_MIX 8192
#endif
#ifndef CV1_TAIL_G4
#define CV1_TAIL_G4 8192
#endif
#ifndef CV0_TAIL_G3
#define CV0_TAIL_G3 0
#endif
__device__ __forceinline__ CvItem cv_decode1(unsigned char* ws, int it, int lane) {
    const size_t L1 = (size_t)32 * 1024 * 512; int r = it;
    if (r < 32 * CV_I_GU) { const int e = r / CV_I_GU; return cv_make_gu(kin(23) + L1 + (size_t)e * 1024 * 512, kin(24) + L1 + (size_t)e * 1024 * 512, (bf16_t*)(ws + WS_WGU) + (size_t)e * 1024 * 1024, r % CV_I_GU, lane); } r -= 32 * CV_I_GU;
    { const int e = r / CV_I_D; return cv_make(SrcPlain{kin(25) + L1 + (size_t)e * 512 * 1024, 1024}, 1024, 512, 32, (bf16_t*)(ws + WS_WD) + (size_t)e * 1024 * 512, r % CV_I_D, lane); }
}
__device__ __forceinline__ void cv_run1(unsigned char* ws, int lo, int hi, int w, int nw, LAS float* scr, int lane) {
    for (int it = lo + 2 * w; it < hi; it += 2 * nw) {
        float va[32], vb[32]; const CvItem da = cv_decode1(ws, it, lane); cv_load(da, va);
        const bool n1 = it + 1 < hi; CvItem db = da; if (n1) { db = cv_decode1(ws, it + 1, lane); cv_load(db, vb); }
        cv_finish(da, va, scr, lane);
        if (n1) cv_finish(db, vb, scr, lane);
    }
}

__global__ void __launch_bounds__(NTHR, 2) mk_fwd(Args args) {
    extern __shared__ __attribute__((aligned(16))) unsigned char lds_raw[];
    LAS unsigned char* lds = (LAS unsigned char*)lds_raw;
    volatile LAS int* misc = (volatile LAS int*)(lds + MISC_OFF);
    const int tid = threadIdx.x, lane = tid & 63, wave = __builtin_amdgcn_readfirstlane(tid >> 6);
    const int G = gridDim.x, bx = blockIdx.x;
    const int vcu = (G % 8 == 0) ? (bx % 8) * (G / 8) + bx / 8 : bx;
    const int gw = vcu * NWAVES + wave, ngw = G * NWAVES;
    for (int u = tid; u < 256; u += NTHR) misc[u] = 0;
    __syncthreads();
#define ws ((unsigned char*)kin(27))
#define XN ((bf16_t*)(ws + WS_XN))
#define PROJ ((bf16_t*)(ws + WS_PROJ))
#define MIX ((bf16_t*)(ws + WS_MIX))
#define FB ((float*)(ws + WS_FB))
#define LISTS ((int*)(ws + WS_LISTS))
#define GATES ((float*)(ws + WS_GATES))
#define HB ((bf16_t*)(ws + WS_H))
#define YB ((bf16_t*)(ws + WS_Y))
#define outp ((float*)kin(26))
#define HBS ((bf16_t*)(ws + WS_HB))
#define ctl ((unsigned*)(ws + WS_CTL))
    XcdBarrier bar; bar.bar = ctl + CW_BAR + args.li * XCD_BAR_WORDS; bar.x = 0; bar.st = nullptr;
    if (args.use_bar) bar = xcd_barrier_post(ctl + CW_BAR + args.li * XCD_BAR_WORDS, (volatile LAS unsigned*)misc);
#ifdef BAR_TWICE
#define GRID_BAR() do { if (args.use_bar) { xcd_barrier(bar); xcd_barrier(bar); } } while (0)
#else
#define GRID_BAR() do { if (args.use_bar) xcd_barrier(bar); } while (0)
#endif
    const int lo = args.ph_lo, hi = args.ph_hi;
#ifndef MK_PHASE_MASK
#define MK_PHASE_MASK 0xffffffffu
#endif
#define IN(k) (((MK_PHASE_MASK >> (k)) & 1u) && lo <= (k) && (k) < hi)
#ifndef MK_REP_MASK
#define MK_REP_MASK 0u
#endif
#define NREP(k) ((((MK_REP_MASK) >> (k)) & 1u) ? 2 : 1)
#define REP(k) for (int _r = 0; _r < ((((MK_REP_MASK) >> (k)) & 1u) ? 2 : 1); ++_r)
#define SEAM(k) do { if (IN(k) && IN((k) + 1)) GRID_BAR(); } while (0)
#define XIN kin(0)

    if (IN(P_CONV0)) REP(P_CONV0) {
        LAS float* scr = (LAS float*)(lds + wave * 16384);
        constexpr int OI_LO = CV_I_EIN + CV_I_EOUT, OI_HI = OI_LO + CV_I_OIN + CV_I_OOUT;
        if (CV0_TAIL_G3 && G == 256) { cv_run0(ws, 0, OI_LO, gw, ngw, scr, lane); cv_run0(ws, OI_HI, CV_NITEMS - CV_TAIL_ITEMS, gw, ngw, scr, lane); }
        else cv_run0(ws, 0, CV_NITEMS - CV_TAIL_ITEMS, gw, ngw, scr, lane);
        { bf16_t* wrt = (bf16_t*)(ws + WS_WRT);
          for (int i = gw * 64 + lane; i < 2 * 48 * 1024; i += ngw * 64) { const int l = i / (48 * 1024), rem = i % (48 * 1024), e = rem >> 10, k = rem & 1023;
              const float v = ((e < 4) ? kin(19)[(size_t)l * 4096 + k * 4 + e] : (e < 36 ? kin(21)[(size_t)l * 32768 + k * 32 + (e - 4)] : 0.f)) * kin(2)[(size_t)l * DM + k];
              const unsigned hi = cvt_pk_bf16(v, 0.f) & 0xffffu; const unsigned lo = cvt_pk_bf16(v - __uint_as_float(hi << 16), 0.f) & 0xffffu;
              wrt[(size_t)(2 * l) * 48 * 1024 + rem] = (bf16_t)hi; wrt[(size_t)(2 * l + 1) * 48 * 1024 + rem] = (bf16_t)lo; } }
        tp_norm_rows(XIN, kin(1), XN, gw, ngw, lane);
    }
    SEAM(P_CONV0);
    if (IN(P_G1)) {
        pg8::Gemm g{XN, (const bf16_t*)(ws + WS_WEIN), 1024, 0}; pg8::DenseOrder S; S.init(T, NE_IN, G, bx, NREP(P_G1));
        pg8::EpiProjEven E{PROJ, FB};
        pg8::gemm_phase<pg8::EpiProjEven, pg8::DenseOrder, true>(lds, g, S, E);
        if (CV_TAIL_ITEMS > 0 && G == 256 && bx >= 128)
            cv_run0(ws, CV_NITEMS - CV_TAIL_ITEMS, CV_NITEMS, (bx - 128) * NWAVES + wave, 128 * NWAVES, (LAS float*)(lds + wave * 16384), lane);
        else if (CV_TAIL_ITEMS > 0 && G != 256) cv_run0(ws, CV_NITEMS - CV_TAIL_ITEMS, CV_NITEMS, gw, ngw, (LAS float*)(lds + wave * 16384), lane);
    }
    SEAM(P_G1);
    if (IN(P_ATT)) REP(P_ATT) {
        if (G == 256) {
            const int bh = vcu >> 2, s = vcu & 3, b = bh >> 3, h = bh & 7;
            const float fbias = kin(6)[h];
            att::fox_unit_p<false>((char*)lds_raw, (LAS char*)lds, b, h, 7 - s, PROJ, FB, fbias, MIX, ctl + 32, true);
            att::fox_unit_p<false>((char*)lds_raw, (LAS char*)lds, b, h, s, PROJ, FB, fbias, MIX, ctl + 32, false);
            for (int i = 0; i < 2; ++i) { const int u = vcu * 2 + i; const int sb = u >> 6, kvh = (u >> 5) & 1, blk = u & 31; att::swa_unit((LAS char*)lds, sb, kvh, blk, PROJ, kin(5), MIX); }
        }
    }
    SEAM(P_ATT);
    if (IN(P_G2)) {
        pg8::Gemm g{MIX, (const bf16_t*)(ws + WS_WEOUT), 1024, 0}; pg8::DenseOrder S; S.init(T, DM, G, bx, NREP(P_G2));
        pg8::EpiResidB<true> E{XIN, HBS};
        pg8::gemm_phase<pg8::EpiResidB<true>, pg8::DenseOrder, true>(lds, g, S, E);
    }
    SEAM(P_G2);
    if (IN(P_TP1)) {
#ifdef TP1_REP
        tp_route_mfma<true>(HBS, kin(2), XN, (const bf16_t*)(ws + WS_WRT), (const bf16_t*)(ws + WS_WRT) + 48 * 1024, kin(20), kin(22), ctl + CW_CNT, LISTS, GATES, (LAS char*)lds, vcu, G, lane, wave);
#endif
        tp_route_mfma<false>(HBS, kin(2), XN, (const bf16_t*)(ws + WS_WRT), (const bf16_t*)(ws + WS_WRT) + 48 * 1024, kin(20), kin(22), ctl + CW_CNT, LISTS, GATES, (LAS char*)lds, vcu, G, lane, wave);
    }
    SEAM(P_TP1);
    if (IN(P_G3)) {
        moe_setup(misc, ctl + CW_CNT);
        if (CV0_TAIL_G3 && G == 256) {
            const int U = misc[16 + 32] * 4, nidle = 768 - U;
            if (nidle > 0 && bx >= 256 - nidle) { constexpr int OI_LO = CV_I_EIN + CV_I_EOUT, OI_HI = OI_LO + CV_I_OIN + CV_I_OOUT;
                cv_run0(ws, OI_LO, OI_HI, (bx - (256 - nidle)) * NWAVES + wave, nidle * NWAVES, (LAS float*)(lds + wave * 16384), lane); }
            else if (nidle <= 0) { constexpr int OI_LO = CV_I_EIN + CV_I_EOUT, OI_HI = OI_LO + CV_I_OIN + CV_I_OOUT; cv_run0(ws, OI_LO, OI_HI, gw, ngw, (LAS float*)(lds + wave * 16384), lane); }
        }
        __syncthreads();
        pg8::Gemm g{XN, (const bf16_t*)(ws + WS_WGU), 1024, (size_t)1024 * 1024 * 2};
        pg8::MoeOrder S{(const volatile LAS int*)(misc + 16), (const volatile LAS int*)(misc + 64), LISTS, G, bx, true, NREP(P_G3)};
        pg8::EpiGateUp E{HB};
        pg8::gemm_phase<pg8::EpiGateUp, pg8::MoeOrder, true>(lds, g, S, E);
    }
    SEAM(P_G3);
    if (IN(P_G4)) {
        moe_setup(misc, ctl + CW_CNT);
        pg8::Gemm g{HB, (const bf16_t*)(ws + WS_WD), 512, (size_t)1024 * 512 * 2};
        pg8::MoeOrder S{(const volatile LAS int*)(misc + 16), (const volatile LAS int*)(misc + 64), LISTS, G, bx, false, NREP(P_G4)};
        pg8::EpiDown E{YB, LISTS, GATES, (const volatile LAS int*)(misc + 64)};
        pg8::gemm_phase<pg8::EpiDown, pg8::MoeOrder, true>(lds, g, S, E);
        if (CV1_TAIL_G4 > 0 && G == 256) {
            const int U = misc[16 + 32] * 4, nidle = 768 - U, lo1 = CV_NIT1 - CV1_TAIL_G5 - CV1_TAIL_MIX - CV1_TAIL_G4, hi1 = lo1 + CV1_TAIL_G4;
            if (nidle >= 32) { if (bx >= 256 - nidle) cv_run1(ws, lo1, hi1, (bx - (256 - nidle)) * NWAVES + wave, nidle * NWAVES, (LAS float*)(lds + wave * 16384), lane); }
            else cv_run1(ws, lo1, hi1, gw, ngw, (LAS float*)(lds + wave * 16384), lane);
        }
    }
    SEAM(P_G4);
    if (IN(P_TP2)) {
        tp_combine_norm<false>(HBS, YB, kin(1) + DM, XN, nullptr, gw, ngw, lane);
        LAS float* scr = (LAS float*)(lds + wave * 16384);
        constexpr int I_GU = 16 * 32, I_D = 8 * 32; const size_t L1 = (size_t)32 * 1024 * 512;
        auto decode = [&](int it) -> CvItem {
            int r = it;
            if (r < 32 * I_GU) { const int e = r / I_GU; return cv_make_gu(kin(23) + L1 + (size_t)e * 1024 * 512, kin(24) + L1 + (size_t)e * 1024 * 512, (bf16_t*)(ws + WS_WGU) + (size_t)e * 1024 * 1024, r % I_GU, lane); } r -= 32 * I_GU;
            { const int e = r / I_D; return cv_make(SrcPlain{kin(25) + L1 + (size_t)e * 512 * 1024, 1024}, 1024, 512, 32, (bf16_t*)(ws + WS_WD) + (size_t)e * 1024 * 512, r % I_D, lane); }
        };
        const int NIT1 = CV_NIT1 - ((G == 256) ? (CV1_TAIL_G5 + CV1_TAIL_MIX + CV1_TAIL_G4) : 0);
        for (int it = 2 * gw; it < NIT1; it += 2 * ngw) {
            float va[32], vb[32]; const CvItem da = decode(it); cv_load(da, va);
            const bool n1 = it + 1 < NIT1; CvItem db = da; if (n1) { db = decode(it + 1); cv_load(db, vb); }
            cv_finish(da, va, scr, lane);
            if (n1) cv_finish(db, vb, scr, lane);
        }
    }
    SEAM(P_TP2);
    if (IN(P_G5)) {
        pg8::Gemm g{XN, (const bf16_t*)(ws + WS_WOIN), 1024, 0}; pg8::DenseOrder S; S.init(T, NO_IN, G, bx, NREP(P_G5));
        pg8::EpiProjOdd E{PROJ, (float*)(ws + WS_DTG)};
        pg8::gemm_phase<pg8::EpiProjOdd, pg8::DenseOrder, true>(lds, g, S, E);
        if (CV1_TAIL_G5 > 0 && G == 256 && bx >= 192)
            cv_run1(ws, CV_NIT1 - CV1_TAIL_G5 - CV1_TAIL_MIX, CV_NIT1 - CV1_TAIL_MIX, (bx - 192) * NWAVES + wave, 64 * NWAVES, (LAS float*)(lds + wave * 16384), lane);
    }
    SEAM(P_G5);
    if (IN(P_CONV)) {
        mx::prep_conv(PROJ, (bf16_t*)(ws + WS_CONV), kin(9), kin(10), vcu, G, tid);
#ifdef PREP_REP_CONV
        mx::prep_conv(PROJ, (bf16_t*)(ws + WS_CONV), kin(9), kin(10), vcu, G, tid);
#endif
        mx::prep_ssd((const float*)(ws + WS_DTG), (float*)(ws + mx::WS_DTV), (float*)(ws + mx::WS_ACS), kin(11), kin(12), vcu, G, lane, wave);
#ifdef PREP_REP_SSD
        mx::prep_ssd((const float*)(ws + WS_DTG), (float*)(ws + mx::WS_DTV), (float*)(ws + mx::WS_ACS), kin(11), kin(12), vcu, G, lane, wave);
#endif
        mx::prep_gla(PROJ, (const float*)(ws + WS_DTG), (bf16_t*)(ws + mx::WS_QD), (bf16_t*)(ws + mx::WS_KI), (bf16_t*)(ws + mx::WS_KE), (float*)(ws + mx::WS_DEC), kin(15), kin(16), vcu, G, tid, lane, wave, (LAS char*)lds);
#ifdef PREP_REP_GLA
        mx::prep_gla(PROJ, (const float*)(ws + WS_DTG), (bf16_t*)(ws + mx::WS_QD), (bf16_t*)(ws + mx::WS_KI), (bf16_t*)(ws + mx::WS_KE), (float*)(ws + mx::WS_DEC), kin(15), kin(16), vcu, G, tid, lane, wave, (LAS char*)lds);
#endif
    }
    SEAM(P_CONV);
    if (IN(P_MIXER)) {
        if (G == 256) {
            if (vcu < 128) {
                mx::ssd_unit64((LAS char*)lds, vcu >> 4, vcu & 15, (const bf16_t*)(ws + WS_CONV), (const float*)(ws + mx::WS_ACS), (const float*)(ws + mx::WS_DTV), kin(13)[vcu & 15], MIX);
#ifdef MIX_SSD_REP
                __syncthreads(); mx::ssd_unit((LAS char*)lds, vcu >> 4, vcu & 15, (const bf16_t*)(ws + WS_CONV), (const float*)(ws + mx::WS_ACS), (const float*)(ws + mx::WS_DTV), kin(13)[vcu & 15], MIX);
#endif
            }
            else { const int u = vcu - 128; mx::gla_unit<false>((LAS char*)lds, u >> 4, (u >> 2) & 3, u & 3, PROJ, (const bf16_t*)(ws + mx::WS_QD), (const bf16_t*)(ws + mx::WS_KI),
                                                          (const float*)(ws + mx::WS_DEC), MIX, ctl + 32);
                if (CV1_TAIL_MIX > 0) { __syncthreads(); cv_run1(ws, CV_NIT1 - CV1_TAIL_MIX, CV_NIT1, (vcu - 128) * NWAVES + wave, 128 * NWAVES, (LAS float*)(lds + wave * 16384), lane); }
#ifdef MIX_GLA_REP
                __syncthreads(); mx::gla_unit<false>((LAS char*)lds, u >> 4, (u >> 2) & 3, u & 3, PROJ, (const bf16_t*)(ws + mx::WS_QD), (const bf16_t*)(ws + mx::WS_KI), (const float*)(ws + mx::WS_DEC), MIX, ctl + 32);
#endif
            }
        }
    }
    SEAM(P_MIXER);
    if (IN(P_FIN)) {
        mx::finalize_phase(MIX, PROJ, kin(14), kin(17), gw, ngw, lane);
    }
    SEAM(P_FIN);
    if (IN(P_G6)) {
        pg8::Gemm g{MIX, (const bf16_t*)(ws + WS_WOOUT), 2048, 0}; pg8::DenseOrder S; S.init(T, DM, G, bx, NREP(P_G6));
        pg8::EpiResidB<false> E{HBS, HBS};
        pg8::gemm_phase<pg8::EpiResidB<false>, pg8::DenseOrder, true>(lds, g, S, E);
    }
    SEAM(P_G6);
    if (IN(P_TP3)) {
        tp_route_mfma<false>(HBS, kin(2) + DM, XN, (const bf16_t*)(ws + WS_WRT) + 2 * 48 * 1024, (const bf16_t*)(ws + WS_WRT) + 3 * 48 * 1024, kin(20) + 4, kin(22) + 32,
                             ctl + CW_CNT + 32 * 64, LISTS, GATES, (LAS char*)lds, vcu, G, lane, wave);
    }
    SEAM(P_TP3);
    if (IN(P_G7)) {
        moe_setup(misc, ctl + CW_CNT + 32 * 64);
        pg8::Gemm g{XN, (const bf16_t*)(ws + WS_WGU), 1024, (size_t)1024 * 1024 * 2};
        pg8::MoeOrder S{(const volatile LAS int*)(misc + 16), (const volatile LAS int*)(misc + 64), LISTS, G, bx, true, NREP(P_G7)};
        pg8::EpiGateUp E{HB};
        pg8::gemm_phase<pg8::EpiGateUp, pg8::MoeOrder, true>(lds, g, S, E);
    }
    SEAM(P_G7);
    if (IN(P_G8)) {
        moe_setup(misc, ctl + CW_CNT + 32 * 64);
        pg8::Gemm g{HB, (const bf16_t*)(ws + WS_WD), 512, (size_t)1024 * 512 * 2};
        pg8::MoeOrder S{(const volatile LAS int*)(misc + 16), (const volatile LAS int*)(misc + 64), LISTS, G, bx, false, NREP(P_G8)};
        pg8::EpiDown E{YB, LISTS, GATES, (const volatile LAS int*)(misc + 64)};
        pg8::gemm_phase<pg8::EpiDown, pg8::MoeOrder, true>(lds, g, S, E);
    }
    SEAM(P_G8);
    if (IN(P_TP4)) {
        tp_combine_norm<true>(HBS, YB, kin(3), nullptr, outp, gw, ngw, lane);
#ifdef TP4_REP
        tp_combine_norm<true>(HBS, YB, kin(3), nullptr, outp, gw, ngw, lane);
#endif
#if defined(GLA_CHECK) || defined(ATT_CHECK)
        if (__hip_atomic_load(ctl + 32, __ATOMIC_RELAXED, __HIP_MEMORY_SCOPE_AGENT) != 0u) { for (int m = gw; m < T; m += ngw) outp[(size_t)m * DM + lane] = 1000.f; }
#endif
    }
#undef IN
#undef SEAM
#undef GRID_BAR
#undef ws
#undef XN
#undef PROJ
#undef MIX
#undef FB
#undef LISTS
#undef GATES
#undef HB
#undef YB
#undef outp
#undef HBS
#undef ctl
#undef XIN
}
}

extern "C" void kernel_launch(void* const* d_in, const int* in_sizes, int n_in, void* d_out, int out_size, void* d_ws, size_t ws_size, hipStream_t stream) {
    static int grid = 0;
    if (grid == 0) {
        int dev = 0, cus = 0, per_cu = 0;
        (void)hipGetDevice(&dev); (void)hipDeviceGetAttribute(&cus, hipDeviceAttributeMultiprocessorCount, dev);
        if (n_in != 26 || out_size != mk::T * mk::DM || ws_size < mk::WS_TOTAL) { fprintf(stderr, "kernel_launch: unexpected shapes (n_in %d out %d ws %zu)\n", n_in, out_size, ws_size); grid = -1; return; }
        if (hipFuncSetAttribute((const void*)mk::mk_fwd, hipFuncAttributeMaxDynamicSharedMemorySize, mk::LDS_BYTES) != hipSuccess) { fprintf(stderr, "hipFuncSetAttribute failed\n"); grid = -1; return; }
        if (hipOccupancyMaxActiveBlocksPerMultiprocessor(&per_cu, (const void*)mk::mk_fwd, mk::NTHR, mk::LDS_BYTES) != hipSuccess || per_cu < 1) { fprintf(stderr, "occupancy query reports %d blocks per CU\n", per_cu); }
        (void)hipGetLastError();
        grid = cus;
        if (grid != 256) fprintf(stderr, "kernel_launch: %d CUs; the attention / mixer phases need 256\n", grid);
    }
    if (grid < 0) return;
    (void)hipMemsetAsync((char*)d_ws + mk::WS_CTL, 0, mk::CTL_ZERO_BYTES, stream);
    mk::Args a{};
    for (int i = 0; i < 26; ++i) a.in[i] = (const float*)d_in[i];
    a.out = (float*)d_out; a.ws = (unsigned char*)d_ws;
    a.ph_lo = 0; a.ph_hi = mk::P_COUNT; a.use_bar = 1; a.li = 0;
    hipLaunchKernelGGL(mk::mk_fwd, dim3(grid), dim3(mk::NTHR), mk::LDS_BYTES, stream, a);
}
```
